# Optimizing an MI355X kernel written in HIP

```python
import jax, jax.numpy as jnp
from jax import lax
import numpy as np

D_MODEL = 1024
BATCH = 32
SEQ = 256
DEPTH = 4
DEC_BATCH = 4
DEC_SEQ = 1024
PAST_LEN = 256

GRID_W = 64
N_HEADS = 16
HEAD_DIM = D_MODEL // N_HEADS
WIN_ROWS_MAX = 8
WIN_COLS = 16
Q_COL_BLOCK = WIN_COLS
K_COL_BLOCK = 2 * WIN_COLS
CONV_WIDTH = 31
D_FF = 4 * D_MODEL
N_MIXERS = 2
N_ATTN = (DEPTH + 1) // 2
N_CONV = DEPTH // 2
RMS_EPS = 1e-6
LN_EPS = 1e-5

kernel_name = "hybrid_natten_conformer_flow_step"


def rms_norm(x, g):
    xf = x.astype(jnp.float32)
    y = xf * lax.rsqrt(jnp.mean(xf * xf, axis=-1, keepdims=True) + RMS_EPS)
    return (y * g.astype(jnp.float32)).astype(x.dtype)


def layer_norm(x, g, b):
    xf = x.astype(jnp.float32)
    mu = jnp.mean(xf, axis=-1, keepdims=True)
    xc = xf - mu
    y = xc * lax.rsqrt(jnp.mean(xc * xc, axis=-1, keepdims=True) + LN_EPS)
    return (y * g.astype(jnp.float32) + b.astype(jnp.float32)).astype(x.dtype)


def adaln(cond, w, b):
    m = jax.nn.silu(cond) @ w + b
    return jnp.split(m, 6, axis=-1)


def modulate(h, shift, scale):
    return h * (1 + scale) + shift


def split_heads(x):
    return x.reshape(x.shape[0], x.shape[1], N_HEADS, HEAD_DIM)


def _na_indices(rows):
    kr = min(WIN_ROWS_MAX, rows)
    r = np.arange(rows)
    row_start = np.clip(r - kr // 2, 0, rows - kr)
    row_idx = row_start[:, None] + np.arange(kr)[None, :]
    n_cb = GRID_W // Q_COL_BLOCK
    cb = np.arange(n_cb)
    kcol_start = np.clip(cb * Q_COL_BLOCK - WIN_COLS // 2, 0, GRID_W - K_COL_BLOCK)
    col_idx = kcol_start[:, None] + np.arange(K_COL_BLOCK)[None, :]
    qcol = cb[:, None] * Q_COL_BLOCK + np.arange(Q_COL_BLOCK)[None, :]
    win_start = np.clip(qcol - WIN_COLS // 2, 0, GRID_W - WIN_COLS)
    kc = col_idx[:, None, :]
    col_valid = (kc >= win_start[..., None]) & (kc < win_start[..., None] + WIN_COLS)
    mask = np.broadcast_to(col_valid[:, :, None, :], (n_cb, Q_COL_BLOCK, kr, K_COL_BLOCK))
    mask = mask.reshape(n_cb, Q_COL_BLOCK, kr * K_COL_BLOCK)
    d_row = row_idx - r[:, None] + (WIN_ROWS_MAX - 1)
    d_col = np.clip(kc - qcol[..., None] + (WIN_COLS - 1), 0, 2 * WIN_COLS - 2)
    return kr, n_cb, row_idx, col_idx, mask, d_row, d_col


def na_context(h, w_qkv, w_o):
    q, k, v = jnp.split(h @ w_qkv, 3, axis=-1)
    q, k, v = split_heads(q), split_heads(k), split_heads(v)
    s = jnp.einsum('bqhd,bkhd->bhqk', q, k).astype(jnp.float32) * (HEAD_DIM ** -0.5)
    p = jax.nn.softmax(s, axis=-1).astype(v.dtype)
    o = jnp.einsum('bhqk,bkhd->bqhd', p, v).reshape(h.shape[0], h.shape[1], D_MODEL)
    return o @ w_o, k, v


def na_latent(h, k_ctx, v_ctx, w_qkv, w_o, rpb):
    b, t = h.shape[0], h.shape[1]
    rows = t // GRID_W
    kr, n_cb, row_idx, col_idx, mask, d_row, d_col = _na_indices(rows)
    q, k, v = jnp.split(h @ w_qkv, 3, axis=-1)
    qg = q.reshape(b, rows, n_cb, Q_COL_BLOCK, N_HEADS, HEAD_DIM)
    kg = k.reshape(b, rows, GRID_W, N_HEADS, HEAD_DIM)
    vg = v.reshape(b, rows, GRID_W, N_HEADS, HEAD_DIM)
    ri = row_idx[:, None, :, None]
    ci = col_idx[None, :, None, :]
    n_loc = kr * K_COL_BLOCK
    kb = kg[:, ri, ci].reshape(b, rows, n_cb, n_loc, N_HEADS, HEAD_DIM)
    vb = vg[:, ri, ci].reshape(b, rows, n_cb, n_loc, N_HEADS, HEAD_DIM)
    rel = rpb[:, d_row[:, None, None, :, None], d_col[None, :, :, None, :]]
    rel = rel.reshape(N_HEADS, rows, n_cb, Q_COL_BLOCK, n_loc).astype(jnp.float32)
    bias = jnp.where(mask, rel, -jnp.inf)
    scale = HEAD_DIM ** -0.5
    s_loc = jnp.einsum('brjqhd,brjkhd->bhrjqk', qg, kb).astype(jnp.float32) * scale + bias[None]
    s_ctx = jnp.einsum('brjqhd,blhd->bhrjql', qg, k_ctx).astype(jnp.float32) * scale
    p = jax.nn.softmax(jnp.concatenate([s_loc, s_ctx], axis=-1), axis=-1).astype(v.dtype)
    o = (jnp.einsum('bhrjqk,brjkhd->brjqhd', p[..., :n_loc], vb)
         + jnp.einsum('bhrjql,blhd->brjqhd', p[..., n_loc:], v_ctx))
    return o.reshape(b, t, D_MODEL) @ w_o


def conv_module(h, w_pw1, w_dw, b_dw, ln_g, ln_b, w_pw2):
    a, g = jnp.split(h @ w_pw1, 2, axis=-1)
    u = a * jax.nn.sigmoid(g)
    u = lax.conv_general_dilated(
        u, w_dw[:, None, :].astype(u.dtype), window_strides=(1,),
        padding=[(CONV_WIDTH // 2, CONV_WIDTH // 2)],
        dimension_numbers=('NWC', 'WIO', 'NWC'), feature_group_count=D_MODEL) + b_dw
    u = jax.nn.silu(layer_norm(u, ln_g, ln_b))
    return u @ w_pw2


def sq_relu_mlp(h, w_up, w_down):
    return jnp.square(jax.nn.relu(h @ w_up)) @ w_down


def setup_inputs(seed: int = 0) -> dict:
    key = jax.random.key(seed)
    ks = jax.random.split(key, 21)
    d = D_MODEL

    def nrm(k, shape, s):
        return jax.random.normal(k, shape, jnp.float32) * s

    return {
        "x_prompt": nrm(ks[0], (BATCH, SEQ, d), 1.0),
        "x_sample": nrm(ks[1], (DEC_BATCH, DEC_SEQ, d), 1.0),
        "cache_k": nrm(ks[2], (DEC_BATCH, N_ATTN, PAST_LEN, N_HEADS, HEAD_DIM), 1.0),
        "cache_v": nrm(ks[3], (DEC_BATCH, N_ATTN, PAST_LEN, N_HEADS, HEAD_DIM), 1.0),
        "c": nrm(ks[4], (DEC_BATCH, d), 1.0),
        "c_ctx": nrm(ks[5], (d,), 1.0),
        "norm_g": 1.0 + nrm(ks[6], (DEPTH, 2, d), 0.02),
        "w_ada": nrm(ks[7], (DEPTH, d, 6 * d), 0.5 * d ** -0.5),
        "b_ada": nrm(ks[8], (DEPTH, 6 * d), 0.01),
        "w_qkv": nrm(ks[9], (N_ATTN, d, 3 * d), d ** -0.5),
        "w_o": nrm(ks[10], (N_ATTN, d, d), d ** -0.5),
        "rpb": nrm(ks[11], (N_ATTN, N_HEADS, 2 * WIN_ROWS_MAX - 1, 2 * WIN_COLS - 1), 0.1),
        "w_pw1": nrm(ks[12], (N_CONV, d, 2 * d), d ** -0.5),
        "w_dw": nrm(ks[13], (N_CONV, CONV_WIDTH, d), CONV_WIDTH ** -0.5),
        "b_dw": nrm(ks[14], (N_CONV, d), 0.01),
        "conv_ln_g": 1.0 + nrm(ks[15], (N_CONV, d), 0.02),
        "conv_ln_b": nrm(ks[16], (N_CONV, d), 0.01),
        "w_pw2": nrm(ks[17], (N_CONV, d, d), d ** -0.5),
        "w_up": nrm(ks[18], (DEPTH, d, D_FF), d ** -0.5),
        "w_down": nrm(ks[19], (DEPTH, D_FF, d), D_FF ** -0.5),
        "final_g": 1.0 + nrm(ks[20], (d,), 0.02),
    }


def reference(x_prompt, x_sample, cache_k, cache_v, c, c_ctx, norm_g, w_ada, b_ada,
              w_qkv, w_o, rpb, w_pw1, w_dw, b_dw, conv_ln_g, conv_ln_b, w_pw2,
              w_up, w_down, final_g):
    xp, xs = x_prompt, x_sample
    new_k, new_v = [], []
    for l in range(DEPTH):
        i = l // N_MIXERS
        sh1c, sc1c, g1c, sh2c, sc2c, g2c = adaln(c_ctx, w_ada[l], b_ada[l])
        sh1, sc1, g1, sh2, sc2, g2 = [m[:, None, :] for m in adaln(c, w_ada[l], b_ada[l])]
        hp = modulate(rms_norm(xp, norm_g[l, 0]), sh1c, sc1c)
        hs = modulate(rms_norm(xs, norm_g[l, 0]), sh1, sc1)
        if l % N_MIXERS == 0:
            yp, kp, vp = na_context(hp, w_qkv[i], w_o[i])
            new_k.append(kp)
            new_v.append(vp)
            ys = na_latent(hs, cache_k[:, i], cache_v[:, i], w_qkv[i], w_o[i], rpb[i])
        else:
            yp = conv_module(hp, w_pw1[i], w_dw[i], b_dw[i], conv_ln_g[i], conv_ln_b[i], w_pw2[i])
            ys = conv_module(hs, w_pw1[i], w_dw[i], b_dw[i], conv_ln_g[i], conv_ln_b[i], w_pw2[i])
        xp = xp + g1c * yp
        xs = xs + g1 * ys
        hp = modulate(rms_norm(xp, norm_g[l, 1]), sh2c, sc2c)
        hs = modulate(rms_norm(xs, norm_g[l, 1]), sh2, sc2)
        xp = xp + g2c * sq_relu_mlp(hp, w_up[l], w_down[l])
        xs = xs + g2 * sq_relu_mlp(hs, w_up[l], w_down[l])
    y_prompt = rms_norm(xp, final_g)
    y_sample = rms_norm(xs, final_g)
    new_cache_k = jnp.stack(new_k, axis=1)
    new_cache_v = jnp.stack(new_v, axis=1)
    return (y_prompt, y_sample, new_cache_k, new_cache_v)
```

```cpp
#define SINGLE_LAUNCH 1
#include <hip/hip_runtime.h>
#include <hip/hip_cooperative_groups.h>
#include <cstdio>
#include <cstdint>
#include <cmath>
#include <utility>
namespace cg = cooperative_groups;
namespace pg8 {
#define PG8_LAS __attribute__((address_space(3)))
typedef unsigned short bf16_t;
typedef short bf16x8 __attribute__((ext_vector_type(8)));
typedef float f32x4 __attribute__((ext_vector_type(4)));
typedef unsigned u32x4 __attribute__((ext_vector_type(4)));
constexpr int RM = 192;
constexpr int BM = 256, BK = 64, HALF = 128, HTB = HALF * BK * 2  , STAGE_BYTES = 8 * HTB, NXCD = 8, WGM = 8;

__host__ __device__ __forceinline__ int lds_byte(int r, int c) { const int st = (r >> 4) * 2 + (c >> 5), rr = r & 15, cc = c & 31, ob = rr * 64 + cc * 2; return st * 1024 + (ob ^ (((ob >> 9) & 1) << 5)); }
__host__ __device__ __forceinline__ void stage_rc(int b, int& R, int& C) { const int st = b / 1024, sb = b % 1024, swz = sb ^ (((sb >> 9) & 1) << 5); R = (st >> 1) * 16 + swz / 64; C = (st & 1) * 32 + (swz % 64) / 2; }
__host__ __device__ __forceinline__ int perm32(int rho) { const int n = rho >> 4, i = rho & 15; return 8 * (i >> 2) + 4 * n + (i & 3); }

struct Unit { int pm, pn; };
struct Gemm { const bf16_t* A; const bf16_t* Bt; int M, N, K; };

struct StaticOrder {
    int nM, nN, nwg, G, c;
    __host__ __device__ void init(int M, int N, int G_, int c_) { nM = M / RM; nN = N / BM; nwg = nM * nN; G = G_; c = c_; }
    __host__ __device__ bool next(int i, Unit& u) const {
        const long L = (long)i * G + c; if (L >= nwg) return false;
        int wgid = (int)L; { const int q = nwg / NXCD, r = nwg % NXCD, xcd = wgid % NXCD, off = wgid / NXCD; wgid = (xcd < r ? xcd * (q + 1) : r * (q + 1) + (xcd - r) * q) + off; }
        const int nig = WGM * nN, gid = wgid / nig, fm = gid * WGM, gsz = (nM - fm) < WGM ? (nM - fm) : WGM;
        u.pm = fm + ((wgid % nig) % gsz); u.pn = (wgid % nig) / gsz; return true;
    }
    __device__ __forceinline__ void a_ready(const Unit&) const {}
    __device__ __forceinline__ void done(const Unit&) const {}
};

__device__ __forceinline__ unsigned cvt_pk_bf16(float lo, float hi) { unsigned r; asm volatile("v_cvt_pk_bf16_f32 %0, %1, %2" : "=v"(r) : "v"(lo), "v"(hi)); return r; }
typedef float f32x2 __attribute__((ext_vector_type(2)));
__device__ __forceinline__ int cond_of_row(int r) { return r < 8192 ? 0 : 1 + ((r - 8192) >> 10); }
__device__ __forceinline__ int half_row0(int ai, int wr) { return ai == 0 ? wr * 64 : 128 + wr * 32; }
#define EPI_MLOOP(ai, m) _Pragma("unroll") for (int m = 0; m < 4; ++m) if (ai == 0 || m < 2)
struct EpiQKV {
    static constexpr bool PERM = true, AFTER_DRAIN = false;
    const float* ss; const float* shw;
    bf16_t* Q; size_t qkv_stride; float* ck; size_t ckv_stride;
    __device__ __forceinline__ void operator()(const f32x4 (&acc)[2][2][4][2], const Unit& u, int wr, int wc, int fr, int fq) const {
        const int t = u.pn >> 2;
        bf16_t* base = Q + (size_t)t * qkv_stride;
        const int col0 = (u.pn & 3) * BM + wc * 32 + 8 * fq;
        float* cbase = ck + (size_t)(t > 0 ? t - 1 : 0) * ckv_stride + col0;
#pragma unroll
        for (int ai = 0; ai < 2; ++ai) { const int rbase = u.pm * RM + half_row0(ai, wr) + fr; const bool wc_ = (t > 0) && (rbase < 8192);
            const float* sp = shw + cond_of_row(rbase) * 4096 + u.pn * BM + wc * 32 + 8 * fq;
            f32x4 sv[2][2];
#pragma unroll
            for (int bj = 0; bj < 2; ++bj) { sv[bj][0] = *(const f32x4*)(sp + bj * HALF); sv[bj][1] = *(const f32x4*)(sp + bj * HALF + 4); }
            float rr[4];
            EPI_MLOOP(ai, m) rr[m] = ss[rbase + m * 16];
            EPI_MLOOP(ai, m) { const int row = rbase + m * 16; bf16_t* rowp = base + (size_t)row * 1024 + col0;
                const float r = __builtin_amdgcn_rsqf(rr[m] * (1.f / 1024.f) + 1e-6f);
                float* cp0 = cbase + ((size_t)(row >> 8) * 2 * 256 + (row & 255)) * 1024;
#pragma unroll
                for (int bj = 0; bj < 2; ++bj) { const f32x4 v0 = acc[ai][bj][m][0] * r + sv[bj][0], v1 = acc[ai][bj][m][1] * r + sv[bj][1];
                    u32x4 w; w.x = cvt_pk_bf16(v0[0], v0[1]); w.y = cvt_pk_bf16(v0[2], v0[3]); w.z = cvt_pk_bf16(v1[0], v1[1]); w.w = cvt_pk_bf16(v1[2], v1[3]);
                    *(u32x4*)(rowp + bj * HALF) = w;
                    if (wc_) { float* cp = cp0 + bj * HALF; *(f32x4*)cp = v0; *(f32x4*)(cp + 4) = v1; } } } }
    }
};
struct EpiUp {
    static constexpr bool PERM = true, AFTER_DRAIN = false;
    const float* ss; const float* shw; bf16_t* O; int ldc;
    __device__ __forceinline__ void operator()(const f32x4 (&acc)[2][2][4][2], const Unit& u, int wr, int wc, int fr, int fq) const {
        const int col0 = u.pn * BM + wc * 32 + 8 * fq;
#pragma unroll
        for (int ai = 0; ai < 2; ++ai) { const int rbase = u.pm * RM + half_row0(ai, wr) + fr;
            const float* sp = shw + cond_of_row(rbase) * 4096 + col0;
            f32x4 sv[2][2];
#pragma unroll
            for (int bj = 0; bj < 2; ++bj) { sv[bj][0] = *(const f32x4*)(sp + bj * HALF); sv[bj][1] = *(const f32x4*)(sp + bj * HALF + 4); }
            float rr[4];
            EPI_MLOOP(ai, m) rr[m] = ss[rbase + m * 16];
            EPI_MLOOP(ai, m) { bf16_t* rowp = O + (size_t)(rbase + m * 16) * ldc + col0;
                const float r = __builtin_amdgcn_rsqf(rr[m] * (1.f / 1024.f) + 1e-6f);
#pragma unroll
                for (int bj = 0; bj < 2; ++bj) { f32x4 v0 = acc[ai][bj][m][0] * r + sv[bj][0], v1 = acc[ai][bj][m][1] * r + sv[bj][1];
#pragma unroll
                    for (int e = 0; e < 4; ++e) { const float a = fmaxf(v0[e], 0.f), b = fmaxf(v1[e], 0.f); v0[e] = a * a; v1[e] = b * b; }
                    u32x4 w; w.x = cvt_pk_bf16(v0[0], v0[1]); w.y = cvt_pk_bf16(v0[2], v0[3]); w.z = cvt_pk_bf16(v1[0], v1[1]); w.w = cvt_pk_bf16(v1[2], v1[3]);
                    *(u32x4*)(rowp + bj * HALF) = w; } } }
    }
};
struct EpiGLU {
    static constexpr bool PERM = true, AFTER_DRAIN = false;
    const float* ss; const float* shw; bf16_t* O;
    __device__ __forceinline__ void operator()(const f32x4 (&acc)[2][2][4][2], const Unit& u, int wr, int wc, int fr, int fq) const {
        const int col0 = u.pn * HALF + wc * 32 + 8 * fq;
#pragma unroll
        for (int ai = 0; ai < 2; ++ai) { const int rbase = u.pm * RM + half_row0(ai, wr) + fr;
            const float* sp = shw + cond_of_row(rbase) * 4096 + u.pn * BM + wc * 32 + 8 * fq;
            f32x4 sv[2][2];
#pragma unroll
            for (int bj = 0; bj < 2; ++bj) { sv[bj][0] = *(const f32x4*)(sp + bj * HALF); sv[bj][1] = *(const f32x4*)(sp + bj * HALF + 4); }
            float rr[4];
            EPI_MLOOP(ai, m) rr[m] = ss[rbase + m * 16];
            EPI_MLOOP(ai, m) { bf16_t* rowp = O + (size_t)(rbase + m * 16) * 1024 + col0;
                const float r = __builtin_amdgcn_rsqf(rr[m] * (1.f / 1024.f) + 1e-6f);
                f32x4 v0 = acc[ai][0][m][0] * r + sv[0][0], v1 = acc[ai][0][m][1] * r + sv[0][1]; const f32x4 g0 = acc[ai][1][m][0] * r + sv[1][0], g1 = acc[ai][1][m][1] * r + sv[1][1];
#pragma unroll
                for (int e = 0; e < 4; ++e) { v0[e] = v0[e] * __builtin_amdgcn_rcpf(1.f + __expf(-g0[e])); v1[e] = v1[e] * __builtin_amdgcn_rcpf(1.f + __expf(-g1[e])); }
                u32x4 w; w.x = cvt_pk_bf16(v0[0], v0[1]); w.y = cvt_pk_bf16(v0[2], v0[3]); w.z = cvt_pk_bf16(v1[0], v1[1]); w.w = cvt_pk_bf16(v1[2], v1[3]);
                *(u32x4*)rowp = w; } }
    }
};
struct EpiRes {
    static constexpr bool PERM = false, AFTER_DRAIN = false;
    const float* base_p; const float* base_s; const bf16_t* base_b; bf16_t* out; const float* gate;
    bf16_t* xb; const float* g_next; const float* sc_next; float* ss_next;
    __device__ __forceinline__ void operator()(const f32x4 (&acc)[2][2][4][2], const Unit& u, int wr, int wc, int fr, int fq) const {
        typedef unsigned u32x2e __attribute__((ext_vector_type(2)));
        const int col0 = u.pn * BM + wc * 32 + 4 * fq;
        const int lane_x = fq * 16 + fr;
#pragma unroll
        for (int ai = 0; ai < 2; ++ai) { const int row0 = u.pm * RM + half_row0(ai, wr) + fr; const int cond = cond_of_row(row0);
            const float* gp = gate + cond * 6144 + col0;
            const float* bp = (row0 < 8192) ? base_p + (size_t)row0 * 1024 + col0 : base_s + (size_t)(row0 - 8192) * 1024 + col0;
            const bf16_t* bb = base_b + (size_t)row0 * 1024 + col0;
            bf16_t* op = out + (size_t)row0 * 1024 + col0;
            f32x4 gv[2][2], gs[2][2];
#pragma unroll
            for (int bj = 0; bj < 2; ++bj)
#pragma unroll
                for (int n = 0; n < 2; ++n) gv[bj][n] = *(const f32x4*)(gp + bj * HALF + n * 16);
            if (xb) { f32x4 ga[2][2], sa[2][2];
#pragma unroll
                for (int bj = 0; bj < 2; ++bj)
#pragma unroll
                    for (int n = 0; n < 2; ++n) { ga[bj][n] = *(const f32x4*)(g_next + col0 + bj * HALF + n * 16); sa[bj][n] = *(const f32x4*)(sc_next + cond * 6144 + col0 + bj * HALF + n * 16); }
#pragma unroll
                for (int bj = 0; bj < 2; ++bj)
#pragma unroll
                    for (int n = 0; n < 2; ++n) gs[bj][n] = ga[bj][n] * (1.f + sa[bj][n]); }
#pragma unroll
            for (int mp = 0; mp < 2; ++mp) if (ai == 0 || mp == 0) { f32x4 bs[2][2][2];
                if (base_b) {
#pragma unroll
                    for (int mm = 0; mm < 2; ++mm)
#pragma unroll
                        for (int bj = 0; bj < 2; ++bj)
#pragma unroll
                            for (int n = 0; n < 2; ++n) { const u32x2e w = *(const u32x2e*)(bb + (size_t)((2 * mp + mm) * 16) * 1024 + bj * HALF + n * 16);
                                bs[mm][bj][n] = (f32x4){__builtin_bit_cast(float, w.x << 16), __builtin_bit_cast(float, w.x & 0xffff0000u), __builtin_bit_cast(float, w.y << 16), __builtin_bit_cast(float, w.y & 0xffff0000u)}; }
                } else {
#pragma unroll
                    for (int mm = 0; mm < 2; ++mm)
#pragma unroll
                        for (int bj = 0; bj < 2; ++bj)
#pragma unroll
                            for (int n = 0; n < 2; ++n) bs[mm][bj][n] = *(const f32x4*)(bp + (size_t)((2 * mp + mm) * 16) * 1024 + bj * HALF + n * 16);
                }
#pragma unroll
                for (int mm = 0; mm < 2; ++mm) { float sq = 0.f;
#pragma unroll
                    for (int bj = 0; bj < 2; ++bj)
#pragma unroll
                        for (int n = 0; n < 2; ++n) { const f32x4 xn = bs[mm][bj][n] + gv[bj][n] * acc[ai][bj][2 * mp + mm][n];
                            { u32x2e w; w.x = cvt_pk_bf16(xn[0], xn[1]); w.y = cvt_pk_bf16(xn[2], xn[3]); *(u32x2e*)(op + (size_t)((2 * mp + mm) * 16) * 1024 + bj * HALF + n * 16) = w; }
                            if (xb) { const f32x4 hb = xn * gs[bj][n]; u32x2e w; w.x = cvt_pk_bf16(hb[0], hb[1]); w.y = cvt_pk_bf16(hb[2], hb[3]);
                                *(u32x2e*)(xb + (size_t)(row0 + (2 * mp + mm) * 16) * 1024 + col0 + bj * HALF + n * 16) = w;
                                sq += (xn[0] * xn[0] + xn[1] * xn[1]) + (xn[2] * xn[2] + xn[3] * xn[3]); } }
                    if (xb) {
                        sq += __builtin_bit_cast(float, __builtin_amdgcn_ds_bpermute((lane_x ^ 16) << 2, __builtin_bit_cast(int, sq)));
                        sq += __builtin_bit_cast(float, __builtin_amdgcn_ds_bpermute((lane_x ^ 32) << 2, __builtin_bit_cast(int, sq)));
                        if (fq == 0) atomicAdd(ss_next + row0 + (2 * mp + mm) * 16, sq); } }
                asm volatile("" ::: "memory"); } }
    }
};
template <class Epi, class Sched, bool ALIGN_EPI = false, bool SP2 = false>
__device__ __forceinline__ void gemm_phase(PG8_LAS unsigned char* lds, const Gemm g, const Sched& S, const Epi& E, const int tid) {
    static_assert(SP2, "the 192-row tile form exists for the SP2 loop only");
    const int wid = __builtin_amdgcn_readfirstlane(tid >> 6), lane = tid & 63, wr = wid >> 2, wc = wid & 3, fr = lane & 15, fq = lane >> 4;
    const int K = g.K, nt = K / BK;
    unsigned voffA[2], voffB[2];
#pragma unroll
    for (int i = 0; i < 2; ++i) { int R, C; stage_rc(tid * 16 + i * 8192, R, C); const int Rb = Epi::PERM ? ((R & ~31) + perm32(R & 31)) : R;
        voffA[i] = (unsigned)(R * K + C) * 2u; voffB[i] = (unsigned)(Rb * K + C) * 2u; }
    const size_t kstep = (size_t)(BK * 2);
    const size_t hstep = (size_t)HALF * K * 2;
    const size_t tstepA = (size_t)RM * K * 2;
    const size_t tstep = 2 * hstep;
    const unsigned ldsw = (unsigned)wid * 1024u;
    const int aoff = lds_byte(wr * 64 + fr, fq * 8), boff = lds_byte(wc * 32 + fr, fq * 8);
#define PG8_SA(b, h) (((b) * 2 + (h)) * HTB)
#define PG8_SB(b, h) ((4 + (b) * 2 + (h)) * HTB)
#define PG8_STAGE(bufoff, gbase, voff) do { _Pragma("unroll") for (int _i = 0; _i < 2; ++_i) \
        __builtin_amdgcn_global_load_lds((const unsigned*)((const char*)(gbase) + (voff)[_i]), (PG8_LAS unsigned*)(lds + (bufoff) + ldsw + _i * 8192), 16, 0, 0); } while (0)
#define PG8_LDA(dst, b, h) do { _Pragma("unroll") for (int m = 0; m < 4; ++m) _Pragma("unroll") for (int k = 0; k < 2; ++k) dst[m][k] = *(const PG8_LAS bf16x8*)(lds + PG8_SA(b, h) + aoff + m * 2048 + k * 1024); } while (0)
#define PG8_LDB(dst, b, h) do { _Pragma("unroll") for (int n = 0; n < 2; ++n) _Pragma("unroll") for (int k = 0; k < 2; ++k) dst[n][k] = *(const PG8_LAS bf16x8*)(lds + PG8_SB(b, h) + boff + n * 2048 + k * 1024); } while (0)
#define PG8_MMA(ai, bj, At, Bt) do { __builtin_amdgcn_s_setprio(1); _Pragma("unroll") for (int m = 0; m < 4; ++m) _Pragma("unroll") for (int n = 0; n < 2; ++n) _Pragma("unroll") for (int k = 0; k < 2; ++k) \
        acc[ai][bj][m][n] = __builtin_amdgcn_mfma_f32_16x16x32_bf16(Bt[n][k], At[m][k], acc[ai][bj][m][n], 0, 0, 0); __builtin_amdgcn_s_setprio(0); } while (0)
    const int aoff1 = lds_byte(wr * 32 + fr, fq * 8);
#define PG8_STAGE1(bufoff, gbase, voff) __builtin_amdgcn_global_load_lds((const unsigned*)((const char*)(gbase) + (voff)[0]), (PG8_LAS unsigned*)(lds + (bufoff) + ldsw), 16, 0, 0)
#define PG8_LDA1(dst, b) do { _Pragma("unroll") for (int m = 0; m < 2; ++m) _Pragma("unroll") for (int k = 0; k < 2; ++k) dst[m][k] = *(const PG8_LAS bf16x8*)(lds + PG8_SA(b, 1) + aoff1 + m * 2048 + k * 1024); } while (0)
#define PG8_MMA1(bj, At, Bt) do { __builtin_amdgcn_s_setprio(1); _Pragma("unroll") for (int m = 0; m < 2; ++m) _Pragma("unroll") for (int n = 0; n < 2; ++n) _Pragma("unroll") for (int k = 0; k < 2; ++k) \
        acc[1][bj][m][n] = __builtin_amdgcn_mfma_f32_16x16x32_bf16(Bt[n][k], At[m][k], acc[1][bj][m][n], 0, 0, 0); __builtin_amdgcn_s_setprio(0); } while (0)
#define PG8_WAIT_V(n) asm volatile("s_waitcnt vmcnt(" #n ")" ::: "memory")
#define PG8_WAIT_L(n) asm volatile("s_waitcnt lgkmcnt(" #n ")" ::: "memory")
#define PG8_BAR __builtin_amdgcn_s_barrier()
#define PG8_SCHED __builtin_amdgcn_sched_barrier(0)
    Unit cur, nxt; int ui = 0;
    if (!S.next(0, cur)) return;
    f32x4 acc[2][2][4][2];
#pragma unroll
    for (int a = 0; a < 2; ++a)
#pragma unroll
        for (int b = 0; b < 2; ++b)
#pragma unroll
            for (int m = 0; m < 4; ++m)
#pragma unroll
                for (int n = 0; n < 2; ++n) acc[a][b][m][n] = (f32x4){0.f, 0.f, 0.f, 0.f};
    bf16x8 At[4][2], B0[2][2], B1[2][2];
    const char* cA = (const char*)g.A + (size_t)cur.pm * tstepA; const char* cB = (const char*)g.Bt + (size_t)cur.pn * tstep;
    S.a_ready(cur);
    if constexpr (SP2) {
        PG8_STAGE(PG8_SB(0, 0), cB, voffB); PG8_STAGE(PG8_SB(0, 1), cB + hstep, voffB); PG8_STAGE(PG8_SA(0, 0), cA, voffA); PG8_STAGE1(PG8_SA(0, 1), cA + hstep, voffA);
        if (wr == 1) PG8_BAR;
        PG8_WAIT_V(1); PG8_BAR;
        PG8_STAGE(PG8_SB(1, 0), cB + kstep, voffB); PG8_STAGE(PG8_SA(1, 0), cA + kstep, voffA); PG8_STAGE(PG8_SB(1, 1), cB + hstep + kstep, voffB);
        PG8_WAIT_V(6); PG8_BAR;
    } else {
        PG8_STAGE(PG8_SB(0, 0), cB, voffB); PG8_STAGE(PG8_SA(0, 0), cA, voffA); PG8_STAGE(PG8_SB(0, 1), cB + hstep, voffB); PG8_STAGE(PG8_SA(0, 1), cA + hstep, voffA);
        if (wr == 1) PG8_BAR;
        PG8_WAIT_V(4); PG8_BAR;
        PG8_STAGE(PG8_SB(1, 0), cB + kstep, voffB); PG8_STAGE(PG8_SA(1, 0), cA + kstep, voffA); PG8_STAGE(PG8_SB(1, 1), cB + hstep + kstep, voffB);
        PG8_WAIT_V(6); PG8_BAR;
    }
    for (;;) {
        const bool has_next = S.next(ui + 1, nxt);
        const char* nA = has_next ? (const char*)g.A + (size_t)nxt.pm * tstepA : cA; const char* nB = has_next ? (const char*)g.Bt + (size_t)nxt.pn * tstep : cB;
        for (int t = 0; t < nt; t += 2) {
            const bool last = (t == nt - 2);
            const char* a1 = cA + (size_t)(t + 1) * kstep;
            const char* a2 = last ? nA : cA + (size_t)(t + 2) * kstep; const char* b2 = last ? nB : cB + (size_t)(t + 2) * kstep;
            const char* a3 = a2 + kstep; const char* b3 = b2 + kstep;
            if (last && has_next) S.a_ready(nxt);
            if constexpr (SP2) {
            PG8_LDB(B0, 0, 0); PG8_LDB(B1, 0, 1); PG8_SCHED; PG8_LDA(At, 0, 0); PG8_STAGE1(PG8_SA(1, 1), a1 + hstep, voffA);
            PG8_WAIT_V(7); PG8_WAIT_L(0); PG8_BAR; PG8_MMA(0, 0, At, B0); PG8_MMA(0, 1, At, B1); PG8_BAR; PG8_SCHED;
            PG8_LDA1(At, 0); PG8_STAGE(PG8_SB(0, 0), b2, voffB); PG8_STAGE(PG8_SB(0, 1), b2 + hstep, voffB); PG8_STAGE(PG8_SA(0, 0), a2, voffA);
            PG8_WAIT_V(7); PG8_WAIT_L(0); PG8_BAR; PG8_MMA1(0, At, B0); PG8_MMA1(1, At, B1); PG8_BAR; PG8_SCHED;
            PG8_LDB(B0, 1, 0); PG8_LDB(B1, 1, 1); PG8_SCHED; PG8_LDA(At, 1, 0); PG8_STAGE1(PG8_SA(0, 1), a2 + hstep, voffA);
            PG8_WAIT_V(7); PG8_WAIT_L(0); PG8_BAR; PG8_MMA(0, 0, At, B0); PG8_MMA(0, 1, At, B1); PG8_BAR; PG8_SCHED;
            PG8_LDA1(At, 1); PG8_STAGE(PG8_SB(1, 0), b3, voffB); PG8_STAGE(PG8_SB(1, 1), b3 + hstep, voffB); PG8_STAGE(PG8_SA(1, 0), a3, voffA);
            PG8_WAIT_V(7); PG8_WAIT_L(0); PG8_BAR; PG8_MMA1(0, At, B0); PG8_MMA1(1, At, B1); PG8_BAR; PG8_SCHED;
            } else {
            PG8_LDB(B0, 0, 0); PG8_SCHED; PG8_LDA(At, 0, 0); PG8_STAGE(PG8_SA(1, 1), a1 + hstep, voffA);
            PG8_WAIT_L(8); PG8_BAR; PG8_WAIT_L(0); PG8_MMA(0, 0, At, B0); PG8_BAR; PG8_SCHED;
            PG8_LDB(B1, 0, 1); PG8_STAGE(PG8_SB(0, 0), b2, voffB);
            PG8_BAR; PG8_WAIT_L(0); PG8_MMA(0, 1, At, B1); PG8_BAR;
            PG8_LDA(At, 0, 1); PG8_STAGE(PG8_SA(0, 0), a2, voffA);
            PG8_BAR; PG8_WAIT_L(0); PG8_MMA(1, 0, At, B0); PG8_BAR; PG8_SCHED;
            PG8_STAGE(PG8_SB(0, 1), b2 + hstep, voffB);
            PG8_WAIT_V(6); PG8_BAR; PG8_MMA(1, 1, At, B1); PG8_BAR;
            PG8_LDB(B0, 1, 0); PG8_SCHED; PG8_LDA(At, 1, 0); PG8_STAGE(PG8_SA(0, 1), a2 + hstep, voffA);
            PG8_WAIT_L(8); PG8_BAR; PG8_WAIT_L(0); PG8_MMA(0, 0, At, B0); PG8_BAR; PG8_SCHED;
            PG8_LDB(B1, 1, 1); PG8_STAGE(PG8_SB(1, 0), b3, voffB);
            PG8_BAR; PG8_WAIT_L(0); PG8_MMA(0, 1, At, B1); PG8_BAR;
            PG8_LDA(At, 1, 1); PG8_STAGE(PG8_SA(1, 0), a3, voffA);
            PG8_BAR; PG8_WAIT_L(0); PG8_MMA(1, 0, At, B0); PG8_BAR; PG8_SCHED;
            PG8_STAGE(PG8_SB(1, 1), b3 + hstep, voffB);
            PG8_WAIT_V(6); PG8_BAR; PG8_MMA(1, 1, At, B1); PG8_BAR;
            }
        }
        if constexpr (ALIGN_EPI) { if (wr == 0) PG8_BAR; }
        if constexpr (!Epi::AFTER_DRAIN) { E(acc, cur, wr, wc, fr, fq); S.done(cur); }
        if (!has_next) break;
#pragma unroll
        for (int a = 0; a < 2; ++a)
#pragma unroll
            for (int b = 0; b < 2; ++b)
#pragma unroll
                for (int m = 0; m < 4; ++m)
#pragma unroll
                    for (int n = 0; n < 2; ++n) acc[a][b][m][n] = (f32x4){0.f, 0.f, 0.f, 0.f};
        cur = nxt; cA = nA; cB = nB; ++ui;
        if constexpr (ALIGN_EPI) { if (wr == 1) PG8_BAR; }
    }
    PG8_WAIT_V(0);
    if constexpr (!ALIGN_EPI) { if (wr == 0) PG8_BAR; }
    PG8_BAR;
    if constexpr (Epi::AFTER_DRAIN) { E.fused(acc, cur, wr, wc, fr, fq, lds, wid, lane); S.done(cur); }
#undef PG8_SA
#undef PG8_SB
#undef PG8_STAGE
#undef PG8_LDA
#undef PG8_LDB
#undef PG8_MMA
#undef PG8_STAGE1
#undef PG8_LDA1
#undef PG8_MMA1
#undef PG8_WAIT_V
#undef PG8_WAIT_L
#undef PG8_BAR
#undef PG8_SCHED
}
}
constexpr int D = 1024, MP = 8192, MS = 4096, M = MP + MS, FF = 4096, NL = 4;
constexpr int NWAVES = 8, NTHR = 512;
constexpr size_t MiB = 1u << 20;
constexpr size_t WS_MOD = 1 * MiB;
constexpr size_t WS_W = 2 * MiB;
constexpr size_t WS_X = 94 * MiB;
constexpr size_t WS_H = 142 * MiB;
constexpr size_t WS_R = 166 * MiB;
constexpr size_t WS_CK = 262 * MiB, WS_CV = 266 * MiB, WS_SHW = 270 * MiB, WS_SS = 271 * MiB, WS_END = 272 * MiB;
constexpr size_t MEL = 1u << 20;
constexpr size_t W_QKV = 0, W_O = 6 * MEL, W_PW1 = 8 * MEL, W_PW2 = 12 * MEL, W_UP = 14 * MEL, W_DOWN = 30 * MEL;
constexpr int LDS_BYTES = 163840, LDS_ST = LDS_BYTES - 16, LDS_KC = 112640;

#define LAS __attribute__((address_space(3)))
#define SB0() __builtin_amdgcn_sched_barrier(0)
typedef unsigned short bf16;
typedef float f32x4 __attribute__((ext_vector_type(4)));
typedef float f32x2 __attribute__((ext_vector_type(2)));
typedef unsigned u32x4 __attribute__((ext_vector_type(4)));
typedef unsigned u32x2 __attribute__((ext_vector_type(2)));
typedef short bf16x8 __attribute__((ext_vector_type(8)));
typedef short s16x4 __attribute__((ext_vector_type(4)));
typedef float f32x32 __attribute__((ext_vector_type(32)));

__device__ __forceinline__ unsigned f2bf(float f) { unsigned u = __builtin_bit_cast(unsigned, f); return (u + 0x7fffu + ((u >> 16) & 1u)) >> 16; }
__device__ __forceinline__ unsigned pk2(float lo, float hi) { unsigned r; asm("v_cvt_pk_bf16_f32 %0, %1, %2" : "=v"(r) : "v"(lo), "v"(hi)); return r; }
__device__ __forceinline__ float bflo(unsigned w) { return __builtin_bit_cast(float, w << 16); }
__device__ __forceinline__ float bfhi(unsigned w) { return __builtin_bit_cast(float, w & 0xffff0000u); }
__device__ __forceinline__ float shx(float v, int k, int lane) { return __builtin_bit_cast(float, __builtin_amdgcn_ds_bpermute((lane ^ k) << 2, __builtin_bit_cast(int, v))); }
__device__ __forceinline__ float wave_sum(float v, int lane) {
#pragma unroll
    for (int o = 1; o < 64; o <<= 1) v += shx(v, o, lane);
    return v;
}

template <bool GLU>
__device__ __forceinline__ void transpose_item(const float* W, int K, int N, bf16* WT, LAS float* scr, int item, int lane) {
    const int nblk = N / 32, kb = item / nblk, nb = item % nblk, k0 = 64 * kb, n0 = 32 * nb;
    { float tv[32];
#pragma unroll
      for (int i = 0; i < 32; ++i) tv[i] = W[(size_t)(k0 + 2 * i + (lane >> 5)) * N + n0 + (lane & 31)];
      __builtin_amdgcn_sched_barrier(0);
#pragma unroll
      for (int i = 0; i < 32; ++i) scr[(2 * i + (lane >> 5)) * 33 + (lane & 31)] = tv[i]; }
    asm volatile("s_waitcnt lgkmcnt(0)" ::: "memory");
    int d0 = n0;
    if (GLU) { const int nn = n0 & 1023; d0 = ((nn >> 7) << 8) + (nn & 127) + ((n0 >> 10) << 7); }
    const int c = lane & 7;
#pragma unroll
    for (int j = 0; j < 4; ++j) { const int n = (lane >> 3) + 8 * j; const LAS float* s = scr + (8 * c) * 33 + n;
        u32x4 o; o.x = pk2(s[0 * 33], s[1 * 33]); o.y = pk2(s[2 * 33], s[3 * 33]); o.z = pk2(s[4 * 33], s[5 * 33]); o.w = pk2(s[6 * 33], s[7 * 33]);
        *(u32x4*)(WT + (size_t)(d0 + n) * K + k0 + 8 * c) = o; }
    asm volatile("s_waitcnt lgkmcnt(0)" ::: "memory");
}

struct Ptrs {
    const float *x_prompt, *x_sample, *cache_k, *cache_v, *c, *c_ctx, *norm_g, *w_ada, *b_ada, *w_qkv, *w_o, *rpb, *w_pw1, *w_dw, *b_dw, *ln_g, *ln_b, *w_pw2, *w_up, *w_down, *final_g;
};

__device__ __forceinline__ void p0_phase(const Ptrs& P, unsigned char* ws, LAS unsigned char* lds, int tid, int lane, int wave, int G, int bid) {
    bf16* Wt = (bf16*)(ws + WS_W);
    const int gw = bid * NWAVES + wave, NGW = G * NWAVES;
    LAS float* scr = (LAS float*)(lds + wave * 16384);
    constexpr int NIT = 23552;
    for (int it = gw; it < NIT; it += NGW) {
        if (it < 7168) { const int i = it / 3584; int r = it % 3584;
            if (r < 1536) { transpose_item<false>(P.w_qkv + (size_t)i * D * 3 * D, D, 3 * D, Wt + W_QKV + (size_t)i * 3 * MEL, scr, r, lane); continue; } r -= 1536;
            if (r < 512) { transpose_item<false>(P.w_o + (size_t)i * D * D, D, D, Wt + W_O + (size_t)i * MEL, scr, r, lane); continue; } r -= 512;
            if (r < 1024) { transpose_item<true>(P.w_pw1 + (size_t)i * D * 2 * D, D, 2 * D, Wt + W_PW1 + (size_t)i * 2 * MEL, scr, r, lane); continue; } r -= 1024;
            transpose_item<false>(P.w_pw2 + (size_t)i * D * D, D, D, Wt + W_PW2 + (size_t)i * MEL, scr, r, lane);
        } else { const int l = (it - 7168) / 4096; int r = (it - 7168) % 4096;
            if (r < 2048) transpose_item<false>(P.w_up + (size_t)l * D * FF, D, FF, Wt + W_UP + (size_t)l * 4 * MEL, scr, r, lane);
            else transpose_item<false>(P.w_down + (size_t)l * D * FF, FF, D, Wt + W_DOWN + (size_t)l * 4 * MEL, scr, r - 2048, lane);
        }
    }
    { bf16* CK = (bf16*)(ws + WS_CK); bf16* CV = (bf16*)(ws + WS_CV);
      const int NT = G * NTHR; constexpr int NV = 2 * 4 * 2 * 256 * 1024 / 8;
      for (int v = bid * NTHR + tid; v < NV; v += NT) { const int which = v >= NV / 2; const int e = (which ? v - NV / 2 : v) * 8;
          const float* src = (which ? P.cache_v : P.cache_k) + e; const f32x4 a = *(const f32x4*)src, b = *(const f32x4*)(src + 4);
          u32x4 o; o.x = pk2(a[0], a[1]); o.y = pk2(a[2], a[3]); o.z = pk2(b[0], b[1]); o.w = pk2(b[2], b[3]);
          *(u32x4*)((which ? CV : CK) + e) = o; } }
    { f32x4* z = (f32x4*)(ws + WS_SS); const int NT = G * NTHR; float zf = 0.f; asm volatile("" : "+v"(zf));
      const f32x4 zz = (f32x4){zf, zf, zf, zf}; for (int v = bid * NTHR + tid; v < 9 * M / 4; v += NT) z[v] = zz; }
    __syncthreads();
    { LAS float* sil = (LAS float*)lds; LAS float* red = (LAS float*)(lds + 20480); float* mod = (float*)(ws + WS_MOD);
      for (int k = tid; k < 5 * 1024; k += NTHR) { const int cc = k >> 10, kk = k & 1023; const float v = cc == 0 ? P.c_ctx[kk] : P.c[(cc - 1) * 1024 + kk]; sil[k] = v / (1.f + __expf(-v)); }
      __syncthreads();
      const int kg = tid >> 4, cl = tid & 15;
      for (int item = bid; item < 384; item += G) { const int l = item / 96, n0 = (item % 96) * 64;
          const float* W = P.w_ada + (size_t)l * D * 6144 + n0 + 4 * cl;
          f32x4 a[5];
#pragma unroll
          for (int cc = 0; cc < 5; ++cc) a[cc] = (f32x4){0.f, 0.f, 0.f, 0.f};
#pragma unroll 4
          for (int kk = 0; kk < 32; ++kk) { const int k = kg * 32 + kk; const f32x4 w = *(const f32x4*)(W + (size_t)k * 6144);
#pragma unroll
              for (int cc = 0; cc < 5; ++cc) a[cc] += sil[cc * 1024 + k] * w; }
#pragma unroll
          for (int cc = 0; cc < 5; ++cc) *(LAS f32x4*)(red + (kg * 5 + cc) * 64 + 4 * cl) = a[cc];
          __syncthreads();
          if (tid < 320) { const int cc = tid >> 6, n = tid & 63; float s = 0.f;
#pragma unroll 8
              for (int g = 0; g < 32; ++g) s += red[(g * 5 + cc) * 64 + n];
              mod[(size_t)(l * 5 + cc) * 6144 + n0 + n] = s + P.b_ada[l * 6144 + n0 + n]; }
          __syncthreads();
      } }
}

__device__ __forceinline__ void norm_phase(const float* xp, const float* xs, bf16* H, float* yout, const float* g, const float* shift, const float* scale, int gw, int NGW, int lane) {
    f32x4 gv[4];
#pragma unroll
    for (int j = 0; j < 4; ++j) gv[j] = *(const f32x4*)(g + 4 * (lane + 64 * j));
    for (int m = gw; m < M; m += NGW) {
        const float* xrow = m < MP ? xp + (size_t)m * D : xs + (size_t)(m - MP) * D;
        const int cond = m < MP ? 0 : 1 + ((m - MP) >> 10);
        f32x4 v[4]; float ss = 0.f;
#pragma unroll
        for (int j = 0; j < 4; ++j) { v[j] = *(const f32x4*)(xrow + 4 * (lane + 64 * j)); ss += (v[j][0] * v[j][0] + v[j][1] * v[j][1]) + (v[j][2] * v[j][2] + v[j][3] * v[j][3]); }
        const float r = 1.0f / sqrtf(wave_sum(ss, lane) * (1.f / D) + 1e-6f);
        if (yout) {
#pragma unroll
            for (int j = 0; j < 4; ++j) *(f32x4*)(yout + (size_t)m * D + 4 * (lane + 64 * j)) = v[j] * r * gv[j];
        } else {
#pragma unroll
            for (int j = 0; j < 4; ++j) { const f32x4 sc = *(const f32x4*)(scale + cond * 6144 + 4 * (lane + 64 * j)), sh = *(const f32x4*)(shift + cond * 6144 + 4 * (lane + 64 * j));
                const f32x4 h = (v[j] * r * gv[j]) * (1.f + sc) + sh; u32x2 o; o.x = pk2(h[0], h[1]); o.y = pk2(h[2], h[3]);
                *(u32x2*)(H + (size_t)m * D + 4 * (lane + 64 * j)) = o; }
        }
    }
}

template <class F, int... I> __device__ __forceinline__ void sfor_impl(F&& f, std::integer_sequence<int, I...>) { (f(std::integral_constant<int, I>{}), ...); }
template <int N, class F> __device__ __forceinline__ void sfor(F&& f) { sfor_impl(f, std::make_integer_sequence<int, N>{}); }
__device__ __forceinline__ float dpp_add(float v, int ctrl_b1, int ctrl_4e, int dummy) { return v; }
__device__ __forceinline__ float wave_sum_dpp(float v) {
    v += __builtin_bit_cast(float, __builtin_amdgcn_update_dpp(0, __builtin_bit_cast(int, v), 0xB1, 0xf, 0xf, false));
    v += __builtin_bit_cast(float, __builtin_amdgcn_update_dpp(0, __builtin_bit_cast(int, v), 0x4E, 0xf, 0xf, false));
    v += __builtin_bit_cast(float, __builtin_amdgcn_update_dpp(0, __builtin_bit_cast(int, v), 0x141, 0xf, 0xf, false));
    v += __builtin_bit_cast(float, __builtin_amdgcn_update_dpp(0, __builtin_bit_cast(int, v), 0x140, 0xf, 0xf, false));
    const int vi = __builtin_bit_cast(int, v);
    return (__builtin_bit_cast(float, __builtin_amdgcn_readlane(vi, 0)) + __builtin_bit_cast(float, __builtin_amdgcn_readlane(vi, 16))) +
           (__builtin_bit_cast(float, __builtin_amdgcn_readlane(vi, 32)) + __builtin_bit_cast(float, __builtin_amdgcn_readlane(vi, 48)));
}
constexpr int CT = 16, CROWS = CT + 30, CCH = (CROWS + 15) / 16;
__device__ __forceinline__ void conv_phase(const bf16* U, bf16* Vc, const float* wdw, const float* bdw, const float* lng, const float* lnb, LAS unsigned char* lds, int tid, int lane, int wave, int G, int bid) {
    f32x2 w[31];
    sfor<31>([&](auto K) __attribute__((always_inline)) { constexpr int k = decltype(K)::value; w[k] = *(const f32x2*)(wdw + k * D + 2 * tid); });
    const f32x2 bd = *(const f32x2*)(bdw + 2 * tid), lg = *(const f32x2*)(lng + 2 * tid), lb = *(const f32x2*)(lnb + 2 * tid);
    LAS f32x2* part = (LAS f32x2*)lds;
    LAS f32x2* stats = part + 8 * CT;
    for (int unit = bid; unit < M / CT; unit += G) {
        const int m0 = unit * CT, seg = m0 < MP ? 0 : MP, L = m0 < MP ? 256 : 1024, t0 = (m0 - seg) & (L - 1);
        const bf16* Ub = U + (size_t)(m0 - t0) * D + 2 * tid;
        f32x2 acc[CT];
        sfor<CT>([&](auto O) __attribute__((always_inline)) { acc[decltype(O)::value] = bd; });
        sfor<CCH>([&](auto C) __attribute__((always_inline)) { constexpr int c = decltype(C)::value;
            unsigned raw[16];
            sfor<16>([&](auto I) __attribute__((always_inline)) { constexpr int i = decltype(I)::value, j = c * 16 + i;
                if constexpr (j < CROWS) { const int t = t0 - 15 + j, tc = min(max(t, 0), L - 1);
                    raw[i] = *(const unsigned*)(Ub + (size_t)tc * D); } });
            SB0();
            sfor<16>([&](auto I) __attribute__((always_inline)) { constexpr int i = decltype(I)::value, j = c * 16 + i;
                if constexpr (j < CROWS) { const int t = t0 - 15 + j; const unsigned rm = raw[i] & (unsigned)(-(int)((t >= 0) & (t < L))); const f32x2 u = (f32x2){bflo(rm), bfhi(rm)};
                    sfor<31>([&](auto K) __attribute__((always_inline)) { constexpr int k = decltype(K)::value, o = j - k;
                        if constexpr (o >= 0 && o < CT) acc[o] += u * w[k]; }); } });
        });
        sfor<CT>([&](auto O) __attribute__((always_inline)) { constexpr int o = decltype(O)::value;
            const float s = wave_sum_dpp(acc[o].x + acc[o].y), q = wave_sum_dpp(acc[o].x * acc[o].x + acc[o].y * acc[o].y); if (lane == 0) part[wave * CT + o] = (f32x2){s, q}; });
        __syncthreads();
        if (tid < CT) { float s = 0.f, q = 0.f;
#pragma unroll
            for (int wv = 0; wv < 8; ++wv) { const f32x2 p = part[wv * CT + tid]; s += p.x; q += p.y; }
            const float mean = s * (1.f / D), var = fmaxf(q * (1.f / D) - mean * mean, 0.f); stats[tid] = (f32x2){mean, 1.0f / sqrtf(var + 1e-5f)}; }
        __syncthreads();
        sfor<CT>([&](auto O) __attribute__((always_inline)) { constexpr int o = decltype(O)::value;
            const f32x2 st = stats[o]; f32x2 y = (acc[o] - st.x) * st.y * lg + lb;
            y.x = y.x * __builtin_amdgcn_rcpf(1.f + __expf(-y.x)); y.y = y.y * __builtin_amdgcn_rcpf(1.f + __expf(-y.y));
            *(unsigned*)(Vc + (size_t)(m0 + o) * D + 2 * tid) = pk2(y.x, y.y); });
        __syncthreads();
    }
}

__device__ __forceinline__ void final_norm_phase(const bf16* X, float* yout, const float* g, int gw, int NGW, int lane) {
    f32x4 gv[4];
#pragma unroll
    for (int j = 0; j < 4; ++j) gv[j] = *(const f32x4*)(g + 16 * lane + 4 * j);
    for (int m = gw; m < M; m += NGW) {
        const bf16* xr = X + (size_t)m * D + 16 * lane;
        const u32x4 w0 = *(const u32x4*)xr, w1 = *(const u32x4*)(xr + 8);
        f32x4 v[4]; v[0] = (f32x4){bflo(w0[0]), bfhi(w0[0]), bflo(w0[1]), bfhi(w0[1])}; v[1] = (f32x4){bflo(w0[2]), bfhi(w0[2]), bflo(w0[3]), bfhi(w0[3])};
        v[2] = (f32x4){bflo(w1[0]), bfhi(w1[0]), bflo(w1[1]), bfhi(w1[1])}; v[3] = (f32x4){bflo(w1[2]), bfhi(w1[2]), bflo(w1[3]), bfhi(w1[3])};
        float sq = 0.f;
#pragma unroll
        for (int j = 0; j < 4; ++j) sq += (v[j][0] * v[j][0] + v[j][1] * v[j][1]) + (v[j][2] * v[j][2] + v[j][3] * v[j][3]);
        const float r = 1.0f / sqrtf(wave_sum_dpp(sq) * (1.f / D) + 1e-6f);
#pragma unroll
        for (int j = 0; j < 4; ++j) *(f32x4*)(yout + (size_t)m * D + 16 * lane + 4 * j) = v[j] * r * gv[j];
    }
}

__device__ __forceinline__ void prep_phase(const float* xp, const float* xs, bf16* H, float* ss0, const float* g, const float* scale, const float* mod, const bf16* Wt, float* shw, int gw, int NGW, int lane) {
    { f32x4 gv[4];
#pragma unroll
      for (int j = 0; j < 4; ++j) gv[j] = *(const f32x4*)(g + 4 * (lane + 64 * j));
      for (int m = gw; m < M; m += NGW) {
          const float* xrow = m < MP ? xp + (size_t)m * D : xs + (size_t)(m - MP) * D;
          const int cond = m < MP ? 0 : 1 + ((m - MP) >> 10);
          f32x4 v[4]; float sq = 0.f;
#pragma unroll
          for (int j = 0; j < 4; ++j) { v[j] = *(const f32x4*)(xrow + 4 * (lane + 64 * j)); sq += (v[j][0] * v[j][0] + v[j][1] * v[j][1]) + (v[j][2] * v[j][2] + v[j][3] * v[j][3]); }
          sq = wave_sum_dpp(sq); if (lane == 0) ss0[m] = sq;
          f32x4 sc[4];
#pragma unroll
          for (int j = 0; j < 4; ++j) sc[j] = *(const f32x4*)(scale + cond * 6144 + 4 * (lane + 64 * j));
#pragma unroll
          for (int j = 0; j < 4; ++j) { const f32x4 h = v[j] * gv[j] * (1.f + sc[j]); u32x2 o; o.x = pk2(h[0], h[1]); o.y = pk2(h[2], h[3]);
              *(u32x2*)(H + (size_t)m * D + 4 * (lane + 64 * j)) = o; }
      } }
    for (int it = gw; it < 4 * 8192; it += NGW) {
        const int l = it >> 13, which = (it >> 12) & 1, n = it & 4095, i = l >> 1; const bool conv = (l & 1) != 0;
        const int N = which ? 4096 : (conv ? 2048 : 3072);
        if (n >= N) continue;
        const bf16* wrow = Wt + (which ? W_UP + (size_t)l * 4 * MEL : (conv ? W_PW1 + (size_t)i * 2 * MEL : W_QKV + (size_t)i * 3 * MEL)) + (size_t)n * D + 16 * lane;
        const u32x4 w0 = *(const u32x4*)wrow, w1 = *(const u32x4*)(wrow + 8);
        float wv[16];
#pragma unroll
        for (int e = 0; e < 4; ++e) { wv[2 * e] = bflo(w0[e]); wv[2 * e + 1] = bfhi(w0[e]); wv[8 + 2 * e] = bflo(w1[e]); wv[8 + 2 * e + 1] = bfhi(w1[e]); }
#pragma unroll
        for (int cond = 0; cond < 5; ++cond) { const float* sh = mod + (size_t)(l * 5 + cond) * 6144 + (which ? 3 : 0) * 1024 + 16 * lane; float dot = 0.f;
#pragma unroll
            for (int q = 0; q < 4; ++q) { const f32x4 s4 = *(const f32x4*)(sh + 4 * q); dot += (s4[0] * wv[4 * q] + s4[1] * wv[4 * q + 1]) + (s4[2] * wv[4 * q + 2] + s4[3] * wv[4 * q + 3]); }
            dot = wave_sum_dpp(dot); if (lane == 0) shw[(size_t)((l * 2 + which) * 5 + cond) * 4096 + n] = dot; }
    }
}

constexpr float SCL = 0.125f * 1.4426950408889634f, LOG2E = 1.4426950408889634f;
__device__ __forceinline__ void vt_write(LAS bf16* Vt, int pitch, int slot, int chunk, u32x4 v) {
    LAS bf16* p = Vt + (8 * chunk) * pitch + slot;
    p[0] = (bf16)(v.x & 0xffffu); p[pitch] = (bf16)(v.x >> 16); p[2 * pitch] = (bf16)(v.y & 0xffffu); p[3 * pitch] = (bf16)(v.y >> 16);
    p[4 * pitch] = (bf16)(v.z & 0xffffu); p[5 * pitch] = (bf16)(v.z >> 16); p[6 * pitch] = (bf16)(v.w & 0xffffu); p[7 * pitch] = (bf16)(v.w >> 16);
}
template <int NB> __device__ __forceinline__ void softmax_part(f32x4 (&s)[NB], float& mx_out, float& sum_out, int lane, float m_floor = -INFINITY) {
    float mx = m_floor;
#pragma unroll
    for (int b = 0; b < NB; ++b) mx = fmaxf(mx, fmaxf(fmaxf(s[b][0], s[b][1]), fmaxf(s[b][2], s[b][3])));
    mx = fmaxf(mx, shx(mx, 16, lane)); mx = fmaxf(mx, shx(mx, 32, lane));
    float sum = 0.f;
#pragma unroll
    for (int b = 0; b < NB; ++b) {
#pragma unroll
        for (int e = 0; e < 4; ++e) { s[b][e] = __builtin_amdgcn_exp2f(s[b][e] - mx); sum += s[b][e]; } }
    sum += shx(sum, 16, lane); sum += shx(sum, 32, lane);
    mx_out = mx; sum_out = sum;
}
__device__ __forceinline__ bf16x8 pack_p(const f32x4& a, const f32x4& b) {
    u32x4 w; w.x = pk2(a[0], a[1]); w.y = pk2(a[2], a[3]); w.z = pk2(b[0], b[1]); w.w = pk2(b[2], b[3]); return __builtin_bit_cast(bf16x8, w);
}
__device__ __forceinline__ bf16x8 vt_read(const LAS bf16* p0, const LAS bf16* p1) {
    const s16x4 a = *(const LAS s16x4*)p0, b = *(const LAS s16x4*)p1; return (bf16x8){a[0], a[1], a[2], a[3], b[0], b[1], b[2], b[3]};
}
__device__ __forceinline__ f32x4 qk_block(const bf16* kp, const bf16x8& qf0, const bf16x8& qf1) {
    const bf16x8 k0 = *(const bf16x8*)kp, k1 = *(const bf16x8*)(kp + 32);
    f32x4 a = __builtin_amdgcn_mfma_f32_16x16x32_bf16(k0, qf0, (f32x4){0.f, 0.f, 0.f, 0.f}, 0, 0, 0);
    return __builtin_amdgcn_mfma_f32_16x16x32_bf16(k1, qf1, a, 0, 0, 0);
}
#define PV16(o, s, SLOT_EXPR, PITCH_) do { _Pragma("unroll") for (int pp = 0; pp < 8; ++pp) { const bf16x8 pf = pack_p(s[2 * pp], s[2 * pp + 1]); const int slot0 = (SLOT_EXPR); \
        _Pragma("unroll") for (int db = 0; db < 4; ++db) { const LAS bf16* vp = Vt + (16 * db + l15) * (PITCH_) + slot0; \
            o[db] = __builtin_amdgcn_mfma_f32_16x16x32_bf16(vt_read(vp, vp + 16), pf, o[db], 0, 0, 0); } } } while (0)

#ifndef CBN
#define CBN 4
#endif
__device__ __forceinline__ void attn_phase(const bf16* Qb, const bf16* Kb, const bf16* Vb, bf16* Ob, const bf16* CK, const bf16* CV, const float* rpb  ,
                                           int li, LAS unsigned char* lds, int tid, int lane, int wave, int G, int bid, int ulo, int uhi) {
    LAS bf16* Vt = (LAS bf16*)lds; LAS float* rpl = (LAS float*)(lds + 110592); LAS unsigned char* Kc = lds + LDS_KC;
    for (int u = bid + ulo; u < uhi; u += G) {
        int lz_ = lane; asm volatile("" : "+v"(lz_));
        const int l15 = lz_ & 15, g = lz_ >> 4;
        if (u < 512) {
            const int b = u >> 4, h = u & 15; constexpr int PITCH = 264;
            const int qrow0 = b * 256 + 32 * wave + l15;
            const bf16x8 qa0 = *(const bf16x8*)(Qb + (size_t)qrow0 * D + h * 64 + 8 * g), qa1 = *(const bf16x8*)(Qb + (size_t)qrow0 * D + h * 64 + 32 + 8 * g);
            const bf16x8 qb0 = *(const bf16x8*)(Qb + (size_t)(qrow0 + 16) * D + h * 64 + 8 * g), qb1 = *(const bf16x8*)(Qb + (size_t)(qrow0 + 16) * D + h * 64 + 32 + 8 * g);
            SB0();
            { int t2 = tid; asm volatile("" : "+v"(t2));
              const int key = t2 & 255, c0 = (t2 >> 8) * 4; const bf16* src = Vb + (size_t)(b * 256 + key) * D + h * 64 + 8 * c0; const bf16* ksrc = Kb + (size_t)(b * 256 + key) * D + h * 64 + 8 * c0;
              u32x4 v[4], kv[4];
#pragma unroll
              for (int c = 0; c < 4; ++c) { v[c] = *(const u32x4*)(src + 8 * c); kv[c] = *(const u32x4*)(ksrc + 8 * c); }
              SB0();
#pragma unroll
              for (int c = 0; c < 4; ++c) *(LAS u32x4*)(Kc + key * 144 + (c0 + c) * 16) = kv[c];
#pragma unroll
              for (int c = 0; c < 4; ++c) vt_write(Vt, PITCH, key, c0 + c, v[c]); }
            __syncthreads();
            SB0();
            f32x4 s0[16], s1[16];
            { const LAS unsigned char* kl = Kc + l15 * 144 + g * 16;
              sfor<16>([&](auto I) __attribute__((always_inline)) { constexpr int kb = decltype(I)::value;
                const bf16x8 k0 = *(const LAS bf16x8*)(kl + kb * (16 * 144)), k1 = *(const LAS bf16x8*)(kl + kb * (16 * 144) + 64);
                f32x4 a = __builtin_amdgcn_mfma_f32_16x16x32_bf16(k0, qa0, (f32x4){0.f, 0.f, 0.f, 0.f}, 0, 0, 0); s0[kb] = __builtin_amdgcn_mfma_f32_16x16x32_bf16(k1, qa1, a, 0, 0, 0) * SCL;
                f32x4 c = __builtin_amdgcn_mfma_f32_16x16x32_bf16(k0, qb0, (f32x4){0.f, 0.f, 0.f, 0.f}, 0, 0, 0); s1[kb] = __builtin_amdgcn_mfma_f32_16x16x32_bf16(k1, qb1, c, 0, 0, 0) * SCL; }); }
            { float mx, sum; softmax_part<16>(s0, mx, sum, lane);
              f32x4 o[4];
#pragma unroll
              for (int db = 0; db < 4; ++db) o[db] = (f32x4){0.f, 0.f, 0.f, 0.f};
              PV16(o, s0, 32 * pp + 4 * g, PITCH);
              const float rl = 1.0f / sum;
#pragma unroll
              for (int db = 0; db < 4; ++db) { const f32x4 ov = o[db] * rl; u32x2 w; w.x = pk2(ov[0], ov[1]); w.y = pk2(ov[2], ov[3]);
                  *(u32x2*)(Ob + (size_t)qrow0 * D + h * 64 + 16 * db + 4 * g) = w; } }
            { float mx, sum; softmax_part<16>(s1, mx, sum, lane);
              f32x4 o[4];
#pragma unroll
              for (int db = 0; db < 4; ++db) o[db] = (f32x4){0.f, 0.f, 0.f, 0.f};
              PV16(o, s1, 32 * pp + 4 * g, PITCH);
              const float rl = 1.0f / sum;
#pragma unroll
              for (int db = 0; db < 4; ++db) { const f32x4 ov = o[db] * rl; u32x2 w; w.x = pk2(ov[0], ov[1]); w.y = pk2(ov[2], ov[3]);
                  *(u32x2*)(Ob + (size_t)(qrow0 + 16) * D + h * 64 + 16 * db + 4 * g) = w; } }
            __syncthreads();
        } else {
            const int ui = u - 512, xcd = ui & 7, idx = (ui >> 3) & 63, uu = (G == 256) ? ((xcd * 8 + (idx >> 3)) << 3) + (idx & 7) : ui;
            const int b = uu >> 7, h = (uu >> 3) & 15, rp = uu & 7, r0 = 2 * rp; constexpr int PITCH = 840;
            const int rs0 = min(max(r0 - 4, 0), 8);
            const size_t tokb = (size_t)MP + (size_t)b * 1024;
            const int r = r0 + (wave >> 2), j = wave & 3, rs = min(max(r - 4, 0), 8), rrel = rs - rs0, kcs = min(max(16 * j - 8, 0), 32);
            const int qcol = 16 * j + l15, wst = min(max(qcol - 8, 0), 48);
            const size_t qtok = tokb + r * 64 + qcol;
            const bf16* kloc = Kb + (tokb + rs * 64 + kcs + l15) * D + h * 64 + 8 * g;
            bf16x8 kf[16][2];
#define LOAD_KLOC(H) sfor<8>([&](auto I) __attribute__((always_inline)) { constexpr int lb = 8 * (H) + decltype(I)::value; const bf16* kp = kloc + (size_t)((lb >> 1) * 64 + 16 * (lb & 1)) * D; kf[lb][0] = *(const bf16x8*)kp; kf[lb][1] = *(const bf16x8*)(kp + 32); })
            LOAD_KLOC(0);
            const bf16x8 qf0 = *(const bf16x8*)(Qb + qtok * D + h * 64 + 8 * g), qf1 = *(const bf16x8*)(Qb + qtok * D + h * 64 + 32 + 8 * g);
            SB0();
            { int t2 = tid; asm volatile("" : "+v"(t2));
              const int slotA = t2, slotB = t2 + NTHR, slotBc = min(slotB, 831);
              const bf16* srcA = (slotA < 576) ? Vb + (tokb + min(rs0 + (slotA >> 6), 15) * 64 + (slotA & 63)) * D + h * 64 : CV + ((size_t)(b * 2 + li) * 256 + (slotA - 576)) * D + h * 64;
              const bf16* srcB = (slotBc < 576) ? Vb + (tokb + min(rs0 + (slotBc >> 6), 15) * 64 + (slotBc & 63)) * D + h * 64 : CV + ((size_t)(b * 2 + li) * 256 + (slotBc - 576)) * D + h * 64;
              const int key = t2 & 255, c0 = (t2 >> 8) * 4; const bf16* ksrc = CK + ((size_t)(b * 2 + li) * 256 + key) * D + h * 64 + 8 * c0;
              u32x4 va[8], vb[8], kv[4];
#pragma unroll
              for (int c = 0; c < 8; ++c) { va[c] = *(const u32x4*)(srcA + 8 * c); vb[c] = *(const u32x4*)(srcB + 8 * c); }
#pragma unroll
              for (int c = 0; c < 4; ++c) kv[c] = *(const u32x4*)(ksrc + 8 * c);
              const float rv = rpb[h * 465 + min(t2, 464)];
              SB0();
#pragma unroll
              for (int c = 0; c < 8; ++c) vt_write(Vt, PITCH, slotA, c, va[c]);
              if (slotB < 832) {
#pragma unroll
                  for (int c = 0; c < 8; ++c) vt_write(Vt, PITCH, slotB, c, vb[c]); }
#pragma unroll
              for (int c = 0; c < 4; ++c) *(LAS u32x4*)(Kc + key * 144 + (c0 + c) * 16) = kv[c];
              if (t2 < 465) rpl[t2] = rv; }
            SB0(); LOAD_KLOC(1); SB0();
            __syncthreads();
            SB0();
            f32x4 o1[4]; float m1, l1, m2, l2;
#pragma unroll
            for (int db = 0; db < 4; ++db) o1[db] = (f32x4){0.f, 0.f, 0.f, 0.f};
            {
                int dcv[8]; unsigned vmask = 0u;
#pragma unroll
                for (int ce = 0; ce < 8; ++ce) { const int kc = kcs + 16 * (ce >> 2) + 4 * g + (ce & 3); vmask |= ((kc >= wst) && (kc < wst + 16)) ? (1u << ce) : 0u; dcv[ce] = min(max(kc - qcol + 15, 0), 30); }
                f32x4 s[16];
#define QK_LOC(H) sfor<8>([&](auto I) __attribute__((always_inline)) { constexpr int lb = 8 * (H) + decltype(I)::value, krow = lb >> 1, ch = lb & 1; \
                    f32x4 a = __builtin_amdgcn_mfma_f32_16x16x32_bf16(kf[lb][0], qf0, (f32x4){0.f, 0.f, 0.f, 0.f}, 0, 0, 0); a = __builtin_amdgcn_mfma_f32_16x16x32_bf16(kf[lb][1], qf1, a, 0, 0, 0); \
                    const LAS float* rp_row = rpl + (rs + krow - r + 7) * 31; float bias[4]; \
                    _Pragma("unroll") for (int e = 0; e < 4; ++e) bias[e] = rp_row[dcv[ch * 4 + e]]; \
                    _Pragma("unroll") for (int e = 0; e < 4; ++e) { const float t = a[e] * SCL + bias[e] * LOG2E; a[e] = ((vmask >> (ch * 4 + e)) & 1u) ? t : -INFINITY; } \
                    s[lb] = a; })
                QK_LOC(0); QK_LOC(1); SB0();
                softmax_part<16>(s, m1, l1, lane);
                PV16(o1, s, (rrel + pp) * 64 + kcs + 4 * g, PITCH);
            }
            SB0();
            {
                f32x4 s[16];
                { const LAS unsigned char* kl = Kc + l15 * 144 + g * 16;
                  sfor<16>([&](auto I) __attribute__((always_inline)) { constexpr int cb = decltype(I)::value;
                    const bf16x8 k0 = *(const LAS bf16x8*)(kl + cb * (16 * 144)), k1 = *(const LAS bf16x8*)(kl + cb * (16 * 144) + 64);
                    f32x4 a = __builtin_amdgcn_mfma_f32_16x16x32_bf16(k0, qf0, (f32x4){0.f, 0.f, 0.f, 0.f}, 0, 0, 0); s[cb] = __builtin_amdgcn_mfma_f32_16x16x32_bf16(k1, qf1, a, 0, 0, 0) * SCL; }); }
                softmax_part<16>(s, m2, l2, lane, m1);
                const float a1 = __builtin_amdgcn_exp2f(m1 - m2);
#pragma unroll
                for (int db = 0; db < 4; ++db) o1[db] = o1[db] * a1;
                l1 = l1 * a1 + l2;
                PV16(o1, s, 576 + 32 * pp + 4 * g, PITCH);
            }
            const float rl = 1.0f / l1;
            int r2_ = r; asm volatile("" : "+s"(r2_));
            const size_t qtok2 = tokb + r2_ * 64 + qcol;
#pragma unroll
            for (int db = 0; db < 4; ++db) { const f32x4 ov = o1[db] * rl; u32x2 w; w.x = pk2(ov[0], ov[1]); w.y = pk2(ov[2], ov[3]);
                *(u32x2*)(Ob + qtok2 * D + h * 64 + 16 * db + 4 * g) = w; }
            __syncthreads();
        }
    }
}

#define RLX_AGENT __ATOMIC_RELAXED, __HIP_MEMORY_SCOPE_AGENT
#define XB_TMO      128
#define XB_XCNT(j)  (256  + 64 * (j))
#define XB_XSUB(j)  (1280 + 64 * (j))
#define XB_XGEN(j)  (2304 + 64 * (j))
#define XB_TOP      3328
#define XB_TOPGEN   3392
#define XCD_BAR_WORDS 3456
#define XB_SPIN_CAP (1u << 18)

__device__ __forceinline__ unsigned xb_ld(unsigned* p)              { return __hip_atomic_load(p, __ATOMIC_RELAXED, __HIP_MEMORY_SCOPE_AGENT); }
__device__ __forceinline__ unsigned xb_add(unsigned* p, unsigned v) { return __hip_atomic_fetch_add(p, v, __ATOMIC_RELAXED, __HIP_MEMORY_SCOPE_AGENT); }
__device__ __forceinline__ unsigned xb_xcc_id() { return (unsigned)__builtin_amdgcn_s_getreg((3 << 11) | 20) & 0xFu; }
#define XB_SPIN(cond, bar) do { unsigned _sp = 0; while (cond) { __builtin_amdgcn_s_sleep(1); \
    if ((++_sp & 255u) == 0u) { if (xb_ld(&(bar)[XB_TMO])) break; if (_sp > XB_SPIN_CAP) { atomicAdd(&(bar)[XB_TMO], 1u); break; } } } } while (0)

struct XcdBarrier {
    unsigned* bar; unsigned x;
    volatile LAS unsigned* st;
};

__device__ __forceinline__ XcdBarrier xcd_barrier_post(unsigned* bar, volatile LAS unsigned* st) {
    XcdBarrier b; b.bar = bar; b.x = xb_xcc_id(); b.st = st;
    if (threadIdx.x == 0) (void)xb_add(&bar[XB_XCNT(b.x)], 1u);
    return b;
}
__device__ __forceinline__ void xcd_barrier_complete(unsigned* bar, unsigned x, unsigned& nloc, unsigned& nx) {
    const unsigned G = gridDim.x * gridDim.y * gridDim.z;
    unsigned sum, cnt, mine, sp = 0u;
    for (;;) {
        sum = 0u; cnt = 0u; mine = 0u;
#pragma unroll
        for (unsigned j = 0; j < 16; ++j) { const unsigned c = xb_ld(&bar[XB_XCNT(j)]); sum += c; cnt += (c > 0u) ? 1u : 0u; mine = (j == x) ? c : mine; }
        if (sum == G) break;
        __builtin_amdgcn_s_sleep(1);
        if ((++sp & 255u) == 0u) { if (xb_ld(&bar[XB_TMO])) break; if (sp > XB_SPIN_CAP) { atomicAdd(&bar[XB_TMO], 1u); break; } }
    }
    nloc = mine > 0u ? mine : 1u; nx = cnt > 0u ? cnt : 1u;
}

__device__ __forceinline__ void xcd_barrier(const XcdBarrier& b) {
    asm volatile("s_waitcnt vmcnt(0)" ::: "memory");
    __syncthreads();
    if (threadIdx.x == 0) {
        unsigned* bar = b.bar;
        __builtin_amdgcn_s_waitcnt(0);
        unsigned nloc = b.st[0], nx = b.st[1];
        if (nloc == 0u) { xcd_barrier_complete(bar, b.x, nloc, nx); b.st[0] = nloc; b.st[1] = nx; }
        const unsigned old = xb_add(&bar[XB_XSUB(b.x)], 1u);
        const unsigned gen = old / nloc;
        if (old + 1u == (gen + 1u) * nloc) {
            __builtin_amdgcn_fence(__ATOMIC_RELEASE, "agent");
            asm volatile("s_waitcnt vmcnt(0)" ::: "memory");
            const unsigned og = xb_add(&bar[XB_TOP], 1u);
            const unsigned tg = og / nx;
            if (og + 1u == (tg + 1u) * nx) xb_add(&bar[XB_TOPGEN], 1u);
            else XB_SPIN(xb_ld(&bar[XB_TOPGEN]) == tg, bar);
            __builtin_amdgcn_fence(__ATOMIC_ACQUIRE, "agent");
            xb_add(&bar[XB_XGEN(b.x)], 1u);
            asm volatile("s_waitcnt vmcnt(0)" ::: "memory");
        } else {
            XB_SPIN(xb_ld(&bar[XB_XGEN(b.x)]) == gen, bar);
            __builtin_amdgcn_fence(__ATOMIC_ACQUIRE, "agent");
            asm volatile("s_waitcnt vmcnt(0)" ::: "memory");
        }
    }
    __syncthreads();
}

constexpr int NPH = 2 + 5 * NL + 1;
struct Args { const float* in[21]; float* out; unsigned char* ws; int nprog, pad; int prog[48]; };
typedef const __attribute__((address_space(4))) Args* KArgPtr;
__global__ void __launch_bounds__(NTHR, 2) fwd_kernel(Args a_unused) {
    extern __shared__ __attribute__((aligned(16))) unsigned char lds_raw[];
    LAS unsigned char* lds = (LAS unsigned char*)lds_raw;
    cg::grid_group grid = cg::this_grid();
    const int wave0 = __builtin_amdgcn_readfirstlane((int)threadIdx.x >> 6);
    { volatile LAS unsigned* st0 = (volatile LAS unsigned*)(lds + LDS_ST); if (threadIdx.x < 2) st0[threadIdx.x] = 0u; }
    __syncthreads();
    XcdBarrier xbar; { KArgPtr kpb = (KArgPtr)__builtin_amdgcn_kernarg_segment_ptr(); xbar.bar = (unsigned*)kpb->ws; xbar.x = 0; xbar.st = (volatile LAS unsigned*)(lds + LDS_ST);
        if (blockIdx.x == 0) { for (int wI = threadIdx.x; wI < XCD_BAR_WORDS; wI += NTHR) __hip_atomic_store(xbar.bar + wI, 0u, __ATOMIC_RELAXED, __HIP_MEMORY_SCOPE_AGENT); } }
    int nprog; { KArgPtr kp0 = (KArgPtr)__builtin_amdgcn_kernarg_segment_ptr(); nprog = kp0->nprog; }
    for (int pc = 0; pc < nprog; ++pc) {
        KArgPtr kp = (KArgPtr)__builtin_amdgcn_kernarg_segment_ptr(); asm volatile("" : "+s"(kp));
        int z_ = 0; asm volatile("" : "+s"(z_));
        const int lane_ = (int)__builtin_amdgcn_mbcnt_hi(~0u, __builtin_amdgcn_mbcnt_lo(~0u, (unsigned)z_)); const int tid_ = wave0 * 64 + lane_;
        int bid_ = (int)__builtin_amdgcn_workgroup_id_x(), G_ = (int)gridDim.x; asm volatile("" : "+s"(bid_), "+s"(G_));
        const int pe_ = kp->prog[pc]; const int ph = pe_ & 63, amode = pe_ >> 6;
        const int tid = tid_, lane = lane_, wave = wave0, G = G_, bid = bid_;
        const int gw = bid * NWAVES + wave, NGW = G * NWAVES;
        Ptrs P; P = Ptrs{kp->in[0], kp->in[1], kp->in[2], kp->in[3], kp->in[4], kp->in[5], kp->in[6], kp->in[7], kp->in[8], kp->in[9], kp->in[10], kp->in[11], kp->in[12], kp->in[13], kp->in[14], kp->in[15], kp->in[16], kp->in[17], kp->in[18], kp->in[19], kp->in[20]};
        unsigned char* ws = kp->ws; float* outp = kp->out;
        float* mod = (float*)(ws + WS_MOD); bf16* Wt = (bf16*)(ws + WS_W); bf16* X = (bf16*)(ws + WS_X); bf16* H = (bf16*)(ws + WS_H);
        bf16* R = (bf16*)(ws + WS_R); bf16* Qb = R; bf16* Kb = R + (size_t)M * D; bf16* Vb = R + (size_t)2 * M * D; bf16* Ob = R + (size_t)3 * M * D;
        bf16* Ub = R; bf16* Vc = R + (size_t)M * D; bf16* Fb = R;
        const bf16* CK = (const bf16*)(ws + WS_CK); const bf16* CV = (const bf16*)(ws + WS_CV);
        float* out_y = outp; float* out_ck = outp + (size_t)M * D; float* out_cv = out_ck + (size_t)32 * 2 * 256 * 1024;
        float* SS = (float*)(ws + WS_SS); float* SHW = (float*)(ws + WS_SHW);
        if (ph == 0) { p0_phase(P, ws, lds, tid, lane, wave, G, bid); }
        else if (ph == 1) { prep_phase(P.x_prompt, P.x_sample, H, SS, P.norm_g, mod + 1 * 1024, mod, Wt, SHW, gw, NGW, lane); }
        else if (ph == NPH - 1) { final_norm_phase(X, out_y, P.final_g, gw, NGW, lane); }
        else if (ph >= 60) { }
        else {
            const int l = (ph - 2) / 5, s = (ph - 2) % 5, i = l >> 1; const bool conv = (l & 1) != 0;
            const float* modl = mod + (size_t)l * 5 * 6144;
            if (s == 0) {
                const float* ssl = SS + (size_t)(2 * l) * M; const float* shl = SHW + (size_t)((2 * l) * 5) * 4096;
                if (!conv) { pg8::Gemm gm{H, Wt + W_QKV + (size_t)i * 3 * MEL, M, 3 * D, D}; pg8::StaticOrder S; S.init(M, 3 * D, G, bid);
                    pg8::EpiQKV E{ssl, shl, Qb, (size_t)M * D, out_ck + (size_t)i * 256 * 1024, (size_t)32 * 2 * 256 * 1024};
                    pg8::gemm_phase<pg8::EpiQKV, pg8::StaticOrder, true, true>(lds, gm, S, E, tid); }
                else { pg8::Gemm gm{H, Wt + W_PW1 + (size_t)i * 2 * MEL, M, 2 * D, D}; pg8::StaticOrder S; S.init(M, 2 * D, G, bid);
                    pg8::EpiGLU E{ssl, shl, Ub};
                    pg8::gemm_phase<pg8::EpiGLU, pg8::StaticOrder, true, true>(lds, gm, S, E, tid); }
            } else if (s == 1) {
                if (!conv) attn_phase(Qb, Kb, Vb, Ob, CK, CV, P.rpb + (size_t)i * 16 * 15 * 31, i, lds, tid, lane, wave, G, bid, amode == 2 ? 512 : 0, amode == 1 ? 512 : 1024);
                else conv_phase(Ub, Vc, P.w_dw + (size_t)i * 31 * D, P.b_dw + i * D, P.ln_g + i * D, P.ln_b + i * D, lds, tid, lane, wave, G, bid);
            } else if (s == 2 || s == 4) {
                pg8::Gemm gm; pg8::EpiRes E;
                if (s == 2) { gm = pg8::Gemm{conv ? Vc : Ob, Wt + (conv ? W_PW2 : W_O) + (size_t)i * MEL, M, D, D};
                    E = pg8::EpiRes{P.x_prompt, P.x_sample, l == 0 ? (const bf16*)nullptr : X, X, modl + 2 * 1024, H, P.norm_g + (l * 2 + 1) * D, modl + 4 * 1024, SS + (size_t)(2 * l + 1) * M}; }
                else { gm = pg8::Gemm{Fb, Wt + W_DOWN + (size_t)l * 4 * MEL, M, D, FF};
                    E = pg8::EpiRes{P.x_prompt, P.x_sample, X, X, modl + 5 * 1024, l < NL - 1 ? H : nullptr, P.norm_g + ((l + 1) * 2) * D, modl + 5 * 6144 + 1 * 1024, SS + (size_t)(2 * l + 2) * M}; }
                pg8::StaticOrder S; S.init(M, D, G, bid);
                pg8::gemm_phase<pg8::EpiRes, pg8::StaticOrder, true, true>(lds, gm, S, E, tid);
            } else {
                pg8::Gemm gm{H, Wt + W_UP + (size_t)l * 4 * MEL, M, FF, D}; pg8::StaticOrder S; S.init(M, FF, G, bid);
                pg8::EpiUp E{SS + (size_t)(2 * l + 1) * M, SHW + (size_t)((2 * l + 1) * 5) * 4096, Fb, FF};
                pg8::gemm_phase<pg8::EpiUp, pg8::StaticOrder, true, true>(lds, gm, S, E, tid);
            }
        }
        if (pc + 1 < nprog) { if (pc == 0) { grid.sync(); xbar = xcd_barrier_post(xbar.bar, xbar.st); } else xcd_barrier(xbar); }
    }
}

#ifndef SINGLE_LAUNCH
#define SINGLE_LAUNCH 0
#endif
extern "C" void kernel_launch(void* const* d_in, const int* in_sizes, int n_in, void* d_out, int out_size, void* d_ws, size_t ws_size, hipStream_t stream) {
    static int grid = 0;
    if (grid == 0) {
        if (n_in != 21 || ws_size < WS_END) { fprintf(stderr, "kernel_launch: unexpected n_in %d / ws_size %zu\n", n_in, ws_size); grid = -1; return; }
        int dev = 0, cus = 0, per_cu = 0;
        hipGetDevice(&dev); hipDeviceGetAttribute(&cus, hipDeviceAttributeMultiprocessorCount, dev);
        hipFuncSetAttribute((const void*)fwd_kernel, hipFuncAttributeMaxDynamicSharedMemorySize, LDS_BYTES);
        hipOccupancyMaxActiveBlocksPerMultiprocessor(&per_cu, (const void*)fwd_kernel, NTHR, LDS_BYTES);
        if (per_cu < 1) { fprintf(stderr, "kernel_launch: occupancy query says %d blocks/CU\n", per_cu); per_cu = 1; }
        (void)hipGetLastError();
        grid = cus * per_cu;
    }
    if (grid < 0) return;
    Args a{};
    for (int i = 0; i < 21; ++i) a.in[i] = (const float*)d_in[i];
    a.out = (float*)d_out; a.ws = (unsigned char*)d_ws;
#if SINGLE_LAUNCH
    { int n = 0;
      for (int ph = 0; ph < NPH; ++ph) { a.prog[n++] = ph;
#ifdef PROBE_ATTN_MODE
          if (ph >= 2 && ph < NPH - 1 && (ph - 2) % 5 == 1 && ((ph - 2) / 5) % 2 == 0) a.prog[n++] = ph | (PROBE_ATTN_MODE << 6);
#endif
#ifdef PROBE_EMPTY
          if (ph == 5) for (int q = 0; q < PROBE_EMPTY; ++q) a.prog[n++] = 60;
#endif
#ifdef PROBE_REPEAT_P0
          if (ph == 0) a.prog[n++] = 0;
#endif
#ifdef PROBE_REPEAT_S
          if (ph >= 2 && ph < NPH - 1 && (ph - 2) % 5 == PROBE_REPEAT_S && (PROBE_REPEAT_PAR < 0 || ((ph - 2) / 5) % 2 == PROBE_REPEAT_PAR)) a.prog[n++] = ph;
#endif
      }
      a.nprog = n; }
    void* args[] = {&a};
    hipError_t e = hipLaunchCooperativeKernel((const void*)fwd_kernel, dim3(grid), dim3(NTHR), args, LDS_BYTES, stream);
    if (e != hipSuccess) fprintf(stderr, "cooperative launch failed: %s (grid %d)\n", hipGetErrorString(e), grid);
#else
    for (int ph = 0; ph < NPH; ++ph) { a.nprog = 1; a.prog[0] = ph; hipLaunchKernelGGL(fwd_kernel, dim3(grid), dim3(NTHR), LDS_BYTES, stream, a); }
#endif
}
```

```cpp
#define SINGLE_LAUNCH 1
#include <hip/hip_runtime.h>
#include <hip/hip_cooperative_groups.h>
#include <cstdio>
#include <cstdint>
#include <cmath>
#include <utility>
namespace cg = cooperative_groups;
namespace pg8 {
#define PG8_LAS __attribute__((address_space(3)))
typedef unsigned short bf16_t;
typedef short bf16x8 __attribute__((ext_vector_type(8)));
typedef float f32x4 __attribute__((ext_vector_type(4)));
typedef unsigned u32x4 __attribute__((ext_vector_type(4)));
constexpr int RM = 192;
constexpr int BM = 256, BK = 64, HALF = 128, HTB = HALF * BK * 2  , STAGE_BYTES = 8 * HTB, NXCD = 8, WGM = 8;

__host__ __device__ __forceinline__ int lds_byte(int r, int c) { const int st = (r >> 4) * 2 + (c >> 5), rr = r & 15, cc = c & 31, ob = rr * 64 + cc * 2; return st * 1024 + (ob ^ (((ob >> 9) & 1) << 5)); }
__host__ __device__ __forceinline__ void stage_rc(int b, int& R, int& C) { const int st = b / 1024, sb = b % 1024, swz = sb ^ (((sb >> 9) & 1) << 5); R = (st >> 1) * 16 + swz / 64; C = (st & 1) * 32 + (swz % 64) / 2; }
__host__ __device__ __forceinline__ int perm32(int rho) { const int n = rho >> 4, i = rho & 15; return 8 * (i >> 2) + 4 * n + (i & 3); }

struct Unit { int pm, pn; };
struct Gemm { const bf16_t* A; const bf16_t* Bt; int M, N, K; };

struct StaticOrder {
    int nM, nN, nwg, G, c;
    __host__ __device__ void init(int M, int N, int G_, int c_) { nM = M / RM; nN = N / BM; nwg = nM * nN; G = G_; c = c_; }
    __host__ __device__ bool next(int i, Unit& u) const {
        const long L = (long)i * G + c; if (L >= nwg) return false;
        int wgid = (int)L; { const int q = nwg / NXCD, r = nwg % NXCD, xcd = wgid % NXCD, off = wgid / NXCD; wgid = (xcd < r ? xcd * (q + 1) : r * (q + 1) + (xcd - r) * q) + off; }
        const int nig = WGM * nN, gid = wgid / nig, fm = gid * WGM, gsz = (nM - fm) < WGM ? (nM - fm) : WGM;
        u.pm = fm + ((wgid % nig) % gsz); u.pn = (wgid % nig) / gsz; return true;
    }
    __device__ __forceinline__ void a_ready(const Unit&) const {}
    __device__ __forceinline__ void done(const Unit&) const {}
};

__device__ __forceinline__ unsigned cvt_pk_bf16(float lo, float hi) { unsigned r; asm volatile("v_cvt_pk_bf16_f32 %0, %1, %2" : "=v"(r) : "v"(lo), "v"(hi)); return r; }
typedef float f32x2 __attribute__((ext_vector_type(2)));
__device__ __forceinline__ int cond_of_row(int r) { return r < 8192 ? 0 : 1 + ((r - 8192) >> 10); }
__device__ __forceinline__ int half_row0(int ai, int wr) { return ai == 0 ? wr * 64 : 128 + wr * 32; }
#define EPI_MLOOP(ai, m) _Pragma("unroll") for (int m = 0; m < 4; ++m) if (ai == 0 || m < 2)
struct EpiQKV {
    static constexpr bool PERM = true, AFTER_DRAIN = false;
    const float* ss; const float* shw;
    bf16_t* Q; size_t qkv_stride; float* ck; size_t ckv_stride;
    __device__ __forceinline__ void operator()(const f32x4 (&acc)[2][2][4][2], const Unit& u, int wr, int wc, int fr, int fq) const {
        const int t = u.pn >> 2;
        bf16_t* base = Q + (size_t)t * qkv_stride;
        const int col0 = (u.pn & 3) * BM + wc * 32 + 8 * fq;
        float* cbase = ck + (size_t)(t > 0 ? t - 1 : 0) * ckv_stride + col0;
#pragma unroll
        for (int ai = 0; ai < 2; ++ai) { const int rbase = u.pm * RM + half_row0(ai, wr) + fr; const bool wc_ = (t > 0) && (rbase < 8192);
            const float* sp = shw + cond_of_row(rbase) * 4096 + u.pn * BM + wc * 32 + 8 * fq;
            f32x4 sv[2][2];
#pragma unroll
            for (int bj = 0; bj < 2; ++bj) { sv[bj][0] = *(const f32x4*)(sp + bj * HALF); sv[bj][1] = *(const f32x4*)(sp + bj * HALF + 4); }
            float rr[4];
            EPI_MLOOP(ai, m) rr[m] = ss[rbase + m * 16];
            EPI_MLOOP(ai, m) { const int row = rbase + m * 16; bf16_t* rowp = base + (size_t)row * 1024 + col0;
                const float r = __builtin_amdgcn_rsqf(rr[m] * (1.f / 1024.f) + 1e-6f);
                float* cp0 = cbase + ((size_t)(row >> 8) * 2 * 256 + (row & 255)) * 1024;
#pragma unroll
                for (int bj = 0; bj < 2; ++bj) { const f32x4 v0 = acc[ai][bj][m][0] * r + sv[bj][0], v1 = acc[ai][bj][m][1] * r + sv[bj][1];
                    u32x4 w; w.x = cvt_pk_bf16(v0[0], v0[1]); w.y = cvt_pk_bf16(v0[2], v0[3]); w.z = cvt_pk_bf16(v1[0], v1[1]); w.w = cvt_pk_bf16(v1[2], v1[3]);
                    *(u32x4*)(rowp + bj * HALF) = w;
                    if (wc_) { float* cp = cp0 + bj * HALF; __builtin_nontemporal_store(v0, (f32x4*)cp); __builtin_nontemporal_store(v1, (f32x4*)(cp + 4)); } } } }
    }
};
struct EpiUp {
    static constexpr bool PERM = true, AFTER_DRAIN = false;
    const float* ss; const float* shw; bf16_t* O; int ldc;
    __device__ __forceinline__ void operator()(const f32x4 (&acc)[2][2][4][2], const Unit& u, int wr, int wc, int fr, int fq) const {
        const int col0 = u.pn * BM + wc * 32 + 8 * fq;
#pragma unroll
        for (int ai = 0; ai < 2; ++ai) { const int rbase = u.pm * RM + half_row0(ai, wr) + fr;
            const float* sp = shw + cond_of_row(rbase) * 4096 + col0;
            f32x4 sv[2][2];
#pragma unroll
            for (int bj = 0; bj < 2; ++bj) { sv[bj][0] = *(const f32x4*)(sp + bj * HALF); sv[bj][1] = *(const f32x4*)(sp + bj * HALF + 4); }
            float rr[4];
            EPI_MLOOP(ai, m) rr[m] = ss[rbase + m * 16];
            EPI_MLOOP(ai, m) { bf16_t* rowp = O + (size_t)(rbase + m * 16) * ldc + col0;
                const float r = __builtin_amdgcn_rsqf(rr[m] * (1.f / 1024.f) + 1e-6f);
#pragma unroll
                for (int bj = 0; bj < 2; ++bj) { f32x4 v0 = acc[ai][bj][m][0] * r + sv[bj][0], v1 = acc[ai][bj][m][1] * r + sv[bj][1];
#pragma unroll
                    for (int e = 0; e < 4; ++e) { const float a = fmaxf(v0[e], 0.f), b = fmaxf(v1[e], 0.f); v0[e] = a * a; v1[e] = b * b; }
                    u32x4 w; w.x = cvt_pk_bf16(v0[0], v0[1]); w.y = cvt_pk_bf16(v0[2], v0[3]); w.z = cvt_pk_bf16(v1[0], v1[1]); w.w = cvt_pk_bf16(v1[2], v1[3]);
                    *(u32x4*)(rowp + bj * HALF) = w; } } }
    }
};
struct EpiGLU {
    static constexpr bool PERM = true, AFTER_DRAIN = false;
    const float* ss; const float* shw; bf16_t* O;
    __device__ __forceinline__ void operator()(const f32x4 (&acc)[2][2][4][2], const Unit& u, int wr, int wc, int fr, int fq) const {
        const int col0 = u.pn * HALF + wc * 32 + 8 * fq;
#pragma unroll
        for (int ai = 0; ai < 2; ++ai) { const int rbase = u.pm * RM + half_row0(ai, wr) + fr;
            const float* sp = shw + cond_of_row(rbase) * 4096 + u.pn * BM + wc * 32 + 8 * fq;
            f32x4 sv[2][2];
#pragma unroll
            for (int bj = 0; bj < 2; ++bj) { sv[bj][0] = *(const f32x4*)(sp + bj * HALF); sv[bj][1] = *(const f32x4*)(sp + bj * HALF + 4); }
            float rr[4];
            EPI_MLOOP(ai, m) rr[m] = ss[rbase + m * 16];
            EPI_MLOOP(ai, m) { bf16_t* rowp = O + (size_t)(rbase + m * 16) * 1024 + col0;
                const float r = __builtin_amdgcn_rsqf(rr[m] * (1.f / 1024.f) + 1e-6f);
                f32x4 v0 = acc[ai][0][m][0] * r + sv[0][0], v1 = acc[ai][0][m][1] * r + sv[0][1]; const f32x4 g0 = acc[ai][1][m][0] * r + sv[1][0], g1 = acc[ai][1][m][1] * r + sv[1][1];
#pragma unroll
                for (int e = 0; e < 4; ++e) { v0[e] = v0[e] * __builtin_amdgcn_rcpf(1.f + __expf(-g0[e])); v1[e] = v1[e] * __builtin_amdgcn_rcpf(1.f + __expf(-g1[e])); }
                u32x4 w; w.x = cvt_pk_bf16(v0[0], v0[1]); w.y = cvt_pk_bf16(v0[2], v0[3]); w.z = cvt_pk_bf16(v1[0], v1[1]); w.w = cvt_pk_bf16(v1[2], v1[3]);
                *(u32x4*)rowp = w; } }
    }
};
struct EpiRes {
    static constexpr bool PERM = false, AFTER_DRAIN = false;
    const float* base_p; const float* base_s; const bf16_t* base_b; bf16_t* out; const float* gate;
    bf16_t* xb; const float* g_next; const float* sc_next; float* ss_next;
    __device__ __forceinline__ void operator()(const f32x4 (&acc)[2][2][4][2], const Unit& u, int wr, int wc, int fr, int fq) const {
        typedef unsigned u32x2e __attribute__((ext_vector_type(2)));
        const int col0 = u.pn * BM + wc * 32 + 4 * fq;
        const int lane_x = fq * 16 + fr;
#pragma unroll
        for (int ai = 0; ai < 2; ++ai) { const int row0 = u.pm * RM + half_row0(ai, wr) + fr; const int cond = cond_of_row(row0);
            const float* gp = gate + cond * 6144 + col0;
            const float* bp = (row0 < 8192) ? base_p + (size_t)row0 * 1024 + col0 : base_s + (size_t)(row0 - 8192) * 1024 + col0;
            const bf16_t* bb = base_b + (size_t)row0 * 1024 + col0;
            bf16_t* op = out + (size_t)row0 * 1024 + col0;
            f32x4 gv[2][2], gs[2][2];
#pragma unroll
            for (int bj = 0; bj < 2; ++bj)
#pragma unroll
                for (int n = 0; n < 2; ++n) gv[bj][n] = *(const f32x4*)(gp + bj * HALF + n * 16);
            if (xb) { f32x4 ga[2][2], sa[2][2];
#pragma unroll
                for (int bj = 0; bj < 2; ++bj)
#pragma unroll
                    for (int n = 0; n < 2; ++n) { ga[bj][n] = *(const f32x4*)(g_next + col0 + bj * HALF + n * 16); sa[bj][n] = *(const f32x4*)(sc_next + cond * 6144 + col0 + bj * HALF + n * 16); }
#pragma unroll
                for (int bj = 0; bj < 2; ++bj)
#pragma unroll
                    for (int n = 0; n < 2; ++n) gs[bj][n] = ga[bj][n] * (1.f + sa[bj][n]); }
#pragma unroll
            for (int mp = 0; mp < 2; ++mp) if (ai == 0 || mp == 0) { f32x4 bs[2][2][2];
                if (base_b) {
#pragma unroll
                    for (int mm = 0; mm < 2; ++mm)
#pragma unroll
                        for (int bj = 0; bj < 2; ++bj)
#pragma unroll
                            for (int n = 0; n < 2; ++n) { const u32x2e w = *(const u32x2e*)(bb + (size_t)((2 * mp + mm) * 16) * 1024 + bj * HALF + n * 16);
                                bs[mm][bj][n] = (f32x4){__builtin_bit_cast(float, w.x << 16), __builtin_bit_cast(float, w.x & 0xffff0000u), __builtin_bit_cast(float, w.y << 16), __builtin_bit_cast(float, w.y & 0xffff0000u)}; }
                } else {
#pragma unroll
                    for (int mm = 0; mm < 2; ++mm)
#pragma unroll
                        for (int bj = 0; bj < 2; ++bj)
#pragma unroll
                            for (int n = 0; n < 2; ++n) bs[mm][bj][n] = *(const f32x4*)(bp + (size_t)((2 * mp + mm) * 16) * 1024 + bj * HALF + n * 16);
                }
#pragma unroll
                for (int mm = 0; mm < 2; ++mm) { float sq = 0.f;
#pragma unroll
                    for (int bj = 0; bj < 2; ++bj)
#pragma unroll
                        for (int n = 0; n < 2; ++n) { const f32x4 xn = bs[mm][bj][n] + gv[bj][n] * acc[ai][bj][2 * mp + mm][n];
                            { u32x2e w; w.x = cvt_pk_bf16(xn[0], xn[1]); w.y = cvt_pk_bf16(xn[2], xn[3]); *(u32x2e*)(op + (size_t)((2 * mp + mm) * 16) * 1024 + bj * HALF + n * 16) = w; }
                            if (xb) { const f32x4 hb = xn * gs[bj][n]; u32x2e w; w.x = cvt_pk_bf16(hb[0], hb[1]); w.y = cvt_pk_bf16(hb[2], hb[3]);
                                *(u32x2e*)(xb + (size_t)(row0 + (2 * mp + mm) * 16) * 1024 + col0 + bj * HALF + n * 16) = w;
                                sq += (xn[0] * xn[0] + xn[1] * xn[1]) + (xn[2] * xn[2] + xn[3] * xn[3]); } }
                    if (xb) {
                        sq += __builtin_bit_cast(float, __builtin_amdgcn_ds_bpermute((lane_x ^ 16) << 2, __builtin_bit_cast(int, sq)));
                        sq += __builtin_bit_cast(float, __builtin_amdgcn_ds_bpermute((lane_x ^ 32) << 2, __builtin_bit_cast(int, sq)));
                        if (fq == 0) atomicAdd(ss_next + row0 + (2 * mp + mm) * 16, sq); } }
                asm volatile("" ::: "memory"); } }
    }
};
template <class Epi, class Sched, bool ALIGN_EPI = false, bool SP2 = false>
__device__ __forceinline__ void gemm_phase(PG8_LAS unsigned char* lds, const Gemm g, const Sched& S, const Epi& E, const int tid) {
    static_assert(SP2, "the 192-row tile form exists for the SP2 loop only");
    const int wid = __builtin_amdgcn_readfirstlane(tid >> 6), lane = tid & 63, wr = wid >> 2, wc = wid & 3, fr = lane & 15, fq = lane >> 4;
    const int K = g.K, nt = K / BK;
    unsigned voffA[2], voffB[2];
#pragma unroll
    for (int i = 0; i < 2; ++i) { int R, C; stage_rc(tid * 16 + i * 8192, R, C); const int Rb = Epi::PERM ? ((R & ~31) + perm32(R & 31)) : R;
        voffA[i] = (unsigned)(R * K + C) * 2u; voffB[i] = (unsigned)(Rb * K + C) * 2u; }
    const size_t kstep = (size_t)(BK * 2);
    const size_t hstep = (size_t)HALF * K * 2;
    const size_t tstepA = (size_t)RM * K * 2;
    const size_t tstep = 2 * hstep;
    const unsigned ldsw = (unsigned)wid * 1024u;
    const int aoff = lds_byte(wr * 64 + fr, fq * 8), boff = lds_byte(wc * 32 + fr, fq * 8);
#define PG8_SA(b, h) (((b) * 2 + (h)) * HTB)
#define PG8_SB(b, h) ((4 + (b) * 2 + (h)) * HTB)
#define PG8_STAGE(bufoff, gbase, voff) do { _Pragma("unroll") for (int _i = 0; _i < 2; ++_i) \
        __builtin_amdgcn_global_load_lds((const unsigned*)((const char*)(gbase) + (voff)[_i]), (PG8_LAS unsigned*)(lds + (bufoff) + ldsw + _i * 8192), 16, 0, 0); } while (0)
#define PG8_LDA(dst, b, h) do { _Pragma("unroll") for (int m = 0; m < 4; ++m) _Pragma("unroll") for (int k = 0; k < 2; ++k) dst[m][k] = *(const PG8_LAS bf16x8*)(lds + PG8_SA(b, h) + aoff + m * 2048 + k * 1024); } while (0)
#define PG8_LDB(dst, b, h) do { _Pragma("unroll") for (int n = 0; n < 2; ++n) _Pragma("unroll") for (int k = 0; k < 2; ++k) dst[n][k] = *(const PG8_LAS bf16x8*)(lds + PG8_SB(b, h) + boff + n * 2048 + k * 1024); } while (0)
#define PG8_MMA(ai, bj, At, Bt) do { __builtin_amdgcn_s_setprio(1); _Pragma("unroll") for (int m = 0; m < 4; ++m) _Pragma("unroll") for (int n = 0; n < 2; ++n) _Pragma("unroll") for (int k = 0; k < 2; ++k) \
        acc[ai][bj][m][n] = __builtin_amdgcn_mfma_f32_16x16x32_bf16(Bt[n][k], At[m][k], acc[ai][bj][m][n], 0, 0, 0); __builtin_amdgcn_s_setprio(0); } while (0)
    const int aoff1 = lds_byte(wr * 32 + fr, fq * 8);
#define PG8_STAGE1(bufoff, gbase, voff) __builtin_amdgcn_global_load_lds((const unsigned*)((const char*)(gbase) + (voff)[0]), (PG8_LAS unsigned*)(lds + (bufoff) + ldsw), 16, 0, 0)
#define PG8_LDA1(dst, b) do { _Pragma("unroll") for (int m = 0; m < 2; ++m) _Pragma("unroll") for (int k = 0; k < 2; ++k) dst[m][k] = *(const PG8_LAS bf16x8*)(lds + PG8_SA(b, 1) + aoff1 + m * 2048 + k * 1024); } while (0)
#define PG8_MMA1(bj, At, Bt) do { __builtin_amdgcn_s_setprio(1); _Pragma("unroll") for (int m = 0; m < 2; ++m) _Pragma("unroll") for (int n = 0; n < 2; ++n) _Pragma("unroll") for (int k = 0; k < 2; ++k) \
        acc[1][bj][m][n] = __builtin_amdgcn_mfma_f32_16x16x32_bf16(Bt[n][k], At[m][k], acc[1][bj][m][n], 0, 0, 0); __builtin_amdgcn_s_setprio(0); } while (0)
#define PG8_WAIT_V(n) asm volatile("s_waitcnt vmcnt(" #n ")" ::: "memory")
#define PG8_WAIT_L(n) asm volatile("s_waitcnt lgkmcnt(" #n ")" ::: "memory")
#define PG8_BAR __builtin_amdgcn_s_barrier()
#define PG8_SCHED __builtin_amdgcn_sched_barrier(0)
    Unit cur, nxt; int ui = 0;
    if (!S.next(0, cur)) return;
    f32x4 acc[2][2][4][2];
#pragma unroll
    for (int a = 0; a < 2; ++a)
#pragma unroll
        for (int b = 0; b < 2; ++b)
#pragma unroll
            for (int m = 0; m < 4; ++m)
#pragma unroll
                for (int n = 0; n < 2; ++n) acc[a][b][m][n] = (f32x4){0.f, 0.f, 0.f, 0.f};
    bf16x8 At[4][2], B0[2][2], B1[2][2];
    const char* cA = (const char*)g.A + (size_t)cur.pm * tstepA; const char* cB = (const char*)g.Bt + (size_t)cur.pn * tstep;
    S.a_ready(cur);
    if constexpr (SP2) {
        PG8_STAGE(PG8_SB(0, 0), cB, voffB); PG8_STAGE(PG8_SB(0, 1), cB + hstep, voffB); PG8_STAGE(PG8_SA(0, 0), cA, voffA); PG8_STAGE1(PG8_SA(0, 1), cA + hstep, voffA);
        if (wr == 1) PG8_BAR;
        PG8_WAIT_V(1); PG8_BAR;
        PG8_STAGE(PG8_SB(1, 0), cB + kstep, voffB); PG8_STAGE(PG8_SA(1, 0), cA + kstep, voffA); PG8_STAGE(PG8_SB(1, 1), cB + hstep + kstep, voffB);
        PG8_WAIT_V(6); PG8_BAR;
    } else {
        PG8_STAGE(PG8_SB(0, 0), cB, voffB); PG8_STAGE(PG8_SA(0, 0), cA, voffA); PG8_STAGE(PG8_SB(0, 1), cB + hstep, voffB); PG8_STAGE(PG8_SA(0, 1), cA + hstep, voffA);
        if (wr == 1) PG8_BAR;
        PG8_WAIT_V(4); PG8_BAR;
        PG8_STAGE(PG8_SB(1, 0), cB + kstep, voffB); PG8_STAGE(PG8_SA(1, 0), cA + kstep, voffA); PG8_STAGE(PG8_SB(1, 1), cB + hstep + kstep, voffB);
        PG8_WAIT_V(6); PG8_BAR;
    }
    for (;;) {
        const bool has_next = S.next(ui + 1, nxt);
        const char* nA = has_next ? (const char*)g.A + (size_t)nxt.pm * tstepA : cA; const char* nB = has_next ? (const char*)g.Bt + (size_t)nxt.pn * tstep : cB;
        for (int t = 0; t < nt; t += 2) {
            const bool last = (t == nt - 2);
            const char* a1 = cA + (size_t)(t + 1) * kstep;
            const char* a2 = last ? nA : cA + (size_t)(t + 2) * kstep; const char* b2 = last ? nB : cB + (size_t)(t + 2) * kstep;
            const char* a3 = a2 + kstep; const char* b3 = b2 + kstep;
            if (last && has_next) S.a_ready(nxt);
            if constexpr (SP2) {
            PG8_LDB(B0, 0, 0); PG8_LDB(B1, 0, 1); PG8_SCHED; PG8_LDA(At, 0, 0); PG8_STAGE1(PG8_SA(1, 1), a1 + hstep, voffA);
            PG8_WAIT_V(7); PG8_WAIT_L(0); PG8_BAR; PG8_MMA(0, 0, At, B0); PG8_MMA(0, 1, At, B1); PG8_BAR; PG8_SCHED;
            PG8_LDA1(At, 0); PG8_STAGE(PG8_SB(0, 0), b2, voffB); PG8_STAGE(PG8_SB(0, 1), b2 + hstep, voffB); PG8_STAGE(PG8_SA(0, 0), a2, voffA);
            PG8_WAIT_V(7); PG8_WAIT_L(0); PG8_BAR; PG8_MMA1(0, At, B0); PG8_MMA1(1, At, B1); PG8_BAR; PG8_SCHED;
            PG8_LDB(B0, 1, 0); PG8_LDB(B1, 1, 1); PG8_SCHED; PG8_LDA(At, 1, 0); PG8_STAGE1(PG8_SA(0, 1), a2 + hstep, voffA);
            PG8_WAIT_V(7); PG8_WAIT_L(0); PG8_BAR; PG8_MMA(0, 0, At, B0); PG8_MMA(0, 1, At, B1); PG8_BAR; PG8_SCHED;
            PG8_LDA1(At, 1); PG8_STAGE(PG8_SB(1, 0), b3, voffB); PG8_STAGE(PG8_SB(1, 1), b3 + hstep, voffB); PG8_STAGE(PG8_SA(1, 0), a3, voffA);
            PG8_WAIT_V(7); PG8_WAIT_L(0); PG8_BAR; PG8_MMA1(0, At, B0); PG8_MMA1(1, At, B1); PG8_BAR; PG8_SCHED;
            } else {
            PG8_LDB(B0, 0, 0); PG8_SCHED; PG8_LDA(At, 0, 0); PG8_STAGE(PG8_SA(1, 1), a1 + hstep, voffA);
            PG8_WAIT_L(8); PG8_BAR; PG8_WAIT_L(0); PG8_MMA(0, 0, At, B0); PG8_BAR; PG8_SCHED;
            PG8_LDB(B1, 0, 1); PG8_STAGE(PG8_SB(0, 0), b2, voffB);
            PG8_BAR; PG8_WAIT_L(0); PG8_MMA(0, 1, At, B1); PG8_BAR;
            PG8_LDA(At, 0, 1); PG8_STAGE(PG8_SA(0, 0), a2, voffA);
            PG8_BAR; PG8_WAIT_L(0); PG8_MMA(1, 0, At, B0); PG8_BAR; PG8_SCHED;
            PG8_STAGE(PG8_SB(0, 1), b2 + hstep, voffB);
            PG8_WAIT_V(6); PG8_BAR; PG8_MMA(1, 1, At, B1); PG8_BAR;
            PG8_LDB(B0, 1, 0); PG8_SCHED; PG8_LDA(At, 1, 0); PG8_STAGE(PG8_SA(0, 1), a2 + hstep, voffA);
            PG8_WAIT_L(8); PG8_BAR; PG8_WAIT_L(0); PG8_MMA(0, 0, At, B0); PG8_BAR; PG8_SCHED;
            PG8_LDB(B1, 1, 1); PG8_STAGE(PG8_SB(1, 0), b3, voffB);
            PG8_BAR; PG8_WAIT_L(0); PG8_MMA(0, 1, At, B1); PG8_BAR;
            PG8_LDA(At, 1, 1); PG8_STAGE(PG8_SA(1, 0), a3, voffA);
            PG8_BAR; PG8_WAIT_L(0); PG8_MMA(1, 0, At, B0); PG8_BAR; PG8_SCHED;
            PG8_STAGE(PG8_SB(1, 1), b3 + hstep, voffB);
            PG8_WAIT_V(6); PG8_BAR; PG8_MMA(1, 1, At, B1); PG8_BAR;
            }
        }
        if constexpr (ALIGN_EPI) { if (wr == 0) PG8_BAR; }
        if constexpr (!Epi::AFTER_DRAIN) { E(acc, cur, wr, wc, fr, fq); S.done(cur); }
        if (!has_next) break;
#pragma unroll
        for (int a = 0; a < 2; ++a)
#pragma unroll
            for (int b = 0; b < 2; ++b)
#pragma unroll
                for (int m = 0; m < 4; ++m)
#pragma unroll
                    for (int n = 0; n < 2; ++n) acc[a][b][m][n] = (f32x4){0.f, 0.f, 0.f, 0.f};
        cur = nxt; cA = nA; cB = nB; ++ui;
        if constexpr (ALIGN_EPI) { if (wr == 1) PG8_BAR; }
    }
    PG8_WAIT_V(0);
    if constexpr (!ALIGN_EPI) { if (wr == 0) PG8_BAR; }
    PG8_BAR;
    if constexpr (Epi::AFTER_DRAIN) { E.fused(acc, cur, wr, wc, fr, fq, lds, wid, lane); S.done(cur); }
#undef PG8_SA
#undef PG8_SB
#undef PG8_STAGE
#undef PG8_LDA
#undef PG8_LDB
#undef PG8_MMA
#undef PG8_STAGE1
#undef PG8_LDA1
#undef PG8_MMA1
#undef PG8_WAIT_V
#undef PG8_WAIT_L
#undef PG8_BAR
#undef PG8_SCHED
}
}
constexpr int D = 1024, MP = 8192, MS = 4096, M = MP + MS, FF = 4096, NL = 4;
constexpr int NWAVES = 8, NTHR = 512;
constexpr size_t MiB = 1u << 20;
constexpr size_t WS_MOD = 1 * MiB;
constexpr size_t WS_W = 2 * MiB;
constexpr size_t WS_X = 94 * MiB;
constexpr size_t WS_H = 142 * MiB;
constexpr size_t WS_R = 166 * MiB;
constexpr size_t WS_CK = 262 * MiB, WS_CV = 266 * MiB, WS_SHW = 270 * MiB, WS_SS = 271 * MiB, WS_END = 272 * MiB;
constexpr size_t MEL = 1u << 20;
constexpr size_t W_QKV = 0, W_O = 6 * MEL, W_PW1 = 8 * MEL, W_PW2 = 12 * MEL, W_UP = 14 * MEL, W_DOWN = 30 * MEL;
constexpr int LDS_BYTES = 163840, LDS_ST = LDS_BYTES - 16, LDS_KC = 112640;

#define LAS __attribute__((address_space(3)))
#define SB0() __builtin_amdgcn_sched_barrier(0)
typedef unsigned short bf16;
typedef float f32x4 __attribute__((ext_vector_type(4)));
typedef float f32x2 __attribute__((ext_vector_type(2)));
typedef unsigned u32x4 __attribute__((ext_vector_type(4)));
typedef unsigned u32x2 __attribute__((ext_vector_type(2)));
typedef short bf16x8 __attribute__((ext_vector_type(8)));
typedef short s16x4 __attribute__((ext_vector_type(4)));
typedef float f32x32 __attribute__((ext_vector_type(32)));

__device__ __forceinline__ unsigned f2bf(float f) { unsigned u = __builtin_bit_cast(unsigned, f); return (u + 0x7fffu + ((u >> 16) & 1u)) >> 16; }
__device__ __forceinline__ unsigned pk2(float lo, float hi) { unsigned r; asm("v_cvt_pk_bf16_f32 %0, %1, %2" : "=v"(r) : "v"(lo), "v"(hi)); return r; }
__device__ __forceinline__ float bflo(unsigned w) { return __builtin_bit_cast(float, w << 16); }
__device__ __forceinline__ float bfhi(unsigned w) { return __builtin_bit_cast(float, w & 0xffff0000u); }
__device__ __forceinline__ float shx(float v, int k, int lane) { return __builtin_bit_cast(float, __builtin_amdgcn_ds_bpermute((lane ^ k) << 2, __builtin_bit_cast(int, v))); }
__device__ __forceinline__ float wave_sum(float v, int lane) {
#pragma unroll
    for (int o = 1; o < 64; o <<= 1) v += shx(v, o, lane);
    return v;
}

template <bool GLU>
__device__ __forceinline__ void transpose_item(const float* W, int K, int N, bf16* WT, LAS float* scr, int item, int lane) {
    const int nblk = N / 32, kb = item / nblk, nb = item % nblk, k0 = 64 * kb, n0 = 32 * nb;
    { float tv[32];
#pragma unroll
      for (int i = 0; i < 32; ++i) tv[i] = __builtin_nontemporal_load(W + (size_t)(k0 + 2 * i + (lane >> 5)) * N + n0 + (lane & 31));
      __builtin_amdgcn_sched_barrier(0);
#pragma unroll
      for (int i = 0; i < 32; ++i) scr[(2 * i + (lane >> 5)) * 33 + (lane & 31)] = tv[i]; }
    asm volatile("s_waitcnt lgkmcnt(0)" ::: "memory");
    int d0 = n0;
    if (GLU) { const int nn = n0 & 1023; d0 = ((nn >> 7) << 8) + (nn & 127) + ((n0 >> 10) << 7); }
    const int c = lane & 7;
#pragma unroll
    for (int j = 0; j < 4; ++j) { const int n = (lane >> 3) + 8 * j; const LAS float* s = scr + (8 * c) * 33 + n;
        u32x4 o; o.x = pk2(s[0 * 33], s[1 * 33]); o.y = pk2(s[2 * 33], s[3 * 33]); o.z = pk2(s[4 * 33], s[5 * 33]); o.w = pk2(s[6 * 33], s[7 * 33]);
        *(u32x4*)(WT + (size_t)(d0 + n) * K + k0 + 8 * c) = o; }
    asm volatile("s_waitcnt lgkmcnt(0)" ::: "memory");
}

struct Ptrs {
    const float *x_prompt, *x_sample, *cache_k, *cache_v, *c, *c_ctx, *norm_g, *w_ada, *b_ada, *w_qkv, *w_o, *rpb, *w_pw1, *w_dw, *b_dw, *ln_g, *ln_b, *w_pw2, *w_up, *w_down, *final_g;
};

__device__ __forceinline__ void p0_phase(const Ptrs& P, unsigned char* ws, LAS unsigned char* lds, int tid, int lane, int wave, int G, int bid) {
    bf16* Wt = (bf16*)(ws + WS_W);
    const int gw = bid * NWAVES + wave, NGW = G * NWAVES;
    LAS float* scr = (LAS float*)(lds + wave * 16384);
    constexpr int NIT = 23552;
    for (int it = gw; it < NIT; it += NGW) {
        if (it < 7168) { const int i = it / 3584; int r = it % 3584;
            if (r < 1536) { transpose_item<false>(P.w_qkv + (size_t)i * D * 3 * D, D, 3 * D, Wt + W_QKV + (size_t)i * 3 * MEL, scr, r, lane); continue; } r -= 1536;
            if (r < 512) { transpose_item<false>(P.w_o + (size_t)i * D * D, D, D, Wt + W_O + (size_t)i * MEL, scr, r, lane); continue; } r -= 512;
            if (r < 1024) { transpose_item<true>(P.w_pw1 + (size_t)i * D * 2 * D, D, 2 * D, Wt + W_PW1 + (size_t)i * 2 * MEL, scr, r, lane); continue; } r -= 1024;
            transpose_item<false>(P.w_pw2 + (size_t)i * D * D, D, D, Wt + W_PW2 + (size_t)i * MEL, scr, r, lane);
        } else { const int l = (it - 7168) / 4096; int r = (it - 7168) % 4096;
            if (r < 2048) transpose_item<false>(P.w_up + (size_t)l * D * FF, D, FF, Wt + W_UP + (size_t)l * 4 * MEL, scr, r, lane);
            else transpose_item<false>(P.w_down + (size_t)l * D * FF, FF, D, Wt + W_DOWN + (size_t)l * 4 * MEL, scr, r - 2048, lane);
        }
    }
    { bf16* CK = (bf16*)(ws + WS_CK); bf16* CV = (bf16*)(ws + WS_CV);
      const int NT = G * NTHR; constexpr int NV = 2 * 4 * 2 * 256 * 1024 / 8;
      for (int v = bid * NTHR + tid; v < NV; v += NT) { const int which = v >= NV / 2; const int e = (which ? v - NV / 2 : v) * 8;
          const float* src = (which ? P.cache_v : P.cache_k) + e; const f32x4 a = *(const f32x4*)src, b = *(const f32x4*)(src + 4);
          u32x4 o; o.x = pk2(a[0], a[1]); o.y = pk2(a[2], a[3]); o.z = pk2(b[0], b[1]); o.w = pk2(b[2], b[3]);
          *(u32x4*)((which ? CV : CK) + e) = o; } }
    { f32x4* z = (f32x4*)(ws + WS_SS); const int NT = G * NTHR; float zf = 0.f; asm volatile("" : "+v"(zf));
      const f32x4 zz = (f32x4){zf, zf, zf, zf}; for (int v = bid * NTHR + tid; v < 9 * M / 4; v += NT) z[v] = zz; }
    __syncthreads();
    { LAS float* sil = (LAS float*)lds; LAS float* red = (LAS float*)(lds + 20480); float* mod = (float*)(ws + WS_MOD);
      for (int k = tid; k < 5 * 1024; k += NTHR) { const int cc = k >> 10, kk = k & 1023; const float v = cc == 0 ? P.c_ctx[kk] : P.c[(cc - 1) * 1024 + kk]; sil[k] = v / (1.f + __expf(-v)); }
      __syncthreads();
      const int kg = tid >> 4, cl = tid & 15; const bool cact = cl < 12;
      for (int item = bid; item < 512; item += G) { const int l = item >> 7, n0 = (item & 127) * 48;
          const float* W = P.w_ada + (size_t)l * D * 6144 + n0 + 4 * cl;
          f32x4 a[5];
#pragma unroll
          for (int cc = 0; cc < 5; ++cc) a[cc] = (f32x4){0.f, 0.f, 0.f, 0.f};
#pragma unroll 4
          for (int kk = 0; kk < 32; ++kk) { const int k = kg * 32 + kk; f32x4 w = (f32x4){0.f, 0.f, 0.f, 0.f}; if (cact) w = __builtin_nontemporal_load((const f32x4*)(W + (size_t)k * 6144));
#pragma unroll
              for (int cc = 0; cc < 5; ++cc) a[cc] += sil[cc * 1024 + k] * w; }
#pragma unroll
          for (int cc = 0; cc < 5; ++cc) *(LAS f32x4*)(red + (kg * 5 + cc) * 64 + 4 * cl) = a[cc];
          __syncthreads();
          if (tid < 320 && (tid & 63) < 48) { const int cc = tid >> 6, n = tid & 63; float s = 0.f;
#pragma unroll 8
              for (int g = 0; g < 32; ++g) s += red[(g * 5 + cc) * 64 + n];
              mod[(size_t)(l * 5 + cc) * 6144 + n0 + n] = s + P.b_ada[l * 6144 + n0 + n]; }
          __syncthreads();
      } }
}

__device__ __forceinline__ void norm_phase(const float* xp, const float* xs, bf16* H, float* yout, const float* g, const float* shift, const float* scale, int gw, int NGW, int lane) {
    f32x4 gv[4];
#pragma unroll
    for (int j = 0; j < 4; ++j) gv[j] = *(const f32x4*)(g + 4 * (lane + 64 * j));
    for (int m = gw; m < M; m += NGW) {
        const float* xrow = m < MP ? xp + (size_t)m * D : xs + (size_t)(m - MP) * D;
        const int cond = m < MP ? 0 : 1 + ((m - MP) >> 10);
        f32x4 v[4]; float ss = 0.f;
#pragma unroll
        for (int j = 0; j < 4; ++j) { v[j] = *(const f32x4*)(xrow + 4 * (lane + 64 * j)); ss += (v[j][0] * v[j][0] + v[j][1] * v[j][1]) + (v[j][2] * v[j][2] + v[j][3] * v[j][3]); }
        const float r = 1.0f / sqrtf(wave_sum(ss, lane) * (1.f / D) + 1e-6f);
        if (yout) {
#pragma unroll
            for (int j = 0; j < 4; ++j) *(f32x4*)(yout + (size_t)m * D + 4 * (lane + 64 * j)) = v[j] * r * gv[j];
        } else {
#pragma unroll
            for (int j = 0; j < 4; ++j) { const f32x4 sc = *(const f32x4*)(scale + cond * 6144 + 4 * (lane + 64 * j)), sh = *(const f32x4*)(shift + cond * 6144 + 4 * (lane + 64 * j));
                const f32x4 h = (v[j] * r * gv[j]) * (1.f + sc) + sh; u32x2 o; o.x = pk2(h[0], h[1]); o.y = pk2(h[2], h[3]);
                *(u32x2*)(H + (size_t)m * D + 4 * (lane + 64 * j)) = o; }
        }
    }
}

template <class F, int... I> __device__ __forceinline__ void sfor_impl(F&& f, std::integer_sequence<int, I...>) { (f(std::integral_constant<int, I>{}), ...); }
template <int N, class F> __device__ __forceinline__ void sfor(F&& f) { sfor_impl(f, std::make_integer_sequence<int, N>{}); }
__device__ __forceinline__ float dpp_add(float v, int ctrl_b1, int ctrl_4e, int dummy) { return v; }
__device__ __forceinline__ float wave_sum_dpp(float v) {
    v += __builtin_bit_cast(float, __builtin_amdgcn_update_dpp(0, __builtin_bit_cast(int, v), 0xB1, 0xf, 0xf, false));
    v += __builtin_bit_cast(float, __builtin_amdgcn_update_dpp(0, __builtin_bit_cast(int, v), 0x4E, 0xf, 0xf, false));
    v += __builtin_bit_cast(float, __builtin_amdgcn_update_dpp(0, __builtin_bit_cast(int, v), 0x141, 0xf, 0xf, false));
    v += __builtin_bit_cast(float, __builtin_amdgcn_update_dpp(0, __builtin_bit_cast(int, v), 0x140, 0xf, 0xf, false));
    const int vi = __builtin_bit_cast(int, v);
    return (__builtin_bit_cast(float, __builtin_amdgcn_readlane(vi, 0)) + __builtin_bit_cast(float, __builtin_amdgcn_readlane(vi, 16))) +
           (__builtin_bit_cast(float, __builtin_amdgcn_readlane(vi, 32)) + __builtin_bit_cast(float, __builtin_amdgcn_readlane(vi, 48)));
}
constexpr int CT = 16, CROWS = CT + 30, CCH = (CROWS + 15) / 16;
__device__ __forceinline__ void conv_phase(const bf16* U, bf16* Vc, const float* wdw, const float* bdw, const float* lng, const float* lnb, LAS unsigned char* lds, int tid, int lane, int wave, int G, int bid) {
    f32x2 w[31];
    sfor<31>([&](auto K) __attribute__((always_inline)) { constexpr int k = decltype(K)::value; w[k] = *(const f32x2*)(wdw + k * D + 2 * tid); });
    const f32x2 bd = *(const f32x2*)(bdw + 2 * tid), lg = *(const f32x2*)(lng + 2 * tid), lb = *(const f32x2*)(lnb + 2 * tid);
    LAS f32x2* part = (LAS f32x2*)lds;
    LAS f32x2* stats = part + 8 * CT;
    for (int unit = bid; unit < M / CT; unit += G) {
        const int m0 = unit * CT, seg = m0 < MP ? 0 : MP, L = m0 < MP ? 256 : 1024, t0 = (m0 - seg) & (L - 1);
        const bf16* Ub = U + (size_t)(m0 - t0) * D + 2 * tid;
        f32x2 acc[CT];
        sfor<CT>([&](auto O) __attribute__((always_inline)) { acc[decltype(O)::value] = bd; });
        sfor<CCH>([&](auto C) __attribute__((always_inline)) { constexpr int c = decltype(C)::value;
            unsigned raw[16];
            sfor<16>([&](auto I) __attribute__((always_inline)) { constexpr int i = decltype(I)::value, j = c * 16 + i;
                if constexpr (j < CROWS) { const int t = t0 - 15 + j, tc = min(max(t, 0), L - 1);
                    raw[i] = *(const unsigned*)(Ub + (size_t)tc * D); } });
            SB0();
            sfor<16>([&](auto I) __attribute__((always_inline)) { constexpr int i = decltype(I)::value, j = c * 16 + i;
                if constexpr (j < CROWS) { const int t = t0 - 15 + j; const unsigned rm = raw[i] & (unsigned)(-(int)((t >= 0) & (t < L))); const f32x2 u = (f32x2){bflo(rm), bfhi(rm)};
                    sfor<31>([&](auto K) __attribute__((always_inline)) { constexpr int k = decltype(K)::value, o = j - k;
                        if constexpr (o >= 0 && o < CT) acc[o] += u * w[k]; }); } });
        });
        sfor<CT>([&](auto O) __attribute__((always_inline)) { constexpr int o = decltype(O)::value;
            const float s = wave_sum_dpp(acc[o].x + acc[o].y), q = wave_sum_dpp(acc[o].x * acc[o].x + acc[o].y * acc[o].y); if (lane == 0) part[wave * CT + o] = (f32x2){s, q}; });
        __syncthreads();
        if (tid < CT) { float s = 0.f, q = 0.f;
#pragma unroll
            for (int wv = 0; wv < 8; ++wv) { const f32x2 p = part[wv * CT + tid]; s += p.x; q += p.y; }
            const float mean = s * (1.f / D), var = fmaxf(q * (1.f / D) - mean * mean, 0.f); stats[tid] = (f32x2){mean, 1.0f / sqrtf(var + 1e-5f)}; }
        __syncthreads();
        sfor<CT>([&](auto O) __attribute__((always_inline)) { constexpr int o = decltype(O)::value;
            const f32x2 st = stats[o]; f32x2 y = (acc[o] - st.x) * st.y * lg + lb;
            y.x = y.x * __builtin_amdgcn_rcpf(1.f + __expf(-y.x)); y.y = y.y * __builtin_amdgcn_rcpf(1.f + __expf(-y.y));
            *(unsigned*)(Vc + (size_t)(m0 + o) * D + 2 * tid) = pk2(y.x, y.y); });
        __syncthreads();
    }
}

__device__ __forceinline__ void final_norm_phase(const bf16* X, float* yout, const float* g, int gw, int NGW, int lane) {
    f32x4 gv[4];
#pragma unroll
    for (int j = 0; j < 4; ++j) gv[j] = *(const f32x4*)(g + 16 * lane + 4 * j);
    for (int m = gw; m < M; m += NGW) {
        const bf16* xr = X + (size_t)m * D + 16 * lane;
        const u32x4 w0 = *(const u32x4*)xr, w1 = *(const u32x4*)(xr + 8);
        f32x4 v[4]; v[0] = (f32x4){bflo(w0[0]), bfhi(w0[0]), bflo(w0[1]), bfhi(w0[1])}; v[1] = (f32x4){bflo(w0[2]), bfhi(w0[2]), bflo(w0[3]), bfhi(w0[3])};
        v[2] = (f32x4){bflo(w1[0]), bfhi(w1[0]), bflo(w1[1]), bfhi(w1[1])}; v[3] = (f32x4){bflo(w1[2]), bfhi(w1[2]), bflo(w1[3]), bfhi(w1[3])};
        float sq = 0.f;
#pragma unroll
        for (int j = 0; j < 4; ++j) sq += (v[j][0] * v[j][0] + v[j][1] * v[j][1]) + (v[j][2] * v[j][2] + v[j][3] * v[j][3]);
        const float r = 1.0f / sqrtf(wave_sum_dpp(sq) * (1.f / D) + 1e-6f);
#pragma unroll
        for (int j = 0; j < 4; ++j) __builtin_nontemporal_store(v[j] * r * gv[j], (f32x4*)(yout + (size_t)m * D + 16 * lane + 4 * j));
    }
}

__device__ __forceinline__ void prep_phase(const float* xp, const float* xs, bf16* H, float* ss0, const float* g, const float* scale, const float* mod, const bf16* Wt, float* shw, int gw, int NGW, int lane) {
    { f32x4 gv[4];
#pragma unroll
      for (int j = 0; j < 4; ++j) gv[j] = *(const f32x4*)(g + 4 * (lane + 64 * j));
      for (int m = gw; m < M; m += NGW) {
          const float* xrow = m < MP ? xp + (size_t)m * D : xs + (size_t)(m - MP) * D;
          const int cond = m < MP ? 0 : 1 + ((m - MP) >> 10);
          f32x4 v[4]; float sq = 0.f;
#pragma unroll
          for (int j = 0; j < 4; ++j) { v[j] = *(const f32x4*)(xrow + 4 * (lane + 64 * j)); sq += (v[j][0] * v[j][0] + v[j][1] * v[j][1]) + (v[j][2] * v[j][2] + v[j][3] * v[j][3]); }
          sq = wave_sum_dpp(sq); if (lane == 0) ss0[m] = sq;
          f32x4 sc[4];
#pragma unroll
          for (int j = 0; j < 4; ++j) sc[j] = *(const f32x4*)(scale + cond * 6144 + 4 * (lane + 64 * j));
#pragma unroll
          for (int j = 0; j < 4; ++j) { const f32x4 h = v[j] * gv[j] * (1.f + sc[j]); u32x2 o; o.x = pk2(h[0], h[1]); o.y = pk2(h[2], h[3]);
              *(u32x2*)(H + (size_t)m * D + 4 * (lane + 64 * j)) = o; }
      } }
    for (int it = gw; it < 4 * 8192; it += NGW) {
        const int l = it >> 13, which = (it >> 12) & 1, n = it & 4095, i = l >> 1; const bool conv = (l & 1) != 0;
        const int N = which ? 4096 : (conv ? 2048 : 3072);
        if (n >= N) continue;
        const bf16* wrow = Wt + (which ? W_UP + (size_t)l * 4 * MEL : (conv ? W_PW1 + (size_t)i * 2 * MEL : W_QKV + (size_t)i * 3 * MEL)) + (size_t)n * D + 16 * lane;
        const u32x4 w0 = *(const u32x4*)wrow, w1 = *(const u32x4*)(wrow + 8);
        float wv[16];
#pragma unroll
        for (int e = 0; e < 4; ++e) { wv[2 * e] = bflo(w0[e]); wv[2 * e + 1] = bfhi(w0[e]); wv[8 + 2 * e] = bflo(w1[e]); wv[8 + 2 * e + 1] = bfhi(w1[e]); }
#pragma unroll
        for (int cond = 0; cond < 5; ++cond) { const float* sh = mod + (size_t)(l * 5 + cond) * 6144 + (which ? 3 : 0) * 1024 + 16 * lane; float dot = 0.f;
#pragma unroll
            for (int q = 0; q < 4; ++q) { const f32x4 s4 = *(const f32x4*)(sh + 4 * q); dot += (s4[0] * wv[4 * q] + s4[1] * wv[4 * q + 1]) + (s4[2] * wv[4 * q + 2] + s4[3] * wv[4 * q + 3]); }
            dot = wave_sum_dpp(dot); if (lane == 0) shw[(size_t)((l * 2 + which) * 5 + cond) * 4096 + n] = dot; }
    }
}

constexpr float SCL = 0.125f * 1.4426950408889634f, LOG2E = 1.4426950408889634f;
__device__ __forceinline__ void vt_write(LAS bf16* Vt, int pitch, int slot, int chunk, u32x4 v) {
    LAS bf16* p = Vt + (8 * chunk) * pitch + slot;
    p[0] = (bf16)(v.x & 0xffffu); p[pitch] = (bf16)(v.x >> 16); p[2 * pitch] = (bf16)(v.y & 0xffffu); p[3 * pitch] = (bf16)(v.y >> 16);
    p[4 * pitch] = (bf16)(v.z & 0xffffu); p[5 * pitch] = (bf16)(v.z >> 16); p[6 * pitch] = (bf16)(v.w & 0xffffu); p[7 * pitch] = (bf16)(v.w >> 16);
}
template <int NB> __device__ __forceinline__ void softmax_part(f32x4 (&s)[NB], float& mx_out, float& sum_out, int lane, float m_floor = -INFINITY) {
    float mx = m_floor;
#pragma unroll
    for (int b = 0; b < NB; ++b) mx = fmaxf(mx, fmaxf(fmaxf(s[b][0], s[b][1]), fmaxf(s[b][2], s[b][3])));
    mx = fmaxf(mx, shx(mx, 16, lane)); mx = fmaxf(mx, shx(mx, 32, lane));
    float sum = 0.f;
#pragma unroll
    for (int b = 0; b < NB; ++b) {
#pragma unroll
        for (int e = 0; e < 4; ++e) { s[b][e] = __builtin_amdgcn_exp2f(s[b][e] - mx); sum += s[b][e]; } }
    sum += shx(sum, 16, lane); sum += shx(sum, 32, lane);
    mx_out = mx; sum_out = sum;
}
__device__ __forceinline__ bf16x8 pack_p(const f32x4& a, const f32x4& b) {
    u32x4 w; w.x = pk2(a[0], a[1]); w.y = pk2(a[2], a[3]); w.z = pk2(b[0], b[1]); w.w = pk2(b[2], b[3]); return __builtin_bit_cast(bf16x8, w);
}
__device__ __forceinline__ bf16x8 vt_read(const LAS bf16* p0, const LAS bf16* p1) {
    const s16x4 a = *(const LAS s16x4*)p0, b = *(const LAS s16x4*)p1; return (bf16x8){a[0], a[1], a[2], a[3], b[0], b[1], b[2], b[3]};
}
__device__ __forceinline__ f32x4 qk_block(const bf16* kp, const bf16x8& qf0, const bf16x8& qf1) {
    const bf16x8 k0 = *(const bf16x8*)kp, k1 = *(const bf16x8*)(kp + 32);
    f32x4 a = __builtin_amdgcn_mfma_f32_16x16x32_bf16(k0, qf0, (f32x4){0.f, 0.f, 0.f, 0.f}, 0, 0, 0);
    return __builtin_amdgcn_mfma_f32_16x16x32_bf16(k1, qf1, a, 0, 0, 0);
}
#define PV16(o, s, SLOT_EXPR, PITCH_) do { _Pragma("unroll") for (int pp = 0; pp < 8; ++pp) { const bf16x8 pf = pack_p(s[2 * pp], s[2 * pp + 1]); const int slot0 = (SLOT_EXPR); \
        _Pragma("unroll") for (int db = 0; db < 4; ++db) { const LAS bf16* vp = Vt + (16 * db + l15) * (PITCH_) + slot0; \
            o[db] = __builtin_amdgcn_mfma_f32_16x16x32_bf16(vt_read(vp, vp + 16), pf, o[db], 0, 0, 0); } } } while (0)

#ifndef CBN
#define CBN 4
#endif
__device__ __forceinline__ void attn_phase(const bf16* Qb, const bf16* Kb, const bf16* Vb, bf16* Ob, const bf16* CK, const bf16* CV, const float* rpb  ,
                                           int li, LAS unsigned char* lds, int tid, int lane, int wave, int G, int bid, int ulo, int uhi) {
    LAS bf16* Vt = (LAS bf16*)lds; LAS float* rpl = (LAS float*)(lds + 110592); LAS unsigned char* Kc = lds + LDS_KC;
    for (int u = bid + ulo; u < uhi; u += G) {
        int lz_ = lane; asm volatile("" : "+v"(lz_));
        const int l15 = lz_ & 15, g = lz_ >> 4;
        if (u < 512) {
            const int b = u >> 4, h = u & 15; constexpr int PITCH = 264;
            const int qrow0 = b * 256 + 32 * wave + l15;
            const bf16x8 qa0 = *(const bf16x8*)(Qb + (size_t)qrow0 * D + h * 64 + 8 * g), qa1 = *(const bf16x8*)(Qb + (size_t)qrow0 * D + h * 64 + 32 + 8 * g);
            const bf16x8 qb0 = *(const bf16x8*)(Qb + (size_t)(qrow0 + 16) * D + h * 64 + 8 * g), qb1 = *(const bf16x8*)(Qb + (size_t)(qrow0 + 16) * D + h * 64 + 32 + 8 * g);
            SB0();
            { int t2 = tid; asm volatile("" : "+v"(t2));
              const int key = t2 & 255, c0 = (t2 >> 8) * 4; const bf16* src = Vb + (size_t)(b * 256 + key) * D + h * 64 + 8 * c0; const bf16* ksrc = Kb + (size_t)(b * 256 + key) * D + h * 64 + 8 * c0;
              u32x4 v[4], kv[4];
#pragma unroll
              for (int c = 0; c < 4; ++c) { v[c] = *(const u32x4*)(src + 8 * c); kv[c] = *(const u32x4*)(ksrc + 8 * c); }
              SB0();
#pragma unroll
              for (int c = 0; c < 4; ++c) *(LAS u32x4*)(Kc + key * 144 + (c0 + c) * 16) = kv[c];
#pragma unroll
              for (int c = 0; c < 4; ++c) vt_write(Vt, PITCH, key, c0 + c, v[c]); }
            __syncthreads();
            SB0();
            f32x4 s0[16], s1[16];
            { const LAS unsigned char* kl = Kc + l15 * 144 + g * 16;
              sfor<16>([&](auto I) __attribute__((always_inline)) { constexpr int kb = decltype(I)::value;
                const bf16x8 k0 = *(const LAS bf16x8*)(kl + kb * (16 * 144)), k1 = *(const LAS bf16x8*)(kl + kb * (16 * 144) + 64);
                f32x4 a = __builtin_amdgcn_mfma_f32_16x16x32_bf16(k0, qa0, (f32x4){0.f, 0.f, 0.f, 0.f}, 0, 0, 0); s0[kb] = __builtin_amdgcn_mfma_f32_16x16x32_bf16(k1, qa1, a, 0, 0, 0) * SCL;
                f32x4 c = __builtin_amdgcn_mfma_f32_16x16x32_bf16(k0, qb0, (f32x4){0.f, 0.f, 0.f, 0.f}, 0, 0, 0); s1[kb] = __builtin_amdgcn_mfma_f32_16x16x32_bf16(k1, qb1, c, 0, 0, 0) * SCL; }); }
            { float mx, sum; softmax_part<16>(s0, mx, sum, lane);
              f32x4 o[4];
#pragma unroll
              for (int db = 0; db < 4; ++db) o[db] = (f32x4){0.f, 0.f, 0.f, 0.f};
              PV16(o, s0, 32 * pp + 4 * g, PITCH);
              const float rl = 1.0f / sum;
#pragma unroll
              for (int db = 0; db < 4; ++db) { const f32x4 ov = o[db] * rl; u32x2 w; w.x = pk2(ov[0], ov[1]); w.y = pk2(ov[2], ov[3]);
                  *(u32x2*)(Ob + (size_t)qrow0 * D + h * 64 + 16 * db + 4 * g) = w; } }
            { float mx, sum; softmax_part<16>(s1, mx, sum, lane);
              f32x4 o[4];
#pragma unroll
              for (int db = 0; db < 4; ++db) o[db] = (f32x4){0.f, 0.f, 0.f, 0.f};
              PV16(o, s1, 32 * pp + 4 * g, PITCH);
              const float rl = 1.0f / sum;
#pragma unroll
              for (int db = 0; db < 4; ++db) { const f32x4 ov = o[db] * rl; u32x2 w; w.x = pk2(ov[0], ov[1]); w.y = pk2(ov[2], ov[3]);
                  *(u32x2*)(Ob + (size_t)(qrow0 + 16) * D + h * 64 + 16 * db + 4 * g) = w; } }
            __syncthreads();
        } else {
            const int ui = u - 512, xcd = ui & 7, idx = (ui >> 3) & 63, uu = (G == 256) ? ((xcd * 8 + (idx >> 3)) << 3) + (idx & 7) : ui;
            const int b = uu >> 7, h = (uu >> 3) & 15, rp = uu & 7, r0 = 2 * rp; constexpr int PITCH = 840;
            const int rs0 = min(max(r0 - 4, 0), 8);
            const size_t tokb = (size_t)MP + (size_t)b * 1024;
            const int r = r0 + (wave >> 2), j = wave & 3, rs = min(max(r - 4, 0), 8), rrel = rs - rs0, kcs = min(max(16 * j - 8, 0), 32);
            const int qcol = 16 * j + l15, wst = min(max(qcol - 8, 0), 48);
            const size_t qtok = tokb + r * 64 + qcol;
            const bf16* kloc = Kb + (tokb + rs * 64 + kcs + l15) * D + h * 64 + 8 * g;
            bf16x8 kf[16][2];
#define LOAD_KLOC(H) sfor<8>([&](auto I) __attribute__((always_inline)) { constexpr int lb = 8 * (H) + decltype(I)::value; const bf16* kp = kloc + (size_t)((lb >> 1) * 64 + 16 * (lb & 1)) * D; kf[lb][0] = *(const bf16x8*)kp; kf[lb][1] = *(const bf16x8*)(kp + 32); })
            LOAD_KLOC(0);
            const bf16x8 qf0 = *(const bf16x8*)(Qb + qtok * D + h * 64 + 8 * g), qf1 = *(const bf16x8*)(Qb + qtok * D + h * 64 + 32 + 8 * g);
            SB0();
            { int t2 = tid; asm volatile("" : "+v"(t2));
              const int slotA = t2, slotB = t2 + NTHR, slotBc = min(slotB, 831);
              const bf16* srcA = (slotA < 576) ? Vb + (tokb + min(rs0 + (slotA >> 6), 15) * 64 + (slotA & 63)) * D + h * 64 : CV + ((size_t)(b * 2 + li) * 256 + (slotA - 576)) * D + h * 64;
              const bf16* srcB = (slotBc < 576) ? Vb + (tokb + min(rs0 + (slotBc >> 6), 15) * 64 + (slotBc & 63)) * D + h * 64 : CV + ((size_t)(b * 2 + li) * 256 + (slotBc - 576)) * D + h * 64;
              const int key = t2 & 255, c0 = (t2 >> 8) * 4; const bf16* ksrc = CK + ((size_t)(b * 2 + li) * 256 + key) * D + h * 64 + 8 * c0;
              u32x4 va[8], vb[8], kv[4];
#pragma unroll
              for (int c = 0; c < 8; ++c) { va[c] = *(const u32x4*)(srcA + 8 * c); vb[c] = *(const u32x4*)(srcB + 8 * c); }
#pragma unroll
              for (int c = 0; c < 4; ++c) kv[c] = *(const u32x4*)(ksrc + 8 * c);
              const float rv = rpb[h * 465 + min(t2, 464)];
              SB0();
#pragma unroll
              for (int c = 0; c < 8; ++c) vt_write(Vt, PITCH, slotA, c, va[c]);
              if (slotB < 832) {
#pragma unroll
                  for (int c = 0; c < 8; ++c) vt_write(Vt, PITCH, slotB, c, vb[c]); }
#pragma unroll
              for (int c = 0; c < 4; ++c) *(LAS u32x4*)(Kc + key * 144 + (c0 + c) * 16) = kv[c];
              if (t2 < 465) rpl[t2] = rv; }
            SB0(); LOAD_KLOC(1); SB0();
            __syncthreads();
            SB0();
            f32x4 o1[4]; float m1, l1, m2, l2;
#pragma unroll
            for (int db = 0; db < 4; ++db) o1[db] = (f32x4){0.f, 0.f, 0.f, 0.f};
            {
                int dcv[8]; unsigned vmask = 0u;
#pragma unroll
                for (int ce = 0; ce < 8; ++ce) { const int kc = kcs + 16 * (ce >> 2) + 4 * g + (ce & 3); vmask |= ((kc >= wst) && (kc < wst + 16)) ? (1u << ce) : 0u; dcv[ce] = min(max(kc - qcol + 15, 0), 30); }
                f32x4 s[16];
#define QK_LOC(H) sfor<8>([&](auto I) __attribute__((always_inline)) { constexpr int lb = 8 * (H) + decltype(I)::value, krow = lb >> 1, ch = lb & 1; \
                    f32x4 a = __builtin_amdgcn_mfma_f32_16x16x32_bf16(kf[lb][0], qf0, (f32x4){0.f, 0.f, 0.f, 0.f}, 0, 0, 0); a = __builtin_amdgcn_mfma_f32_16x16x32_bf16(kf[lb][1], qf1, a, 0, 0, 0); \
                    const LAS float* rp_row = rpl + (rs + krow - r + 7) * 31; float bias[4]; \
                    _Pragma("unroll") for (int e = 0; e < 4; ++e) bias[e] = rp_row[dcv[ch * 4 + e]]; \
                    _Pragma("unroll") for (int e = 0; e < 4; ++e) { const float t = a[e] * SCL + bias[e] * LOG2E; a[e] = ((vmask >> (ch * 4 + e)) & 1u) ? t : -INFINITY; } \
                    s[lb] = a; })
                QK_LOC(0); QK_LOC(1); SB0();
                softmax_part<16>(s, m1, l1, lane);
                PV16(o1, s, (rrel + pp) * 64 + kcs + 4 * g, PITCH);
            }
            SB0();
            {
                f32x4 s[16];
                { const LAS unsigned char* kl = Kc + l15 * 144 + g * 16;
                  sfor<16>([&](auto I) __attribute__((always_inline)) { constexpr int cb = decltype(I)::value;
                    const bf16x8 k0 = *(const LAS bf16x8*)(kl + cb * (16 * 144)), k1 = *(const LAS bf16x8*)(kl + cb * (16 * 144) + 64);
                    f32x4 a = __builtin_amdgcn_mfma_f32_16x16x32_bf16(k0, qf0, (f32x4){0.f, 0.f, 0.f, 0.f}, 0, 0, 0); s[cb] = __builtin_amdgcn_mfma_f32_16x16x32_bf16(k1, qf1, a, 0, 0, 0) * SCL; }); }
                softmax_part<16>(s, m2, l2, lane, m1);
                const float a1 = __builtin_amdgcn_exp2f(m1 - m2);
#pragma unroll
                for (int db = 0; db < 4; ++db) o1[db] = o1[db] * a1;
                l1 = l1 * a1 + l2;
                PV16(o1, s, 576 + 32 * pp + 4 * g, PITCH);
            }
            const float rl = 1.0f / l1;
            int r2_ = r; asm volatile("" : "+s"(r2_));
            const size_t qtok2 = tokb + r2_ * 64 + qcol;
#pragma unroll
            for (int db = 0; db < 4; ++db) { const f32x4 ov = o1[db] * rl; u32x2 w; w.x = pk2(ov[0], ov[1]); w.y = pk2(ov[2], ov[3]);
                *(u32x2*)(Ob + qtok2 * D + h * 64 + 16 * db + 4 * g) = w; }
            __syncthreads();
        }
    }
}

#define RLX_AGENT __ATOMIC_RELAXED, __HIP_MEMORY_SCOPE_AGENT
#define XB_TMO      128
#define XB_XCNT(j)  (256  + 64 * (j))
#define XB_XSUB(j)  (1280 + 64 * (j))
#define XB_XGEN(j)  (2304 + 64 * (j))
#define XB_TOP      3328
#define XB_TOPGEN   3392
#define XCD_BAR_WORDS 3456
#define XB_SPIN_CAP (1u << 18)

__device__ __forceinline__ unsigned xb_ld(unsigned* p)              { return __hip_atomic_load(p, __ATOMIC_RELAXED, __HIP_MEMORY_SCOPE_AGENT); }
__device__ __forceinline__ unsigned xb_add(unsigned* p, unsigned v) { return __hip_atomic_fetch_add(p, v, __ATOMIC_RELAXED, __HIP_MEMORY_SCOPE_AGENT); }
__device__ __forceinline__ unsigned xb_xcc_id() { return (unsigned)__builtin_amdgcn_s_getreg((3 << 11) | 20) & 0xFu; }
#define XB_SPIN(cond, bar) do { unsigned _sp = 0; while (cond) { __builtin_amdgcn_s_sleep(1); \
    if ((++_sp & 255u) == 0u) { if (xb_ld(&(bar)[XB_TMO])) break; if (_sp > XB_SPIN_CAP) { atomicAdd(&(bar)[XB_TMO], 1u); break; } } } } while (0)

struct XcdBarrier {
    unsigned* bar; unsigned x;
    volatile LAS unsigned* st;
};

__device__ __forceinline__ XcdBarrier xcd_barrier_post(unsigned* bar, volatile LAS unsigned* st) {
    XcdBarrier b; b.bar = bar; b.x = xb_xcc_id(); b.st = st;
    if (threadIdx.x == 0) (void)xb_add(&bar[XB_XCNT(b.x)], 1u);
    return b;
}
__device__ __forceinline__ void xcd_barrier_complete(unsigned* bar, unsigned x, unsigned& nloc, unsigned& nx) {
    const unsigned G = gridDim.x * gridDim.y * gridDim.z;
    unsigned sum, cnt, mine, sp = 0u;
    for (;;) {
        sum = 0u; cnt = 0u; mine = 0u;
#pragma unroll
        for (unsigned j = 0; j < 16; ++j) { const unsigned c = xb_ld(&bar[XB_XCNT(j)]); sum += c; cnt += (c > 0u) ? 1u : 0u; mine = (j == x) ? c : mine; }
        if (sum == G) break;
        __builtin_amdgcn_s_sleep(1);
        if ((++sp & 255u) == 0u) { if (xb_ld(&bar[XB_TMO])) break; if (sp > XB_SPIN_CAP) { atomicAdd(&bar[XB_TMO], 1u); break; } }
    }
    nloc = mine > 0u ? mine : 1u; nx = cnt > 0u ? cnt : 1u;
}

__device__ __forceinline__ void xcd_barrier(const XcdBarrier& b) {
    asm volatile("s_waitcnt vmcnt(0)" ::: "memory");
    __syncthreads();
    if (threadIdx.x == 0) {
        unsigned* bar = b.bar;
        __builtin_amdgcn_s_waitcnt(0);
        unsigned nloc = b.st[0], nx = b.st[1];
        if (nloc == 0u) { xcd_barrier_complete(bar, b.x, nloc, nx); b.st[0] = nloc; b.st[1] = nx; }
        const unsigned old = xb_add(&bar[XB_XSUB(b.x)], 1u);
        const unsigned gen = old / nloc;
        if (old + 1u == (gen + 1u) * nloc) {
            __builtin_amdgcn_fence(__ATOMIC_RELEASE, "agent");
            asm volatile("s_waitcnt vmcnt(0)" ::: "memory");
            const unsigned og = xb_add(&bar[XB_TOP], 1u);
            const unsigned tg = og / nx;
            if (og + 1u == (tg + 1u) * nx) xb_add(&bar[XB_TOPGEN], 1u);
            else XB_SPIN(xb_ld(&bar[XB_TOPGEN]) == tg, bar);
            __builtin_amdgcn_fence(__ATOMIC_ACQUIRE, "agent");
            xb_add(&bar[XB_XGEN(b.x)], 1u);
            asm volatile("s_waitcnt vmcnt(0)" ::: "memory");
        } else {
            XB_SPIN(xb_ld(&bar[XB_XGEN(b.x)]) == gen, bar);
            __builtin_amdgcn_fence(__ATOMIC_ACQUIRE, "agent");
            asm volatile("s_waitcnt vmcnt(0)" ::: "memory");
        }
    }
    __syncthreads();
}

constexpr int NPH = 2 + 5 * NL + 1;
struct Args { const float* in[21]; float* out; unsigned char* ws; int nprog, pad; int prog[48]; };
typedef const __attribute__((address_space(4))) Args* KArgPtr;
__global__ void __launch_bounds__(NTHR, 2) fwd_kernel(Args a_unused) {
    extern __shared__ __attribute__((aligned(16))) unsigned char lds_raw[];
    LAS unsigned char* lds = (LAS unsigned char*)lds_raw;
    cg::grid_group grid = cg::this_grid();
    const int wave0 = __builtin_amdgcn_readfirstlane((int)threadIdx.x >> 6);
    { volatile LAS unsigned* st0 = (volatile LAS unsigned*)(lds + LDS_ST); if (threadIdx.x < 2) st0[threadIdx.x] = 0u; }
    __syncthreads();
    XcdBarrier xbar; { KArgPtr kpb = (KArgPtr)__builtin_amdgcn_kernarg_segment_ptr(); xbar.bar = (unsigned*)kpb->ws; xbar.x = 0; xbar.st = (volatile LAS unsigned*)(lds + LDS_ST);
        if (blockIdx.x == 0) { for (int wI = threadIdx.x; wI < XCD_BAR_WORDS; wI += NTHR) __hip_atomic_store(xbar.bar + wI, 0u, __ATOMIC_RELAXED, __HIP_MEMORY_SCOPE_AGENT); } }
    int nprog; { KArgPtr kp0 = (KArgPtr)__builtin_amdgcn_kernarg_segment_ptr(); nprog = kp0->nprog; }
    for (int pc = 0; pc < nprog; ++pc) {
        KArgPtr kp = (KArgPtr)__builtin_amdgcn_kernarg_segment_ptr(); asm volatile("" : "+s"(kp));
        int z_ = 0; asm volatile("" : "+s"(z_));
        const int lane_ = (int)__builtin_amdgcn_mbcnt_hi(~0u, __builtin_amdgcn_mbcnt_lo(~0u, (unsigned)z_)); const int tid_ = wave0 * 64 + lane_;
        int bid_ = (int)__builtin_amdgcn_workgroup_id_x(), G_ = (int)gridDim.x; asm volatile("" : "+s"(bid_), "+s"(G_));
        const int pe_ = kp->prog[pc]; const int ph = pe_ & 63, amode = pe_ >> 6;
        const int tid = tid_, lane = lane_, wave = wave0, G = G_, bid = bid_;
        const int gw = bid * NWAVES + wave, NGW = G * NWAVES;
        Ptrs P; P = Ptrs{kp->in[0], kp->in[1], kp->in[2], kp->in[3], kp->in[4], kp->in[5], kp->in[6], kp->in[7], kp->in[8], kp->in[9], kp->in[10], kp->in[11], kp->in[12], kp->in[13], kp->in[14], kp->in[15], kp->in[16], kp->in[17], kp->in[18], kp->in[19], kp->in[20]};
        unsigned char* ws = kp->ws; float* outp = kp->out;
        float* mod = (float*)(ws + WS_MOD); bf16* Wt = (bf16*)(ws + WS_W); bf16* X = (bf16*)(ws + WS_X); bf16* H = (bf16*)(ws + WS_H);
        bf16* R = (bf16*)(ws + WS_R); bf16* Qb = R; bf16* Kb = R + (size_t)M * D; bf16* Vb = R + (size_t)2 * M * D; bf16* Ob = R + (size_t)3 * M * D;
        bf16* Ub = R; bf16* Vc = R + (size_t)M * D; bf16* Fb = R;
        const bf16* CK = (const bf16*)(ws + WS_CK); const bf16* CV = (const bf16*)(ws + WS_CV);
        float* out_y = outp; float* out_ck = outp + (size_t)M * D; float* out_cv = out_ck + (size_t)32 * 2 * 256 * 1024;
        float* SS = (float*)(ws + WS_SS); float* SHW = (float*)(ws + WS_SHW);
        if (ph == 0) { p0_phase(P, ws, lds, tid, lane, wave, G, bid); }
        else if (ph == 1) { prep_phase(P.x_prompt, P.x_sample, H, SS, P.norm_g, mod + 1 * 1024, mod, Wt, SHW, gw, NGW, lane); }
        else if (ph == NPH - 1) { final_norm_phase(X, out_y, P.final_g, gw, NGW, lane); }
        else if (ph >= 60) { }
        else {
            const int l = (ph - 2) / 5, s = (ph - 2) % 5, i = l >> 1; const bool conv = (l & 1) != 0;
            const float* modl = mod + (size_t)l * 5 * 6144;
            if (s == 0) {
                const float* ssl = SS + (size_t)(2 * l) * M; const float* shl = SHW + (size_t)((2 * l) * 5) * 4096;
                if (!conv) { pg8::Gemm gm{H, Wt + W_QKV + (size_t)i * 3 * MEL, M, 3 * D, D}; pg8::StaticOrder S; S.init(M, 3 * D, G, bid);
                    pg8::EpiQKV E{ssl, shl, Qb, (size_t)M * D, out_ck + (size_t)i * 256 * 1024, (size_t)32 * 2 * 256 * 1024};
                    pg8::gemm_phase<pg8::EpiQKV, pg8::StaticOrder, true, true>(lds, gm, S, E, tid); }
                else { pg8::Gemm gm{H, Wt + W_PW1 + (size_t)i * 2 * MEL, M, 2 * D, D}; pg8::StaticOrder S; S.init(M, 2 * D, G, bid);
                    pg8::EpiGLU E{ssl, shl, Ub};
                    pg8::gemm_phase<pg8::EpiGLU, pg8::StaticOrder, true, true>(lds, gm, S, E, tid); }
            } else if (s == 1) {
                if (!conv) attn_phase(Qb, Kb, Vb, Ob, CK, CV, P.rpb + (size_t)i * 16 * 15 * 31, i, lds, tid, lane, wave, G, bid, amode == 2 ? 512 : 0, amode == 1 ? 512 : 1024);
                else conv_phase(Ub, Vc, P.w_dw + (size_t)i * 31 * D, P.b_dw + i * D, P.ln_g + i * D, P.ln_b + i * D, lds, tid, lane, wave, G, bid);
            } else if (s == 2 || s == 4) {
                pg8::Gemm gm; pg8::EpiRes E;
                if (s == 2) { gm = pg8::Gemm{conv ? Vc : Ob, Wt + (conv ? W_PW2 : W_O) + (size_t)i * MEL, M, D, D};
                    E = pg8::EpiRes{P.x_prompt, P.x_sample, l == 0 ? (const bf16*)nullptr : X, X, modl + 2 * 1024, H, P.norm_g + (l * 2 + 1) * D, modl + 4 * 1024, SS + (size_t)(2 * l + 1) * M}; }
                else { gm = pg8::Gemm{Fb, Wt + W_DOWN + (size_t)l * 4 * MEL, M, D, FF};
                    E = pg8::EpiRes{P.x_prompt, P.x_sample, X, X, modl + 5 * 1024, l < NL - 1 ? H : nullptr, P.norm_g + ((l + 1) * 2) * D, modl + 5 * 6144 + 1 * 1024, SS + (size_t)(2 * l + 2) * M}; }
                pg8::StaticOrder S; S.init(M, D, G, bid);
                pg8::gemm_phase<pg8::EpiRes, pg8::StaticOrder, true, true>(lds, gm, S, E, tid);
            } else {
                pg8::Gemm gm{H, Wt + W_UP + (size_t)l * 4 * MEL, M, FF, D}; pg8::StaticOrder S; S.init(M, FF, G, bid);
                pg8::EpiUp E{SS + (size_t)(2 * l + 1) * M, SHW + (size_t)((2 * l + 1) * 5) * 4096, Fb, FF};
                pg8::gemm_phase<pg8::EpiUp, pg8::StaticOrder, true, true>(lds, gm, S, E, tid);
            }
        }
        if (pc + 1 < nprog) { if (pc == 0) { grid.sync(); xbar = xcd_barrier_post(xbar.bar, xbar.st); } else xcd_barrier(xbar); }
    }
}

#ifndef SINGLE_LAUNCH
#define SINGLE_LAUNCH 0
#endif
extern "C" void kernel_launch(void* const* d_in, const int* in_sizes, int n_in, void* d_out, int out_size, void* d_ws, size_t ws_size, hipStream_t stream) {
    static int grid = 0;
    if (grid == 0) {
        if (n_in != 21 || ws_size < WS_END) { fprintf(stderr, "kernel_launch: unexpected n_in %d / ws_size %zu\n", n_in, ws_size); grid = -1; return; }
        int dev = 0, cus = 0, per_cu = 0;
        hipGetDevice(&dev); hipDeviceGetAttribute(&cus, hipDeviceAttributeMultiprocessorCount, dev);
        hipFuncSetAttribute((const void*)fwd_kernel, hipFuncAttributeMaxDynamicSharedMemorySize, LDS_BYTES);
        hipOccupancyMaxActiveBlocksPerMultiprocessor(&per_cu, (const void*)fwd_kernel, NTHR, LDS_BYTES);
        if (per_cu < 1) { fprintf(stderr, "kernel_launch: occupancy query says %d blocks/CU\n", per_cu); per_cu = 1; }
        (void)hipGetLastError();
        grid = cus * per_cu;
    }
    if (grid < 0) return;
    Args a{};
    for (int i = 0; i < 21; ++i) a.in[i] = (const float*)d_in[i];
    a.out = (float*)d_out; a.ws = (unsigned char*)d_ws;
#if SINGLE_LAUNCH
    { int n = 0;
      for (int ph = 0; ph < NPH; ++ph) { a.prog[n++] = ph;
#ifdef PROBE_ATTN_MODE
          if (ph >= 2 && ph < NPH - 1 && (ph - 2) % 5 == 1 && ((ph - 2) / 5) % 2 == 0) a.prog[n++] = ph | (PROBE_ATTN_MODE << 6);
#endif
#ifdef PROBE_EMPTY
          if (ph == 5) for (int q = 0; q < PROBE_EMPTY; ++q) a.prog[n++] = 60;
#endif
#ifdef PROBE_REPEAT_P0
          if (ph == 0) a.prog[n++] = 0;
#endif
#ifdef PROBE_REPEAT_S
          if (ph >= 2 && ph < NPH - 1 && (ph - 2) % 5 == PROBE_REPEAT_S && (PROBE_REPEAT_PAR < 0 || ((ph - 2) / 5) % 2 == PROBE_REPEAT_PAR)) a.prog[n++] = ph;
#endif
      }
      a.nprog = n; }
    void* args[] = {&a};
    hipError_t e = hipLaunchCooperativeKernel((const void*)fwd_kernel, dim3(grid), dim3(NTHR), args, LDS_BYTES, stream);
    if (e != hipSuccess) fprintf(stderr, "cooperative launch failed: %s (grid %d)\n", hipGetErrorString(e), grid);
#else
    for (int ph = 0; ph < NPH; ++ph) { a.nprog = 1; a.prog[0] = ph; hipLaunchKernelGGL(fwd_kernel, dim3(grid), dim3(NTHR), LDS_BYTES, stream, a); }
#endif
}
```

```cpp
#define SINGLE_LAUNCH 1
#include <hip/hip_runtime.h>
#include <hip/hip_cooperative_groups.h>
#include <cstdio>
#include <cstdint>
#include <cmath>
#include <utility>
namespace cg = cooperative_groups;
namespace pg8 {
#define PG8_LAS __attribute__((address_space(3)))
typedef unsigned short bf16_t;
typedef short bf16x8 __attribute__((ext_vector_type(8)));
typedef float f32x4 __attribute__((ext_vector_type(4)));
typedef unsigned u32x4 __attribute__((ext_vector_type(4)));
constexpr int RM = 192;
constexpr int BM = 256, BK = 64, HALF = 128, HTB = HALF * BK * 2  , STAGE_BYTES = 8 * HTB, NXCD = 8, WGM = 8;

__host__ __device__ __forceinline__ int lds_byte(int r, int c) { const int st = (r >> 4) * 2 + (c >> 5), rr = r & 15, cc = c & 31, ob = rr * 64 + cc * 2; return st * 1024 + (ob ^ (((ob >> 9) & 1) << 5)); }
__host__ __device__ __forceinline__ void stage_rc(int b, int& R, int& C) { const int st = b / 1024, sb = b % 1024, swz = sb ^ (((sb >> 9) & 1) << 5); R = (st >> 1) * 16 + swz / 64; C = (st & 1) * 32 + (swz % 64) / 2; }
__host__ __device__ __forceinline__ int perm32(int rho) { const int n = rho >> 4, i = rho & 15; return 8 * (i >> 2) + 4 * n + (i & 3); }

struct Unit { int pm, pn; };
struct Gemm { const bf16_t* A; const bf16_t* Bt; int M, N, K; };

struct StaticOrder {
    int nM, nN, nwg, G, c;
    __host__ __device__ void init(int M, int N, int G_, int c_) { nM = M / RM; nN = N / BM; nwg = nM * nN; G = G_; c = c_; }
    __host__ __device__ bool next(int i, Unit& u) const {
        const long L = (long)i * G + c; if (L >= nwg) return false;
        int wgid = (int)L; { const int q = nwg / NXCD, r = nwg % NXCD, xcd = wgid % NXCD, off = wgid / NXCD; wgid = (xcd < r ? xcd * (q + 1) : r * (q + 1) + (xcd - r) * q) + off; }
        const int nig = WGM * nN, gid = wgid / nig, fm = gid * WGM, gsz = (nM - fm) < WGM ? (nM - fm) : WGM;
        u.pm = fm + ((wgid % nig) % gsz); u.pn = (wgid % nig) / gsz; return true;
    }
    __device__ __forceinline__ void a_ready(const Unit&) const {}
    __device__ __forceinline__ void done(const Unit&) const {}
};

__device__ __forceinline__ unsigned cvt_pk_bf16(float lo, float hi) { unsigned r; asm volatile("v_cvt_pk_bf16_f32 %0, %1, %2" : "=v"(r) : "v"(lo), "v"(hi)); return r; }
typedef float f32x2 __attribute__((ext_vector_type(2)));
__device__ __forceinline__ int cond_of_row(int r) { return r < 8192 ? 0 : 1 + ((r - 8192) >> 10); }
__device__ __forceinline__ int half_row0(int ai, int wr) { return ai == 0 ? wr * 64 : 128 + wr * 32; }
#define EPI_MLOOP(ai, m) _Pragma("unroll") for (int m = 0; m < 4; ++m) if (ai == 0 || m < 2)
struct EpiQKV {
    static constexpr bool PERM = true, AFTER_DRAIN = false;
    const float* ss; const float* shw;
    bf16_t* Q; size_t qkv_stride; float* ck; size_t ckv_stride;
    __device__ __forceinline__ void operator()(const f32x4 (&acc)[2][2][4][2], const Unit& u, int wr, int wc, int fr, int fq) const {
        const int t = u.pn >> 2;
        bf16_t* base = Q + (size_t)t * qkv_stride;
        const int col0 = (u.pn & 3) * BM + wc * 32 + 8 * fq;
        float* cbase = ck + (size_t)(t > 0 ? t - 1 : 0) * ckv_stride + col0;
#pragma unroll
        for (int ai = 0; ai < 2; ++ai) { const int rbase = u.pm * RM + half_row0(ai, wr) + fr; const bool wc_ = (t > 0) && (rbase < 8192);
            const float* sp = shw + cond_of_row(rbase) * 4096 + u.pn * BM + wc * 32 + 8 * fq;
            f32x4 sv[2][2];
#pragma unroll
            for (int bj = 0; bj < 2; ++bj) { sv[bj][0] = *(const f32x4*)(sp + bj * HALF); sv[bj][1] = *(const f32x4*)(sp + bj * HALF + 4); }
            float rr[4];
            EPI_MLOOP(ai, m) rr[m] = ss[rbase + m * 16];
            EPI_MLOOP(ai, m) { const int row = rbase + m * 16; bf16_t* rowp = base + (size_t)row * 1024 + col0;
                const float r = __builtin_amdgcn_rsqf(rr[m] * (1.f / 1024.f) + 1e-6f);
                float* cp0 = cbase + ((size_t)(row >> 8) * 2 * 256 + (row & 255)) * 1024;
#pragma unroll
                for (int bj = 0; bj < 2; ++bj) { const f32x4 v0 = acc[ai][bj][m][0] * r + sv[bj][0], v1 = acc[ai][bj][m][1] * r + sv[bj][1];
                    u32x4 w; w.x = cvt_pk_bf16(v0[0], v0[1]); w.y = cvt_pk_bf16(v0[2], v0[3]); w.z = cvt_pk_bf16(v1[0], v1[1]); w.w = cvt_pk_bf16(v1[2], v1[3]);
                    *(u32x4*)(rowp + bj * HALF) = w;
                    if (wc_) { float* cp = cp0 + bj * HALF; __builtin_nontemporal_store(v0, (f32x4*)cp); __builtin_nontemporal_store(v1, (f32x4*)(cp + 4)); } } } }
    }
};
struct EpiUp {
    static constexpr bool PERM = true, AFTER_DRAIN = false;
    const float* ss; const float* shw; bf16_t* O; int ldc;
    __device__ __forceinline__ void operator()(const f32x4 (&acc)[2][2][4][2], const Unit& u, int wr, int wc, int fr, int fq) const {
        const int col0 = u.pn * BM + wc * 32 + 8 * fq;
#pragma unroll
        for (int ai = 0; ai < 2; ++ai) { const int rbase = u.pm * RM + half_row0(ai, wr) + fr;
            const float* sp = shw + cond_of_row(rbase) * 4096 + col0;
            f32x4 sv[2][2];
#pragma unroll
            for (int bj = 0; bj < 2; ++bj) { sv[bj][0] = *(const f32x4*)(sp + bj * HALF); sv[bj][1] = *(const f32x4*)(sp + bj * HALF + 4); }
            float rr[4];
            EPI_MLOOP(ai, m) rr[m] = ss[rbase + m * 16];
            EPI_MLOOP(ai, m) { bf16_t* rowp = O + (size_t)(rbase + m * 16) * ldc + col0;
                const float r = __builtin_amdgcn_rsqf(rr[m] * (1.f / 1024.f) + 1e-6f);
#pragma unroll
                for (int bj = 0; bj < 2; ++bj) { f32x4 v0 = acc[ai][bj][m][0] * r + sv[bj][0], v1 = acc[ai][bj][m][1] * r + sv[bj][1];
#pragma unroll
                    for (int e = 0; e < 4; ++e) { const float a = fmaxf(v0[e], 0.f), b = fmaxf(v1[e], 0.f); v0[e] = a * a; v1[e] = b * b; }
                    u32x4 w; w.x = cvt_pk_bf16(v0[0], v0[1]); w.y = cvt_pk_bf16(v0[2], v0[3]); w.z = cvt_pk_bf16(v1[0], v1[1]); w.w = cvt_pk_bf16(v1[2], v1[3]);
                    *(u32x4*)(rowp + bj * HALF) = w; } } }
    }
};
struct EpiGLU {
    static constexpr bool PERM = true, AFTER_DRAIN = false;
    const float* ss; const float* shw; bf16_t* O;
    __device__ __forceinline__ void operator()(const f32x4 (&acc)[2][2][4][2], const Unit& u, int wr, int wc, int fr, int fq) const {
        const int col0 = u.pn * HALF + wc * 32 + 8 * fq;
#pragma unroll
        for (int ai = 0; ai < 2; ++ai) { const int rbase = u.pm * RM + half_row0(ai, wr) + fr;
            const float* sp = shw + cond_of_row(rbase) * 4096 + u.pn * BM + wc * 32 + 8 * fq;
            f32x4 sv[2][2];
#pragma unroll
            for (int bj = 0; bj < 2; ++bj) { sv[bj][0] = *(const f32x4*)(sp + bj * HALF); sv[bj][1] = *(const f32x4*)(sp + bj * HALF + 4); }
            float rr[4];
            EPI_MLOOP(ai, m) rr[m] = ss[rbase + m * 16];
            EPI_MLOOP(ai, m) { bf16_t* rowp = O + (size_t)(rbase + m * 16) * 1024 + col0;
                const float r = __builtin_amdgcn_rsqf(rr[m] * (1.f / 1024.f) + 1e-6f);
                f32x4 v0 = acc[ai][0][m][0] * r + sv[0][0], v1 = acc[ai][0][m][1] * r + sv[0][1]; const f32x4 g0 = acc[ai][1][m][0] * r + sv[1][0], g1 = acc[ai][1][m][1] * r + sv[1][1];
#pragma unroll
                for (int e = 0; e < 4; ++e) { v0[e] = v0[e] * __builtin_amdgcn_rcpf(1.f + __expf(-g0[e])); v1[e] = v1[e] * __builtin_amdgcn_rcpf(1.f + __expf(-g1[e])); }
                u32x4 w; w.x = cvt_pk_bf16(v0[0], v0[1]); w.y = cvt_pk_bf16(v0[2], v0[3]); w.z = cvt_pk_bf16(v1[0], v1[1]); w.w = cvt_pk_bf16(v1[2], v1[3]);
                *(u32x4*)rowp = w; } }
    }
};
struct EpiRes {
    static constexpr bool PERM = false, AFTER_DRAIN = false;
    const float* base_p; const float* base_s; const bf16_t* base_b; bf16_t* out; const float* gate;
    bf16_t* xb; const float* g_next; const float* sc_next; float* ss_next;
    __device__ __forceinline__ void operator()(const f32x4 (&acc)[2][2][4][2], const Unit& u, int wr, int wc, int fr, int fq) const {
        typedef unsigned u32x2e __attribute__((ext_vector_type(2)));
        const int col0 = u.pn * BM + wc * 32 + 4 * fq;
        const int lane_x = fq * 16 + fr;
#pragma unroll
        for (int ai = 0; ai < 2; ++ai) { const int row0 = u.pm * RM + half_row0(ai, wr) + fr; const int cond = cond_of_row(row0);
            const float* gp = gate + cond * 6144 + col0;
            const float* bp = (row0 < 8192) ? base_p + (size_t)row0 * 1024 + col0 : base_s + (size_t)(row0 - 8192) * 1024 + col0;
            const bf16_t* bb = base_b + (size_t)row0 * 1024 + col0;
            bf16_t* op = out + (size_t)row0 * 1024 + col0;
            f32x4 gv[2][2], gs[2][2];
#pragma unroll
            for (int bj = 0; bj < 2; ++bj)
#pragma unroll
                for (int n = 0; n < 2; ++n) gv[bj][n] = *(const f32x4*)(gp + bj * HALF + n * 16);
            if (xb) { f32x4 ga[2][2], sa[2][2];
#pragma unroll
                for (int bj = 0; bj < 2; ++bj)
#pragma unroll
                    for (int n = 0; n < 2; ++n) { ga[bj][n] = *(const f32x4*)(g_next + col0 + bj * HALF + n * 16); sa[bj][n] = *(const f32x4*)(sc_next + cond * 6144 + col0 + bj * HALF + n * 16); }
#pragma unroll
                for (int bj = 0; bj < 2; ++bj)
#pragma unroll
                    for (int n = 0; n < 2; ++n) gs[bj][n] = ga[bj][n] * (1.f + sa[bj][n]); }
#pragma unroll
            for (int mp = 0; mp < 2; ++mp) if (ai == 0 || mp == 0) { f32x4 bs[2][2][2];
                if (base_b) {
#pragma unroll
                    for (int mm = 0; mm < 2; ++mm)
#pragma unroll
                        for (int bj = 0; bj < 2; ++bj)
#pragma unroll
                            for (int n = 0; n < 2; ++n) { const u32x2e w = *(const u32x2e*)(bb + (size_t)((2 * mp + mm) * 16) * 1024 + bj * HALF + n * 16);
                                bs[mm][bj][n] = (f32x4){__builtin_bit_cast(float, w.x << 16), __builtin_bit_cast(float, w.x & 0xffff0000u), __builtin_bit_cast(float, w.y << 16), __builtin_bit_cast(float, w.y & 0xffff0000u)}; }
                } else {
#pragma unroll
                    for (int mm = 0; mm < 2; ++mm)
#pragma unroll
                        for (int bj = 0; bj < 2; ++bj)
#pragma unroll
                            for (int n = 0; n < 2; ++n) bs[mm][bj][n] = *(const f32x4*)(bp + (size_t)((2 * mp + mm) * 16) * 1024 + bj * HALF + n * 16);
                }
#pragma unroll
                for (int mm = 0; mm < 2; ++mm) { float sq = 0.f;
#pragma unroll
                    for (int bj = 0; bj < 2; ++bj)
#pragma unroll
                        for (int n = 0; n < 2; ++n) { const f32x4 xn = bs[mm][bj][n] + gv[bj][n] * acc[ai][bj][2 * mp + mm][n];
                            { u32x2e w; w.x = cvt_pk_bf16(xn[0], xn[1]); w.y = cvt_pk_bf16(xn[2], xn[3]); *(u32x2e*)(op + (size_t)((2 * mp + mm) * 16) * 1024 + bj * HALF + n * 16) = w; }
                            if (xb) { const f32x4 hb = xn * gs[bj][n]; u32x2e w; w.x = cvt_pk_bf16(hb[0], hb[1]); w.y = cvt_pk_bf16(hb[2], hb[3]);
                                *(u32x2e*)(xb + (size_t)(row0 + (2 * mp + mm) * 16) * 1024 + col0 + bj * HALF + n * 16) = w;
                                sq += (xn[0] * xn[0] + xn[1] * xn[1]) + (xn[2] * xn[2] + xn[3] * xn[3]); } }
                    if (xb) {
                        sq += __builtin_bit_cast(float, __builtin_amdgcn_ds_bpermute((lane_x ^ 16) << 2, __builtin_bit_cast(int, sq)));
                        sq += __builtin_bit_cast(float, __builtin_amdgcn_ds_bpermute((lane_x ^ 32) << 2, __builtin_bit_cast(int, sq)));
                        if (fq == 0) atomicAdd(ss_next + row0 + (2 * mp + mm) * 16, sq); } }
                asm volatile("" ::: "memory"); } }
    }
};
template <class Epi, class Sched, bool ALIGN_EPI = false, bool SP2 = false>
__device__ __forceinline__ void gemm_phase(PG8_LAS unsigned char* lds, const Gemm g, const Sched& S, const Epi& E, const int tid) {
    static_assert(SP2, "the 192-row tile form exists for the SP2 loop only");
    const int wid = __builtin_amdgcn_readfirstlane(tid >> 6), lane = tid & 63, wr = wid >> 2, wc = wid & 3, fr = lane & 15, fq = lane >> 4;
    const int K = g.K, nt = K / BK;
    unsigned voffA[2], voffB[2];
#pragma unroll
    for (int i = 0; i < 2; ++i) { int R, C; stage_rc(tid * 16 + i * 8192, R, C); const int Rb = Epi::PERM ? ((R & ~31) + perm32(R & 31)) : R;
        voffA[i] = (unsigned)(R * K + C) * 2u; voffB[i] = (unsigned)(Rb * K + C) * 2u; }
    const size_t kstep = (size_t)(BK * 2);
    const size_t hstep = (size_t)HALF * K * 2;
    const size_t tstepA = (size_t)RM * K * 2;
    const size_t tstep = 2 * hstep;
    const unsigned ldsw = (unsigned)wid * 1024u;
    const int aoff = lds_byte(wr * 64 + fr, fq * 8), boff = lds_byte(wc * 32 + fr, fq * 8);
#define PG8_SA(b, h) (((b) * 2 + (h)) * HTB)
#define PG8_SB(b, h) ((4 + (b) * 2 + (h)) * HTB)
#define PG8_STAGE(bufoff, gbase, voff) do { _Pragma("unroll") for (int _i = 0; _i < 2; ++_i) \
        __builtin_amdgcn_global_load_lds((const unsigned*)((const char*)(gbase) + (voff)[_i]), (PG8_LAS unsigned*)(lds + (bufoff) + ldsw + _i * 8192), 16, 0, 0); } while (0)
#define PG8_LDA(dst, b, h) do { _Pragma("unroll") for (int m = 0; m < 4; ++m) _Pragma("unroll") for (int k = 0; k < 2; ++k) dst[m][k] = *(const PG8_LAS bf16x8*)(lds + PG8_SA(b, h) + aoff + m * 2048 + k * 1024); } while (0)
#define PG8_LDB(dst, b, h) do { _Pragma("unroll") for (int n = 0; n < 2; ++n) _Pragma("unroll") for (int k = 0; k < 2; ++k) dst[n][k] = *(const PG8_LAS bf16x8*)(lds + PG8_SB(b, h) + boff + n * 2048 + k * 1024); } while (0)
#define PG8_MMA(ai, bj, At, Bt) do { __builtin_amdgcn_s_setprio(1); _Pragma("unroll") for (int m = 0; m < 4; ++m) _Pragma("unroll") for (int n = 0; n < 2; ++n) _Pragma("unroll") for (int k = 0; k < 2; ++k) \
        acc[ai][bj][m][n] = __builtin_amdgcn_mfma_f32_16x16x32_bf16(Bt[n][k], At[m][k], acc[ai][bj][m][n], 0, 0, 0); __builtin_amdgcn_s_setprio(0); } while (0)
    const int aoff1 = lds_byte(wr * 32 + fr, fq * 8);
#define PG8_STAGE1(bufoff, gbase, voff) __builtin_amdgcn_global_load_lds((const unsigned*)((const char*)(gbase) + (voff)[0]), (PG8_LAS unsigned*)(lds + (bufoff) + ldsw), 16, 0, 0)
#define PG8_LDA1(dst, b) do { _Pragma("unroll") for (int m = 0; m < 2; ++m) _Pragma("unroll") for (int k = 0; k < 2; ++k) dst[m][k] = *(const PG8_LAS bf16x8*)(lds + PG8_SA(b, 1) + aoff1 + m * 2048 + k * 1024); } while (0)
#define PG8_MMA1(bj, At, Bt) do { __builtin_amdgcn_s_setprio(1); _Pragma("unroll") for (int m = 0; m < 2; ++m) _Pragma("unroll") for (int n = 0; n < 2; ++n) _Pragma("unroll") for (int k = 0; k < 2; ++k) \
        acc[1][bj][m][n] = __builtin_amdgcn_mfma_f32_16x16x32_bf16(Bt[n][k], At[m][k], acc[1][bj][m][n], 0, 0, 0); __builtin_amdgcn_s_setprio(0); } while (0)
#define PG8_WAIT_V(n) asm volatile("s_waitcnt vmcnt(" #n ")" ::: "memory")
#define PG8_WAIT_L(n) asm volatile("s_waitcnt lgkmcnt(" #n ")" ::: "memory")
#define PG8_BAR __builtin_amdgcn_s_barrier()
#define PG8_SCHED __builtin_amdgcn_sched_barrier(0)
    Unit cur, nxt; int ui = 0;
    if (!S.next(0, cur)) return;
    f32x4 acc[2][2][4][2];
#pragma unroll
    for (int a = 0; a < 2; ++a)
#pragma unroll
        for (int b = 0; b < 2; ++b)
#pragma unroll
            for (int m = 0; m < 4; ++m)
#pragma unroll
                for (int n = 0; n < 2; ++n) acc[a][b][m][n] = (f32x4){0.f, 0.f, 0.f, 0.f};
    bf16x8 At[4][2], B0[2][2], B1[2][2];
    const char* cA = (const char*)g.A + (size_t)cur.pm * tstepA; const char* cB = (const char*)g.Bt + (size_t)cur.pn * tstep;
    S.a_ready(cur);
    if constexpr (SP2) {
        PG8_STAGE(PG8_SB(0, 0), cB, voffB); PG8_STAGE(PG8_SB(0, 1), cB + hstep, voffB); PG8_STAGE(PG8_SA(0, 0), cA, voffA); PG8_STAGE1(PG8_SA(0, 1), cA + hstep, voffA);
        if (wr == 1) PG8_BAR;
        PG8_WAIT_V(1); PG8_BAR;
        PG8_STAGE(PG8_SB(1, 0), cB + kstep, voffB); PG8_STAGE(PG8_SA(1, 0), cA + kstep, voffA); PG8_STAGE(PG8_SB(1, 1), cB + hstep + kstep, voffB);
        PG8_WAIT_V(6); PG8_BAR;
    } else {
        PG8_STAGE(PG8_SB(0, 0), cB, voffB); PG8_STAGE(PG8_SA(0, 0), cA, voffA); PG8_STAGE(PG8_SB(0, 1), cB + hstep, voffB); PG8_STAGE(PG8_SA(0, 1), cA + hstep, voffA);
        if (wr == 1) PG8_BAR;
        PG8_WAIT_V(4); PG8_BAR;
        PG8_STAGE(PG8_SB(1, 0), cB + kstep, voffB); PG8_STAGE(PG8_SA(1, 0), cA + kstep, voffA); PG8_STAGE(PG8_SB(1, 1), cB + hstep + kstep, voffB);
        PG8_WAIT_V(6); PG8_BAR;
    }
    for (;;) {
        const bool has_next = S.next(ui + 1, nxt);
        const char* nA = has_next ? (const char*)g.A + (size_t)nxt.pm * tstepA : cA; const char* nB = has_next ? (const char*)g.Bt + (size_t)nxt.pn * tstep : cB;
        for (int t = 0; t < nt; t += 2) {
            const bool last = (t == nt - 2);
            const char* a1 = cA + (size_t)(t + 1) * kstep;
            const char* a2 = last ? nA : cA + (size_t)(t + 2) * kstep; const char* b2 = last ? nB : cB + (size_t)(t + 2) * kstep;
            const char* a3 = a2 + kstep; const char* b3 = b2 + kstep;
            if (last && has_next) S.a_ready(nxt);
            if constexpr (SP2) {
            PG8_LDB(B0, 0, 0); PG8_LDB(B1, 0, 1); PG8_SCHED; PG8_LDA(At, 0, 0); PG8_STAGE1(PG8_SA(1, 1), a1 + hstep, voffA);
            PG8_WAIT_V(7); PG8_WAIT_L(0); PG8_BAR; PG8_MMA(0, 0, At, B0); PG8_MMA(0, 1, At, B1); PG8_BAR; PG8_SCHED;
            PG8_LDA1(At, 0); PG8_STAGE(PG8_SB(0, 0), b2, voffB); PG8_STAGE(PG8_SB(0, 1), b2 + hstep, voffB); PG8_STAGE(PG8_SA(0, 0), a2, voffA);
            PG8_WAIT_V(7); PG8_WAIT_L(0); PG8_BAR; PG8_MMA1(0, At, B0); PG8_MMA1(1, At, B1); PG8_BAR; PG8_SCHED;
            PG8_LDB(B0, 1, 0); PG8_LDB(B1, 1, 1); PG8_SCHED; PG8_LDA(At, 1, 0); PG8_STAGE1(PG8_SA(0, 1), a2 + hstep, voffA);
            PG8_WAIT_V(7); PG8_WAIT_L(0); PG8_BAR; PG8_MMA(0, 0, At, B0); PG8_MMA(0, 1, At, B1); PG8_BAR; PG8_SCHED;
            PG8_LDA1(At, 1); PG8_STAGE(PG8_SB(1, 0), b3, voffB); PG8_STAGE(PG8_SB(1, 1), b3 + hstep, voffB); PG8_STAGE(PG8_SA(1, 0), a3, voffA);
            PG8_WAIT_V(7); PG8_WAIT_L(0); PG8_BAR; PG8_MMA1(0, At, B0); PG8_MMA1(1, At, B1); PG8_BAR; PG8_SCHED;
            } else {
            PG8_LDB(B0, 0, 0); PG8_SCHED; PG8_LDA(At, 0, 0); PG8_STAGE(PG8_SA(1, 1), a1 + hstep, voffA);
            PG8_WAIT_L(8); PG8_BAR; PG8_WAIT_L(0); PG8_MMA(0, 0, At, B0); PG8_BAR; PG8_SCHED;
            PG8_LDB(B1, 0, 1); PG8_STAGE(PG8_SB(0, 0), b2, voffB);
            PG8_BAR; PG8_WAIT_L(0); PG8_MMA(0, 1, At, B1); PG8_BAR;
            PG8_LDA(At, 0, 1); PG8_STAGE(PG8_SA(0, 0), a2, voffA);
            PG8_BAR; PG8_WAIT_L(0); PG8_MMA(1, 0, At, B0); PG8_BAR; PG8_SCHED;
            PG8_STAGE(PG8_SB(0, 1), b2 + hstep, voffB);
            PG8_WAIT_V(6); PG8_BAR; PG8_MMA(1, 1, At, B1); PG8_BAR;
            PG8_LDB(B0, 1, 0); PG8_SCHED; PG8_LDA(At, 1, 0); PG8_STAGE(PG8_SA(0, 1), a2 + hstep, voffA);
            PG8_WAIT_L(8); PG8_BAR; PG8_WAIT_L(0); PG8_MMA(0, 0, At, B0); PG8_BAR; PG8_SCHED;
            PG8_LDB(B1, 1, 1); PG8_STAGE(PG8_SB(1, 0), b3, voffB);
            PG8_BAR; PG8_WAIT_L(0); PG8_MMA(0, 1, At, B1); PG8_BAR;
            PG8_LDA(At, 1, 1); PG8_STAGE(PG8_SA(1, 0), a3, voffA);
            PG8_BAR; PG8_WAIT_L(0); PG8_MMA(1, 0, At, B0); PG8_BAR; PG8_SCHED;
            PG8_STAGE(PG8_SB(1, 1), b3 + hstep, voffB);
            PG8_WAIT_V(6); PG8_BAR; PG8_MMA(1, 1, At, B1); PG8_BAR;
            }
        }
        if constexpr (ALIGN_EPI) { if (wr == 0) PG8_BAR; }
        if constexpr (!Epi::AFTER_DRAIN) { E(acc, cur, wr, wc, fr, fq); S.done(cur); }
        if (!has_next) break;
#pragma unroll
        for (int a = 0; a < 2; ++a)
#pragma unroll
            for (int b = 0; b < 2; ++b)
#pragma unroll
                for (int m = 0; m < 4; ++m)
#pragma unroll
                    for (int n = 0; n < 2; ++n) acc[a][b][m][n] = (f32x4){0.f, 0.f, 0.f, 0.f};
        cur = nxt; cA = nA; cB = nB; ++ui;
        if constexpr (ALIGN_EPI) { if (wr == 1) PG8_BAR; }
    }
    PG8_WAIT_V(0);
    if constexpr (!ALIGN_EPI) { if (wr == 0) PG8_BAR; }
    PG8_BAR;
    if constexpr (Epi::AFTER_DRAIN) { E.fused(acc, cur, wr, wc, fr, fq, lds, wid, lane); S.done(cur); }
#undef PG8_SA
#undef PG8_SB
#undef PG8_STAGE
#undef PG8_LDA
#undef PG8_LDB
#undef PG8_MMA
#undef PG8_STAGE1
#undef PG8_LDA1
#undef PG8_MMA1
#undef PG8_WAIT_V
#undef PG8_WAIT_L
#undef PG8_BAR
#undef PG8_SCHED
}
}
constexpr int D = 1024, MP = 8192, MS = 4096, M = MP + MS, FF = 4096, NL = 4;
constexpr int NWAVES = 8, NTHR = 512;
constexpr size_t MiB = 1u << 20;
constexpr size_t WS_MOD = 1 * MiB;
constexpr size_t WS_W = 2 * MiB;
constexpr size_t WS_X = 94 * MiB;
constexpr size_t WS_H = 142 * MiB;
constexpr size_t WS_R = 166 * MiB;
constexpr size_t WS_CK = 262 * MiB, WS_CV = 266 * MiB, WS_SHW = 270 * MiB, WS_SS = 271 * MiB, WS_END = 272 * MiB;
constexpr size_t MEL = 1u << 20;
constexpr size_t W_QKV = 0, W_O = 6 * MEL, W_PW1 = 8 * MEL, W_PW2 = 12 * MEL, W_UP = 14 * MEL, W_DOWN = 30 * MEL;
constexpr int LDS_BYTES = 163840, LDS_ST = LDS_BYTES - 16, LDS_KC = 112640;

#define LAS __attribute__((address_space(3)))
#define SB0() __builtin_amdgcn_sched_barrier(0)
typedef unsigned short bf16;
typedef float f32x4 __attribute__((ext_vector_type(4)));
typedef float f32x2 __attribute__((ext_vector_type(2)));
typedef unsigned u32x4 __attribute__((ext_vector_type(4)));
typedef unsigned u32x2 __attribute__((ext_vector_type(2)));
typedef short bf16x8 __attribute__((ext_vector_type(8)));
typedef short s16x4 __attribute__((ext_vector_type(4)));
typedef float f32x32 __attribute__((ext_vector_type(32)));

__device__ __forceinline__ unsigned f2bf(float f) { unsigned u = __builtin_bit_cast(unsigned, f); return (u + 0x7fffu + ((u >> 16) & 1u)) >> 16; }
__device__ __forceinline__ unsigned pk2(float lo, float hi) { unsigned r; asm("v_cvt_pk_bf16_f32 %0, %1, %2" : "=v"(r) : "v"(lo), "v"(hi)); return r; }
__device__ __forceinline__ float bflo(unsigned w) { return __builtin_bit_cast(float, w << 16); }
__device__ __forceinline__ float bfhi(unsigned w) { return __builtin_bit_cast(float, w & 0xffff0000u); }
__device__ __forceinline__ float shx(float v, int k, int lane) { return __builtin_bit_cast(float, __builtin_amdgcn_ds_bpermute((lane ^ k) << 2, __builtin_bit_cast(int, v))); }
__device__ __forceinline__ float wave_sum(float v, int lane) {
#pragma unroll
    for (int o = 1; o < 64; o <<= 1) v += shx(v, o, lane);
    return v;
}

template <bool GLU>
__device__ __forceinline__ void transpose_item(const float* W, int K, int N, bf16* WT, LAS float* scr, int item, int lane) {
    const int nblk = N / 32, kb = item / nblk, nb = item % nblk, k0 = 64 * kb, n0 = 32 * nb;
    { float tv[32];
#pragma unroll
      for (int i = 0; i < 32; ++i) tv[i] = __builtin_nontemporal_load(W + (size_t)(k0 + 2 * i + (lane >> 5)) * N + n0 + (lane & 31));
      __builtin_amdgcn_sched_barrier(0);
#pragma unroll
      for (int i = 0; i < 32; ++i) scr[(2 * i + (lane >> 5)) * 33 + (lane & 31)] = tv[i]; }
    asm volatile("s_waitcnt lgkmcnt(0)" ::: "memory");
    int d0 = n0;
    if (GLU) { const int nn = n0 & 1023; d0 = ((nn >> 7) << 8) + (nn & 127) + ((n0 >> 10) << 7); }
    const int c = lane & 7;
#pragma unroll
    for (int j = 0; j < 4; ++j) { const int n = (lane >> 3) + 8 * j; const LAS float* s = scr + (8 * c) * 33 + n;
        u32x4 o; o.x = pk2(s[0 * 33], s[1 * 33]); o.y = pk2(s[2 * 33], s[3 * 33]); o.z = pk2(s[4 * 33], s[5 * 33]); o.w = pk2(s[6 * 33], s[7 * 33]);
        *(u32x4*)(WT + (size_t)(d0 + n) * K + k0 + 8 * c) = o; }
    asm volatile("s_waitcnt lgkmcnt(0)" ::: "memory");
}

struct Ptrs {
    const float *x_prompt, *x_sample, *cache_k, *cache_v, *c, *c_ctx, *norm_g, *w_ada, *b_ada, *w_qkv, *w_o, *rpb, *w_pw1, *w_dw, *b_dw, *ln_g, *ln_b, *w_pw2, *w_up, *w_down, *final_g;
};

__device__ __forceinline__ void p0_phase(const Ptrs& P, unsigned char* ws, LAS unsigned char* lds, int tid, int lane, int wave, int G, int bid) {
    bf16* Wt = (bf16*)(ws + WS_W);
    const int gw = bid * NWAVES + wave, NGW = G * NWAVES;
    LAS float* scr = (LAS float*)(lds + wave * 16384);
    constexpr int NIT = 23552;
    for (int it = gw; it < NIT; it += NGW) {
        if (it < 7168) { const int i = it / 3584; int r = it % 3584;
            if (r < 1536) { transpose_item<false>(P.w_qkv + (size_t)i * D * 3 * D, D, 3 * D, Wt + W_QKV + (size_t)i * 3 * MEL, scr, r, lane); continue; } r -= 1536;
            if (r < 512) { transpose_item<false>(P.w_o + (size_t)i * D * D, D, D, Wt + W_O + (size_t)i * MEL, scr, r, lane); continue; } r -= 512;
            if (r < 1024) { transpose_item<true>(P.w_pw1 + (size_t)i * D * 2 * D, D, 2 * D, Wt + W_PW1 + (size_t)i * 2 * MEL, scr, r, lane); continue; } r -= 1024;
            transpose_item<false>(P.w_pw2 + (size_t)i * D * D, D, D, Wt + W_PW2 + (size_t)i * MEL, scr, r, lane);
        } else { const int l = (it - 7168) / 4096; int r = (it - 7168) % 4096;
            if (r < 2048) transpose_item<false>(P.w_up + (size_t)l * D * FF, D, FF, Wt + W_UP + (size_t)l * 4 * MEL, scr, r, lane);
            else transpose_item<false>(P.w_down + (size_t)l * D * FF, FF, D, Wt + W_DOWN + (size_t)l * 4 * MEL, scr, r - 2048, lane);
        }
    }
    { bf16* CK = (bf16*)(ws + WS_CK); bf16* CV = (bf16*)(ws + WS_CV);
      const int NT = G * NTHR; constexpr int NV = 2 * 4 * 2 * 256 * 1024 / 8;
      for (int v = bid * NTHR + tid; v < NV; v += NT) { const int which = v >= NV / 2; const int e = (which ? v - NV / 2 : v) * 8;
          const float* src = (which ? P.cache_v : P.cache_k) + e; const f32x4 a = __builtin_nontemporal_load((const f32x4*)src), b = __builtin_nontemporal_load((const f32x4*)(src + 4));
          u32x4 o; o.x = pk2(a[0], a[1]); o.y = pk2(a[2], a[3]); o.z = pk2(b[0], b[1]); o.w = pk2(b[2], b[3]);
          *(u32x4*)((which ? CV : CK) + e) = o; } }
    { f32x4* z = (f32x4*)(ws + WS_SS); const int NT = G * NTHR; float zf = 0.f; asm volatile("" : "+v"(zf));
      const f32x4 zz = (f32x4){zf, zf, zf, zf}; for (int v = bid * NTHR + tid; v < 9 * M / 4; v += NT) z[v] = zz; }
    __syncthreads();
    { LAS float* sil = (LAS float*)lds; LAS float* red = (LAS float*)(lds + 20480); float* mod = (float*)(ws + WS_MOD);
      for (int k = tid; k < 5 * 1024; k += NTHR) { const int cc = k >> 10, kk = k & 1023; const float v = cc == 0 ? P.c_ctx[kk] : P.c[(cc - 1) * 1024 + kk]; sil[k] = v / (1.f + __expf(-v)); }
      __syncthreads();
      const int kg = tid >> 4, cl = tid & 15; const bool cact = cl < 12;
      for (int item = bid; item < 512; item += G) { const int l = item >> 7, n0 = (item & 127) * 48;
          const float* W = P.w_ada + (size_t)l * D * 6144 + n0 + 4 * cl;
          f32x4 a[5];
#pragma unroll
          for (int cc = 0; cc < 5; ++cc) a[cc] = (f32x4){0.f, 0.f, 0.f, 0.f};
#pragma unroll 4
          for (int kk = 0; kk < 32; ++kk) { const int k = kg * 32 + kk; f32x4 w = (f32x4){0.f, 0.f, 0.f, 0.f}; if (cact) w = __builtin_nontemporal_load((const f32x4*)(W + (size_t)k * 6144));
#pragma unroll
              for (int cc = 0; cc < 5; ++cc) a[cc] += sil[cc * 1024 + k] * w; }
#pragma unroll
          for (int cc = 0; cc < 5; ++cc) *(LAS f32x4*)(red + (kg * 5 + cc) * 64 + 4 * cl) = a[cc];
          __syncthreads();
          if (tid < 320 && (tid & 63) < 48) { const int cc = tid >> 6, n = tid & 63; float s = 0.f;
#pragma unroll 8
              for (int g = 0; g < 32; ++g) s += red[(g * 5 + cc) * 64 + n];
              mod[(size_t)(l * 5 + cc) * 6144 + n0 + n] = s + P.b_ada[l * 6144 + n0 + n]; }
          __syncthreads();
      } }
}

__device__ __forceinline__ void norm_phase(const float* xp, const float* xs, bf16* H, float* yout, const float* g, const float* shift, const float* scale, int gw, int NGW, int lane) {
    f32x4 gv[4];
#pragma unroll
    for (int j = 0; j < 4; ++j) gv[j] = *(const f32x4*)(g + 4 * (lane + 64 * j));
    for (int m = gw; m < M; m += NGW) {
        const float* xrow = m < MP ? xp + (size_t)m * D : xs + (size_t)(m - MP) * D;
        const int cond = m < MP ? 0 : 1 + ((m - MP) >> 10);
        f32x4 v[4]; float ss = 0.f;
#pragma unroll
        for (int j = 0; j < 4; ++j) { v[j] = *(const f32x4*)(xrow + 4 * (lane + 64 * j)); ss += (v[j][0] * v[j][0] + v[j][1] * v[j][1]) + (v[j][2] * v[j][2] + v[j][3] * v[j][3]); }
        const float r = 1.0f / sqrtf(wave_sum(ss, lane) * (1.f / D) + 1e-6f);
        if (yout) {
#pragma unroll
            for (int j = 0; j < 4; ++j) *(f32x4*)(yout + (size_t)m * D + 4 * (lane + 64 * j)) = v[j] * r * gv[j];
        } else {
#pragma unroll
            for (int j = 0; j < 4; ++j) { const f32x4 sc = *(const f32x4*)(scale + cond * 6144 + 4 * (lane + 64 * j)), sh = *(const f32x4*)(shift + cond * 6144 + 4 * (lane + 64 * j));
                const f32x4 h = (v[j] * r * gv[j]) * (1.f + sc) + sh; u32x2 o; o.x = pk2(h[0], h[1]); o.y = pk2(h[2], h[3]);
                *(u32x2*)(H + (size_t)m * D + 4 * (lane + 64 * j)) = o; }
        }
    }
}

template <class F, int... I> __device__ __forceinline__ void sfor_impl(F&& f, std::integer_sequence<int, I...>) { (f(std::integral_constant<int, I>{}), ...); }
template <int N, class F> __device__ __forceinline__ void sfor(F&& f) { sfor_impl(f, std::make_integer_sequence<int, N>{}); }
__device__ __forceinline__ float dpp_add(float v, int ctrl_b1, int ctrl_4e, int dummy) { return v; }
__device__ __forceinline__ float wave_sum_dpp(float v) {
    v += __builtin_bit_cast(float, __builtin_amdgcn_update_dpp(0, __builtin_bit_cast(int, v), 0xB1, 0xf, 0xf, false));
    v += __builtin_bit_cast(float, __builtin_amdgcn_update_dpp(0, __builtin_bit_cast(int, v), 0x4E, 0xf, 0xf, false));
    v += __builtin_bit_cast(float, __builtin_amdgcn_update_dpp(0, __builtin_bit_cast(int, v), 0x141, 0xf, 0xf, false));
    v += __builtin_bit_cast(float, __builtin_amdgcn_update_dpp(0, __builtin_bit_cast(int, v), 0x140, 0xf, 0xf, false));
    const int vi = __builtin_bit_cast(int, v);
    return (__builtin_bit_cast(float, __builtin_amdgcn_readlane(vi, 0)) + __builtin_bit_cast(float, __builtin_amdgcn_readlane(vi, 16))) +
           (__builtin_bit_cast(float, __builtin_amdgcn_readlane(vi, 32)) + __builtin_bit_cast(float, __builtin_amdgcn_readlane(vi, 48)));
}
constexpr int CT = 16, CROWS = CT + 30, CCH = (CROWS + 15) / 16;
__device__ __forceinline__ void conv_phase(const bf16* U, bf16* Vc, const float* wdw, const float* bdw, const float* lng, const float* lnb, LAS unsigned char* lds, int tid, int lane, int wave, int G, int bid) {
    f32x2 w[31];
    sfor<31>([&](auto K) __attribute__((always_inline)) { constexpr int k = decltype(K)::value; w[k] = *(const f32x2*)(wdw + k * D + 2 * tid); });
    const f32x2 bd = *(const f32x2*)(bdw + 2 * tid), lg = *(const f32x2*)(lng + 2 * tid), lb = *(const f32x2*)(lnb + 2 * tid);
    LAS f32x2* part = (LAS f32x2*)lds;
    LAS f32x2* stats = part + 8 * CT;
    for (int unit = bid; unit < M / CT; unit += G) {
        const int m0 = unit * CT, seg = m0 < MP ? 0 : MP, L = m0 < MP ? 256 : 1024, t0 = (m0 - seg) & (L - 1);
        const bf16* Ub = U + (size_t)(m0 - t0) * D + 2 * tid;
        f32x2 acc[CT];
        sfor<CT>([&](auto O) __attribute__((always_inline)) { acc[decltype(O)::value] = bd; });
        sfor<CCH>([&](auto C) __attribute__((always_inline)) { constexpr int c = decltype(C)::value;
            unsigned raw[16];
            sfor<16>([&](auto I) __attribute__((always_inline)) { constexpr int i = decltype(I)::value, j = c * 16 + i;
                if constexpr (j < CROWS) { const int t = t0 - 15 + j, tc = min(max(t, 0), L - 1);
                    raw[i] = *(const unsigned*)(Ub + (size_t)tc * D); } });
            SB0();
            sfor<16>([&](auto I) __attribute__((always_inline)) { constexpr int i = decltype(I)::value, j = c * 16 + i;
                if constexpr (j < CROWS) { const int t = t0 - 15 + j; const unsigned rm = raw[i] & (unsigned)(-(int)((t >= 0) & (t < L))); const f32x2 u = (f32x2){bflo(rm), bfhi(rm)};
                    sfor<31>([&](auto K) __attribute__((always_inline)) { constexpr int k = decltype(K)::value, o = j - k;
                        if constexpr (o >= 0 && o < CT) acc[o] += u * w[k]; }); } });
        });
        sfor<CT>([&](auto O) __attribute__((always_inline)) { constexpr int o = decltype(O)::value;
            const float s = wave_sum_dpp(acc[o].x + acc[o].y), q = wave_sum_dpp(acc[o].x * acc[o].x + acc[o].y * acc[o].y); if (lane == 0) part[wave * CT + o] = (f32x2){s, q}; });
        __syncthreads();
        if (tid < CT) { float s = 0.f, q = 0.f;
#pragma unroll
            for (int wv = 0; wv < 8; ++wv) { const f32x2 p = part[wv * CT + tid]; s += p.x; q += p.y; }
            const float mean = s * (1.f / D), var = fmaxf(q * (1.f / D) - mean * mean, 0.f); stats[tid] = (f32x2){mean, 1.0f / sqrtf(var + 1e-5f)}; }
        __syncthreads();
        sfor<CT>([&](auto O) __attribute__((always_inline)) { constexpr int o = decltype(O)::value;
            const f32x2 st = stats[o]; f32x2 y = (acc[o] - st.x) * st.y * lg + lb;
            y.x = y.x * __builtin_amdgcn_rcpf(1.f + __expf(-y.x)); y.y = y.y * __builtin_amdgcn_rcpf(1.f + __expf(-y.y));
            *(unsigned*)(Vc + (size_t)(m0 + o) * D + 2 * tid) = pk2(y.x, y.y); });
        __syncthreads();
    }
}

__device__ __forceinline__ void final_norm_phase(const bf16* X, float* yout, const float* g, int gw, int NGW, int lane) {
    f32x4 gv[4];
#pragma unroll
    for (int j = 0; j < 4; ++j) gv[j] = *(const f32x4*)(g + 16 * lane + 4 * j);
    for (int m = gw; m < M; m += NGW) {
        const bf16* xr = X + (size_t)m * D + 16 * lane;
        const u32x4 w0 = *(const u32x4*)xr, w1 = *(const u32x4*)(xr + 8);
        f32x4 v[4]; v[0] = (f32x4){bflo(w0[0]), bfhi(w0[0]), bflo(w0[1]), bfhi(w0[1])}; v[1] = (f32x4){bflo(w0[2]), bfhi(w0[2]), bflo(w0[3]), bfhi(w0[3])};
        v[2] = (f32x4){bflo(w1[0]), bfhi(w1[0]), bflo(w1[1]), bfhi(w1[1])}; v[3] = (f32x4){bflo(w1[2]), bfhi(w1[2]), bflo(w1[3]), bfhi(w1[3])};
        float sq = 0.f;
#pragma unroll
        for (int j = 0; j < 4; ++j) sq += (v[j][0] * v[j][0] + v[j][1] * v[j][1]) + (v[j][2] * v[j][2] + v[j][3] * v[j][3]);
        const float r = 1.0f / sqrtf(wave_sum_dpp(sq) * (1.f / D) + 1e-6f);
#pragma unroll
        for (int j = 0; j < 4; ++j) __builtin_nontemporal_store(v[j] * r * gv[j], (f32x4*)(yout + (size_t)m * D + 16 * lane + 4 * j));
    }
}

__device__ __forceinline__ void prep_phase(const float* xp, const float* xs, bf16* H, float* ss0, const float* g, const float* scale, const float* mod, const bf16* Wt, float* shw, int gw, int NGW, int lane) {
    { f32x4 gv[4];
#pragma unroll
      for (int j = 0; j < 4; ++j) gv[j] = *(const f32x4*)(g + 4 * (lane + 64 * j));
      for (int m = gw; m < M; m += NGW) {
          const float* xrow = m < MP ? xp + (size_t)m * D : xs + (size_t)(m - MP) * D;
          const int cond = m < MP ? 0 : 1 + ((m - MP) >> 10);
          f32x4 v[4]; float sq = 0.f;
#pragma unroll
          for (int j = 0; j < 4; ++j) { v[j] = *(const f32x4*)(xrow + 4 * (lane + 64 * j)); sq += (v[j][0] * v[j][0] + v[j][1] * v[j][1]) + (v[j][2] * v[j][2] + v[j][3] * v[j][3]); }
          sq = wave_sum_dpp(sq); if (lane == 0) ss0[m] = sq;
          f32x4 sc[4];
#pragma unroll
          for (int j = 0; j < 4; ++j) sc[j] = *(const f32x4*)(scale + cond * 6144 + 4 * (lane + 64 * j));
#pragma unroll
          for (int j = 0; j < 4; ++j) { const f32x4 h = v[j] * gv[j] * (1.f + sc[j]); u32x2 o; o.x = pk2(h[0], h[1]); o.y = pk2(h[2], h[3]);
              *(u32x2*)(H + (size_t)m * D + 4 * (lane + 64 * j)) = o; }
      } }
    for (int it = gw; it < 4 * 8192; it += NGW) {
        const int l = it >> 13, which = (it >> 12) & 1, n = it & 4095, i = l >> 1; const bool conv = (l & 1) != 0;
        const int N = which ? 4096 : (conv ? 2048 : 3072);
        if (n >= N) continue;
        const bf16* wrow = Wt + (which ? W_UP + (size_t)l * 4 * MEL : (conv ? W_PW1 + (size_t)i * 2 * MEL : W_QKV + (size_t)i * 3 * MEL)) + (size_t)n * D + 16 * lane;
        const u32x4 w0 = *(const u32x4*)wrow, w1 = *(const u32x4*)(wrow + 8);
        float wv[16];
#pragma unroll
        for (int e = 0; e < 4; ++e) { wv[2 * e] = bflo(w0[e]); wv[2 * e + 1] = bfhi(w0[e]); wv[8 + 2 * e] = bflo(w1[e]); wv[8 + 2 * e + 1] = bfhi(w1[e]); }
#pragma unroll
        for (int cond = 0; cond < 5; ++cond) { const float* sh = mod + (size_t)(l * 5 + cond) * 6144 + (which ? 3 : 0) * 1024 + 16 * lane; float dot = 0.f;
#pragma unroll
            for (int q = 0; q < 4; ++q) { const f32x4 s4 = *(const f32x4*)(sh + 4 * q); dot += (s4[0] * wv[4 * q] + s4[1] * wv[4 * q + 1]) + (s4[2] * wv[4 * q + 2] + s4[3] * wv[4 * q + 3]); }
            dot = wave_sum_dpp(dot); if (lane == 0) shw[(size_t)((l * 2 + which) * 5 + cond) * 4096 + n] = dot; }
    }
}

constexpr float SCL = 0.125f * 1.4426950408889634f, LOG2E = 1.4426950408889634f;
__device__ __forceinline__ void vt_write(LAS bf16* Vt, int pitch, int slot, int chunk, u32x4 v) {
    LAS bf16* p = Vt + (8 * chunk) * pitch + slot;
    p[0] = (bf16)(v.x & 0xffffu); p[pitch] = (bf16)(v.x >> 16); p[2 * pitch] = (bf16)(v.y & 0xffffu); p[3 * pitch] = (bf16)(v.y >> 16);
    p[4 * pitch] = (bf16)(v.z & 0xffffu); p[5 * pitch] = (bf16)(v.z >> 16); p[6 * pitch] = (bf16)(v.w & 0xffffu); p[7 * pitch] = (bf16)(v.w >> 16);
}
template <int NB> __device__ __forceinline__ void softmax_part(f32x4 (&s)[NB], float& mx_out, float& sum_out, int lane, float m_floor = -INFINITY) {
    float mx = m_floor;
#pragma unroll
    for (int b = 0; b < NB; ++b) mx = fmaxf(mx, fmaxf(fmaxf(s[b][0], s[b][1]), fmaxf(s[b][2], s[b][3])));
    mx = fmaxf(mx, shx(mx, 16, lane)); mx = fmaxf(mx, shx(mx, 32, lane));
    float sum = 0.f;
#pragma unroll
    for (int b = 0; b < NB; ++b) {
#pragma unroll
        for (int e = 0; e < 4; ++e) { s[b][e] = __builtin_amdgcn_exp2f(s[b][e] - mx); sum += s[b][e]; } }
    sum += shx(sum, 16, lane); sum += shx(sum, 32, lane);
    mx_out = mx; sum_out = sum;
}
__device__ __forceinline__ bf16x8 pack_p(const f32x4& a, const f32x4& b) {
    u32x4 w; w.x = pk2(a[0], a[1]); w.y = pk2(a[2], a[3]); w.z = pk2(b[0], b[1]); w.w = pk2(b[2], b[3]); return __builtin_bit_cast(bf16x8, w);
}
__device__ __forceinline__ bf16x8 vt_read(const LAS bf16* p0, const LAS bf16* p1) {
    const s16x4 a = *(const LAS s16x4*)p0, b = *(const LAS s16x4*)p1; return (bf16x8){a[0], a[1], a[2], a[3], b[0], b[1], b[2], b[3]};
}
__device__ __forceinline__ f32x4 qk_block(const bf16* kp, const bf16x8& qf0, const bf16x8& qf1) {
    const bf16x8 k0 = *(const bf16x8*)kp, k1 = *(const bf16x8*)(kp + 32);
    f32x4 a = __builtin_amdgcn_mfma_f32_16x16x32_bf16(k0, qf0, (f32x4){0.f, 0.f, 0.f, 0.f}, 0, 0, 0);
    return __builtin_amdgcn_mfma_f32_16x16x32_bf16(k1, qf1, a, 0, 0, 0);
}
#define PV16(o, s, SLOT_EXPR, PITCH_) do { _Pragma("unroll") for (int pp = 0; pp < 8; ++pp) { const bf16x8 pf = pack_p(s[2 * pp], s[2 * pp + 1]); const int slot0 = (SLOT_EXPR); \
        _Pragma("unroll") for (int db = 0; db < 4; ++db) { const LAS bf16* vp = Vt + (16 * db + l15) * (PITCH_) + slot0; \
            o[db] = __builtin_amdgcn_mfma_f32_16x16x32_bf16(vt_read(vp, vp + 16), pf, o[db], 0, 0, 0); } } } while (0)

#ifndef CBN
#define CBN 4
#endif
__device__ __forceinline__ void attn_phase(const bf16* Qb, const bf16* Kb, const bf16* Vb, bf16* Ob, const bf16* CK, const bf16* CV, const float* rpb  ,
                                           int li, LAS unsigned char* lds, int tid, int lane, int wave, int G, int bid, int ulo, int uhi) {
    LAS bf16* Vt = (LAS bf16*)lds; LAS float* rpl = (LAS float*)(lds + 110592); LAS unsigned char* Kc = lds + LDS_KC;
    for (int u = bid + ulo; u < uhi; u += G) {
        int lz_ = lane; asm volatile("" : "+v"(lz_));
        const int l15 = lz_ & 15, g = lz_ >> 4;
        if (u < 512) {
            const int b = u >> 4, h = u & 15; constexpr int PITCH = 264;
            const int qrow0 = b * 256 + 32 * wave + l15;
            const bf16x8 qa0 = *(const bf16x8*)(Qb + (size_t)qrow0 * D + h * 64 + 8 * g), qa1 = *(const bf16x8*)(Qb + (size_t)qrow0 * D + h * 64 + 32 + 8 * g);
            const bf16x8 qb0 = *(const bf16x8*)(Qb + (size_t)(qrow0 + 16) * D + h * 64 + 8 * g), qb1 = *(const bf16x8*)(Qb + (size_t)(qrow0 + 16) * D + h * 64 + 32 + 8 * g);
            SB0();
            { int t2 = tid; asm volatile("" : "+v"(t2));
              const int key = t2 & 255, c0 = (t2 >> 8) * 4; const bf16* src = Vb + (size_t)(b * 256 + key) * D + h * 64 + 8 * c0; const bf16* ksrc = Kb + (size_t)(b * 256 + key) * D + h * 64 + 8 * c0;
              u32x4 v[4], kv[4];
#pragma unroll
              for (int c = 0; c < 4; ++c) { v[c] = *(const u32x4*)(src + 8 * c); kv[c] = *(const u32x4*)(ksrc + 8 * c); }
              SB0();
#pragma unroll
              for (int c = 0; c < 4; ++c) *(LAS u32x4*)(Kc + key * 144 + (c0 + c) * 16) = kv[c];
#pragma unroll
              for (int c = 0; c < 4; ++c) vt_write(Vt, PITCH, key, c0 + c, v[c]); }
            __syncthreads();
            SB0();
            f32x4 s0[16], s1[16];
            { const LAS unsigned char* kl = Kc + l15 * 144 + g * 16;
              sfor<16>([&](auto I) __attribute__((always_inline)) { constexpr int kb = decltype(I)::value;
                const bf16x8 k0 = *(const LAS bf16x8*)(kl + kb * (16 * 144)), k1 = *(const LAS bf16x8*)(kl + kb * (16 * 144) + 64);
                f32x4 a = __builtin_amdgcn_mfma_f32_16x16x32_bf16(k0, qa0, (f32x4){0.f, 0.f, 0.f, 0.f}, 0, 0, 0); s0[kb] = __builtin_amdgcn_mfma_f32_16x16x32_bf16(k1, qa1, a, 0, 0, 0) * SCL;
                f32x4 c = __builtin_amdgcn_mfma_f32_16x16x32_bf16(k0, qb0, (f32x4){0.f, 0.f, 0.f, 0.f}, 0, 0, 0); s1[kb] = __builtin_amdgcn_mfma_f32_16x16x32_bf16(k1, qb1, c, 0, 0, 0) * SCL; }); }
            { float mx, sum; softmax_part<16>(s0, mx, sum, lane);
              f32x4 o[4];
#pragma unroll
              for (int db = 0; db < 4; ++db) o[db] = (f32x4){0.f, 0.f, 0.f, 0.f};
              PV16(o, s0, 32 * pp + 4 * g, PITCH);
              const float rl = 1.0f / sum;
#pragma unroll
              for (int db = 0; db < 4; ++db) { const f32x4 ov = o[db] * rl; u32x2 w; w.x = pk2(ov[0], ov[1]); w.y = pk2(ov[2], ov[3]);
                  *(u32x2*)(Ob + (size_t)qrow0 * D + h * 64 + 16 * db + 4 * g) = w; } }
            { float mx, sum; softmax_part<16>(s1, mx, sum, lane);
              f32x4 o[4];
#pragma unroll
              for (int db = 0; db < 4; ++db) o[db] = (f32x4){0.f, 0.f, 0.f, 0.f};
              PV16(o, s1, 32 * pp + 4 * g, PITCH);
              const float rl = 1.0f / sum;
#pragma unroll
              for (int db = 0; db < 4; ++db) { const f32x4 ov = o[db] * rl; u32x2 w; w.x = pk2(ov[0], ov[1]); w.y = pk2(ov[2], ov[3]);
                  *(u32x2*)(Ob + (size_t)(qrow0 + 16) * D + h * 64 + 16 * db + 4 * g) = w; } }
            __syncthreads();
        } else {
            const int ui = u - 512, xcd = ui & 7, idx = (ui >> 3) & 63, uu = (G == 256) ? ((xcd * 8 + (idx >> 3)) << 3) + (idx & 7) : ui;
            const int b = uu >> 7, h = (uu >> 3) & 15, rp = uu & 7, r0 = 2 * rp; constexpr int PITCH = 840;
            const int rs0 = min(max(r0 - 4, 0), 8);
            const size_t tokb = (size_t)MP + (size_t)b * 1024;
            const int r = r0 + (wave >> 2), j = wave & 3, rs = min(max(r - 4, 0), 8), rrel = rs - rs0, kcs = min(max(16 * j - 8, 0), 32);
            const int qcol = 16 * j + l15, wst = min(max(qcol - 8, 0), 48);
            const size_t qtok = tokb + r * 64 + qcol;
            const bf16* kloc = Kb + (tokb + rs * 64 + kcs + l15) * D + h * 64 + 8 * g;
            bf16x8 kf[16][2];
#define LOAD_KLOC(H) sfor<8>([&](auto I) __attribute__((always_inline)) { constexpr int lb = 8 * (H) + decltype(I)::value; const bf16* kp = kloc + (size_t)((lb >> 1) * 64 + 16 * (lb & 1)) * D; kf[lb][0] = *(const bf16x8*)kp; kf[lb][1] = *(const bf16x8*)(kp + 32); })
            LOAD_KLOC(0);
            const bf16x8 qf0 = *(const bf16x8*)(Qb + qtok * D + h * 64 + 8 * g), qf1 = *(const bf16x8*)(Qb + qtok * D + h * 64 + 32 + 8 * g);
            SB0();
            { int t2 = tid; asm volatile("" : "+v"(t2));
              const int slotA = t2, slotB = t2 + NTHR, slotBc = min(slotB, 831);
              const bf16* srcA = (slotA < 576) ? Vb + (tokb + min(rs0 + (slotA >> 6), 15) * 64 + (slotA & 63)) * D + h * 64 : CV + ((size_t)(b * 2 + li) * 256 + (slotA - 576)) * D + h * 64;
              const bf16* srcB = (slotBc < 576) ? Vb + (tokb + min(rs0 + (slotBc >> 6), 15) * 64 + (slotBc & 63)) * D + h * 64 : CV + ((size_t)(b * 2 + li) * 256 + (slotBc - 576)) * D + h * 64;
              const int key = t2 & 255, c0 = (t2 >> 8) * 4; const bf16* ksrc = CK + ((size_t)(b * 2 + li) * 256 + key) * D + h * 64 + 8 * c0;
              u32x4 va[8], vb[8], kv[4];
#pragma unroll
              for (int c = 0; c < 8; ++c) { va[c] = *(const u32x4*)(srcA + 8 * c); vb[c] = *(const u32x4*)(srcB + 8 * c); }
#pragma unroll
              for (int c = 0; c < 4; ++c) kv[c] = *(const u32x4*)(ksrc + 8 * c);
              const float rv = rpb[h * 465 + min(t2, 464)];
              SB0();
#pragma unroll
              for (int c = 0; c < 8; ++c) vt_write(Vt, PITCH, slotA, c, va[c]);
              if (slotB < 832) {
#pragma unroll
                  for (int c = 0; c < 8; ++c) vt_write(Vt, PITCH, slotB, c, vb[c]); }
#pragma unroll
              for (int c = 0; c < 4; ++c) *(LAS u32x4*)(Kc + key * 144 + (c0 + c) * 16) = kv[c];
              if (t2 < 465) rpl[t2] = rv; }
            SB0(); LOAD_KLOC(1); SB0();
            __syncthreads();
            SB0();
            f32x4 o1[4]; float m1, l1, m2, l2;
#pragma unroll
            for (int db = 0; db < 4; ++db) o1[db] = (f32x4){0.f, 0.f, 0.f, 0.f};
            {
                int dcv[8]; unsigned vmask = 0u;
#pragma unroll
                for (int ce = 0; ce < 8; ++ce) { const int kc = kcs + 16 * (ce >> 2) + 4 * g + (ce & 3); vmask |= ((kc >= wst) && (kc < wst + 16)) ? (1u << ce) : 0u; dcv[ce] = min(max(kc - qcol + 15, 0), 30); }
                f32x4 s[16];
#define QK_LOC(H) sfor<8>([&](auto I) __attribute__((always_inline)) { constexpr int lb = 8 * (H) + decltype(I)::value, krow = lb >> 1, ch = lb & 1; \
                    f32x4 a = __builtin_amdgcn_mfma_f32_16x16x32_bf16(kf[lb][0], qf0, (f32x4){0.f, 0.f, 0.f, 0.f}, 0, 0, 0); a = __builtin_amdgcn_mfma_f32_16x16x32_bf16(kf[lb][1], qf1, a, 0, 0, 0); \
                    const LAS float* rp_row = rpl + (rs + krow - r + 7) * 31; float bias[4]; \
                    _Pragma("unroll") for (int e = 0; e < 4; ++e) bias[e] = rp_row[dcv[ch * 4 + e]]; \
                    _Pragma("unroll") for (int e = 0; e < 4; ++e) { const float t = a[e] * SCL + bias[e] * LOG2E; a[e] = ((vmask >> (ch * 4 + e)) & 1u) ? t : -INFINITY; } \
                    s[lb] = a; })
                QK_LOC(0); QK_LOC(1); SB0();
                softmax_part<16>(s, m1, l1, lane);
                PV16(o1, s, (rrel + pp) * 64 + kcs + 4 * g, PITCH);
            }
            SB0();
            {
                f32x4 s[16];
                { const LAS unsigned char* kl = Kc + l15 * 144 + g * 16;
                  sfor<16>([&](auto I) __attribute__((always_inline)) { constexpr int cb = decltype(I)::value;
                    const bf16x8 k0 = *(const LAS bf16x8*)(kl + cb * (16 * 144)), k1 = *(const LAS bf16x8*)(kl + cb * (16 * 144) + 64);
                    f32x4 a = __builtin_amdgcn_mfma_f32_16x16x32_bf16(k0, qf0, (f32x4){0.f, 0.f, 0.f, 0.f}, 0, 0, 0); s[cb] = __builtin_amdgcn_mfma_f32_16x16x32_bf16(k1, qf1, a, 0, 0, 0) * SCL; }); }
                softmax_part<16>(s, m2, l2, lane, m1);
                const float a1 = __builtin_amdgcn_exp2f(m1 - m2);
#pragma unroll
                for (int db = 0; db < 4; ++db) o1[db] = o1[db] * a1;
                l1 = l1 * a1 + l2;
                PV16(o1, s, 576 + 32 * pp + 4 * g, PITCH);
            }
            const float rl = 1.0f / l1;
            int r2_ = r; asm volatile("" : "+s"(r2_));
            const size_t qtok2 = tokb + r2_ * 64 + qcol;
#pragma unroll
            for (int db = 0; db < 4; ++db) { const f32x4 ov = o1[db] * rl; u32x2 w; w.x = pk2(ov[0], ov[1]); w.y = pk2(ov[2], ov[3]);
                *(u32x2*)(Ob + qtok2 * D + h * 64 + 16 * db + 4 * g) = w; }
            __syncthreads();
        }
    }
}

#define RLX_AGENT __ATOMIC_RELAXED, __HIP_MEMORY_SCOPE_AGENT
#define XB_TMO      128
#define XB_XCNT(j)  (256  + 64 * (j))
#define XB_XSUB(j)  (1280 + 64 * (j))
#define XB_XGEN(j)  (2304 + 64 * (j))
#define XB_TOP      3328
#define XB_TOPGEN   3392
#define XCD_BAR_WORDS 3456
#define XB_SPIN_CAP (1u << 18)

__device__ __forceinline__ unsigned xb_ld(unsigned* p)              { return __hip_atomic_load(p, __ATOMIC_RELAXED, __HIP_MEMORY_SCOPE_AGENT); }
__device__ __forceinline__ unsigned xb_add(unsigned* p, unsigned v) { return __hip_atomic_fetch_add(p, v, __ATOMIC_RELAXED, __HIP_MEMORY_SCOPE_AGENT); }
__device__ __forceinline__ unsigned xb_xcc_id() { return (unsigned)__builtin_amdgcn_s_getreg((3 << 11) | 20) & 0xFu; }
#define XB_SPIN(cond, bar) do { unsigned _sp = 0; while (cond) { __builtin_amdgcn_s_sleep(1); \
    if ((++_sp & 255u) == 0u) { if (xb_ld(&(bar)[XB_TMO])) break; if (_sp > XB_SPIN_CAP) { atomicAdd(&(bar)[XB_TMO], 1u); break; } } } } while (0)

struct XcdBarrier {
    unsigned* bar; unsigned x;
    volatile LAS unsigned* st;
};

__device__ __forceinline__ XcdBarrier xcd_barrier_post(unsigned* bar, volatile LAS unsigned* st) {
    XcdBarrier b; b.bar = bar; b.x = xb_xcc_id(); b.st = st;
    if (threadIdx.x == 0) (void)xb_add(&bar[XB_XCNT(b.x)], 1u);
    return b;
}
__device__ __forceinline__ void xcd_barrier_complete(unsigned* bar, unsigned x, unsigned& nloc, unsigned& nx) {
    const unsigned G = gridDim.x * gridDim.y * gridDim.z;
    unsigned sum, cnt, mine, sp = 0u;
    for (;;) {
        sum = 0u; cnt = 0u; mine = 0u;
#pragma unroll
        for (unsigned j = 0; j < 16; ++j) { const unsigned c = xb_ld(&bar[XB_XCNT(j)]); sum += c; cnt += (c > 0u) ? 1u : 0u; mine = (j == x) ? c : mine; }
        if (sum == G) break;
        __builtin_amdgcn_s_sleep(1);
        if ((++sp & 255u) == 0u) { if (xb_ld(&bar[XB_TMO])) break; if (sp > XB_SPIN_CAP) { atomicAdd(&bar[XB_TMO], 1u); break; } }
    }
    nloc = mine > 0u ? mine : 1u; nx = cnt > 0u ? cnt : 1u;
}

__device__ __forceinline__ void xcd_barrier(const XcdBarrier& b) {
    asm volatile("s_waitcnt vmcnt(0)" ::: "memory");
    __syncthreads();
    if (threadIdx.x == 0) {
        unsigned* bar = b.bar;
        __builtin_amdgcn_s_waitcnt(0);
        unsigned nloc = b.st[0], nx = b.st[1];
        if (nloc == 0u) { xcd_barrier_complete(bar, b.x, nloc, nx); b.st[0] = nloc; b.st[1] = nx; }
        const unsigned old = xb_add(&bar[XB_XSUB(b.x)], 1u);
        const unsigned gen = old / nloc;
        if (old + 1u == (gen + 1u) * nloc) {
            __builtin_amdgcn_fence(__ATOMIC_RELEASE, "agent");
            asm volatile("s_waitcnt vmcnt(0)" ::: "memory");
            const unsigned og = xb_add(&bar[XB_TOP], 1u);
            const unsigned tg = og / nx;
            if (og + 1u == (tg + 1u) * nx) xb_add(&bar[XB_TOPGEN], 1u);
            else XB_SPIN(xb_ld(&bar[XB_TOPGEN]) == tg, bar);
            __builtin_amdgcn_fence(__ATOMIC_ACQUIRE, "agent");
            xb_add(&bar[XB_XGEN(b.x)], 1u);
            asm volatile("s_waitcnt vmcnt(0)" ::: "memory");
        } else {
            XB_SPIN(xb_ld(&bar[XB_XGEN(b.x)]) == gen, bar);
            __builtin_amdgcn_fence(__ATOMIC_ACQUIRE, "agent");
            asm volatile("s_waitcnt vmcnt(0)" ::: "memory");
        }
    }
    __syncthreads();
}

constexpr int NPH = 2 + 5 * NL + 1;
struct Args { const float* in[21]; float* out; unsigned char* ws; int nprog, pad; int prog[48]; };
typedef const __attribute__((address_space(4))) Args* KArgPtr;
__global__ void __launch_bounds__(NTHR, 2) fwd_kernel(Args a_unused) {
    extern __shared__ __attribute__((aligned(16))) unsigned char lds_raw[];
    LAS unsigned char* lds = (LAS unsigned char*)lds_raw;
    cg::grid_group grid = cg::this_grid();
    const int wave0 = __builtin_amdgcn_readfirstlane((int)threadIdx.x >> 6);
    { volatile LAS unsigned* st0 = (volatile LAS unsigned*)(lds + LDS_ST); if (threadIdx.x < 2) st0[threadIdx.x] = 0u; }
    __syncthreads();
    XcdBarrier xbar; { KArgPtr kpb = (KArgPtr)__builtin_amdgcn_kernarg_segment_ptr(); xbar.bar = (unsigned*)kpb->ws; xbar.x = 0; xbar.st = (volatile LAS unsigned*)(lds + LDS_ST);
        if (blockIdx.x == 0) { for (int wI = threadIdx.x; wI < XCD_BAR_WORDS; wI += NTHR) __hip_atomic_store(xbar.bar + wI, 0u, __ATOMIC_RELAXED, __HIP_MEMORY_SCOPE_AGENT); } }
    int nprog; { KArgPtr kp0 = (KArgPtr)__builtin_amdgcn_kernarg_segment_ptr(); nprog = kp0->nprog; }
    for (int pc = 0; pc < nprog; ++pc) {
        KArgPtr kp = (KArgPtr)__builtin_amdgcn_kernarg_segment_ptr(); asm volatile("" : "+s"(kp));
        int z_ = 0; asm volatile("" : "+s"(z_));
        const int lane_ = (int)__builtin_amdgcn_mbcnt_hi(~0u, __builtin_amdgcn_mbcnt_lo(~0u, (unsigned)z_)); const int tid_ = wave0 * 64 + lane_;
        int bid_ = (int)__builtin_amdgcn_workgroup_id_x(), G_ = (int)gridDim.x; asm volatile("" : "+s"(bid_), "+s"(G_));
        const int pe_ = kp->prog[pc]; const int ph = pe_ & 63, amode = pe_ >> 6;
        const int tid = tid_, lane = lane_, wave = wave0, G = G_, bid = bid_;
        const int gw = bid * NWAVES + wave, NGW = G * NWAVES;
        Ptrs P; P = Ptrs{kp->in[0], kp->in[1], kp->in[2], kp->in[3], kp->in[4], kp->in[5], kp->in[6], kp->in[7], kp->in[8], kp->in[9], kp->in[10], kp->in[11], kp->in[12], kp->in[13], kp->in[14], kp->in[15], kp->in[16], kp->in[17], kp->in[18], kp->in[19], kp->in[20]};
        unsigned char* ws = kp->ws; float* outp = kp->out;
        float* mod = (float*)(ws + WS_MOD); bf16* Wt = (bf16*)(ws + WS_W); bf16* X = (bf16*)(ws + WS_X); bf16* H = (bf16*)(ws + WS_H);
        bf16* R = (bf16*)(ws + WS_R); bf16* Qb = R; bf16* Kb = R + (size_t)M * D; bf16* Vb = R + (size_t)2 * M * D; bf16* Ob = R + (size_t)3 * M * D;
        bf16* Ub = R; bf16* Vc = R + (size_t)M * D; bf16* Fb = R;
        const bf16* CK = (const bf16*)(ws + WS_CK); const bf16* CV = (const bf16*)(ws + WS_CV);
        float* out_y = outp; float* out_ck = outp + (size_t)M * D; float* out_cv = out_ck + (size_t)32 * 2 * 256 * 1024;
        float* SS = (float*)(ws + WS_SS); float* SHW = (float*)(ws + WS_SHW);
        if (ph == 0) { p0_phase(P, ws, lds, tid, lane, wave, G, bid); }
        else if (ph == 1) { prep_phase(P.x_prompt, P.x_sample, H, SS, P.norm_g, mod + 1 * 1024, mod, Wt, SHW, gw, NGW, lane); }
        else if (ph == NPH - 1) { final_norm_phase(X, out_y, P.final_g, gw, NGW, lane); }
        else if (ph >= 60) { }
        else {
            const int l = (ph - 2) / 5, s = (ph - 2) % 5, i = l >> 1; const bool conv = (l & 1) != 0;
            const float* modl = mod + (size_t)l * 5 * 6144;
            if (s == 0) {
                const float* ssl = SS + (size_t)(2 * l) * M; const float* shl = SHW + (size_t)((2 * l) * 5) * 4096;
                if (!conv) { pg8::Gemm gm{H, Wt + W_QKV + (size_t)i * 3 * MEL, M, 3 * D, D}; pg8::StaticOrder S; S.init(M, 3 * D, G, bid);
                    pg8::EpiQKV E{ssl, shl, Qb, (size_t)M * D, out_ck + (size_t)i * 256 * 1024, (size_t)32 * 2 * 256 * 1024};
                    pg8::gemm_phase<pg8::EpiQKV, pg8::StaticOrder, true, true>(lds, gm, S, E, tid); }
                else { pg8::Gemm gm{H, Wt + W_PW1 + (size_t)i * 2 * MEL, M, 2 * D, D}; pg8::StaticOrder S; S.init(M, 2 * D, G, bid);
                    pg8::EpiGLU E{ssl, shl, Ub};
                    pg8::gemm_phase<pg8::EpiGLU, pg8::StaticOrder, true, true>(lds, gm, S, E, tid); }
            } else if (s == 1) {
                if (!conv) attn_phase(Qb, Kb, Vb, Ob, CK, CV, P.rpb + (size_t)i * 16 * 15 * 31, i, lds, tid, lane, wave, G, bid, amode == 2 ? 512 : 0, amode == 1 ? 512 : 1024);
                else conv_phase(Ub, Vc, P.w_dw + (size_t)i * 31 * D, P.b_dw + i * D, P.ln_g + i * D, P.ln_b + i * D, lds, tid, lane, wave, G, bid);
            } else if (s == 2 || s == 4) {
                pg8::Gemm gm; pg8::EpiRes E;
                if (s == 2) { gm = pg8::Gemm{conv ? Vc : Ob, Wt + (conv ? W_PW2 : W_O) + (size_t)i * MEL, M, D, D};
                    E = pg8::EpiRes{P.x_prompt, P.x_sample, l == 0 ? (const bf16*)nullptr : X, X, modl + 2 * 1024, H, P.norm_g + (l * 2 + 1) * D, modl + 4 * 1024, SS + (size_t)(2 * l + 1) * M}; }
                else { gm = pg8::Gemm{Fb, Wt + W_DOWN + (size_t)l * 4 * MEL, M, D, FF};
                    E = pg8::EpiRes{P.x_prompt, P.x_sample, X, X, modl + 5 * 1024, l < NL - 1 ? H : nullptr, P.norm_g + ((l + 1) * 2) * D, modl + 5 * 6144 + 1 * 1024, SS + (size_t)(2 * l + 2) * M}; }
                pg8::StaticOrder S; S.init(M, D, G, bid);
                pg8::gemm_phase<pg8::EpiRes, pg8::StaticOrder, true, true>(lds, gm, S, E, tid);
            } else {
                pg8::Gemm gm{H, Wt + W_UP + (size_t)l * 4 * MEL, M, FF, D}; pg8::StaticOrder S; S.init(M, FF, G, bid);
                pg8::EpiUp E{SS + (size_t)(2 * l + 1) * M, SHW + (size_t)((2 * l + 1) * 5) * 4096, Fb, FF};
                pg8::gemm_phase<pg8::EpiUp, pg8::StaticOrder, true, true>(lds, gm, S, E, tid);
            }
        }
        if (pc + 1 < nprog) { if (pc == 0) { grid.sync(); xbar = xcd_barrier_post(xbar.bar, xbar.st); } else xcd_barrier(xbar); }
    }
}

#ifndef SINGLE_LAUNCH
#define SINGLE_LAUNCH 0
#endif
extern "C" void kernel_launch(void* const* d_in, const int* in_sizes, int n_in, void* d_out, int out_size, void* d_ws, size_t ws_size, hipStream_t stream) {
    static int grid = 0;
    if (grid == 0) {
        if (n_in != 21 || ws_size < WS_END) { fprintf(stderr, "kernel_launch: unexpected n_in %d / ws_size %zu\n", n_in, ws_size); grid = -1; return; }
        int dev = 0, cus = 0, per_cu = 0;
        hipGetDevice(&dev); hipDeviceGetAttribute(&cus, hipDeviceAttributeMultiprocessorCount, dev);
        hipFuncSetAttribute((const void*)fwd_kernel, hipFuncAttributeMaxDynamicSharedMemorySize, LDS_BYTES);
        hipOccupancyMaxActiveBlocksPerMultiprocessor(&per_cu, (const void*)fwd_kernel, NTHR, LDS_BYTES);
        if (per_cu < 1) { fprintf(stderr, "kernel_launch: occupancy query says %d blocks/CU\n", per_cu); per_cu = 1; }
        (void)hipGetLastError();
        grid = cus * per_cu;
    }
    if (grid < 0) return;
    Args a{};
    for (int i = 0; i < 21; ++i) a.in[i] = (const float*)d_in[i];
    a.out = (float*)d_out; a.ws = (unsigned char*)d_ws;
#if SINGLE_LAUNCH
    { int n = 0;
      for (int ph = 0; ph < NPH; ++ph) { a.prog[n++] = ph;
#ifdef PROBE_ATTN_MODE
          if (ph >= 2 && ph < NPH - 1 && (ph - 2) % 5 == 1 && ((ph - 2) / 5) % 2 == 0) a.prog[n++] = ph | (PROBE_ATTN_MODE << 6);
#endif
#ifdef PROBE_EMPTY
          if (ph == 5) for (int q = 0; q < PROBE_EMPTY; ++q) a.prog[n++] = 60;
#endif
#ifdef PROBE_REPEAT_P0
          if (ph == 0) a.prog[n++] = 0;
#endif
#ifdef PROBE_REPEAT_S
          if (ph >= 2 && ph < NPH - 1 && (ph - 2) % 5 == PROBE_REPEAT_S && (PROBE_REPEAT_PAR < 0 || ((ph - 2) / 5) % 2 == PROBE_REPEAT_PAR)) a.prog[n++] = ph;
#endif
      }
      a.nprog = n; }
    void* args[] = {&a};
    hipError_t e = hipLaunchCooperativeKernel((const void*)fwd_kernel, dim3(grid), dim3(NTHR), args, LDS_BYTES, stream);
    if (e != hipSuccess) fprintf(stderr, "cooperative launch failed: %s (grid %d)\n", hipGetErrorString(e), grid);
#else
    for (int ph = 0; ph < NPH; ++ph) { a.nprog = 1; a.prog[0] = ph; hipLaunchKernelGGL(fwd_kernel, dim3(grid), dim3(NTHR), LDS_BYTES, stream, a); }
#endif
}
```

```cpp
#define SINGLE_LAUNCH 1
#define UP256 1
#include <hip/hip_runtime.h>
#include <hip/hip_cooperative_groups.h>
#include <cstdio>
#include <cstdint>
#include <cmath>
#include <utility>
namespace cg = cooperative_groups;
namespace pg8 {
#define PG8_LAS __attribute__((address_space(3)))
typedef unsigned short bf16_t;
typedef short bf16x8 __attribute__((ext_vector_type(8)));
typedef float f32x4 __attribute__((ext_vector_type(4)));
typedef unsigned u32x4 __attribute__((ext_vector_type(4)));
constexpr int RM = 192;
constexpr int BM = 256, BK = 64, HALF = 128, HTB = HALF * BK * 2  , STAGE_BYTES = 8 * HTB, NXCD = 8, WGM = 8;

__host__ __device__ __forceinline__ int lds_byte(int r, int c) { const int st = (r >> 4) * 2 + (c >> 5), rr = r & 15, cc = c & 31, ob = rr * 64 + cc * 2; return st * 1024 + (ob ^ (((ob >> 9) & 1) << 5)); }
__host__ __device__ __forceinline__ void stage_rc(int b, int& R, int& C) { const int st = b / 1024, sb = b % 1024, swz = sb ^ (((sb >> 9) & 1) << 5); R = (st >> 1) * 16 + swz / 64; C = (st & 1) * 32 + (swz % 64) / 2; }
__host__ __device__ __forceinline__ int perm32(int rho) { const int n = rho >> 4, i = rho & 15; return 8 * (i >> 2) + 4 * n + (i & 3); }

struct Unit { int pm, pn; };
struct Gemm { const bf16_t* A; const bf16_t* Bt; int M, N, K; };

struct StaticOrder {
    int nM, nN, nwg, G, c;
    __host__ __device__ void init(int M, int N, int G_, int c_) { nM = M / RM; nN = N / BM; nwg = nM * nN; G = G_; c = c_; }
    __host__ __device__ bool next(int i, Unit& u) const {
        const long L = (long)i * G + c; if (L >= nwg) return false;
        int wgid = (int)L; { const int q = nwg / NXCD, r = nwg % NXCD, xcd = wgid % NXCD, off = wgid / NXCD; wgid = (xcd < r ? xcd * (q + 1) : r * (q + 1) + (xcd - r) * q) + off; }
        const int nig = WGM * nN, gid = wgid / nig, fm = gid * WGM, gsz = (nM - fm) < WGM ? (nM - fm) : WGM;
        u.pm = fm + ((wgid % nig) % gsz); u.pn = (wgid % nig) / gsz; return true;
    }
    __device__ __forceinline__ void a_ready(const Unit&) const {}
    __device__ __forceinline__ void done(const Unit&) const {}
};

__device__ __forceinline__ unsigned cvt_pk_bf16(float lo, float hi) { unsigned r; asm volatile("v_cvt_pk_bf16_f32 %0, %1, %2" : "=v"(r) : "v"(lo), "v"(hi)); return r; }
typedef float f32x2 __attribute__((ext_vector_type(2)));
__device__ __forceinline__ int cond_of_row(int r) { return r < 8192 ? 0 : 1 + ((r - 8192) >> 10); }
__device__ __forceinline__ int half_row0(int ai, int wr) { return ai == 0 ? wr * 64 : 128 + wr * 32; }
#define EPI_MLOOP(ai, m) _Pragma("unroll") for (int m = 0; m < 4; ++m) if (ai == 0 || m < 2)
struct EpiQKV {
    static constexpr bool PERM = true, AFTER_DRAIN = false;
    const float* ss; const float* shw;
    bf16_t* Q; size_t qkv_stride; float* ck; size_t ckv_stride;
    __device__ __forceinline__ void operator()(const f32x4 (&acc)[2][2][4][2], const Unit& u, int wr, int wc, int fr, int fq) const {
        const int t = u.pn >> 2;
        bf16_t* base = Q + (size_t)t * qkv_stride;
        const int col0 = (u.pn & 3) * BM + wc * 32 + 8 * fq;
        float* cbase = ck + (size_t)(t > 0 ? t - 1 : 0) * ckv_stride + col0;
#pragma unroll
        for (int ai = 0; ai < 2; ++ai) { const int rbase = u.pm * RM + half_row0(ai, wr) + fr; const bool wc_ = (t > 0) && (rbase < 8192);
            const float* sp = shw + cond_of_row(rbase) * 4096 + u.pn * BM + wc * 32 + 8 * fq;
            f32x4 sv[2][2];
#pragma unroll
            for (int bj = 0; bj < 2; ++bj) { sv[bj][0] = *(const f32x4*)(sp + bj * HALF); sv[bj][1] = *(const f32x4*)(sp + bj * HALF + 4); }
            float rr[4];
            EPI_MLOOP(ai, m) rr[m] = ss[rbase + m * 16];
            EPI_MLOOP(ai, m) { const int row = rbase + m * 16; bf16_t* rowp = base + (size_t)row * 1024 + col0;
                const float r = __builtin_amdgcn_rsqf(rr[m] * (1.f / 1024.f) + 1e-6f);
                float* cp0 = cbase + ((size_t)(row >> 8) * 2 * 256 + (row & 255)) * 1024;
#pragma unroll
                for (int bj = 0; bj < 2; ++bj) { const f32x4 v0 = acc[ai][bj][m][0] * r + sv[bj][0], v1 = acc[ai][bj][m][1] * r + sv[bj][1];
                    u32x4 w; w.x = cvt_pk_bf16(v0[0], v0[1]); w.y = cvt_pk_bf16(v0[2], v0[3]); w.z = cvt_pk_bf16(v1[0], v1[1]); w.w = cvt_pk_bf16(v1[2], v1[3]);
                    *(u32x4*)(rowp + bj * HALF) = w;
                    if (wc_) { float* cp = cp0 + bj * HALF; __builtin_nontemporal_store(v0, (f32x4*)cp); __builtin_nontemporal_store(v1, (f32x4*)(cp + 4)); } } } }
    }
};
struct EpiUp {
    static constexpr bool PERM = true, AFTER_DRAIN = false;
    const float* ss; const float* shw; bf16_t* O; int ldc;
    __device__ __forceinline__ void operator()(const f32x4 (&acc)[2][2][4][2], const Unit& u, int wr, int wc, int fr, int fq) const {
        const int col0 = u.pn * BM + wc * 32 + 8 * fq;
#pragma unroll
        for (int ai = 0; ai < 2; ++ai) { const int rbase = u.pm * RM + half_row0(ai, wr) + fr;
            const float* sp = shw + cond_of_row(rbase) * 4096 + col0;
            f32x4 sv[2][2];
#pragma unroll
            for (int bj = 0; bj < 2; ++bj) { sv[bj][0] = *(const f32x4*)(sp + bj * HALF); sv[bj][1] = *(const f32x4*)(sp + bj * HALF + 4); }
            float rr[4];
            EPI_MLOOP(ai, m) rr[m] = ss[rbase + m * 16];
            EPI_MLOOP(ai, m) { bf16_t* rowp = O + (size_t)(rbase + m * 16) * ldc + col0;
                const float r = __builtin_amdgcn_rsqf(rr[m] * (1.f / 1024.f) + 1e-6f);
#pragma unroll
                for (int bj = 0; bj < 2; ++bj) { f32x4 v0 = acc[ai][bj][m][0] * r + sv[bj][0], v1 = acc[ai][bj][m][1] * r + sv[bj][1];
#pragma unroll
                    for (int e = 0; e < 4; ++e) { const float a = fmaxf(v0[e], 0.f), b = fmaxf(v1[e], 0.f); v0[e] = a * a; v1[e] = b * b; }
                    u32x4 w; w.x = cvt_pk_bf16(v0[0], v0[1]); w.y = cvt_pk_bf16(v0[2], v0[3]); w.z = cvt_pk_bf16(v1[0], v1[1]); w.w = cvt_pk_bf16(v1[2], v1[3]);
                    *(u32x4*)(rowp + bj * HALF) = w; } } }
    }
};
struct EpiGLU {
    static constexpr bool PERM = true, AFTER_DRAIN = false;
    const float* ss; const float* shw; bf16_t* O;
    __device__ __forceinline__ void operator()(const f32x4 (&acc)[2][2][4][2], const Unit& u, int wr, int wc, int fr, int fq) const {
        const int col0 = u.pn * HALF + wc * 32 + 8 * fq;
#pragma unroll
        for (int ai = 0; ai < 2; ++ai) { const int rbase = u.pm * RM + half_row0(ai, wr) + fr;
            const float* sp = shw + cond_of_row(rbase) * 4096 + u.pn * BM + wc * 32 + 8 * fq;
            f32x4 sv[2][2];
#pragma unroll
            for (int bj = 0; bj < 2; ++bj) { sv[bj][0] = *(const f32x4*)(sp + bj * HALF); sv[bj][1] = *(const f32x4*)(sp + bj * HALF + 4); }
            float rr[4];
            EPI_MLOOP(ai, m) rr[m] = ss[rbase + m * 16];
            EPI_MLOOP(ai, m) { bf16_t* rowp = O + (size_t)(rbase + m * 16) * 1024 + col0;
                const float r = __builtin_amdgcn_rsqf(rr[m] * (1.f / 1024.f) + 1e-6f);
                f32x4 v0 = acc[ai][0][m][0] * r + sv[0][0], v1 = acc[ai][0][m][1] * r + sv[0][1]; const f32x4 g0 = acc[ai][1][m][0] * r + sv[1][0], g1 = acc[ai][1][m][1] * r + sv[1][1];
#pragma unroll
                for (int e = 0; e < 4; ++e) { v0[e] = v0[e] * __builtin_amdgcn_rcpf(1.f + __expf(-g0[e])); v1[e] = v1[e] * __builtin_amdgcn_rcpf(1.f + __expf(-g1[e])); }
                u32x4 w; w.x = cvt_pk_bf16(v0[0], v0[1]); w.y = cvt_pk_bf16(v0[2], v0[3]); w.z = cvt_pk_bf16(v1[0], v1[1]); w.w = cvt_pk_bf16(v1[2], v1[3]);
                *(u32x4*)rowp = w; } }
    }
};
struct EpiRes {
    static constexpr bool PERM = false, AFTER_DRAIN = false;
    const float* base_p; const float* base_s; const bf16_t* base_b; bf16_t* out; const float* gate;
    bf16_t* xb; const float* g_next; const float* sc_next; float* ss_next;
    __device__ __forceinline__ void operator()(const f32x4 (&acc)[2][2][4][2], const Unit& u, int wr, int wc, int fr, int fq) const {
        typedef unsigned u32x2e __attribute__((ext_vector_type(2)));
        const int col0 = u.pn * BM + wc * 32 + 4 * fq;
        const int lane_x = fq * 16 + fr;
#pragma unroll
        for (int ai = 0; ai < 2; ++ai) { const int row0 = u.pm * RM + half_row0(ai, wr) + fr; const int cond = cond_of_row(row0);
            const float* gp = gate + cond * 6144 + col0;
            const float* bp = (row0 < 8192) ? base_p + (size_t)row0 * 1024 + col0 : base_s + (size_t)(row0 - 8192) * 1024 + col0;
            const bf16_t* bb = base_b + (size_t)row0 * 1024 + col0;
            bf16_t* op = out + (size_t)row0 * 1024 + col0;
            f32x4 gv[2][2], gs[2][2];
#pragma unroll
            for (int bj = 0; bj < 2; ++bj)
#pragma unroll
                for (int n = 0; n < 2; ++n) gv[bj][n] = *(const f32x4*)(gp + bj * HALF + n * 16);
            if (xb) { f32x4 ga[2][2], sa[2][2];
#pragma unroll
                for (int bj = 0; bj < 2; ++bj)
#pragma unroll
                    for (int n = 0; n < 2; ++n) { ga[bj][n] = *(const f32x4*)(g_next + col0 + bj * HALF + n * 16); sa[bj][n] = *(const f32x4*)(sc_next + cond * 6144 + col0 + bj * HALF + n * 16); }
#pragma unroll
                for (int bj = 0; bj < 2; ++bj)
#pragma unroll
                    for (int n = 0; n < 2; ++n) gs[bj][n] = ga[bj][n] * (1.f + sa[bj][n]); }
#pragma unroll
            for (int mp = 0; mp < 2; ++mp) if (ai == 0 || mp == 0) { f32x4 bs[2][2][2];
                if (base_b) {
#pragma unroll
                    for (int mm = 0; mm < 2; ++mm)
#pragma unroll
                        for (int bj = 0; bj < 2; ++bj)
#pragma unroll
                            for (int n = 0; n < 2; ++n) { const u32x2e w = *(const u32x2e*)(bb + (size_t)((2 * mp + mm) * 16) * 1024 + bj * HALF + n * 16);
                                bs[mm][bj][n] = (f32x4){__builtin_bit_cast(float, w.x << 16), __builtin_bit_cast(float, w.x & 0xffff0000u), __builtin_bit_cast(float, w.y << 16), __builtin_bit_cast(float, w.y & 0xffff0000u)}; }
                } else {
#pragma unroll
                    for (int mm = 0; mm < 2; ++mm)
#pragma unroll
                        for (int bj = 0; bj < 2; ++bj)
#pragma unroll
                            for (int n = 0; n < 2; ++n) bs[mm][bj][n] = *(const f32x4*)(bp + (size_t)((2 * mp + mm) * 16) * 1024 + bj * HALF + n * 16);
                }
#pragma unroll
                for (int mm = 0; mm < 2; ++mm) { float sq = 0.f;
#pragma unroll
                    for (int bj = 0; bj < 2; ++bj)
#pragma unroll
                        for (int n = 0; n < 2; ++n) { const f32x4 xn = bs[mm][bj][n] + gv[bj][n] * acc[ai][bj][2 * mp + mm][n];
                            { u32x2e w; w.x = cvt_pk_bf16(xn[0], xn[1]); w.y = cvt_pk_bf16(xn[2], xn[3]); *(u32x2e*)(op + (size_t)((2 * mp + mm) * 16) * 1024 + bj * HALF + n * 16) = w; }
                            if (xb) { const f32x4 hb = xn * gs[bj][n]; u32x2e w; w.x = cvt_pk_bf16(hb[0], hb[1]); w.y = cvt_pk_bf16(hb[2], hb[3]);
                                *(u32x2e*)(xb + (size_t)(row0 + (2 * mp + mm) * 16) * 1024 + col0 + bj * HALF + n * 16) = w;
                                sq += (xn[0] * xn[0] + xn[1] * xn[1]) + (xn[2] * xn[2] + xn[3] * xn[3]); } }
                    if (xb) {
                        sq += __builtin_bit_cast(float, __builtin_amdgcn_ds_bpermute((lane_x ^ 16) << 2, __builtin_bit_cast(int, sq)));
                        sq += __builtin_bit_cast(float, __builtin_amdgcn_ds_bpermute((lane_x ^ 32) << 2, __builtin_bit_cast(int, sq)));
                        if (fq == 0) atomicAdd(ss_next + row0 + (2 * mp + mm) * 16, sq); } }
                asm volatile("" ::: "memory"); } }
    }
};

struct StaticOrder256 {
    int nM, nN, nwg, G, c;
    __host__ __device__ void init(int M, int N, int G_, int c_) { nM = M / BM; nN = N / BM; nwg = nM * nN; G = G_; c = c_; }
    __host__ __device__ bool next(int i, Unit& u) const {
        const long L = (long)i * G + c; if (L >= nwg) return false;
        int wgid = (int)L; { const int q = nwg / NXCD, r = nwg % NXCD, xcd = wgid % NXCD, off = wgid / NXCD; wgid = (xcd < r ? xcd * (q + 1) : r * (q + 1) + (xcd - r) * q) + off; }
        const int nig = WGM * nN, gid = wgid / nig, fm = gid * WGM, gsz = (nM - fm) < WGM ? (nM - fm) : WGM;
        u.pm = fm + ((wgid % nig) % gsz); u.pn = (wgid % nig) / gsz; return true;
    }
    __device__ __forceinline__ void a_ready(const Unit&) const {}
    __device__ __forceinline__ void done(const Unit&) const {}
};
struct EpiUp256 {
    static constexpr bool PERM = true, AFTER_DRAIN = false;
    const float* ss; const float* shw; bf16_t* O; int ldc;
    __device__ __forceinline__ void operator()(const f32x4 (&acc)[2][2][4][2], const Unit& u, int wr, int wc, int fr, int fq) const {
        const int col0 = u.pn * BM + wc * 32 + 8 * fq;
#pragma unroll
        for (int ai = 0; ai < 2; ++ai) { const int rbase = u.pm * BM + ai * HALF + wr * 64 + fr;
            const float* sp = shw + cond_of_row(rbase) * 4096 + col0;
            f32x4 sv[2][2];
#pragma unroll
            for (int bj = 0; bj < 2; ++bj) { sv[bj][0] = *(const f32x4*)(sp + bj * HALF); sv[bj][1] = *(const f32x4*)(sp + bj * HALF + 4); }
            float rr[4];
#pragma unroll
            for (int m = 0; m < 4; ++m) rr[m] = ss[rbase + m * 16];
#pragma unroll
            for (int m = 0; m < 4; ++m) { bf16_t* rowp = O + (size_t)(rbase + m * 16) * ldc + col0;
                const float r = __builtin_amdgcn_rsqf(rr[m] * (1.f / 1024.f) + 1e-6f);
#pragma unroll
                for (int bj = 0; bj < 2; ++bj) { f32x4 v0 = acc[ai][bj][m][0] * r + sv[bj][0], v1 = acc[ai][bj][m][1] * r + sv[bj][1];
#pragma unroll
                    for (int e = 0; e < 4; ++e) { const float a = fmaxf(v0[e], 0.f), b = fmaxf(v1[e], 0.f); v0[e] = a * a; v1[e] = b * b; }
                    u32x4 w; w.x = cvt_pk_bf16(v0[0], v0[1]); w.y = cvt_pk_bf16(v0[2], v0[3]); w.z = cvt_pk_bf16(v1[0], v1[1]); w.w = cvt_pk_bf16(v1[2], v1[3]);
                    *(u32x4*)(rowp + bj * HALF) = w; } } }
    }
};
template <class Epi, class Sched, bool ALIGN_EPI = false, bool SP2 = false>
__device__ __forceinline__ void gemm_phase256(PG8_LAS unsigned char* lds, const Gemm g, const Sched& S, const Epi& E, const int tid) {
    const int wid = __builtin_amdgcn_readfirstlane(tid >> 6), lane = tid & 63, wr = wid >> 2, wc = wid & 3, fr = lane & 15, fq = lane >> 4;
    const int K = g.K, nt = K / BK;
    unsigned voffA[2], voffB[2];
#pragma unroll
    for (int i = 0; i < 2; ++i) { int R, C; stage_rc(tid * 16 + i * 8192, R, C); const int Rb = Epi::PERM ? ((R & ~31) + perm32(R & 31)) : R;
        voffA[i] = (unsigned)(R * K + C) * 2u; voffB[i] = (unsigned)(Rb * K + C) * 2u; }
    const size_t kstep = (size_t)(BK * 2);
    const size_t hstep = (size_t)HALF * K * 2;
    const size_t tstep = 2 * hstep;
    const unsigned ldsw = (unsigned)wid * 1024u;
    const int aoff = lds_byte(wr * 64 + fr, fq * 8), boff = lds_byte(wc * 32 + fr, fq * 8);
#define PG8_SA(b, h) (((b) * 2 + (h)) * HTB)
#define PG8_SB(b, h) ((4 + (b) * 2 + (h)) * HTB)
#define PG8_STAGE(bufoff, gbase, voff) do { _Pragma("unroll") for (int _i = 0; _i < 2; ++_i) \
        __builtin_amdgcn_global_load_lds((const unsigned*)((const char*)(gbase) + (voff)[_i]), (PG8_LAS unsigned*)(lds + (bufoff) + ldsw + _i * 8192), 16, 0, 0); } while (0)
#define PG8_LDA(dst, b, h) do { _Pragma("unroll") for (int m = 0; m < 4; ++m) _Pragma("unroll") for (int k = 0; k < 2; ++k) dst[m][k] = *(const PG8_LAS bf16x8*)(lds + PG8_SA(b, h) + aoff + m * 2048 + k * 1024); } while (0)
#define PG8_LDB(dst, b, h) do { _Pragma("unroll") for (int n = 0; n < 2; ++n) _Pragma("unroll") for (int k = 0; k < 2; ++k) dst[n][k] = *(const PG8_LAS bf16x8*)(lds + PG8_SB(b, h) + boff + n * 2048 + k * 1024); } while (0)
#define PG8_MMA(ai, bj, At, Bt) do { __builtin_amdgcn_s_setprio(1); _Pragma("unroll") for (int m = 0; m < 4; ++m) _Pragma("unroll") for (int n = 0; n < 2; ++n) _Pragma("unroll") for (int k = 0; k < 2; ++k) \
        acc[ai][bj][m][n] = __builtin_amdgcn_mfma_f32_16x16x32_bf16(Bt[n][k], At[m][k], acc[ai][bj][m][n], 0, 0, 0); __builtin_amdgcn_s_setprio(0); } while (0)
#define PG8_WAIT_V(n) asm volatile("s_waitcnt vmcnt(" #n ")" ::: "memory")
#define PG8_WAIT_L(n) asm volatile("s_waitcnt lgkmcnt(" #n ")" ::: "memory")
#define PG8_BAR __builtin_amdgcn_s_barrier()
#define PG8_SCHED __builtin_amdgcn_sched_barrier(0)
    Unit cur, nxt; int ui = 0;
    if (!S.next(0, cur)) return;
    f32x4 acc[2][2][4][2];
#pragma unroll
    for (int a = 0; a < 2; ++a)
#pragma unroll
        for (int b = 0; b < 2; ++b)
#pragma unroll
            for (int m = 0; m < 4; ++m)
#pragma unroll
                for (int n = 0; n < 2; ++n) acc[a][b][m][n] = (f32x4){0.f, 0.f, 0.f, 0.f};
    bf16x8 At[4][2], B0[2][2], B1[2][2];
    const char* cA = (const char*)g.A + (size_t)cur.pm * tstep; const char* cB = (const char*)g.Bt + (size_t)cur.pn * tstep;
    S.a_ready(cur);
    if constexpr (SP2) {
        PG8_STAGE(PG8_SB(0, 0), cB, voffB); PG8_STAGE(PG8_SB(0, 1), cB + hstep, voffB); PG8_STAGE(PG8_SA(0, 0), cA, voffA); PG8_STAGE(PG8_SA(0, 1), cA + hstep, voffA);
        if (wr == 1) PG8_BAR;
        PG8_WAIT_V(2); PG8_BAR;
        PG8_STAGE(PG8_SB(1, 0), cB + kstep, voffB); PG8_STAGE(PG8_SA(1, 0), cA + kstep, voffA); PG8_STAGE(PG8_SB(1, 1), cB + hstep + kstep, voffB);
        PG8_WAIT_V(6); PG8_BAR;
    } else {
        PG8_STAGE(PG8_SB(0, 0), cB, voffB); PG8_STAGE(PG8_SA(0, 0), cA, voffA); PG8_STAGE(PG8_SB(0, 1), cB + hstep, voffB); PG8_STAGE(PG8_SA(0, 1), cA + hstep, voffA);
        if (wr == 1) PG8_BAR;
        PG8_WAIT_V(4); PG8_BAR;
        PG8_STAGE(PG8_SB(1, 0), cB + kstep, voffB); PG8_STAGE(PG8_SA(1, 0), cA + kstep, voffA); PG8_STAGE(PG8_SB(1, 1), cB + hstep + kstep, voffB);
        PG8_WAIT_V(6); PG8_BAR;
    }
    for (;;) {
        const bool has_next = S.next(ui + 1, nxt);
        const char* nA = has_next ? (const char*)g.A + (size_t)nxt.pm * tstep : cA; const char* nB = has_next ? (const char*)g.Bt + (size_t)nxt.pn * tstep : cB;
        for (int t = 0; t < nt; t += 2) {
            const bool last = (t == nt - 2);
            const char* a1 = cA + (size_t)(t + 1) * kstep;
            const char* a2 = last ? nA : cA + (size_t)(t + 2) * kstep; const char* b2 = last ? nB : cB + (size_t)(t + 2) * kstep;
            const char* a3 = a2 + kstep; const char* b3 = b2 + kstep;
            if (last && has_next) S.a_ready(nxt);
            if constexpr (SP2) {
            PG8_LDB(B0, 0, 0); PG8_LDB(B1, 0, 1); PG8_SCHED; PG8_LDA(At, 0, 0); PG8_STAGE(PG8_SA(1, 1), a1 + hstep, voffA);
            PG8_WAIT_V(8); PG8_WAIT_L(0); PG8_BAR; PG8_MMA(0, 0, At, B0); PG8_MMA(0, 1, At, B1); PG8_BAR; PG8_SCHED;
            PG8_LDA(At, 0, 1); PG8_STAGE(PG8_SB(0, 0), b2, voffB); PG8_STAGE(PG8_SB(0, 1), b2 + hstep, voffB); PG8_STAGE(PG8_SA(0, 0), a2, voffA);
            PG8_WAIT_V(8); PG8_WAIT_L(0); PG8_BAR; PG8_MMA(1, 0, At, B0); PG8_MMA(1, 1, At, B1); PG8_BAR; PG8_SCHED;
            PG8_LDB(B0, 1, 0); PG8_LDB(B1, 1, 1); PG8_SCHED; PG8_LDA(At, 1, 0); PG8_STAGE(PG8_SA(0, 1), a2 + hstep, voffA);
            PG8_WAIT_V(8); PG8_WAIT_L(0); PG8_BAR; PG8_MMA(0, 0, At, B0); PG8_MMA(0, 1, At, B1); PG8_BAR; PG8_SCHED;
            PG8_LDA(At, 1, 1); PG8_STAGE(PG8_SB(1, 0), b3, voffB); PG8_STAGE(PG8_SB(1, 1), b3 + hstep, voffB); PG8_STAGE(PG8_SA(1, 0), a3, voffA);
            PG8_WAIT_V(8); PG8_WAIT_L(0); PG8_BAR; PG8_MMA(1, 0, At, B0); PG8_MMA(1, 1, At, B1); PG8_BAR; PG8_SCHED;
            } else {
            PG8_LDB(B0, 0, 0); PG8_SCHED; PG8_LDA(At, 0, 0); PG8_STAGE(PG8_SA(1, 1), a1 + hstep, voffA);
            PG8_WAIT_L(8); PG8_BAR; PG8_WAIT_L(0); PG8_MMA(0, 0, At, B0); PG8_BAR; PG8_SCHED;
            PG8_LDB(B1, 0, 1); PG8_STAGE(PG8_SB(0, 0), b2, voffB);
            PG8_BAR; PG8_WAIT_L(0); PG8_MMA(0, 1, At, B1); PG8_BAR;
            PG8_LDA(At, 0, 1); PG8_STAGE(PG8_SA(0, 0), a2, voffA);
            PG8_BAR; PG8_WAIT_L(0); PG8_MMA(1, 0, At, B0); PG8_BAR; PG8_SCHED;
            PG8_STAGE(PG8_SB(0, 1), b2 + hstep, voffB);
            PG8_WAIT_V(6); PG8_BAR; PG8_MMA(1, 1, At, B1); PG8_BAR;
            PG8_LDB(B0, 1, 0); PG8_SCHED; PG8_LDA(At, 1, 0); PG8_STAGE(PG8_SA(0, 1), a2 + hstep, voffA);
            PG8_WAIT_L(8); PG8_BAR; PG8_WAIT_L(0); PG8_MMA(0, 0, At, B0); PG8_BAR; PG8_SCHED;
            PG8_LDB(B1, 1, 1); PG8_STAGE(PG8_SB(1, 0), b3, voffB);
            PG8_BAR; PG8_WAIT_L(0); PG8_MMA(0, 1, At, B1); PG8_BAR;
            PG8_LDA(At, 1, 1); PG8_STAGE(PG8_SA(1, 0), a3, voffA);
            PG8_BAR; PG8_WAIT_L(0); PG8_MMA(1, 0, At, B0); PG8_BAR; PG8_SCHED;
            PG8_STAGE(PG8_SB(1, 1), b3 + hstep, voffB);
            PG8_WAIT_V(6); PG8_BAR; PG8_MMA(1, 1, At, B1); PG8_BAR;
            }
        }
        if constexpr (ALIGN_EPI) { if (wr == 0) PG8_BAR; }
        if constexpr (!Epi::AFTER_DRAIN) { E(acc, cur, wr, wc, fr, fq); S.done(cur); }
        if (!has_next) break;
#pragma unroll
        for (int a = 0; a < 2; ++a)
#pragma unroll
            for (int b = 0; b < 2; ++b)
#pragma unroll
                for (int m = 0; m < 4; ++m)
#pragma unroll
                    for (int n = 0; n < 2; ++n) acc[a][b][m][n] = (f32x4){0.f, 0.f, 0.f, 0.f};
        cur = nxt; cA = nA; cB = nB; ++ui;
        if constexpr (ALIGN_EPI) { if (wr == 1) PG8_BAR; }
    }
    PG8_WAIT_V(0);
    if constexpr (!ALIGN_EPI) { if (wr == 0) PG8_BAR; }
    PG8_BAR;
    if constexpr (Epi::AFTER_DRAIN) { E.fused(acc, cur, wr, wc, fr, fq, lds, wid, lane); S.done(cur); }
#undef PG8_SA
#undef PG8_SB
#undef PG8_STAGE
#undef PG8_LDA
#undef PG8_LDB
#undef PG8_MMA
#undef PG8_WAIT_V
#undef PG8_WAIT_L
#undef PG8_BAR
#undef PG8_SCHED
}
template <class Epi, class Sched, bool ALIGN_EPI = false, bool SP2 = false>
__device__ __forceinline__ void gemm_phase(PG8_LAS unsigned char* lds, const Gemm g, const Sched& S, const Epi& E, const int tid) {
    static_assert(SP2, "the 192-row tile form exists for the SP2 loop only");
    const int wid = __builtin_amdgcn_readfirstlane(tid >> 6), lane = tid & 63, wr = wid >> 2, wc = wid & 3, fr = lane & 15, fq = lane >> 4;
    const int K = g.K, nt = K / BK;
    unsigned voffA[2], voffB[2];
#pragma unroll
    for (int i = 0; i < 2; ++i) { int R, C; stage_rc(tid * 16 + i * 8192, R, C); const int Rb = Epi::PERM ? ((R & ~31) + perm32(R & 31)) : R;
        voffA[i] = (unsigned)(R * K + C) * 2u; voffB[i] = (unsigned)(Rb * K + C) * 2u; }
    const size_t kstep = (size_t)(BK * 2);
    const size_t hstep = (size_t)HALF * K * 2;
    const size_t tstepA = (size_t)RM * K * 2;
    const size_t tstep = 2 * hstep;
    const unsigned ldsw = (unsigned)wid * 1024u;
    const int aoff = lds_byte(wr * 64 + fr, fq * 8), boff = lds_byte(wc * 32 + fr, fq * 8);
#define PG8_SA(b, h) (((b) * 2 + (h)) * HTB)
#define PG8_SB(b, h) ((4 + (b) * 2 + (h)) * HTB)
#define PG8_STAGE(bufoff, gbase, voff) do { _Pragma("unroll") for (int _i = 0; _i < 2; ++_i) \
        __builtin_amdgcn_global_load_lds((const unsigned*)((const char*)(gbase) + (voff)[_i]), (PG8_LAS unsigned*)(lds + (bufoff) + ldsw + _i * 8192), 16, 0, 0); } while (0)
#define PG8_LDA(dst, b, h) do { _Pragma("unroll") for (int m = 0; m < 4; ++m) _Pragma("unroll") for (int k = 0; k < 2; ++k) dst[m][k] = *(const PG8_LAS bf16x8*)(lds + PG8_SA(b, h) + aoff + m * 2048 + k * 1024); } while (0)
#define PG8_LDB(dst, b, h) do { _Pragma("unroll") for (int n = 0; n < 2; ++n) _Pragma("unroll") for (int k = 0; k < 2; ++k) dst[n][k] = *(const PG8_LAS bf16x8*)(lds + PG8_SB(b, h) + boff + n * 2048 + k * 1024); } while (0)
#define PG8_MMA(ai, bj, At, Bt) do { __builtin_amdgcn_s_setprio(1); _Pragma("unroll") for (int m = 0; m < 4; ++m) _Pragma("unroll") for (int n = 0; n < 2; ++n) _Pragma("unroll") for (int k = 0; k < 2; ++k) \
        acc[ai][bj][m][n] = __builtin_amdgcn_mfma_f32_16x16x32_bf16(Bt[n][k], At[m][k], acc[ai][bj][m][n], 0, 0, 0); __builtin_amdgcn_s_setprio(0); } while (0)
    const int aoff1 = lds_byte(wr * 32 + fr, fq * 8);
#define PG8_STAGE1(bufoff, gbase, voff) __builtin_amdgcn_global_load_lds((const unsigned*)((const char*)(gbase) + (voff)[0]), (PG8_LAS unsigned*)(lds + (bufoff) + ldsw), 16, 0, 0)
#define PG8_LDA1(dst, b) do { _Pragma("unroll") for (int m = 0; m < 2; ++m) _Pragma("unroll") for (int k = 0; k < 2; ++k) dst[m][k] = *(const PG8_LAS bf16x8*)(lds + PG8_SA(b, 1) + aoff1 + m * 2048 + k * 1024); } while (0)
#define PG8_MMA1(bj, At, Bt) do { __builtin_amdgcn_s_setprio(1); _Pragma("unroll") for (int m = 0; m < 2; ++m) _Pragma("unroll") for (int n = 0; n < 2; ++n) _Pragma("unroll") for (int k = 0; k < 2; ++k) \
        acc[1][bj][m][n] = __builtin_amdgcn_mfma_f32_16x16x32_bf16(Bt[n][k], At[m][k], acc[1][bj][m][n], 0, 0, 0); __builtin_amdgcn_s_setprio(0); } while (0)
#define PG8_WAIT_V(n) asm volatile("s_waitcnt vmcnt(" #n ")" ::: "memory")
#define PG8_WAIT_L(n) asm volatile("s_waitcnt lgkmcnt(" #n ")" ::: "memory")
#define PG8_BAR __builtin_amdgcn_s_barrier()
#define PG8_SCHED __builtin_amdgcn_sched_barrier(0)
    Unit cur, nxt; int ui = 0;
    if (!S.next(0, cur)) return;
    f32x4 acc[2][2][4][2];
#pragma unroll
    for (int a = 0; a < 2; ++a)
#pragma unroll
        for (int b = 0; b < 2; ++b)
#pragma unroll
            for (int m = 0; m < 4; ++m)
#pragma unroll
                for (int n = 0; n < 2; ++n) acc[a][b][m][n] = (f32x4){0.f, 0.f, 0.f, 0.f};
    bf16x8 At[4][2], B0[2][2], B1[2][2];
    const char* cA = (const char*)g.A + (size_t)cur.pm * tstepA; const char* cB = (const char*)g.Bt + (size_t)cur.pn * tstep;
    S.a_ready(cur);
    if constexpr (SP2) {
        PG8_STAGE(PG8_SB(0, 0), cB, voffB); PG8_STAGE(PG8_SB(0, 1), cB + hstep, voffB); PG8_STAGE(PG8_SA(0, 0), cA, voffA); PG8_STAGE1(PG8_SA(0, 1), cA + hstep, voffA);
        if (wr == 1) PG8_BAR;
        PG8_WAIT_V(1); PG8_BAR;
        PG8_STAGE(PG8_SB(1, 0), cB + kstep, voffB); PG8_STAGE(PG8_SA(1, 0), cA + kstep, voffA); PG8_STAGE(PG8_SB(1, 1), cB + hstep + kstep, voffB);
        PG8_WAIT_V(6); PG8_BAR;
    } else {
        PG8_STAGE(PG8_SB(0, 0), cB, voffB); PG8_STAGE(PG8_SA(0, 0), cA, voffA); PG8_STAGE(PG8_SB(0, 1), cB + hstep, voffB); PG8_STAGE(PG8_SA(0, 1), cA + hstep, voffA);
        if (wr == 1) PG8_BAR;
        PG8_WAIT_V(4); PG8_BAR;
        PG8_STAGE(PG8_SB(1, 0), cB + kstep, voffB); PG8_STAGE(PG8_SA(1, 0), cA + kstep, voffA); PG8_STAGE(PG8_SB(1, 1), cB + hstep + kstep, voffB);
        PG8_WAIT_V(6); PG8_BAR;
    }
    for (;;) {
        const bool has_next = S.next(ui + 1, nxt);
        const char* nA = has_next ? (const char*)g.A + (size_t)nxt.pm * tstepA : cA; const char* nB = has_next ? (const char*)g.Bt + (size_t)nxt.pn * tstep : cB;
        for (int t = 0; t < nt; t += 2) {
            const bool last = (t == nt - 2);
            const char* a1 = cA + (size_t)(t + 1) * kstep;
            const char* a2 = last ? nA : cA + (size_t)(t + 2) * kstep; const char* b2 = last ? nB : cB + (size_t)(t + 2) * kstep;
            const char* a3 = a2 + kstep; const char* b3 = b2 + kstep;
            if (last && has_next) S.a_ready(nxt);
            if constexpr (SP2) {
            PG8_LDB(B0, 0, 0); PG8_LDB(B1, 0, 1); PG8_SCHED; PG8_LDA(At, 0, 0); PG8_STAGE1(PG8_SA(1, 1), a1 + hstep, voffA);
            PG8_WAIT_V(7); PG8_WAIT_L(0); PG8_BAR; PG8_MMA(0, 0, At, B0); PG8_MMA(0, 1, At, B1); PG8_BAR; PG8_SCHED;
            PG8_LDA1(At, 0); PG8_STAGE(PG8_SB(0, 0), b2, voffB); PG8_STAGE(PG8_SB(0, 1), b2 + hstep, voffB); PG8_STAGE(PG8_SA(0, 0), a2, voffA);
            PG8_WAIT_V(7); PG8_WAIT_L(0); PG8_BAR; PG8_MMA1(0, At, B0); PG8_MMA1(1, At, B1); PG8_BAR; PG8_SCHED;
            PG8_LDB(B0, 1, 0); PG8_LDB(B1, 1, 1); PG8_SCHED; PG8_LDA(At, 1, 0); PG8_STAGE1(PG8_SA(0, 1), a2 + hstep, voffA);
            PG8_WAIT_V(7); PG8_WAIT_L(0); PG8_BAR; PG8_MMA(0, 0, At, B0); PG8_MMA(0, 1, At, B1); PG8_BAR; PG8_SCHED;
            PG8_LDA1(At, 1); PG8_STAGE(PG8_SB(1, 0), b3, voffB); PG8_STAGE(PG8_SB(1, 1), b3 + hstep, voffB); PG8_STAGE(PG8_SA(1, 0), a3, voffA);
            PG8_WAIT_V(7); PG8_WAIT_L(0); PG8_BAR; PG8_MMA1(0, At, B0); PG8_MMA1(1, At, B1); PG8_BAR; PG8_SCHED;
            } else {
            PG8_LDB(B0, 0, 0); PG8_SCHED; PG8_LDA(At, 0, 0); PG8_STAGE(PG8_SA(1, 1), a1 + hstep, voffA);
            PG8_WAIT_L(8); PG8_BAR; PG8_WAIT_L(0); PG8_MMA(0, 0, At, B0); PG8_BAR; PG8_SCHED;
            PG8_LDB(B1, 0, 1); PG8_STAGE(PG8_SB(0, 0), b2, voffB);
            PG8_BAR; PG8_WAIT_L(0); PG8_MMA(0, 1, At, B1); PG8_BAR;
            PG8_LDA(At, 0, 1); PG8_STAGE(PG8_SA(0, 0), a2, voffA);
            PG8_BAR; PG8_WAIT_L(0); PG8_MMA(1, 0, At, B0); PG8_BAR; PG8_SCHED;
            PG8_STAGE(PG8_SB(0, 1), b2 + hstep, voffB);
            PG8_WAIT_V(6); PG8_BAR; PG8_MMA(1, 1, At, B1); PG8_BAR;
            PG8_LDB(B0, 1, 0); PG8_SCHED; PG8_LDA(At, 1, 0); PG8_STAGE(PG8_SA(0, 1), a2 + hstep, voffA);
            PG8_WAIT_L(8); PG8_BAR; PG8_WAIT_L(0); PG8_MMA(0, 0, At, B0); PG8_BAR; PG8_SCHED;
            PG8_LDB(B1, 1, 1); PG8_STAGE(PG8_SB(1, 0), b3, voffB);
            PG8_BAR; PG8_WAIT_L(0); PG8_MMA(0, 1, At, B1); PG8_BAR;
            PG8_LDA(At, 1, 1); PG8_STAGE(PG8_SA(1, 0), a3, voffA);
            PG8_BAR; PG8_WAIT_L(0); PG8_MMA(1, 0, At, B0); PG8_BAR; PG8_SCHED;
            PG8_STAGE(PG8_SB(1, 1), b3 + hstep, voffB);
            PG8_WAIT_V(6); PG8_BAR; PG8_MMA(1, 1, At, B1); PG8_BAR;
            }
        }
        if constexpr (ALIGN_EPI) { if (wr == 0) PG8_BAR; }
        if constexpr (!Epi::AFTER_DRAIN) { E(acc, cur, wr, wc, fr, fq); S.done(cur); }
        if (!has_next) break;
#pragma unroll
        for (int a = 0; a < 2; ++a)
#pragma unroll
            for (int b = 0; b < 2; ++b)
#pragma unroll
                for (int m = 0; m < 4; ++m)
#pragma unroll
                    for (int n = 0; n < 2; ++n) acc[a][b][m][n] = (f32x4){0.f, 0.f, 0.f, 0.f};
        cur = nxt; cA = nA; cB = nB; ++ui;
        if constexpr (ALIGN_EPI) { if (wr == 1) PG8_BAR; }
    }
    PG8_WAIT_V(0);
    if constexpr (!ALIGN_EPI) { if (wr == 0) PG8_BAR; }
    PG8_BAR;
    if constexpr (Epi::AFTER_DRAIN) { E.fused(acc, cur, wr, wc, fr, fq, lds, wid, lane); S.done(cur); }
#undef PG8_SA
#undef PG8_SB
#undef PG8_STAGE
#undef PG8_LDA
#undef PG8_LDB
#undef PG8_MMA
#undef PG8_STAGE1
#undef PG8_LDA1
#undef PG8_MMA1
#undef PG8_WAIT_V
#undef PG8_WAIT_L
#undef PG8_BAR
#undef PG8_SCHED
}
}
constexpr int D = 1024, MP = 8192, MS = 4096, M = MP + MS, FF = 4096, NL = 4;
constexpr int NWAVES = 8, NTHR = 512;
constexpr size_t MiB = 1u << 20;
constexpr size_t WS_MOD = 1 * MiB;
constexpr size_t WS_W = 2 * MiB;
constexpr size_t WS_X = 94 * MiB;
constexpr size_t WS_H = 142 * MiB;
constexpr size_t WS_R = 166 * MiB;
constexpr size_t WS_CK = 262 * MiB, WS_CV = 266 * MiB, WS_SHW = 270 * MiB, WS_SS = 271 * MiB, WS_END = 272 * MiB;
constexpr size_t MEL = 1u << 20;
constexpr size_t W_QKV = 0, W_O = 6 * MEL, W_PW1 = 8 * MEL, W_PW2 = 12 * MEL, W_UP = 14 * MEL, W_DOWN = 30 * MEL;
constexpr int LDS_BYTES = 163840, LDS_ST = LDS_BYTES - 16, LDS_KC = 112640;

#define LAS __attribute__((address_space(3)))
#define SB0() __builtin_amdgcn_sched_barrier(0)
typedef unsigned short bf16;
typedef float f32x4 __attribute__((ext_vector_type(4)));
typedef float f32x2 __attribute__((ext_vector_type(2)));
typedef unsigned u32x4 __attribute__((ext_vector_type(4)));
typedef unsigned u32x2 __attribute__((ext_vector_type(2)));
typedef short bf16x8 __attribute__((ext_vector_type(8)));
typedef short s16x4 __attribute__((ext_vector_type(4)));
typedef float f32x32 __attribute__((ext_vector_type(32)));

__device__ __forceinline__ unsigned f2bf(float f) { unsigned u = __builtin_bit_cast(unsigned, f); return (u + 0x7fffu + ((u >> 16) & 1u)) >> 16; }
__device__ __forceinline__ unsigned pk2(float lo, float hi) { unsigned r; asm("v_cvt_pk_bf16_f32 %0, %1, %2" : "=v"(r) : "v"(lo), "v"(hi)); return r; }
__device__ __forceinline__ float bflo(unsigned w) { return __builtin_bit_cast(float, w << 16); }
__device__ __forceinline__ float bfhi(unsigned w) { return __builtin_bit_cast(float, w & 0xffff0000u); }
__device__ __forceinline__ float shx(float v, int k, int lane) { return __builtin_bit_cast(float, __builtin_amdgcn_ds_bpermute((lane ^ k) << 2, __builtin_bit_cast(int, v))); }
__device__ __forceinline__ float wave_sum(float v, int lane) {
#pragma unroll
    for (int o = 1; o < 64; o <<= 1) v += shx(v, o, lane);
    return v;
}

template <bool GLU>
__device__ __forceinline__ void transpose_item(const float* W, int K, int N, bf16* WT, LAS float* scr, int item, int lane) {
    const int nblk = N / 32, kb = item / nblk, nb = item % nblk, k0 = 64 * kb, n0 = 32 * nb;
    { float tv[32];
#pragma unroll
      for (int i = 0; i < 32; ++i) tv[i] = __builtin_nontemporal_load(W + (size_t)(k0 + 2 * i + (lane >> 5)) * N + n0 + (lane & 31));
      __builtin_amdgcn_sched_barrier(0);
#pragma unroll
      for (int i = 0; i < 32; ++i) scr[(2 * i + (lane >> 5)) * 33 + (lane & 31)] = tv[i]; }
    asm volatile("s_waitcnt lgkmcnt(0)" ::: "memory");
    int d0 = n0;
    if (GLU) { const int nn = n0 & 1023; d0 = ((nn >> 7) << 8) + (nn & 127) + ((n0 >> 10) << 7); }
    const int c = lane & 7;
#pragma unroll
    for (int j = 0; j < 4; ++j) { const int n = (lane >> 3) + 8 * j; const LAS float* s = scr + (8 * c) * 33 + n;
        u32x4 o; o.x = pk2(s[0 * 33], s[1 * 33]); o.y = pk2(s[2 * 33], s[3 * 33]); o.z = pk2(s[4 * 33], s[5 * 33]); o.w = pk2(s[6 * 33], s[7 * 33]);
        *(u32x4*)(WT + (size_t)(d0 + n) * K + k0 + 8 * c) = o; }
    asm volatile("s_waitcnt lgkmcnt(0)" ::: "memory");
}

struct Ptrs {
    const float *x_prompt, *x_sample, *cache_k, *cache_v, *c, *c_ctx, *norm_g, *w_ada, *b_ada, *w_qkv, *w_o, *rpb, *w_pw1, *w_dw, *b_dw, *ln_g, *ln_b, *w_pw2, *w_up, *w_down, *final_g;
};

__device__ __forceinline__ void p0_phase(const Ptrs& P, unsigned char* ws, LAS unsigned char* lds, int tid, int lane, int wave, int G, int bid) {
    bf16* Wt = (bf16*)(ws + WS_W);
    const int gw = bid * NWAVES + wave, NGW = G * NWAVES;
    LAS float* scr = (LAS float*)(lds + wave * 16384);
    constexpr int NIT = 23552;
    for (int it = gw; it < NIT; it += NGW) {
        if (it < 7168) { const int i = it / 3584; int r = it % 3584;
            if (r < 1536) { transpose_item<false>(P.w_qkv + (size_t)i * D * 3 * D, D, 3 * D, Wt + W_QKV + (size_t)i * 3 * MEL, scr, r, lane); continue; } r -= 1536;
            if (r < 512) { transpose_item<false>(P.w_o + (size_t)i * D * D, D, D, Wt + W_O + (size_t)i * MEL, scr, r, lane); continue; } r -= 512;
            if (r < 1024) { transpose_item<true>(P.w_pw1 + (size_t)i * D * 2 * D, D, 2 * D, Wt + W_PW1 + (size_t)i * 2 * MEL, scr, r, lane); continue; } r -= 1024;
            transpose_item<false>(P.w_pw2 + (size_t)i * D * D, D, D, Wt + W_PW2 + (size_t)i * MEL, scr, r, lane);
        } else { const int l = (it - 7168) / 4096; int r = (it - 7168) % 4096;
            if (r < 2048) transpose_item<false>(P.w_up + (size_t)l * D * FF, D, FF, Wt + W_UP + (size_t)l * 4 * MEL, scr, r, lane);
            else transpose_item<false>(P.w_down + (size_t)l * D * FF, FF, D, Wt + W_DOWN + (size_t)l * 4 * MEL, scr, r - 2048, lane);
        }
    }
    { bf16* CK = (bf16*)(ws + WS_CK); bf16* CV = (bf16*)(ws + WS_CV);
      const int NT = G * NTHR; constexpr int NV = 2 * 4 * 2 * 256 * 1024 / 8;
      for (int v = bid * NTHR + tid; v < NV; v += NT) { const int which = v >= NV / 2; const int e = (which ? v - NV / 2 : v) * 8;
          const float* src = (which ? P.cache_v : P.cache_k) + e; const f32x4 a = __builtin_nontemporal_load((const f32x4*)src), b = __builtin_nontemporal_load((const f32x4*)(src + 4));
          u32x4 o; o.x = pk2(a[0], a[1]); o.y = pk2(a[2], a[3]); o.z = pk2(b[0], b[1]); o.w = pk2(b[2], b[3]);
          *(u32x4*)((which ? CV : CK) + e) = o; } }
    { f32x4* z = (f32x4*)(ws + WS_SS); const int NT = G * NTHR; float zf = 0.f; asm volatile("" : "+v"(zf));
      const f32x4 zz = (f32x4){zf, zf, zf, zf}; for (int v = bid * NTHR + tid; v < 9 * M / 4; v += NT) z[v] = zz; }
    __syncthreads();
    { LAS float* sil = (LAS float*)lds; LAS float* red = (LAS float*)(lds + 20480); float* mod = (float*)(ws + WS_MOD);
      for (int k = tid; k < 5 * 1024; k += NTHR) { const int cc = k >> 10, kk = k & 1023; const float v = cc == 0 ? P.c_ctx[kk] : P.c[(cc - 1) * 1024 + kk]; sil[k] = v / (1.f + __expf(-v)); }
      __syncthreads();
      const int kg = tid >> 4, cl = tid & 15; const bool cact = cl < 12;
      for (int item = bid; item < 512; item += G) { const int l = item >> 7, n0 = (item & 127) * 48;
          const float* W = P.w_ada + (size_t)l * D * 6144 + n0 + 4 * cl;
          f32x4 a[5];
#pragma unroll
          for (int cc = 0; cc < 5; ++cc) a[cc] = (f32x4){0.f, 0.f, 0.f, 0.f};
#pragma unroll 4
          for (int kk = 0; kk < 32; ++kk) { const int k = kg * 32 + kk; f32x4 w = (f32x4){0.f, 0.f, 0.f, 0.f}; if (cact) w = __builtin_nontemporal_load((const f32x4*)(W + (size_t)k * 6144));
#pragma unroll
              for (int cc = 0; cc < 5; ++cc) a[cc] += sil[cc * 1024 + k] * w; }
#pragma unroll
          for (int cc = 0; cc < 5; ++cc) *(LAS f32x4*)(red + (kg * 5 + cc) * 64 + 4 * cl) = a[cc];
          __syncthreads();
          if (tid < 320 && (tid & 63) < 48) { const int cc = tid >> 6, n = tid & 63; float s = 0.f;
#pragma unroll 8
              for (int g = 0; g < 32; ++g) s += red[(g * 5 + cc) * 64 + n];
              mod[(size_t)(l * 5 + cc) * 6144 + n0 + n] = s + P.b_ada[l * 6144 + n0 + n]; }
          __syncthreads();
      } }
}

__device__ __forceinline__ void norm_phase(const float* xp, const float* xs, bf16* H, float* yout, const float* g, const float* shift, const float* scale, int gw, int NGW, int lane) {
    f32x4 gv[4];
#pragma unroll
    for (int j = 0; j < 4; ++j) gv[j] = *(const f32x4*)(g + 4 * (lane + 64 * j));
    for (int m = gw; m < M; m += NGW) {
        const float* xrow = m < MP ? xp + (size_t)m * D : xs + (size_t)(m - MP) * D;
        const int cond = m < MP ? 0 : 1 + ((m - MP) >> 10);
        f32x4 v[4]; float ss = 0.f;
#pragma unroll
        for (int j = 0; j < 4; ++j) { v[j] = *(const f32x4*)(xrow + 4 * (lane + 64 * j)); ss += (v[j][0] * v[j][0] + v[j][1] * v[j][1]) + (v[j][2] * v[j][2] + v[j][3] * v[j][3]); }
        const float r = 1.0f / sqrtf(wave_sum(ss, lane) * (1.f / D) + 1e-6f);
        if (yout) {
#pragma unroll
            for (int j = 0; j < 4; ++j) *(f32x4*)(yout + (size_t)m * D + 4 * (lane + 64 * j)) = v[j] * r * gv[j];
        } else {
#pragma unroll
            for (int j = 0; j < 4; ++j) { const f32x4 sc = *(const f32x4*)(scale + cond * 6144 + 4 * (lane + 64 * j)), sh = *(const f32x4*)(shift + cond * 6144 + 4 * (lane + 64 * j));
                const f32x4 h = (v[j] * r * gv[j]) * (1.f + sc) + sh; u32x2 o; o.x = pk2(h[0], h[1]); o.y = pk2(h[2], h[3]);
                *(u32x2*)(H + (size_t)m * D + 4 * (lane + 64 * j)) = o; }
        }
    }
}

template <class F, int... I> __device__ __forceinline__ void sfor_impl(F&& f, std::integer_sequence<int, I...>) { (f(std::integral_constant<int, I>{}), ...); }
template <int N, class F> __device__ __forceinline__ void sfor(F&& f) { sfor_impl(f, std::make_integer_sequence<int, N>{}); }
__device__ __forceinline__ float dpp_add(float v, int ctrl_b1, int ctrl_4e, int dummy) { return v; }
__device__ __forceinline__ float wave_sum_dpp(float v) {
    v += __builtin_bit_cast(float, __builtin_amdgcn_update_dpp(0, __builtin_bit_cast(int, v), 0xB1, 0xf, 0xf, false));
    v += __builtin_bit_cast(float, __builtin_amdgcn_update_dpp(0, __builtin_bit_cast(int, v), 0x4E, 0xf, 0xf, false));
    v += __builtin_bit_cast(float, __builtin_amdgcn_update_dpp(0, __builtin_bit_cast(int, v), 0x141, 0xf, 0xf, false));
    v += __builtin_bit_cast(float, __builtin_amdgcn_update_dpp(0, __builtin_bit_cast(int, v), 0x140, 0xf, 0xf, false));
    const int vi = __builtin_bit_cast(int, v);
    return (__builtin_bit_cast(float, __builtin_amdgcn_readlane(vi, 0)) + __builtin_bit_cast(float, __builtin_amdgcn_readlane(vi, 16))) +
           (__builtin_bit_cast(float, __builtin_amdgcn_readlane(vi, 32)) + __builtin_bit_cast(float, __builtin_amdgcn_readlane(vi, 48)));
}
constexpr int CT = 16, CROWS = CT + 30, CCH = (CROWS + 15) / 16;
__device__ __forceinline__ void conv_phase(const bf16* U, bf16* Vc, const float* wdw, const float* bdw, const float* lng, const float* lnb, LAS unsigned char* lds, int tid, int lane, int wave, int G, int bid) {
    f32x2 w[31];
    sfor<31>([&](auto K) __attribute__((always_inline)) { constexpr int k = decltype(K)::value; w[k] = *(const f32x2*)(wdw + k * D + 2 * tid); });
    const f32x2 bd = *(const f32x2*)(bdw + 2 * tid), lg = *(const f32x2*)(lng + 2 * tid), lb = *(const f32x2*)(lnb + 2 * tid);
    LAS f32x2* part = (LAS f32x2*)lds;
    LAS f32x2* stats = part + 8 * CT;
    for (int unit = bid; unit < M / CT; unit += G) {
        const int m0 = unit * CT, seg = m0 < MP ? 0 : MP, L = m0 < MP ? 256 : 1024, t0 = (m0 - seg) & (L - 1);
        const bf16* Ub = U + (size_t)(m0 - t0) * D + 2 * tid;
        f32x2 acc[CT];
        sfor<CT>([&](auto O) __attribute__((always_inline)) { acc[decltype(O)::value] = bd; });
        sfor<CCH>([&](auto C) __attribute__((always_inline)) { constexpr int c = decltype(C)::value;
            unsigned raw[16];
            sfor<16>([&](auto I) __attribute__((always_inline)) { constexpr int i = decltype(I)::value, j = c * 16 + i;
                if constexpr (j < CROWS) { const int t = t0 - 15 + j, tc = min(max(t, 0), L - 1);
                    raw[i] = *(const unsigned*)(Ub + (size_t)tc * D); } });
            SB0();
            sfor<16>([&](auto I) __attribute__((always_inline)) { constexpr int i = decltype(I)::value, j = c * 16 + i;
                if constexpr (j < CROWS) { const int t = t0 - 15 + j; const unsigned rm = raw[i] & (unsigned)(-(int)((t >= 0) & (t < L))); const f32x2 u = (f32x2){bflo(rm), bfhi(rm)};
                    sfor<31>([&](auto K) __attribute__((always_inline)) { constexpr int k = decltype(K)::value, o = j - k;
                        if constexpr (o >= 0 && o < CT) acc[o] += u * w[k]; }); } });
        });
        sfor<CT>([&](auto O) __attribute__((always_inline)) { constexpr int o = decltype(O)::value;
            const float s = wave_sum_dpp(acc[o].x + acc[o].y), q = wave_sum_dpp(acc[o].x * acc[o].x + acc[o].y * acc[o].y); if (lane == 0) part[wave * CT + o] = (f32x2){s, q}; });
        __syncthreads();
        if (tid < CT) { float s = 0.f, q = 0.f;
#pragma unroll
            for (int wv = 0; wv < 8; ++wv) { const f32x2 p = part[wv * CT + tid]; s += p.x; q += p.y; }
            const float mean = s * (1.f / D), var = fmaxf(q * (1.f / D) - mean * mean, 0.f); stats[tid] = (f32x2){mean, 1.0f / sqrtf(var + 1e-5f)}; }
        __syncthreads();
        sfor<CT>([&](auto O) __attribute__((always_inline)) { constexpr int o = decltype(O)::value;
            const f32x2 st = stats[o]; f32x2 y = (acc[o] - st.x) * st.y * lg + lb;
            y.x = y.x * __builtin_amdgcn_rcpf(1.f + __expf(-y.x)); y.y = y.y * __builtin_amdgcn_rcpf(1.f + __expf(-y.y));
            *(unsigned*)(Vc + (size_t)(m0 + o) * D + 2 * tid) = pk2(y.x, y.y); });
        __syncthreads();
    }
}

__device__ __forceinline__ void final_norm_phase(const bf16* X, float* yout, const float* g, int gw, int NGW, int lane) {
    f32x4 gv[4];
#pragma unroll
    for (int j = 0; j < 4; ++j) gv[j] = *(const f32x4*)(g + 16 * lane + 4 * j);
    for (int m = gw; m < M; m += NGW) {
        const bf16* xr = X + (size_t)m * D + 16 * lane;
        const u32x4 w0 = *(const u32x4*)xr, w1 = *(const u32x4*)(xr + 8);
        f32x4 v[4]; v[0] = (f32x4){bflo(w0[0]), bfhi(w0[0]), bflo(w0[1]), bfhi(w0[1])}; v[1] = (f32x4){bflo(w0[2]), bfhi(w0[2]), bflo(w0[3]), bfhi(w0[3])};
        v[2] = (f32x4){bflo(w1[0]), bfhi(w1[0]), bflo(w1[1]), bfhi(w1[1])}; v[3] = (f32x4){bflo(w1[2]), bfhi(w1[2]), bflo(w1[3]), bfhi(w1[3])};
        float sq = 0.f;
#pragma unroll
        for (int j = 0; j < 4; ++j) sq += (v[j][0] * v[j][0] + v[j][1] * v[j][1]) + (v[j][2] * v[j][2] + v[j][3] * v[j][3]);
        const float r = 1.0f / sqrtf(wave_sum_dpp(sq) * (1.f / D) + 1e-6f);
#pragma unroll
        for (int j = 0; j < 4; ++j) __builtin_nontemporal_store(v[j] * r * gv[j], (f32x4*)(yout + (size_t)m * D + 16 * lane + 4 * j));
    }
}

__device__ __forceinline__ void prep_phase(const float* xp, const float* xs, bf16* H, float* ss0, const float* g, const float* scale, const float* mod, const bf16* Wt, float* shw, int gw, int NGW, int lane) {
    { f32x4 gv[4];
#pragma unroll
      for (int j = 0; j < 4; ++j) gv[j] = *(const f32x4*)(g + 4 * (lane + 64 * j));
      for (int m = gw; m < M; m += NGW) {
          const float* xrow = m < MP ? xp + (size_t)m * D : xs + (size_t)(m - MP) * D;
          const int cond = m < MP ? 0 : 1 + ((m - MP) >> 10);
          f32x4 v[4]; float sq = 0.f;
#pragma unroll
          for (int j = 0; j < 4; ++j) { v[j] = *(const f32x4*)(xrow + 4 * (lane + 64 * j)); sq += (v[j][0] * v[j][0] + v[j][1] * v[j][1]) + (v[j][2] * v[j][2] + v[j][3] * v[j][3]); }
          sq = wave_sum_dpp(sq); if (lane == 0) ss0[m] = sq;
          f32x4 sc[4];
#pragma unroll
          for (int j = 0; j < 4; ++j) sc[j] = *(const f32x4*)(scale + cond * 6144 + 4 * (lane + 64 * j));
#pragma unroll
          for (int j = 0; j < 4; ++j) { const f32x4 h = v[j] * gv[j] * (1.f + sc[j]); u32x2 o; o.x = pk2(h[0], h[1]); o.y = pk2(h[2], h[3]);
              *(u32x2*)(H + (size_t)m * D + 4 * (lane + 64 * j)) = o; }
      } }
    for (int it = gw; it < 4 * 8192; it += NGW) {
        const int l = it >> 13, which = (it >> 12) & 1, n = it & 4095, i = l >> 1; const bool conv = (l & 1) != 0;
        const int N = which ? 4096 : (conv ? 2048 : 3072);
        if (n >= N) continue;
        const bf16* wrow = Wt + (which ? W_UP + (size_t)l * 4 * MEL : (conv ? W_PW1 + (size_t)i * 2 * MEL : W_QKV + (size_t)i * 3 * MEL)) + (size_t)n * D + 16 * lane;
        const u32x4 w0 = *(const u32x4*)wrow, w1 = *(const u32x4*)(wrow + 8);
        float wv[16];
#pragma unroll
        for (int e = 0; e < 4; ++e) { wv[2 * e] = bflo(w0[e]); wv[2 * e + 1] = bfhi(w0[e]); wv[8 + 2 * e] = bflo(w1[e]); wv[8 + 2 * e + 1] = bfhi(w1[e]); }
#pragma unroll
        for (int cond = 0; cond < 5; ++cond) { const float* sh = mod + (size_t)(l * 5 + cond) * 6144 + (which ? 3 : 0) * 1024 + 16 * lane; float dot = 0.f;
#pragma unroll
            for (int q = 0; q < 4; ++q) { const f32x4 s4 = *(const f32x4*)(sh + 4 * q); dot += (s4[0] * wv[4 * q] + s4[1] * wv[4 * q + 1]) + (s4[2] * wv[4 * q + 2] + s4[3] * wv[4 * q + 3]); }
            dot = wave_sum_dpp(dot); if (lane == 0) shw[(size_t)((l * 2 + which) * 5 + cond) * 4096 + n] = dot; }
    }
}

constexpr float SCL = 0.125f * 1.4426950408889634f, LOG2E = 1.4426950408889634f;
__device__ __forceinline__ void vt_write(LAS bf16* Vt, int pitch, int slot, int chunk, u32x4 v) {
    LAS bf16* p = Vt + (8 * chunk) * pitch + slot;
    p[0] = (bf16)(v.x & 0xffffu); p[pitch] = (bf16)(v.x >> 16); p[2 * pitch] = (bf16)(v.y & 0xffffu); p[3 * pitch] = (bf16)(v.y >> 16);
    p[4 * pitch] = (bf16)(v.z & 0xffffu); p[5 * pitch] = (bf16)(v.z >> 16); p[6 * pitch] = (bf16)(v.w & 0xffffu); p[7 * pitch] = (bf16)(v.w >> 16);
}
template <int NB> __device__ __forceinline__ void softmax_part(f32x4 (&s)[NB], float& mx_out, float& sum_out, int lane, float m_floor = -INFINITY) {
    float mx = m_floor;
#pragma unroll
    for (int b = 0; b < NB; ++b) mx = fmaxf(mx, fmaxf(fmaxf(s[b][0], s[b][1]), fmaxf(s[b][2], s[b][3])));
    mx = fmaxf(mx, shx(mx, 16, lane)); mx = fmaxf(mx, shx(mx, 32, lane));
    float sum = 0.f;
#pragma unroll
    for (int b = 0; b < NB; ++b) {
#pragma unroll
        for (int e = 0; e < 4; ++e) { s[b][e] = __builtin_amdgcn_exp2f(s[b][e] - mx); sum += s[b][e]; } }
    sum += shx(sum, 16, lane); sum += shx(sum, 32, lane);
    mx_out = mx; sum_out = sum;
}
__device__ __forceinline__ bf16x8 pack_p(const f32x4& a, const f32x4& b) {
    u32x4 w; w.x = pk2(a[0], a[1]); w.y = pk2(a[2], a[3]); w.z = pk2(b[0], b[1]); w.w = pk2(b[2], b[3]); return __builtin_bit_cast(bf16x8, w);
}
__device__ __forceinline__ bf16x8 vt_read(const LAS bf16* p0, const LAS bf16* p1) {
    const s16x4 a = *(const LAS s16x4*)p0, b = *(const LAS s16x4*)p1; return (bf16x8){a[0], a[1], a[2], a[3], b[0], b[1], b[2], b[3]};
}
__device__ __forceinline__ f32x4 qk_block(const bf16* kp, const bf16x8& qf0, const bf16x8& qf1) {
    const bf16x8 k0 = *(const bf16x8*)kp, k1 = *(const bf16x8*)(kp + 32);
    f32x4 a = __builtin_amdgcn_mfma_f32_16x16x32_bf16(k0, qf0, (f32x4){0.f, 0.f, 0.f, 0.f}, 0, 0, 0);
    return __builtin_amdgcn_mfma_f32_16x16x32_bf16(k1, qf1, a, 0, 0, 0);
}
#define PV16(o, s, SLOT_EXPR, PITCH_) do { _Pragma("unroll") for (int pp = 0; pp < 8; ++pp) { const bf16x8 pf = pack_p(s[2 * pp], s[2 * pp + 1]); const int slot0 = (SLOT_EXPR); \
        _Pragma("unroll") for (int db = 0; db < 4; ++db) { const LAS bf16* vp = Vt + (16 * db + l15) * (PITCH_) + slot0; \
            o[db] = __builtin_amdgcn_mfma_f32_16x16x32_bf16(vt_read(vp, vp + 16), pf, o[db], 0, 0, 0); } } } while (0)

#ifndef CBN
#define CBN 4
#endif
__device__ __forceinline__ void attn_phase(const bf16* Qb, const bf16* Kb, const bf16* Vb, bf16* Ob, const bf16* CK, const bf16* CV, const float* rpb  ,
                                           int li, LAS unsigned char* lds, int tid, int lane, int wave, int G, int bid, int ulo, int uhi) {
    LAS bf16* Vt = (LAS bf16*)lds; LAS float* rpl = (LAS float*)(lds + 110592); LAS unsigned char* Kc = lds + LDS_KC;
    for (int u = bid + ulo; u < uhi; u += G) {
        int lz_ = lane; asm volatile("" : "+v"(lz_));
        const int l15 = lz_ & 15, g = lz_ >> 4;
        if (u < 512) {
            const int b = u >> 4, h = u & 15; constexpr int PITCH = 264;
            const int qrow0 = b * 256 + 32 * wave + l15;
            const bf16x8 qa0 = *(const bf16x8*)(Qb + (size_t)qrow0 * D + h * 64 + 8 * g), qa1 = *(const bf16x8*)(Qb + (size_t)qrow0 * D + h * 64 + 32 + 8 * g);
            const bf16x8 qb0 = *(const bf16x8*)(Qb + (size_t)(qrow0 + 16) * D + h * 64 + 8 * g), qb1 = *(const bf16x8*)(Qb + (size_t)(qrow0 + 16) * D + h * 64 + 32 + 8 * g);
            SB0();
            { int t2 = tid; asm volatile("" : "+v"(t2));
              const int key = t2 & 255, c0 = (t2 >> 8) * 4; const bf16* src = Vb + (size_t)(b * 256 + key) * D + h * 64 + 8 * c0; const bf16* ksrc = Kb + (size_t)(b * 256 + key) * D + h * 64 + 8 * c0;
              u32x4 v[4], kv[4];
#pragma unroll
              for (int c = 0; c < 4; ++c) { v[c] = *(const u32x4*)(src + 8 * c); kv[c] = *(const u32x4*)(ksrc + 8 * c); }
              SB0();
#pragma unroll
              for (int c = 0; c < 4; ++c) *(LAS u32x4*)(Kc + key * 144 + (c0 + c) * 16) = kv[c];
#pragma unroll
              for (int c = 0; c < 4; ++c) vt_write(Vt, PITCH, key, c0 + c, v[c]); }
            __syncthreads();
            SB0();
            f32x4 s0[16], s1[16];
            { const LAS unsigned char* kl = Kc + l15 * 144 + g * 16;
              sfor<16>([&](auto I) __attribute__((always_inline)) { constexpr int kb = decltype(I)::value;
                const bf16x8 k0 = *(const LAS bf16x8*)(kl + kb * (16 * 144)), k1 = *(const LAS bf16x8*)(kl + kb * (16 * 144) + 64);
                f32x4 a = __builtin_amdgcn_mfma_f32_16x16x32_bf16(k0, qa0, (f32x4){0.f, 0.f, 0.f, 0.f}, 0, 0, 0); s0[kb] = __builtin_amdgcn_mfma_f32_16x16x32_bf16(k1, qa1, a, 0, 0, 0) * SCL;
                f32x4 c = __builtin_amdgcn_mfma_f32_16x16x32_bf16(k0, qb0, (f32x4){0.f, 0.f, 0.f, 0.f}, 0, 0, 0); s1[kb] = __builtin_amdgcn_mfma_f32_16x16x32_bf16(k1, qb1, c, 0, 0, 0) * SCL; }); }
            { float mx, sum; softmax_part<16>(s0, mx, sum, lane);
              f32x4 o[4];
#pragma unroll
              for (int db = 0; db < 4; ++db) o[db] = (f32x4){0.f, 0.f, 0.f, 0.f};
              PV16(o, s0, 32 * pp + 4 * g, PITCH);
              const float rl = 1.0f / sum;
#pragma unroll
              for (int db = 0; db < 4; ++db) { const f32x4 ov = o[db] * rl; u32x2 w; w.x = pk2(ov[0], ov[1]); w.y = pk2(ov[2], ov[3]);
                  *(u32x2*)(Ob + (size_t)qrow0 * D + h * 64 + 16 * db + 4 * g) = w; } }
            { float mx, sum; softmax_part<16>(s1, mx, sum, lane);
              f32x4 o[4];
#pragma unroll
              for (int db = 0; db < 4; ++db) o[db] = (f32x4){0.f, 0.f, 0.f, 0.f};
              PV16(o, s1, 32 * pp + 4 * g, PITCH);
              const float rl = 1.0f / sum;
#pragma unroll
              for (int db = 0; db < 4; ++db) { const f32x4 ov = o[db] * rl; u32x2 w; w.x = pk2(ov[0], ov[1]); w.y = pk2(ov[2], ov[3]);
                  *(u32x2*)(Ob + (size_t)(qrow0 + 16) * D + h * 64 + 16 * db + 4 * g) = w; } }
            __syncthreads();
        } else {
            const int ui = u - 512, xcd = ui & 7, idx = (ui >> 3) & 63, uu = (G == 256) ? ((xcd * 8 + (idx >> 3)) << 3) + (idx & 7) : ui;
            const int b = uu >> 7, h = (uu >> 3) & 15, rp = uu & 7, r0 = 2 * rp; constexpr int PITCH = 840;
            const int rs0 = min(max(r0 - 4, 0), 8);
            const size_t tokb = (size_t)MP + (size_t)b * 1024;
            const int r = r0 + (wave >> 2), j = wave & 3, rs = min(max(r - 4, 0), 8), rrel = rs - rs0, kcs = min(max(16 * j - 8, 0), 32);
            const int qcol = 16 * j + l15, wst = min(max(qcol - 8, 0), 48);
            const size_t qtok = tokb + r * 64 + qcol;
            const bf16* kloc = Kb + (tokb + rs * 64 + kcs + l15) * D + h * 64 + 8 * g;
            bf16x8 kf[16][2];
#define LOAD_KLOC(H) sfor<8>([&](auto I) __attribute__((always_inline)) { constexpr int lb = 8 * (H) + decltype(I)::value; const bf16* kp = kloc + (size_t)((lb >> 1) * 64 + 16 * (lb & 1)) * D; kf[lb][0] = *(const bf16x8*)kp; kf[lb][1] = *(const bf16x8*)(kp + 32); })
            LOAD_KLOC(0);
            const bf16x8 qf0 = *(const bf16x8*)(Qb + qtok * D + h * 64 + 8 * g), qf1 = *(const bf16x8*)(Qb + qtok * D + h * 64 + 32 + 8 * g);
            SB0();
            { int t2 = tid; asm volatile("" : "+v"(t2));
              const int slotA = t2, slotB = t2 + NTHR, slotBc = min(slotB, 831);
              const bf16* srcA = (slotA < 576) ? Vb + (tokb + min(rs0 + (slotA >> 6), 15) * 64 + (slotA & 63)) * D + h * 64 : CV + ((size_t)(b * 2 + li) * 256 + (slotA - 576)) * D + h * 64;
              const bf16* srcB = (slotBc < 576) ? Vb + (tokb + min(rs0 + (slotBc >> 6), 15) * 64 + (slotBc & 63)) * D + h * 64 : CV + ((size_t)(b * 2 + li) * 256 + (slotBc - 576)) * D + h * 64;
              const int key = t2 & 255, c0 = (t2 >> 8) * 4; const bf16* ksrc = CK + ((size_t)(b * 2 + li) * 256 + key) * D + h * 64 + 8 * c0;
              u32x4 va[8], vb[8], kv[4];
#pragma unroll
              for (int c = 0; c < 8; ++c) { va[c] = *(const u32x4*)(srcA + 8 * c); vb[c] = *(const u32x4*)(srcB + 8 * c); }
#pragma unroll
              for (int c = 0; c < 4; ++c) kv[c] = *(const u32x4*)(ksrc + 8 * c);
              const float rv = rpb[h * 465 + min(t2, 464)];
              SB0();
#pragma unroll
              for (int c = 0; c < 8; ++c) vt_write(Vt, PITCH, slotA, c, va[c]);
              if (slotB < 832) {
#pragma unroll
                  for (int c = 0; c < 8; ++c) vt_write(Vt, PITCH, slotB, c, vb[c]); }
#pragma unroll
              for (int c = 0; c < 4; ++c) *(LAS u32x4*)(Kc + key * 144 + (c0 + c) * 16) = kv[c];
              if (t2 < 465) rpl[t2] = rv; }
            SB0(); LOAD_KLOC(1); SB0();
            __syncthreads();
            SB0();
            f32x4 o1[4]; float m1, l1, m2, l2;
#pragma unroll
            for (int db = 0; db < 4; ++db) o1[db] = (f32x4){0.f, 0.f, 0.f, 0.f};
            {
                int dcv[8]; unsigned vmask = 0u;
#pragma unroll
                for (int ce = 0; ce < 8; ++ce) { const int kc = kcs + 16 * (ce >> 2) + 4 * g + (ce & 3); vmask |= ((kc >= wst) && (kc < wst + 16)) ? (1u << ce) : 0u; dcv[ce] = min(max(kc - qcol + 15, 0), 30); }
                f32x4 s[16];
#define QK_LOC(H) sfor<8>([&](auto I) __attribute__((always_inline)) { constexpr int lb = 8 * (H) + decltype(I)::value, krow = lb >> 1, ch = lb & 1; \
                    f32x4 a = __builtin_amdgcn_mfma_f32_16x16x32_bf16(kf[lb][0], qf0, (f32x4){0.f, 0.f, 0.f, 0.f}, 0, 0, 0); a = __builtin_amdgcn_mfma_f32_16x16x32_bf16(kf[lb][1], qf1, a, 0, 0, 0); \
                    const LAS float* rp_row = rpl + (rs + krow - r + 7) * 31; float bias[4]; \
                    _Pragma("unroll") for (int e = 0; e < 4; ++e) bias[e] = rp_row[dcv[ch * 4 + e]]; \
                    _Pragma("unroll") for (int e = 0; e < 4; ++e) { const float t = a[e] * SCL + bias[e] * LOG2E; a[e] = ((vmask >> (ch * 4 + e)) & 1u) ? t : -INFINITY; } \
                    s[lb] = a; })
                QK_LOC(0); QK_LOC(1); SB0();
                softmax_part<16>(s, m1, l1, lane);
                PV16(o1, s, (rrel + pp) * 64 + kcs + 4 * g, PITCH);
            }
            SB0();
            {
                f32x4 s[16];
                { const LAS unsigned char* kl = Kc + l15 * 144 + g * 16;
                  sfor<16>([&](auto I) __attribute__((always_inline)) { constexpr int cb = decltype(I)::value;
                    const bf16x8 k0 = *(const LAS bf16x8*)(kl + cb * (16 * 144)), k1 = *(const LAS bf16x8*)(kl + cb * (16 * 144) + 64);
                    f32x4 a = __builtin_amdgcn_mfma_f32_16x16x32_bf16(k0, qf0, (f32x4){0.f, 0.f, 0.f, 0.f}, 0, 0, 0); s[cb] = __builtin_amdgcn_mfma_f32_16x16x32_bf16(k1, qf1, a, 0, 0, 0) * SCL; }); }
                softmax_part<16>(s, m2, l2, lane, m1);
                const float a1 = __builtin_amdgcn_exp2f(m1 - m2);
#pragma unroll
                for (int db = 0; db < 4; ++db) o1[db] = o1[db] * a1;
                l1 = l1 * a1 + l2;
                PV16(o1, s, 576 + 32 * pp + 4 * g, PITCH);
            }
            const float rl = 1.0f / l1;
            int r2_ = r; asm volatile("" : "+s"(r2_));
            const size_t qtok2 = tokb + r2_ * 64 + qcol;
#pragma unroll
            for (int db = 0; db < 4; ++db) { const f32x4 ov = o1[db] * rl; u32x2 w; w.x = pk2(ov[0], ov[1]); w.y = pk2(ov[2], ov[3]);
                *(u32x2*)(Ob + qtok2 * D + h * 64 + 16 * db + 4 * g) = w; }
            __syncthreads();
        }
    }
}

#define RLX_AGENT __ATOMIC_RELAXED, __HIP_MEMORY_SCOPE_AGENT
#define XB_TMO      128
#define XB_XCNT(j)  (256  + 64 * (j))
#define XB_XSUB(j)  (1280 + 64 * (j))
#define XB_XGEN(j)  (2304 + 64 * (j))
#define XB_TOP      3328
#define XB_TOPGEN   3392
#define XCD_BAR_WORDS 3456
#define XB_SPIN_CAP (1u << 18)

__device__ __forceinline__ unsigned xb_ld(unsigned* p)              { return __hip_atomic_load(p, __ATOMIC_RELAXED, __HIP_MEMORY_SCOPE_AGENT); }
__device__ __forceinline__ unsigned xb_add(unsigned* p, unsigned v) { return __hip_atomic_fetch_add(p, v, __ATOMIC_RELAXED, __HIP_MEMORY_SCOPE_AGENT); }
__device__ __forceinline__ unsigned xb_xcc_id() { return (unsigned)__builtin_amdgcn_s_getreg((3 << 11) | 20) & 0xFu; }
#define XB_SPIN(cond, bar) do { unsigned _sp = 0; while (cond) { __builtin_amdgcn_s_sleep(1); \
    if ((++_sp & 255u) == 0u) { if (xb_ld(&(bar)[XB_TMO])) break; if (_sp > XB_SPIN_CAP) { atomicAdd(&(bar)[XB_TMO], 1u); break; } } } } while (0)

struct XcdBarrier {
    unsigned* bar; unsigned x;
    volatile LAS unsigned* st;
};

__device__ __forceinline__ XcdBarrier xcd_barrier_post(unsigned* bar, volatile LAS unsigned* st) {
    XcdBarrier b; b.bar = bar; b.x = xb_xcc_id(); b.st = st;
    if (threadIdx.x == 0) (void)xb_add(&bar[XB_XCNT(b.x)], 1u);
    return b;
}
__device__ __forceinline__ void xcd_barrier_complete(unsigned* bar, unsigned x, unsigned& nloc, unsigned& nx) {
    const unsigned G = gridDim.x * gridDim.y * gridDim.z;
    unsigned sum, cnt, mine, sp = 0u;
    for (;;) {
        sum = 0u; cnt = 0u; mine = 0u;
#pragma unroll
        for (unsigned j = 0; j < 16; ++j) { const unsigned c = xb_ld(&bar[XB_XCNT(j)]); sum += c; cnt += (c > 0u) ? 1u : 0u; mine = (j == x) ? c : mine; }
        if (sum == G) break;
        __builtin_amdgcn_s_sleep(1);
        if ((++sp & 255u) == 0u) { if (xb_ld(&bar[XB_TMO])) break; if (sp > XB_SPIN_CAP) { atomicAdd(&bar[XB_TMO], 1u); break; } }
    }
    nloc = mine > 0u ? mine : 1u; nx = cnt > 0u ? cnt : 1u;
}

__device__ __forceinline__ void xcd_barrier(const XcdBarrier& b) {
    asm volatile("s_waitcnt vmcnt(0)" ::: "memory");
    __syncthreads();
    if (threadIdx.x == 0) {
        unsigned* bar = b.bar;
        __builtin_amdgcn_s_waitcnt(0);
        unsigned nloc = b.st[0], nx = b.st[1];
        if (nloc == 0u) { xcd_barrier_complete(bar, b.x, nloc, nx); b.st[0] = nloc; b.st[1] = nx; }
        const unsigned old = xb_add(&bar[XB_XSUB(b.x)], 1u);
        const unsigned gen = old / nloc;
        if (old + 1u == (gen + 1u) * nloc) {
            __builtin_amdgcn_fence(__ATOMIC_RELEASE, "agent");
            asm volatile("s_waitcnt vmcnt(0)" ::: "memory");
            const unsigned og = xb_add(&bar[XB_TOP], 1u);
            const unsigned tg = og / nx;
            if (og + 1u == (tg + 1u) * nx) xb_add(&bar[XB_TOPGEN], 1u);
            else XB_SPIN(xb_ld(&bar[XB_TOPGEN]) == tg, bar);
            __builtin_amdgcn_fence(__ATOMIC_ACQUIRE, "agent");
            xb_add(&bar[XB_XGEN(b.x)], 1u);
            asm volatile("s_waitcnt vmcnt(0)" ::: "memory");
        } else {
            XB_SPIN(xb_ld(&bar[XB_XGEN(b.x)]) == gen, bar);
            __builtin_amdgcn_fence(__ATOMIC_ACQUIRE, "agent");
            asm volatile("s_waitcnt vmcnt(0)" ::: "memory");
        }
    }
    __syncthreads();
}

constexpr int NPH = 2 + 5 * NL + 1;
struct Args { const float* in[21]; float* out; unsigned char* ws; int nprog, pad; int prog[48]; };
typedef const __attribute__((address_space(4))) Args* KArgPtr;
__global__ void __launch_bounds__(NTHR, 2) fwd_kernel(Args a_unused) {
    extern __shared__ __attribute__((aligned(16))) unsigned char lds_raw[];
    LAS unsigned char* lds = (LAS unsigned char*)lds_raw;
    cg::grid_group grid = cg::this_grid();
    const int wave0 = __builtin_amdgcn_readfirstlane((int)threadIdx.x >> 6);
    { volatile LAS unsigned* st0 = (volatile LAS unsigned*)(lds + LDS_ST); if (threadIdx.x < 2) st0[threadIdx.x] = 0u; }
    __syncthreads();
    XcdBarrier xbar; { KArgPtr kpb = (KArgPtr)__builtin_amdgcn_kernarg_segment_ptr(); xbar.bar = (unsigned*)kpb->ws; xbar.x = 0; xbar.st = (volatile LAS unsigned*)(lds + LDS_ST);
        if (blockIdx.x == 0) { for (int wI = threadIdx.x; wI < XCD_BAR_WORDS; wI += NTHR) __hip_atomic_store(xbar.bar + wI, 0u, __ATOMIC_RELAXED, __HIP_MEMORY_SCOPE_AGENT); } }
    int nprog; { KArgPtr kp0 = (KArgPtr)__builtin_amdgcn_kernarg_segment_ptr(); nprog = kp0->nprog; }
    for (int pc = 0; pc < nprog; ++pc) {
        KArgPtr kp = (KArgPtr)__builtin_amdgcn_kernarg_segment_ptr(); asm volatile("" : "+s"(kp));
        int z_ = 0; asm volatile("" : "+s"(z_));
        const int lane_ = (int)__builtin_amdgcn_mbcnt_hi(~0u, __builtin_amdgcn_mbcnt_lo(~0u, (unsigned)z_)); const int tid_ = wave0 * 64 + lane_;
        int bid_ = (int)__builtin_amdgcn_workgroup_id_x(), G_ = (int)gridDim.x; asm volatile("" : "+s"(bid_), "+s"(G_));
        const int pe_ = kp->prog[pc]; const int ph = pe_ & 63, amode = pe_ >> 6;
        const int tid = tid_, lane = lane_, wave = wave0, G = G_, bid = bid_;
        const int gw = bid * NWAVES + wave, NGW = G * NWAVES;
        Ptrs P; P = Ptrs{kp->in[0], kp->in[1], kp->in[2], kp->in[3], kp->in[4], kp->in[5], kp->in[6], kp->in[7], kp->in[8], kp->in[9], kp->in[10], kp->in[11], kp->in[12], kp->in[13], kp->in[14], kp->in[15], kp->in[16], kp->in[17], kp->in[18], kp->in[19], kp->in[20]};
        unsigned char* ws = kp->ws; float* outp = kp->out;
        float* mod = (float*)(ws + WS_MOD); bf16* Wt = (bf16*)(ws + WS_W); bf16* X = (bf16*)(ws + WS_X); bf16* H = (bf16*)(ws + WS_H);
        bf16* R = (bf16*)(ws + WS_R); bf16* Qb = R; bf16* Kb = R + (size_t)M * D; bf16* Vb = R + (size_t)2 * M * D; bf16* Ob = R + (size_t)3 * M * D;
        bf16* Ub = R; bf16* Vc = R + (size_t)M * D; bf16* Fb = R;
        const bf16* CK = (const bf16*)(ws + WS_CK); const bf16* CV = (const bf16*)(ws + WS_CV);
        float* out_y = outp; float* out_ck = outp + (size_t)M * D; float* out_cv = out_ck + (size_t)32 * 2 * 256 * 1024;
        float* SS = (float*)(ws + WS_SS); float* SHW = (float*)(ws + WS_SHW);
        if (ph == 0) { p0_phase(P, ws, lds, tid, lane, wave, G, bid); }
        else if (ph == 1) { prep_phase(P.x_prompt, P.x_sample, H, SS, P.norm_g, mod + 1 * 1024, mod, Wt, SHW, gw, NGW, lane); }
        else if (ph == NPH - 1) { final_norm_phase(X, out_y, P.final_g, gw, NGW, lane); }
        else if (ph >= 60) { }
        else {
            const int l = (ph - 2) / 5, s = (ph - 2) % 5, i = l >> 1; const bool conv = (l & 1) != 0;
            const float* modl = mod + (size_t)l * 5 * 6144;
            if (s == 0) {
                const float* ssl = SS + (size_t)(2 * l) * M; const float* shl = SHW + (size_t)((2 * l) * 5) * 4096;
                if (!conv) { pg8::Gemm gm{H, Wt + W_QKV + (size_t)i * 3 * MEL, M, 3 * D, D}; pg8::StaticOrder S; S.init(M, 3 * D, G, bid);
                    pg8::EpiQKV E{ssl, shl, Qb, (size_t)M * D, out_ck + (size_t)i * 256 * 1024, (size_t)32 * 2 * 256 * 1024};
                    pg8::gemm_phase<pg8::EpiQKV, pg8::StaticOrder, true, true>(lds, gm, S, E, tid); }
                else { pg8::Gemm gm{H, Wt + W_PW1 + (size_t)i * 2 * MEL, M, 2 * D, D}; pg8::StaticOrder S; S.init(M, 2 * D, G, bid);
                    pg8::EpiGLU E{ssl, shl, Ub};
                    pg8::gemm_phase<pg8::EpiGLU, pg8::StaticOrder, true, true>(lds, gm, S, E, tid); }
            } else if (s == 1) {
                if (!conv) attn_phase(Qb, Kb, Vb, Ob, CK, CV, P.rpb + (size_t)i * 16 * 15 * 31, i, lds, tid, lane, wave, G, bid, amode == 2 ? 512 : 0, amode == 1 ? 512 : 1024);
                else conv_phase(Ub, Vc, P.w_dw + (size_t)i * 31 * D, P.b_dw + i * D, P.ln_g + i * D, P.ln_b + i * D, lds, tid, lane, wave, G, bid);
            } else if (s == 2 || s == 4) {
                pg8::Gemm gm; pg8::EpiRes E;
                if (s == 2) { gm = pg8::Gemm{conv ? Vc : Ob, Wt + (conv ? W_PW2 : W_O) + (size_t)i * MEL, M, D, D};
                    E = pg8::EpiRes{P.x_prompt, P.x_sample, l == 0 ? (const bf16*)nullptr : X, X, modl + 2 * 1024, H, P.norm_g + (l * 2 + 1) * D, modl + 4 * 1024, SS + (size_t)(2 * l + 1) * M}; }
                else { gm = pg8::Gemm{Fb, Wt + W_DOWN + (size_t)l * 4 * MEL, M, D, FF};
                    E = pg8::EpiRes{P.x_prompt, P.x_sample, X, X, modl + 5 * 1024, l < NL - 1 ? H : nullptr, P.norm_g + ((l + 1) * 2) * D, modl + 5 * 6144 + 1 * 1024, SS + (size_t)(2 * l + 2) * M}; }
                pg8::StaticOrder S; S.init(M, D, G, bid);
                pg8::gemm_phase<pg8::EpiRes, pg8::StaticOrder, true, true>(lds, gm, S, E, tid);
            } else {
#ifdef UP256
                pg8::Gemm gm{H, Wt + W_UP + (size_t)l * 4 * MEL, M, FF, D}; pg8::StaticOrder256 S; S.init(M, FF, G, bid);
                pg8::EpiUp256 E{SS + (size_t)(2 * l + 1) * M, SHW + (size_t)((2 * l + 1) * 5) * 4096, Fb, FF};
                pg8::gemm_phase256<pg8::EpiUp256, pg8::StaticOrder256, true, true>(lds, gm, S, E, tid);
#else
                pg8::Gemm gm{H, Wt + W_UP + (size_t)l * 4 * MEL, M, FF, D}; pg8::StaticOrder S; S.init(M, FF, G, bid);
                pg8::EpiUp E{SS + (size_t)(2 * l + 1) * M, SHW + (size_t)((2 * l + 1) * 5) * 4096, Fb, FF};
                pg8::gemm_phase<pg8::EpiUp, pg8::StaticOrder, true, true>(lds, gm, S, E, tid);
#endif
            }
        }
        if (pc + 1 < nprog) { if (pc == 0) { grid.sync(); xbar = xcd_barrier_post(xbar.bar, xbar.st); } else xcd_barrier(xbar); }
    }
}

#ifndef SINGLE_LAUNCH
#define SINGLE_LAUNCH 0
#endif
extern "C" void kernel_launch(void* const* d_in, const int* in_sizes, int n_in, void* d_out, int out_size, void* d_ws, size_t ws_size, hipStream_t stream) {
    static int grid = 0;
    if (grid == 0) {
        if (n_in != 21 || ws_size < WS_END) { fprintf(stderr, "kernel_launch: unexpected n_in %d / ws_size %zu\n", n_in, ws_size); grid = -1; return; }
        int dev = 0, cus = 0, per_cu = 0;
        hipGetDevice(&dev); hipDeviceGetAttribute(&cus, hipDeviceAttributeMultiprocessorCount, dev);
        hipFuncSetAttribute((const void*)fwd_kernel, hipFuncAttributeMaxDynamicSharedMemorySize, LDS_BYTES);
        hipOccupancyMaxActiveBlocksPerMultiprocessor(&per_cu, (const void*)fwd_kernel, NTHR, LDS_BYTES);
        if (per_cu < 1) { fprintf(stderr, "kernel_launch: occupancy query says %d blocks/CU\n", per_cu); per_cu = 1; }
        (void)hipGetLastError();
        grid = cus * per_cu;
    }
    if (grid < 0) return;
    Args a{};
    for (int i = 0; i < 21; ++i) a.in[i] = (const float*)d_in[i];
    a.out = (float*)d_out; a.ws = (unsigned char*)d_ws;
#if SINGLE_LAUNCH
    { int n = 0;
      for (int ph = 0; ph < NPH; ++ph) { a.prog[n++] = ph;
#ifdef PROBE_ATTN_MODE
          if (ph >= 2 && ph < NPH - 1 && (ph - 2) % 5 == 1 && ((ph - 2) / 5) % 2 == 0) a.prog[n++] = ph | (PROBE_ATTN_MODE << 6);
#endif
#ifdef PROBE_EMPTY
          if (ph == 5) for (int q = 0; q < PROBE_EMPTY; ++q) a.prog[n++] = 60;
#endif
#ifdef PROBE_REPEAT_P0
          if (ph == 0) a.prog[n++] = 0;
#endif
#ifdef PROBE_REPEAT_S
          if (ph >= 2 && ph < NPH - 1 && (ph - 2) % 5 == PROBE_REPEAT_S && (PROBE_REPEAT_PAR < 0 || ((ph - 2) / 5) % 2 == PROBE_REPEAT_PAR)) a.prog[n++] = ph;
#endif
      }
      a.nprog = n; }
    void* args[] = {&a};
    hipError_t e = hipLaunchCooperativeKernel((const void*)fwd_kernel, dim3(grid), dim3(NTHR), args, LDS_BYTES, stream);
    if (e != hipSuccess) fprintf(stderr, "cooperative launch failed: %s (grid %d)\n", hipGetErrorString(e), grid);
#else
    for (int ph = 0; ph < NPH; ++ph) { a.nprog = 1; a.prog[0] = ph; hipLaunchKernelGGL(fwd_kernel, dim3(grid), dim3(NTHR), LDS_BYTES, stream, a); }
#endif
}
```

```cpp
#define SINGLE_LAUNCH 1
#define UP256 1
#include <hip/hip_runtime.h>
#include <hip/hip_cooperative_groups.h>
#include <cstdio>
#include <cstdint>
#include <cmath>
#include <utility>
namespace cg = cooperative_groups;
namespace pg8 {
#define PG8_LAS __attribute__((address_space(3)))
typedef unsigned short bf16_t;
typedef short bf16x8 __attribute__((ext_vector_type(8)));
typedef float f32x4 __attribute__((ext_vector_type(4)));
typedef unsigned u32x4 __attribute__((ext_vector_type(4)));
constexpr int RM = 192;
constexpr int BM = 256, BK = 64, HALF = 128, HTB = HALF * BK * 2  , STAGE_BYTES = 8 * HTB, NXCD = 8, WGM = 8;

__host__ __device__ __forceinline__ int lds_byte(int r, int c) { const int st = (r >> 4) * 2 + (c >> 5), rr = r & 15, cc = c & 31, ob = rr * 64 + cc * 2; return st * 1024 + (ob ^ (((ob >> 9) & 1) << 5)); }
__host__ __device__ __forceinline__ void stage_rc(int b, int& R, int& C) { const int st = b / 1024, sb = b % 1024, swz = sb ^ (((sb >> 9) & 1) << 5); R = (st >> 1) * 16 + swz / 64; C = (st & 1) * 32 + (swz % 64) / 2; }
__host__ __device__ __forceinline__ int perm32(int rho) { const int n = rho >> 4, i = rho & 15; return 8 * (i >> 2) + 4 * n + (i & 3); }

struct Unit { int pm, pn; };
struct Gemm { const bf16_t* A; const bf16_t* Bt; int M, N, K; };

struct StaticOrder {
    int nM, nN, nwg, G, c;
    __host__ __device__ void init(int M, int N, int G_, int c_) { nM = M / RM; nN = N / BM; nwg = nM * nN; G = G_; c = c_; }
    __host__ __device__ bool next(int i, Unit& u) const {
        const long L = (long)i * G + c; if (L >= nwg) return false;
        int wgid = (int)L; { const int q = nwg / NXCD, r = nwg % NXCD, xcd = wgid % NXCD, off = wgid / NXCD; wgid = (xcd < r ? xcd * (q + 1) : r * (q + 1) + (xcd - r) * q) + off; }
        const int nig = WGM * nN, gid = wgid / nig, fm = gid * WGM, gsz = (nM - fm) < WGM ? (nM - fm) : WGM;
        u.pm = fm + ((wgid % nig) % gsz); u.pn = (wgid % nig) / gsz; return true;
    }
    __device__ __forceinline__ void a_ready(const Unit&) const {}
    __device__ __forceinline__ void done(const Unit&) const {}
};

__device__ __forceinline__ unsigned cvt_pk_bf16(float lo, float hi) { unsigned r; asm volatile("v_cvt_pk_bf16_f32 %0, %1, %2" : "=v"(r) : "v"(lo), "v"(hi)); return r; }
typedef float f32x2 __attribute__((ext_vector_type(2)));
__device__ __forceinline__ int cond_of_row(int r) { return r < 8192 ? 0 : 1 + ((r - 8192) >> 10); }
__device__ __forceinline__ int half_row0(int ai, int wr) { return ai == 0 ? wr * 64 : 128 + wr * 32; }
#define EPI_MLOOP(ai, m) _Pragma("unroll") for (int m = 0; m < 4; ++m) if (ai == 0 || m < 2)
struct EpiQKV {
    static constexpr bool PERM = true, AFTER_DRAIN = false;
    const float* ss; const float* shw;
    bf16_t* Q; size_t qkv_stride; float* ck; size_t ckv_stride;
    __device__ __forceinline__ void operator()(const f32x4 (&acc)[2][2][4][2], const Unit& u, int wr, int wc, int fr, int fq) const {
        const int t = u.pn >> 2;
        bf16_t* base = Q + (size_t)t * qkv_stride;
        const int col0 = (u.pn & 3) * BM + wc * 32 + 8 * fq;
        float* cbase = ck + (size_t)(t > 0 ? t - 1 : 0) * ckv_stride + col0;
#pragma unroll
        for (int ai = 0; ai < 2; ++ai) { const int rbase = u.pm * RM + half_row0(ai, wr) + fr; const bool wc_ = (t > 0) && (rbase < 8192);
            const float* sp = shw + cond_of_row(rbase) * 4096 + u.pn * BM + wc * 32 + 8 * fq;
            f32x4 sv[2][2];
#pragma unroll
            for (int bj = 0; bj < 2; ++bj) { sv[bj][0] = *(const f32x4*)(sp + bj * HALF); sv[bj][1] = *(const f32x4*)(sp + bj * HALF + 4); }
            float rr[4];
            EPI_MLOOP(ai, m) rr[m] = ss[rbase + m * 16];
            EPI_MLOOP(ai, m) { const int row = rbase + m * 16; bf16_t* rowp = base + (size_t)row * 1024 + col0;
                const float r = __builtin_amdgcn_rsqf(rr[m] * (1.f / 1024.f) + 1e-6f);
                float* cp0 = cbase + ((size_t)(row >> 8) * 2 * 256 + (row & 255)) * 1024;
#pragma unroll
                for (int bj = 0; bj < 2; ++bj) { const f32x4 v0 = acc[ai][bj][m][0] * r + sv[bj][0], v1 = acc[ai][bj][m][1] * r + sv[bj][1];
                    u32x4 w; w.x = cvt_pk_bf16(v0[0], v0[1]); w.y = cvt_pk_bf16(v0[2], v0[3]); w.z = cvt_pk_bf16(v1[0], v1[1]); w.w = cvt_pk_bf16(v1[2], v1[3]);
                    *(u32x4*)(rowp + bj * HALF) = w;
                    if (wc_) { float* cp = cp0 + bj * HALF; __builtin_nontemporal_store(v0, (f32x4*)cp); __builtin_nontemporal_store(v1, (f32x4*)(cp + 4)); } } } }
    }
};
struct EpiUp {
    static constexpr bool PERM = true, AFTER_DRAIN = false;
    const float* ss; const float* shw; bf16_t* O; int ldc;
    __device__ __forceinline__ void operator()(const f32x4 (&acc)[2][2][4][2], const Unit& u, int wr, int wc, int fr, int fq) const {
        const int col0 = u.pn * BM + wc * 32 + 8 * fq;
#pragma unroll
        for (int ai = 0; ai < 2; ++ai) { const int rbase = u.pm * RM + half_row0(ai, wr) + fr;
            const float* sp = shw + cond_of_row(rbase) * 4096 + col0;
            f32x4 sv[2][2];
#pragma unroll
            for (int bj = 0; bj < 2; ++bj) { sv[bj][0] = *(const f32x4*)(sp + bj * HALF); sv[bj][1] = *(const f32x4*)(sp + bj * HALF + 4); }
            float rr[4];
            EPI_MLOOP(ai, m) rr[m] = ss[rbase + m * 16];
            EPI_MLOOP(ai, m) { bf16_t* rowp = O + (size_t)(rbase + m * 16) * ldc + col0;
                const float r = __builtin_amdgcn_rsqf(rr[m] * (1.f / 1024.f) + 1e-6f);
#pragma unroll
                for (int bj = 0; bj < 2; ++bj) { f32x4 v0 = acc[ai][bj][m][0] * r + sv[bj][0], v1 = acc[ai][bj][m][1] * r + sv[bj][1];
#pragma unroll
                    for (int e = 0; e < 4; ++e) { const float a = fmaxf(v0[e], 0.f), b = fmaxf(v1[e], 0.f); v0[e] = a * a; v1[e] = b * b; }
                    u32x4 w; w.x = cvt_pk_bf16(v0[0], v0[1]); w.y = cvt_pk_bf16(v0[2], v0[3]); w.z = cvt_pk_bf16(v1[0], v1[1]); w.w = cvt_pk_bf16(v1[2], v1[3]);
                    *(u32x4*)(rowp + bj * HALF) = w; } } }
    }
};
struct EpiGLU {
    static constexpr bool PERM = true, AFTER_DRAIN = false;
    const float* ss; const float* shw; bf16_t* O;
    __device__ __forceinline__ void operator()(const f32x4 (&acc)[2][2][4][2], const Unit& u, int wr, int wc, int fr, int fq) const {
        const int col0 = u.pn * HALF + wc * 32 + 8 * fq;
#pragma unroll
        for (int ai = 0; ai < 2; ++ai) { const int rbase = u.pm * RM + half_row0(ai, wr) + fr;
            const float* sp = shw + cond_of_row(rbase) * 4096 + u.pn * BM + wc * 32 + 8 * fq;
            f32x4 sv[2][2];
#pragma unroll
            for (int bj = 0; bj < 2; ++bj) { sv[bj][0] = *(const f32x4*)(sp + bj * HALF); sv[bj][1] = *(const f32x4*)(sp + bj * HALF + 4); }
            float rr[4];
            EPI_MLOOP(ai, m) rr[m] = ss[rbase + m * 16];
            EPI_MLOOP(ai, m) { bf16_t* rowp = O + (size_t)(rbase + m * 16) * 1024 + col0;
                const float r = __builtin_amdgcn_rsqf(rr[m] * (1.f / 1024.f) + 1e-6f);
                f32x4 v0 = acc[ai][0][m][0] * r + sv[0][0], v1 = acc[ai][0][m][1] * r + sv[0][1]; const f32x4 g0 = acc[ai][1][m][0] * r + sv[1][0], g1 = acc[ai][1][m][1] * r + sv[1][1];
#pragma unroll
                for (int e = 0; e < 4; ++e) { v0[e] = v0[e] * __builtin_amdgcn_rcpf(1.f + __expf(-g0[e])); v1[e] = v1[e] * __builtin_amdgcn_rcpf(1.f + __expf(-g1[e])); }
                u32x4 w; w.x = cvt_pk_bf16(v0[0], v0[1]); w.y = cvt_pk_bf16(v0[2], v0[3]); w.z = cvt_pk_bf16(v1[0], v1[1]); w.w = cvt_pk_bf16(v1[2], v1[3]);
                *(u32x4*)rowp = w; } }
    }
};
struct EpiRes {
    static constexpr bool PERM = false, AFTER_DRAIN = false;
    const float* base_p; const float* base_s; const bf16_t* base_b; bf16_t* out; const float* gate;
    bf16_t* xb; const float* g_next; const float* sc_next; float* ss_next;
    __device__ __forceinline__ void operator()(const f32x4 (&acc)[2][2][4][2], const Unit& u, int wr, int wc, int fr, int fq) const {
        typedef unsigned u32x2e __attribute__((ext_vector_type(2)));
        const int col0 = u.pn * BM + wc * 32 + 4 * fq;
        const int lane_x = fq * 16 + fr;
#pragma unroll
        for (int ai = 0; ai < 2; ++ai) { const int row0 = u.pm * RM + half_row0(ai, wr) + fr; const int cond = cond_of_row(row0);
            const float* gp = gate + cond * 6144 + col0;
            const float* bp = (row0 < 8192) ? base_p + (size_t)row0 * 1024 + col0 : base_s + (size_t)(row0 - 8192) * 1024 + col0;
            const bf16_t* bb = base_b + (size_t)row0 * 1024 + col0;
            bf16_t* op = out + (size_t)row0 * 1024 + col0;
            f32x4 gv[2][2], gs[2][2];
#pragma unroll
            for (int bj = 0; bj < 2; ++bj)
#pragma unroll
                for (int n = 0; n < 2; ++n) gv[bj][n] = *(const f32x4*)(gp + bj * HALF + n * 16);
            if (xb) { f32x4 ga[2][2], sa[2][2];
#pragma unroll
                for (int bj = 0; bj < 2; ++bj)
#pragma unroll
                    for (int n = 0; n < 2; ++n) { ga[bj][n] = *(const f32x4*)(g_next + col0 + bj * HALF + n * 16); sa[bj][n] = *(const f32x4*)(sc_next + cond * 6144 + col0 + bj * HALF + n * 16); }
#pragma unroll
                for (int bj = 0; bj < 2; ++bj)
#pragma unroll
                    for (int n = 0; n < 2; ++n) gs[bj][n] = ga[bj][n] * (1.f + sa[bj][n]); }
#pragma unroll
            for (int mp = 0; mp < 2; ++mp) if (ai == 0 || mp == 0) { f32x4 bs[2][2][2];
                if (base_b) {
#pragma unroll
                    for (int mm = 0; mm < 2; ++mm)
#pragma unroll
                        for (int bj = 0; bj < 2; ++bj)
#pragma unroll
                            for (int n = 0; n < 2; ++n) { const u32x2e w = *(const u32x2e*)(bb + (size_t)((2 * mp + mm) * 16) * 1024 + bj * HALF + n * 16);
                                bs[mm][bj][n] = (f32x4){__builtin_bit_cast(float, w.x << 16), __builtin_bit_cast(float, w.x & 0xffff0000u), __builtin_bit_cast(float, w.y << 16), __builtin_bit_cast(float, w.y & 0xffff0000u)}; }
                } else {
#pragma unroll
                    for (int mm = 0; mm < 2; ++mm)
#pragma unroll
                        for (int bj = 0; bj < 2; ++bj)
#pragma unroll
                            for (int n = 0; n < 2; ++n) bs[mm][bj][n] = *(const f32x4*)(bp + (size_t)((2 * mp + mm) * 16) * 1024 + bj * HALF + n * 16);
                }
#pragma unroll
                for (int mm = 0; mm < 2; ++mm) { float sq = 0.f;
#pragma unroll
                    for (int bj = 0; bj < 2; ++bj)
#pragma unroll
                        for (int n = 0; n < 2; ++n) { const f32x4 xn = bs[mm][bj][n] + gv[bj][n] * acc[ai][bj][2 * mp + mm][n];
                            { u32x2e w; w.x = cvt_pk_bf16(xn[0], xn[1]); w.y = cvt_pk_bf16(xn[2], xn[3]); *(u32x2e*)(op + (size_t)((2 * mp + mm) * 16) * 1024 + bj * HALF + n * 16) = w; }
                            if (xb) { const f32x4 hb = xn * gs[bj][n]; u32x2e w; w.x = cvt_pk_bf16(hb[0], hb[1]); w.y = cvt_pk_bf16(hb[2], hb[3]);
                                *(u32x2e*)(xb + (size_t)(row0 + (2 * mp + mm) * 16) * 1024 + col0 + bj * HALF + n * 16) = w;
                                sq += (xn[0] * xn[0] + xn[1] * xn[1]) + (xn[2] * xn[2] + xn[3] * xn[3]); } }
                    if (xb) {
                        sq += __builtin_bit_cast(float, __builtin_amdgcn_ds_bpermute((lane_x ^ 16) << 2, __builtin_bit_cast(int, sq)));
                        sq += __builtin_bit_cast(float, __builtin_amdgcn_ds_bpermute((lane_x ^ 32) << 2, __builtin_bit_cast(int, sq)));
                        if (fq == 0) atomicAdd(ss_next + row0 + (2 * mp + mm) * 16, sq); } }
                asm volatile("" ::: "memory"); } }
    }
};

struct StaticOrder256 {
    int nM, nN, nwg, G, c;
    __host__ __device__ void init(int M, int N, int G_, int c_) { nM = M / BM; nN = N / BM; nwg = nM * nN; G = G_; c = c_; }
    __host__ __device__ bool next(int i, Unit& u) const {
        const long L = (long)i * G + c; if (L >= nwg) return false;
        int wgid = (int)L; { const int q = nwg / NXCD, r = nwg % NXCD, xcd = wgid % NXCD, off = wgid / NXCD; wgid = (xcd < r ? xcd * (q + 1) : r * (q + 1) + (xcd - r) * q) + off; }
        const int nig = WGM * nN, gid = wgid / nig, fm = gid * WGM, gsz = (nM - fm) < WGM ? (nM - fm) : WGM;
        u.pm = fm + ((wgid % nig) % gsz); u.pn = (wgid % nig) / gsz; return true;
    }
    __device__ __forceinline__ void a_ready(const Unit&) const {}
    __device__ __forceinline__ void done(const Unit&) const {}
};
struct EpiUp256 {
    static constexpr bool PERM = true, AFTER_DRAIN = false;
    const float* ss; const float* shw; bf16_t* O; int ldc;
    __device__ __forceinline__ void operator()(const f32x4 (&acc)[2][2][4][2], const Unit& u, int wr, int wc, int fr, int fq) const {
        const int col0 = u.pn * BM + wc * 32 + 8 * fq;
#pragma unroll
        for (int ai = 0; ai < 2; ++ai) { const int rbase = u.pm * BM + ai * HALF + wr * 64 + fr;
            const float* sp = shw + cond_of_row(rbase) * 4096 + col0;
            f32x4 sv[2][2];
#pragma unroll
            for (int bj = 0; bj < 2; ++bj) { sv[bj][0] = *(const f32x4*)(sp + bj * HALF); sv[bj][1] = *(const f32x4*)(sp + bj * HALF + 4); }
            float rr[4];
#pragma unroll
            for (int m = 0; m < 4; ++m) rr[m] = ss[rbase + m * 16];
#pragma unroll
            for (int m = 0; m < 4; ++m) { bf16_t* rowp = O + (size_t)(rbase + m * 16) * ldc + col0;
                const float r = __builtin_amdgcn_rsqf(rr[m] * (1.f / 1024.f) + 1e-6f);
#pragma unroll
                for (int bj = 0; bj < 2; ++bj) { f32x4 v0 = acc[ai][bj][m][0] * r + sv[bj][0], v1 = acc[ai][bj][m][1] * r + sv[bj][1];
#pragma unroll
                    for (int e = 0; e < 4; ++e) { const float a = fmaxf(v0[e], 0.f), b = fmaxf(v1[e], 0.f); v0[e] = a * a; v1[e] = b * b; }
                    u32x4 w; w.x = cvt_pk_bf16(v0[0], v0[1]); w.y = cvt_pk_bf16(v0[2], v0[3]); w.z = cvt_pk_bf16(v1[0], v1[1]); w.w = cvt_pk_bf16(v1[2], v1[3]);
                    *(u32x4*)(rowp + bj * HALF) = w; } } }
    }
};
template <class Epi, class Sched, bool ALIGN_EPI = false, bool SP2 = false>
__device__ __forceinline__ void gemm_phase256(PG8_LAS unsigned char* lds, const Gemm g, const Sched& S, const Epi& E, const int tid) {
    const int wid = __builtin_amdgcn_readfirstlane(tid >> 6), lane = tid & 63, wr = wid >> 2, wc = wid & 3, fr = lane & 15, fq = lane >> 4;
    const int K = g.K, nt = K / BK;
    unsigned voffA[2], voffB[2];
#pragma unroll
    for (int i = 0; i < 2; ++i) { int R, C; stage_rc(tid * 16 + i * 8192, R, C); const int Rb = Epi::PERM ? ((R & ~31) + perm32(R & 31)) : R;
        voffA[i] = (unsigned)(R * K + C) * 2u; voffB[i] = (unsigned)(Rb * K + C) * 2u; }
    const size_t kstep = (size_t)(BK * 2);
    const size_t hstep = (size_t)HALF * K * 2;
    const size_t tstep = 2 * hstep;
    const unsigned ldsw = (unsigned)wid * 1024u;
    const int aoff = lds_byte(wr * 64 + fr, fq * 8), boff = lds_byte(wc * 32 + fr, fq * 8);
#define PG8_SA(b, h) (((b) * 2 + (h)) * HTB)
#define PG8_SB(b, h) ((4 + (b) * 2 + (h)) * HTB)
#define PG8_STAGE(bufoff, gbase, voff) do { _Pragma("unroll") for (int _i = 0; _i < 2; ++_i) \
        __builtin_amdgcn_global_load_lds((const unsigned*)((const char*)(gbase) + (voff)[_i]), (PG8_LAS unsigned*)(lds + (bufoff) + ldsw + _i * 8192), 16, 0, 0); } while (0)
#define PG8_LDA(dst, b, h) do { _Pragma("unroll") for (int m = 0; m < 4; ++m) _Pragma("unroll") for (int k = 0; k < 2; ++k) dst[m][k] = *(const PG8_LAS bf16x8*)(lds + PG8_SA(b, h) + aoff + m * 2048 + k * 1024); } while (0)
#define PG8_LDB(dst, b, h) do { _Pragma("unroll") for (int n = 0; n < 2; ++n) _Pragma("unroll") for (int k = 0; k < 2; ++k) dst[n][k] = *(const PG8_LAS bf16x8*)(lds + PG8_SB(b, h) + boff + n * 2048 + k * 1024); } while (0)
#define PG8_MMA(ai, bj, At, Bt) do { __builtin_amdgcn_s_setprio(1); _Pragma("unroll") for (int m = 0; m < 4; ++m) _Pragma("unroll") for (int n = 0; n < 2; ++n) _Pragma("unroll") for (int k = 0; k < 2; ++k) \
        acc[ai][bj][m][n] = __builtin_amdgcn_mfma_f32_16x16x32_bf16(Bt[n][k], At[m][k], acc[ai][bj][m][n], 0, 0, 0); __builtin_amdgcn_s_setprio(0); } while (0)
#define PG8_WAIT_V(n) asm volatile("s_waitcnt vmcnt(" #n ")" ::: "memory")
#define PG8_WAIT_L(n) asm volatile("s_waitcnt lgkmcnt(" #n ")" ::: "memory")
#define PG8_BAR __builtin_amdgcn_s_barrier()
#define PG8_SCHED __builtin_amdgcn_sched_barrier(0)
    Unit cur, nxt; int ui = 0;
    if (!S.next(0, cur)) return;
    f32x4 acc[2][2][4][2];
#pragma unroll
    for (int a = 0; a < 2; ++a)
#pragma unroll
        for (int b = 0; b < 2; ++b)
#pragma unroll
            for (int m = 0; m < 4; ++m)
#pragma unroll
                for (int n = 0; n < 2; ++n) acc[a][b][m][n] = (f32x4){0.f, 0.f, 0.f, 0.f};
    bf16x8 At[4][2], B0[2][2], B1[2][2];
    const char* cA = (const char*)g.A + (size_t)cur.pm * tstep; const char* cB = (const char*)g.Bt + (size_t)cur.pn * tstep;
    S.a_ready(cur);
    if constexpr (SP2) {
        PG8_STAGE(PG8_SB(0, 0), cB, voffB); PG8_STAGE(PG8_SB(0, 1), cB + hstep, voffB); PG8_STAGE(PG8_SA(0, 0), cA, voffA); PG8_STAGE(PG8_SA(0, 1), cA + hstep, voffA);
        if (wr == 1) PG8_BAR;
        PG8_WAIT_V(2); PG8_BAR;
        PG8_STAGE(PG8_SB(1, 0), cB + kstep, voffB); PG8_STAGE(PG8_SA(1, 0), cA + kstep, voffA); PG8_STAGE(PG8_SB(1, 1), cB + hstep + kstep, voffB);
        PG8_WAIT_V(6); PG8_BAR;
    } else {
        PG8_STAGE(PG8_SB(0, 0), cB, voffB); PG8_STAGE(PG8_SA(0, 0), cA, voffA); PG8_STAGE(PG8_SB(0, 1), cB + hstep, voffB); PG8_STAGE(PG8_SA(0, 1), cA + hstep, voffA);
        if (wr == 1) PG8_BAR;
        PG8_WAIT_V(4); PG8_BAR;
        PG8_STAGE(PG8_SB(1, 0), cB + kstep, voffB); PG8_STAGE(PG8_SA(1, 0), cA + kstep, voffA); PG8_STAGE(PG8_SB(1, 1), cB + hstep + kstep, voffB);
        PG8_WAIT_V(6); PG8_BAR;
    }
    for (;;) {
        const bool has_next = S.next(ui + 1, nxt);
        const char* nA = has_next ? (const char*)g.A + (size_t)nxt.pm * tstep : cA; const char* nB = has_next ? (const char*)g.Bt + (size_t)nxt.pn * tstep : cB;
        for (int t = 0; t < nt; t += 2) {
            const bool last = (t == nt - 2);
            const char* a1 = cA + (size_t)(t + 1) * kstep;
            const char* a2 = last ? nA : cA + (size_t)(t + 2) * kstep; const char* b2 = last ? nB : cB + (size_t)(t + 2) * kstep;
            const char* a3 = a2 + kstep; const char* b3 = b2 + kstep;
            if (last && has_next) S.a_ready(nxt);
            if constexpr (SP2) {
            PG8_LDB(B0, 0, 0); PG8_LDB(B1, 0, 1); PG8_SCHED; PG8_LDA(At, 0, 0); PG8_STAGE(PG8_SA(1, 1), a1 + hstep, voffA);
            PG8_WAIT_V(8); PG8_WAIT_L(0); PG8_BAR; PG8_MMA(0, 0, At, B0); PG8_MMA(0, 1, At, B1); PG8_BAR; PG8_SCHED;
            PG8_LDA(At, 0, 1); PG8_STAGE(PG8_SB(0, 0), b2, voffB); PG8_STAGE(PG8_SB(0, 1), b2 + hstep, voffB); PG8_STAGE(PG8_SA(0, 0), a2, voffA);
            PG8_WAIT_V(8); PG8_WAIT_L(0); PG8_BAR; PG8_MMA(1, 0, At, B0); PG8_MMA(1, 1, At, B1); PG8_BAR; PG8_SCHED;
            PG8_LDB(B0, 1, 0); PG8_LDB(B1, 1, 1); PG8_SCHED; PG8_LDA(At, 1, 0); PG8_STAGE(PG8_SA(0, 1), a2 + hstep, voffA);
            PG8_WAIT_V(8); PG8_WAIT_L(0); PG8_BAR; PG8_MMA(0, 0, At, B0); PG8_MMA(0, 1, At, B1); PG8_BAR; PG8_SCHED;
            PG8_LDA(At, 1, 1); PG8_STAGE(PG8_SB(1, 0), b3, voffB); PG8_STAGE(PG8_SB(1, 1), b3 + hstep, voffB); PG8_STAGE(PG8_SA(1, 0), a3, voffA);
            PG8_WAIT_V(8); PG8_WAIT_L(0); PG8_BAR; PG8_MMA(1, 0, At, B0); PG8_MMA(1, 1, At, B1); PG8_BAR; PG8_SCHED;
            } else {
            PG8_LDB(B0, 0, 0); PG8_SCHED; PG8_LDA(At, 0, 0); PG8_STAGE(PG8_SA(1, 1), a1 + hstep, voffA);
            PG8_WAIT_L(8); PG8_BAR; PG8_WAIT_L(0); PG8_MMA(0, 0, At, B0); PG8_BAR; PG8_SCHED;
            PG8_LDB(B1, 0, 1); PG8_STAGE(PG8_SB(0, 0), b2, voffB);
            PG8_BAR; PG8_WAIT_L(0); PG8_MMA(0, 1, At, B1); PG8_BAR;
            PG8_LDA(At, 0, 1); PG8_STAGE(PG8_SA(0, 0), a2, voffA);
            PG8_BAR; PG8_WAIT_L(0); PG8_MMA(1, 0, At, B0); PG8_BAR; PG8_SCHED;
            PG8_STAGE(PG8_SB(0, 1), b2 + hstep, voffB);
            PG8_WAIT_V(6); PG8_BAR; PG8_MMA(1, 1, At, B1); PG8_BAR;
            PG8_LDB(B0, 1, 0); PG8_SCHED; PG8_LDA(At, 1, 0); PG8_STAGE(PG8_SA(0, 1), a2 + hstep, voffA);
            PG8_WAIT_L(8); PG8_BAR; PG8_WAIT_L(0); PG8_MMA(0, 0, At, B0); PG8_BAR; PG8_SCHED;
            PG8_LDB(B1, 1, 1); PG8_STAGE(PG8_SB(1, 0), b3, voffB);
            PG8_BAR; PG8_WAIT_L(0); PG8_MMA(0, 1, At, B1); PG8_BAR;
            PG8_LDA(At, 1, 1); PG8_STAGE(PG8_SA(1, 0), a3, voffA);
            PG8_BAR; PG8_WAIT_L(0); PG8_MMA(1, 0, At, B0); PG8_BAR; PG8_SCHED;
            PG8_STAGE(PG8_SB(1, 1), b3 + hstep, voffB);
            PG8_WAIT_V(6); PG8_BAR; PG8_MMA(1, 1, At, B1); PG8_BAR;
            }
        }
        if constexpr (ALIGN_EPI) { if (wr == 0) PG8_BAR; }
        if constexpr (!Epi::AFTER_DRAIN) { E(acc, cur, wr, wc, fr, fq); S.done(cur); }
        if (!has_next) break;
#pragma unroll
        for (int a = 0; a < 2; ++a)
#pragma unroll
            for (int b = 0; b < 2; ++b)
#pragma unroll
                for (int m = 0; m < 4; ++m)
#pragma unroll
                    for (int n = 0; n < 2; ++n) acc[a][b][m][n] = (f32x4){0.f, 0.f, 0.f, 0.f};
        cur = nxt; cA = nA; cB = nB; ++ui;
        if constexpr (ALIGN_EPI) { if (wr == 1) PG8_BAR; }
    }
    PG8_WAIT_V(0);
    if constexpr (!ALIGN_EPI) { if (wr == 0) PG8_BAR; }
    PG8_BAR;
    if constexpr (Epi::AFTER_DRAIN) { E.fused(acc, cur, wr, wc, fr, fq, lds, wid, lane); S.done(cur); }
#undef PG8_SA
#undef PG8_SB
#undef PG8_STAGE
#undef PG8_LDA
#undef PG8_LDB
#undef PG8_MMA
#undef PG8_WAIT_V
#undef PG8_WAIT_L
#undef PG8_BAR
#undef PG8_SCHED
}
template <class Epi, class Sched, bool ALIGN_EPI = false, bool SP2 = false>
__device__ __forceinline__ void gemm_phase(PG8_LAS unsigned char* lds, const Gemm g, const Sched& S, const Epi& E, const int tid) {
    static_assert(SP2, "the 192-row tile form exists for the SP2 loop only");
    const int wid = __builtin_amdgcn_readfirstlane(tid >> 6), lane = tid & 63, wr = wid >> 2, wc = wid & 3, fr = lane & 15, fq = lane >> 4;
    const int K = g.K, nt = K / BK;
    unsigned voffA[2], voffB[2];
#pragma unroll
    for (int i = 0; i < 2; ++i) { int R, C; stage_rc(tid * 16 + i * 8192, R, C); const int Rb = Epi::PERM ? ((R & ~31) + perm32(R & 31)) : R;
        voffA[i] = (unsigned)(R * K + C) * 2u; voffB[i] = (unsigned)(Rb * K + C) * 2u; }
    const size_t kstep = (size_t)(BK * 2);
    const size_t hstep = (size_t)HALF * K * 2;
    const size_t tstepA = (size_t)RM * K * 2;
    const size_t tstep = 2 * hstep;
    const unsigned ldsw = (unsigned)wid * 1024u;
    const int aoff = lds_byte(wr * 64 + fr, fq * 8), boff = lds_byte(wc * 32 + fr, fq * 8);
#define PG8_SA(b, h) (((b) * 2 + (h)) * HTB)
#define PG8_SB(b, h) ((4 + (b) * 2 + (h)) * HTB)
#define PG8_STAGE(bufoff, gbase, voff) do { _Pragma("unroll") for (int _i = 0; _i < 2; ++_i) \
        __builtin_amdgcn_global_load_lds((const unsigned*)((const char*)(gbase) + (voff)[_i]), (PG8_LAS unsigned*)(lds + (bufoff) + ldsw + _i * 8192), 16, 0, 0); } while (0)
#define PG8_LDA(dst, b, h) do { _Pragma("unroll") for (int m = 0; m < 4; ++m) _Pragma("unroll") for (int k = 0; k < 2; ++k) dst[m][k] = *(const PG8_LAS bf16x8*)(lds + PG8_SA(b, h) + aoff + m * 2048 + k * 1024); } while (0)
#define PG8_LDB(dst, b, h) do { _Pragma("unroll") for (int n = 0; n < 2; ++n) _Pragma("unroll") for (int k = 0; k < 2; ++k) dst[n][k] = *(const PG8_LAS bf16x8*)(lds + PG8_SB(b, h) + boff + n * 2048 + k * 1024); } while (0)
#define PG8_MMA(ai, bj, At, Bt) do { __builtin_amdgcn_s_setprio(1); _Pragma("unroll") for (int m = 0; m < 4; ++m) _Pragma("unroll") for (int n = 0; n < 2; ++n) _Pragma("unroll") for (int k = 0; k < 2; ++k) \
        acc[ai][bj][m][n] = __builtin_amdgcn_mfma_f32_16x16x32_bf16(Bt[n][k], At[m][k], acc[ai][bj][m][n], 0, 0, 0); __builtin_amdgcn_s_setprio(0); } while (0)
    const int aoff1 = lds_byte(wr * 32 + fr, fq * 8);
#define PG8_STAGE1(bufoff, gbase, voff) __builtin_amdgcn_global_load_lds((const unsigned*)((const char*)(gbase) + (voff)[0]), (PG8_LAS unsigned*)(lds + (bufoff) + ldsw), 16, 0, 0)
#define PG8_LDA1(dst, b) do { _Pragma("unroll") for (int m = 0; m < 2; ++m) _Pragma("unroll") for (int k = 0; k < 2; ++k) dst[m][k] = *(const PG8_LAS bf16x8*)(lds + PG8_SA(b, 1) + aoff1 + m * 2048 + k * 1024); } while (0)
#define PG8_MMA1(bj, At, Bt) do { __builtin_amdgcn_s_setprio(1); _Pragma("unroll") for (int m = 0; m < 2; ++m) _Pragma("unroll") for (int n = 0; n < 2; ++n) _Pragma("unroll") for (int k = 0; k < 2; ++k) \
        acc[1][bj][m][n] = __builtin_amdgcn_mfma_f32_16x16x32_bf16(Bt[n][k], At[m][k], acc[1][bj][m][n], 0, 0, 0); __builtin_amdgcn_s_setprio(0); } while (0)
#define PG8_WAIT_V(n) asm volatile("s_waitcnt vmcnt(" #n ")" ::: "memory")
#define PG8_WAIT_L(n) asm volatile("s_waitcnt lgkmcnt(" #n ")" ::: "memory")
#define PG8_BAR __builtin_amdgcn_s_barrier()
#define PG8_SCHED __builtin_amdgcn_sched_barrier(0)
    Unit cur, nxt; int ui = 0;
    if (!S.next(0, cur)) return;
    f32x4 acc[2][2][4][2];
#pragma unroll
    for (int a = 0; a < 2; ++a)
#pragma unroll
        for (int b = 0; b < 2; ++b)
#pragma unroll
            for (int m = 0; m < 4; ++m)
#pragma unroll
                for (int n = 0; n < 2; ++n) acc[a][b][m][n] = (f32x4){0.f, 0.f, 0.f, 0.f};
    bf16x8 At[4][2], B0[2][2], B1[2][2];
    const char* cA = (const char*)g.A + (size_t)cur.pm * tstepA; const char* cB = (const char*)g.Bt + (size_t)cur.pn * tstep;
    S.a_ready(cur);
    if constexpr (SP2) {
        PG8_STAGE(PG8_SB(0, 0), cB, voffB); PG8_STAGE(PG8_SB(0, 1), cB + hstep, voffB); PG8_STAGE(PG8_SA(0, 0), cA, voffA); PG8_STAGE1(PG8_SA(0, 1), cA + hstep, voffA);
        if (wr == 1) PG8_BAR;
        PG8_WAIT_V(1); PG8_BAR;
        PG8_STAGE(PG8_SB(1, 0), cB + kstep, voffB); PG8_STAGE(PG8_SA(1, 0), cA + kstep, voffA); PG8_STAGE(PG8_SB(1, 1), cB + hstep + kstep, voffB);
        PG8_WAIT_V(6); PG8_BAR;
    } else {
        PG8_STAGE(PG8_SB(0, 0), cB, voffB); PG8_STAGE(PG8_SA(0, 0), cA, voffA); PG8_STAGE(PG8_SB(0, 1), cB + hstep, voffB); PG8_STAGE(PG8_SA(0, 1), cA + hstep, voffA);
        if (wr == 1) PG8_BAR;
        PG8_WAIT_V(4); PG8_BAR;
        PG8_STAGE(PG8_SB(1, 0), cB + kstep, voffB); PG8_STAGE(PG8_SA(1, 0), cA + kstep, voffA); PG8_STAGE(PG8_SB(1, 1), cB + hstep + kstep, voffB);
        PG8_WAIT_V(6); PG8_BAR;
    }
    for (;;) {
        const bool has_next = S.next(ui + 1, nxt);
        const char* nA = has_next ? (const char*)g.A + (size_t)nxt.pm * tstepA : cA; const char* nB = has_next ? (const char*)g.Bt + (size_t)nxt.pn * tstep : cB;
        for (int t = 0; t < nt; t += 2) {
            const bool last = (t == nt - 2);
            const char* a1 = cA + (size_t)(t + 1) * kstep;
            const char* a2 = last ? nA : cA + (size_t)(t + 2) * kstep; const char* b2 = last ? nB : cB + (size_t)(t + 2) * kstep;
            const char* a3 = a2 + kstep; const char* b3 = b2 + kstep;
            if (last && has_next) S.a_ready(nxt);
            if constexpr (SP2) {
            PG8_LDB(B0, 0, 0); PG8_LDB(B1, 0, 1); PG8_SCHED; PG8_LDA(At, 0, 0); PG8_STAGE1(PG8_SA(1, 1), a1 + hstep, voffA);
            PG8_WAIT_V(7); PG8_WAIT_L(0); PG8_BAR; PG8_MMA(0, 0, At, B0); PG8_MMA(0, 1, At, B1); PG8_BAR; PG8_SCHED;
            PG8_LDA1(At, 0); PG8_STAGE(PG8_SB(0, 0), b2, voffB); PG8_STAGE(PG8_SB(0, 1), b2 + hstep, voffB); PG8_STAGE(PG8_SA(0, 0), a2, voffA);
            PG8_WAIT_V(7); PG8_WAIT_L(0); PG8_BAR; PG8_MMA1(0, At, B0); PG8_MMA1(1, At, B1); PG8_BAR; PG8_SCHED;
            PG8_LDB(B0, 1, 0); PG8_LDB(B1, 1, 1); PG8_SCHED; PG8_LDA(At, 1, 0); PG8_STAGE1(PG8_SA(0, 1), a2 + hstep, voffA);
            PG8_WAIT_V(7); PG8_WAIT_L(0); PG8_BAR; PG8_MMA(0, 0, At, B0); PG8_MMA(0, 1, At, B1); PG8_BAR; PG8_SCHED;
            PG8_LDA1(At, 1); PG8_STAGE(PG8_SB(1, 0), b3, voffB); PG8_STAGE(PG8_SB(1, 1), b3 + hstep, voffB); PG8_STAGE(PG8_SA(1, 0), a3, voffA);
            PG8_WAIT_V(7); PG8_WAIT_L(0); PG8_BAR; PG8_MMA1(0, At, B0); PG8_MMA1(1, At, B1); PG8_BAR; PG8_SCHED;
            } else {
            PG8_LDB(B0, 0, 0); PG8_SCHED; PG8_LDA(At, 0, 0); PG8_STAGE(PG8_SA(1, 1), a1 + hstep, voffA);
            PG8_WAIT_L(8); PG8_BAR; PG8_WAIT_L(0); PG8_MMA(0, 0, At, B0); PG8_BAR; PG8_SCHED;
            PG8_LDB(B1, 0, 1); PG8_STAGE(PG8_SB(0, 0), b2, voffB);
            PG8_BAR; PG8_WAIT_L(0); PG8_MMA(0, 1, At, B1); PG8_BAR;
            PG8_LDA(At, 0, 1); PG8_STAGE(PG8_SA(0, 0), a2, voffA);
            PG8_BAR; PG8_WAIT_L(0); PG8_MMA(1, 0, At, B0); PG8_BAR; PG8_SCHED;
            PG8_STAGE(PG8_SB(0, 1), b2 + hstep, voffB);
            PG8_WAIT_V(6); PG8_BAR; PG8_MMA(1, 1, At, B1); PG8_BAR;
            PG8_LDB(B0, 1, 0); PG8_SCHED; PG8_LDA(At, 1, 0); PG8_STAGE(PG8_SA(0, 1), a2 + hstep, voffA);
            PG8_WAIT_L(8); PG8_BAR; PG8_WAIT_L(0); PG8_MMA(0, 0, At, B0); PG8_BAR; PG8_SCHED;
            PG8_LDB(B1, 1, 1); PG8_STAGE(PG8_SB(1, 0), b3, voffB);
            PG8_BAR; PG8_WAIT_L(0); PG8_MMA(0, 1, At, B1); PG8_BAR;
            PG8_LDA(At, 1, 1); PG8_STAGE(PG8_SA(1, 0), a3, voffA);
            PG8_BAR; PG8_WAIT_L(0); PG8_MMA(1, 0, At, B0); PG8_BAR; PG8_SCHED;
            PG8_STAGE(PG8_SB(1, 1), b3 + hstep, voffB);
            PG8_WAIT_V(6); PG8_BAR; PG8_MMA(1, 1, At, B1); PG8_BAR;
            }
        }
        if constexpr (ALIGN_EPI) { if (wr == 0) PG8_BAR; }
        if constexpr (!Epi::AFTER_DRAIN) { E(acc, cur, wr, wc, fr, fq); S.done(cur); }
        if (!has_next) break;
#pragma unroll
        for (int a = 0; a < 2; ++a)
#pragma unroll
            for (int b = 0; b < 2; ++b)
#pragma unroll
                for (int m = 0; m < 4; ++m)
#pragma unroll
                    for (int n = 0; n < 2; ++n) acc[a][b][m][n] = (f32x4){0.f, 0.f, 0.f, 0.f};
        cur = nxt; cA = nA; cB = nB; ++ui;
        if constexpr (ALIGN_EPI) { if (wr == 1) PG8_BAR; }
    }
    PG8_WAIT_V(0);
    if constexpr (!ALIGN_EPI) { if (wr == 0) PG8_BAR; }
    PG8_BAR;
    if constexpr (Epi::AFTER_DRAIN) { E.fused(acc, cur, wr, wc, fr, fq, lds, wid, lane); S.done(cur); }
#undef PG8_SA
#undef PG8_SB
#undef PG8_STAGE
#undef PG8_LDA
#undef PG8_LDB
#undef PG8_MMA
#undef PG8_STAGE1
#undef PG8_LDA1
#undef PG8_MMA1
#undef PG8_WAIT_V
#undef PG8_WAIT_L
#undef PG8_BAR
#undef PG8_SCHED
}
}
constexpr int D = 1024, MP = 8192, MS = 4096, M = MP + MS, FF = 4096, NL = 4;
constexpr int NWAVES = 8, NTHR = 512;
constexpr size_t MiB = 1u << 20;
constexpr size_t WS_MOD = 1 * MiB;
constexpr size_t WS_W = 2 * MiB;
constexpr size_t WS_X = 94 * MiB;
constexpr size_t WS_H = 142 * MiB;
constexpr size_t WS_R = 166 * MiB;
constexpr size_t WS_CK = 262 * MiB, WS_CV = 266 * MiB, WS_SHW = 270 * MiB, WS_SS = 271 * MiB, WS_END = 272 * MiB;
constexpr size_t MEL = 1u << 20;
constexpr size_t W_QKV = 0, W_O = 6 * MEL, W_PW1 = 8 * MEL, W_PW2 = 12 * MEL, W_UP = 14 * MEL, W_DOWN = 30 * MEL;
constexpr int LDS_BYTES = 163840, LDS_ST = LDS_BYTES - 16, LDS_KC = 112640;

#define LAS __attribute__((address_space(3)))
#define SB0() __builtin_amdgcn_sched_barrier(0)
typedef unsigned short bf16;
typedef float f32x4 __attribute__((ext_vector_type(4)));
typedef float f32x2 __attribute__((ext_vector_type(2)));
typedef unsigned u32x4 __attribute__((ext_vector_type(4)));
typedef unsigned u32x2 __attribute__((ext_vector_type(2)));
typedef short bf16x8 __attribute__((ext_vector_type(8)));
typedef short s16x4 __attribute__((ext_vector_type(4)));
typedef float f32x32 __attribute__((ext_vector_type(32)));

__device__ __forceinline__ unsigned f2bf(float f) { unsigned u = __builtin_bit_cast(unsigned, f); return (u + 0x7fffu + ((u >> 16) & 1u)) >> 16; }
__device__ __forceinline__ unsigned pk2(float lo, float hi) { unsigned r; asm("v_cvt_pk_bf16_f32 %0, %1, %2" : "=v"(r) : "v"(lo), "v"(hi)); return r; }
__device__ __forceinline__ float bflo(unsigned w) { return __builtin_bit_cast(float, w << 16); }
__device__ __forceinline__ float bfhi(unsigned w) { return __builtin_bit_cast(float, w & 0xffff0000u); }
__device__ __forceinline__ float shx(float v, int k, int lane) { return __builtin_bit_cast(float, __builtin_amdgcn_ds_bpermute((lane ^ k) << 2, __builtin_bit_cast(int, v))); }
__device__ __forceinline__ float wave_sum(float v, int lane) {
#pragma unroll
    for (int o = 1; o < 64; o <<= 1) v += shx(v, o, lane);
    return v;
}

template <bool GLU>
__device__ __forceinline__ void transpose_item(const float* W, int K, int N, bf16* WT, LAS float* scr, int item, int lane) {
    const int nblk = N / 32, kb = item / nblk, nb = item % nblk, k0 = 64 * kb, n0 = 32 * nb;
    { float tv[32];
#pragma unroll
      for (int i = 0; i < 32; ++i) tv[i] = __builtin_nontemporal_load(W + (size_t)(k0 + 2 * i + (lane >> 5)) * N + n0 + (lane & 31));
      __builtin_amdgcn_sched_barrier(0);
#pragma unroll
      for (int i = 0; i < 32; ++i) scr[(2 * i + (lane >> 5)) * 33 + (lane & 31)] = tv[i]; }
    asm volatile("s_waitcnt lgkmcnt(0)" ::: "memory");
    int d0 = n0;
    if (GLU) { const int nn = n0 & 1023; d0 = ((nn >> 7) << 8) + (nn & 127) + ((n0 >> 10) << 7); }
    const int c = lane & 7;
#pragma unroll
    for (int j = 0; j < 4; ++j) { const int n = (lane >> 3) + 8 * j; const LAS float* s = scr + (8 * c) * 33 + n;
        u32x4 o; o.x = pk2(s[0 * 33], s[1 * 33]); o.y = pk2(s[2 * 33], s[3 * 33]); o.z = pk2(s[4 * 33], s[5 * 33]); o.w = pk2(s[6 * 33], s[7 * 33]);
        *(u32x4*)(WT + (size_t)(d0 + n) * K + k0 + 8 * c) = o; }
    asm volatile("s_waitcnt lgkmcnt(0)" ::: "memory");
}

struct Ptrs {
    const float *x_prompt, *x_sample, *cache_k, *cache_v, *c, *c_ctx, *norm_g, *w_ada, *b_ada, *w_qkv, *w_o, *rpb, *w_pw1, *w_dw, *b_dw, *ln_g, *ln_b, *w_pw2, *w_up, *w_down, *final_g;
};

__device__ __forceinline__ void p0_phase(const Ptrs& P, unsigned char* ws, LAS unsigned char* lds, int tid, int lane, int wave, int G, int bid) {
    bf16* Wt = (bf16*)(ws + WS_W);
    const int gw = bid * NWAVES + wave, NGW = G * NWAVES;
    LAS float* scr = (LAS float*)(lds + wave * 16384);
    constexpr int NIT = 23552;
    for (int it = gw; it < NIT; it += NGW) {
        if (it < 7168) { const int i = it / 3584; int r = it % 3584;
            if (r < 1536) { transpose_item<false>(P.w_qkv + (size_t)i * D * 3 * D, D, 3 * D, Wt + W_QKV + (size_t)i * 3 * MEL, scr, r, lane); continue; } r -= 1536;
            if (r < 512) { transpose_item<false>(P.w_o + (size_t)i * D * D, D, D, Wt + W_O + (size_t)i * MEL, scr, r, lane); continue; } r -= 512;
            if (r < 1024) { transpose_item<true>(P.w_pw1 + (size_t)i * D * 2 * D, D, 2 * D, Wt + W_PW1 + (size_t)i * 2 * MEL, scr, r, lane); continue; } r -= 1024;
            transpose_item<false>(P.w_pw2 + (size_t)i * D * D, D, D, Wt + W_PW2 + (size_t)i * MEL, scr, r, lane);
        } else { const int l = (it - 7168) / 4096; int r = (it - 7168) % 4096;
            if (r < 2048) transpose_item<false>(P.w_up + (size_t)l * D * FF, D, FF, Wt + W_UP + (size_t)l * 4 * MEL, scr, r, lane);
            else transpose_item<false>(P.w_down + (size_t)l * D * FF, FF, D, Wt + W_DOWN + (size_t)l * 4 * MEL, scr, r - 2048, lane);
        }
    }
    { bf16* CK = (bf16*)(ws + WS_CK); bf16* CV = (bf16*)(ws + WS_CV);
      const int NT = G * NTHR; constexpr int NV = 2 * 4 * 2 * 256 * 1024 / 8;
      for (int v = bid * NTHR + tid; v < NV; v += NT) { const int which = v >= NV / 2; const int e = (which ? v - NV / 2 : v) * 8;
          const float* src = (which ? P.cache_v : P.cache_k) + e; const f32x4 a = __builtin_nontemporal_load((const f32x4*)src), b = __builtin_nontemporal_load((const f32x4*)(src + 4));
          u32x4 o; o.x = pk2(a[0], a[1]); o.y = pk2(a[2], a[3]); o.z = pk2(b[0], b[1]); o.w = pk2(b[2], b[3]);
          *(u32x4*)((which ? CV : CK) + e) = o; } }
    { f32x4* z = (f32x4*)(ws + WS_SS); const int NT = G * NTHR; float zf = 0.f; asm volatile("" : "+v"(zf));
      const f32x4 zz = (f32x4){zf, zf, zf, zf}; for (int v = bid * NTHR + tid; v < 9 * M / 4; v += NT) z[v] = zz; }
    __syncthreads();
    { LAS float* sil = (LAS float*)lds; LAS float* red = (LAS float*)(lds + 20480); float* mod = (float*)(ws + WS_MOD);
      for (int k = tid; k < 5 * 1024; k += NTHR) { const int cc = k >> 10, kk = k & 1023; const float v = cc == 0 ? P.c_ctx[kk] : P.c[(cc - 1) * 1024 + kk]; sil[k] = v / (1.f + __expf(-v)); }
      __syncthreads();
      const int kg = tid >> 4, cl = tid & 15; const bool cact = cl < 12;
      for (int item = bid; item < 512; item += G) { const int l = item >> 7, n0 = (item & 127) * 48;
          const float* W = P.w_ada + (size_t)l * D * 6144 + n0 + 4 * cl;
          f32x4 a[5];
#pragma unroll
          for (int cc = 0; cc < 5; ++cc) a[cc] = (f32x4){0.f, 0.f, 0.f, 0.f};
#pragma unroll 4
          for (int kk = 0; kk < 32; ++kk) { const int k = kg * 32 + kk; f32x4 w = (f32x4){0.f, 0.f, 0.f, 0.f}; if (cact) w = __builtin_nontemporal_load((const f32x4*)(W + (size_t)k * 6144));
#pragma unroll
              for (int cc = 0; cc < 5; ++cc) a[cc] += sil[cc * 1024 + k] * w; }
#pragma unroll
          for (int cc = 0; cc < 5; ++cc) *(LAS f32x4*)(red + (kg * 5 + cc) * 64 + 4 * cl) = a[cc];
          __syncthreads();
          if (tid < 320 && (tid & 63) < 48) { const int cc = tid >> 6, n = tid & 63; float s = 0.f;
#pragma unroll 8
              for (int g = 0; g < 32; ++g) s += red[(g * 5 + cc) * 64 + n];
              mod[(size_t)(l * 5 + cc) * 6144 + n0 + n] = s + P.b_ada[l * 6144 + n0 + n]; }
          __syncthreads();
      } }
}

__device__ __forceinline__ void norm_phase(const float* xp, const float* xs, bf16* H, float* yout, const float* g, const float* shift, const float* scale, int gw, int NGW, int lane) {
    f32x4 gv[4];
#pragma unroll
    for (int j = 0; j < 4; ++j) gv[j] = *(const f32x4*)(g + 4 * (lane + 64 * j));
    for (int m = gw; m < M; m += NGW) {
        const float* xrow = m < MP ? xp + (size_t)m * D : xs + (size_t)(m - MP) * D;
        const int cond = m < MP ? 0 : 1 + ((m - MP) >> 10);
        f32x4 v[4]; float ss = 0.f;
#pragma unroll
        for (int j = 0; j < 4; ++j) { v[j] = *(const f32x4*)(xrow + 4 * (lane + 64 * j)); ss += (v[j][0] * v[j][0] + v[j][1] * v[j][1]) + (v[j][2] * v[j][2] + v[j][3] * v[j][3]); }
        const float r = 1.0f / sqrtf(wave_sum(ss, lane) * (1.f / D) + 1e-6f);
        if (yout) {
#pragma unroll
            for (int j = 0; j < 4; ++j) *(f32x4*)(yout + (size_t)m * D + 4 * (lane + 64 * j)) = v[j] * r * gv[j];
        } else {
#pragma unroll
            for (int j = 0; j < 4; ++j) { const f32x4 sc = *(const f32x4*)(scale + cond * 6144 + 4 * (lane + 64 * j)), sh = *(const f32x4*)(shift + cond * 6144 + 4 * (lane + 64 * j));
                const f32x4 h = (v[j] * r * gv[j]) * (1.f + sc) + sh; u32x2 o; o.x = pk2(h[0], h[1]); o.y = pk2(h[2], h[3]);
                *(u32x2*)(H + (size_t)m * D + 4 * (lane + 64 * j)) = o; }
        }
    }
}

template <class F, int... I> __device__ __forceinline__ void sfor_impl(F&& f, std::integer_sequence<int, I...>) { (f(std::integral_constant<int, I>{}), ...); }
template <int N, class F> __device__ __forceinline__ void sfor(F&& f) { sfor_impl(f, std::make_integer_sequence<int, N>{}); }
__device__ __forceinline__ float dpp_add(float v, int ctrl_b1, int ctrl_4e, int dummy) { return v; }
__device__ __forceinline__ float wave_sum_dpp(float v) {
    v += __builtin_bit_cast(float, __builtin_amdgcn_update_dpp(0, __builtin_bit_cast(int, v), 0xB1, 0xf, 0xf, false));
    v += __builtin_bit_cast(float, __builtin_amdgcn_update_dpp(0, __builtin_bit_cast(int, v), 0x4E, 0xf, 0xf, false));
    v += __builtin_bit_cast(float, __builtin_amdgcn_update_dpp(0, __builtin_bit_cast(int, v), 0x141, 0xf, 0xf, false));
    v += __builtin_bit_cast(float, __builtin_amdgcn_update_dpp(0, __builtin_bit_cast(int, v), 0x140, 0xf, 0xf, false));
    const int vi = __builtin_bit_cast(int, v);
    return (__builtin_bit_cast(float, __builtin_amdgcn_readlane(vi, 0)) + __builtin_bit_cast(float, __builtin_amdgcn_readlane(vi, 16))) +
           (__builtin_bit_cast(float, __builtin_amdgcn_readlane(vi, 32)) + __builtin_bit_cast(float, __builtin_amdgcn_readlane(vi, 48)));
}
constexpr int CT = 16, CROWS = CT + 30, CCH = (CROWS + 15) / 16;
__device__ __forceinline__ void conv_phase(const bf16* U, bf16* Vc, const float* wdw, const float* bdw, const float* lng, const float* lnb, LAS unsigned char* lds, int tid, int lane, int wave, int G, int bid) {
    f32x2 w[31];
    sfor<31>([&](auto K) __attribute__((always_inline)) { constexpr int k = decltype(K)::value; w[k] = *(const f32x2*)(wdw + k * D + 2 * tid); });
    const f32x2 bd = *(const f32x2*)(bdw + 2 * tid), lg = *(const f32x2*)(lng + 2 * tid), lb = *(const f32x2*)(lnb + 2 * tid);
    LAS f32x2* part = (LAS f32x2*)lds;
    LAS f32x2* stats = part + 8 * CT;
    for (int unit = bid; unit < M / CT; unit += G) {
        const int m0 = unit * CT, seg = m0 < MP ? 0 : MP, L = m0 < MP ? 256 : 1024, t0 = (m0 - seg) & (L - 1);
        const bf16* Ub = U + (size_t)(m0 - t0) * D + 2 * tid;
        f32x2 acc[CT];
        sfor<CT>([&](auto O) __attribute__((always_inline)) { acc[decltype(O)::value] = bd; });
        sfor<CCH>([&](auto C) __attribute__((always_inline)) { constexpr int c = decltype(C)::value;
            unsigned raw[16];
            sfor<16>([&](auto I) __attribute__((always_inline)) { constexpr int i = decltype(I)::value, j = c * 16 + i;
                if constexpr (j < CROWS) { const int t = t0 - 15 + j, tc = min(max(t, 0), L - 1);
                    raw[i] = *(const unsigned*)(Ub + (size_t)tc * D); } });
            SB0();
            sfor<16>([&](auto I) __attribute__((always_inline)) { constexpr int i = decltype(I)::value, j = c * 16 + i;
                if constexpr (j < CROWS) { const int t = t0 - 15 + j; const unsigned rm = raw[i] & (unsigned)(-(int)((t >= 0) & (t < L))); const f32x2 u = (f32x2){bflo(rm), bfhi(rm)};
                    sfor<31>([&](auto K) __attribute__((always_inline)) { constexpr int k = decltype(K)::value, o = j - k;
                        if constexpr (o >= 0 && o < CT) acc[o] += u * w[k]; }); } });
        });
        sfor<CT>([&](auto O) __attribute__((always_inline)) { constexpr int o = decltype(O)::value;
            const float s = wave_sum_dpp(acc[o].x + acc[o].y), q = wave_sum_dpp(acc[o].x * acc[o].x + acc[o].y * acc[o].y); if (lane == 0) part[wave * CT + o] = (f32x2){s, q}; });
        __syncthreads();
        if (tid < CT) { float s = 0.f, q = 0.f;
#pragma unroll
            for (int wv = 0; wv < 8; ++wv) { const f32x2 p = part[wv * CT + tid]; s += p.x; q += p.y; }
            const float mean = s * (1.f / D), var = fmaxf(q * (1.f / D) - mean * mean, 0.f); stats[tid] = (f32x2){mean, 1.0f / sqrtf(var + 1e-5f)}; }
        __syncthreads();
        sfor<CT>([&](auto O) __attribute__((always_inline)) { constexpr int o = decltype(O)::value;
            const f32x2 st = stats[o]; f32x2 y = (acc[o] - st.x) * st.y * lg + lb;
            y.x = y.x * __builtin_amdgcn_rcpf(1.f + __expf(-y.x)); y.y = y.y * __builtin_amdgcn_rcpf(1.f + __expf(-y.y));
            *(unsigned*)(Vc + (size_t)(m0 + o) * D + 2 * tid) = pk2(y.x, y.y); });
        __syncthreads();
    }
}

__device__ __forceinline__ void final_norm_phase(const bf16* X, float* yout, const float* g, int gw, int NGW, int lane) {
    f32x4 gv[4];
#pragma unroll
    for (int j = 0; j < 4; ++j) gv[j] = *(const f32x4*)(g + 16 * lane + 4 * j);
    for (int m = gw; m < M; m += NGW) {
        const bf16* xr = X + (size_t)m * D + 16 * lane;
        const u32x4 w0 = *(const u32x4*)xr, w1 = *(const u32x4*)(xr + 8);
        f32x4 v[4]; v[0] = (f32x4){bflo(w0[0]), bfhi(w0[0]), bflo(w0[1]), bfhi(w0[1])}; v[1] = (f32x4){bflo(w0[2]), bfhi(w0[2]), bflo(w0[3]), bfhi(w0[3])};
        v[2] = (f32x4){bflo(w1[0]), bfhi(w1[0]), bflo(w1[1]), bfhi(w1[1])}; v[3] = (f32x4){bflo(w1[2]), bfhi(w1[2]), bflo(w1[3]), bfhi(w1[3])};
        float sq = 0.f;
#pragma unroll
        for (int j = 0; j < 4; ++j) sq += (v[j][0] * v[j][0] + v[j][1] * v[j][1]) + (v[j][2] * v[j][2] + v[j][3] * v[j][3]);
        const float r = 1.0f / sqrtf(wave_sum_dpp(sq) * (1.f / D) + 1e-6f);
#pragma unroll
        for (int j = 0; j < 4; ++j) __builtin_nontemporal_store(v[j] * r * gv[j], (f32x4*)(yout + (size_t)m * D + 16 * lane + 4 * j));
    }
}

__device__ __forceinline__ void prep_phase(const float* xp, const float* xs, bf16* H, float* ss0, const float* g, const float* scale, const float* mod, const bf16* Wt, float* shw, int gw, int NGW, int lane) {
    { f32x4 gv[4];
#pragma unroll
      for (int j = 0; j < 4; ++j) gv[j] = *(const f32x4*)(g + 4 * (lane + 64 * j));
      for (int m = gw; m < M; m += NGW) {
          const float* xrow = m < MP ? xp + (size_t)m * D : xs + (size_t)(m - MP) * D;
          const int cond = m < MP ? 0 : 1 + ((m - MP) >> 10);
          f32x4 v[4]; float sq = 0.f;
#pragma unroll
          for (int j = 0; j < 4; ++j) { v[j] = *(const f32x4*)(xrow + 4 * (lane + 64 * j)); sq += (v[j][0] * v[j][0] + v[j][1] * v[j][1]) + (v[j][2] * v[j][2] + v[j][3] * v[j][3]); }
          sq = wave_sum_dpp(sq); if (lane == 0) ss0[m] = sq;
          f32x4 sc[4];
#pragma unroll
          for (int j = 0; j < 4; ++j) sc[j] = *(const f32x4*)(scale + cond * 6144 + 4 * (lane + 64 * j));
#pragma unroll
          for (int j = 0; j < 4; ++j) { const f32x4 h = v[j] * gv[j] * (1.f + sc[j]); u32x2 o; o.x = pk2(h[0], h[1]); o.y = pk2(h[2], h[3]);
              *(u32x2*)(H + (size_t)m * D + 4 * (lane + 64 * j)) = o; }
      } }
    for (int it = gw; it < 4 * 8192; it += NGW) {
        const int l = it >> 13, which = (it >> 12) & 1, n = it & 4095, i = l >> 1; const bool conv = (l & 1) != 0;
        const int N = which ? 4096 : (conv ? 2048 : 3072);
        if (n >= N) continue;
        const bf16* wrow = Wt + (which ? W_UP + (size_t)l * 4 * MEL : (conv ? W_PW1 + (size_t)i * 2 * MEL : W_QKV + (size_t)i * 3 * MEL)) + (size_t)n * D + 16 * lane;
        const u32x4 w0 = *(const u32x4*)wrow, w1 = *(const u32x4*)(wrow + 8);
        float wv[16];
#pragma unroll
        for (int e = 0; e < 4; ++e) { wv[2 * e] = bflo(w0[e]); wv[2 * e + 1] = bfhi(w0[e]); wv[8 + 2 * e] = bflo(w1[e]); wv[8 + 2 * e + 1] = bfhi(w1[e]); }
#pragma unroll
        for (int cond = 0; cond < 5; ++cond) { const float* sh = mod + (size_t)(l * 5 + cond) * 6144 + (which ? 3 : 0) * 1024 + 16 * lane; float dot = 0.f;
#pragma unroll
            for (int q = 0; q < 4; ++q) { const f32x4 s4 = *(const f32x4*)(sh + 4 * q); dot += (s4[0] * wv[4 * q] + s4[1] * wv[4 * q + 1]) + (s4[2] * wv[4 * q + 2] + s4[3] * wv[4 * q + 3]); }
            dot = wave_sum_dpp(dot); if (lane == 0) shw[(size_t)((l * 2 + which) * 5 + cond) * 4096 + n] = dot; }
    }
}

constexpr float SCL = 0.125f * 1.4426950408889634f, LOG2E = 1.4426950408889634f;
__device__ __forceinline__ void vt_write(LAS bf16* Vt, int pitch, int slot, int chunk, u32x4 v) {
    LAS bf16* p = Vt + (8 * chunk) * pitch + slot;
    p[0] = (bf16)(v.x & 0xffffu); p[pitch] = (bf16)(v.x >> 16); p[2 * pitch] = (bf16)(v.y & 0xffffu); p[3 * pitch] = (bf16)(v.y >> 16);
    p[4 * pitch] = (bf16)(v.z & 0xffffu); p[5 * pitch] = (bf16)(v.z >> 16); p[6 * pitch] = (bf16)(v.w & 0xffffu); p[7 * pitch] = (bf16)(v.w >> 16);
}
template <int NB> __device__ __forceinline__ void softmax_part(f32x4 (&s)[NB], float& mx_out, float& sum_out, int lane, float m_floor = -INFINITY) {
    float mx = m_floor;
#pragma unroll
    for (int b = 0; b < NB; ++b) mx = fmaxf(mx, fmaxf(fmaxf(s[b][0], s[b][1]), fmaxf(s[b][2], s[b][3])));
    mx = fmaxf(mx, shx(mx, 16, lane)); mx = fmaxf(mx, shx(mx, 32, lane));
    float sum = 0.f;
#pragma unroll
    for (int b = 0; b < NB; ++b) {
#pragma unroll
        for (int e = 0; e < 4; ++e) { s[b][e] = __builtin_amdgcn_exp2f(s[b][e] - mx); sum += s[b][e]; } }
    sum += shx(sum, 16, lane); sum += shx(sum, 32, lane);
    mx_out = mx; sum_out = sum;
}
__device__ __forceinline__ bf16x8 pack_p(const f32x4& a, const f32x4& b) {
    u32x4 w; w.x = pk2(a[0], a[1]); w.y = pk2(a[2], a[3]); w.z = pk2(b[0], b[1]); w.w = pk2(b[2], b[3]); return __builtin_bit_cast(bf16x8, w);
}
__device__ __forceinline__ bf16x8 vt_read(const LAS bf16* p0, const LAS bf16* p1) {
    const s16x4 a = *(const LAS s16x4*)p0, b = *(const LAS s16x4*)p1; return (bf16x8){a[0], a[1], a[2], a[3], b[0], b[1], b[2], b[3]};
}
__device__ __forceinline__ f32x4 qk_block(const bf16* kp, const bf16x8& qf0, const bf16x8& qf1) {
    const bf16x8 k0 = *(const bf16x8*)kp, k1 = *(const bf16x8*)(kp + 32);
    f32x4 a = __builtin_amdgcn_mfma_f32_16x16x32_bf16(k0, qf0, (f32x4){0.f, 0.f, 0.f, 0.f}, 0, 0, 0);
    return __builtin_amdgcn_mfma_f32_16x16x32_bf16(k1, qf1, a, 0, 0, 0);
}
#define PV16(o, s, SLOT_EXPR, PITCH_) do { _Pragma("unroll") for (int pp = 0; pp < 8; ++pp) { const bf16x8 pf = pack_p(s[2 * pp], s[2 * pp + 1]); const int slot0 = (SLOT_EXPR); \
        _Pragma("unroll") for (int db = 0; db < 4; ++db) { const LAS bf16* vp = Vt + (16 * db + l15) * (PITCH_) + slot0; \
            o[db] = __builtin_amdgcn_mfma_f32_16x16x32_bf16(vt_read(vp, vp + 16), pf, o[db], 0, 0, 0); } } } while (0)

#ifndef CBN
#define CBN 4
#endif
__device__ __forceinline__ void attn_phase(const bf16* Qb, const bf16* Kb, const bf16* Vb, bf16* Ob, const bf16* CK, const bf16* CV, const float* rpb  ,
                                           int li, LAS unsigned char* lds, int tid, int lane, int wave, int G, int bid, int ulo, int uhi) {
    LAS bf16* Vt = (LAS bf16*)lds; LAS float* rpl = (LAS float*)(lds + 110592); LAS unsigned char* Kc = lds + LDS_KC;
    for (int u = bid + ulo; u < uhi; u += G) {
        int lz_ = lane; asm volatile("" : "+v"(lz_));
        const int l15 = lz_ & 15, g = lz_ >> 4;
        if (u < 512) {
            const int b = u >> 4, h = u & 15; constexpr int PITCH = 264;
            const int qrow0 = b * 256 + 32 * wave + l15;
            const bf16x8 qa0 = *(const bf16x8*)(Qb + (size_t)qrow0 * D + h * 64 + 8 * g), qa1 = *(const bf16x8*)(Qb + (size_t)qrow0 * D + h * 64 + 32 + 8 * g);
            const bf16x8 qb0 = *(const bf16x8*)(Qb + (size_t)(qrow0 + 16) * D + h * 64 + 8 * g), qb1 = *(const bf16x8*)(Qb + (size_t)(qrow0 + 16) * D + h * 64 + 32 + 8 * g);
            SB0();
            { int t2 = tid; asm volatile("" : "+v"(t2));
              const int key = t2 & 255, c0 = (t2 >> 8) * 4; const bf16* src = Vb + (size_t)(b * 256 + key) * D + h * 64 + 8 * c0; const bf16* ksrc = Kb + (size_t)(b * 256 + key) * D + h * 64 + 8 * c0;
              u32x4 v[4], kv[4];
#pragma unroll
              for (int c = 0; c < 4; ++c) { v[c] = *(const u32x4*)(src + 8 * c); kv[c] = *(const u32x4*)(ksrc + 8 * c); }
              SB0();
#pragma unroll
              for (int c = 0; c < 4; ++c) *(LAS u32x4*)(Kc + key * 144 + (c0 + c) * 16) = kv[c];
#pragma unroll
              for (int c = 0; c < 4; ++c) vt_write(Vt, PITCH, key, c0 + c, v[c]); }
            __syncthreads();
            SB0();
            f32x4 s0[16], s1[16];
            { const LAS unsigned char* kl = Kc + l15 * 144 + g * 16;
              sfor<16>([&](auto I) __attribute__((always_inline)) { constexpr int kb = decltype(I)::value;
                const bf16x8 k0 = *(const LAS bf16x8*)(kl + kb * (16 * 144)), k1 = *(const LAS bf16x8*)(kl + kb * (16 * 144) + 64);
                f32x4 a = __builtin_amdgcn_mfma_f32_16x16x32_bf16(k0, qa0, (f32x4){0.f, 0.f, 0.f, 0.f}, 0, 0, 0); s0[kb] = __builtin_amdgcn_mfma_f32_16x16x32_bf16(k1, qa1, a, 0, 0, 0) * SCL;
                f32x4 c = __builtin_amdgcn_mfma_f32_16x16x32_bf16(k0, qb0, (f32x4){0.f, 0.f, 0.f, 0.f}, 0, 0, 0); s1[kb] = __builtin_amdgcn_mfma_f32_16x16x32_bf16(k1, qb1, c, 0, 0, 0) * SCL; }); }
            { float mx, sum; softmax_part<16>(s0, mx, sum, lane);
              f32x4 o[4];
#pragma unroll
              for (int db = 0; db < 4; ++db) o[db] = (f32x4){0.f, 0.f, 0.f, 0.f};
              PV16(o, s0, 32 * pp + 4 * g, PITCH);
              const float rl = 1.0f / sum;
#pragma unroll
              for (int db = 0; db < 4; ++db) { const f32x4 ov = o[db] * rl; u32x2 w; w.x = pk2(ov[0], ov[1]); w.y = pk2(ov[2], ov[3]);
                  *(u32x2*)(Ob + (size_t)qrow0 * D + h * 64 + 16 * db + 4 * g) = w; } }
            { float mx, sum; softmax_part<16>(s1, mx, sum, lane);
              f32x4 o[4];
#pragma unroll
              for (int db = 0; db < 4; ++db) o[db] = (f32x4){0.f, 0.f, 0.f, 0.f};
              PV16(o, s1, 32 * pp + 4 * g, PITCH);
              const float rl = 1.0f / sum;
#pragma unroll
              for (int db = 0; db < 4; ++db) { const f32x4 ov = o[db] * rl; u32x2 w; w.x = pk2(ov[0], ov[1]); w.y = pk2(ov[2], ov[3]);
                  *(u32x2*)(Ob + (size_t)(qrow0 + 16) * D + h * 64 + 16 * db + 4 * g) = w; } }
            __syncthreads();
        } else {
            const int ui = u - 512, xcd = ui & 7, idx = (ui >> 3) & 63, uu = (G == 256) ? ((xcd * 8 + (idx >> 3)) << 3) + (idx & 7) : ui;
            const int b = uu >> 7, h = (uu >> 3) & 15, rp = uu & 7, r0 = 2 * rp; constexpr int PITCH = 840;
            const int rs0 = min(max(r0 - 4, 0), 8);
            const size_t tokb = (size_t)MP + (size_t)b * 1024;
            const int r = r0 + (wave >> 2), j = wave & 3, rs = min(max(r - 4, 0), 8), rrel = rs - rs0, kcs = min(max(16 * j - 8, 0), 32);
            const int qcol = 16 * j + l15, wst = min(max(qcol - 8, 0), 48);
            const size_t qtok = tokb + r * 64 + qcol;
            const bf16* kloc = Kb + (tokb + rs * 64 + kcs + l15) * D + h * 64 + 8 * g;
            bf16x8 kf[16][2];
#define LOAD_KLOC(H) sfor<8>([&](auto I) __attribute__((always_inline)) { constexpr int lb = 8 * (H) + decltype(I)::value; const bf16* kp = kloc + (size_t)((lb >> 1) * 64 + 16 * (lb & 1)) * D; kf[lb][0] = *(const bf16x8*)kp; kf[lb][1] = *(const bf16x8*)(kp + 32); })
            LOAD_KLOC(0);
            const bf16x8 qf0 = *(const bf16x8*)(Qb + qtok * D + h * 64 + 8 * g), qf1 = *(const bf16x8*)(Qb + qtok * D + h * 64 + 32 + 8 * g);
            SB0();
            { int t2 = tid; asm volatile("" : "+v"(t2));
              const int slotA = t2, slotB = t2 + NTHR, slotBc = min(slotB, 831);
              const bf16* srcA = (slotA < 576) ? Vb + (tokb + min(rs0 + (slotA >> 6), 15) * 64 + (slotA & 63)) * D + h * 64 : CV + ((size_t)(b * 2 + li) * 256 + (slotA - 576)) * D + h * 64;
              const bf16* srcB = (slotBc < 576) ? Vb + (tokb + min(rs0 + (slotBc >> 6), 15) * 64 + (slotBc & 63)) * D + h * 64 : CV + ((size_t)(b * 2 + li) * 256 + (slotBc - 576)) * D + h * 64;
              const int key = t2 & 255, c0 = (t2 >> 8) * 4; const bf16* ksrc = CK + ((size_t)(b * 2 + li) * 256 + key) * D + h * 64 + 8 * c0;
              u32x4 va[8], vb[8], kv[4];
#pragma unroll
              for (int c = 0; c < 8; ++c) { va[c] = *(const u32x4*)(srcA + 8 * c); vb[c] = *(const u32x4*)(srcB + 8 * c); }
#pragma unroll
              for (int c = 0; c < 4; ++c) kv[c] = *(const u32x4*)(ksrc + 8 * c);
              const float rv = rpb[h * 465 + min(t2, 464)];
              SB0();
#pragma unroll
              for (int c = 0; c < 8; ++c) vt_write(Vt, PITCH, slotA, c, va[c]);
              if (slotB < 832) {
#pragma unroll
                  for (int c = 0; c < 8; ++c) vt_write(Vt, PITCH, slotB, c, vb[c]); }
#pragma unroll
              for (int c = 0; c < 4; ++c) *(LAS u32x4*)(Kc + key * 144 + (c0 + c) * 16) = kv[c];
              if (t2 < 465) rpl[t2] = rv; }
            SB0(); LOAD_KLOC(1); SB0();
            __syncthreads();
            SB0();
            f32x4 o1[4]; float m1, l1, m2, l2;
#pragma unroll
            for (int db = 0; db < 4; ++db) o1[db] = (f32x4){0.f, 0.f, 0.f, 0.f};
            {
                int dcv[8]; unsigned vmask = 0u;
#pragma unroll
                for (int ce = 0; ce < 8; ++ce) { const int kc = kcs + 16 * (ce >> 2) + 4 * g + (ce & 3); vmask |= ((kc >= wst) && (kc < wst + 16)) ? (1u << ce) : 0u; dcv[ce] = min(max(kc - qcol + 15, 0), 30); }
                f32x4 s[16];
#define QK_LOC(H) sfor<8>([&](auto I) __attribute__((always_inline)) { constexpr int lb = 8 * (H) + decltype(I)::value, krow = lb >> 1, ch = lb & 1; \
                    f32x4 a = __builtin_amdgcn_mfma_f32_16x16x32_bf16(kf[lb][0], qf0, (f32x4){0.f, 0.f, 0.f, 0.f}, 0, 0, 0); a = __builtin_amdgcn_mfma_f32_16x16x32_bf16(kf[lb][1], qf1, a, 0, 0, 0); \
                    const LAS float* rp_row = rpl + (rs + krow - r + 7) * 31; float bias[4]; \
                    _Pragma("unroll") for (int e = 0; e < 4; ++e) bias[e] = rp_row[dcv[ch * 4 + e]]; \
                    _Pragma("unroll") for (int e = 0; e < 4; ++e) { const float t = a[e] * SCL + bias[e] * LOG2E; a[e] = ((vmask >> (ch * 4 + e)) & 1u) ? t : -INFINITY; } \
                    s[lb] = a; })
                QK_LOC(0); QK_LOC(1); SB0();
                softmax_part<16>(s, m1, l1, lane);
                PV16(o1, s, (rrel + pp) * 64 + kcs + 4 * g, PITCH);
            }
            SB0();
            {
                f32x4 s[16];
                { const LAS unsigned char* kl = Kc + l15 * 144 + g * 16;
                  sfor<16>([&](auto I) __attribute__((always_inline)) { constexpr int cb = decltype(I)::value;
                    const bf16x8 k0 = *(const LAS bf16x8*)(kl + cb * (16 * 144)), k1 = *(const LAS bf16x8*)(kl + cb * (16 * 144) + 64);
                    f32x4 a = __builtin_amdgcn_mfma_f32_16x16x32_bf16(k0, qf0, (f32x4){0.f, 0.f, 0.f, 0.f}, 0, 0, 0); s[cb] = __builtin_amdgcn_mfma_f32_16x16x32_bf16(k1, qf1, a, 0, 0, 0) * SCL; }); }
                softmax_part<16>(s, m2, l2, lane, m1);
                const float a1 = __builtin_amdgcn_exp2f(m1 - m2);
#pragma unroll
                for (int db = 0; db < 4; ++db) o1[db] = o1[db] * a1;
                l1 = l1 * a1 + l2;
                PV16(o1, s, 576 + 32 * pp + 4 * g, PITCH);
            }
            const float rl = 1.0f / l1;
            int r2_ = r; asm volatile("" : "+s"(r2_));
            const size_t qtok2 = tokb + r2_ * 64 + qcol;
#pragma unroll
            for (int db = 0; db < 4; ++db) { const f32x4 ov = o1[db] * rl; u32x2 w; w.x = pk2(ov[0], ov[1]); w.y = pk2(ov[2], ov[3]);
                *(u32x2*)(Ob + qtok2 * D + h * 64 + 16 * db + 4 * g) = w; }
            __syncthreads();
        }
    }
}

#define RLX_AGENT __ATOMIC_RELAXED, __HIP_MEMORY_SCOPE_AGENT
#define XB_TMO      128
#define XB_XCNT(j)  (256  + 64 * (j))
#define XB_XSUB(j)  (1280 + 64 * (j))
#define XB_XGEN(j)  (2304 + 64 * (j))
#define XB_TOP      3328
#define XB_TOPGEN   3392
#define XCD_BAR_WORDS 3456
#define XB_SPIN_CAP (1u << 18)

__device__ __forceinline__ unsigned xb_ld(unsigned* p)              { return __hip_atomic_load(p, __ATOMIC_RELAXED, __HIP_MEMORY_SCOPE_AGENT); }
__device__ __forceinline__ unsigned xb_add(unsigned* p, unsigned v) { return __hip_atomic_fetch_add(p, v, __ATOMIC_RELAXED, __HIP_MEMORY_SCOPE_AGENT); }
__device__ __forceinline__ unsigned xb_xcc_id() { return (unsigned)__builtin_amdgcn_s_getreg((3 << 11) | 20) & 0xFu; }
#define XB_SPIN(cond, bar) do { unsigned _sp = 0; while (cond) { __builtin_amdgcn_s_sleep(1); \
    if ((++_sp & 255u) == 0u) { if (xb_ld(&(bar)[XB_TMO])) break; if (_sp > XB_SPIN_CAP) { atomicAdd(&(bar)[XB_TMO], 1u); break; } } } } while (0)

struct XcdBarrier {
    unsigned* bar; unsigned x;
    volatile LAS unsigned* st;
};

__device__ __forceinline__ XcdBarrier xcd_barrier_post(unsigned* bar, volatile LAS unsigned* st) {
    XcdBarrier b; b.bar = bar; b.x = xb_xcc_id(); b.st = st;
    if (threadIdx.x == 0) (void)xb_add(&bar[XB_XCNT(b.x)], 1u);
    return b;
}
__device__ __forceinline__ void xcd_barrier_complete(unsigned* bar, unsigned x, unsigned& nloc, unsigned& nx) {
    const unsigned G = gridDim.x * gridDim.y * gridDim.z;
    unsigned sum, cnt, mine, sp = 0u;
    for (;;) {
        sum = 0u; cnt = 0u; mine = 0u;
#pragma unroll
        for (unsigned j = 0; j < 16; ++j) { const unsigned c = xb_ld(&bar[XB_XCNT(j)]); sum += c; cnt += (c > 0u) ? 1u : 0u; mine = (j == x) ? c : mine; }
        if (sum == G) break;
        __builtin_amdgcn_s_sleep(1);
        if ((++sp & 255u) == 0u) { if (xb_ld(&bar[XB_TMO])) break; if (sp > XB_SPIN_CAP) { atomicAdd(&bar[XB_TMO], 1u); break; } }
    }
    nloc = mine > 0u ? mine : 1u; nx = cnt > 0u ? cnt : 1u;
}

__device__ __forceinline__ void xcd_barrier(const XcdBarrier& b) {
    asm volatile("s_waitcnt vmcnt(0)" ::: "memory");
    __syncthreads();
    if (threadIdx.x == 0) {
        unsigned* bar = b.bar;
        __builtin_amdgcn_s_waitcnt(0);
        unsigned nloc = b.st[0], nx = b.st[1];
        if (nloc == 0u) { xcd_barrier_complete(bar, b.x, nloc, nx); b.st[0] = nloc; b.st[1] = nx; }
        const unsigned old = xb_add(&bar[XB_XSUB(b.x)], 1u);
        const unsigned gen = old / nloc;
        if (old + 1u == (gen + 1u) * nloc) {
            __builtin_amdgcn_fence(__ATOMIC_RELEASE, "agent");
            asm volatile("s_waitcnt vmcnt(0)" ::: "memory");
            const unsigned og = xb_add(&bar[XB_TOP], 1u);
            if (og + 1u == (gen + 1u) * nx) xb_add(&bar[XB_TOPGEN], 1u);
            else XB_SPIN(xb_ld(&bar[XB_TOPGEN]) == gen, bar);
            __builtin_amdgcn_fence(__ATOMIC_ACQUIRE, "agent");
            asm volatile("s_waitcnt vmcnt(0)" ::: "memory");
        } else {
            XB_SPIN(xb_ld(&bar[XB_TOPGEN]) == gen, bar);
            __builtin_amdgcn_fence(__ATOMIC_ACQUIRE, "agent");
            asm volatile("s_waitcnt vmcnt(0)" ::: "memory");
        }
    }
    __syncthreads();
}

constexpr int NPH = 2 + 5 * NL + 1;
struct Args { const float* in[21]; float* out; unsigned char* ws; int nprog, pad; int prog[48]; };
typedef const __attribute__((address_space(4))) Args* KArgPtr;
__global__ void __launch_bounds__(NTHR, 2) fwd_kernel(Args a_unused) {
    extern __shared__ __attribute__((aligned(16))) unsigned char lds_raw[];
    LAS unsigned char* lds = (LAS unsigned char*)lds_raw;
    cg::grid_group grid = cg::this_grid();
    const int wave0 = __builtin_amdgcn_readfirstlane((int)threadIdx.x >> 6);
    { volatile LAS unsigned* st0 = (volatile LAS unsigned*)(lds + LDS_ST); if (threadIdx.x < 2) st0[threadIdx.x] = 0u; }
    __syncthreads();
    XcdBarrier xbar; { KArgPtr kpb = (KArgPtr)__builtin_amdgcn_kernarg_segment_ptr(); xbar.bar = (unsigned*)kpb->ws; xbar.x = 0; xbar.st = (volatile LAS unsigned*)(lds + LDS_ST);
        if (blockIdx.x == 0) { for (int wI = threadIdx.x; wI < XCD_BAR_WORDS; wI += NTHR) __hip_atomic_store(xbar.bar + wI, 0u, __ATOMIC_RELAXED, __HIP_MEMORY_SCOPE_AGENT); } }
    int nprog; { KArgPtr kp0 = (KArgPtr)__builtin_amdgcn_kernarg_segment_ptr(); nprog = kp0->nprog; }
    for (int pc = 0; pc < nprog; ++pc) {
        KArgPtr kp = (KArgPtr)__builtin_amdgcn_kernarg_segment_ptr(); asm volatile("" : "+s"(kp));
        int z_ = 0; asm volatile("" : "+s"(z_));
        const int lane_ = (int)__builtin_amdgcn_mbcnt_hi(~0u, __builtin_amdgcn_mbcnt_lo(~0u, (unsigned)z_)); const int tid_ = wave0 * 64 + lane_;
        int bid_ = (int)__builtin_amdgcn_workgroup_id_x(), G_ = (int)gridDim.x; asm volatile("" : "+s"(bid_), "+s"(G_));
        const int pe_ = kp->prog[pc]; const int ph = pe_ & 63, amode = pe_ >> 6;
        const int tid = tid_, lane = lane_, wave = wave0, G = G_, bid = bid_;
        const int gw = bid * NWAVES + wave, NGW = G * NWAVES;
        Ptrs P; P = Ptrs{kp->in[0], kp->in[1], kp->in[2], kp->in[3], kp->in[4], kp->in[5], kp->in[6], kp->in[7], kp->in[8], kp->in[9], kp->in[10], kp->in[11], kp->in[12], kp->in[13], kp->in[14], kp->in[15], kp->in[16], kp->in[17], kp->in[18], kp->in[19], kp->in[20]};
        unsigned char* ws = kp->ws; float* outp = kp->out;
        float* mod = (float*)(ws + WS_MOD); bf16* Wt = (bf16*)(ws + WS_W); bf16* X = (bf16*)(ws + WS_X); bf16* H = (bf16*)(ws + WS_H);
        bf16* R = (bf16*)(ws + WS_R); bf16* Qb = R; bf16* Kb = R + (size_t)M * D; bf16* Vb = R + (size_t)2 * M * D; bf16* Ob = R + (size_t)3 * M * D;
        bf16* Ub = R; bf16* Vc = R + (size_t)M * D; bf16* Fb = R;
        const bf16* CK = (const bf16*)(ws + WS_CK); const bf16* CV = (const bf16*)(ws + WS_CV);
        float* out_y = outp; float* out_ck = outp + (size_t)M * D; float* out_cv = out_ck + (size_t)32 * 2 * 256 * 1024;
        float* SS = (float*)(ws + WS_SS); float* SHW = (float*)(ws + WS_SHW);
        if (ph == 0) { p0_phase(P, ws, lds, tid, lane, wave, G, bid); }
        else if (ph == 1) { prep_phase(P.x_prompt, P.x_sample, H, SS, P.norm_g, mod + 1 * 1024, mod, Wt, SHW, gw, NGW, lane); }
        else if (ph == NPH - 1) { final_norm_phase(X, out_y, P.final_g, gw, NGW, lane); }
        else if (ph >= 60) { }
        else {
            const int l = (ph - 2) / 5, s = (ph - 2) % 5, i = l >> 1; const bool conv = (l & 1) != 0;
            const float* modl = mod + (size_t)l * 5 * 6144;
            if (s == 0) {
                const float* ssl = SS + (size_t)(2 * l) * M; const float* shl = SHW + (size_t)((2 * l) * 5) * 4096;
                if (!conv) { pg8::Gemm gm{H, Wt + W_QKV + (size_t)i * 3 * MEL, M, 3 * D, D}; pg8::StaticOrder S; S.init(M, 3 * D, G, bid);
                    pg8::EpiQKV E{ssl, shl, Qb, (size_t)M * D, out_ck + (size_t)i * 256 * 1024, (size_t)32 * 2 * 256 * 1024};
                    pg8::gemm_phase<pg8::EpiQKV, pg8::StaticOrder, true, true>(lds, gm, S, E, tid); }
                else { pg8::Gemm gm{H, Wt + W_PW1 + (size_t)i * 2 * MEL, M, 2 * D, D}; pg8::StaticOrder S; S.init(M, 2 * D, G, bid);
                    pg8::EpiGLU E{ssl, shl, Ub};
                    pg8::gemm_phase<pg8::EpiGLU, pg8::StaticOrder, true, true>(lds, gm, S, E, tid); }
            } else if (s == 1) {
                if (!conv) attn_phase(Qb, Kb, Vb, Ob, CK, CV, P.rpb + (size_t)i * 16 * 15 * 31, i, lds, tid, lane, wave, G, bid, amode == 2 ? 512 : 0, amode == 1 ? 512 : 1024);
                else conv_phase(Ub, Vc, P.w_dw + (size_t)i * 31 * D, P.b_dw + i * D, P.ln_g + i * D, P.ln_b + i * D, lds, tid, lane, wave, G, bid);
            } else if (s == 2 || s == 4) {
                pg8::Gemm gm; pg8::EpiRes E;
                if (s == 2) { gm = pg8::Gemm{conv ? Vc : Ob, Wt + (conv ? W_PW2 : W_O) + (size_t)i * MEL, M, D, D};
                    E = pg8::EpiRes{P.x_prompt, P.x_sample, l == 0 ? (const bf16*)nullptr : X, X, modl + 2 * 1024, H, P.norm_g + (l * 2 + 1) * D, modl + 4 * 1024, SS + (size_t)(2 * l + 1) * M}; }
                else { gm = pg8::Gemm{Fb, Wt + W_DOWN + (size_t)l * 4 * MEL, M, D, FF};
                    E = pg8::EpiRes{P.x_prompt, P.x_sample, X, X, modl + 5 * 1024, l < NL - 1 ? H : nullptr, P.norm_g + ((l + 1) * 2) * D, modl + 5 * 6144 + 1 * 1024, SS + (size_t)(2 * l + 2) * M}; }
                pg8::StaticOrder S; S.init(M, D, G, bid);
                pg8::gemm_phase<pg8::EpiRes, pg8::StaticOrder, true, true>(lds, gm, S, E, tid);
            } else {
#ifdef UP256
                pg8::Gemm gm{H, Wt + W_UP + (size_t)l * 4 * MEL, M, FF, D}; pg8::StaticOrder256 S; S.init(M, FF, G, bid);
                pg8::EpiUp256 E{SS + (size_t)(2 * l + 1) * M, SHW + (size_t)((2 * l + 1) * 5) * 4096, Fb, FF};
                pg8::gemm_phase256<pg8::EpiUp256, pg8::StaticOrder256, true, true>(lds, gm, S, E, tid);
#else
                pg8::Gemm gm{H, Wt + W_UP + (size_t)l * 4 * MEL, M, FF, D}; pg8::StaticOrder S; S.init(M, FF, G, bid);
                pg8::EpiUp E{SS + (size_t)(2 * l + 1) * M, SHW + (size_t)((2 * l + 1) * 5) * 4096, Fb, FF};
                pg8::gemm_phase<pg8::EpiUp, pg8::StaticOrder, true, true>(lds, gm, S, E, tid);
#endif
            }
        }
        if (pc + 1 < nprog) { if (pc == 0) { grid.sync(); xbar = xcd_barrier_post(xbar.bar, xbar.st); } else xcd_barrier(xbar); }
    }
}

#ifndef SINGLE_LAUNCH
#define SINGLE_LAUNCH 0
#endif
extern "C" void kernel_launch(void* const* d_in, const int* in_sizes, int n_in, void* d_out, int out_size, void* d_ws, size_t ws_size, hipStream_t stream) {
    static int grid = 0;
    if (grid == 0) {
        if (n_in != 21 || ws_size < WS_END) { fprintf(stderr, "kernel_launch: unexpected n_in %d / ws_size %zu\n", n_in, ws_size); grid = -1; return; }
        int dev = 0, cus = 0, per_cu = 0;
        hipGetDevice(&dev); hipDeviceGetAttribute(&cus, hipDeviceAttributeMultiprocessorCount, dev);
        hipFuncSetAttribute((const void*)fwd_kernel, hipFuncAttributeMaxDynamicSharedMemorySize, LDS_BYTES);
        hipOccupancyMaxActiveBlocksPerMultiprocessor(&per_cu, (const void*)fwd_kernel, NTHR, LDS_BYTES);
        if (per_cu < 1) { fprintf(stderr, "kernel_launch: occupancy query says %d blocks/CU\n", per_cu); per_cu = 1; }
        (void)hipGetLastError();
        grid = cus * per_cu;
    }
    if (grid < 0) return;
    Args a{};
    for (int i = 0; i < 21; ++i) a.in[i] = (const float*)d_in[i];
    a.out = (float*)d_out; a.ws = (unsigned char*)d_ws;
#if SINGLE_LAUNCH
    { int n = 0;
      for (int ph = 0; ph < NPH; ++ph) { a.prog[n++] = ph;
#ifdef PROBE_ATTN_MODE
          if (ph >= 2 && ph < NPH - 1 && (ph - 2) % 5 == 1 && ((ph - 2) / 5) % 2 == 0) a.prog[n++] = ph | (PROBE_ATTN_MODE << 6);
#endif
#ifdef PROBE_EMPTY
          if (ph == 5) for (int q = 0; q < PROBE_EMPTY; ++q) a.prog[n++] = 60;
#endif
#ifdef PROBE_REPEAT_P0
          if (ph == 0) a.prog[n++] = 0;
#endif
#ifdef PROBE_REPEAT_S
          if (ph >= 2 && ph < NPH - 1 && (ph - 2) % 5 == PROBE_REPEAT_S && (PROBE_REPEAT_PAR < 0 || ((ph - 2) / 5) % 2 == PROBE_REPEAT_PAR)) a.prog[n++] = ph;
#endif
      }
      a.nprog = n; }
    void* args[] = {&a};
    hipError_t e = hipLaunchCooperativeKernel((const void*)fwd_kernel, dim3(grid), dim3(NTHR), args, LDS_BYTES, stream);
    if (e != hipSuccess) fprintf(stderr, "cooperative launch failed: %s (grid %d)\n", hipGetErrorString(e), grid);
#else
    for (int ph = 0; ph < NPH; ++ph) { a.nprog = 1; a.prog[0] = ph; hipLaunchKernelGGL(fwd_kernel, dim3(grid), dim3(NTHR), LDS_BYTES, stream, a); }
#endif
}
```

```cpp
#define SINGLE_LAUNCH 1
#define UP256 1
#include <hip/hip_runtime.h>
#include <hip/hip_cooperative_groups.h>
#include <cstdio>
#include <cstdint>
#include <cmath>
#include <utility>
namespace cg = cooperative_groups;
namespace pg8 {
#define PG8_LAS __attribute__((address_space(3)))
typedef unsigned short bf16_t;
typedef short bf16x8 __attribute__((ext_vector_type(8)));
typedef float f32x4 __attribute__((ext_vector_type(4)));
typedef unsigned u32x4 __attribute__((ext_vector_type(4)));
constexpr int RM = 192;
constexpr int BM = 256, BK = 64, HALF = 128, HTB = HALF * BK * 2  , STAGE_BYTES = 8 * HTB, NXCD = 8, WGM = 8;

__host__ __device__ __forceinline__ int lds_byte(int r, int c) { const int st = (r >> 4) * 2 + (c >> 5), rr = r & 15, cc = c & 31, ob = rr * 64 + cc * 2; return st * 1024 + (ob ^ (((ob >> 9) & 1) << 5)); }
__host__ __device__ __forceinline__ void stage_rc(int b, int& R, int& C) { const int st = b / 1024, sb = b % 1024, swz = sb ^ (((sb >> 9) & 1) << 5); R = (st >> 1) * 16 + swz / 64; C = (st & 1) * 32 + (swz % 64) / 2; }
__host__ __device__ __forceinline__ int perm32(int rho) { const int n = rho >> 4, i = rho & 15; return 8 * (i >> 2) + 4 * n + (i & 3); }

struct Unit { int pm, pn; };
struct Gemm { const bf16_t* A; const bf16_t* Bt; int M, N, K; };

struct StaticOrder {
    int nM, nN, nwg, G, c;
    __host__ __device__ void init(int M, int N, int G_, int c_) { nM = M / RM; nN = N / BM; nwg = nM * nN; G = G_; c = c_; }
    __host__ __device__ bool next(int i, Unit& u) const {
        const long L = (long)i * G + c; if (L >= nwg) return false;
        int wgid = (int)L; { const int q = nwg / NXCD, r = nwg % NXCD, xcd = wgid % NXCD, off = wgid / NXCD; wgid = (xcd < r ? xcd * (q + 1) : r * (q + 1) + (xcd - r) * q) + off; }
        const int nig = WGM * nN, gid = wgid / nig, fm = gid * WGM, gsz = (nM - fm) < WGM ? (nM - fm) : WGM;
        u.pm = fm + ((wgid % nig) % gsz); u.pn = (wgid % nig) / gsz; return true;
    }
    __device__ __forceinline__ void a_ready(const Unit&) const {}
    __device__ __forceinline__ void done(const Unit&) const {}
};

__device__ __forceinline__ unsigned cvt_pk_bf16(float lo, float hi) { unsigned r; asm volatile("v_cvt_pk_bf16_f32 %0, %1, %2" : "=v"(r) : "v"(lo), "v"(hi)); return r; }
typedef float f32x2 __attribute__((ext_vector_type(2)));
__device__ __forceinline__ int cond_of_row(int r) { return r < 8192 ? 0 : 1 + ((r - 8192) >> 10); }
__device__ __forceinline__ int half_row0(int ai, int wr) { return ai == 0 ? wr * 64 : 128 + wr * 32; }
#define EPI_MLOOP(ai, m) _Pragma("unroll") for (int m = 0; m < 4; ++m) if (ai == 0 || m < 2)
struct EpiQKV {
    static constexpr bool PERM = true, AFTER_DRAIN = false;
    const float* ss; const float* shw;
    bf16_t* Q; size_t qkv_stride; float* ck; size_t ckv_stride;
    __device__ __forceinline__ void operator()(const f32x4 (&acc)[2][2][4][2], const Unit& u, int wr, int wc, int fr, int fq) const {
        const int t = u.pn >> 2;
        bf16_t* base = Q + (size_t)t * qkv_stride;
        const int col0 = (u.pn & 3) * BM + wc * 32 + 8 * fq;
        float* cbase = ck + (size_t)(t > 0 ? t - 1 : 0) * ckv_stride + col0;
#pragma unroll
        for (int ai = 0; ai < 2; ++ai) { const int rbase = u.pm * RM + half_row0(ai, wr) + fr; const bool wc_ = (t > 0) && (rbase < 8192);
            const float* sp = shw + cond_of_row(rbase) * 4096 + u.pn * BM + wc * 32 + 8 * fq;
            f32x4 sv[2][2];
#pragma unroll
            for (int bj = 0; bj < 2; ++bj) { sv[bj][0] = *(const f32x4*)(sp + bj * HALF); sv[bj][1] = *(const f32x4*)(sp + bj * HALF + 4); }
            float rr[4];
            EPI_MLOOP(ai, m) rr[m] = ss[rbase + m * 16];
            EPI_MLOOP(ai, m) { const int row = rbase + m * 16; bf16_t* rowp = base + (size_t)row * 1024 + col0;
                const float r = __builtin_amdgcn_rsqf(rr[m] * (1.f / 1024.f) + 1e-6f);
                float* cp0 = cbase + ((size_t)(row >> 8) * 2 * 256 + (row & 255)) * 1024;
#pragma unroll
                for (int bj = 0; bj < 2; ++bj) { const f32x4 v0 = acc[ai][bj][m][0] * r + sv[bj][0], v1 = acc[ai][bj][m][1] * r + sv[bj][1];
                    u32x4 w; w.x = cvt_pk_bf16(v0[0], v0[1]); w.y = cvt_pk_bf16(v0[2], v0[3]); w.z = cvt_pk_bf16(v1[0], v1[1]); w.w = cvt_pk_bf16(v1[2], v1[3]);
                    *(u32x4*)(rowp + bj * HALF) = w;
                    if (wc_) { float* cp = cp0 + bj * HALF; __builtin_nontemporal_store(v0, (f32x4*)cp); __builtin_nontemporal_store(v1, (f32x4*)(cp + 4)); } } } }
    }
};
struct EpiUp {
    static constexpr bool PERM = true, AFTER_DRAIN = false;
    const float* ss; const float* shw; bf16_t* O; int ldc;
    __device__ __forceinline__ void operator()(const f32x4 (&acc)[2][2][4][2], const Unit& u, int wr, int wc, int fr, int fq) const {
        const int col0 = u.pn * BM + wc * 32 + 8 * fq;
#pragma unroll
        for (int ai = 0; ai < 2; ++ai) { const int rbase = u.pm * RM + half_row0(ai, wr) + fr;
            const float* sp = shw + cond_of_row(rbase) * 4096 + col0;
            f32x4 sv[2][2];
#pragma unroll
            for (int bj = 0; bj < 2; ++bj) { sv[bj][0] = *(const f32x4*)(sp + bj * HALF); sv[bj][1] = *(const f32x4*)(sp + bj * HALF + 4); }
            float rr[4];
            EPI_MLOOP(ai, m) rr[m] = ss[rbase + m * 16];
            EPI_MLOOP(ai, m) { bf16_t* rowp = O + (size_t)(rbase + m * 16) * ldc + col0;
                const float r = __builtin_amdgcn_rsqf(rr[m] * (1.f / 1024.f) + 1e-6f);
#pragma unroll
                for (int bj = 0; bj < 2; ++bj) { f32x4 v0 = acc[ai][bj][m][0] * r + sv[bj][0], v1 = acc[ai][bj][m][1] * r + sv[bj][1];
#pragma unroll
                    for (int e = 0; e < 4; ++e) { const float a = fmaxf(v0[e], 0.f), b = fmaxf(v1[e], 0.f); v0[e] = a * a; v1[e] = b * b; }
                    u32x4 w; w.x = cvt_pk_bf16(v0[0], v0[1]); w.y = cvt_pk_bf16(v0[2], v0[3]); w.z = cvt_pk_bf16(v1[0], v1[1]); w.w = cvt_pk_bf16(v1[2], v1[3]);
                    *(u32x4*)(rowp + bj * HALF) = w; } } }
    }
};
struct EpiGLU {
    static constexpr bool PERM = true, AFTER_DRAIN = false;
    const float* ss; const float* shw; bf16_t* O;
    __device__ __forceinline__ void operator()(const f32x4 (&acc)[2][2][4][2], const Unit& u, int wr, int wc, int fr, int fq) const {
        const int col0 = u.pn * HALF + wc * 32 + 8 * fq;
#pragma unroll
        for (int ai = 0; ai < 2; ++ai) { const int rbase = u.pm * RM + half_row0(ai, wr) + fr;
            const float* sp = shw + cond_of_row(rbase) * 4096 + u.pn * BM + wc * 32 + 8 * fq;
            f32x4 sv[2][2];
#pragma unroll
            for (int bj = 0; bj < 2; ++bj) { sv[bj][0] = *(const f32x4*)(sp + bj * HALF); sv[bj][1] = *(const f32x4*)(sp + bj * HALF + 4); }
            float rr[4];
            EPI_MLOOP(ai, m) rr[m] = ss[rbase + m * 16];
            EPI_MLOOP(ai, m) { bf16_t* rowp = O + (size_t)(rbase + m * 16) * 1024 + col0;
                const float r = __builtin_amdgcn_rsqf(rr[m] * (1.f / 1024.f) + 1e-6f);
                f32x4 v0 = acc[ai][0][m][0] * r + sv[0][0], v1 = acc[ai][0][m][1] * r + sv[0][1]; const f32x4 g0 = acc[ai][1][m][0] * r + sv[1][0], g1 = acc[ai][1][m][1] * r + sv[1][1];
#pragma unroll
                for (int e = 0; e < 4; ++e) { v0[e] = v0[e] * __builtin_amdgcn_rcpf(1.f + __expf(-g0[e])); v1[e] = v1[e] * __builtin_amdgcn_rcpf(1.f + __expf(-g1[e])); }
                u32x4 w; w.x = cvt_pk_bf16(v0[0], v0[1]); w.y = cvt_pk_bf16(v0[2], v0[3]); w.z = cvt_pk_bf16(v1[0], v1[1]); w.w = cvt_pk_bf16(v1[2], v1[3]);
                *(u32x4*)rowp = w; } }
    }
};
struct EpiRes {
    static constexpr bool PERM = true, AFTER_DRAIN = false;
    const float* base_p; const float* base_s; const bf16_t* base_b; bf16_t* out; const float* gate;
    bf16_t* xb; const float* g_next; const float* sc_next; float* ss_next;
    __device__ __forceinline__ void operator()(const f32x4 (&acc)[2][2][4][2], const Unit& u, int wr, int wc, int fr, int fq) const {
        const int col0 = u.pn * BM + wc * 32 + 8 * fq;
        const int lane_x = fq * 16 + fr;
#pragma unroll
        for (int ai = 0; ai < 2; ++ai) { const int row0 = u.pm * RM + half_row0(ai, wr) + fr; const int cond = cond_of_row(row0);
            const float* gp = gate + cond * 6144 + col0;
            const float* bp = (row0 < 8192) ? base_p + (size_t)row0 * 1024 + col0 : base_s + (size_t)(row0 - 8192) * 1024 + col0;
            const bf16_t* bb = base_b + (size_t)row0 * 1024 + col0;
            bf16_t* op = out + (size_t)row0 * 1024 + col0;
            f32x4 gv[2][2], gs[2][2];
#pragma unroll
            for (int bj = 0; bj < 2; ++bj)
#pragma unroll
                for (int n = 0; n < 2; ++n) gv[bj][n] = *(const f32x4*)(gp + bj * HALF + n * 4);
            if (xb) { f32x4 ga[2][2], sa[2][2];
#pragma unroll
                for (int bj = 0; bj < 2; ++bj)
#pragma unroll
                    for (int n = 0; n < 2; ++n) { ga[bj][n] = *(const f32x4*)(g_next + col0 + bj * HALF + n * 4); sa[bj][n] = *(const f32x4*)(sc_next + cond * 6144 + col0 + bj * HALF + n * 4); }
#pragma unroll
                for (int bj = 0; bj < 2; ++bj)
#pragma unroll
                    for (int n = 0; n < 2; ++n) gs[bj][n] = ga[bj][n] * (1.f + sa[bj][n]); }
#pragma unroll
            for (int mp = 0; mp < 2; ++mp) if (ai == 0 || mp == 0) { f32x4 bs[2][2][2];
                if (base_b) {
#pragma unroll
                    for (int mm = 0; mm < 2; ++mm)
#pragma unroll
                        for (int bj = 0; bj < 2; ++bj) { const u32x4 w = *(const u32x4*)(bb + (size_t)((2 * mp + mm) * 16) * 1024 + bj * HALF);
                            bs[mm][bj][0] = (f32x4){__builtin_bit_cast(float, w.x << 16), __builtin_bit_cast(float, w.x & 0xffff0000u), __builtin_bit_cast(float, w.y << 16), __builtin_bit_cast(float, w.y & 0xffff0000u)};
                            bs[mm][bj][1] = (f32x4){__builtin_bit_cast(float, w.z << 16), __builtin_bit_cast(float, w.z & 0xffff0000u), __builtin_bit_cast(float, w.w << 16), __builtin_bit_cast(float, w.w & 0xffff0000u)}; }
                } else {
#pragma unroll
                    for (int mm = 0; mm < 2; ++mm)
#pragma unroll
                        for (int bj = 0; bj < 2; ++bj)
#pragma unroll
                            for (int n = 0; n < 2; ++n) bs[mm][bj][n] = *(const f32x4*)(bp + (size_t)((2 * mp + mm) * 16) * 1024 + bj * HALF + n * 4);
                }
#pragma unroll
                for (int mm = 0; mm < 2; ++mm) { float sq = 0.f;
#pragma unroll
                    for (int bj = 0; bj < 2; ++bj) { const f32x4 x0 = bs[mm][bj][0] + gv[bj][0] * acc[ai][bj][2 * mp + mm][0], x1 = bs[mm][bj][1] + gv[bj][1] * acc[ai][bj][2 * mp + mm][1];
                        { u32x4 w; w.x = cvt_pk_bf16(x0[0], x0[1]); w.y = cvt_pk_bf16(x0[2], x0[3]); w.z = cvt_pk_bf16(x1[0], x1[1]); w.w = cvt_pk_bf16(x1[2], x1[3]); *(u32x4*)(op + (size_t)((2 * mp + mm) * 16) * 1024 + bj * HALF) = w; }
                        if (xb) { const f32x4 h0 = x0 * gs[bj][0], h1 = x1 * gs[bj][1]; u32x4 w; w.x = cvt_pk_bf16(h0[0], h0[1]); w.y = cvt_pk_bf16(h0[2], h0[3]); w.z = cvt_pk_bf16(h1[0], h1[1]); w.w = cvt_pk_bf16(h1[2], h1[3]);
                            *(u32x4*)(xb + (size_t)(row0 + (2 * mp + mm) * 16) * 1024 + col0 + bj * HALF) = w;
                            sq += ((x0[0] * x0[0] + x0[1] * x0[1]) + (x0[2] * x0[2] + x0[3] * x0[3])) + ((x1[0] * x1[0] + x1[1] * x1[1]) + (x1[2] * x1[2] + x1[3] * x1[3])); } }
                    if (xb) {
                        sq += __builtin_bit_cast(float, __builtin_amdgcn_ds_bpermute((lane_x ^ 16) << 2, __builtin_bit_cast(int, sq)));
                        sq += __builtin_bit_cast(float, __builtin_amdgcn_ds_bpermute((lane_x ^ 32) << 2, __builtin_bit_cast(int, sq)));
                        if (fq == 0) atomicAdd(ss_next + row0 + (2 * mp + mm) * 16, sq); } }
                asm volatile("" ::: "memory"); } }
    }
};

struct StaticOrder256 {
    int nM, nN, nwg, G, c;
    __host__ __device__ void init(int M, int N, int G_, int c_) { nM = M / BM; nN = N / BM; nwg = nM * nN; G = G_; c = c_; }
    __host__ __device__ bool next(int i, Unit& u) const {
        const long L = (long)i * G + c; if (L >= nwg) return false;
        int wgid = (int)L; { const int q = nwg / NXCD, r = nwg % NXCD, xcd = wgid % NXCD, off = wgid / NXCD; wgid = (xcd < r ? xcd * (q + 1) : r * (q + 1) + (xcd - r) * q) + off; }
        const int nig = WGM * nN, gid = wgid / nig, fm = gid * WGM, gsz = (nM - fm) < WGM ? (nM - fm) : WGM;
        u.pm = fm + ((wgid % nig) % gsz); u.pn = (wgid % nig) / gsz; return true;
    }
    __device__ __forceinline__ void a_ready(const Unit&) const {}
    __device__ __forceinline__ void done(const Unit&) const {}
};
struct EpiUp256 {
    static constexpr bool PERM = true, AFTER_DRAIN = false;
    const float* ss; const float* shw; bf16_t* O; int ldc;
    __device__ __forceinline__ void operator()(const f32x4 (&acc)[2][2][4][2], const Unit& u, int wr, int wc, int fr, int fq) const {
        const int col0 = u.pn * BM + wc * 32 + 8 * fq;
        f32x4 sv[2][2][2]; float rr[2][4];
#pragma unroll
        for (int ai = 0; ai < 2; ++ai) { const int rbase = u.pm * BM + ai * HALF + wr * 64 + fr; const float* sp = shw + cond_of_row(rbase) * 4096 + col0;
#pragma unroll
            for (int bj = 0; bj < 2; ++bj) { sv[ai][bj][0] = *(const f32x4*)(sp + bj * HALF); sv[ai][bj][1] = *(const f32x4*)(sp + bj * HALF + 4); }
#pragma unroll
            for (int m = 0; m < 4; ++m) rr[ai][m] = ss[rbase + m * 16]; }
        __builtin_amdgcn_sched_barrier(0);
#pragma unroll
        for (int ai = 0; ai < 2; ++ai) { const int rbase = u.pm * BM + ai * HALF + wr * 64 + fr;
#pragma unroll
            for (int m = 0; m < 4; ++m) { bf16_t* rowp = O + (size_t)(rbase + m * 16) * ldc + col0;
                const float r = __builtin_amdgcn_rsqf(rr[ai][m] * (1.f / 1024.f) + 1e-6f);
#pragma unroll
                for (int bj = 0; bj < 2; ++bj) { f32x4 v0 = acc[ai][bj][m][0] * r + sv[ai][bj][0], v1 = acc[ai][bj][m][1] * r + sv[ai][bj][1];
#pragma unroll
                    for (int e = 0; e < 4; ++e) { const float a = fmaxf(v0[e], 0.f), b = fmaxf(v1[e], 0.f); v0[e] = a * a; v1[e] = b * b; }
                    u32x4 w; w.x = cvt_pk_bf16(v0[0], v0[1]); w.y = cvt_pk_bf16(v0[2], v0[3]); w.z = cvt_pk_bf16(v1[0], v1[1]); w.w = cvt_pk_bf16(v1[2], v1[3]);
                    *(u32x4*)(rowp + bj * HALF) = w; } } }
    }
};
template <class Epi, class Sched, bool ALIGN_EPI = false, bool SP2 = false>
__device__ __forceinline__ void gemm_phase256(PG8_LAS unsigned char* lds, const Gemm g, const Sched& S, const Epi& E, const int tid) {
    const int wid = __builtin_amdgcn_readfirstlane(tid >> 6), lane = tid & 63, wr = wid >> 2, wc = wid & 3, fr = lane & 15, fq = lane >> 4;
    const int K = g.K, nt = K / BK;
    unsigned voffA[2], voffB[2];
#pragma unroll
    for (int i = 0; i < 2; ++i) { int R, C; stage_rc(tid * 16 + i * 8192, R, C); const int Rb = Epi::PERM ? ((R & ~31) + perm32(R & 31)) : R;
        voffA[i] = (unsigned)(R * K + C) * 2u; voffB[i] = (unsigned)(Rb * K + C) * 2u; }
    const size_t kstep = (size_t)(BK * 2);
    const size_t hstep = (size_t)HALF * K * 2;
    const size_t tstep = 2 * hstep;
    const unsigned ldsw = (unsigned)wid * 1024u;
    const int aoff = lds_byte(wr * 64 + fr, fq * 8), boff = lds_byte(wc * 32 + fr, fq * 8);
#define PG8_SA(b, h) (((b) * 2 + (h)) * HTB)
#define PG8_SB(b, h) ((4 + (b) * 2 + (h)) * HTB)
#define PG8_STAGE(bufoff, gbase, voff) do { _Pragma("unroll") for (int _i = 0; _i < 2; ++_i) \
        __builtin_amdgcn_global_load_lds((const unsigned*)((const char*)(gbase) + (voff)[_i]), (PG8_LAS unsigned*)(lds + (bufoff) + ldsw + _i * 8192), 16, 0, 0); } while (0)
#define PG8_LDA(dst, b, h) do { _Pragma("unroll") for (int m = 0; m < 4; ++m) _Pragma("unroll") for (int k = 0; k < 2; ++k) dst[m][k] = *(const PG8_LAS bf16x8*)(lds + PG8_SA(b, h) + aoff + m * 2048 + k * 1024); } while (0)
#define PG8_LDB(dst, b, h) do { _Pragma("unroll") for (int n = 0; n < 2; ++n) _Pragma("unroll") for (int k = 0; k < 2; ++k) dst[n][k] = *(const PG8_LAS bf16x8*)(lds + PG8_SB(b, h) + boff + n * 2048 + k * 1024); } while (0)
#define PG8_MMA(ai, bj, At, Bt) do { __builtin_amdgcn_s_setprio(1); _Pragma("unroll") for (int m = 0; m < 4; ++m) _Pragma("unroll") for (int n = 0; n < 2; ++n) _Pragma("unroll") for (int k = 0; k < 2; ++k) \
        acc[ai][bj][m][n] = __builtin_amdgcn_mfma_f32_16x16x32_bf16(Bt[n][k], At[m][k], acc[ai][bj][m][n], 0, 0, 0); __builtin_amdgcn_s_setprio(0); } while (0)
#define PG8_WAIT_V(n) asm volatile("s_waitcnt vmcnt(" #n ")" ::: "memory")
#define PG8_WAIT_L(n) asm volatile("s_waitcnt lgkmcnt(" #n ")" ::: "memory")
#define PG8_BAR __builtin_amdgcn_s_barrier()
#define PG8_SCHED __builtin_amdgcn_sched_barrier(0)
    Unit cur, nxt; int ui = 0;
    if (!S.next(0, cur)) return;
    f32x4 acc[2][2][4][2];
#pragma unroll
    for (int a = 0; a < 2; ++a)
#pragma unroll
        for (int b = 0; b < 2; ++b)
#pragma unroll
            for (int m = 0; m < 4; ++m)
#pragma unroll
                for (int n = 0; n < 2; ++n) acc[a][b][m][n] = (f32x4){0.f, 0.f, 0.f, 0.f};
    bf16x8 At[4][2], B0[2][2], B1[2][2];
    const char* cA = (const char*)g.A + (size_t)cur.pm * tstep; const char* cB = (const char*)g.Bt + (size_t)cur.pn * tstep;
    S.a_ready(cur);
    if constexpr (SP2) {
        PG8_STAGE(PG8_SB(0, 0), cB, voffB); PG8_STAGE(PG8_SB(0, 1), cB + hstep, voffB); PG8_STAGE(PG8_SA(0, 0), cA, voffA); PG8_STAGE(PG8_SA(0, 1), cA + hstep, voffA);
        if (wr == 1) PG8_BAR;
        PG8_WAIT_V(2); PG8_BAR;
        PG8_STAGE(PG8_SB(1, 0), cB + kstep, voffB); PG8_STAGE(PG8_SA(1, 0), cA + kstep, voffA); PG8_STAGE(PG8_SB(1, 1), cB + hstep + kstep, voffB);
        PG8_WAIT_V(6); PG8_BAR;
    } else {
        PG8_STAGE(PG8_SB(0, 0), cB, voffB); PG8_STAGE(PG8_SA(0, 0), cA, voffA); PG8_STAGE(PG8_SB(0, 1), cB + hstep, voffB); PG8_STAGE(PG8_SA(0, 1), cA + hstep, voffA);
        if (wr == 1) PG8_BAR;
        PG8_WAIT_V(4); PG8_BAR;
        PG8_STAGE(PG8_SB(1, 0), cB + kstep, voffB); PG8_STAGE(PG8_SA(1, 0), cA + kstep, voffA); PG8_STAGE(PG8_SB(1, 1), cB + hstep + kstep, voffB);
        PG8_WAIT_V(6); PG8_BAR;
    }
    for (;;) {
        const bool has_next = S.next(ui + 1, nxt);
        const char* nA = has_next ? (const char*)g.A + (size_t)nxt.pm * tstep : cA; const char* nB = has_next ? (const char*)g.Bt + (size_t)nxt.pn * tstep : cB;
        for (int t = 0; t < nt; t += 2) {
            const bool last = (t == nt - 2);
            const char* a1 = cA + (size_t)(t + 1) * kstep;
            const char* a2 = last ? nA : cA + (size_t)(t + 2) * kstep; const char* b2 = last ? nB : cB + (size_t)(t + 2) * kstep;
            const char* a3 = a2 + kstep; const char* b3 = b2 + kstep;
            if (last && has_next) S.a_ready(nxt);
            if constexpr (SP2) {
            PG8_LDB(B0, 0, 0); PG8_LDB(B1, 0, 1); PG8_SCHED; PG8_LDA(At, 0, 0); PG8_STAGE(PG8_SA(1, 1), a1 + hstep, voffA);
            PG8_WAIT_V(8); PG8_WAIT_L(0); PG8_BAR; PG8_MMA(0, 0, At, B0); PG8_MMA(0, 1, At, B1); PG8_BAR; PG8_SCHED;
            PG8_LDA(At, 0, 1); PG8_STAGE(PG8_SB(0, 0), b2, voffB); PG8_STAGE(PG8_SB(0, 1), b2 + hstep, voffB); PG8_STAGE(PG8_SA(0, 0), a2, voffA);
            PG8_WAIT_V(8); PG8_WAIT_L(0); PG8_BAR; PG8_MMA(1, 0, At, B0); PG8_MMA(1, 1, At, B1); PG8_BAR; PG8_SCHED;
            PG8_LDB(B0, 1, 0); PG8_LDB(B1, 1, 1); PG8_SCHED; PG8_LDA(At, 1, 0); PG8_STAGE(PG8_SA(0, 1), a2 + hstep, voffA);
            PG8_WAIT_V(8); PG8_WAIT_L(0); PG8_BAR; PG8_MMA(0, 0, At, B0); PG8_MMA(0, 1, At, B1); PG8_BAR; PG8_SCHED;
            PG8_LDA(At, 1, 1); PG8_STAGE(PG8_SB(1, 0), b3, voffB); PG8_STAGE(PG8_SB(1, 1), b3 + hstep, voffB); PG8_STAGE(PG8_SA(1, 0), a3, voffA);
            PG8_WAIT_V(8); PG8_WAIT_L(0); PG8_BAR; PG8_MMA(1, 0, At, B0); PG8_MMA(1, 1, At, B1); PG8_BAR; PG8_SCHED;
            } else {
            PG8_LDB(B0, 0, 0); PG8_SCHED; PG8_LDA(At, 0, 0); PG8_STAGE(PG8_SA(1, 1), a1 + hstep, voffA);
            PG8_WAIT_L(8); PG8_BAR; PG8_WAIT_L(0); PG8_MMA(0, 0, At, B0); PG8_BAR; PG8_SCHED;
            PG8_LDB(B1, 0, 1); PG8_STAGE(PG8_SB(0, 0), b2, voffB);
            PG8_BAR; PG8_WAIT_L(0); PG8_MMA(0, 1, At, B1); PG8_BAR;
            PG8_LDA(At, 0, 1); PG8_STAGE(PG8_SA(0, 0), a2, voffA);
            PG8_BAR; PG8_WAIT_L(0); PG8_MMA(1, 0, At, B0); PG8_BAR; PG8_SCHED;
            PG8_STAGE(PG8_SB(0, 1), b2 + hstep, voffB);
            PG8_WAIT_V(6); PG8_BAR; PG8_MMA(1, 1, At, B1); PG8_BAR;
            PG8_LDB(B0, 1, 0); PG8_SCHED; PG8_LDA(At, 1, 0); PG8_STAGE(PG8_SA(0, 1), a2 + hstep, voffA);
            PG8_WAIT_L(8); PG8_BAR; PG8_WAIT_L(0); PG8_MMA(0, 0, At, B0); PG8_BAR; PG8_SCHED;
            PG8_LDB(B1, 1, 1); PG8_STAGE(PG8_SB(1, 0), b3, voffB);
            PG8_BAR; PG8_WAIT_L(0); PG8_MMA(0, 1, At, B1); PG8_BAR;
            PG8_LDA(At, 1, 1); PG8_STAGE(PG8_SA(1, 0), a3, voffA);
            PG8_BAR; PG8_WAIT_L(0); PG8_MMA(1, 0, At, B0); PG8_BAR; PG8_SCHED;
            PG8_STAGE(PG8_SB(1, 1), b3 + hstep, voffB);
            PG8_WAIT_V(6); PG8_BAR; PG8_MMA(1, 1, At, B1); PG8_BAR;
            }
        }
        if constexpr (ALIGN_EPI) { if (wr == 0) PG8_BAR; }
        if constexpr (!Epi::AFTER_DRAIN) { E(acc, cur, wr, wc, fr, fq); S.done(cur); }
        if (!has_next) break;
#pragma unroll
        for (int a = 0; a < 2; ++a)
#pragma unroll
            for (int b = 0; b < 2; ++b)
#pragma unroll
                for (int m = 0; m < 4; ++m)
#pragma unroll
                    for (int n = 0; n < 2; ++n) acc[a][b][m][n] = (f32x4){0.f, 0.f, 0.f, 0.f};
        cur = nxt; cA = nA; cB = nB; ++ui;
        if constexpr (ALIGN_EPI) { if (wr == 1) PG8_BAR; }
    }
    PG8_WAIT_V(0);
    if constexpr (!ALIGN_EPI) { if (wr == 0) PG8_BAR; }
    PG8_BAR;
    if constexpr (Epi::AFTER_DRAIN) { E.fused(acc, cur, wr, wc, fr, fq, lds, wid, lane); S.done(cur); }
#undef PG8_SA
#undef PG8_SB
#undef PG8_STAGE
#undef PG8_LDA
#undef PG8_LDB
#undef PG8_MMA
#undef PG8_WAIT_V
#undef PG8_WAIT_L
#undef PG8_BAR
#undef PG8_SCHED
}
template <class Epi, class Sched, bool ALIGN_EPI = false, bool SP2 = false>
__device__ __forceinline__ void gemm_phase(PG8_LAS unsigned char* lds, const Gemm g, const Sched& S, const Epi& E, const int tid) {
    static_assert(SP2, "the 192-row tile form exists for the SP2 loop only");
    const int wid = __builtin_amdgcn_readfirstlane(tid >> 6), lane = tid & 63, wr = wid >> 2, wc = wid & 3, fr = lane & 15, fq = lane >> 4;
    const int K = g.K, nt = K / BK;
    unsigned voffA[2], voffB[2];
#pragma unroll
    for (int i = 0; i < 2; ++i) { int R, C; stage_rc(tid * 16 + i * 8192, R, C); const int Rb = Epi::PERM ? ((R & ~31) + perm32(R & 31)) : R;
        voffA[i] = (unsigned)(R * K + C) * 2u; voffB[i] = (unsigned)(Rb * K + C) * 2u; }
    const size_t kstep = (size_t)(BK * 2);
    const size_t hstep = (size_t)HALF * K * 2;
    const size_t tstepA = (size_t)RM * K * 2;
    const size_t tstep = 2 * hstep;
    const unsigned ldsw = (unsigned)wid * 1024u;
    const int aoff = lds_byte(wr * 64 + fr, fq * 8), boff = lds_byte(wc * 32 + fr, fq * 8);
#define PG8_SA(b, h) (((b) * 2 + (h)) * HTB)
#define PG8_SB(b, h) ((4 + (b) * 2 + (h)) * HTB)
#define PG8_STAGE(bufoff, gbase, voff) do { _Pragma("unroll") for (int _i = 0; _i < 2; ++_i) \
        __builtin_amdgcn_global_load_lds((const unsigned*)((const char*)(gbase) + (voff)[_i]), (PG8_LAS unsigned*)(lds + (bufoff) + ldsw + _i * 8192), 16, 0, 0); } while (0)
#define PG8_LDA(dst, b, h) do { _Pragma("unroll") for (int m = 0; m < 4; ++m) _Pragma("unroll") for (int k = 0; k < 2; ++k) dst[m][k] = *(const PG8_LAS bf16x8*)(lds + PG8_SA(b, h) + aoff + m * 2048 + k * 1024); } while (0)
#define PG8_LDB(dst, b, h) do { _Pragma("unroll") for (int n = 0; n < 2; ++n) _Pragma("unroll") for (int k = 0; k < 2; ++k) dst[n][k] = *(const PG8_LAS bf16x8*)(lds + PG8_SB(b, h) + boff + n * 2048 + k * 1024); } while (0)
#define PG8_MMA(ai, bj, At, Bt) do { __builtin_amdgcn_s_setprio(1); _Pragma("unroll") for (int m = 0; m < 4; ++m) _Pragma("unroll") for (int n = 0; n < 2; ++n) _Pragma("unroll") for (int k = 0; k < 2; ++k) \
        acc[ai][bj][m][n] = __builtin_amdgcn_mfma_f32_16x16x32_bf16(Bt[n][k], At[m][k], acc[ai][bj][m][n], 0, 0, 0); __builtin_amdgcn_s_setprio(0); } while (0)
    const int aoff1 = lds_byte(wr * 32 + fr, fq * 8);
#define PG8_STAGE1(bufoff, gbase, voff) __builtin_amdgcn_global_load_lds((const unsigned*)((const char*)(gbase) + (voff)[0]), (PG8_LAS unsigned*)(lds + (bufoff) + ldsw), 16, 0, 0)
#define PG8_LDA1(dst, b) do { _Pragma("unroll") for (int m = 0; m < 2; ++m) _Pragma("unroll") for (int k = 0; k < 2; ++k) dst[m][k] = *(const PG8_LAS bf16x8*)(lds + PG8_SA(b, 1) + aoff1 + m * 2048 + k * 1024); } while (0)
#define PG8_MMA1(bj, At, Bt) do { __builtin_amdgcn_s_setprio(1); _Pragma("unroll") for (int m = 0; m < 2; ++m) _Pragma("unroll") for (int n = 0; n < 2; ++n) _Pragma("unroll") for (int k = 0; k < 2; ++k) \
        acc[1][bj][m][n] = __builtin_amdgcn_mfma_f32_16x16x32_bf16(Bt[n][k], At[m][k], acc[1][bj][m][n], 0, 0, 0); __builtin_amdgcn_s_setprio(0); } while (0)
#define PG8_WAIT_V(n) asm volatile("s_waitcnt vmcnt(" #n ")" ::: "memory")
#define PG8_WAIT_L(n) asm volatile("s_waitcnt lgkmcnt(" #n ")" ::: "memory")
#define PG8_BAR __builtin_amdgcn_s_barrier()
#define PG8_SCHED __builtin_amdgcn_sched_barrier(0)
    Unit cur, nxt; int ui = 0;
    if (!S.next(0, cur)) return;
    f32x4 acc[2][2][4][2];
#pragma unroll
    for (int a = 0; a < 2; ++a)
#pragma unroll
        for (int b = 0; b < 2; ++b)
#pragma unroll
            for (int m = 0; m < 4; ++m)
#pragma unroll
                for (int n = 0; n < 2; ++n) acc[a][b][m][n] = (f32x4){0.f, 0.f, 0.f, 0.f};
    bf16x8 At[4][2], B0[2][2], B1[2][2];
    const char* cA = (const char*)g.A + (size_t)cur.pm * tstepA; const char* cB = (const char*)g.Bt + (size_t)cur.pn * tstep;
    S.a_ready(cur);
    if constexpr (SP2) {
        PG8_STAGE(PG8_SB(0, 0), cB, voffB); PG8_STAGE(PG8_SB(0, 1), cB + hstep, voffB); PG8_STAGE(PG8_SA(0, 0), cA, voffA); PG8_STAGE1(PG8_SA(0, 1), cA + hstep, voffA);
        if (wr == 1) PG8_BAR;
        PG8_WAIT_V(1); PG8_BAR;
        PG8_STAGE(PG8_SB(1, 0), cB + kstep, voffB); PG8_STAGE(PG8_SA(1, 0), cA + kstep, voffA); PG8_STAGE(PG8_SB(1, 1), cB + hstep + kstep, voffB);
        PG8_WAIT_V(6); PG8_BAR;
    } else {
        PG8_STAGE(PG8_SB(0, 0), cB, voffB); PG8_STAGE(PG8_SA(0, 0), cA, voffA); PG8_STAGE(PG8_SB(0, 1), cB + hstep, voffB); PG8_STAGE(PG8_SA(0, 1), cA + hstep, voffA);
        if (wr == 1) PG8_BAR;
        PG8_WAIT_V(4); PG8_BAR;
        PG8_STAGE(PG8_SB(1, 0), cB + kstep, voffB); PG8_STAGE(PG8_SA(1, 0), cA + kstep, voffA); PG8_STAGE(PG8_SB(1, 1), cB + hstep + kstep, voffB);
        PG8_WAIT_V(6); PG8_BAR;
    }
    for (;;) {
        const bool has_next = S.next(ui + 1, nxt);
        const char* nA = has_next ? (const char*)g.A + (size_t)nxt.pm * tstepA : cA; const char* nB = has_next ? (const char*)g.Bt + (size_t)nxt.pn * tstep : cB;
        for (int t = 0; t < nt; t += 2) {
            const bool last = (t == nt - 2);
            const char* a1 = cA + (size_t)(t + 1) * kstep;
            const char* a2 = last ? nA : cA + (size_t)(t + 2) * kstep; const char* b2 = last ? nB : cB + (size_t)(t + 2) * kstep;
            const char* a3 = a2 + kstep; const char* b3 = b2 + kstep;
            if (last && has_next) S.a_ready(nxt);
            if constexpr (SP2) {
            PG8_LDB(B0, 0, 0); PG8_LDB(B1, 0, 1); PG8_SCHED; PG8_LDA(At, 0, 0); PG8_STAGE1(PG8_SA(1, 1), a1 + hstep, voffA);
            PG8_WAIT_V(7); PG8_WAIT_L(0); PG8_BAR; PG8_MMA(0, 0, At, B0); PG8_MMA(0, 1, At, B1); PG8_BAR; PG8_SCHED;
            PG8_LDA1(At, 0); PG8_STAGE(PG8_SB(0, 0), b2, voffB); PG8_STAGE(PG8_SB(0, 1), b2 + hstep, voffB); PG8_STAGE(PG8_SA(0, 0), a2, voffA);
            PG8_WAIT_V(7); PG8_WAIT_L(0); PG8_BAR; PG8_MMA1(0, At, B0); PG8_MMA1(1, At, B1); PG8_BAR; PG8_SCHED;
            PG8_LDB(B0, 1, 0); PG8_LDB(B1, 1, 1); PG8_SCHED; PG8_LDA(At, 1, 0); PG8_STAGE1(PG8_SA(0, 1), a2 + hstep, voffA);
            PG8_WAIT_V(7); PG8_WAIT_L(0); PG8_BAR; PG8_MMA(0, 0, At, B0); PG8_MMA(0, 1, At, B1); PG8_BAR; PG8_SCHED;
            PG8_LDA1(At, 1); PG8_STAGE(PG8_SB(1, 0), b3, voffB); PG8_STAGE(PG8_SB(1, 1), b3 + hstep, voffB); PG8_STAGE(PG8_SA(1, 0), a3, voffA);
            PG8_WAIT_V(7); PG8_WAIT_L(0); PG8_BAR; PG8_MMA1(0, At, B0); PG8_MMA1(1, At, B1); PG8_BAR; PG8_SCHED;
            } else {
            PG8_LDB(B0, 0, 0); PG8_SCHED; PG8_LDA(At, 0, 0); PG8_STAGE(PG8_SA(1, 1), a1 + hstep, voffA);
            PG8_WAIT_L(8); PG8_BAR; PG8_WAIT_L(0); PG8_MMA(0, 0, At, B0); PG8_BAR; PG8_SCHED;
            PG8_LDB(B1, 0, 1); PG8_STAGE(PG8_SB(0, 0), b2, voffB);
            PG8_BAR; PG8_WAIT_L(0); PG8_MMA(0, 1, At, B1); PG8_BAR;
            PG8_LDA(At, 0, 1); PG8_STAGE(PG8_SA(0, 0), a2, voffA);
            PG8_BAR; PG8_WAIT_L(0); PG8_MMA(1, 0, At, B0); PG8_BAR; PG8_SCHED;
            PG8_STAGE(PG8_SB(0, 1), b2 + hstep, voffB);
            PG8_WAIT_V(6); PG8_BAR; PG8_MMA(1, 1, At, B1); PG8_BAR;
            PG8_LDB(B0, 1, 0); PG8_SCHED; PG8_LDA(At, 1, 0); PG8_STAGE(PG8_SA(0, 1), a2 + hstep, voffA);
            PG8_WAIT_L(8); PG8_BAR; PG8_WAIT_L(0); PG8_MMA(0, 0, At, B0); PG8_BAR; PG8_SCHED;
            PG8_LDB(B1, 1, 1); PG8_STAGE(PG8_SB(1, 0), b3, voffB);
            PG8_BAR; PG8_WAIT_L(0); PG8_MMA(0, 1, At, B1); PG8_BAR;
            PG8_LDA(At, 1, 1); PG8_STAGE(PG8_SA(1, 0), a3, voffA);
            PG8_BAR; PG8_WAIT_L(0); PG8_MMA(1, 0, At, B0); PG8_BAR; PG8_SCHED;
            PG8_STAGE(PG8_SB(1, 1), b3 + hstep, voffB);
            PG8_WAIT_V(6); PG8_BAR; PG8_MMA(1, 1, At, B1); PG8_BAR;
            }
        }
        if constexpr (ALIGN_EPI) { if (wr == 0) PG8_BAR; }
        if constexpr (!Epi::AFTER_DRAIN) { E(acc, cur, wr, wc, fr, fq); S.done(cur); }
        if (!has_next) break;
#pragma unroll
        for (int a = 0; a < 2; ++a)
#pragma unroll
            for (int b = 0; b < 2; ++b)
#pragma unroll
                for (int m = 0; m < 4; ++m)
#pragma unroll
                    for (int n = 0; n < 2; ++n) acc[a][b][m][n] = (f32x4){0.f, 0.f, 0.f, 0.f};
        cur = nxt; cA = nA; cB = nB; ++ui;
        if constexpr (ALIGN_EPI) { if (wr == 1) PG8_BAR; }
    }
    PG8_WAIT_V(0);
    if constexpr (!ALIGN_EPI) { if (wr == 0) PG8_BAR; }
    PG8_BAR;
    if constexpr (Epi::AFTER_DRAIN) { E.fused(acc, cur, wr, wc, fr, fq, lds, wid, lane); S.done(cur); }
#undef PG8_SA
#undef PG8_SB
#undef PG8_STAGE
#undef PG8_LDA
#undef PG8_LDB
#undef PG8_MMA
#undef PG8_STAGE1
#undef PG8_LDA1
#undef PG8_MMA1
#undef PG8_WAIT_V
#undef PG8_WAIT_L
#undef PG8_BAR
#undef PG8_SCHED
}
}
constexpr int D = 1024, MP = 8192, MS = 4096, M = MP + MS, FF = 4096, NL = 4;
constexpr int NWAVES = 8, NTHR = 512;
constexpr size_t MiB = 1u << 20;
constexpr size_t WS_MOD = 1 * MiB;
constexpr size_t WS_W = 2 * MiB;
constexpr size_t WS_X = 94 * MiB;
constexpr size_t WS_H = 142 * MiB;
constexpr size_t WS_R = 166 * MiB;
constexpr size_t WS_CK = 262 * MiB, WS_CV = 266 * MiB, WS_SHW = 270 * MiB, WS_SS = 271 * MiB, WS_END = 272 * MiB;
constexpr size_t MEL = 1u << 20;
constexpr size_t W_QKV = 0, W_O = 6 * MEL, W_PW1 = 8 * MEL, W_PW2 = 12 * MEL, W_UP = 14 * MEL, W_DOWN = 30 * MEL;
constexpr int LDS_BYTES = 163840, LDS_ST = LDS_BYTES - 16, LDS_KC = 112640;

#define LAS __attribute__((address_space(3)))
#define SB0() __builtin_amdgcn_sched_barrier(0)
typedef unsigned short bf16;
typedef float f32x4 __attribute__((ext_vector_type(4)));
typedef float f32x2 __attribute__((ext_vector_type(2)));
typedef unsigned u32x4 __attribute__((ext_vector_type(4)));
typedef unsigned u32x2 __attribute__((ext_vector_type(2)));
typedef short bf16x8 __attribute__((ext_vector_type(8)));
typedef short s16x4 __attribute__((ext_vector_type(4)));
typedef float f32x32 __attribute__((ext_vector_type(32)));

__device__ __forceinline__ unsigned f2bf(float f) { unsigned u = __builtin_bit_cast(unsigned, f); return (u + 0x7fffu + ((u >> 16) & 1u)) >> 16; }
__device__ __forceinline__ unsigned pk2(float lo, float hi) { unsigned r; asm("v_cvt_pk_bf16_f32 %0, %1, %2" : "=v"(r) : "v"(lo), "v"(hi)); return r; }
__device__ __forceinline__ float bflo(unsigned w) { return __builtin_bit_cast(float, w << 16); }
__device__ __forceinline__ float bfhi(unsigned w) { return __builtin_bit_cast(float, w & 0xffff0000u); }
__device__ __forceinline__ float shx(float v, int k, int lane) { return __builtin_bit_cast(float, __builtin_amdgcn_ds_bpermute((lane ^ k) << 2, __builtin_bit_cast(int, v))); }
__device__ __forceinline__ float wave_sum(float v, int lane) {
#pragma unroll
    for (int o = 1; o < 64; o <<= 1) v += shx(v, o, lane);
    return v;
}

template <bool GLU>
__device__ __forceinline__ void transpose_item(const float* W, int K, int N, bf16* WT, LAS float* scr, int item, int lane) {
    const int nblk = N / 32, kb = item / nblk, nb = item % nblk, k0 = 64 * kb, n0 = 32 * nb;
    { float tv[32];
#pragma unroll
      for (int i = 0; i < 32; ++i) tv[i] = __builtin_nontemporal_load(W + (size_t)(k0 + 2 * i + (lane >> 5)) * N + n0 + (lane & 31));
      __builtin_amdgcn_sched_barrier(0);
#pragma unroll
      for (int i = 0; i < 32; ++i) scr[(2 * i + (lane >> 5)) * 33 + (lane & 31)] = tv[i]; }
    asm volatile("s_waitcnt lgkmcnt(0)" ::: "memory");
    int d0 = n0;
    if (GLU) { const int nn = n0 & 1023; d0 = ((nn >> 7) << 8) + (nn & 127) + ((n0 >> 10) << 7); }
    const int c = lane & 7;
#pragma unroll
    for (int j = 0; j < 4; ++j) { const int n = (lane >> 3) + 8 * j; const LAS float* s = scr + (8 * c) * 33 + n;
        u32x4 o; o.x = pk2(s[0 * 33], s[1 * 33]); o.y = pk2(s[2 * 33], s[3 * 33]); o.z = pk2(s[4 * 33], s[5 * 33]); o.w = pk2(s[6 * 33], s[7 * 33]);
        *(u32x4*)(WT + (size_t)(d0 + n) * K + k0 + 8 * c) = o; }
    asm volatile("s_waitcnt lgkmcnt(0)" ::: "memory");
}

struct Ptrs {
    const float *x_prompt, *x_sample, *cache_k, *cache_v, *c, *c_ctx, *norm_g, *w_ada, *b_ada, *w_qkv, *w_o, *rpb, *w_pw1, *w_dw, *b_dw, *ln_g, *ln_b, *w_pw2, *w_up, *w_down, *final_g;
};

__device__ __forceinline__ void p0_phase(const Ptrs& P, unsigned char* ws, LAS unsigned char* lds, int tid, int lane, int wave, int G, int bid) {
    bf16* Wt = (bf16*)(ws + WS_W);
    const int gw = bid * NWAVES + wave, NGW = G * NWAVES;
    LAS float* scr = (LAS float*)(lds + wave * 16384);
    constexpr int NIT = 23552;
    for (int it = gw; it < NIT; it += NGW) {
        if (it < 7168) { const int i = it / 3584; int r = it % 3584;
            if (r < 1536) { transpose_item<false>(P.w_qkv + (size_t)i * D * 3 * D, D, 3 * D, Wt + W_QKV + (size_t)i * 3 * MEL, scr, r, lane); continue; } r -= 1536;
            if (r < 512) { transpose_item<false>(P.w_o + (size_t)i * D * D, D, D, Wt + W_O + (size_t)i * MEL, scr, r, lane); continue; } r -= 512;
            if (r < 1024) { transpose_item<true>(P.w_pw1 + (size_t)i * D * 2 * D, D, 2 * D, Wt + W_PW1 + (size_t)i * 2 * MEL, scr, r, lane); continue; } r -= 1024;
            transpose_item<false>(P.w_pw2 + (size_t)i * D * D, D, D, Wt + W_PW2 + (size_t)i * MEL, scr, r, lane);
        } else { const int l = (it - 7168) / 4096; int r = (it - 7168) % 4096;
            if (r < 2048) transpose_item<false>(P.w_up + (size_t)l * D * FF, D, FF, Wt + W_UP + (size_t)l * 4 * MEL, scr, r, lane);
            else transpose_item<false>(P.w_down + (size_t)l * D * FF, FF, D, Wt + W_DOWN + (size_t)l * 4 * MEL, scr, r - 2048, lane);
        }
    }
    { bf16* CK = (bf16*)(ws + WS_CK); bf16* CV = (bf16*)(ws + WS_CV);
      const int NT = G * NTHR; constexpr int NV = 2 * 4 * 2 * 256 * 1024 / 8;
      for (int v = bid * NTHR + tid; v < NV; v += NT) { const int which = v >= NV / 2; const int e = (which ? v - NV / 2 : v) * 8;
          const float* src = (which ? P.cache_v : P.cache_k) + e; const f32x4 a = __builtin_nontemporal_load((const f32x4*)src), b = __builtin_nontemporal_load((const f32x4*)(src + 4));
          u32x4 o; o.x = pk2(a[0], a[1]); o.y = pk2(a[2], a[3]); o.z = pk2(b[0], b[1]); o.w = pk2(b[2], b[3]);
          *(u32x4*)((which ? CV : CK) + e) = o; } }
    { f32x4* z = (f32x4*)(ws + WS_SS); const int NT = G * NTHR; float zf = 0.f; asm volatile("" : "+v"(zf));
      const f32x4 zz = (f32x4){zf, zf, zf, zf}; for (int v = bid * NTHR + tid; v < 9 * M / 4; v += NT) z[v] = zz; }
    __syncthreads();
    { LAS float* sil = (LAS float*)lds; LAS float* red = (LAS float*)(lds + 20480); float* mod = (float*)(ws + WS_MOD);
      for (int k = tid; k < 5 * 1024; k += NTHR) { const int cc = k >> 10, kk = k & 1023; const float v = cc == 0 ? P.c_ctx[kk] : P.c[(cc - 1) * 1024 + kk]; sil[k] = v / (1.f + __expf(-v)); }
      __syncthreads();
      const int kg = tid >> 4, cl = tid & 15; const bool cact = cl < 12;
      for (int item = bid; item < 512; item += G) { const int l = item >> 7, n0 = (item & 127) * 48;
          const float* W = P.w_ada + (size_t)l * D * 6144 + n0 + 4 * cl;
          f32x4 a[5];
#pragma unroll
          for (int cc = 0; cc < 5; ++cc) a[cc] = (f32x4){0.f, 0.f, 0.f, 0.f};
#pragma unroll 4
          for (int kk = 0; kk < 32; ++kk) { const int k = kg * 32 + kk; f32x4 w = (f32x4){0.f, 0.f, 0.f, 0.f}; if (cact) w = __builtin_nontemporal_load((const f32x4*)(W + (size_t)k * 6144));
#pragma unroll
              for (int cc = 0; cc < 5; ++cc) a[cc] += sil[cc * 1024 + k] * w; }
#pragma unroll
          for (int cc = 0; cc < 5; ++cc) *(LAS f32x4*)(red + (kg * 5 + cc) * 64 + 4 * cl) = a[cc];
          __syncthreads();
          if (tid < 320 && (tid & 63) < 48) { const int cc = tid >> 6, n = tid & 63; float s = 0.f;
#pragma unroll 8
              for (int g = 0; g < 32; ++g) s += red[(g * 5 + cc) * 64 + n];
              mod[(size_t)(l * 5 + cc) * 6144 + n0 + n] = s + P.b_ada[l * 6144 + n0 + n]; }
          __syncthreads();
      } }
}

__device__ __forceinline__ void norm_phase(const float* xp, const float* xs, bf16* H, float* yout, const float* g, const float* shift, const float* scale, int gw, int NGW, int lane) {
    f32x4 gv[4];
#pragma unroll
    for (int j = 0; j < 4; ++j) gv[j] = *(const f32x4*)(g + 4 * (lane + 64 * j));
    for (int m = gw; m < M; m += NGW) {
        const float* xrow = m < MP ? xp + (size_t)m * D : xs + (size_t)(m - MP) * D;
        const int cond = m < MP ? 0 : 1 + ((m - MP) >> 10);
        f32x4 v[4]; float ss = 0.f;
#pragma unroll
        for (int j = 0; j < 4; ++j) { v[j] = *(const f32x4*)(xrow + 4 * (lane + 64 * j)); ss += (v[j][0] * v[j][0] + v[j][1] * v[j][1]) + (v[j][2] * v[j][2] + v[j][3] * v[j][3]); }
        const float r = 1.0f / sqrtf(wave_sum(ss, lane) * (1.f / D) + 1e-6f);
        if (yout) {
#pragma unroll
            for (int j = 0; j < 4; ++j) *(f32x4*)(yout + (size_t)m * D + 4 * (lane + 64 * j)) = v[j] * r * gv[j];
        } else {
#pragma unroll
            for (int j = 0; j < 4; ++j) { const f32x4 sc = *(const f32x4*)(scale + cond * 6144 + 4 * (lane + 64 * j)), sh = *(const f32x4*)(shift + cond * 6144 + 4 * (lane + 64 * j));
                const f32x4 h = (v[j] * r * gv[j]) * (1.f + sc) + sh; u32x2 o; o.x = pk2(h[0], h[1]); o.y = pk2(h[2], h[3]);
                *(u32x2*)(H + (size_t)m * D + 4 * (lane + 64 * j)) = o; }
        }
    }
}

template <class F, int... I> __device__ __forceinline__ void sfor_impl(F&& f, std::integer_sequence<int, I...>) { (f(std::integral_constant<int, I>{}), ...); }
template <int N, class F> __device__ __forceinline__ void sfor(F&& f) { sfor_impl(f, std::make_integer_sequence<int, N>{}); }
__device__ __forceinline__ float dpp_add(float v, int ctrl_b1, int ctrl_4e, int dummy) { return v; }
__device__ __forceinline__ float wave_sum_dpp(float v) {
    v += __builtin_bit_cast(float, __builtin_amdgcn_update_dpp(0, __builtin_bit_cast(int, v), 0xB1, 0xf, 0xf, false));
    v += __builtin_bit_cast(float, __builtin_amdgcn_update_dpp(0, __builtin_bit_cast(int, v), 0x4E, 0xf, 0xf, false));
    v += __builtin_bit_cast(float, __builtin_amdgcn_update_dpp(0, __builtin_bit_cast(int, v), 0x141, 0xf, 0xf, false));
    v += __builtin_bit_cast(float, __builtin_amdgcn_update_dpp(0, __builtin_bit_cast(int, v), 0x140, 0xf, 0xf, false));
    const int vi = __builtin_bit_cast(int, v);
    return (__builtin_bit_cast(float, __builtin_amdgcn_readlane(vi, 0)) + __builtin_bit_cast(float, __builtin_amdgcn_readlane(vi, 16))) +
           (__builtin_bit_cast(float, __builtin_amdgcn_readlane(vi, 32)) + __builtin_bit_cast(float, __builtin_amdgcn_readlane(vi, 48)));
}
constexpr int CT = 16, CROWS = CT + 30, CCS = 16, CCH = (CROWS + CCS - 1) / CCS;
__device__ __forceinline__ void conv_phase(const bf16* U, bf16* Vc, const float* wdw, const float* bdw, const float* lng, const float* lnb, LAS unsigned char* lds, int tid, int lane, int wave, int G, int bid) {
    f32x2 w[31];
    sfor<31>([&](auto K) __attribute__((always_inline)) { constexpr int k = decltype(K)::value; w[k] = *(const f32x2*)(wdw + k * D + 2 * tid); });
    const f32x2 bd = *(const f32x2*)(bdw + 2 * tid), lg = *(const f32x2*)(lng + 2 * tid), lb = *(const f32x2*)(lnb + 2 * tid);
    LAS f32x2* part = (LAS f32x2*)lds;
    LAS f32x2* stats = part + 8 * CT;
    for (int unit = bid; unit < M / CT; unit += G) {
        const int m0 = unit * CT, seg = m0 < MP ? 0 : MP, L = m0 < MP ? 256 : 1024, t0 = (m0 - seg) & (L - 1);
        const bf16* Ub = U + (size_t)(m0 - t0) * D + 2 * tid;
        f32x2 acc[CT];
        sfor<CT>([&](auto O) __attribute__((always_inline)) { acc[decltype(O)::value] = bd; });
        sfor<CCH>([&](auto C) __attribute__((always_inline)) { constexpr int c = decltype(C)::value;
            unsigned raw[CCS];
            sfor<CCS>([&](auto I) __attribute__((always_inline)) { constexpr int i = decltype(I)::value, j = c * CCS + i;
                if constexpr (j < CROWS) { const int t = t0 - 15 + j, tc = min(max(t, 0), L - 1);
                    raw[i] = *(const unsigned*)(Ub + (size_t)tc * D); } });
            SB0();
            sfor<CCS>([&](auto I) __attribute__((always_inline)) { constexpr int i = decltype(I)::value, j = c * CCS + i;
                if constexpr (j < CROWS) { const int t = t0 - 15 + j; const unsigned rm = raw[i] & (unsigned)(-(int)((t >= 0) & (t < L))); const f32x2 u = (f32x2){bflo(rm), bfhi(rm)};
                    sfor<31>([&](auto K) __attribute__((always_inline)) { constexpr int k = decltype(K)::value, o = j - k;
                        if constexpr (o >= 0 && o < CT) acc[o] += u * w[k]; }); } });
        });
        sfor<CT>([&](auto O) __attribute__((always_inline)) { constexpr int o = decltype(O)::value;
            const float s = wave_sum_dpp(acc[o].x + acc[o].y), q = wave_sum_dpp(acc[o].x * acc[o].x + acc[o].y * acc[o].y); if (lane == 0) part[wave * CT + o] = (f32x2){s, q}; });
        __syncthreads();
        if (tid < CT) { float s = 0.f, q = 0.f;
#pragma unroll
            for (int wv = 0; wv < 8; ++wv) { const f32x2 p = part[wv * CT + tid]; s += p.x; q += p.y; }
            const float mean = s * (1.f / D), var = fmaxf(q * (1.f / D) - mean * mean, 0.f); stats[tid] = (f32x2){mean, 1.0f / sqrtf(var + 1e-5f)}; }
        __syncthreads();
        sfor<CT>([&](auto O) __attribute__((always_inline)) { constexpr int o = decltype(O)::value;
            const f32x2 st = stats[o]; f32x2 y = (acc[o] - st.x) * st.y * lg + lb;
            y.x = y.x * __builtin_amdgcn_rcpf(1.f + __expf(-y.x)); y.y = y.y * __builtin_amdgcn_rcpf(1.f + __expf(-y.y));
            *(unsigned*)(Vc + (size_t)(m0 + o) * D + 2 * tid) = pk2(y.x, y.y); });
        __syncthreads();
    }
}

__device__ __forceinline__ void final_norm_phase(const bf16* X, float* yout, const float* g, int gw, int NGW, int lane) {
    f32x4 gv[4];
#pragma unroll
    for (int j = 0; j < 4; ++j) gv[j] = *(const f32x4*)(g + 16 * lane + 4 * j);
    for (int m = gw; m < M; m += NGW) {
        const bf16* xr = X + (size_t)m * D + 16 * lane;
        const u32x4 w0 = *(const u32x4*)xr, w1 = *(const u32x4*)(xr + 8);
        f32x4 v[4]; v[0] = (f32x4){bflo(w0[0]), bfhi(w0[0]), bflo(w0[1]), bfhi(w0[1])}; v[1] = (f32x4){bflo(w0[2]), bfhi(w0[2]), bflo(w0[3]), bfhi(w0[3])};
        v[2] = (f32x4){bflo(w1[0]), bfhi(w1[0]), bflo(w1[1]), bfhi(w1[1])}; v[3] = (f32x4){bflo(w1[2]), bfhi(w1[2]), bflo(w1[3]), bfhi(w1[3])};
        float sq = 0.f;
#pragma unroll
        for (int j = 0; j < 4; ++j) sq += (v[j][0] * v[j][0] + v[j][1] * v[j][1]) + (v[j][2] * v[j][2] + v[j][3] * v[j][3]);
        const float r = 1.0f / sqrtf(wave_sum_dpp(sq) * (1.f / D) + 1e-6f);
#pragma unroll
        for (int j = 0; j < 4; ++j) __builtin_nontemporal_store(v[j] * r * gv[j], (f32x4*)(yout + (size_t)m * D + 16 * lane + 4 * j));
    }
}

__device__ __forceinline__ void prep_phase(const float* xp, const float* xs, bf16* H, float* ss0, const float* g, const float* scale, const float* mod, const bf16* Wt, float* shw, int gw, int NGW, int lane) {
    { f32x4 gv[4];
#pragma unroll
      for (int j = 0; j < 4; ++j) gv[j] = *(const f32x4*)(g + 4 * (lane + 64 * j));
      for (int m = gw; m < M; m += NGW) {
          const float* xrow = m < MP ? xp + (size_t)m * D : xs + (size_t)(m - MP) * D;
          const int cond = m < MP ? 0 : 1 + ((m - MP) >> 10);
          f32x4 v[4]; float sq = 0.f;
#pragma unroll
          for (int j = 0; j < 4; ++j) { v[j] = *(const f32x4*)(xrow + 4 * (lane + 64 * j)); sq += (v[j][0] * v[j][0] + v[j][1] * v[j][1]) + (v[j][2] * v[j][2] + v[j][3] * v[j][3]); }
          sq = wave_sum_dpp(sq); if (lane == 0) ss0[m] = sq;
          f32x4 sc[4];
#pragma unroll
          for (int j = 0; j < 4; ++j) sc[j] = *(const f32x4*)(scale + cond * 6144 + 4 * (lane + 64 * j));
#pragma unroll
          for (int j = 0; j < 4; ++j) { const f32x4 h = v[j] * gv[j] * (1.f + sc[j]); u32x2 o; o.x = pk2(h[0], h[1]); o.y = pk2(h[2], h[3]);
              *(u32x2*)(H + (size_t)m * D + 4 * (lane + 64 * j)) = o; }
      } }
    for (int it = gw; it < 4 * 8192; it += NGW) {
        const int l = it >> 13, which = (it >> 12) & 1, n = it & 4095, i = l >> 1; const bool conv = (l & 1) != 0;
        const int N = which ? 4096 : (conv ? 2048 : 3072);
        if (n >= N) continue;
        const bf16* wrow = Wt + (which ? W_UP + (size_t)l * 4 * MEL : (conv ? W_PW1 + (size_t)i * 2 * MEL : W_QKV + (size_t)i * 3 * MEL)) + (size_t)n * D + 16 * lane;
        const u32x4 w0 = *(const u32x4*)wrow, w1 = *(const u32x4*)(wrow + 8);
        float wv[16];
#pragma unroll
        for (int e = 0; e < 4; ++e) { wv[2 * e] = bflo(w0[e]); wv[2 * e + 1] = bfhi(w0[e]); wv[8 + 2 * e] = bflo(w1[e]); wv[8 + 2 * e + 1] = bfhi(w1[e]); }
#pragma unroll
        for (int cond = 0; cond < 5; ++cond) { const float* sh = mod + (size_t)(l * 5 + cond) * 6144 + (which ? 3 : 0) * 1024 + 16 * lane; float dot = 0.f;
#pragma unroll
            for (int q = 0; q < 4; ++q) { const f32x4 s4 = *(const f32x4*)(sh + 4 * q); dot += (s4[0] * wv[4 * q] + s4[1] * wv[4 * q + 1]) + (s4[2] * wv[4 * q + 2] + s4[3] * wv[4 * q + 3]); }
            dot = wave_sum_dpp(dot); if (lane == 0) shw[(size_t)((l * 2 + which) * 5 + cond) * 4096 + n] = dot; }
    }
}

constexpr float SCL = 0.125f * 1.4426950408889634f, LOG2E = 1.4426950408889634f;
__device__ __forceinline__ void vt_write(LAS bf16* Vt, int pitch, int slot, int chunk, u32x4 v) {
    LAS bf16* p = Vt + (8 * chunk) * pitch + slot;
    p[0] = (bf16)(v.x & 0xffffu); p[pitch] = (bf16)(v.x >> 16); p[2 * pitch] = (bf16)(v.y & 0xffffu); p[3 * pitch] = (bf16)(v.y >> 16);
    p[4 * pitch] = (bf16)(v.z & 0xffffu); p[5 * pitch] = (bf16)(v.z >> 16); p[6 * pitch] = (bf16)(v.w & 0xffffu); p[7 * pitch] = (bf16)(v.w >> 16);
}
template <int NB> __device__ __forceinline__ void softmax_part(f32x4 (&s)[NB], float& mx_out, float& sum_out, int lane, float m_floor = -INFINITY) {
    float mx = m_floor;
#pragma unroll
    for (int b = 0; b < NB; ++b) mx = fmaxf(mx, fmaxf(fmaxf(s[b][0], s[b][1]), fmaxf(s[b][2], s[b][3])));
    mx = fmaxf(mx, shx(mx, 16, lane)); mx = fmaxf(mx, shx(mx, 32, lane));
    float sum = 0.f;
#pragma unroll
    for (int b = 0; b < NB; ++b) {
#pragma unroll
        for (int e = 0; e < 4; ++e) { s[b][e] = __builtin_amdgcn_exp2f(s[b][e] - mx); sum += s[b][e]; } }
    sum += shx(sum, 16, lane); sum += shx(sum, 32, lane);
    mx_out = mx; sum_out = sum;
}
__device__ __forceinline__ bf16x8 pack_p(const f32x4& a, const f32x4& b) {
    u32x4 w; w.x = pk2(a[0], a[1]); w.y = pk2(a[2], a[3]); w.z = pk2(b[0], b[1]); w.w = pk2(b[2], b[3]); return __builtin_bit_cast(bf16x8, w);
}
__device__ __forceinline__ bf16x8 vt_read(const LAS bf16* p0, const LAS bf16* p1) {
    const s16x4 a = *(const LAS s16x4*)p0, b = *(const LAS s16x4*)p1; return (bf16x8){a[0], a[1], a[2], a[3], b[0], b[1], b[2], b[3]};
}
__device__ __forceinline__ f32x4 qk_block(const bf16* kp, const bf16x8& qf0, const bf16x8& qf1) {
    const bf16x8 k0 = *(const bf16x8*)kp, k1 = *(const bf16x8*)(kp + 32);
    f32x4 a = __builtin_amdgcn_mfma_f32_16x16x32_bf16(k0, qf0, (f32x4){0.f, 0.f, 0.f, 0.f}, 0, 0, 0);
    return __builtin_amdgcn_mfma_f32_16x16x32_bf16(k1, qf1, a, 0, 0, 0);
}
#define PV16(o, s, SLOT_EXPR, PITCH_) do { _Pragma("unroll") for (int pp = 0; pp < 8; ++pp) { const bf16x8 pf = pack_p(s[2 * pp], s[2 * pp + 1]); const int slot0 = (SLOT_EXPR); \
        _Pragma("unroll") for (int db = 0; db < 4; ++db) { const LAS bf16* vp = Vt + (16 * db + l15) * (PITCH_) + slot0; \
            o[db] = __builtin_amdgcn_mfma_f32_16x16x32_bf16(vt_read(vp, vp + 16), pf, o[db], 0, 0, 0); } } } while (0)

#ifndef CBN
#define CBN 4
#endif
__device__ __forceinline__ void attn_phase(const bf16* Qb, const bf16* Kb, const bf16* Vb, bf16* Ob, const bf16* CK, const bf16* CV, const float* rpb  ,
                                           int li, LAS unsigned char* lds, int tid, int lane, int wave, int G, int bid, int ulo, int uhi) {
    LAS bf16* Vt = (LAS bf16*)lds; LAS float* rpl = (LAS float*)(lds + 110592); LAS unsigned char* Kc = lds + LDS_KC;
    for (int u = bid + ulo; u < uhi; u += G) {
        int lz_ = lane; asm volatile("" : "+v"(lz_));
        const int l15 = lz_ & 15, g = lz_ >> 4;
        if (u < 512) {
            const int b = u >> 4, h = u & 15; constexpr int PITCH = 264;
            const int qrow0 = b * 256 + 32 * wave + l15;
            const bf16x8 qa0 = *(const bf16x8*)(Qb + (size_t)qrow0 * D + h * 64 + 8 * g), qa1 = *(const bf16x8*)(Qb + (size_t)qrow0 * D + h * 64 + 32 + 8 * g);
            const bf16x8 qb0 = *(const bf16x8*)(Qb + (size_t)(qrow0 + 16) * D + h * 64 + 8 * g), qb1 = *(const bf16x8*)(Qb + (size_t)(qrow0 + 16) * D + h * 64 + 32 + 8 * g);
            SB0();
            { int t2 = tid; asm volatile("" : "+v"(t2));
              const int key = t2 & 255, c0 = (t2 >> 8) * 4; const bf16* src = Vb + (size_t)(b * 256 + key) * D + h * 64 + 8 * c0; const bf16* ksrc = Kb + (size_t)(b * 256 + key) * D + h * 64 + 8 * c0;
              u32x4 v[4], kv[4];
#pragma unroll
              for (int c = 0; c < 4; ++c) { v[c] = *(const u32x4*)(src + 8 * c); kv[c] = *(const u32x4*)(ksrc + 8 * c); }
              SB0();
#pragma unroll
              for (int c = 0; c < 4; ++c) *(LAS u32x4*)(Kc + key * 144 + (c0 + c) * 16) = kv[c];
#pragma unroll
              for (int c = 0; c < 4; ++c) vt_write(Vt, PITCH, key, c0 + c, v[c]); }
            __syncthreads();
            SB0();
            f32x4 s0[16], s1[16];
            { const LAS unsigned char* kl = Kc + l15 * 144 + g * 16;
              sfor<16>([&](auto I) __attribute__((always_inline)) { constexpr int kb = decltype(I)::value;
                const bf16x8 k0 = *(const LAS bf16x8*)(kl + kb * (16 * 144)), k1 = *(const LAS bf16x8*)(kl + kb * (16 * 144) + 64);
                f32x4 a = __builtin_amdgcn_mfma_f32_16x16x32_bf16(k0, qa0, (f32x4){0.f, 0.f, 0.f, 0.f}, 0, 0, 0); s0[kb] = __builtin_amdgcn_mfma_f32_16x16x32_bf16(k1, qa1, a, 0, 0, 0) * SCL;
                f32x4 c = __builtin_amdgcn_mfma_f32_16x16x32_bf16(k0, qb0, (f32x4){0.f, 0.f, 0.f, 0.f}, 0, 0, 0); s1[kb] = __builtin_amdgcn_mfma_f32_16x16x32_bf16(k1, qb1, c, 0, 0, 0) * SCL; }); }
            { float mx, sum; softmax_part<16>(s0, mx, sum, lane);
              f32x4 o[4];
#pragma unroll
              for (int db = 0; db < 4; ++db) o[db] = (f32x4){0.f, 0.f, 0.f, 0.f};
              PV16(o, s0, 32 * pp + 4 * g, PITCH);
              const float rl = 1.0f / sum;
#pragma unroll
              for (int db = 0; db < 4; ++db) { const f32x4 ov = o[db] * rl; u32x2 w; w.x = pk2(ov[0], ov[1]); w.y = pk2(ov[2], ov[3]);
                  *(u32x2*)(Ob + (size_t)qrow0 * D + h * 64 + 16 * db + 4 * g) = w; } }
            { float mx, sum; softmax_part<16>(s1, mx, sum, lane);
              f32x4 o[4];
#pragma unroll
              for (int db = 0; db < 4; ++db) o[db] = (f32x4){0.f, 0.f, 0.f, 0.f};
              PV16(o, s1, 32 * pp + 4 * g, PITCH);
              const float rl = 1.0f / sum;
#pragma unroll
              for (int db = 0; db < 4; ++db) { const f32x4 ov = o[db] * rl; u32x2 w; w.x = pk2(ov[0], ov[1]); w.y = pk2(ov[2], ov[3]);
                  *(u32x2*)(Ob + (size_t)(qrow0 + 16) * D + h * 64 + 16 * db + 4 * g) = w; } }
            __syncthreads();
        } else {
            const int ui = u - 512, xcd = ui & 7, idx = (ui >> 3) & 63, uu = (G == 256) ? ((xcd * 8 + (idx >> 3)) << 3) + (idx & 7) : ui;
            const int b = uu >> 7, h = (uu >> 3) & 15, rp = uu & 7, r0 = 2 * rp; constexpr int PITCH = 840;
            const int rs0 = min(max(r0 - 4, 0), 8);
            const size_t tokb = (size_t)MP + (size_t)b * 1024;
            const int r = r0 + (wave >> 2), j = wave & 3, rs = min(max(r - 4, 0), 8), rrel = rs - rs0, kcs = min(max(16 * j - 8, 0), 32);
            const int qcol = 16 * j + l15, wst = min(max(qcol - 8, 0), 48);
            const size_t qtok = tokb + r * 64 + qcol;
            const bf16* kloc = Kb + (tokb + rs * 64 + kcs + l15) * D + h * 64 + 8 * g;
            bf16x8 kf[16][2];
#define LOAD_KLOC(H) sfor<8>([&](auto I) __attribute__((always_inline)) { constexpr int lb = 8 * (H) + decltype(I)::value; const bf16* kp = kloc + (size_t)((lb >> 1) * 64 + 16 * (lb & 1)) * D; kf[lb][0] = *(const bf16x8*)kp; kf[lb][1] = *(const bf16x8*)(kp + 32); })
            LOAD_KLOC(0);
            const bf16x8 qf0 = *(const bf16x8*)(Qb + qtok * D + h * 64 + 8 * g), qf1 = *(const bf16x8*)(Qb + qtok * D + h * 64 + 32 + 8 * g);
            SB0();
            { int t2 = tid; asm volatile("" : "+v"(t2));
              const int slotA = t2, slotB = t2 + NTHR, slotBc = min(slotB, 831);
              const bf16* srcA = (slotA < 576) ? Vb + (tokb + min(rs0 + (slotA >> 6), 15) * 64 + (slotA & 63)) * D + h * 64 : CV + ((size_t)(b * 2 + li) * 256 + (slotA - 576)) * D + h * 64;
              const bf16* srcB = (slotBc < 576) ? Vb + (tokb + min(rs0 + (slotBc >> 6), 15) * 64 + (slotBc & 63)) * D + h * 64 : CV + ((size_t)(b * 2 + li) * 256 + (slotBc - 576)) * D + h * 64;
              const int key = t2 & 255, c0 = (t2 >> 8) * 4; const bf16* ksrc = CK + ((size_t)(b * 2 + li) * 256 + key) * D + h * 64 + 8 * c0;
              u32x4 va[8], vb[8], kv[4];
#pragma unroll
              for (int c = 0; c < 8; ++c) { va[c] = *(const u32x4*)(srcA + 8 * c); vb[c] = *(const u32x4*)(srcB + 8 * c); }
#pragma unroll
              for (int c = 0; c < 4; ++c) kv[c] = *(const u32x4*)(ksrc + 8 * c);
              const float rv = rpb[h * 465 + min(t2, 464)];
              SB0();
#pragma unroll
              for (int c = 0; c < 8; ++c) vt_write(Vt, PITCH, slotA, c, va[c]);
              if (slotB < 832) {
#pragma unroll
                  for (int c = 0; c < 8; ++c) vt_write(Vt, PITCH, slotB, c, vb[c]); }
#pragma unroll
              for (int c = 0; c < 4; ++c) *(LAS u32x4*)(Kc + key * 144 + (c0 + c) * 16) = kv[c];
              if (t2 < 465) rpl[t2] = rv; }
            SB0(); LOAD_KLOC(1); SB0();
            __syncthreads();
            SB0();
            f32x4 o1[4]; float m1, l1, m2, l2;
#pragma unroll
            for (int db = 0; db < 4; ++db) o1[db] = (f32x4){0.f, 0.f, 0.f, 0.f};
            {
                int dcv[8]; unsigned vmask = 0u;
#pragma unroll
                for (int ce = 0; ce < 8; ++ce) { const int kc = kcs + 16 * (ce >> 2) + 4 * g + (ce & 3); vmask |= ((kc >= wst) && (kc < wst + 16)) ? (1u << ce) : 0u; dcv[ce] = min(max(kc - qcol + 15, 0), 30); }
                f32x4 s[16];
#define QK_LOC(H) sfor<8>([&](auto I) __attribute__((always_inline)) { constexpr int lb = 8 * (H) + decltype(I)::value, krow = lb >> 1, ch = lb & 1; \
                    f32x4 a = __builtin_amdgcn_mfma_f32_16x16x32_bf16(kf[lb][0], qf0, (f32x4){0.f, 0.f, 0.f, 0.f}, 0, 0, 0); a = __builtin_amdgcn_mfma_f32_16x16x32_bf16(kf[lb][1], qf1, a, 0, 0, 0); \
                    const LAS float* rp_row = rpl + (rs + krow - r + 7) * 31; float bias[4]; \
                    _Pragma("unroll") for (int e = 0; e < 4; ++e) bias[e] = rp_row[dcv[ch * 4 + e]]; \
                    _Pragma("unroll") for (int e = 0; e < 4; ++e) { const float t = a[e] * SCL + bias[e] * LOG2E; a[e] = ((vmask >> (ch * 4 + e)) & 1u) ? t : -INFINITY; } \
                    s[lb] = a; })
                QK_LOC(0); QK_LOC(1); SB0();
                softmax_part<16>(s, m1, l1, lane);
                PV16(o1, s, (rrel + pp) * 64 + kcs + 4 * g, PITCH);
            }
            SB0();
            {
                f32x4 s[16];
                { const LAS unsigned char* kl = Kc + l15 * 144 + g * 16;
                  sfor<16>([&](auto I) __attribute__((always_inline)) { constexpr int cb = decltype(I)::value;
                    const bf16x8 k0 = *(const LAS bf16x8*)(kl + cb * (16 * 144)), k1 = *(const LAS bf16x8*)(kl + cb * (16 * 144) + 64);
                    f32x4 a = __builtin_amdgcn_mfma_f32_16x16x32_bf16(k0, qf0, (f32x4){0.f, 0.f, 0.f, 0.f}, 0, 0, 0); s[cb] = __builtin_amdgcn_mfma_f32_16x16x32_bf16(k1, qf1, a, 0, 0, 0) * SCL; }); }
                softmax_part<16>(s, m2, l2, lane, m1);
                const float a1 = __builtin_amdgcn_exp2f(m1 - m2);
#pragma unroll
                for (int db = 0; db < 4; ++db) o1[db] = o1[db] * a1;
                l1 = l1 * a1 + l2;
                PV16(o1, s, 576 + 32 * pp + 4 * g, PITCH);
            }
            const float rl = 1.0f / l1;
            int r2_ = r; asm volatile("" : "+s"(r2_));
            const size_t qtok2 = tokb + r2_ * 64 + qcol;
#pragma unroll
            for (int db = 0; db < 4; ++db) { const f32x4 ov = o1[db] * rl; u32x2 w; w.x = pk2(ov[0], ov[1]); w.y = pk2(ov[2], ov[3]);
                *(u32x2*)(Ob + qtok2 * D + h * 64 + 16 * db + 4 * g) = w; }
            __syncthreads();
        }
    }
}

#define RLX_AGENT __ATOMIC_RELAXED, __HIP_MEMORY_SCOPE_AGENT
#define XB_TMO      128
#define XB_XCNT(j)  (256  + 64 * (j))
#define XB_XSUB(j)  (1280 + 64 * (j))
#define XB_XGEN(j)  (2304 + 64 * (j))
#define XB_TOP      3328
#define XB_TOPGEN   3392
#define XCD_BAR_WORDS 3456
#define XB_SPIN_CAP (1u << 18)

__device__ __forceinline__ unsigned xb_ld(unsigned* p)              { return __hip_atomic_load(p, __ATOMIC_RELAXED, __HIP_MEMORY_SCOPE_AGENT); }
__device__ __forceinline__ unsigned xb_add(unsigned* p, unsigned v) { return __hip_atomic_fetch_add(p, v, __ATOMIC_RELAXED, __HIP_MEMORY_SCOPE_AGENT); }
__device__ __forceinline__ unsigned xb_xcc_id() { return (unsigned)__builtin_amdgcn_s_getreg((3 << 11) | 20) & 0xFu; }
#define XB_SPIN(cond, bar) do { unsigned _sp = 0; while (cond) { __builtin_amdgcn_s_sleep(1); \
    if ((++_sp & 255u) == 0u) { if (xb_ld(&(bar)[XB_TMO])) break; if (_sp > XB_SPIN_CAP) { atomicAdd(&(bar)[XB_TMO], 1u); break; } } } } while (0)

struct XcdBarrier {
    unsigned* bar; unsigned x;
    volatile LAS unsigned* st;
};

__device__ __forceinline__ XcdBarrier xcd_barrier_post(unsigned* bar, volatile LAS unsigned* st) {
    XcdBarrier b; b.bar = bar; b.x = xb_xcc_id(); b.st = st;
    if (threadIdx.x == 0) (void)xb_add(&bar[XB_XCNT(b.x)], 1u);
    return b;
}
__device__ __forceinline__ void xcd_barrier_complete(unsigned* bar, unsigned x, unsigned& nloc, unsigned& nx) {
    const unsigned G = gridDim.x * gridDim.y * gridDim.z;
    unsigned sum, cnt, mine, sp = 0u;
    for (;;) {
        sum = 0u; cnt = 0u; mine = 0u;
#pragma unroll
        for (unsigned j = 0; j < 16; ++j) { const unsigned c = xb_ld(&bar[XB_XCNT(j)]); sum += c; cnt += (c > 0u) ? 1u : 0u; mine = (j == x) ? c : mine; }
        if (sum == G) break;
        __builtin_amdgcn_s_sleep(1);
        if ((++sp & 255u) == 0u) { if (xb_ld(&bar[XB_TMO])) break; if (sp > XB_SPIN_CAP) { atomicAdd(&bar[XB_TMO], 1u); break; } }
    }
    nloc = mine > 0u ? mine : 1u; nx = cnt > 0u ? cnt : 1u;
}

__device__ __forceinline__ void xcd_barrier(const XcdBarrier& b) {
    asm volatile("s_waitcnt vmcnt(0)" ::: "memory");
    __syncthreads();
    if (threadIdx.x == 0) {
        unsigned* bar = b.bar;
        __builtin_amdgcn_s_waitcnt(0);
        unsigned nloc = b.st[0], nx = b.st[1];
        if (nloc == 0u) { xcd_barrier_complete(bar, b.x, nloc, nx); b.st[0] = nloc; b.st[1] = nx; }
        const unsigned old = xb_add(&bar[XB_XSUB(b.x)], 1u);
        const unsigned gen = old / nloc;
        if (old + 1u == (gen + 1u) * nloc) {
            __builtin_amdgcn_fence(__ATOMIC_RELEASE, "agent");
            asm volatile("s_waitcnt vmcnt(0)" ::: "memory");
            const unsigned og = xb_add(&bar[XB_TOP], 1u);
            if (og + 1u == (gen + 1u) * nx) xb_add(&bar[XB_TOPGEN], 1u);
            else XB_SPIN(xb_ld(&bar[XB_TOPGEN]) == gen, bar);
            __builtin_amdgcn_fence(__ATOMIC_ACQUIRE, "agent");
            asm volatile("s_waitcnt vmcnt(0)" ::: "memory");
        } else {
            XB_SPIN(xb_ld(&bar[XB_TOPGEN]) == gen, bar);
            __builtin_amdgcn_fence(__ATOMIC_ACQUIRE, "agent");
            asm volatile("s_waitcnt vmcnt(0)" ::: "memory");
        }
    }
    __syncthreads();
}

constexpr int NPH = 2 + 5 * NL + 1;
struct Args { const float* in[21]; float* out; unsigned char* ws; int nprog, pad; int prog[48]; };
typedef const __attribute__((address_space(4))) Args* KArgPtr;
__global__ void __launch_bounds__(NTHR, 2) fwd_kernel(Args a_unused) {
    extern __shared__ __attribute__((aligned(16))) unsigned char lds_raw[];
    LAS unsigned char* lds = (LAS unsigned char*)lds_raw;
    cg::grid_group grid = cg::this_grid();
    const int wave0 = __builtin_amdgcn_readfirstlane((int)threadIdx.x >> 6);
    { volatile LAS unsigned* st0 = (volatile LAS unsigned*)(lds + LDS_ST); if (threadIdx.x < 2) st0[threadIdx.x] = 0u; }
    __syncthreads();
    XcdBarrier xbar; { KArgPtr kpb = (KArgPtr)__builtin_amdgcn_kernarg_segment_ptr(); xbar.bar = (unsigned*)kpb->ws; xbar.x = 0; xbar.st = (volatile LAS unsigned*)(lds + LDS_ST);
        if (blockIdx.x == 0) { for (int wI = threadIdx.x; wI < XCD_BAR_WORDS; wI += NTHR) __hip_atomic_store(xbar.bar + wI, 0u, __ATOMIC_RELAXED, __HIP_MEMORY_SCOPE_AGENT); } }
    int nprog; { KArgPtr kp0 = (KArgPtr)__builtin_amdgcn_kernarg_segment_ptr(); nprog = kp0->nprog; }
    for (int pc = 0; pc < nprog; ++pc) {
        KArgPtr kp = (KArgPtr)__builtin_amdgcn_kernarg_segment_ptr(); asm volatile("" : "+s"(kp));
        int z_ = 0; asm volatile("" : "+s"(z_));
        const int lane_ = (int)__builtin_amdgcn_mbcnt_hi(~0u, __builtin_amdgcn_mbcnt_lo(~0u, (unsigned)z_)); const int tid_ = wave0 * 64 + lane_;
        int bid_ = (int)__builtin_amdgcn_workgroup_id_x(), G_ = (int)gridDim.x; asm volatile("" : "+s"(bid_), "+s"(G_));
        const int pe_ = kp->prog[pc]; const int ph = pe_ & 63, amode = pe_ >> 6;
        const int tid = tid_, lane = lane_, wave = wave0, G = G_, bid = bid_;
        const int gw = bid * NWAVES + wave, NGW = G * NWAVES;
        Ptrs P; P = Ptrs{kp->in[0], kp->in[1], kp->in[2], kp->in[3], kp->in[4], kp->in[5], kp->in[6], kp->in[7], kp->in[8], kp->in[9], kp->in[10], kp->in[11], kp->in[12], kp->in[13], kp->in[14], kp->in[15], kp->in[16], kp->in[17], kp->in[18], kp->in[19], kp->in[20]};
        unsigned char* ws = kp->ws; float* outp = kp->out;
        float* mod = (float*)(ws + WS_MOD); bf16* Wt = (bf16*)(ws + WS_W); bf16* X = (bf16*)(ws + WS_X); bf16* H = (bf16*)(ws + WS_H);
        bf16* R = (bf16*)(ws + WS_R); bf16* Qb = R; bf16* Kb = R + (size_t)M * D; bf16* Vb = R + (size_t)2 * M * D; bf16* Ob = R + (size_t)3 * M * D;
        bf16* Ub = R; bf16* Vc = R + (size_t)M * D; bf16* Fb = R;
        const bf16* CK = (const bf16*)(ws + WS_CK); const bf16* CV = (const bf16*)(ws + WS_CV);
        float* out_y = outp; float* out_ck = outp + (size_t)M * D; float* out_cv = out_ck + (size_t)32 * 2 * 256 * 1024;
        float* SS = (float*)(ws + WS_SS); float* SHW = (float*)(ws + WS_SHW);
        if (ph == 0) { p0_phase(P, ws, lds, tid, lane, wave, G, bid); }
        else if (ph == 1) { prep_phase(P.x_prompt, P.x_sample, H, SS, P.norm_g, mod + 1 * 1024, mod, Wt, SHW, gw, NGW, lane); }
        else if (ph == NPH - 1) { final_norm_phase(X, out_y, P.final_g, gw, NGW, lane); }
        else if (ph >= 60) { }
        else {
            const int l = (ph - 2) / 5, s = (ph - 2) % 5, i = l >> 1; const bool conv = (l & 1) != 0;
            const float* modl = mod + (size_t)l * 5 * 6144;
            if (s == 0) {
                const float* ssl = SS + (size_t)(2 * l) * M; const float* shl = SHW + (size_t)((2 * l) * 5) * 4096;
                if (!conv) { pg8::Gemm gm{H, Wt + W_QKV + (size_t)i * 3 * MEL, M, 3 * D, D}; pg8::StaticOrder S; S.init(M, 3 * D, G, bid);
                    pg8::EpiQKV E{ssl, shl, Qb, (size_t)M * D, out_ck + (size_t)i * 256 * 1024, (size_t)32 * 2 * 256 * 1024};
                    pg8::gemm_phase<pg8::EpiQKV, pg8::StaticOrder, true, true>(lds, gm, S, E, tid); }
                else { pg8::Gemm gm{H, Wt + W_PW1 + (size_t)i * 2 * MEL, M, 2 * D, D}; pg8::StaticOrder S; S.init(M, 2 * D, G, bid);
                    pg8::EpiGLU E{ssl, shl, Ub};
                    pg8::gemm_phase<pg8::EpiGLU, pg8::StaticOrder, true, true>(lds, gm, S, E, tid); }
            } else if (s == 1) {
                if (!conv) attn_phase(Qb, Kb, Vb, Ob, CK, CV, P.rpb + (size_t)i * 16 * 15 * 31, i, lds, tid, lane, wave, G, bid, amode == 2 ? 512 : 0, amode == 1 ? 512 : 1024);
                else conv_phase(Ub, Vc, P.w_dw + (size_t)i * 31 * D, P.b_dw + i * D, P.ln_g + i * D, P.ln_b + i * D, lds, tid, lane, wave, G, bid);
            } else if (s == 2 || s == 4) {
                pg8::Gemm gm; pg8::EpiRes E;
                if (s == 2) { gm = pg8::Gemm{conv ? Vc : Ob, Wt + (conv ? W_PW2 : W_O) + (size_t)i * MEL, M, D, D};
                    E = pg8::EpiRes{P.x_prompt, P.x_sample, l == 0 ? (const bf16*)nullptr : X, X, modl + 2 * 1024, H, P.norm_g + (l * 2 + 1) * D, modl + 4 * 1024, SS + (size_t)(2 * l + 1) * M}; }
                else { gm = pg8::Gemm{Fb, Wt + W_DOWN + (size_t)l * 4 * MEL, M, D, FF};
                    E = pg8::EpiRes{P.x_prompt, P.x_sample, X, X, modl + 5 * 1024, l < NL - 1 ? H : nullptr, P.norm_g + ((l + 1) * 2) * D, modl + 5 * 6144 + 1 * 1024, SS + (size_t)(2 * l + 2) * M}; }
                pg8::StaticOrder S; S.init(M, D, G, bid);
                pg8::gemm_phase<pg8::EpiRes, pg8::StaticOrder, true, true>(lds, gm, S, E, tid);
            } else {
#ifdef UP256
                pg8::Gemm gm{H, Wt + W_UP + (size_t)l * 4 * MEL, M, FF, D}; pg8::StaticOrder256 S; S.init(M, FF, G, bid);
                pg8::EpiUp256 E{SS + (size_t)(2 * l + 1) * M, SHW + (size_t)((2 * l + 1) * 5) * 4096, Fb, FF};
                pg8::gemm_phase256<pg8::EpiUp256, pg8::StaticOrder256, true, true>(lds, gm, S, E, tid);
#else
                pg8::Gemm gm{H, Wt + W_UP + (size_t)l * 4 * MEL, M, FF, D}; pg8::StaticOrder S; S.init(M, FF, G, bid);
                pg8::EpiUp E{SS + (size_t)(2 * l + 1) * M, SHW + (size_t)((2 * l + 1) * 5) * 4096, Fb, FF};
                pg8::gemm_phase<pg8::EpiUp, pg8::StaticOrder, true, true>(lds, gm, S, E, tid);
#endif
            }
        }
        if (pc + 1 < nprog) { if (pc == 0) { grid.sync(); xbar = xcd_barrier_post(xbar.bar, xbar.st); } else xcd_barrier(xbar); }
    }
}

#ifndef SINGLE_LAUNCH
#define SINGLE_LAUNCH 0
#endif
extern "C" void kernel_launch(void* const* d_in, const int* in_sizes, int n_in, void* d_out, int out_size, void* d_ws, size_t ws_size, hipStream_t stream) {
    static int grid = 0;
    if (grid == 0) {
        if (n_in != 21 || ws_size < WS_END) { fprintf(stderr, "kernel_launch: unexpected n_in %d / ws_size %zu\n", n_in, ws_size); grid = -1; return; }
        int dev = 0, cus = 0, per_cu = 0;
        hipGetDevice(&dev); hipDeviceGetAttribute(&cus, hipDeviceAttributeMultiprocessorCount, dev);
        hipFuncSetAttribute((const void*)fwd_kernel, hipFuncAttributeMaxDynamicSharedMemorySize, LDS_BYTES);
        hipOccupancyMaxActiveBlocksPerMultiprocessor(&per_cu, (const void*)fwd_kernel, NTHR, LDS_BYTES);
        if (per_cu < 1) { fprintf(stderr, "kernel_launch: occupancy query says %d blocks/CU\n", per_cu); per_cu = 1; }
        (void)hipGetLastError();
        grid = cus * per_cu;
    }
    if (grid < 0) return;
    Args a{};
    for (int i = 0; i < 21; ++i) a.in[i] = (const float*)d_in[i];
    a.out = (float*)d_out; a.ws = (unsigned char*)d_ws;
#if SINGLE_LAUNCH
    { int n = 0;
      for (int ph = 0; ph < NPH; ++ph) { a.prog[n++] = ph;
#ifdef PROBE_ATTN_MODE
          if (ph >= 2 && ph < NPH - 1 && (ph - 2) % 5 == 1 && ((ph - 2) / 5) % 2 == 0) a.prog[n++] = ph | (PROBE_ATTN_MODE << 6);
#endif
#ifdef PROBE_EMPTY
          if (ph == 5) for (int q = 0; q < PROBE_EMPTY; ++q) a.prog[n++] = 60;
#endif
#ifdef PROBE_REPEAT_P0
          if (ph == 0) a.prog[n++] = 0;
#endif
#ifdef PROBE_REPEAT_S
          if (ph >= 2 && ph < NPH - 1 && (ph - 2) % 5 == PROBE_REPEAT_S && (PROBE_REPEAT_PAR < 0 || ((ph - 2) / 5) % 2 == PROBE_REPEAT_PAR)) a.prog[n++] = ph;
#endif
      }
      a.nprog = n; }
    void* args[] = {&a};
    hipError_t e = hipLaunchCooperativeKernel((const void*)fwd_kernel, dim3(grid), dim3(NTHR), args, LDS_BYTES, stream);
    if (e != hipSuccess) fprintf(stderr, "cooperative launch failed: %s (grid %d)\n", hipGetErrorString(e), grid);
#else
    for (int ph = 0; ph < NPH; ++ph) { a.nprog = 1; a.prog[0] = ph; hipLaunchKernelGGL(fwd_kernel, dim3(grid), dim3(NTHR), LDS_BYTES, stream, a); }
#endif
}
```

```cpp
#define SINGLE_LAUNCH 1
#define UP256 1
#include <hip/hip_runtime.h>
#include <hip/hip_cooperative_groups.h>
#include <cstdio>
#include <cstdint>
#include <cmath>
#include <utility>
namespace cg = cooperative_groups;
namespace pg8 {
#define PG8_LAS __attribute__((address_space(3)))
typedef unsigned short bf16_t;
typedef short bf16x8 __attribute__((ext_vector_type(8)));
typedef float f32x4 __attribute__((ext_vector_type(4)));
typedef unsigned u32x4 __attribute__((ext_vector_type(4)));
constexpr int RM = 192;
constexpr int BM = 256, BK = 64, HALF = 128, HTB = HALF * BK * 2  , STAGE_BYTES = 8 * HTB, NXCD = 8, WGM = 8;

__host__ __device__ __forceinline__ int lds_byte(int r, int c) { const int st = (r >> 4) * 2 + (c >> 5), rr = r & 15, cc = c & 31, ob = rr * 64 + cc * 2; return st * 1024 + (ob ^ (((ob >> 9) & 1) << 5)); }
__host__ __device__ __forceinline__ void stage_rc(int b, int& R, int& C) { const int st = b / 1024, sb = b % 1024, swz = sb ^ (((sb >> 9) & 1) << 5); R = (st >> 1) * 16 + swz / 64; C = (st & 1) * 32 + (swz % 64) / 2; }
__host__ __device__ __forceinline__ int perm32(int rho) { const int n = rho >> 4, i = rho & 15; return 8 * (i >> 2) + 4 * n + (i & 3); }

struct Unit { int pm, pn; };
struct Gemm { const bf16_t* A; const bf16_t* Bt; int M, N, K; };

struct StaticOrder {
    int nM, nN, nwg, G, c;
    __host__ __device__ void init(int M, int N, int G_, int c_) { nM = M / RM; nN = N / BM; nwg = nM * nN; G = G_; c = c_; }
    __host__ __device__ bool next(int i, Unit& u) const {
        const long L = (long)i * G + c; if (L >= nwg) return false;
        int wgid = (int)L; { const int q = nwg / NXCD, r = nwg % NXCD, xcd = wgid % NXCD, off = wgid / NXCD; wgid = (xcd < r ? xcd * (q + 1) : r * (q + 1) + (xcd - r) * q) + off; }
        const int nig = WGM * nN, gid = wgid / nig, fm = gid * WGM, gsz = (nM - fm) < WGM ? (nM - fm) : WGM;
        u.pm = fm + ((wgid % nig) % gsz); u.pn = (wgid % nig) / gsz; return true;
    }
    __device__ __forceinline__ void a_ready(const Unit&) const {}
    __device__ __forceinline__ void done(const Unit&) const {}
};

__device__ __forceinline__ unsigned cvt_pk_bf16(float lo, float hi) { unsigned r; asm volatile("v_cvt_pk_bf16_f32 %0, %1, %2" : "=v"(r) : "v"(lo), "v"(hi)); return r; }
typedef float f32x2 __attribute__((ext_vector_type(2)));
__device__ __forceinline__ int cond_of_row(int r) { return r < 8192 ? 0 : 1 + ((r - 8192) >> 10); }
__device__ __forceinline__ int half_row0(int ai, int wr) { return ai == 0 ? wr * 64 : 128 + wr * 32; }
#define EPI_MLOOP(ai, m) _Pragma("unroll") for (int m = 0; m < 4; ++m) if (ai == 0 || m < 2)
struct EpiQKV {
    static constexpr bool PERM = true, AFTER_DRAIN = false;
    const float* ss; const float* shw;
    bf16_t* Q; size_t qkv_stride; float* ck; size_t ckv_stride;
    __device__ __forceinline__ void operator()(const f32x4 (&acc)[2][2][4][2], const Unit& u, int wr, int wc, int fr, int fq) const {
        const int t = u.pn >> 2;
        bf16_t* base = Q + (size_t)t * qkv_stride;
        const int col0 = (u.pn & 3) * BM + wc * 32 + 8 * fq;
        float* cbase = ck + (size_t)(t > 0 ? t - 1 : 0) * ckv_stride + col0;
#pragma unroll
        for (int ai = 0; ai < 2; ++ai) { const int rbase = u.pm * RM + half_row0(ai, wr) + fr; const bool wc_ = (t > 0) && (rbase < 8192);
            const float* sp = shw + cond_of_row(rbase) * 4096 + u.pn * BM + wc * 32 + 8 * fq;
            f32x4 sv[2][2];
#pragma unroll
            for (int bj = 0; bj < 2; ++bj) { sv[bj][0] = *(const f32x4*)(sp + bj * HALF); sv[bj][1] = *(const f32x4*)(sp + bj * HALF + 4); }
            float rr[4];
            EPI_MLOOP(ai, m) rr[m] = ss[rbase + m * 16];
            EPI_MLOOP(ai, m) { const int row = rbase + m * 16; bf16_t* rowp = base + (size_t)row * 1024 + col0;
                const float r = __builtin_amdgcn_rsqf(rr[m] * (1.f / 1024.f) + 1e-6f);
                float* cp0 = cbase + ((size_t)(row >> 8) * 2 * 256 + (row & 255)) * 1024;
#pragma unroll
                for (int bj = 0; bj < 2; ++bj) { const f32x4 v0 = acc[ai][bj][m][0] * r + sv[bj][0], v1 = acc[ai][bj][m][1] * r + sv[bj][1];
                    u32x4 w; w.x = cvt_pk_bf16(v0[0], v0[1]); w.y = cvt_pk_bf16(v0[2], v0[3]); w.z = cvt_pk_bf16(v1[0], v1[1]); w.w = cvt_pk_bf16(v1[2], v1[3]);
                    *(u32x4*)(rowp + bj * HALF) = w;
                    if (wc_) { float* cp = cp0 + bj * HALF; __builtin_nontemporal_store(v0, (f32x4*)cp); __builtin_nontemporal_store(v1, (f32x4*)(cp + 4)); } } } }
    }
};
struct EpiUp {
    static constexpr bool PERM = true, AFTER_DRAIN = false;
    const float* ss; const float* shw; bf16_t* O; int ldc;
    __device__ __forceinline__ void operator()(const f32x4 (&acc)[2][2][4][2], const Unit& u, int wr, int wc, int fr, int fq) const {
        const int col0 = u.pn * BM + wc * 32 + 8 * fq;
#pragma unroll
        for (int ai = 0; ai < 2; ++ai) { const int rbase = u.pm * RM + half_row0(ai, wr) + fr;
            const float* sp = shw + cond_of_row(rbase) * 4096 + col0;
            f32x4 sv[2][2];
#pragma unroll
            for (int bj = 0; bj < 2; ++bj) { sv[bj][0] = *(const f32x4*)(sp + bj * HALF); sv[bj][1] = *(const f32x4*)(sp + bj * HALF + 4); }
            float rr[4];
            EPI_MLOOP(ai, m) rr[m] = ss[rbase + m * 16];
            EPI_MLOOP(ai, m) { bf16_t* rowp = O + (size_t)(rbase + m * 16) * ldc + col0;
                const float r = __builtin_amdgcn_rsqf(rr[m] * (1.f / 1024.f) + 1e-6f);
#pragma unroll
                for (int bj = 0; bj < 2; ++bj) { f32x4 v0 = acc[ai][bj][m][0] * r + sv[bj][0], v1 = acc[ai][bj][m][1] * r + sv[bj][1];
#pragma unroll
                    for (int e = 0; e < 4; ++e) { const float a = fmaxf(v0[e], 0.f), b = fmaxf(v1[e], 0.f); v0[e] = a * a; v1[e] = b * b; }
                    u32x4 w; w.x = cvt_pk_bf16(v0[0], v0[1]); w.y = cvt_pk_bf16(v0[2], v0[3]); w.z = cvt_pk_bf16(v1[0], v1[1]); w.w = cvt_pk_bf16(v1[2], v1[3]);
                    *(u32x4*)(rowp + bj * HALF) = w; } } }
    }
};
struct EpiGLU {
    static constexpr bool PERM = true, AFTER_DRAIN = false;
    const float* ss; const float* shw; bf16_t* O;
    __device__ __forceinline__ void operator()(const f32x4 (&acc)[2][2][4][2], const Unit& u, int wr, int wc, int fr, int fq) const {
        const int col0 = u.pn * HALF + wc * 32 + 8 * fq;
#pragma unroll
        for (int ai = 0; ai < 2; ++ai) { const int rbase = u.pm * RM + half_row0(ai, wr) + fr;
            const float* sp = shw + cond_of_row(rbase) * 4096 + u.pn * BM + wc * 32 + 8 * fq;
            f32x4 sv[2][2];
#pragma unroll
            for (int bj = 0; bj < 2; ++bj) { sv[bj][0] = *(const f32x4*)(sp + bj * HALF); sv[bj][1] = *(const f32x4*)(sp + bj * HALF + 4); }
            float rr[4];
            EPI_MLOOP(ai, m) rr[m] = ss[rbase + m * 16];
            EPI_MLOOP(ai, m) { bf16_t* rowp = O + (size_t)(rbase + m * 16) * 1024 + col0;
                const float r = __builtin_amdgcn_rsqf(rr[m] * (1.f / 1024.f) + 1e-6f);
                f32x4 v0 = acc[ai][0][m][0] * r + sv[0][0], v1 = acc[ai][0][m][1] * r + sv[0][1]; const f32x4 g0 = acc[ai][1][m][0] * r + sv[1][0], g1 = acc[ai][1][m][1] * r + sv[1][1];
#pragma unroll
                for (int e = 0; e < 4; ++e) { v0[e] = v0[e] * __builtin_amdgcn_rcpf(1.f + __expf(-g0[e])); v1[e] = v1[e] * __builtin_amdgcn_rcpf(1.f + __expf(-g1[e])); }
                u32x4 w; w.x = cvt_pk_bf16(v0[0], v0[1]); w.y = cvt_pk_bf16(v0[2], v0[3]); w.z = cvt_pk_bf16(v1[0], v1[1]); w.w = cvt_pk_bf16(v1[2], v1[3]);
                *(u32x4*)rowp = w; } }
    }
};
struct EpiRes {
    static constexpr bool PERM = true, AFTER_DRAIN = false;
    const float* base_p; const float* base_s; const bf16_t* base_b; bf16_t* out; const float* gate;
    bf16_t* xb; const float* g_next; const float* sc_next; float* ss_next;
    __device__ __forceinline__ void operator()(const f32x4 (&acc)[2][2][4][2], const Unit& u, int wr, int wc, int fr, int fq) const {
        const int col0 = u.pn * BM + wc * 32 + 8 * fq;
        const int lane_x = fq * 16 + fr;
#pragma unroll
        for (int ai = 0; ai < 2; ++ai) { const int row0 = u.pm * RM + half_row0(ai, wr) + fr; const int cond = cond_of_row(row0);
            const float* gp = gate + cond * 6144 + col0;
            const float* bp = (row0 < 8192) ? base_p + (size_t)row0 * 1024 + col0 : base_s + (size_t)(row0 - 8192) * 1024 + col0;
            const bf16_t* bb = base_b + (size_t)row0 * 1024 + col0;
            bf16_t* op = out + (size_t)row0 * 1024 + col0;
            f32x4 gv[2][2], gs[2][2];
#pragma unroll
            for (int bj = 0; bj < 2; ++bj)
#pragma unroll
                for (int n = 0; n < 2; ++n) gv[bj][n] = *(const f32x4*)(gp + bj * HALF + n * 4);
            if (xb) { f32x4 ga[2][2], sa[2][2];
#pragma unroll
                for (int bj = 0; bj < 2; ++bj)
#pragma unroll
                    for (int n = 0; n < 2; ++n) { ga[bj][n] = *(const f32x4*)(g_next + col0 + bj * HALF + n * 4); sa[bj][n] = *(const f32x4*)(sc_next + cond * 6144 + col0 + bj * HALF + n * 4); }
#pragma unroll
                for (int bj = 0; bj < 2; ++bj)
#pragma unroll
                    for (int n = 0; n < 2; ++n) gs[bj][n] = ga[bj][n] * (1.f + sa[bj][n]); }
#pragma unroll
            for (int mp = 0; mp < 2; ++mp) if (ai == 0 || mp == 0) { f32x4 bs[2][2][2];
                if (base_b) {
#pragma unroll
                    for (int mm = 0; mm < 2; ++mm)
#pragma unroll
                        for (int bj = 0; bj < 2; ++bj) { const u32x4 w = *(const u32x4*)(bb + (size_t)((2 * mp + mm) * 16) * 1024 + bj * HALF);
                            bs[mm][bj][0] = (f32x4){__builtin_bit_cast(float, w.x << 16), __builtin_bit_cast(float, w.x & 0xffff0000u), __builtin_bit_cast(float, w.y << 16), __builtin_bit_cast(float, w.y & 0xffff0000u)};
                            bs[mm][bj][1] = (f32x4){__builtin_bit_cast(float, w.z << 16), __builtin_bit_cast(float, w.z & 0xffff0000u), __builtin_bit_cast(float, w.w << 16), __builtin_bit_cast(float, w.w & 0xffff0000u)}; }
                } else {
#pragma unroll
                    for (int mm = 0; mm < 2; ++mm)
#pragma unroll
                        for (int bj = 0; bj < 2; ++bj)
#pragma unroll
                            for (int n = 0; n < 2; ++n) bs[mm][bj][n] = *(const f32x4*)(bp + (size_t)((2 * mp + mm) * 16) * 1024 + bj * HALF + n * 4);
                }
#pragma unroll
                for (int mm = 0; mm < 2; ++mm) { float sq = 0.f;
#pragma unroll
                    for (int bj = 0; bj < 2; ++bj) { const f32x4 x0 = bs[mm][bj][0] + gv[bj][0] * acc[ai][bj][2 * mp + mm][0], x1 = bs[mm][bj][1] + gv[bj][1] * acc[ai][bj][2 * mp + mm][1];
                        { u32x4 w; w.x = cvt_pk_bf16(x0[0], x0[1]); w.y = cvt_pk_bf16(x0[2], x0[3]); w.z = cvt_pk_bf16(x1[0], x1[1]); w.w = cvt_pk_bf16(x1[2], x1[3]); *(u32x4*)(op + (size_t)((2 * mp + mm) * 16) * 1024 + bj * HALF) = w; }
                        if (xb) { const f32x4 h0 = x0 * gs[bj][0], h1 = x1 * gs[bj][1]; u32x4 w; w.x = cvt_pk_bf16(h0[0], h0[1]); w.y = cvt_pk_bf16(h0[2], h0[3]); w.z = cvt_pk_bf16(h1[0], h1[1]); w.w = cvt_pk_bf16(h1[2], h1[3]);
                            *(u32x4*)(xb + (size_t)(row0 + (2 * mp + mm) * 16) * 1024 + col0 + bj * HALF) = w;
                            sq += ((x0[0] * x0[0] + x0[1] * x0[1]) + (x0[2] * x0[2] + x0[3] * x0[3])) + ((x1[0] * x1[0] + x1[1] * x1[1]) + (x1[2] * x1[2] + x1[3] * x1[3])); } }
                    if (xb) {
                        sq += __builtin_bit_cast(float, __builtin_amdgcn_ds_bpermute((lane_x ^ 16) << 2, __builtin_bit_cast(int, sq)));
                        sq += __builtin_bit_cast(float, __builtin_amdgcn_ds_bpermute((lane_x ^ 32) << 2, __builtin_bit_cast(int, sq)));
                        if (fq == 0) atomicAdd(ss_next + row0 + (2 * mp + mm) * 16, sq); } }
                asm volatile("" ::: "memory"); } }
    }
};

struct StaticOrder256 {
    int nM, nN, nwg, G, c;
    __host__ __device__ void init(int M, int N, int G_, int c_) { nM = M / BM; nN = N / BM; nwg = nM * nN; G = G_; c = c_; }
    __host__ __device__ bool next(int i, Unit& u) const {
        const long L = (long)i * G + c; if (L >= nwg) return false;
        int wgid = (int)L; { const int q = nwg / NXCD, r = nwg % NXCD, xcd = wgid % NXCD, off = wgid / NXCD; wgid = (xcd < r ? xcd * (q + 1) : r * (q + 1) + (xcd - r) * q) + off; }
        const int nig = WGM * nN, gid = wgid / nig, fm = gid * WGM, gsz = (nM - fm) < WGM ? (nM - fm) : WGM;
        u.pm = fm + ((wgid % nig) % gsz); u.pn = (wgid % nig) / gsz; return true;
    }
    __device__ __forceinline__ void a_ready(const Unit&) const {}
    __device__ __forceinline__ void done(const Unit&) const {}
};
struct EpiUp256 {
    static constexpr bool PERM = true, AFTER_DRAIN = false;
    const float* ss; const float* shw; bf16_t* O; int ldc;
    __device__ __forceinline__ void operator()(const f32x4 (&acc)[2][2][4][2], const Unit& u, int wr, int wc, int fr, int fq) const {
        const int col0 = u.pn * BM + wc * 32 + 8 * fq;
        f32x4 sv[2][2][2]; float rr[2][4];
#pragma unroll
        for (int ai = 0; ai < 2; ++ai) { const int rbase = u.pm * BM + ai * HALF + wr * 64 + fr; const float* sp = shw + cond_of_row(rbase) * 4096 + col0;
#pragma unroll
            for (int bj = 0; bj < 2; ++bj) { sv[ai][bj][0] = *(const f32x4*)(sp + bj * HALF); sv[ai][bj][1] = *(const f32x4*)(sp + bj * HALF + 4); }
#pragma unroll
            for (int m = 0; m < 4; ++m) rr[ai][m] = ss[rbase + m * 16]; }
        __builtin_amdgcn_sched_barrier(0);
#pragma unroll
        for (int ai = 0; ai < 2; ++ai) { const int rbase = u.pm * BM + ai * HALF + wr * 64 + fr;
#pragma unroll
            for (int m = 0; m < 4; ++m) { bf16_t* rowp = O + (size_t)(rbase + m * 16) * ldc + col0;
                const float r = __builtin_amdgcn_rsqf(rr[ai][m] * (1.f / 1024.f) + 1e-6f);
#pragma unroll
                for (int bj = 0; bj < 2; ++bj) { f32x4 v0 = acc[ai][bj][m][0] * r + sv[ai][bj][0], v1 = acc[ai][bj][m][1] * r + sv[ai][bj][1];
#pragma unroll
                    for (int e = 0; e < 4; ++e) { const float a = fmaxf(v0[e], 0.f), b = fmaxf(v1[e], 0.f); v0[e] = a * a; v1[e] = b * b; }
                    u32x4 w; w.x = cvt_pk_bf16(v0[0], v0[1]); w.y = cvt_pk_bf16(v0[2], v0[3]); w.z = cvt_pk_bf16(v1[0], v1[1]); w.w = cvt_pk_bf16(v1[2], v1[3]);
                    *(u32x4*)(rowp + bj * HALF) = w; } } }
    }
};
template <class Epi, class Sched, bool ALIGN_EPI = false, bool SP2 = false>
__device__ __forceinline__ void gemm_phase256(PG8_LAS unsigned char* lds, const Gemm g, const Sched& S, const Epi& E, const int tid) {
    const int wid = __builtin_amdgcn_readfirstlane(tid >> 6), lane = tid & 63, wr = wid >> 2, wc = wid & 3, fr = lane & 15, fq = lane >> 4;
    const int K = g.K, nt = K / BK;
    unsigned voffA[2], voffB[2];
#pragma unroll
    for (int i = 0; i < 2; ++i) { int R, C; stage_rc(tid * 16 + i * 8192, R, C); const int Rb = Epi::PERM ? ((R & ~31) + perm32(R & 31)) : R;
        voffA[i] = (unsigned)(R * K + C) * 2u; voffB[i] = (unsigned)(Rb * K + C) * 2u; }
    const size_t kstep = (size_t)(BK * 2);
    const size_t hstep = (size_t)HALF * K * 2;
    const size_t tstep = 2 * hstep;
    const unsigned ldsw = (unsigned)wid * 1024u;
    const int aoff = lds_byte(wr * 64 + fr, fq * 8), boff = lds_byte(wc * 32 + fr, fq * 8);
#define PG8_SA(b, h) (((b) * 2 + (h)) * HTB)
#define PG8_SB(b, h) ((4 + (b) * 2 + (h)) * HTB)
#define PG8_STAGE(bufoff, gbase, voff) do { _Pragma("unroll") for (int _i = 0; _i < 2; ++_i) \
        __builtin_amdgcn_global_load_lds((const unsigned*)((const char*)(gbase) + (voff)[_i]), (PG8_LAS unsigned*)(lds + (bufoff) + ldsw + _i * 8192), 16, 0, 0); } while (0)
#define PG8_LDA(dst, b, h) do { _Pragma("unroll") for (int m = 0; m < 4; ++m) _Pragma("unroll") for (int k = 0; k < 2; ++k) dst[m][k] = *(const PG8_LAS bf16x8*)(lds + PG8_SA(b, h) + aoff + m * 2048 + k * 1024); } while (0)
#define PG8_LDB(dst, b, h) do { _Pragma("unroll") for (int n = 0; n < 2; ++n) _Pragma("unroll") for (int k = 0; k < 2; ++k) dst[n][k] = *(const PG8_LAS bf16x8*)(lds + PG8_SB(b, h) + boff + n * 2048 + k * 1024); } while (0)
#define PG8_MMA(ai, bj, At, Bt) do { __builtin_amdgcn_s_setprio(1); _Pragma("unroll") for (int m = 0; m < 4; ++m) _Pragma("unroll") for (int n = 0; n < 2; ++n) _Pragma("unroll") for (int k = 0; k < 2; ++k) \
        acc[ai][bj][m][n] = __builtin_amdgcn_mfma_f32_16x16x32_bf16(Bt[n][k], At[m][k], acc[ai][bj][m][n], 0, 0, 0); __builtin_amdgcn_s_setprio(0); } while (0)
#define PG8_WAIT_V(n) asm volatile("s_waitcnt vmcnt(" #n ")" ::: "memory")
#define PG8_WAIT_L(n) asm volatile("s_waitcnt lgkmcnt(" #n ")" ::: "memory")
#define PG8_BAR __builtin_amdgcn_s_barrier()
#define PG8_SCHED __builtin_amdgcn_sched_barrier(0)
    Unit cur, nxt; int ui = 0;
    if (!S.next(0, cur)) return;
    f32x4 acc[2][2][4][2];
#pragma unroll
    for (int a = 0; a < 2; ++a)
#pragma unroll
        for (int b = 0; b < 2; ++b)
#pragma unroll
            for (int m = 0; m < 4; ++m)
#pragma unroll
                for (int n = 0; n < 2; ++n) acc[a][b][m][n] = (f32x4){0.f, 0.f, 0.f, 0.f};
    bf16x8 At[4][2], B0[2][2], B1[2][2];
    const char* cA = (const char*)g.A + (size_t)cur.pm * tstep; const char* cB = (const char*)g.Bt + (size_t)cur.pn * tstep;
    S.a_ready(cur);
    if constexpr (SP2) {
        PG8_STAGE(PG8_SB(0, 0), cB, voffB); PG8_STAGE(PG8_SB(0, 1), cB + hstep, voffB); PG8_STAGE(PG8_SA(0, 0), cA, voffA); PG8_STAGE(PG8_SA(0, 1), cA + hstep, voffA);
        if (wr == 1) PG8_BAR;
        PG8_WAIT_V(2); PG8_BAR;
        PG8_STAGE(PG8_SB(1, 0), cB + kstep, voffB); PG8_STAGE(PG8_SA(1, 0), cA + kstep, voffA); PG8_STAGE(PG8_SB(1, 1), cB + hstep + kstep, voffB);
        PG8_WAIT_V(6); PG8_BAR;
    } else {
        PG8_STAGE(PG8_SB(0, 0), cB, voffB); PG8_STAGE(PG8_SA(0, 0), cA, voffA); PG8_STAGE(PG8_SB(0, 1), cB + hstep, voffB); PG8_STAGE(PG8_SA(0, 1), cA + hstep, voffA);
        if (wr == 1) PG8_BAR;
        PG8_WAIT_V(4); PG8_BAR;
        PG8_STAGE(PG8_SB(1, 0), cB + kstep, voffB); PG8_STAGE(PG8_SA(1, 0), cA + kstep, voffA); PG8_STAGE(PG8_SB(1, 1), cB + hstep + kstep, voffB);
        PG8_WAIT_V(6); PG8_BAR;
    }
    for (;;) {
        const bool has_next = S.next(ui + 1, nxt);
        const char* nA = has_next ? (const char*)g.A + (size_t)nxt.pm * tstep : cA; const char* nB = has_next ? (const char*)g.Bt + (size_t)nxt.pn * tstep : cB;
        for (int t = 0; t < nt; t += 2) {
            const bool last = (t == nt - 2);
            const char* a1 = cA + (size_t)(t + 1) * kstep;
            const char* a2 = last ? nA : cA + (size_t)(t + 2) * kstep; const char* b2 = last ? nB : cB + (size_t)(t + 2) * kstep;
            const char* a3 = a2 + kstep; const char* b3 = b2 + kstep;
            if (last && has_next) S.a_ready(nxt);
            if constexpr (SP2) {
            PG8_LDB(B0, 0, 0); PG8_LDB(B1, 0, 1); PG8_SCHED; PG8_LDA(At, 0, 0); PG8_STAGE(PG8_SA(1, 1), a1 + hstep, voffA);
            PG8_WAIT_V(8); PG8_WAIT_L(0); PG8_BAR; PG8_MMA(0, 0, At, B0); PG8_MMA(0, 1, At, B1); PG8_BAR; PG8_SCHED;
            PG8_LDA(At, 0, 1); PG8_STAGE(PG8_SB(0, 0), b2, voffB); PG8_STAGE(PG8_SB(0, 1), b2 + hstep, voffB); PG8_STAGE(PG8_SA(0, 0), a2, voffA);
            PG8_WAIT_V(8); PG8_WAIT_L(0); PG8_BAR; PG8_MMA(1, 0, At, B0); PG8_MMA(1, 1, At, B1); PG8_BAR; PG8_SCHED;
            PG8_LDB(B0, 1, 0); PG8_LDB(B1, 1, 1); PG8_SCHED; PG8_LDA(At, 1, 0); PG8_STAGE(PG8_SA(0, 1), a2 + hstep, voffA);
            PG8_WAIT_V(8); PG8_WAIT_L(0); PG8_BAR; PG8_MMA(0, 0, At, B0); PG8_MMA(0, 1, At, B1); PG8_BAR; PG8_SCHED;
            PG8_LDA(At, 1, 1); PG8_STAGE(PG8_SB(1, 0), b3, voffB); PG8_STAGE(PG8_SB(1, 1), b3 + hstep, voffB); PG8_STAGE(PG8_SA(1, 0), a3, voffA);
            PG8_WAIT_V(8); PG8_WAIT_L(0); PG8_BAR; PG8_MMA(1, 0, At, B0); PG8_MMA(1, 1, At, B1); PG8_BAR; PG8_SCHED;
            } else {
            PG8_LDB(B0, 0, 0); PG8_SCHED; PG8_LDA(At, 0, 0); PG8_STAGE(PG8_SA(1, 1), a1 + hstep, voffA);
            PG8_WAIT_L(8); PG8_BAR; PG8_WAIT_L(0); PG8_MMA(0, 0, At, B0); PG8_BAR; PG8_SCHED;
            PG8_LDB(B1, 0, 1); PG8_STAGE(PG8_SB(0, 0), b2, voffB);
            PG8_BAR; PG8_WAIT_L(0); PG8_MMA(0, 1, At, B1); PG8_BAR;
            PG8_LDA(At, 0, 1); PG8_STAGE(PG8_SA(0, 0), a2, voffA);
            PG8_BAR; PG8_WAIT_L(0); PG8_MMA(1, 0, At, B0); PG8_BAR; PG8_SCHED;
            PG8_STAGE(PG8_SB(0, 1), b2 + hstep, voffB);
            PG8_WAIT_V(6); PG8_BAR; PG8_MMA(1, 1, At, B1); PG8_BAR;
            PG8_LDB(B0, 1, 0); PG8_SCHED; PG8_LDA(At, 1, 0); PG8_STAGE(PG8_SA(0, 1), a2 + hstep, voffA);
            PG8_WAIT_L(8); PG8_BAR; PG8_WAIT_L(0); PG8_MMA(0, 0, At, B0); PG8_BAR; PG8_SCHED;
            PG8_LDB(B1, 1, 1); PG8_STAGE(PG8_SB(1, 0), b3, voffB);
            PG8_BAR; PG8_WAIT_L(0); PG8_MMA(0, 1, At, B1); PG8_BAR;
            PG8_LDA(At, 1, 1); PG8_STAGE(PG8_SA(1, 0), a3, voffA);
            PG8_BAR; PG8_WAIT_L(0); PG8_MMA(1, 0, At, B0); PG8_BAR; PG8_SCHED;
            PG8_STAGE(PG8_SB(1, 1), b3 + hstep, voffB);
            PG8_WAIT_V(6); PG8_BAR; PG8_MMA(1, 1, At, B1); PG8_BAR;
            }
        }
        if constexpr (ALIGN_EPI) { if (wr == 0) PG8_BAR; }
        if constexpr (!Epi::AFTER_DRAIN) { E(acc, cur, wr, wc, fr, fq); S.done(cur); }
        if (!has_next) break;
#pragma unroll
        for (int a = 0; a < 2; ++a)
#pragma unroll
            for (int b = 0; b < 2; ++b)
#pragma unroll
                for (int m = 0; m < 4; ++m)
#pragma unroll
                    for (int n = 0; n < 2; ++n) acc[a][b][m][n] = (f32x4){0.f, 0.f, 0.f, 0.f};
        cur = nxt; cA = nA; cB = nB; ++ui;
        if constexpr (ALIGN_EPI) { if (wr == 1) PG8_BAR; }
    }
    PG8_WAIT_V(0);
    if constexpr (!ALIGN_EPI) { if (wr == 0) PG8_BAR; }
    PG8_BAR;
    if constexpr (Epi::AFTER_DRAIN) { E.fused(acc, cur, wr, wc, fr, fq, lds, wid, lane); S.done(cur); }
#undef PG8_SA
#undef PG8_SB
#undef PG8_STAGE
#undef PG8_LDA
#undef PG8_LDB
#undef PG8_MMA
#undef PG8_WAIT_V
#undef PG8_WAIT_L
#undef PG8_BAR
#undef PG8_SCHED
}
template <class Epi, class Sched, bool ALIGN_EPI = false, bool SP2 = false>
__device__ __forceinline__ void gemm_phase(PG8_LAS unsigned char* lds, const Gemm g, const Sched& S, const Epi& E, const int tid) {
    static_assert(SP2, "the 192-row tile form exists for the SP2 loop only");
    const int wid = __builtin_amdgcn_readfirstlane(tid >> 6), lane = tid & 63, wr = wid >> 2, wc = wid & 3, fr = lane & 15, fq = lane >> 4;
    const int K = g.K, nt = K / BK;
    unsigned voffA[2], voffB[2];
#pragma unroll
    for (int i = 0; i < 2; ++i) { int R, C; stage_rc(tid * 16 + i * 8192, R, C); const int Rb = Epi::PERM ? ((R & ~31) + perm32(R & 31)) : R;
        voffA[i] = (unsigned)(R * K + C) * 2u; voffB[i] = (unsigned)(Rb * K + C) * 2u; }
    const size_t kstep = (size_t)(BK * 2);
    const size_t hstep = (size_t)HALF * K * 2;
    const size_t tstepA = (size_t)RM * K * 2;
    const size_t tstep = 2 * hstep;
    const unsigned ldsw = (unsigned)wid * 1024u;
    const int aoff = lds_byte(wr * 64 + fr, fq * 8), boff = lds_byte(wc * 32 + fr, fq * 8);
#define PG8_SA(b, h) (((b) * 2 + (h)) * HTB)
#define PG8_SB(b, h) ((4 + (b) * 2 + (h)) * HTB)
#define PG8_STAGE(bufoff, gbase, voff) do { _Pragma("unroll") for (int _i = 0; _i < 2; ++_i) \
        __builtin_amdgcn_global_load_lds((const unsigned*)((const char*)(gbase) + (voff)[_i]), (PG8_LAS unsigned*)(lds + (bufoff) + ldsw + _i * 8192), 16, 0, 0); } while (0)
#define PG8_LDA(dst, b, h) do { _Pragma("unroll") for (int m = 0; m < 4; ++m) _Pragma("unroll") for (int k = 0; k < 2; ++k) dst[m][k] = *(const PG8_LAS bf16x8*)(lds + PG8_SA(b, h) + aoff + m * 2048 + k * 1024); } while (0)
#define PG8_LDB(dst, b, h) do { _Pragma("unroll") for (int n = 0; n < 2; ++n) _Pragma("unroll") for (int k = 0; k < 2; ++k) dst[n][k] = *(const PG8_LAS bf16x8*)(lds + PG8_SB(b, h) + boff + n * 2048 + k * 1024); } while (0)
#define PG8_MMA(ai, bj, At, Bt) do { __builtin_amdgcn_s_setprio(1); _Pragma("unroll") for (int m = 0; m < 4; ++m) _Pragma("unroll") for (int n = 0; n < 2; ++n) _Pragma("unroll") for (int k = 0; k < 2; ++k) \
        acc[ai][bj][m][n] = __builtin_amdgcn_mfma_f32_16x16x32_bf16(Bt[n][k], At[m][k], acc[ai][bj][m][n], 0, 0, 0); __builtin_amdgcn_s_setprio(0); } while (0)
    const int aoff1 = lds_byte(wr * 32 + fr, fq * 8);
#define PG8_STAGE1(bufoff, gbase, voff) __builtin_amdgcn_global_load_lds((const unsigned*)((const char*)(gbase) + (voff)[0]), (PG8_LAS unsigned*)(lds + (bufoff) + ldsw), 16, 0, 0)
#define PG8_LDA1(dst, b) do { _Pragma("unroll") for (int m = 0; m < 2; ++m) _Pragma("unroll") for (int k = 0; k < 2; ++k) dst[m][k] = *(const PG8_LAS bf16x8*)(lds + PG8_SA(b, 1) + aoff1 + m * 2048 + k * 1024); } while (0)
#define PG8_MMA1(bj, At, Bt) do { __builtin_amdgcn_s_setprio(1); _Pragma("unroll") for (int m = 0; m < 2; ++m) _Pragma("unroll") for (int n = 0; n < 2; ++n) _Pragma("unroll") for (int k = 0; k < 2; ++k) \
        acc[1][bj][m][n] = __builtin_amdgcn_mfma_f32_16x16x32_bf16(Bt[n][k], At[m][k], acc[1][bj][m][n], 0, 0, 0); __builtin_amdgcn_s_setprio(0); } while (0)
#define PG8_WAIT_V(n) asm volatile("s_waitcnt vmcnt(" #n ")" ::: "memory")
#define PG8_WAIT_L(n) asm volatile("s_waitcnt lgkmcnt(" #n ")" ::: "memory")
#define PG8_BAR __builtin_amdgcn_s_barrier()
#define PG8_SCHED __builtin_amdgcn_sched_barrier(0)
    Unit cur, nxt; int ui = 0;
    if (!S.next(0, cur)) return;
    f32x4 acc[2][2][4][2];
#pragma unroll
    for (int a = 0; a < 2; ++a)
#pragma unroll
        for (int b = 0; b < 2; ++b)
#pragma unroll
            for (int m = 0; m < 4; ++m)
#pragma unroll
                for (int n = 0; n < 2; ++n) acc[a][b][m][n] = (f32x4){0.f, 0.f, 0.f, 0.f};
    bf16x8 At[4][2], B0[2][2], B1[2][2];
    const char* cA = (const char*)g.A + (size_t)cur.pm * tstepA; const char* cB = (const char*)g.Bt + (size_t)cur.pn * tstep;
    S.a_ready(cur);
    if constexpr (SP2) {
        PG8_STAGE(PG8_SB(0, 0), cB, voffB); PG8_STAGE(PG8_SB(0, 1), cB + hstep, voffB); PG8_STAGE(PG8_SA(0, 0), cA, voffA); PG8_STAGE1(PG8_SA(0, 1), cA + hstep, voffA);
        if (wr == 1) PG8_BAR;
        PG8_WAIT_V(1); PG8_BAR;
        PG8_STAGE(PG8_SB(1, 0), cB + kstep, voffB); PG8_STAGE(PG8_SA(1, 0), cA + kstep, voffA); PG8_STAGE(PG8_SB(1, 1), cB + hstep + kstep, voffB);
        PG8_WAIT_V(6); PG8_BAR;
    } else {
        PG8_STAGE(PG8_SB(0, 0), cB, voffB); PG8_STAGE(PG8_SA(0, 0), cA, voffA); PG8_STAGE(PG8_SB(0, 1), cB + hstep, voffB); PG8_STAGE(PG8_SA(0, 1), cA + hstep, voffA);
        if (wr == 1) PG8_BAR;
        PG8_WAIT_V(4); PG8_BAR;
        PG8_STAGE(PG8_SB(1, 0), cB + kstep, voffB); PG8_STAGE(PG8_SA(1, 0), cA + kstep, voffA); PG8_STAGE(PG8_SB(1, 1), cB + hstep + kstep, voffB);
        PG8_WAIT_V(6); PG8_BAR;
    }
    for (;;) {
        const bool has_next = S.next(ui + 1, nxt);
        const char* nA = has_next ? (const char*)g.A + (size_t)nxt.pm * tstepA : cA; const char* nB = has_next ? (const char*)g.Bt + (size_t)nxt.pn * tstep : cB;
        for (int t = 0; t < nt; t += 2) {
            const bool last = (t == nt - 2);
            const char* a1 = cA + (size_t)(t + 1) * kstep;
            const char* a2 = last ? nA : cA + (size_t)(t + 2) * kstep; const char* b2 = last ? nB : cB + (size_t)(t + 2) * kstep;
            const char* a3 = a2 + kstep; const char* b3 = b2 + kstep;
            if (last && has_next) S.a_ready(nxt);
            if constexpr (SP2) {
            PG8_LDB(B0, 0, 0); PG8_LDB(B1, 0, 1); PG8_SCHED; PG8_LDA(At, 0, 0); PG8_STAGE1(PG8_SA(1, 1), a1 + hstep, voffA);
            PG8_WAIT_V(7); PG8_WAIT_L(0); PG8_BAR; PG8_MMA(0, 0, At, B0); PG8_MMA(0, 1, At, B1); PG8_BAR; PG8_SCHED;
            PG8_LDA1(At, 0); PG8_STAGE(PG8_SB(0, 0), b2, voffB); PG8_STAGE(PG8_SB(0, 1), b2 + hstep, voffB); PG8_STAGE(PG8_SA(0, 0), a2, voffA);
            PG8_WAIT_V(7); PG8_WAIT_L(0); PG8_BAR; PG8_MMA1(0, At, B0); PG8_MMA1(1, At, B1); PG8_BAR; PG8_SCHED;
            PG8_LDB(B0, 1, 0); PG8_LDB(B1, 1, 1); PG8_SCHED; PG8_LDA(At, 1, 0); PG8_STAGE1(PG8_SA(0, 1), a2 + hstep, voffA);
            PG8_WAIT_V(7); PG8_WAIT_L(0); PG8_BAR; PG8_MMA(0, 0, At, B0); PG8_MMA(0, 1, At, B1); PG8_BAR; PG8_SCHED;
            PG8_LDA1(At, 1); PG8_STAGE(PG8_SB(1, 0), b3, voffB); PG8_STAGE(PG8_SB(1, 1), b3 + hstep, voffB); PG8_STAGE(PG8_SA(1, 0), a3, voffA);
            PG8_WAIT_V(7); PG8_WAIT_L(0); PG8_BAR; PG8_MMA1(0, At, B0); PG8_MMA1(1, At, B1); PG8_BAR; PG8_SCHED;
            } else {
            PG8_LDB(B0, 0, 0); PG8_SCHED; PG8_LDA(At, 0, 0); PG8_STAGE(PG8_SA(1, 1), a1 + hstep, voffA);
            PG8_WAIT_L(8); PG8_BAR; PG8_WAIT_L(0); PG8_MMA(0, 0, At, B0); PG8_BAR; PG8_SCHED;
            PG8_LDB(B1, 0, 1); PG8_STAGE(PG8_SB(0, 0), b2, voffB);
            PG8_BAR; PG8_WAIT_L(0); PG8_MMA(0, 1, At, B1); PG8_BAR;
            PG8_LDA(At, 0, 1); PG8_STAGE(PG8_SA(0, 0), a2, voffA);
            PG8_BAR; PG8_WAIT_L(0); PG8_MMA(1, 0, At, B0); PG8_BAR; PG8_SCHED;
            PG8_STAGE(PG8_SB(0, 1), b2 + hstep, voffB);
            PG8_WAIT_V(6); PG8_BAR; PG8_MMA(1, 1, At, B1); PG8_BAR;
            PG8_LDB(B0, 1, 0); PG8_SCHED; PG8_LDA(At, 1, 0); PG8_STAGE(PG8_SA(0, 1), a2 + hstep, voffA);
            PG8_WAIT_L(8); PG8_BAR; PG8_WAIT_L(0); PG8_MMA(0, 0, At, B0); PG8_BAR; PG8_SCHED;
            PG8_LDB(B1, 1, 1); PG8_STAGE(PG8_SB(1, 0), b3, voffB);
            PG8_BAR; PG8_WAIT_L(0); PG8_MMA(0, 1, At, B1); PG8_BAR;
            PG8_LDA(At, 1, 1); PG8_STAGE(PG8_SA(1, 0), a3, voffA);
            PG8_BAR; PG8_WAIT_L(0); PG8_MMA(1, 0, At, B0); PG8_BAR; PG8_SCHED;
            PG8_STAGE(PG8_SB(1, 1), b3 + hstep, voffB);
            PG8_WAIT_V(6); PG8_BAR; PG8_MMA(1, 1, At, B1); PG8_BAR;
            }
        }
        if constexpr (ALIGN_EPI) { if (wr == 0) PG8_BAR; }
        if constexpr (!Epi::AFTER_DRAIN) { E(acc, cur, wr, wc, fr, fq); S.done(cur); }
        if (!has_next) break;
#pragma unroll
        for (int a = 0; a < 2; ++a)
#pragma unroll
            for (int b = 0; b < 2; ++b)
#pragma unroll
                for (int m = 0; m < 4; ++m)
#pragma unroll
                    for (int n = 0; n < 2; ++n) acc[a][b][m][n] = (f32x4){0.f, 0.f, 0.f, 0.f};
        cur = nxt; cA = nA; cB = nB; ++ui;
        if constexpr (ALIGN_EPI) { if (wr == 1) PG8_BAR; }
    }
    PG8_WAIT_V(0);
    if constexpr (!ALIGN_EPI) { if (wr == 0) PG8_BAR; }
    PG8_BAR;
    if constexpr (Epi::AFTER_DRAIN) { E.fused(acc, cur, wr, wc, fr, fq, lds, wid, lane); S.done(cur); }
#undef PG8_SA
#undef PG8_SB
#undef PG8_STAGE
#undef PG8_LDA
#undef PG8_LDB
#undef PG8_MMA
#undef PG8_STAGE1
#undef PG8_LDA1
#undef PG8_MMA1
#undef PG8_WAIT_V
#undef PG8_WAIT_L
#undef PG8_BAR
#undef PG8_SCHED
}
}
constexpr int D = 1024, MP = 8192, MS = 4096, M = MP + MS, FF = 4096, NL = 4;
constexpr int NWAVES = 8, NTHR = 512;
constexpr size_t MiB = 1u << 20;
constexpr size_t WS_MOD = 1 * MiB;
constexpr size_t WS_W = 2 * MiB;
constexpr size_t WS_X = 94 * MiB;
constexpr size_t WS_H = 142 * MiB;
constexpr size_t WS_R = 166 * MiB;
constexpr size_t WS_CK = 262 * MiB, WS_CV = 266 * MiB, WS_SHW = 270 * MiB, WS_SS = 271 * MiB, WS_END = 272 * MiB;
constexpr size_t MEL = 1u << 20;
constexpr size_t W_QKV = 0, W_O = 6 * MEL, W_PW1 = 8 * MEL, W_PW2 = 12 * MEL, W_UP = 14 * MEL, W_DOWN = 30 * MEL;
constexpr int LDS_BYTES = 163840, LDS_ST = LDS_BYTES - 16, LDS_KC = 112640;

#define LAS __attribute__((address_space(3)))
#define SB0() __builtin_amdgcn_sched_barrier(0)
typedef unsigned short bf16;
typedef float f32x4 __attribute__((ext_vector_type(4)));
typedef float f32x2 __attribute__((ext_vector_type(2)));
typedef unsigned u32x4 __attribute__((ext_vector_type(4)));
typedef unsigned u32x2 __attribute__((ext_vector_type(2)));
typedef short bf16x8 __attribute__((ext_vector_type(8)));
typedef short s16x4 __attribute__((ext_vector_type(4)));
typedef float f32x32 __attribute__((ext_vector_type(32)));

__device__ __forceinline__ unsigned f2bf(float f) { unsigned u = __builtin_bit_cast(unsigned, f); return (u + 0x7fffu + ((u >> 16) & 1u)) >> 16; }
__device__ __forceinline__ unsigned pk2(float lo, float hi) { unsigned r; asm("v_cvt_pk_bf16_f32 %0, %1, %2" : "=v"(r) : "v"(lo), "v"(hi)); return r; }
__device__ __forceinline__ float bflo(unsigned w) { return __builtin_bit_cast(float, w << 16); }
__device__ __forceinline__ float bfhi(unsigned w) { return __builtin_bit_cast(float, w & 0xffff0000u); }
__device__ __forceinline__ float shx(float v, int k, int lane) { return __builtin_bit_cast(float, __builtin_amdgcn_ds_bpermute((lane ^ k) << 2, __builtin_bit_cast(int, v))); }
__device__ __forceinline__ float wave_sum(float v, int lane) {
#pragma unroll
    for (int o = 1; o < 64; o <<= 1) v += shx(v, o, lane);
    return v;
}

template <bool GLU>
__device__ __forceinline__ void transpose_item(const float* W, int K, int N, bf16* WT, LAS float* scr, int item, int lane) {
    const int nblk = N / 32, kb = item / nblk, nb = item % nblk, k0 = 64 * kb, n0 = 32 * nb;
    { float tv[32];
#pragma unroll
      for (int i = 0; i < 32; ++i) tv[i] = __builtin_nontemporal_load(W + (size_t)(k0 + 2 * i + (lane >> 5)) * N + n0 + (lane & 31));
      __builtin_amdgcn_sched_barrier(0);
#pragma unroll
      for (int i = 0; i < 32; ++i) scr[(2 * i + (lane >> 5)) * 33 + (lane & 31)] = tv[i]; }
    asm volatile("s_waitcnt lgkmcnt(0)" ::: "memory");
    int d0 = n0;
    if (GLU) { const int nn = n0 & 1023; d0 = ((nn >> 7) << 8) + (nn & 127) + ((n0 >> 10) << 7); }
    const int c = lane & 7;
#pragma unroll
    for (int j = 0; j < 4; ++j) { const int n = (lane >> 3) + 8 * j; const LAS float* s = scr + (8 * c) * 33 + n;
        u32x4 o; o.x = pk2(s[0 * 33], s[1 * 33]); o.y = pk2(s[2 * 33], s[3 * 33]); o.z = pk2(s[4 * 33], s[5 * 33]); o.w = pk2(s[6 * 33], s[7 * 33]);
        *(u32x4*)(WT + (size_t)(d0 + n) * K + k0 + 8 * c) = o; }
    asm volatile("s_waitcnt lgkmcnt(0)" ::: "memory");
}

struct Ptrs {
    const float *x_prompt, *x_sample, *cache_k, *cache_v, *c, *c_ctx, *norm_g, *w_ada, *b_ada, *w_qkv, *w_o, *rpb, *w_pw1, *w_dw, *b_dw, *ln_g, *ln_b, *w_pw2, *w_up, *w_down, *final_g;
};

__device__ __forceinline__ void p0_phase(const Ptrs& P, unsigned char* ws, LAS unsigned char* lds, int tid, int lane, int wave, int G, int bid) {
    bf16* Wt = (bf16*)(ws + WS_W);
    const int gw = bid * NWAVES + wave, NGW = G * NWAVES;
    LAS float* scr = (LAS float*)(lds + wave * 16384);
    constexpr int NIT = 23552;
    for (int it = gw; it < NIT; it += NGW) {
        if (it < 7168) { const int i = it / 3584; int r = it % 3584;
            if (r < 1536) { transpose_item<false>(P.w_qkv + (size_t)i * D * 3 * D, D, 3 * D, Wt + W_QKV + (size_t)i * 3 * MEL, scr, r, lane); continue; } r -= 1536;
            if (r < 512) { transpose_item<false>(P.w_o + (size_t)i * D * D, D, D, Wt + W_O + (size_t)i * MEL, scr, r, lane); continue; } r -= 512;
            if (r < 1024) { transpose_item<true>(P.w_pw1 + (size_t)i * D * 2 * D, D, 2 * D, Wt + W_PW1 + (size_t)i * 2 * MEL, scr, r, lane); continue; } r -= 1024;
            transpose_item<false>(P.w_pw2 + (size_t)i * D * D, D, D, Wt + W_PW2 + (size_t)i * MEL, scr, r, lane);
        } else { const int l = (it - 7168) / 4096; int r = (it - 7168) % 4096;
            if (r < 2048) transpose_item<false>(P.w_up + (size_t)l * D * FF, D, FF, Wt + W_UP + (size_t)l * 4 * MEL, scr, r, lane);
            else transpose_item<false>(P.w_down + (size_t)l * D * FF, FF, D, Wt + W_DOWN + (size_t)l * 4 * MEL, scr, r - 2048, lane);
        }
    }
    { bf16* CK = (bf16*)(ws + WS_CK); bf16* CV = (bf16*)(ws + WS_CV);
      const int NT = G * NTHR; constexpr int NV = 2 * 4 * 2 * 256 * 1024 / 4;
      for (int v = bid * NTHR + tid; v < NV; v += NT) { const int which = v >= NV / 2; const int e = (which ? v - NV / 2 : v) * 4;
          const f32x4 a = __builtin_nontemporal_load((const f32x4*)((which ? P.cache_v : P.cache_k) + e));
          u32x2 o; o.x = pk2(a[0], a[1]); o.y = pk2(a[2], a[3]);
          *(u32x2*)((which ? CV : CK) + e) = o; } }
    { f32x4* z = (f32x4*)(ws + WS_SS); const int NT = G * NTHR; float zf = 0.f; asm volatile("" : "+v"(zf));
      const f32x4 zz = (f32x4){zf, zf, zf, zf}; for (int v = bid * NTHR + tid; v < 9 * M / 4; v += NT) z[v] = zz; }
    __syncthreads();
    { LAS float* sil = (LAS float*)lds; LAS float* red = (LAS float*)(lds + 20480); float* mod = (float*)(ws + WS_MOD);
      for (int k = tid; k < 5 * 1024; k += NTHR) { const int cc = k >> 10, kk = k & 1023; const float v = cc == 0 ? P.c_ctx[kk] : P.c[(cc - 1) * 1024 + kk]; sil[k] = v / (1.f + __expf(-v)); }
      __syncthreads();
      const int kg = tid >> 4, cl = tid & 15; const bool cact = cl < 12;
      for (int item = bid; item < 512; item += G) { const int l = item >> 7, n0 = (item & 127) * 48;
          const float* W = P.w_ada + (size_t)l * D * 6144 + n0 + 4 * cl;
          f32x4 a[5];
#pragma unroll
          for (int cc = 0; cc < 5; ++cc) a[cc] = (f32x4){0.f, 0.f, 0.f, 0.f};
#pragma unroll 4
          for (int kk = 0; kk < 32; ++kk) { const int k = kg * 32 + kk; f32x4 w = (f32x4){0.f, 0.f, 0.f, 0.f}; if (cact) w = __builtin_nontemporal_load((const f32x4*)(W + (size_t)k * 6144));
#pragma unroll
              for (int cc = 0; cc < 5; ++cc) a[cc] += sil[cc * 1024 + k] * w; }
#pragma unroll
          for (int cc = 0; cc < 5; ++cc) *(LAS f32x4*)(red + (kg * 5 + cc) * 64 + 4 * cl) = a[cc];
          __syncthreads();
          if (tid < 320 && (tid & 63) < 48) { const int cc = tid >> 6, n = tid & 63; float s = 0.f;
#pragma unroll 8
              for (int g = 0; g < 32; ++g) s += red[(g * 5 + cc) * 64 + n];
              mod[(size_t)(l * 5 + cc) * 6144 + n0 + n] = s + P.b_ada[l * 6144 + n0 + n]; }
          __syncthreads();
      } }
}

__device__ __forceinline__ void norm_phase(const float* xp, const float* xs, bf16* H, float* yout, const float* g, const float* shift, const float* scale, int gw, int NGW, int lane) {
    f32x4 gv[4];
#pragma unroll
    for (int j = 0; j < 4; ++j) gv[j] = *(const f32x4*)(g + 4 * (lane + 64 * j));
    for (int m = gw; m < M; m += NGW) {
        const float* xrow = m < MP ? xp + (size_t)m * D : xs + (size_t)(m - MP) * D;
        const int cond = m < MP ? 0 : 1 + ((m - MP) >> 10);
        f32x4 v[4]; float ss = 0.f;
#pragma unroll
        for (int j = 0; j < 4; ++j) { v[j] = *(const f32x4*)(xrow + 4 * (lane + 64 * j)); ss += (v[j][0] * v[j][0] + v[j][1] * v[j][1]) + (v[j][2] * v[j][2] + v[j][3] * v[j][3]); }
        const float r = 1.0f / sqrtf(wave_sum(ss, lane) * (1.f / D) + 1e-6f);
        if (yout) {
#pragma unroll
            for (int j = 0; j < 4; ++j) *(f32x4*)(yout + (size_t)m * D + 4 * (lane + 64 * j)) = v[j] * r * gv[j];
        } else {
#pragma unroll
            for (int j = 0; j < 4; ++j) { const f32x4 sc = *(const f32x4*)(scale + cond * 6144 + 4 * (lane + 64 * j)), sh = *(const f32x4*)(shift + cond * 6144 + 4 * (lane + 64 * j));
                const f32x4 h = (v[j] * r * gv[j]) * (1.f + sc) + sh; u32x2 o; o.x = pk2(h[0], h[1]); o.y = pk2(h[2], h[3]);
                *(u32x2*)(H + (size_t)m * D + 4 * (lane + 64 * j)) = o; }
        }
    }
}

template <class F, int... I> __device__ __forceinline__ void sfor_impl(F&& f, std::integer_sequence<int, I...>) { (f(std::integral_constant<int, I>{}), ...); }
template <int N, class F> __device__ __forceinline__ void sfor(F&& f) { sfor_impl(f, std::make_integer_sequence<int, N>{}); }
__device__ __forceinline__ float dpp_add(float v, int ctrl_b1, int ctrl_4e, int dummy) { return v; }
__device__ __forceinline__ float wave_sum_dpp(float v) {
    v += __builtin_bit_cast(float, __builtin_amdgcn_update_dpp(0, __builtin_bit_cast(int, v), 0xB1, 0xf, 0xf, false));
    v += __builtin_bit_cast(float, __builtin_amdgcn_update_dpp(0, __builtin_bit_cast(int, v), 0x4E, 0xf, 0xf, false));
    v += __builtin_bit_cast(float, __builtin_amdgcn_update_dpp(0, __builtin_bit_cast(int, v), 0x141, 0xf, 0xf, false));
    v += __builtin_bit_cast(float, __builtin_amdgcn_update_dpp(0, __builtin_bit_cast(int, v), 0x140, 0xf, 0xf, false));
    const int vi = __builtin_bit_cast(int, v);
    return (__builtin_bit_cast(float, __builtin_amdgcn_readlane(vi, 0)) + __builtin_bit_cast(float, __builtin_amdgcn_readlane(vi, 16))) +
           (__builtin_bit_cast(float, __builtin_amdgcn_readlane(vi, 32)) + __builtin_bit_cast(float, __builtin_amdgcn_readlane(vi, 48)));
}
constexpr int CT = 16, CROWS = CT + 30, CCS = 16, CCH = (CROWS + CCS - 1) / CCS;
__device__ __forceinline__ void conv_phase(const bf16* U, bf16* Vc, const float* wdw, const float* bdw, const float* lng, const float* lnb, LAS unsigned char* lds, int tid, int lane, int wave, int G, int bid) {
    f32x2 w[31];
    sfor<31>([&](auto K) __attribute__((always_inline)) { constexpr int k = decltype(K)::value; w[k] = *(const f32x2*)(wdw + k * D + 2 * tid); });
    const f32x2 bd = *(const f32x2*)(bdw + 2 * tid), lg = *(const f32x2*)(lng + 2 * tid), lb = *(const f32x2*)(lnb + 2 * tid);
    LAS f32x2* part = (LAS f32x2*)lds;
    LAS f32x2* stats = part + 8 * CT;
    for (int unit = bid; unit < M / CT; unit += G) {
        const int m0 = unit * CT, seg = m0 < MP ? 0 : MP, L = m0 < MP ? 256 : 1024, t0 = (m0 - seg) & (L - 1);
        const bf16* Ub = U + (size_t)(m0 - t0) * D + 2 * tid;
        f32x2 acc[CT];
        sfor<CT>([&](auto O) __attribute__((always_inline)) { acc[decltype(O)::value] = bd; });
        sfor<CCH>([&](auto C) __attribute__((always_inline)) { constexpr int c = decltype(C)::value;
            unsigned raw[CCS];
            sfor<CCS>([&](auto I) __attribute__((always_inline)) { constexpr int i = decltype(I)::value, j = c * CCS + i;
                if constexpr (j < CROWS) { const int t = t0 - 15 + j, tc = min(max(t, 0), L - 1);
                    raw[i] = *(const unsigned*)(Ub + (size_t)tc * D); } });
            SB0();
            sfor<CCS>([&](auto I) __attribute__((always_inline)) { constexpr int i = decltype(I)::value, j = c * CCS + i;
                if constexpr (j < CROWS) { const int t = t0 - 15 + j; const unsigned rm = raw[i] & (unsigned)(-(int)((t >= 0) & (t < L))); const f32x2 u = (f32x2){bflo(rm), bfhi(rm)};
                    sfor<31>([&](auto K) __attribute__((always_inline)) { constexpr int k = decltype(K)::value, o = j - k;
                        if constexpr (o >= 0 && o < CT) acc[o] += u * w[k]; }); } });
        });
        sfor<CT>([&](auto O) __attribute__((always_inline)) { constexpr int o = decltype(O)::value;
            const float s = wave_sum_dpp(acc[o].x + acc[o].y), q = wave_sum_dpp(acc[o].x * acc[o].x + acc[o].y * acc[o].y); if (lane == 0) part[wave * CT + o] = (f32x2){s, q}; });
        __syncthreads();
        if (tid < CT) { float s = 0.f, q = 0.f;
#pragma unroll
            for (int wv = 0; wv < 8; ++wv) { const f32x2 p = part[wv * CT + tid]; s += p.x; q += p.y; }
            const float mean = s * (1.f / D), var = fmaxf(q * (1.f / D) - mean * mean, 0.f); stats[tid] = (f32x2){mean, 1.0f / sqrtf(var + 1e-5f)}; }
        __syncthreads();
        sfor<CT>([&](auto O) __attribute__((always_inline)) { constexpr int o = decltype(O)::value;
            const f32x2 st = stats[o]; f32x2 y = (acc[o] - st.x) * st.y * lg + lb;
            y.x = y.x * __builtin_amdgcn_rcpf(1.f + __expf(-y.x)); y.y = y.y * __builtin_amdgcn_rcpf(1.f + __expf(-y.y));
            *(unsigned*)(Vc + (size_t)(m0 + o) * D + 2 * tid) = pk2(y.x, y.y); });
        __syncthreads();
    }
}

__device__ __forceinline__ void final_norm_phase(const bf16* X, float* yout, const float* g, int gw, int NGW, int lane) {
    f32x4 gv[4];
#pragma unroll
    for (int j = 0; j < 4; ++j) gv[j] = *(const f32x4*)(g + 4 * (lane + 64 * j));
    for (int m = gw; m < M; m += NGW) {
        const bf16* xr = X + (size_t)m * D;
        f32x4 v[4]; float sq = 0.f;
#pragma unroll
        for (int j = 0; j < 4; ++j) { const u32x2 w = *(const u32x2*)(xr + 4 * (lane + 64 * j)); v[j] = (f32x4){bflo(w.x), bfhi(w.x), bflo(w.y), bfhi(w.y)};
            sq += (v[j][0] * v[j][0] + v[j][1] * v[j][1]) + (v[j][2] * v[j][2] + v[j][3] * v[j][3]); }
        const float r = 1.0f / sqrtf(wave_sum_dpp(sq) * (1.f / D) + 1e-6f);
#pragma unroll
        for (int j = 0; j < 4; ++j) __builtin_nontemporal_store(v[j] * r * gv[j], (f32x4*)(yout + (size_t)m * D + 4 * (lane + 64 * j)));
    }
}

__device__ __forceinline__ void prep_phase(const float* xp, const float* xs, bf16* H, float* ss0, const float* g, const float* scale, const float* mod, const bf16* Wt, float* shw, int gw, int NGW, int lane) {
    { f32x4 gv[4];
#pragma unroll
      for (int j = 0; j < 4; ++j) gv[j] = *(const f32x4*)(g + 4 * (lane + 64 * j));
      for (int m = gw; m < M; m += NGW) {
          const float* xrow = m < MP ? xp + (size_t)m * D : xs + (size_t)(m - MP) * D;
          const int cond = m < MP ? 0 : 1 + ((m - MP) >> 10);
          f32x4 v[4]; float sq = 0.f;
#pragma unroll
          for (int j = 0; j < 4; ++j) { v[j] = *(const f32x4*)(xrow + 4 * (lane + 64 * j)); sq += (v[j][0] * v[j][0] + v[j][1] * v[j][1]) + (v[j][2] * v[j][2] + v[j][3] * v[j][3]); }
          sq = wave_sum_dpp(sq); if (lane == 0) ss0[m] = sq;
          f32x4 sc[4];
#pragma unroll
          for (int j = 0; j < 4; ++j) sc[j] = *(const f32x4*)(scale + cond * 6144 + 4 * (lane + 64 * j));
#pragma unroll
          for (int j = 0; j < 4; ++j) { const f32x4 h = v[j] * gv[j] * (1.f + sc[j]); u32x2 o; o.x = pk2(h[0], h[1]); o.y = pk2(h[2], h[3]);
              *(u32x2*)(H + (size_t)m * D + 4 * (lane + 64 * j)) = o; }
      } }
    for (int it = gw; it < 4 * 8192; it += NGW) {
        const int l = it >> 13, which = (it >> 12) & 1, n = it & 4095, i = l >> 1; const bool conv = (l & 1) != 0;
        const int N = which ? 4096 : (conv ? 2048 : 3072);
        if (n >= N) continue;
        const bf16* wrow = Wt + (which ? W_UP + (size_t)l * 4 * MEL : (conv ? W_PW1 + (size_t)i * 2 * MEL : W_QKV + (size_t)i * 3 * MEL)) + (size_t)n * D;
        float wv[16];
#pragma unroll
        for (int jj = 0; jj < 4; ++jj) { const u32x2 w = *(const u32x2*)(wrow + 4 * (lane + 64 * jj)); wv[4 * jj] = bflo(w.x); wv[4 * jj + 1] = bfhi(w.x); wv[4 * jj + 2] = bflo(w.y); wv[4 * jj + 3] = bfhi(w.y); }
#pragma unroll
        for (int cond = 0; cond < 5; ++cond) { const float* sh = mod + (size_t)(l * 5 + cond) * 6144 + (which ? 3 : 0) * 1024; float dot = 0.f;
#pragma unroll
            for (int jj = 0; jj < 4; ++jj) { const f32x4 s4 = *(const f32x4*)(sh + 4 * (lane + 64 * jj)); dot += (s4[0] * wv[4 * jj] + s4[1] * wv[4 * jj + 1]) + (s4[2] * wv[4 * jj + 2] + s4[3] * wv[4 * jj + 3]); }
            dot = wave_sum_dpp(dot); if (lane == 0) shw[(size_t)((l * 2 + which) * 5 + cond) * 4096 + n] = dot; }
    }
}

constexpr float SCL = 0.125f * 1.4426950408889634f, LOG2E = 1.4426950408889634f;
__device__ __forceinline__ void vt_write(LAS bf16* Vt, int pitch, int slot, int chunk, u32x4 v) {
    LAS bf16* p = Vt + (8 * chunk) * pitch + slot;
    p[0] = (bf16)(v.x & 0xffffu); p[pitch] = (bf16)(v.x >> 16); p[2 * pitch] = (bf16)(v.y & 0xffffu); p[3 * pitch] = (bf16)(v.y >> 16);
    p[4 * pitch] = (bf16)(v.z & 0xffffu); p[5 * pitch] = (bf16)(v.z >> 16); p[6 * pitch] = (bf16)(v.w & 0xffffu); p[7 * pitch] = (bf16)(v.w >> 16);
}
template <int NB> __device__ __forceinline__ void softmax_part(f32x4 (&s)[NB], float& mx_out, float& sum_out, int lane, float m_floor = -INFINITY) {
    float mx = m_floor;
#pragma unroll
    for (int b = 0; b < NB; ++b) mx = fmaxf(mx, fmaxf(fmaxf(s[b][0], s[b][1]), fmaxf(s[b][2], s[b][3])));
    mx = fmaxf(mx, shx(mx, 16, lane)); mx = fmaxf(mx, shx(mx, 32, lane));
    float sum = 0.f;
#pragma unroll
    for (int b = 0; b < NB; ++b) {
#pragma unroll
        for (int e = 0; e < 4; ++e) { s[b][e] = __builtin_amdgcn_exp2f(s[b][e] - mx); sum += s[b][e]; } }
    sum += shx(sum, 16, lane); sum += shx(sum, 32, lane);
    mx_out = mx; sum_out = sum;
}
__device__ __forceinline__ bf16x8 pack_p(const f32x4& a, const f32x4& b) {
    u32x4 w; w.x = pk2(a[0], a[1]); w.y = pk2(a[2], a[3]); w.z = pk2(b[0], b[1]); w.w = pk2(b[2], b[3]); return __builtin_bit_cast(bf16x8, w);
}
__device__ __forceinline__ bf16x8 vt_read(const LAS bf16* p0, const LAS bf16* p1) {
    const s16x4 a = *(const LAS s16x4*)p0, b = *(const LAS s16x4*)p1; return (bf16x8){a[0], a[1], a[2], a[3], b[0], b[1], b[2], b[3]};
}
__device__ __forceinline__ f32x4 qk_block(const bf16* kp, const bf16x8& qf0, const bf16x8& qf1) {
    const bf16x8 k0 = *(const bf16x8*)kp, k1 = *(const bf16x8*)(kp + 32);
    f32x4 a = __builtin_amdgcn_mfma_f32_16x16x32_bf16(k0, qf0, (f32x4){0.f, 0.f, 0.f, 0.f}, 0, 0, 0);
    return __builtin_amdgcn_mfma_f32_16x16x32_bf16(k1, qf1, a, 0, 0, 0);
}
#define PV16(o, s, SLOT_EXPR, PITCH_) do { _Pragma("unroll") for (int pp = 0; pp < 8; ++pp) { const bf16x8 pf = pack_p(s[2 * pp], s[2 * pp + 1]); const int slot0 = (SLOT_EXPR); \
        _Pragma("unroll") for (int db = 0; db < 4; ++db) { const LAS bf16* vp = Vt + (16 * db + l15) * (PITCH_) + slot0; \
            o[db] = __builtin_amdgcn_mfma_f32_16x16x32_bf16(vt_read(vp, vp + 16), pf, o[db], 0, 0, 0); } } } while (0)

#ifndef CBN
#define CBN 4
#endif
__device__ __forceinline__ void attn_phase(const bf16* Qb, const bf16* Kb, const bf16* Vb, bf16* Ob, const bf16* CK, const bf16* CV, const float* rpb  ,
                                           int li, LAS unsigned char* lds, int tid, int lane, int wave, int G, int bid, int ulo, int uhi) {
    LAS bf16* Vt = (LAS bf16*)lds; LAS float* rpl = (LAS float*)(lds + 110592); LAS unsigned char* Kc = lds + LDS_KC;
    for (int u = bid + ulo; u < uhi; u += G) {
        int lz_ = lane; asm volatile("" : "+v"(lz_));
        const int l15 = lz_ & 15, g = lz_ >> 4;
        if (u < 512) {
            const int b = u >> 4, h = u & 15; constexpr int PITCH = 264;
            const int qrow0 = b * 256 + 32 * wave + l15;
            const bf16x8 qa0 = *(const bf16x8*)(Qb + (size_t)qrow0 * D + h * 64 + 8 * g), qa1 = *(const bf16x8*)(Qb + (size_t)qrow0 * D + h * 64 + 32 + 8 * g);
            const bf16x8 qb0 = *(const bf16x8*)(Qb + (size_t)(qrow0 + 16) * D + h * 64 + 8 * g), qb1 = *(const bf16x8*)(Qb + (size_t)(qrow0 + 16) * D + h * 64 + 32 + 8 * g);
            SB0();
            { int t2 = tid; asm volatile("" : "+v"(t2));
              const int key = t2 & 255, c0 = (t2 >> 8) * 4; const bf16* src = Vb + (size_t)(b * 256 + key) * D + h * 64 + 8 * c0; const bf16* ksrc = Kb + (size_t)(b * 256 + key) * D + h * 64 + 8 * c0;
              u32x4 v[4], kv[4];
#pragma unroll
              for (int c = 0; c < 4; ++c) { v[c] = *(const u32x4*)(src + 8 * c); kv[c] = *(const u32x4*)(ksrc + 8 * c); }
              SB0();
#pragma unroll
              for (int c = 0; c < 4; ++c) *(LAS u32x4*)(Kc + key * 144 + (c0 + c) * 16) = kv[c];
#pragma unroll
              for (int c = 0; c < 4; ++c) vt_write(Vt, PITCH, key, c0 + c, v[c]); }
            __syncthreads();
            SB0();
            f32x4 s0[16], s1[16];
            { const LAS unsigned char* kl = Kc + l15 * 144 + g * 16;
              sfor<16>([&](auto I) __attribute__((always_inline)) { constexpr int kb = decltype(I)::value;
                const bf16x8 k0 = *(const LAS bf16x8*)(kl + kb * (16 * 144)), k1 = *(const LAS bf16x8*)(kl + kb * (16 * 144) + 64);
                f32x4 a = __builtin_amdgcn_mfma_f32_16x16x32_bf16(k0, qa0, (f32x4){0.f, 0.f, 0.f, 0.f}, 0, 0, 0); s0[kb] = __builtin_amdgcn_mfma_f32_16x16x32_bf16(k1, qa1, a, 0, 0, 0) * SCL;
                f32x4 c = __builtin_amdgcn_mfma_f32_16x16x32_bf16(k0, qb0, (f32x4){0.f, 0.f, 0.f, 0.f}, 0, 0, 0); s1[kb] = __builtin_amdgcn_mfma_f32_16x16x32_bf16(k1, qb1, c, 0, 0, 0) * SCL; }); }
            { float mx, sum; softmax_part<16>(s0, mx, sum, lane);
              f32x4 o[4];
#pragma unroll
              for (int db = 0; db < 4; ++db) o[db] = (f32x4){0.f, 0.f, 0.f, 0.f};
              PV16(o, s0, 32 * pp + 4 * g, PITCH);
              const float rl = 1.0f / sum;
#pragma unroll
              for (int db = 0; db < 4; ++db) { const f32x4 ov = o[db] * rl; u32x2 w; w.x = pk2(ov[0], ov[1]); w.y = pk2(ov[2], ov[3]);
                  *(u32x2*)(Ob + (size_t)qrow0 * D + h * 64 + 16 * db + 4 * g) = w; } }
            { float mx, sum; softmax_part<16>(s1, mx, sum, lane);
              f32x4 o[4];
#pragma unroll
              for (int db = 0; db < 4; ++db) o[db] = (f32x4){0.f, 0.f, 0.f, 0.f};
              PV16(o, s1, 32 * pp + 4 * g, PITCH);
              const float rl = 1.0f / sum;
#pragma unroll
              for (int db = 0; db < 4; ++db) { const f32x4 ov = o[db] * rl; u32x2 w; w.x = pk2(ov[0], ov[1]); w.y = pk2(ov[2], ov[3]);
                  *(u32x2*)(Ob + (size_t)(qrow0 + 16) * D + h * 64 + 16 * db + 4 * g) = w; } }
            __syncthreads();
        } else {
            const int ui = u - 512, xcd = ui & 7, idx = (ui >> 3) & 63, uu = (G == 256) ? ((xcd * 8 + (idx >> 3)) << 3) + (idx & 7) : ui;
            const int b = uu >> 7, h = (uu >> 3) & 15, rp = uu & 7, r0 = 2 * rp; constexpr int PITCH = 840;
            const int rs0 = min(max(r0 - 4, 0), 8);
            const size_t tokb = (size_t)MP + (size_t)b * 1024;
            const int r = r0 + (wave >> 2), j = wave & 3, rs = min(max(r - 4, 0), 8), rrel = rs - rs0, kcs = min(max(16 * j - 8, 0), 32);
            const int qcol = 16 * j + l15, wst = min(max(qcol - 8, 0), 48);
            const size_t qtok = tokb + r * 64 + qcol;
            const bf16* kloc = Kb + (tokb + rs * 64 + kcs + l15) * D + h * 64 + 8 * g;
            bf16x8 kf[16][2];
#define LOAD_KLOC(H) sfor<8>([&](auto I) __attribute__((always_inline)) { constexpr int lb = 8 * (H) + decltype(I)::value; const bf16* kp = kloc + (size_t)((lb >> 1) * 64 + 16 * (lb & 1)) * D; kf[lb][0] = *(const bf16x8*)kp; kf[lb][1] = *(const bf16x8*)(kp + 32); })
            LOAD_KLOC(0);
            const bf16x8 qf0 = *(const bf16x8*)(Qb + qtok * D + h * 64 + 8 * g), qf1 = *(const bf16x8*)(Qb + qtok * D + h * 64 + 32 + 8 * g);
            SB0();
            { int t2 = tid; asm volatile("" : "+v"(t2));
              const int slotA = t2, slotB = t2 + NTHR, slotBc = min(slotB, 831);
              const bf16* srcA = (slotA < 576) ? Vb + (tokb + min(rs0 + (slotA >> 6), 15) * 64 + (slotA & 63)) * D + h * 64 : CV + ((size_t)(b * 2 + li) * 256 + (slotA - 576)) * D + h * 64;
              const bf16* srcB = (slotBc < 576) ? Vb + (tokb + min(rs0 + (slotBc >> 6), 15) * 64 + (slotBc & 63)) * D + h * 64 : CV + ((size_t)(b * 2 + li) * 256 + (slotBc - 576)) * D + h * 64;
              const int key = t2 & 255, c0 = (t2 >> 8) * 4; const bf16* ksrc = CK + ((size_t)(b * 2 + li) * 256 + key) * D + h * 64 + 8 * c0;
              u32x4 va[8], vb[8], kv[4];
#pragma unroll
              for (int c = 0; c < 8; ++c) { va[c] = *(const u32x4*)(srcA + 8 * c); vb[c] = *(const u32x4*)(srcB + 8 * c); }
#pragma unroll
              for (int c = 0; c < 4; ++c) kv[c] = *(const u32x4*)(ksrc + 8 * c);
              const float rv = rpb[h * 465 + min(t2, 464)];
              SB0();
#pragma unroll
              for (int c = 0; c < 8; ++c) vt_write(Vt, PITCH, slotA, c, va[c]);
              if (slotB < 832) {
#pragma unroll
                  for (int c = 0; c < 8; ++c) vt_write(Vt, PITCH, slotB, c, vb[c]); }
#pragma unroll
              for (int c = 0; c < 4; ++c) *(LAS u32x4*)(Kc + key * 144 + (c0 + c) * 16) = kv[c];
              if (t2 < 465) rpl[t2] = rv; }
            SB0(); LOAD_KLOC(1); SB0();
            __syncthreads();
            SB0();
            f32x4 o1[4]; float m1, l1, m2, l2;
#pragma unroll
            for (int db = 0; db < 4; ++db) o1[db] = (f32x4){0.f, 0.f, 0.f, 0.f};
            {
                int dcv[8]; unsigned vmask = 0u;
#pragma unroll
                for (int ce = 0; ce < 8; ++ce) { const int kc = kcs + 16 * (ce >> 2) + 4 * g + (ce & 3); vmask |= ((kc >= wst) && (kc < wst + 16)) ? (1u << ce) : 0u; dcv[ce] = min(max(kc - qcol + 15, 0), 30); }
                f32x4 s[16];
#define QK_LOC(H) sfor<8>([&](auto I) __attribute__((always_inline)) { constexpr int lb = 8 * (H) + decltype(I)::value, krow = lb >> 1, ch = lb & 1; \
                    f32x4 a = __builtin_amdgcn_mfma_f32_16x16x32_bf16(kf[lb][0], qf0, (f32x4){0.f, 0.f, 0.f, 0.f}, 0, 0, 0); a = __builtin_amdgcn_mfma_f32_16x16x32_bf16(kf[lb][1], qf1, a, 0, 0, 0); \
                    const LAS float* rp_row = rpl + (rs + krow - r + 7) * 31; float bias[4]; \
                    _Pragma("unroll") for (int e = 0; e < 4; ++e) bias[e] = rp_row[dcv[ch * 4 + e]]; \
                    _Pragma("unroll") for (int e = 0; e < 4; ++e) { const float t = a[e] * SCL + bias[e] * LOG2E; a[e] = ((vmask >> (ch * 4 + e)) & 1u) ? t : -INFINITY; } \
                    s[lb] = a; })
                QK_LOC(0); QK_LOC(1); SB0();
                softmax_part<16>(s, m1, l1, lane);
                PV16(o1, s, (rrel + pp) * 64 + kcs + 4 * g, PITCH);
            }
            SB0();
            {
                f32x4 s[16];
                { const LAS unsigned char* kl = Kc + l15 * 144 + g * 16;
                  sfor<16>([&](auto I) __attribute__((always_inline)) { constexpr int cb = decltype(I)::value;
                    const bf16x8 k0 = *(const LAS bf16x8*)(kl + cb * (16 * 144)), k1 = *(const LAS bf16x8*)(kl + cb * (16 * 144) + 64);
                    f32x4 a = __builtin_amdgcn_mfma_f32_16x16x32_bf16(k0, qf0, (f32x4){0.f, 0.f, 0.f, 0.f}, 0, 0, 0); s[cb] = __builtin_amdgcn_mfma_f32_16x16x32_bf16(k1, qf1, a, 0, 0, 0) * SCL; }); }
                softmax_part<16>(s, m2, l2, lane, m1);
                const float a1 = __builtin_amdgcn_exp2f(m1 - m2);
#pragma unroll
                for (int db = 0; db < 4; ++db) o1[db] = o1[db] * a1;
                l1 = l1 * a1 + l2;
                PV16(o1, s, 576 + 32 * pp + 4 * g, PITCH);
            }
            const float rl = 1.0f / l1;
            int r2_ = r; asm volatile("" : "+s"(r2_));
            const size_t qtok2 = tokb + r2_ * 64 + qcol;
#pragma unroll
            for (int db = 0; db < 4; ++db) { const f32x4 ov = o1[db] * rl; u32x2 w; w.x = pk2(ov[0], ov[1]); w.y = pk2(ov[2], ov[3]);
                *(u32x2*)(Ob + qtok2 * D + h * 64 + 16 * db + 4 * g) = w; }
            __syncthreads();
        }
    }
}

#define RLX_AGENT __ATOMIC_RELAXED, __HIP_MEMORY_SCOPE_AGENT
#define XB_TMO      128
#define XB_XCNT(j)  (256  + 64 * (j))
#define XB_XSUB(j)  (1280 + 64 * (j))
#define XB_XGEN(j)  (2304 + 64 * (j))
#define XB_TOP      3328
#define XB_TOPGEN   3392
#define XCD_BAR_WORDS 3456
#define XB_SPIN_CAP (1u << 18)

__device__ __forceinline__ unsigned xb_ld(unsigned* p)              { return __hip_atomic_load(p, __ATOMIC_RELAXED, __HIP_MEMORY_SCOPE_AGENT); }
__device__ __forceinline__ unsigned xb_add(unsigned* p, unsigned v) { return __hip_atomic_fetch_add(p, v, __ATOMIC_RELAXED, __HIP_MEMORY_SCOPE_AGENT); }
__device__ __forceinline__ unsigned xb_xcc_id() { return (unsigned)__builtin_amdgcn_s_getreg((3 << 11) | 20) & 0xFu; }
#define XB_SPIN(cond, bar) do { unsigned _sp = 0; while (cond) { __builtin_amdgcn_s_sleep(1); \
    if ((++_sp & 255u) == 0u) { if (xb_ld(&(bar)[XB_TMO])) break; if (_sp > XB_SPIN_CAP) { atomicAdd(&(bar)[XB_TMO], 1u); break; } } } } while (0)

struct XcdBarrier {
    unsigned* bar; unsigned x;
    volatile LAS unsigned* st;
};

__device__ __forceinline__ XcdBarrier xcd_barrier_post(unsigned* bar, volatile LAS unsigned* st) {
    XcdBarrier b; b.bar = bar; b.x = xb_xcc_id(); b.st = st;
    if (threadIdx.x == 0) (void)xb_add(&bar[XB_XCNT(b.x)], 1u);
    return b;
}
__device__ __forceinline__ void xcd_barrier_complete(unsigned* bar, unsigned x, unsigned& nloc, unsigned& nx) {
    const unsigned G = gridDim.x * gridDim.y * gridDim.z;
    unsigned sum, cnt, mine, sp = 0u;
    for (;;) {
        sum = 0u; cnt = 0u; mine = 0u;
#pragma unroll
        for (unsigned j = 0; j < 16; ++j) { const unsigned c = xb_ld(&bar[XB_XCNT(j)]); sum += c; cnt += (c > 0u) ? 1u : 0u; mine = (j == x) ? c : mine; }
        if (sum == G) break;
        __builtin_amdgcn_s_sleep(1);
        if ((++sp & 255u) == 0u) { if (xb_ld(&bar[XB_TMO])) break; if (sp > XB_SPIN_CAP) { atomicAdd(&bar[XB_TMO], 1u); break; } }
    }
    nloc = mine > 0u ? mine : 1u; nx = cnt > 0u ? cnt : 1u;
}

__device__ __forceinline__ void xcd_barrier(const XcdBarrier& b) {
    asm volatile("s_waitcnt vmcnt(0)" ::: "memory");
    __syncthreads();
    if (threadIdx.x == 0) {
        unsigned* bar = b.bar;
        __builtin_amdgcn_s_waitcnt(0);
        unsigned nloc = b.st[0], nx = b.st[1];
        if (nloc == 0u) { xcd_barrier_complete(bar, b.x, nloc, nx); b.st[0] = nloc; b.st[1] = nx; }
        const unsigned old = xb_add(&bar[XB_XSUB(b.x)], 1u);
        const unsigned gen = old / nloc;
        if (old + 1u == (gen + 1u) * nloc) {
            __builtin_amdgcn_fence(__ATOMIC_RELEASE, "agent");
            asm volatile("s_waitcnt vmcnt(0)" ::: "memory");
            const unsigned og = xb_add(&bar[XB_TOP], 1u);
            if (og + 1u == (gen + 1u) * nx) xb_add(&bar[XB_TOPGEN], 1u);
            else XB_SPIN(xb_ld(&bar[XB_TOPGEN]) == gen, bar);
            __builtin_amdgcn_fence(__ATOMIC_ACQUIRE, "agent");
            asm volatile("s_waitcnt vmcnt(0)" ::: "memory");
        } else {
            XB_SPIN(xb_ld(&bar[XB_TOPGEN]) == gen, bar);
            __builtin_amdgcn_fence(__ATOMIC_ACQUIRE, "agent");
            asm volatile("s_waitcnt vmcnt(0)" ::: "memory");
        }
    }
    __syncthreads();
}

constexpr int NPH = 2 + 5 * NL + 1;
struct Args { const float* in[21]; float* out; unsigned char* ws; int nprog, pad; int prog[48]; };
typedef const __attribute__((address_space(4))) Args* KArgPtr;
__global__ void __launch_bounds__(NTHR, 2) fwd_kernel(Args a_unused) {
    extern __shared__ __attribute__((aligned(16))) unsigned char lds_raw[];
    LAS unsigned char* lds = (LAS unsigned char*)lds_raw;
    cg::grid_group grid = cg::this_grid();
    const int wave0 = __builtin_amdgcn_readfirstlane((int)threadIdx.x >> 6);
    { volatile LAS unsigned* st0 = (volatile LAS unsigned*)(lds + LDS_ST); if (threadIdx.x < 2) st0[threadIdx.x] = 0u; }
    __syncthreads();
    XcdBarrier xbar; { KArgPtr kpb = (KArgPtr)__builtin_amdgcn_kernarg_segment_ptr(); xbar.bar = (unsigned*)kpb->ws; xbar.x = 0; xbar.st = (volatile LAS unsigned*)(lds + LDS_ST);
        if (blockIdx.x == 0) { for (int wI = threadIdx.x; wI < XCD_BAR_WORDS; wI += NTHR) __hip_atomic_store(xbar.bar + wI, 0u, __ATOMIC_RELAXED, __HIP_MEMORY_SCOPE_AGENT); } }
    int nprog; { KArgPtr kp0 = (KArgPtr)__builtin_amdgcn_kernarg_segment_ptr(); nprog = kp0->nprog; }
    for (int pc = 0; pc < nprog; ++pc) {
        KArgPtr kp = (KArgPtr)__builtin_amdgcn_kernarg_segment_ptr(); asm volatile("" : "+s"(kp));
        int z_ = 0; asm volatile("" : "+s"(z_));
        const int lane_ = (int)__builtin_amdgcn_mbcnt_hi(~0u, __builtin_amdgcn_mbcnt_lo(~0u, (unsigned)z_)); const int tid_ = wave0 * 64 + lane_;
        int bid_ = (int)__builtin_amdgcn_workgroup_id_x(), G_ = (int)gridDim.x; asm volatile("" : "+s"(bid_), "+s"(G_));
        const int pe_ = kp->prog[pc]; const int ph = pe_ & 63, amode = pe_ >> 6;
        const int tid = tid_, lane = lane_, wave = wave0, G = G_, bid = bid_;
        const int gw = bid * NWAVES + wave, NGW = G * NWAVES;
        Ptrs P; P = Ptrs{kp->in[0], kp->in[1], kp->in[2], kp->in[3], kp->in[4], kp->in[5], kp->in[6], kp->in[7], kp->in[8], kp->in[9], kp->in[10], kp->in[11], kp->in[12], kp->in[13], kp->in[14], kp->in[15], kp->in[16], kp->in[17], kp->in[18], kp->in[19], kp->in[20]};
        unsigned char* ws = kp->ws; float* outp = kp->out;
        float* mod = (float*)(ws + WS_MOD); bf16* Wt = (bf16*)(ws + WS_W); bf16* X = (bf16*)(ws + WS_X); bf16* H = (bf16*)(ws + WS_H);
        bf16* R = (bf16*)(ws + WS_R); bf16* Qb = R; bf16* Kb = R + (size_t)M * D; bf16* Vb = R + (size_t)2 * M * D; bf16* Ob = R + (size_t)3 * M * D;
        bf16* Ub = R; bf16* Vc = R + (size_t)M * D; bf16* Fb = R;
        const bf16* CK = (const bf16*)(ws + WS_CK); const bf16* CV = (const bf16*)(ws + WS_CV);
        float* out_y = outp; float* out_ck = outp + (size_t)M * D; float* out_cv = out_ck + (size_t)32 * 2 * 256 * 1024;
        float* SS = (float*)(ws + WS_SS); float* SHW = (float*)(ws + WS_SHW);
        if (ph == 0) { p0_phase(P, ws, lds, tid, lane, wave, G, bid); }
        else if (ph == 1) { prep_phase(P.x_prompt, P.x_sample, H, SS, P.norm_g, mod + 1 * 1024, mod, Wt, SHW, gw, NGW, lane); }
        else if (ph == NPH - 1) { final_norm_phase(X, out_y, P.final_g, gw, NGW, lane); }
        else if (ph >= 60) { }
        else {
            const int l = (ph - 2) / 5, s = (ph - 2) % 5, i = l >> 1; const bool conv = (l & 1) != 0;
            const float* modl = mod + (size_t)l * 5 * 6144;
            if (s == 0) {
                const float* ssl = SS + (size_t)(2 * l) * M; const float* shl = SHW + (size_t)((2 * l) * 5) * 4096;
                if (!conv) { pg8::Gemm gm{H, Wt + W_QKV + (size_t)i * 3 * MEL, M, 3 * D, D}; pg8::StaticOrder S; S.init(M, 3 * D, G, bid);
                    pg8::EpiQKV E{ssl, shl, Qb, (size_t)M * D, out_ck + (size_t)i * 256 * 1024, (size_t)32 * 2 * 256 * 1024};
                    pg8::gemm_phase<pg8::EpiQKV, pg8::StaticOrder, true, true>(lds, gm, S, E, tid); }
                else { pg8::Gemm gm{H, Wt + W_PW1 + (size_t)i * 2 * MEL, M, 2 * D, D}; pg8::StaticOrder S; S.init(M, 2 * D, G, bid);
                    pg8::EpiGLU E{ssl, shl, Ub};
                    pg8::gemm_phase<pg8::EpiGLU, pg8::StaticOrder, true, true>(lds, gm, S, E, tid); }
            } else if (s == 1) {
                if (!conv) attn_phase(Qb, Kb, Vb, Ob, CK, CV, P.rpb + (size_t)i * 16 * 15 * 31, i, lds, tid, lane, wave, G, bid, amode == 2 ? 512 : 0, amode == 1 ? 512 : 1024);
                else conv_phase(Ub, Vc, P.w_dw + (size_t)i * 31 * D, P.b_dw + i * D, P.ln_g + i * D, P.ln_b + i * D, lds, tid, lane, wave, G, bid);
            } else if (s == 2 || s == 4) {
                pg8::Gemm gm; pg8::EpiRes E;
                if (s == 2) { gm = pg8::Gemm{conv ? Vc : Ob, Wt + (conv ? W_PW2 : W_O) + (size_t)i * MEL, M, D, D};
                    E = pg8::EpiRes{P.x_prompt, P.x_sample, l == 0 ? (const bf16*)nullptr : X, X, modl + 2 * 1024, H, P.norm_g + (l * 2 + 1) * D, modl + 4 * 1024, SS + (size_t)(2 * l + 1) * M}; }
                else { gm = pg8::Gemm{Fb, Wt + W_DOWN + (size_t)l * 4 * MEL, M, D, FF};
                    E = pg8::EpiRes{P.x_prompt, P.x_sample, X, X, modl + 5 * 1024, l < NL - 1 ? H : nullptr, P.norm_g + ((l + 1) * 2) * D, modl + 5 * 6144 + 1 * 1024, SS + (size_t)(2 * l + 2) * M}; }
                pg8::StaticOrder S; S.init(M, D, G, bid);
                pg8::gemm_phase<pg8::EpiRes, pg8::StaticOrder, true, true>(lds, gm, S, E, tid);
            } else {
#ifdef UP256
                pg8::Gemm gm{H, Wt + W_UP + (size_t)l * 4 * MEL, M, FF, D}; pg8::StaticOrder256 S; S.init(M, FF, G, bid);
                pg8::EpiUp256 E{SS + (size_t)(2 * l + 1) * M, SHW + (size_t)((2 * l + 1) * 5) * 4096, Fb, FF};
                pg8::gemm_phase256<pg8::EpiUp256, pg8::StaticOrder256, true, true>(lds, gm, S, E, tid);
#else
                pg8::Gemm gm{H, Wt + W_UP + (size_t)l * 4 * MEL, M, FF, D}; pg8::StaticOrder S; S.init(M, FF, G, bid);
                pg8::EpiUp E{SS + (size_t)(2 * l + 1) * M, SHW + (size_t)((2 * l + 1) * 5) * 4096, Fb, FF};
                pg8::gemm_phase<pg8::EpiUp, pg8::StaticOrder, true, true>(lds, gm, S, E, tid);
#endif
            }
        }
        if (pc + 1 < nprog) { if (pc == 0) { grid.sync(); xbar = xcd_barrier_post(xbar.bar, xbar.st); } else xcd_barrier(xbar); }
    }
}

#ifndef SINGLE_LAUNCH
#define SINGLE_LAUNCH 0
#endif
extern "C" void kernel_launch(void* const* d_in, const int* in_sizes, int n_in, void* d_out, int out_size, void* d_ws, size_t ws_size, hipStream_t stream) {
    static int grid = 0;
    if (grid == 0) {
        if (n_in != 21 || ws_size < WS_END) { fprintf(stderr, "kernel_launch: unexpected n_in %d / ws_size %zu\n", n_in, ws_size); grid = -1; return; }
        int dev = 0, cus = 0, per_cu = 0;
        hipGetDevice(&dev); hipDeviceGetAttribute(&cus, hipDeviceAttributeMultiprocessorCount, dev);
        hipFuncSetAttribute((const void*)fwd_kernel, hipFuncAttributeMaxDynamicSharedMemorySize, LDS_BYTES);
        hipOccupancyMaxActiveBlocksPerMultiprocessor(&per_cu, (const void*)fwd_kernel, NTHR, LDS_BYTES);
        if (per_cu < 1) { fprintf(stderr, "kernel_launch: occupancy query says %d blocks/CU\n", per_cu); per_cu = 1; }
        (void)hipGetLastError();
        grid = cus * per_cu;
    }
    if (grid < 0) return;
    Args a{};
    for (int i = 0; i < 21; ++i) a.in[i] = (const float*)d_in[i];
    a.out = (float*)d_out; a.ws = (unsigned char*)d_ws;
#if SINGLE_LAUNCH
    { int n = 0;
      for (int ph = 0; ph < NPH; ++ph) { a.prog[n++] = ph;
#ifdef PROBE_ATTN_MODE
          if (ph >= 2 && ph < NPH - 1 && (ph - 2) % 5 == 1 && ((ph - 2) / 5) % 2 == 0) a.prog[n++] = ph | (PROBE_ATTN_MODE << 6);
#endif
#ifdef PROBE_EMPTY
          if (ph == 5) for (int q = 0; q < PROBE_EMPTY; ++q) a.prog[n++] = 60;
#endif
#ifdef PROBE_REPEAT_P0
          if (ph == 0) a.prog[n++] = 0;
#endif
#ifdef PROBE_REPEAT_S
          if (ph >= 2 && ph < NPH - 1 && (ph - 2) % 5 == PROBE_REPEAT_S && (PROBE_REPEAT_PAR < 0 || ((ph - 2) / 5) % 2 == PROBE_REPEAT_PAR)) a.prog[n++] = ph;
#endif
      }
      a.nprog = n; }
    void* args[] = {&a};
    hipError_t e = hipLaunchCooperativeKernel((const void*)fwd_kernel, dim3(grid), dim3(NTHR), args, LDS_BYTES, stream);
    if (e != hipSuccess) fprintf(stderr, "cooperative launch failed: %s (grid %d)\n", hipGetErrorString(e), grid);
#else
    for (int ph = 0; ph < NPH; ++ph) { a.nprog = 1; a.prog[0] = ph; hipLaunchKernelGGL(fwd_kernel, dim3(grid), dim3(NTHR), LDS_BYTES, stream, a); }
#endif
}
```

```cpp
#define SINGLE_LAUNCH 1
#define UP256 1
#include <hip/hip_runtime.h>
#include <hip/hip_cooperative_groups.h>
#include <cstdio>
#include <cstdint>
#include <cmath>
#include <utility>
namespace cg = cooperative_groups;
namespace pg8 {
#define PG8_LAS __attribute__((address_space(3)))
typedef unsigned short bf16_t;
typedef short bf16x8 __attribute__((ext_vector_type(8)));
typedef float f32x4 __attribute__((ext_vector_type(4)));
typedef unsigned u32x4 __attribute__((ext_vector_type(4)));
constexpr int RM = 192;
constexpr int BM = 256, BK = 64, HALF = 128, HTB = HALF * BK * 2  , STAGE_BYTES = 8 * HTB, NXCD = 8, WGM = 8;

__host__ __device__ __forceinline__ int lds_byte(int r, int c) { const int st = (r >> 4) * 2 + (c >> 5), rr = r & 15, cc = c & 31, ob = rr * 64 + cc * 2; return st * 1024 + (ob ^ (((ob >> 9) & 1) << 5)); }
__host__ __device__ __forceinline__ void stage_rc(int b, int& R, int& C) { const int st = b / 1024, sb = b % 1024, swz = sb ^ (((sb >> 9) & 1) << 5); R = (st >> 1) * 16 + swz / 64; C = (st & 1) * 32 + (swz % 64) / 2; }
__host__ __device__ __forceinline__ int perm32(int rho) { const int n = rho >> 4, i = rho & 15; return 8 * (i >> 2) + 4 * n + (i & 3); }

struct Unit { int pm, pn; };
struct Gemm { const bf16_t* A; const bf16_t* Bt; int M, N, K; };

struct StaticOrder {
    int nM, nN, nwg, G, c;
    __host__ __device__ void init(int M, int N, int G_, int c_) { nM = M / RM; nN = N / BM; nwg = nM * nN; G = G_; c = c_; }
    __host__ __device__ bool next(int i, Unit& u) const {
        const long L = (long)i * G + c; if (L >= nwg) return false;
        int wgid = (int)L; { const int q = nwg / NXCD, r = nwg % NXCD, xcd = wgid % NXCD, off = wgid / NXCD; wgid = (xcd < r ? xcd * (q + 1) : r * (q + 1) + (xcd - r) * q) + off; }
        const int nig = WGM * nN, gid = wgid / nig, fm = gid * WGM, gsz = (nM - fm) < WGM ? (nM - fm) : WGM;
        u.pm = fm + ((wgid % nig) % gsz); u.pn = (wgid % nig) / gsz; return true;
    }
    __device__ __forceinline__ void a_ready(const Unit&) const {}
    __device__ __forceinline__ void done(const Unit&) const {}
};

__device__ __forceinline__ unsigned cvt_pk_bf16(float lo, float hi) { unsigned r; asm volatile("v_cvt_pk_bf16_f32 %0, %1, %2" : "=v"(r) : "v"(lo), "v"(hi)); return r; }
typedef float f32x2 __attribute__((ext_vector_type(2)));
__device__ __forceinline__ int cond_of_row(int r) { return r < 8192 ? 0 : 1 + ((r - 8192) >> 10); }
__device__ __forceinline__ int half_row0(int ai, int wr) { return ai == 0 ? wr * 64 : 128 + wr * 32; }
#define EPI_MLOOP(ai, m) _Pragma("unroll") for (int m = 0; m < 4; ++m) if (ai == 0 || m < 2)
struct EpiQKV {
    static constexpr bool PERM = true, AFTER_DRAIN = false;
    const float* ss; const float* shw;
    bf16_t* Q; size_t qkv_stride; float* ck; size_t ckv_stride;
    __device__ __forceinline__ void operator()(const f32x4 (&acc)[2][2][4][2], const Unit& u, int wr, int wc, int fr, int fq) const {
        const int t = u.pn >> 2;
        bf16_t* base = Q + (size_t)t * qkv_stride;
        const int col0 = (u.pn & 3) * BM + wc * 32 + 8 * fq;
        float* cbase = ck + (size_t)(t > 0 ? t - 1 : 0) * ckv_stride + col0;
#pragma unroll
        for (int ai = 0; ai < 2; ++ai) { const int rbase = u.pm * RM + half_row0(ai, wr) + fr; const bool wc_ = (t > 0) && (rbase < 8192);
            const float* sp = shw + cond_of_row(rbase) * 4096 + u.pn * BM + wc * 32 + 8 * fq;
            f32x4 sv[2][2];
#pragma unroll
            for (int bj = 0; bj < 2; ++bj) { sv[bj][0] = *(const f32x4*)(sp + bj * HALF); sv[bj][1] = *(const f32x4*)(sp + bj * HALF + 4); }
            float rr[4];
            EPI_MLOOP(ai, m) rr[m] = ss[rbase + m * 16];
            EPI_MLOOP(ai, m) { const int row = rbase + m * 16; bf16_t* rowp = base + (size_t)row * 1024 + col0;
                const float r = __builtin_amdgcn_rsqf(rr[m] * (1.f / 1024.f) + 1e-6f);
                float* cp0 = cbase + ((size_t)(row >> 8) * 2 * 256 + (row & 255)) * 1024;
#pragma unroll
                for (int bj = 0; bj < 2; ++bj) { const f32x4 v0 = acc[ai][bj][m][0] * r + sv[bj][0], v1 = acc[ai][bj][m][1] * r + sv[bj][1];
                    u32x4 w; w.x = cvt_pk_bf16(v0[0], v0[1]); w.y = cvt_pk_bf16(v0[2], v0[3]); w.z = cvt_pk_bf16(v1[0], v1[1]); w.w = cvt_pk_bf16(v1[2], v1[3]);
                    *(u32x4*)(rowp + bj * HALF) = w;
                    if (wc_) { float* cp = cp0 + bj * HALF; __builtin_nontemporal_store(v0, (f32x4*)cp); __builtin_nontemporal_store(v1, (f32x4*)(cp + 4)); } } } }
    }
};
struct EpiUp {
    static constexpr bool PERM = true, AFTER_DRAIN = false;
    const float* ss; const float* shw; bf16_t* O; int ldc;
    __device__ __forceinline__ void operator()(const f32x4 (&acc)[2][2][4][2], const Unit& u, int wr, int wc, int fr, int fq) const {
        const int col0 = u.pn * BM + wc * 32 + 8 * fq;
#pragma unroll
        for (int ai = 0; ai < 2; ++ai) { const int rbase = u.pm * RM + half_row0(ai, wr) + fr;
            const float* sp = shw + cond_of_row(rbase) * 4096 + col0;
            f32x4 sv[2][2];
#pragma unroll
            for (int bj = 0; bj < 2; ++bj) { sv[bj][0] = *(const f32x4*)(sp + bj * HALF); sv[bj][1] = *(const f32x4*)(sp + bj * HALF + 4); }
            float rr[4];
            EPI_MLOOP(ai, m) rr[m] = ss[rbase + m * 16];
            EPI_MLOOP(ai, m) { bf16_t* rowp = O + (size_t)(rbase + m * 16) * ldc + col0;
                const float r = __builtin_amdgcn_rsqf(rr[m] * (1.f / 1024.f) + 1e-6f);
#pragma unroll
                for (int bj = 0; bj < 2; ++bj) { f32x4 v0 = acc[ai][bj][m][0] * r + sv[bj][0], v1 = acc[ai][bj][m][1] * r + sv[bj][1];
#pragma unroll
                    for (int e = 0; e < 4; ++e) { const float a = fmaxf(v0[e], 0.f), b = fmaxf(v1[e], 0.f); v0[e] = a * a; v1[e] = b * b; }
                    u32x4 w; w.x = cvt_pk_bf16(v0[0], v0[1]); w.y = cvt_pk_bf16(v0[2], v0[3]); w.z = cvt_pk_bf16(v1[0], v1[1]); w.w = cvt_pk_bf16(v1[2], v1[3]);
                    *(u32x4*)(rowp + bj * HALF) = w; } } }
    }
};
struct EpiGLU {
    static constexpr bool PERM = true, AFTER_DRAIN = false;
    const float* ss; const float* shw; bf16_t* O;
    __device__ __forceinline__ void operator()(const f32x4 (&acc)[2][2][4][2], const Unit& u, int wr, int wc, int fr, int fq) const {
        const int col0 = u.pn * HALF + wc * 32 + 8 * fq;
#pragma unroll
        for (int ai = 0; ai < 2; ++ai) { const int rbase = u.pm * RM + half_row0(ai, wr) + fr;
            const float* sp = shw + cond_of_row(rbase) * 4096 + u.pn * BM + wc * 32 + 8 * fq;
            f32x4 sv[2][2];
#pragma unroll
            for (int bj = 0; bj < 2; ++bj) { sv[bj][0] = *(const f32x4*)(sp + bj * HALF); sv[bj][1] = *(const f32x4*)(sp + bj * HALF + 4); }
            float rr[4];
            EPI_MLOOP(ai, m) rr[m] = ss[rbase + m * 16];
            EPI_MLOOP(ai, m) { bf16_t* rowp = O + (size_t)(rbase + m * 16) * 1024 + col0;
                const float r = __builtin_amdgcn_rsqf(rr[m] * (1.f / 1024.f) + 1e-6f);
                f32x4 v0 = acc[ai][0][m][0] * r + sv[0][0], v1 = acc[ai][0][m][1] * r + sv[0][1]; const f32x4 g0 = acc[ai][1][m][0] * r + sv[1][0], g1 = acc[ai][1][m][1] * r + sv[1][1];
#pragma unroll
                for (int e = 0; e < 4; ++e) { v0[e] = v0[e] * __builtin_amdgcn_rcpf(1.f + __expf(-g0[e])); v1[e] = v1[e] * __builtin_amdgcn_rcpf(1.f + __expf(-g1[e])); }
                u32x4 w; w.x = cvt_pk_bf16(v0[0], v0[1]); w.y = cvt_pk_bf16(v0[2], v0[3]); w.z = cvt_pk_bf16(v1[0], v1[1]); w.w = cvt_pk_bf16(v1[2], v1[3]);
                *(u32x4*)rowp = w; } }
    }
};
struct EpiRes {
    static constexpr bool PERM = true, AFTER_DRAIN = false;
    const float* base_p; const float* base_s; const bf16_t* base_b; bf16_t* out; const float* gate;
    bf16_t* xb; const float* g_next; const float* sc_next; float* ss_next;
    __device__ __forceinline__ void operator()(const f32x4 (&acc)[2][2][4][2], const Unit& u, int wr, int wc, int fr, int fq) const {
        const int col0 = u.pn * BM + wc * 32 + 8 * fq;
        const int lane_x = fq * 16 + fr;
#pragma unroll
        for (int ai = 0; ai < 2; ++ai) { const int row0 = u.pm * RM + half_row0(ai, wr) + fr; const int cond = cond_of_row(row0);
            const float* gp = gate + cond * 6144 + col0;
            const float* bp = (row0 < 8192) ? base_p + (size_t)row0 * 1024 + col0 : base_s + (size_t)(row0 - 8192) * 1024 + col0;
            const bf16_t* bb = base_b + (size_t)row0 * 1024 + col0;
            bf16_t* op = out + (size_t)row0 * 1024 + col0;
            f32x4 gv[2][2], gs[2][2];
#pragma unroll
            for (int bj = 0; bj < 2; ++bj)
#pragma unroll
                for (int n = 0; n < 2; ++n) gv[bj][n] = *(const f32x4*)(gp + bj * HALF + n * 4);
            if (xb) { f32x4 ga[2][2], sa[2][2];
#pragma unroll
                for (int bj = 0; bj < 2; ++bj)
#pragma unroll
                    for (int n = 0; n < 2; ++n) { ga[bj][n] = *(const f32x4*)(g_next + col0 + bj * HALF + n * 4); sa[bj][n] = *(const f32x4*)(sc_next + cond * 6144 + col0 + bj * HALF + n * 4); }
#pragma unroll
                for (int bj = 0; bj < 2; ++bj)
#pragma unroll
                    for (int n = 0; n < 2; ++n) gs[bj][n] = ga[bj][n] * (1.f + sa[bj][n]); }
#pragma unroll
            for (int mp = 0; mp < 2; ++mp) if (ai == 0 || mp == 0) { f32x4 bs[2][2][2];
                if (base_b) {
#pragma unroll
                    for (int mm = 0; mm < 2; ++mm)
#pragma unroll
                        for (int bj = 0; bj < 2; ++bj) { const u32x4 w = *(const u32x4*)(bb + (size_t)((2 * mp + mm) * 16) * 1024 + bj * HALF);
                            bs[mm][bj][0] = (f32x4){__builtin_bit_cast(float, w.x << 16), __builtin_bit_cast(float, w.x & 0xffff0000u), __builtin_bit_cast(float, w.y << 16), __builtin_bit_cast(float, w.y & 0xffff0000u)};
                            bs[mm][bj][1] = (f32x4){__builtin_bit_cast(float, w.z << 16), __builtin_bit_cast(float, w.z & 0xffff0000u), __builtin_bit_cast(float, w.w << 16), __builtin_bit_cast(float, w.w & 0xffff0000u)}; }
                } else {
#pragma unroll
                    for (int mm = 0; mm < 2; ++mm)
#pragma unroll
                        for (int bj = 0; bj < 2; ++bj)
#pragma unroll
                            for (int n = 0; n < 2; ++n) bs[mm][bj][n] = *(const f32x4*)(bp + (size_t)((2 * mp + mm) * 16) * 1024 + bj * HALF + n * 4);
                }
#pragma unroll
                for (int mm = 0; mm < 2; ++mm) { float sq = 0.f;
#pragma unroll
                    for (int bj = 0; bj < 2; ++bj) { const f32x4 x0 = bs[mm][bj][0] + gv[bj][0] * acc[ai][bj][2 * mp + mm][0], x1 = bs[mm][bj][1] + gv[bj][1] * acc[ai][bj][2 * mp + mm][1];
                        { u32x4 w; w.x = cvt_pk_bf16(x0[0], x0[1]); w.y = cvt_pk_bf16(x0[2], x0[3]); w.z = cvt_pk_bf16(x1[0], x1[1]); w.w = cvt_pk_bf16(x1[2], x1[3]); *(u32x4*)(op + (size_t)((2 * mp + mm) * 16) * 1024 + bj * HALF) = w; }
                        if (xb) { const f32x4 h0 = x0 * gs[bj][0], h1 = x1 * gs[bj][1]; u32x4 w; w.x = cvt_pk_bf16(h0[0], h0[1]); w.y = cvt_pk_bf16(h0[2], h0[3]); w.z = cvt_pk_bf16(h1[0], h1[1]); w.w = cvt_pk_bf16(h1[2], h1[3]);
                            *(u32x4*)(xb + (size_t)(row0 + (2 * mp + mm) * 16) * 1024 + col0 + bj * HALF) = w;
                            sq += ((x0[0] * x0[0] + x0[1] * x0[1]) + (x0[2] * x0[2] + x0[3] * x0[3])) + ((x1[0] * x1[0] + x1[1] * x1[1]) + (x1[2] * x1[2] + x1[3] * x1[3])); } }
                    if (xb) {
                        sq += __builtin_bit_cast(float, __builtin_amdgcn_ds_bpermute((lane_x ^ 16) << 2, __builtin_bit_cast(int, sq)));
                        sq += __builtin_bit_cast(float, __builtin_amdgcn_ds_bpermute((lane_x ^ 32) << 2, __builtin_bit_cast(int, sq)));
                        if (fq == 0) atomicAdd(ss_next + row0 + (2 * mp + mm) * 16, sq); } }
                asm volatile("" ::: "memory"); } }
    }
};

struct StaticOrder256 {
    int nM, nN, nwg, G, c;
    __host__ __device__ void init(int M, int N, int G_, int c_) { nM = M / BM; nN = N / BM; nwg = nM * nN; G = G_; c = c_; }
    __host__ __device__ bool next(int i, Unit& u) const {
        const long L = (long)i * G + c; if (L >= nwg) return false;
        int wgid = (int)L; { const int q = nwg / NXCD, r = nwg % NXCD, xcd = wgid % NXCD, off = wgid / NXCD; wgid = (xcd < r ? xcd * (q + 1) : r * (q + 1) + (xcd - r) * q) + off; }
        const int nig = WGM * nN, gid = wgid / nig, fm = gid * WGM, gsz = (nM - fm) < WGM ? (nM - fm) : WGM;
        u.pm = fm + ((wgid % nig) % gsz); u.pn = (wgid % nig) / gsz; return true;
    }
    __device__ __forceinline__ void a_ready(const Unit&) const {}
    __device__ __forceinline__ void done(const Unit&) const {}
};
struct EpiUp256 {
    static constexpr bool PERM = true, AFTER_DRAIN = false;
    const float* ss; const float* shw; bf16_t* O; int ldc;
    __device__ __forceinline__ void operator()(const f32x4 (&acc)[2][2][4][2], const Unit& u, int wr, int wc, int fr, int fq) const {
        const int col0 = u.pn * BM + wc * 32 + 8 * fq;
        f32x4 sv[2][2][2]; float rr[2][4];
#pragma unroll
        for (int ai = 0; ai < 2; ++ai) { const int rbase = u.pm * BM + ai * HALF + wr * 64 + fr; const float* sp = shw + cond_of_row(rbase) * 4096 + col0;
#pragma unroll
            for (int bj = 0; bj < 2; ++bj) { sv[ai][bj][0] = *(const f32x4*)(sp + bj * HALF); sv[ai][bj][1] = *(const f32x4*)(sp + bj * HALF + 4); }
#pragma unroll
            for (int m = 0; m < 4; ++m) rr[ai][m] = ss[rbase + m * 16]; }
        __builtin_amdgcn_sched_barrier(0);
#pragma unroll
        for (int ai = 0; ai < 2; ++ai) { const int rbase = u.pm * BM + ai * HALF + wr * 64 + fr;
#pragma unroll
            for (int m = 0; m < 4; ++m) { bf16_t* rowp = O + (size_t)(rbase + m * 16) * ldc + col0;
                const float r = __builtin_amdgcn_rsqf(rr[ai][m] * (1.f / 1024.f) + 1e-6f);
#pragma unroll
                for (int bj = 0; bj < 2; ++bj) { f32x4 v0 = acc[ai][bj][m][0] * r + sv[ai][bj][0], v1 = acc[ai][bj][m][1] * r + sv[ai][bj][1];
#pragma unroll
                    for (int e = 0; e < 4; ++e) { const float a = fmaxf(v0[e], 0.f), b = fmaxf(v1[e], 0.f); v0[e] = a * a; v1[e] = b * b; }
                    u32x4 w; w.x = cvt_pk_bf16(v0[0], v0[1]); w.y = cvt_pk_bf16(v0[2], v0[3]); w.z = cvt_pk_bf16(v1[0], v1[1]); w.w = cvt_pk_bf16(v1[2], v1[3]);
                    *(u32x4*)(rowp + bj * HALF) = w; } } }
    }
};
template <class Epi, class Sched, bool ALIGN_EPI = false, bool SP2 = false>
__device__ __forceinline__ void gemm_phase256(PG8_LAS unsigned char* lds, const Gemm g, const Sched& S, const Epi& E, const int tid) {
    const int wid = __builtin_amdgcn_readfirstlane(tid >> 6), lane = tid & 63, wr = wid >> 2, wc = wid & 3, fr = lane & 15, fq = lane >> 4;
    const int K = g.K, nt = K / BK;
    unsigned voffA[2], voffB[2];
#pragma unroll
    for (int i = 0; i < 2; ++i) { int R, C; stage_rc(tid * 16 + i * 8192, R, C); const int Rb = Epi::PERM ? ((R & ~31) + perm32(R & 31)) : R;
        voffA[i] = (unsigned)(R * K + C) * 2u; voffB[i] = (unsigned)(Rb * K + C) * 2u; }
    const size_t kstep = (size_t)(BK * 2);
    const size_t hstep = (size_t)HALF * K * 2;
    const size_t tstep = 2 * hstep;
    const unsigned ldsw = (unsigned)wid * 1024u;
    const int aoff = lds_byte(wr * 64 + fr, fq * 8), boff = lds_byte(wc * 32 + fr, fq * 8);
#define PG8_SA(b, h) (((b) * 2 + (h)) * HTB)
#define PG8_SB(b, h) ((4 + (b) * 2 + (h)) * HTB)
#define PG8_STAGE(bufoff, gbase, voff) do { _Pragma("unroll") for (int _i = 0; _i < 2; ++_i) \
        __builtin_amdgcn_global_load_lds((const unsigned*)((const char*)(gbase) + (voff)[_i]), (PG8_LAS unsigned*)(lds + (bufoff) + ldsw + _i * 8192), 16, 0, 0); } while (0)
#define PG8_LDA(dst, b, h) do { _Pragma("unroll") for (int m = 0; m < 4; ++m) _Pragma("unroll") for (int k = 0; k < 2; ++k) dst[m][k] = *(const PG8_LAS bf16x8*)(lds + PG8_SA(b, h) + aoff + m * 2048 + k * 1024); } while (0)
#define PG8_LDB(dst, b, h) do { _Pragma("unroll") for (int n = 0; n < 2; ++n) _Pragma("unroll") for (int k = 0; k < 2; ++k) dst[n][k] = *(const PG8_LAS bf16x8*)(lds + PG8_SB(b, h) + boff + n * 2048 + k * 1024); } while (0)
#define PG8_MMA(ai, bj, At, Bt) do { __builtin_amdgcn_s_setprio(1); _Pragma("unroll") for (int m = 0; m < 4; ++m) _Pragma("unroll") for (int n = 0; n < 2; ++n) _Pragma("unroll") for (int k = 0; k < 2; ++k) \
        acc[ai][bj][m][n] = __builtin_amdgcn_mfma_f32_16x16x32_bf16(Bt[n][k], At[m][k], acc[ai][bj][m][n], 0, 0, 0); __builtin_amdgcn_s_setprio(0); } while (0)
#define PG8_WAIT_V(n) asm volatile("s_waitcnt vmcnt(" #n ")" ::: "memory")
#define PG8_WAIT_L(n) asm volatile("s_waitcnt lgkmcnt(" #n ")" ::: "memory")
#define PG8_BAR __builtin_amdgcn_s_barrier()
#define PG8_SCHED __builtin_amdgcn_sched_barrier(0)
    Unit cur, nxt; int ui = 0;
    if (!S.next(0, cur)) return;
    f32x4 acc[2][2][4][2];
#pragma unroll
    for (int a = 0; a < 2; ++a)
#pragma unroll
        for (int b = 0; b < 2; ++b)
#pragma unroll
            for (int m = 0; m < 4; ++m)
#pragma unroll
                for (int n = 0; n < 2; ++n) acc[a][b][m][n] = (f32x4){0.f, 0.f, 0.f, 0.f};
    bf16x8 At[4][2], B0[2][2], B1[2][2];
    const char* cA = (const char*)g.A + (size_t)cur.pm * tstep; const char* cB = (const char*)g.Bt + (size_t)cur.pn * tstep;
    S.a_ready(cur);
    if constexpr (SP2) {
        PG8_STAGE(PG8_SB(0, 0), cB, voffB); PG8_STAGE(PG8_SB(0, 1), cB + hstep, voffB); PG8_STAGE(PG8_SA(0, 0), cA, voffA); PG8_STAGE(PG8_SA(0, 1), cA + hstep, voffA);
        if (wr == 1) PG8_BAR;
        PG8_WAIT_V(2); PG8_BAR;
        PG8_STAGE(PG8_SB(1, 0), cB + kstep, voffB); PG8_STAGE(PG8_SA(1, 0), cA + kstep, voffA); PG8_STAGE(PG8_SB(1, 1), cB + hstep + kstep, voffB);
        PG8_WAIT_V(6); PG8_BAR;
    } else {
        PG8_STAGE(PG8_SB(0, 0), cB, voffB); PG8_STAGE(PG8_SA(0, 0), cA, voffA); PG8_STAGE(PG8_SB(0, 1), cB + hstep, voffB); PG8_STAGE(PG8_SA(0, 1), cA + hstep, voffA);
        if (wr == 1) PG8_BAR;
        PG8_WAIT_V(4); PG8_BAR;
        PG8_STAGE(PG8_SB(1, 0), cB + kstep, voffB); PG8_STAGE(PG8_SA(1, 0), cA + kstep, voffA); PG8_STAGE(PG8_SB(1, 1), cB + hstep + kstep, voffB);
        PG8_WAIT_V(6); PG8_BAR;
    }
    for (;;) {
        const bool has_next = S.next(ui + 1, nxt);
        const char* nA = has_next ? (const char*)g.A + (size_t)nxt.pm * tstep : cA; const char* nB = has_next ? (const char*)g.Bt + (size_t)nxt.pn * tstep : cB;
        for (int t = 0; t < nt; t += 2) {
            const bool last = (t == nt - 2);
            const char* a1 = cA + (size_t)(t + 1) * kstep;
            const char* a2 = last ? nA : cA + (size_t)(t + 2) * kstep; const char* b2 = last ? nB : cB + (size_t)(t + 2) * kstep;
            const char* a3 = a2 + kstep; const char* b3 = b2 + kstep;
            if (last && has_next) S.a_ready(nxt);
            if constexpr (SP2) {
            PG8_LDB(B0, 0, 0); PG8_LDB(B1, 0, 1); PG8_SCHED; PG8_LDA(At, 0, 0); PG8_STAGE(PG8_SA(1, 1), a1 + hstep, voffA);
            PG8_WAIT_V(8); PG8_WAIT_L(0); PG8_BAR; PG8_MMA(0, 0, At, B0); PG8_MMA(0, 1, At, B1); PG8_BAR; PG8_SCHED;
            PG8_LDA(At, 0, 1); PG8_STAGE(PG8_SB(0, 0), b2, voffB); PG8_STAGE(PG8_SB(0, 1), b2 + hstep, voffB); PG8_STAGE(PG8_SA(0, 0), a2, voffA);
            PG8_WAIT_V(8); PG8_WAIT_L(0); PG8_BAR; PG8_MMA(1, 0, At, B0); PG8_MMA(1, 1, At, B1); PG8_BAR; PG8_SCHED;
            PG8_LDB(B0, 1, 0); PG8_LDB(B1, 1, 1); PG8_SCHED; PG8_LDA(At, 1, 0); PG8_STAGE(PG8_SA(0, 1), a2 + hstep, voffA);
            PG8_WAIT_V(8); PG8_WAIT_L(0); PG8_BAR; PG8_MMA(0, 0, At, B0); PG8_MMA(0, 1, At, B1); PG8_BAR; PG8_SCHED;
            PG8_LDA(At, 1, 1); PG8_STAGE(PG8_SB(1, 0), b3, voffB); PG8_STAGE(PG8_SB(1, 1), b3 + hstep, voffB); PG8_STAGE(PG8_SA(1, 0), a3, voffA);
            PG8_WAIT_V(8); PG8_WAIT_L(0); PG8_BAR; PG8_MMA(1, 0, At, B0); PG8_MMA(1, 1, At, B1); PG8_BAR; PG8_SCHED;
            } else {
            PG8_LDB(B0, 0, 0); PG8_SCHED; PG8_LDA(At, 0, 0); PG8_STAGE(PG8_SA(1, 1), a1 + hstep, voffA);
            PG8_WAIT_L(8); PG8_BAR; PG8_WAIT_L(0); PG8_MMA(0, 0, At, B0); PG8_BAR; PG8_SCHED;
            PG8_LDB(B1, 0, 1); PG8_STAGE(PG8_SB(0, 0), b2, voffB);
            PG8_BAR; PG8_WAIT_L(0); PG8_MMA(0, 1, At, B1); PG8_BAR;
            PG8_LDA(At, 0, 1); PG8_STAGE(PG8_SA(0, 0), a2, voffA);
            PG8_BAR; PG8_WAIT_L(0); PG8_MMA(1, 0, At, B0); PG8_BAR; PG8_SCHED;
            PG8_STAGE(PG8_SB(0, 1), b2 + hstep, voffB);
            PG8_WAIT_V(6); PG8_BAR; PG8_MMA(1, 1, At, B1); PG8_BAR;
            PG8_LDB(B0, 1, 0); PG8_SCHED; PG8_LDA(At, 1, 0); PG8_STAGE(PG8_SA(0, 1), a2 + hstep, voffA);
            PG8_WAIT_L(8); PG8_BAR; PG8_WAIT_L(0); PG8_MMA(0, 0, At, B0); PG8_BAR; PG8_SCHED;
            PG8_LDB(B1, 1, 1); PG8_STAGE(PG8_SB(1, 0), b3, voffB);
            PG8_BAR; PG8_WAIT_L(0); PG8_MMA(0, 1, At, B1); PG8_BAR;
            PG8_LDA(At, 1, 1); PG8_STAGE(PG8_SA(1, 0), a3, voffA);
            PG8_BAR; PG8_WAIT_L(0); PG8_MMA(1, 0, At, B0); PG8_BAR; PG8_SCHED;
            PG8_STAGE(PG8_SB(1, 1), b3 + hstep, voffB);
            PG8_WAIT_V(6); PG8_BAR; PG8_MMA(1, 1, At, B1); PG8_BAR;
            }
        }
        if constexpr (ALIGN_EPI) { if (wr == 0) PG8_BAR; }
        if constexpr (!Epi::AFTER_DRAIN) { E(acc, cur, wr, wc, fr, fq); S.done(cur); }
        if (!has_next) break;
#pragma unroll
        for (int a = 0; a < 2; ++a)
#pragma unroll
            for (int b = 0; b < 2; ++b)
#pragma unroll
                for (int m = 0; m < 4; ++m)
#pragma unroll
                    for (int n = 0; n < 2; ++n) acc[a][b][m][n] = (f32x4){0.f, 0.f, 0.f, 0.f};
        cur = nxt; cA = nA; cB = nB; ++ui;
        if constexpr (ALIGN_EPI) { if (wr == 1) PG8_BAR; }
    }
    PG8_WAIT_V(0);
    if constexpr (!ALIGN_EPI) { if (wr == 0) PG8_BAR; }
    PG8_BAR;
    if constexpr (Epi::AFTER_DRAIN) { E.fused(acc, cur, wr, wc, fr, fq, lds, wid, lane); S.done(cur); }
#undef PG8_SA
#undef PG8_SB
#undef PG8_STAGE
#undef PG8_LDA
#undef PG8_LDB
#undef PG8_MMA
#undef PG8_WAIT_V
#undef PG8_WAIT_L
#undef PG8_BAR
#undef PG8_SCHED
}
template <class Epi, class Sched, bool ALIGN_EPI = false, bool SP2 = false>
__device__ __forceinline__ void gemm_phase(PG8_LAS unsigned char* lds, const Gemm g, const Sched& S, const Epi& E, const int tid) {
    static_assert(SP2, "the 192-row tile form exists for the SP2 loop only");
    const int wid = __builtin_amdgcn_readfirstlane(tid >> 6), lane = tid & 63, wr = wid >> 2, wc = wid & 3, fr = lane & 15, fq = lane >> 4;
    const int K = g.K, nt = K / BK;
    unsigned voffA[2], voffB[2];
#pragma unroll
    for (int i = 0; i < 2; ++i) { int R, C; stage_rc(tid * 16 + i * 8192, R, C); const int Rb = Epi::PERM ? ((R & ~31) + perm32(R & 31)) : R;
        voffA[i] = (unsigned)(R * K + C) * 2u; voffB[i] = (unsigned)(Rb * K + C) * 2u; }
    const size_t kstep = (size_t)(BK * 2);
    const size_t hstep = (size_t)HALF * K * 2;
    const size_t tstepA = (size_t)RM * K * 2;
    const size_t tstep = 2 * hstep;
    const unsigned ldsw = (unsigned)wid * 1024u;
    const int aoff = lds_byte(wr * 64 + fr, fq * 8), boff = lds_byte(wc * 32 + fr, fq * 8);
#define PG8_SA(b, h) (((b) * 2 + (h)) * HTB)
#define PG8_SB(b, h) ((4 + (b) * 2 + (h)) * HTB)
#define PG8_STAGE(bufoff, gbase, voff) do { _Pragma("unroll") for (int _i = 0; _i < 2; ++_i) \
        __builtin_amdgcn_global_load_lds((const unsigned*)((const char*)(gbase) + (voff)[_i]), (PG8_LAS unsigned*)(lds + (bufoff) + ldsw + _i * 8192), 16, 0, 0); } while (0)
#define PG8_LDA(dst, b, h) do { _Pragma("unroll") for (int m = 0; m < 4; ++m) _Pragma("unroll") for (int k = 0; k < 2; ++k) dst[m][k] = *(const PG8_LAS bf16x8*)(lds + PG8_SA(b, h) + aoff + m * 2048 + k * 1024); } while (0)
#define PG8_LDB(dst, b, h) do { _Pragma("unroll") for (int n = 0; n < 2; ++n) _Pragma("unroll") for (int k = 0; k < 2; ++k) dst[n][k] = *(const PG8_LAS bf16x8*)(lds + PG8_SB(b, h) + boff + n * 2048 + k * 1024); } while (0)
#define PG8_MMA(ai, bj, At, Bt) do { __builtin_amdgcn_s_setprio(1); _Pragma("unroll") for (int m = 0; m < 4; ++m) _Pragma("unroll") for (int n = 0; n < 2; ++n) _Pragma("unroll") for (int k = 0; k < 2; ++k) \
        acc[ai][bj][m][n] = __builtin_amdgcn_mfma_f32_16x16x32_bf16(Bt[n][k], At[m][k], acc[ai][bj][m][n], 0, 0, 0); __builtin_amdgcn_s_setprio(0); } while (0)
    const int aoff1 = lds_byte(wr * 32 + fr, fq * 8);
#define PG8_STAGE1(bufoff, gbase, voff) __builtin_amdgcn_global_load_lds((const unsigned*)((const char*)(gbase) + (voff)[0]), (PG8_LAS unsigned*)(lds + (bufoff) + ldsw), 16, 0, 0)
#define PG8_LDA1(dst, b) do { _Pragma("unroll") for (int m = 0; m < 2; ++m) _Pragma("unroll") for (int k = 0; k < 2; ++k) dst[m][k] = *(const PG8_LAS bf16x8*)(lds + PG8_SA(b, 1) + aoff1 + m * 2048 + k * 1024); } while (0)
#define PG8_MMA1(bj, At, Bt) do { __builtin_amdgcn_s_setprio(1); _Pragma("unroll") for (int m = 0; m < 2; ++m) _Pragma("unroll") for (int n = 0; n < 2; ++n) _Pragma("unroll") for (int k = 0; k < 2; ++k) \
        acc[1][bj][m][n] = __builtin_amdgcn_mfma_f32_16x16x32_bf16(Bt[n][k], At[m][k], acc[1][bj][m][n], 0, 0, 0); __builtin_amdgcn_s_setprio(0); } while (0)
#define PG8_WAIT_V(n) asm volatile("s_waitcnt vmcnt(" #n ")" ::: "memory")
#define PG8_WAIT_L(n) asm volatile("s_waitcnt lgkmcnt(" #n ")" ::: "memory")
#define PG8_BAR __builtin_amdgcn_s_barrier()
#define PG8_SCHED __builtin_amdgcn_sched_barrier(0)
    Unit cur, nxt; int ui = 0;
    if (!S.next(0, cur)) return;
    f32x4 acc[2][2][4][2];
#pragma unroll
    for (int a = 0; a < 2; ++a)
#pragma unroll
        for (int b = 0; b < 2; ++b)
#pragma unroll
            for (int m = 0; m < 4; ++m)
#pragma unroll
                for (int n = 0; n < 2; ++n) acc[a][b][m][n] = (f32x4){0.f, 0.f, 0.f, 0.f};
    bf16x8 At[4][2], B0[2][2], B1[2][2];
    const char* cA = (const char*)g.A + (size_t)cur.pm * tstepA; const char* cB = (const char*)g.Bt + (size_t)cur.pn * tstep;
    S.a_ready(cur);
    if constexpr (SP2) {
        PG8_STAGE(PG8_SB(0, 0), cB, voffB); PG8_STAGE(PG8_SB(0, 1), cB + hstep, voffB); PG8_STAGE(PG8_SA(0, 0), cA, voffA); PG8_STAGE1(PG8_SA(0, 1), cA + hstep, voffA);
        if (wr == 1) PG8_BAR;
        PG8_WAIT_V(1); PG8_BAR;
        PG8_STAGE(PG8_SB(1, 0), cB + kstep, voffB); PG8_STAGE(PG8_SA(1, 0), cA + kstep, voffA); PG8_STAGE(PG8_SB(1, 1), cB + hstep + kstep, voffB);
        PG8_WAIT_V(6); PG8_BAR;
    } else {
        PG8_STAGE(PG8_SB(0, 0), cB, voffB); PG8_STAGE(PG8_SA(0, 0), cA, voffA); PG8_STAGE(PG8_SB(0, 1), cB + hstep, voffB); PG8_STAGE(PG8_SA(0, 1), cA + hstep, voffA);
        if (wr == 1) PG8_BAR;
        PG8_WAIT_V(4); PG8_BAR;
        PG8_STAGE(PG8_SB(1, 0), cB + kstep, voffB); PG8_STAGE(PG8_SA(1, 0), cA + kstep, voffA); PG8_STAGE(PG8_SB(1, 1), cB + hstep + kstep, voffB);
        PG8_WAIT_V(6); PG8_BAR;
    }
    for (;;) {
        const bool has_next = S.next(ui + 1, nxt);
        const char* nA = has_next ? (const char*)g.A + (size_t)nxt.pm * tstepA : cA; const char* nB = has_next ? (const char*)g.Bt + (size_t)nxt.pn * tstep : cB;
        for (int t = 0; t < nt; t += 2) {
            const bool last = (t == nt - 2);
            const char* a1 = cA + (size_t)(t + 1) * kstep;
            const char* a2 = last ? nA : cA + (size_t)(t + 2) * kstep; const char* b2 = last ? nB : cB + (size_t)(t + 2) * kstep;
            const char* a3 = a2 + kstep; const char* b3 = b2 + kstep;
            if (last && has_next) S.a_ready(nxt);
            if constexpr (SP2) {
            PG8_LDB(B0, 0, 0); PG8_LDB(B1, 0, 1); PG8_SCHED; PG8_LDA(At, 0, 0); PG8_STAGE1(PG8_SA(1, 1), a1 + hstep, voffA);
            PG8_WAIT_V(7); PG8_WAIT_L(0); PG8_BAR; PG8_MMA(0, 0, At, B0); PG8_MMA(0, 1, At, B1); PG8_BAR; PG8_SCHED;
            PG8_LDA1(At, 0); PG8_STAGE(PG8_SB(0, 0), b2, voffB); PG8_STAGE(PG8_SB(0, 1), b2 + hstep, voffB); PG8_STAGE(PG8_SA(0, 0), a2, voffA);
            PG8_WAIT_V(7); PG8_WAIT_L(0); PG8_BAR; PG8_MMA1(0, At, B0); PG8_MMA1(1, At, B1); PG8_BAR; PG8_SCHED;
            PG8_LDB(B0, 1, 0); PG8_LDB(B1, 1, 1); PG8_SCHED; PG8_LDA(At, 1, 0); PG8_STAGE1(PG8_SA(0, 1), a2 + hstep, voffA);
            PG8_WAIT_V(7); PG8_WAIT_L(0); PG8_BAR; PG8_MMA(0, 0, At, B0); PG8_MMA(0, 1, At, B1); PG8_BAR; PG8_SCHED;
            PG8_LDA1(At, 1); PG8_STAGE(PG8_SB(1, 0), b3, voffB); PG8_STAGE(PG8_SB(1, 1), b3 + hstep, voffB); PG8_STAGE(PG8_SA(1, 0), a3, voffA);
            PG8_WAIT_V(7); PG8_WAIT_L(0); PG8_BAR; PG8_MMA1(0, At, B0); PG8_MMA1(1, At, B1); PG8_BAR; PG8_SCHED;
            } else {
            PG8_LDB(B0, 0, 0); PG8_SCHED; PG8_LDA(At, 0, 0); PG8_STAGE(PG8_SA(1, 1), a1 + hstep, voffA);
            PG8_WAIT_L(8); PG8_BAR; PG8_WAIT_L(0); PG8_MMA(0, 0, At, B0); PG8_BAR; PG8_SCHED;
            PG8_LDB(B1, 0, 1); PG8_STAGE(PG8_SB(0, 0), b2, voffB);
            PG8_BAR; PG8_WAIT_L(0); PG8_MMA(0, 1, At, B1); PG8_BAR;
            PG8_LDA(At, 0, 1); PG8_STAGE(PG8_SA(0, 0), a2, voffA);
            PG8_BAR; PG8_WAIT_L(0); PG8_MMA(1, 0, At, B0); PG8_BAR; PG8_SCHED;
            PG8_STAGE(PG8_SB(0, 1), b2 + hstep, voffB);
            PG8_WAIT_V(6); PG8_BAR; PG8_MMA(1, 1, At, B1); PG8_BAR;
            PG8_LDB(B0, 1, 0); PG8_SCHED; PG8_LDA(At, 1, 0); PG8_STAGE(PG8_SA(0, 1), a2 + hstep, voffA);
            PG8_WAIT_L(8); PG8_BAR; PG8_WAIT_L(0); PG8_MMA(0, 0, At, B0); PG8_BAR; PG8_SCHED;
            PG8_LDB(B1, 1, 1); PG8_STAGE(PG8_SB(1, 0), b3, voffB);
            PG8_BAR; PG8_WAIT_L(0); PG8_MMA(0, 1, At, B1); PG8_BAR;
            PG8_LDA(At, 1, 1); PG8_STAGE(PG8_SA(1, 0), a3, voffA);
            PG8_BAR; PG8_WAIT_L(0); PG8_MMA(1, 0, At, B0); PG8_BAR; PG8_SCHED;
            PG8_STAGE(PG8_SB(1, 1), b3 + hstep, voffB);
            PG8_WAIT_V(6); PG8_BAR; PG8_MMA(1, 1, At, B1); PG8_BAR;
            }
        }
        if constexpr (ALIGN_EPI) { if (wr == 0) PG8_BAR; }
        if constexpr (!Epi::AFTER_DRAIN) { E(acc, cur, wr, wc, fr, fq); S.done(cur); }
        if (!has_next) break;
#pragma unroll
        for (int a = 0; a < 2; ++a)
#pragma unroll
            for (int b = 0; b < 2; ++b)
#pragma unroll
                for (int m = 0; m < 4; ++m)
#pragma unroll
                    for (int n = 0; n < 2; ++n) acc[a][b][m][n] = (f32x4){0.f, 0.f, 0.f, 0.f};
        cur = nxt; cA = nA; cB = nB; ++ui;
        if constexpr (ALIGN_EPI) { if (wr == 1) PG8_BAR; }
    }
    PG8_WAIT_V(0);
    if constexpr (!ALIGN_EPI) { if (wr == 0) PG8_BAR; }
    PG8_BAR;
    if constexpr (Epi::AFTER_DRAIN) { E.fused(acc, cur, wr, wc, fr, fq, lds, wid, lane); S.done(cur); }
#undef PG8_SA
#undef PG8_SB
#undef PG8_STAGE
#undef PG8_LDA
#undef PG8_LDB
#undef PG8_MMA
#undef PG8_STAGE1
#undef PG8_LDA1
#undef PG8_MMA1
#undef PG8_WAIT_V
#undef PG8_WAIT_L
#undef PG8_BAR
#undef PG8_SCHED
}
}
constexpr int D = 1024, MP = 8192, MS = 4096, M = MP + MS, FF = 4096, NL = 4;
constexpr int NWAVES = 8, NTHR = 512;
constexpr size_t MiB = 1u << 20;
constexpr size_t WS_MOD = 1 * MiB;
constexpr size_t WS_W = 2 * MiB;
constexpr size_t WS_X = 94 * MiB;
constexpr size_t WS_H = 142 * MiB;
constexpr size_t WS_R = 166 * MiB;
constexpr size_t WS_CK = 262 * MiB, WS_CV = 266 * MiB, WS_SHW = 270 * MiB, WS_SS = 271 * MiB, WS_END = 272 * MiB;
constexpr size_t MEL = 1u << 20;
constexpr size_t W_QKV = 0, W_O = 6 * MEL, W_PW1 = 8 * MEL, W_PW2 = 12 * MEL, W_UP = 14 * MEL, W_DOWN = 30 * MEL;
constexpr int LDS_BYTES = 163840, LDS_ST = LDS_BYTES - 16, LDS_KC = 112640;

#define LAS __attribute__((address_space(3)))
#define SB0() __builtin_amdgcn_sched_barrier(0)
typedef unsigned short bf16;
typedef float f32x4 __attribute__((ext_vector_type(4)));
typedef float f32x2 __attribute__((ext_vector_type(2)));
typedef unsigned u32x4 __attribute__((ext_vector_type(4)));
typedef unsigned u32x2 __attribute__((ext_vector_type(2)));
typedef short bf16x8 __attribute__((ext_vector_type(8)));
typedef short s16x4 __attribute__((ext_vector_type(4)));
typedef float f32x32 __attribute__((ext_vector_type(32)));

__device__ __forceinline__ unsigned f2bf(float f) { unsigned u = __builtin_bit_cast(unsigned, f); return (u + 0x7fffu + ((u >> 16) & 1u)) >> 16; }
__device__ __forceinline__ unsigned pk2(float lo, float hi) { unsigned r; asm("v_cvt_pk_bf16_f32 %0, %1, %2" : "=v"(r) : "v"(lo), "v"(hi)); return r; }
__device__ __forceinline__ float bflo(unsigned w) { return __builtin_bit_cast(float, w << 16); }
__device__ __forceinline__ float bfhi(unsigned w) { return __builtin_bit_cast(float, w & 0xffff0000u); }
__device__ __forceinline__ float shx(float v, int k, int lane) { return __builtin_bit_cast(float, __builtin_amdgcn_ds_bpermute((lane ^ k) << 2, __builtin_bit_cast(int, v))); }
__device__ __forceinline__ float wave_sum(float v, int lane) {
#pragma unroll
    for (int o = 1; o < 64; o <<= 1) v += shx(v, o, lane);
    return v;
}

template <bool GLU>
__device__ __forceinline__ void transpose_item(const float* W, int K, int N, bf16* WT, LAS float* scr, int item, int lane) {
    const int nblk = N / 32, kb = item / nblk, nb = item % nblk, k0 = 64 * kb, n0 = 32 * nb;
    { float tv[32];
#pragma unroll
      for (int i = 0; i < 32; ++i) tv[i] = __builtin_nontemporal_load(W + (size_t)(k0 + 2 * i + (lane >> 5)) * N + n0 + (lane & 31));
      __builtin_amdgcn_sched_barrier(0);
#pragma unroll
      for (int i = 0; i < 32; ++i) scr[(2 * i + (lane >> 5)) * 33 + (lane & 31)] = tv[i]; }
    asm volatile("s_waitcnt lgkmcnt(0)" ::: "memory");
    int d0 = n0;
    if (GLU) { const int nn = n0 & 1023; d0 = ((nn >> 7) << 8) + (nn & 127) + ((n0 >> 10) << 7); }
    const int c = lane & 7;
#pragma unroll
    for (int j = 0; j < 4; ++j) { const int n = (lane >> 3) + 8 * j; const LAS float* s = scr + (8 * c) * 33 + n;
        u32x4 o; o.x = pk2(s[0 * 33], s[1 * 33]); o.y = pk2(s[2 * 33], s[3 * 33]); o.z = pk2(s[4 * 33], s[5 * 33]); o.w = pk2(s[6 * 33], s[7 * 33]);
        *(u32x4*)(WT + (size_t)(d0 + n) * K + k0 + 8 * c) = o; }
    asm volatile("s_waitcnt lgkmcnt(0)" ::: "memory");
}

struct Ptrs {
    const float *x_prompt, *x_sample, *cache_k, *cache_v, *c, *c_ctx, *norm_g, *w_ada, *b_ada, *w_qkv, *w_o, *rpb, *w_pw1, *w_dw, *b_dw, *ln_g, *ln_b, *w_pw2, *w_up, *w_down, *final_g;
};

__device__ __forceinline__ void p0_phase(const Ptrs& P, unsigned char* ws, LAS unsigned char* lds, int tid, int lane, int wave, int G, int bid) {
    bf16* Wt = (bf16*)(ws + WS_W);
    const int gw = bid * NWAVES + wave, NGW = G * NWAVES;
    LAS float* scr = (LAS float*)(lds + wave * 16384);
    constexpr int NIT = 23552;
    for (int it = gw; it < NIT; it += NGW) {
        if (it < 7168) { const int i = it / 3584; int r = it % 3584;
            if (r < 1536) { transpose_item<false>(P.w_qkv + (size_t)i * D * 3 * D, D, 3 * D, Wt + W_QKV + (size_t)i * 3 * MEL, scr, r, lane); continue; } r -= 1536;
            if (r < 512) { transpose_item<false>(P.w_o + (size_t)i * D * D, D, D, Wt + W_O + (size_t)i * MEL, scr, r, lane); continue; } r -= 512;
            if (r < 1024) { transpose_item<true>(P.w_pw1 + (size_t)i * D * 2 * D, D, 2 * D, Wt + W_PW1 + (size_t)i * 2 * MEL, scr, r, lane); continue; } r -= 1024;
            transpose_item<false>(P.w_pw2 + (size_t)i * D * D, D, D, Wt + W_PW2 + (size_t)i * MEL, scr, r, lane);
        } else { const int l = (it - 7168) / 4096; int r = (it - 7168) % 4096;
            if (r < 2048) transpose_item<false>(P.w_up + (size_t)l * D * FF, D, FF, Wt + W_UP + (size_t)l * 4 * MEL, scr, r, lane);
            else transpose_item<false>(P.w_down + (size_t)l * D * FF, FF, D, Wt + W_DOWN + (size_t)l * 4 * MEL, scr, r - 2048, lane);
        }
    }
    { bf16* CK = (bf16*)(ws + WS_CK); bf16* CV = (bf16*)(ws + WS_CV);
      const int NT = G * NTHR; constexpr int NV = 2 * 4 * 2 * 256 * 1024 / 4;
      for (int v = bid * NTHR + tid; v < NV; v += NT) { const int which = v >= NV / 2; const int e = (which ? v - NV / 2 : v) * 4;
          const f32x4 a = __builtin_nontemporal_load((const f32x4*)((which ? P.cache_v : P.cache_k) + e));
          u32x2 o; o.x = pk2(a[0], a[1]); o.y = pk2(a[2], a[3]);
          *(u32x2*)((which ? CV : CK) + e) = o; } }
    { f32x4* z = (f32x4*)(ws + WS_SS); const int NT = G * NTHR; float zf = 0.f; asm volatile("" : "+v"(zf));
      const f32x4 zz = (f32x4){zf, zf, zf, zf}; for (int v = bid * NTHR + tid; v < 9 * M / 4; v += NT) z[v] = zz; }
    __syncthreads();
    { LAS float* sil = (LAS float*)lds; LAS float* red = (LAS float*)(lds + 20480); float* mod = (float*)(ws + WS_MOD);
      for (int k = tid; k < 5 * 1024; k += NTHR) { const int cc = k >> 10, kk = k & 1023; const float v = cc == 0 ? P.c_ctx[kk] : P.c[(cc - 1) * 1024 + kk]; sil[k] = v / (1.f + __expf(-v)); }
      __syncthreads();
      const int kg = tid >> 4, cl = tid & 15; const bool cact = cl < 12;
      for (int item = bid; item < 512; item += G) { const int l = item >> 7, n0 = (item & 127) * 48;
          const float* W = P.w_ada + (size_t)l * D * 6144 + n0 + 4 * cl;
          f32x4 a[5];
#pragma unroll
          for (int cc = 0; cc < 5; ++cc) a[cc] = (f32x4){0.f, 0.f, 0.f, 0.f};
#pragma unroll 4
          for (int kk = 0; kk < 32; ++kk) { const int k = kg * 32 + kk; f32x4 w = (f32x4){0.f, 0.f, 0.f, 0.f}; if (cact) w = __builtin_nontemporal_load((const f32x4*)(W + (size_t)k * 6144));
#pragma unroll
              for (int cc = 0; cc < 5; ++cc) a[cc] += sil[cc * 1024 + k] * w; }
#pragma unroll
          for (int cc = 0; cc < 5; ++cc) *(LAS f32x4*)(red + (kg * 5 + cc) * 64 + 4 * cl) = a[cc];
          __syncthreads();
          if (tid < 320 && (tid & 63) < 48) { const int cc = tid >> 6, n = tid & 63; float s = 0.f;
#pragma unroll 8
              for (int g = 0; g < 32; ++g) s += red[(g * 5 + cc) * 64 + n];
              mod[(size_t)(l * 5 + cc) * 6144 + n0 + n] = s + P.b_ada[l * 6144 + n0 + n]; }
          __syncthreads();
      } }
}

__device__ __forceinline__ void norm_phase(const float* xp, const float* xs, bf16* H, float* yout, const float* g, const float* shift, const float* scale, int gw, int NGW, int lane) {
    f32x4 gv[4];
#pragma unroll
    for (int j = 0; j < 4; ++j) gv[j] = *(const f32x4*)(g + 4 * (lane + 64 * j));
    for (int m = gw; m < M; m += NGW) {
        const float* xrow = m < MP ? xp + (size_t)m * D : xs + (size_t)(m - MP) * D;
        const int cond = m < MP ? 0 : 1 + ((m - MP) >> 10);
        f32x4 v[4]; float ss = 0.f;
#pragma unroll
        for (int j = 0; j < 4; ++j) { v[j] = *(const f32x4*)(xrow + 4 * (lane + 64 * j)); ss += (v[j][0] * v[j][0] + v[j][1] * v[j][1]) + (v[j][2] * v[j][2] + v[j][3] * v[j][3]); }
        const float r = 1.0f / sqrtf(wave_sum(ss, lane) * (1.f / D) + 1e-6f);
        if (yout) {
#pragma unroll
            for (int j = 0; j < 4; ++j) *(f32x4*)(yout + (size_t)m * D + 4 * (lane + 64 * j)) = v[j] * r * gv[j];
        } else {
#pragma unroll
            for (int j = 0; j < 4; ++j) { const f32x4 sc = *(const f32x4*)(scale + cond * 6144 + 4 * (lane + 64 * j)), sh = *(const f32x4*)(shift + cond * 6144 + 4 * (lane + 64 * j));
                const f32x4 h = (v[j] * r * gv[j]) * (1.f + sc) + sh; u32x2 o; o.x = pk2(h[0], h[1]); o.y = pk2(h[2], h[3]);
                *(u32x2*)(H + (size_t)m * D + 4 * (lane + 64 * j)) = o; }
        }
    }
}

template <class F, int... I> __device__ __forceinline__ void sfor_impl(F&& f, std::integer_sequence<int, I...>) { (f(std::integral_constant<int, I>{}), ...); }
template <int N, class F> __device__ __forceinline__ void sfor(F&& f) { sfor_impl(f, std::make_integer_sequence<int, N>{}); }
__device__ __forceinline__ float dpp_add(float v, int ctrl_b1, int ctrl_4e, int dummy) { return v; }
__device__ __forceinline__ float wave_sum_dpp(float v) {
    v += __builtin_bit_cast(float, __builtin_amdgcn_update_dpp(0, __builtin_bit_cast(int, v), 0xB1, 0xf, 0xf, false));
    v += __builtin_bit_cast(float, __builtin_amdgcn_update_dpp(0, __builtin_bit_cast(int, v), 0x4E, 0xf, 0xf, false));
    v += __builtin_bit_cast(float, __builtin_amdgcn_update_dpp(0, __builtin_bit_cast(int, v), 0x141, 0xf, 0xf, false));
    v += __builtin_bit_cast(float, __builtin_amdgcn_update_dpp(0, __builtin_bit_cast(int, v), 0x140, 0xf, 0xf, false));
    const int vi = __builtin_bit_cast(int, v);
    return (__builtin_bit_cast(float, __builtin_amdgcn_readlane(vi, 0)) + __builtin_bit_cast(float, __builtin_amdgcn_readlane(vi, 16))) +
           (__builtin_bit_cast(float, __builtin_amdgcn_readlane(vi, 32)) + __builtin_bit_cast(float, __builtin_amdgcn_readlane(vi, 48)));
}
constexpr int CT = 16, CROWS = CT + 30, CCS = 16, CCH = (CROWS + CCS - 1) / CCS;
__device__ __forceinline__ void conv_phase(const bf16* U, bf16* Vc, const float* wdw, const float* bdw, const float* lng, const float* lnb, LAS unsigned char* lds, int tid, int lane, int wave, int G, int bid) {
    f32x2 w[31];
    sfor<31>([&](auto K) __attribute__((always_inline)) { constexpr int k = decltype(K)::value; w[k] = *(const f32x2*)(wdw + k * D + 2 * tid); });
    const f32x2 bd = *(const f32x2*)(bdw + 2 * tid), lg = *(const f32x2*)(lng + 2 * tid), lb = *(const f32x2*)(lnb + 2 * tid);
    LAS f32x2* part = (LAS f32x2*)lds;
    LAS f32x2* stats = part + 8 * CT;
    for (int unit = bid; unit < M / CT; unit += G) {
        const int m0 = unit * CT, seg = m0 < MP ? 0 : MP, L = m0 < MP ? 256 : 1024, t0 = (m0 - seg) & (L - 1);
        const bf16* Ub = U + (size_t)(m0 - t0) * D + 2 * tid;
        f32x2 acc[CT];
        sfor<CT>([&](auto O) __attribute__((always_inline)) { acc[decltype(O)::value] = bd; });
        sfor<CCH>([&](auto C) __attribute__((always_inline)) { constexpr int c = decltype(C)::value;
            unsigned raw[CCS];
            sfor<CCS>([&](auto I) __attribute__((always_inline)) { constexpr int i = decltype(I)::value, j = c * CCS + i;
                if constexpr (j < CROWS) { const int t = t0 - 15 + j, tc = min(max(t, 0), L - 1);
                    raw[i] = *(const unsigned*)(Ub + (size_t)tc * D); } });
            SB0();
            sfor<CCS>([&](auto I) __attribute__((always_inline)) { constexpr int i = decltype(I)::value, j = c * CCS + i;
                if constexpr (j < CROWS) { const int t = t0 - 15 + j; const unsigned rm = raw[i] & (unsigned)(-(int)((t >= 0) & (t < L))); const f32x2 u = (f32x2){bflo(rm), bfhi(rm)};
                    sfor<31>([&](auto K) __attribute__((always_inline)) { constexpr int k = decltype(K)::value, o = j - k;
                        if constexpr (o >= 0 && o < CT) acc[o] += u * w[k]; }); } });
        });
        sfor<CT>([&](auto O) __attribute__((always_inline)) { constexpr int o = decltype(O)::value;
            const float s = wave_sum_dpp(acc[o].x + acc[o].y), q = wave_sum_dpp(acc[o].x * acc[o].x + acc[o].y * acc[o].y); if (lane == 0) part[wave * CT + o] = (f32x2){s, q}; });
        __syncthreads();
        if (tid < CT) { float s = 0.f, q = 0.f;
#pragma unroll
            for (int wv = 0; wv < 8; ++wv) { const f32x2 p = part[wv * CT + tid]; s += p.x; q += p.y; }
            const float mean = s * (1.f / D), var = fmaxf(q * (1.f / D) - mean * mean, 0.f); stats[tid] = (f32x2){mean, 1.0f / sqrtf(var + 1e-5f)}; }
        __syncthreads();
        sfor<CT>([&](auto O) __attribute__((always_inline)) { constexpr int o = decltype(O)::value;
            const f32x2 st = stats[o]; f32x2 y = (acc[o] - st.x) * st.y * lg + lb;
            y.x = y.x * __builtin_amdgcn_rcpf(1.f + __expf(-y.x)); y.y = y.y * __builtin_amdgcn_rcpf(1.f + __expf(-y.y));
            *(unsigned*)(Vc + (size_t)(m0 + o) * D + 2 * tid) = pk2(y.x, y.y); });
        __syncthreads();
    }
}

__device__ __forceinline__ void final_norm_phase(const bf16* X, float* yout, const float* g, int gw, int NGW, int lane) {
    f32x4 gv[4];
#pragma unroll
    for (int j = 0; j < 4; ++j) gv[j] = *(const f32x4*)(g + 4 * (lane + 64 * j));
    for (int m = gw; m < M; m += NGW) {
        const bf16* xr = X + (size_t)m * D;
        f32x4 v[4]; float sq = 0.f;
#pragma unroll
        for (int j = 0; j < 4; ++j) { const u32x2 w = *(const u32x2*)(xr + 4 * (lane + 64 * j)); v[j] = (f32x4){bflo(w.x), bfhi(w.x), bflo(w.y), bfhi(w.y)};
            sq += (v[j][0] * v[j][0] + v[j][1] * v[j][1]) + (v[j][2] * v[j][2] + v[j][3] * v[j][3]); }
        const float r = 1.0f / sqrtf(wave_sum_dpp(sq) * (1.f / D) + 1e-6f);
#pragma unroll
        for (int j = 0; j < 4; ++j) __builtin_nontemporal_store(v[j] * r * gv[j], (f32x4*)(yout + (size_t)m * D + 4 * (lane + 64 * j)));
    }
}

__device__ __forceinline__ void prep_phase(const float* xp, const float* xs, bf16* H, float* ss0, const float* g, const float* scale, const float* mod, const bf16* Wt, float* shw, int gw, int NGW, int lane) {
    { f32x4 gv[4];
#pragma unroll
      for (int j = 0; j < 4; ++j) gv[j] = *(const f32x4*)(g + 4 * (lane + 64 * j));
      for (int m = gw; m < M; m += NGW) {
          const float* xrow = m < MP ? xp + (size_t)m * D : xs + (size_t)(m - MP) * D;
          const int cond = m < MP ? 0 : 1 + ((m - MP) >> 10);
          f32x4 v[4]; float sq = 0.f;
#pragma unroll
          for (int j = 0; j < 4; ++j) { v[j] = *(const f32x4*)(xrow + 4 * (lane + 64 * j)); sq += (v[j][0] * v[j][0] + v[j][1] * v[j][1]) + (v[j][2] * v[j][2] + v[j][3] * v[j][3]); }
          sq = wave_sum_dpp(sq); if (lane == 0) ss0[m] = sq;
          f32x4 sc[4];
#pragma unroll
          for (int j = 0; j < 4; ++j) sc[j] = *(const f32x4*)(scale + cond * 6144 + 4 * (lane + 64 * j));
#pragma unroll
          for (int j = 0; j < 4; ++j) { const f32x4 h = v[j] * gv[j] * (1.f + sc[j]); u32x2 o; o.x = pk2(h[0], h[1]); o.y = pk2(h[2], h[3]);
              *(u32x2*)(H + (size_t)m * D + 4 * (lane + 64 * j)) = o; }
      } }
    for (int it = gw; it < 4 * 8192; it += NGW) {
        const int l = it >> 13, which = (it >> 12) & 1, n = it & 4095, i = l >> 1; const bool conv = (l & 1) != 0;
        const int N = which ? 4096 : (conv ? 2048 : 3072);
        if (n >= N) continue;
        const bf16* wrow = Wt + (which ? W_UP + (size_t)l * 4 * MEL : (conv ? W_PW1 + (size_t)i * 2 * MEL : W_QKV + (size_t)i * 3 * MEL)) + (size_t)n * D;
        float wv[16];
#pragma unroll
        for (int jj = 0; jj < 4; ++jj) { const u32x2 w = *(const u32x2*)(wrow + 4 * (lane + 64 * jj)); wv[4 * jj] = bflo(w.x); wv[4 * jj + 1] = bfhi(w.x); wv[4 * jj + 2] = bflo(w.y); wv[4 * jj + 3] = bfhi(w.y); }
#pragma unroll
        for (int cond = 0; cond < 5; ++cond) { const float* sh = mod + (size_t)(l * 5 + cond) * 6144 + (which ? 3 : 0) * 1024; float dot = 0.f;
#pragma unroll
            for (int jj = 0; jj < 4; ++jj) { const f32x4 s4 = *(const f32x4*)(sh + 4 * (lane + 64 * jj)); dot += (s4[0] * wv[4 * jj] + s4[1] * wv[4 * jj + 1]) + (s4[2] * wv[4 * jj + 2] + s4[3] * wv[4 * jj + 3]); }
            dot = wave_sum_dpp(dot); if (lane == 0) shw[(size_t)((l * 2 + which) * 5 + cond) * 4096 + n] = dot; }
    }
}

constexpr float SCL = 0.125f * 1.4426950408889634f, LOG2E = 1.4426950408889634f;
__device__ __forceinline__ void vt_write(LAS bf16* Vt, int pitch, int slot, int chunk, u32x4 v) {
    LAS bf16* p = Vt + (8 * chunk) * pitch + (slot ^ (chunk << 2));
    p[0] = (bf16)(v.x & 0xffffu); p[pitch] = (bf16)(v.x >> 16); p[2 * pitch] = (bf16)(v.y & 0xffffu); p[3 * pitch] = (bf16)(v.y >> 16);
    p[4 * pitch] = (bf16)(v.z & 0xffffu); p[5 * pitch] = (bf16)(v.z >> 16); p[6 * pitch] = (bf16)(v.w & 0xffffu); p[7 * pitch] = (bf16)(v.w >> 16);
}
template <int NB> __device__ __forceinline__ void softmax_part(f32x4 (&s)[NB], float& mx_out, float& sum_out, int lane, float m_floor = -INFINITY) {
    float mx = m_floor;
#pragma unroll
    for (int b = 0; b < NB; ++b) mx = fmaxf(mx, fmaxf(fmaxf(s[b][0], s[b][1]), fmaxf(s[b][2], s[b][3])));
    mx = fmaxf(mx, shx(mx, 16, lane)); mx = fmaxf(mx, shx(mx, 32, lane));
    float sum = 0.f;
#pragma unroll
    for (int b = 0; b < NB; ++b) {
#pragma unroll
        for (int e = 0; e < 4; ++e) { s[b][e] = __builtin_amdgcn_exp2f(s[b][e] - mx); sum += s[b][e]; } }
    sum += shx(sum, 16, lane); sum += shx(sum, 32, lane);
    mx_out = mx; sum_out = sum;
}
__device__ __forceinline__ bf16x8 pack_p(const f32x4& a, const f32x4& b) {
    u32x4 w; w.x = pk2(a[0], a[1]); w.y = pk2(a[2], a[3]); w.z = pk2(b[0], b[1]); w.w = pk2(b[2], b[3]); return __builtin_bit_cast(bf16x8, w);
}
__device__ __forceinline__ bf16x8 vt_read(const LAS bf16* p0, const LAS bf16* p1) {
    const s16x4 a = *(const LAS s16x4*)p0, b = *(const LAS s16x4*)p1; return (bf16x8){a[0], a[1], a[2], a[3], b[0], b[1], b[2], b[3]};
}
__device__ __forceinline__ f32x4 qk_block(const bf16* kp, const bf16x8& qf0, const bf16x8& qf1) {
    const bf16x8 k0 = *(const bf16x8*)kp, k1 = *(const bf16x8*)(kp + 32);
    f32x4 a = __builtin_amdgcn_mfma_f32_16x16x32_bf16(k0, qf0, (f32x4){0.f, 0.f, 0.f, 0.f}, 0, 0, 0);
    return __builtin_amdgcn_mfma_f32_16x16x32_bf16(k1, qf1, a, 0, 0, 0);
}
#define PV16(o, s, SLOT_EXPR, PITCH_) do { _Pragma("unroll") for (int pp = 0; pp < 8; ++pp) { const bf16x8 pf = pack_p(s[2 * pp], s[2 * pp + 1]); const int slot0 = (SLOT_EXPR); \
        _Pragma("unroll") for (int db = 0; db < 4; ++db) { const LAS bf16* vr = Vt + (16 * db + l15) * (PITCH_); const int sw_ = (2 * db + (l15 >> 3)) << 2; \
            o[db] = __builtin_amdgcn_mfma_f32_16x16x32_bf16(vt_read(vr + (slot0 ^ sw_), vr + ((slot0 + 16) ^ sw_)), pf, o[db], 0, 0, 0); } } } while (0)

#ifndef CBN
#define CBN 4
#endif
__device__ __forceinline__ void attn_phase(const bf16* Qb, const bf16* Kb, const bf16* Vb, bf16* Ob, const bf16* CK, const bf16* CV, const float* rpb  ,
                                           int li, LAS unsigned char* lds, int tid, int lane, int wave, int G, int bid, int ulo, int uhi) {
    LAS bf16* Vt = (LAS bf16*)lds; LAS float* rpl = (LAS float*)(lds + 110592); LAS unsigned char* Kc = lds + LDS_KC;
    for (int u = bid + ulo; u < uhi; u += G) {
        int lz_ = lane; asm volatile("" : "+v"(lz_));
        const int l15 = lz_ & 15, g = lz_ >> 4;
        if (u < 512) {
            const int b = u >> 4, h = u & 15; constexpr int PITCH = 264;
            const int qrow0 = b * 256 + 32 * wave + l15;
            const bf16x8 qa0 = *(const bf16x8*)(Qb + (size_t)qrow0 * D + h * 64 + 8 * g), qa1 = *(const bf16x8*)(Qb + (size_t)qrow0 * D + h * 64 + 32 + 8 * g);
            const bf16x8 qb0 = *(const bf16x8*)(Qb + (size_t)(qrow0 + 16) * D + h * 64 + 8 * g), qb1 = *(const bf16x8*)(Qb + (size_t)(qrow0 + 16) * D + h * 64 + 32 + 8 * g);
            SB0();
            { int t2 = tid; asm volatile("" : "+v"(t2));
              u32x4 v[4], kv[4];
#pragma unroll
              for (int it = 0; it < 4; ++it) { const int idx = t2 + NTHR * it, key = idx >> 3, chunk = idx & 7; const size_t off = (size_t)(b * 256 + key) * D + h * 64 + 8 * chunk;
                  v[it] = *(const u32x4*)(Vb + off); kv[it] = *(const u32x4*)(Kb + off); }
              SB0();
#pragma unroll
              for (int it = 0; it < 4; ++it) { const int idx = t2 + NTHR * it, key = idx >> 3, chunk = idx & 7;
                  *(LAS u32x4*)(Kc + key * 144 + chunk * 16) = kv[it];
                  vt_write(Vt, PITCH, key, chunk, v[it]); } }
            __syncthreads();
            SB0();
            f32x4 s0[16], s1[16];
            { const LAS unsigned char* kl = Kc + l15 * 144 + g * 16;
              sfor<16>([&](auto I) __attribute__((always_inline)) { constexpr int kb = decltype(I)::value;
                const bf16x8 k0 = *(const LAS bf16x8*)(kl + kb * (16 * 144)), k1 = *(const LAS bf16x8*)(kl + kb * (16 * 144) + 64);
                f32x4 a = __builtin_amdgcn_mfma_f32_16x16x32_bf16(k0, qa0, (f32x4){0.f, 0.f, 0.f, 0.f}, 0, 0, 0); s0[kb] = __builtin_amdgcn_mfma_f32_16x16x32_bf16(k1, qa1, a, 0, 0, 0) * SCL;
                f32x4 c = __builtin_amdgcn_mfma_f32_16x16x32_bf16(k0, qb0, (f32x4){0.f, 0.f, 0.f, 0.f}, 0, 0, 0); s1[kb] = __builtin_amdgcn_mfma_f32_16x16x32_bf16(k1, qb1, c, 0, 0, 0) * SCL; }); }
            { float mx, sum; softmax_part<16>(s0, mx, sum, lane);
              f32x4 o[4];
#pragma unroll
              for (int db = 0; db < 4; ++db) o[db] = (f32x4){0.f, 0.f, 0.f, 0.f};
              PV16(o, s0, 32 * pp + 4 * g, PITCH);
              const float rl = 1.0f / sum;
#pragma unroll
              for (int db = 0; db < 4; ++db) { const f32x4 ov = o[db] * rl; u32x2 w; w.x = pk2(ov[0], ov[1]); w.y = pk2(ov[2], ov[3]);
                  *(u32x2*)(Ob + (size_t)qrow0 * D + h * 64 + 16 * db + 4 * g) = w; } }
            { float mx, sum; softmax_part<16>(s1, mx, sum, lane);
              f32x4 o[4];
#pragma unroll
              for (int db = 0; db < 4; ++db) o[db] = (f32x4){0.f, 0.f, 0.f, 0.f};
              PV16(o, s1, 32 * pp + 4 * g, PITCH);
              const float rl = 1.0f / sum;
#pragma unroll
              for (int db = 0; db < 4; ++db) { const f32x4 ov = o[db] * rl; u32x2 w; w.x = pk2(ov[0], ov[1]); w.y = pk2(ov[2], ov[3]);
                  *(u32x2*)(Ob + (size_t)(qrow0 + 16) * D + h * 64 + 16 * db + 4 * g) = w; } }
            __syncthreads();
        } else {
            const int ui = u - 512, xcd = ui & 7, idx = (ui >> 3) & 63, uu = (G == 256) ? ((xcd * 8 + (idx >> 3)) << 3) + (idx & 7) : ui;
            const int b = uu >> 7, h = (uu >> 3) & 15, rp = uu & 7, r0 = 2 * rp; constexpr int PITCH = 840;
            const int rs0 = min(max(r0 - 4, 0), 8);
            const size_t tokb = (size_t)MP + (size_t)b * 1024;
            const int r = r0 + (wave >> 2), j = wave & 3, rs = min(max(r - 4, 0), 8), rrel = rs - rs0, kcs = min(max(16 * j - 8, 0), 32);
            const int qcol = 16 * j + l15, wst = min(max(qcol - 8, 0), 48);
            const size_t qtok = tokb + r * 64 + qcol;
            const bf16* kloc = Kb + (tokb + rs * 64 + kcs + l15) * D + h * 64 + 8 * g;
            bf16x8 kf[16][2];
#define LOAD_KLOC(H) sfor<8>([&](auto I) __attribute__((always_inline)) { constexpr int lb = 8 * (H) + decltype(I)::value; const bf16* kp = kloc + (size_t)((lb >> 1) * 64 + 16 * (lb & 1)) * D; kf[lb][0] = *(const bf16x8*)kp; kf[lb][1] = *(const bf16x8*)(kp + 32); })
            LOAD_KLOC(0);
            const bf16x8 qf0 = *(const bf16x8*)(Qb + qtok * D + h * 64 + 8 * g), qf1 = *(const bf16x8*)(Qb + qtok * D + h * 64 + 32 + 8 * g);
            SB0();
            { int t2 = tid; asm volatile("" : "+v"(t2));
              u32x4 vv[13], kv[4];
#pragma unroll
              for (int it = 0; it < 13; ++it) { const int idx = t2 + NTHR * it, slot = idx >> 3, chunk = idx & 7;
                  const bf16* src = (slot < 576) ? Vb + (tokb + min(rs0 + (slot >> 6), 15) * 64 + (slot & 63)) * D + h * 64 : CV + ((size_t)(b * 2 + li) * 256 + (slot - 576)) * D + h * 64;
                  vv[it] = *(const u32x4*)(src + 8 * chunk); }
#pragma unroll
              for (int it = 0; it < 4; ++it) { const int idx = t2 + NTHR * it, key = idx >> 3, chunk = idx & 7;
                  kv[it] = *(const u32x4*)(CK + ((size_t)(b * 2 + li) * 256 + key) * D + h * 64 + 8 * chunk); }
              const float rv = rpb[h * 465 + min(t2, 464)];
              SB0();
#pragma unroll
              for (int it = 0; it < 13; ++it) { const int idx = t2 + NTHR * it; vt_write(Vt, PITCH, idx >> 3, idx & 7, vv[it]); }
#pragma unroll
              for (int it = 0; it < 4; ++it) { const int idx = t2 + NTHR * it; *(LAS u32x4*)(Kc + (idx >> 3) * 144 + (idx & 7) * 16) = kv[it]; }
              if (t2 < 465) rpl[t2] = rv; }
            SB0(); LOAD_KLOC(1); SB0();
            __syncthreads();
            SB0();
            f32x4 o1[4]; float m1, l1, m2, l2;
#pragma unroll
            for (int db = 0; db < 4; ++db) o1[db] = (f32x4){0.f, 0.f, 0.f, 0.f};
            {
                int dcv[8]; unsigned vmask = 0u;
#pragma unroll
                for (int ce = 0; ce < 8; ++ce) { const int kc = kcs + 16 * (ce >> 2) + 4 * g + (ce & 3); vmask |= ((kc >= wst) && (kc < wst + 16)) ? (1u << ce) : 0u; dcv[ce] = min(max(kc - qcol + 15, 0), 30); }
                f32x4 s[16];
#define QK_LOC(H) sfor<8>([&](auto I) __attribute__((always_inline)) { constexpr int lb = 8 * (H) + decltype(I)::value, krow = lb >> 1, ch = lb & 1; \
                    f32x4 a = __builtin_amdgcn_mfma_f32_16x16x32_bf16(kf[lb][0], qf0, (f32x4){0.f, 0.f, 0.f, 0.f}, 0, 0, 0); a = __builtin_amdgcn_mfma_f32_16x16x32_bf16(kf[lb][1], qf1, a, 0, 0, 0); \
                    const LAS float* rp_row = rpl + (rs + krow - r + 7) * 31; float bias[4]; \
                    _Pragma("unroll") for (int e = 0; e < 4; ++e) bias[e] = rp_row[dcv[ch * 4 + e]]; \
                    _Pragma("unroll") for (int e = 0; e < 4; ++e) { const float t = a[e] * SCL + bias[e] * LOG2E; a[e] = ((vmask >> (ch * 4 + e)) & 1u) ? t : -INFINITY; } \
                    s[lb] = a; })
                QK_LOC(0); QK_LOC(1); SB0();
                softmax_part<16>(s, m1, l1, lane);
                PV16(o1, s, (rrel + pp) * 64 + kcs + 4 * g, PITCH);
            }
            SB0();
            {
                f32x4 s[16];
                { const LAS unsigned char* kl = Kc + l15 * 144 + g * 16;
                  sfor<16>([&](auto I) __attribute__((always_inline)) { constexpr int cb = decltype(I)::value;
                    const bf16x8 k0 = *(const LAS bf16x8*)(kl + cb * (16 * 144)), k1 = *(const LAS bf16x8*)(kl + cb * (16 * 144) + 64);
                    f32x4 a = __builtin_amdgcn_mfma_f32_16x16x32_bf16(k0, qf0, (f32x4){0.f, 0.f, 0.f, 0.f}, 0, 0, 0); s[cb] = __builtin_amdgcn_mfma_f32_16x16x32_bf16(k1, qf1, a, 0, 0, 0) * SCL; }); }
                softmax_part<16>(s, m2, l2, lane, m1);
                const float a1 = __builtin_amdgcn_exp2f(m1 - m2);
#pragma unroll
                for (int db = 0; db < 4; ++db) o1[db] = o1[db] * a1;
                l1 = l1 * a1 + l2;
                PV16(o1, s, 576 + 32 * pp + 4 * g, PITCH);
            }
            const float rl = 1.0f / l1;
            int r2_ = r; asm volatile("" : "+s"(r2_));
            const size_t qtok2 = tokb + r2_ * 64 + qcol;
#pragma unroll
            for (int db = 0; db < 4; ++db) { const f32x4 ov = o1[db] * rl; u32x2 w; w.x = pk2(ov[0], ov[1]); w.y = pk2(ov[2], ov[3]);
                *(u32x2*)(Ob + qtok2 * D + h * 64 + 16 * db + 4 * g) = w; }
            __syncthreads();
        }
    }
}

#define RLX_AGENT __ATOMIC_RELAXED, __HIP_MEMORY_SCOPE_AGENT
#define XB_TMO      128
#define XB_XCNT(j)  (256  + 64 * (j))
#define XB_XSUB(j)  (1280 + 64 * (j))
#define XB_XGEN(j)  (2304 + 64 * (j))
#define XB_TOP      3328
#define XB_TOPGEN   3392
#define XCD_BAR_WORDS 3456
#define XB_SPIN_CAP (1u << 18)

__device__ __forceinline__ unsigned xb_ld(unsigned* p)              { return __hip_atomic_load(p, __ATOMIC_RELAXED, __HIP_MEMORY_SCOPE_AGENT); }
__device__ __forceinline__ unsigned xb_add(unsigned* p, unsigned v) { return __hip_atomic_fetch_add(p, v, __ATOMIC_RELAXED, __HIP_MEMORY_SCOPE_AGENT); }
__device__ __forceinline__ unsigned xb_xcc_id() { return (unsigned)__builtin_amdgcn_s_getreg((3 << 11) | 20) & 0xFu; }
#define XB_SPIN(cond, bar) do { unsigned _sp = 0; while (cond) { __builtin_amdgcn_s_sleep(1); \
    if ((++_sp & 255u) == 0u) { if (xb_ld(&(bar)[XB_TMO])) break; if (_sp > XB_SPIN_CAP) { atomicAdd(&(bar)[XB_TMO], 1u); break; } } } } while (0)

struct XcdBarrier {
    unsigned* bar; unsigned x;
    volatile LAS unsigned* st;
};

__device__ __forceinline__ XcdBarrier xcd_barrier_post(unsigned* bar, volatile LAS unsigned* st) {
    XcdBarrier b; b.bar = bar; b.x = xb_xcc_id(); b.st = st;
    if (threadIdx.x == 0) (void)xb_add(&bar[XB_XCNT(b.x)], 1u);
    return b;
}
__device__ __forceinline__ void xcd_barrier_complete(unsigned* bar, unsigned x, unsigned& nloc, unsigned& nx) {
    const unsigned G = gridDim.x * gridDim.y * gridDim.z;
    unsigned sum, cnt, mine, sp = 0u;
    for (;;) {
        sum = 0u; cnt = 0u; mine = 0u;
#pragma unroll
        for (unsigned j = 0; j < 16; ++j) { const unsigned c = xb_ld(&bar[XB_XCNT(j)]); sum += c; cnt += (c > 0u) ? 1u : 0u; mine = (j == x) ? c : mine; }
        if (sum == G) break;
        __builtin_amdgcn_s_sleep(1);
        if ((++sp & 255u) == 0u) { if (xb_ld(&bar[XB_TMO])) break; if (sp > XB_SPIN_CAP) { atomicAdd(&bar[XB_TMO], 1u); break; } }
    }
    nloc = mine > 0u ? mine : 1u; nx = cnt > 0u ? cnt : 1u;
}

__device__ __forceinline__ void xcd_barrier(const XcdBarrier& b) {
    asm volatile("s_waitcnt vmcnt(0)" ::: "memory");
    __syncthreads();
    if (threadIdx.x == 0) {
        unsigned* bar = b.bar;
        __builtin_amdgcn_s_waitcnt(0);
        unsigned nloc = b.st[0], nx = b.st[1];
        if (nloc == 0u) { xcd_barrier_complete(bar, b.x, nloc, nx); b.st[0] = nloc; b.st[1] = nx; }
        const unsigned old = xb_add(&bar[XB_XSUB(b.x)], 1u);
        const unsigned gen = old / nloc;
        if (old + 1u == (gen + 1u) * nloc) {
            __builtin_amdgcn_fence(__ATOMIC_RELEASE, "agent");
            asm volatile("s_waitcnt vmcnt(0)" ::: "memory");
            const unsigned og = xb_add(&bar[XB_TOP], 1u);
            if (og + 1u == (gen + 1u) * nx) xb_add(&bar[XB_TOPGEN], 1u);
            else XB_SPIN(xb_ld(&bar[XB_TOPGEN]) == gen, bar);
            __builtin_amdgcn_fence(__ATOMIC_ACQUIRE, "agent");
            asm volatile("s_waitcnt vmcnt(0)" ::: "memory");
        } else {
            XB_SPIN(xb_ld(&bar[XB_TOPGEN]) == gen, bar);
            __builtin_amdgcn_fence(__ATOMIC_ACQUIRE, "agent");
            asm volatile("s_waitcnt vmcnt(0)" ::: "memory");
        }
    }
    __syncthreads();
}

constexpr int NPH = 2 + 5 * NL + 1;
struct Args { const float* in[21]; float* out; unsigned char* ws; int nprog, pad; int prog[48]; };
typedef const __attribute__((address_space(4))) Args* KArgPtr;
__global__ void __launch_bounds__(NTHR, 2) fwd_kernel(Args a_unused) {
    extern __shared__ __attribute__((aligned(16))) unsigned char lds_raw[];
    LAS unsigned char* lds = (LAS unsigned char*)lds_raw;
    cg::grid_group grid = cg::this_grid();
    const int wave0 = __builtin_amdgcn_readfirstlane((int)threadIdx.x >> 6);
    { volatile LAS unsigned* st0 = (volatile LAS unsigned*)(lds + LDS_ST); if (threadIdx.x < 2) st0[threadIdx.x] = 0u; }
    __syncthreads();
    XcdBarrier xbar; { KArgPtr kpb = (KArgPtr)__builtin_amdgcn_kernarg_segment_ptr(); xbar.bar = (unsigned*)kpb->ws; xbar.x = 0; xbar.st = (volatile LAS unsigned*)(lds + LDS_ST);
        if (blockIdx.x == 0) { for (int wI = threadIdx.x; wI < XCD_BAR_WORDS; wI += NTHR) __hip_atomic_store(xbar.bar + wI, 0u, __ATOMIC_RELAXED, __HIP_MEMORY_SCOPE_AGENT); } }
    int nprog; { KArgPtr kp0 = (KArgPtr)__builtin_amdgcn_kernarg_segment_ptr(); nprog = kp0->nprog; }
    for (int pc = 0; pc < nprog; ++pc) {
        KArgPtr kp = (KArgPtr)__builtin_amdgcn_kernarg_segment_ptr(); asm volatile("" : "+s"(kp));
        int z_ = 0; asm volatile("" : "+s"(z_));
        const int lane_ = (int)__builtin_amdgcn_mbcnt_hi(~0u, __builtin_amdgcn_mbcnt_lo(~0u, (unsigned)z_)); const int tid_ = wave0 * 64 + lane_;
        int bid_ = (int)__builtin_amdgcn_workgroup_id_x(), G_ = (int)gridDim.x; asm volatile("" : "+s"(bid_), "+s"(G_));
        const int pe_ = kp->prog[pc]; const int ph = pe_ & 63, amode = pe_ >> 6;
        const int tid = tid_, lane = lane_, wave = wave0, G = G_, bid = bid_;
        const int gw = bid * NWAVES + wave, NGW = G * NWAVES;
        Ptrs P; P = Ptrs{kp->in[0], kp->in[1], kp->in[2], kp->in[3], kp->in[4], kp->in[5], kp->in[6], kp->in[7], kp->in[8], kp->in[9], kp->in[10], kp->in[11], kp->in[12], kp->in[13], kp->in[14], kp->in[15], kp->in[16], kp->in[17], kp->in[18], kp->in[19], kp->in[20]};
        unsigned char* ws = kp->ws; float* outp = kp->out;
        float* mod = (float*)(ws + WS_MOD); bf16* Wt = (bf16*)(ws + WS_W); bf16* X = (bf16*)(ws + WS_X); bf16* H = (bf16*)(ws + WS_H);
        bf16* R = (bf16*)(ws + WS_R); bf16* Qb = R; bf16* Kb = R + (size_t)M * D; bf16* Vb = R + (size_t)2 * M * D; bf16* Ob = R + (size_t)3 * M * D;
        bf16* Ub = R; bf16* Vc = R + (size_t)M * D; bf16* Fb = R;
        const bf16* CK = (const bf16*)(ws + WS_CK); const bf16* CV = (const bf16*)(ws + WS_CV);
        float* out_y = outp; float* out_ck = outp + (size_t)M * D; float* out_cv = out_ck + (size_t)32 * 2 * 256 * 1024;
        float* SS = (float*)(ws + WS_SS); float* SHW = (float*)(ws + WS_SHW);
        if (ph == 0) { p0_phase(P, ws, lds, tid, lane, wave, G, bid); }
        else if (ph == 1) { prep_phase(P.x_prompt, P.x_sample, H, SS, P.norm_g, mod + 1 * 1024, mod, Wt, SHW, gw, NGW, lane); }
        else if (ph == NPH - 1) { final_norm_phase(X, out_y, P.final_g, gw, NGW, lane); }
        else if (ph >= 60) { }
        else {
            const int l = (ph - 2) / 5, s = (ph - 2) % 5, i = l >> 1; const bool conv = (l & 1) != 0;
            const float* modl = mod + (size_t)l * 5 * 6144;
            if (s == 0) {
                const float* ssl = SS + (size_t)(2 * l) * M; const float* shl = SHW + (size_t)((2 * l) * 5) * 4096;
                if (!conv) { pg8::Gemm gm{H, Wt + W_QKV + (size_t)i * 3 * MEL, M, 3 * D, D}; pg8::StaticOrder S; S.init(M, 3 * D, G, bid);
                    pg8::EpiQKV E{ssl, shl, Qb, (size_t)M * D, out_ck + (size_t)i * 256 * 1024, (size_t)32 * 2 * 256 * 1024};
                    pg8::gemm_phase<pg8::EpiQKV, pg8::StaticOrder, true, true>(lds, gm, S, E, tid); }
                else { pg8::Gemm gm{H, Wt + W_PW1 + (size_t)i * 2 * MEL, M, 2 * D, D}; pg8::StaticOrder S; S.init(M, 2 * D, G, bid);
                    pg8::EpiGLU E{ssl, shl, Ub};
                    pg8::gemm_phase<pg8::EpiGLU, pg8::StaticOrder, true, true>(lds, gm, S, E, tid); }
            } else if (s == 1) {
                if (!conv) attn_phase(Qb, Kb, Vb, Ob, CK, CV, P.rpb + (size_t)i * 16 * 15 * 31, i, lds, tid, lane, wave, G, bid, amode == 2 ? 512 : 0, amode == 1 ? 512 : 1024);
                else conv_phase(Ub, Vc, P.w_dw + (size_t)i * 31 * D, P.b_dw + i * D, P.ln_g + i * D, P.ln_b + i * D, lds, tid, lane, wave, G, bid);
            } else if (s == 2 || s == 4) {
                pg8::Gemm gm; pg8::EpiRes E;
                if (s == 2) { gm = pg8::Gemm{conv ? Vc : Ob, Wt + (conv ? W_PW2 : W_O) + (size_t)i * MEL, M, D, D};
                    E = pg8::EpiRes{P.x_prompt, P.x_sample, l == 0 ? (const bf16*)nullptr : X, X, modl + 2 * 1024, H, P.norm_g + (l * 2 + 1) * D, modl + 4 * 1024, SS + (size_t)(2 * l + 1) * M}; }
                else { gm = pg8::Gemm{Fb, Wt + W_DOWN + (size_t)l * 4 * MEL, M, D, FF};
                    E = pg8::EpiRes{P.x_prompt, P.x_sample, X, X, modl + 5 * 1024, l < NL - 1 ? H : nullptr, P.norm_g + ((l + 1) * 2) * D, modl + 5 * 6144 + 1 * 1024, SS + (size_t)(2 * l + 2) * M}; }
                pg8::StaticOrder S; S.init(M, D, G, bid);
                pg8::gemm_phase<pg8::EpiRes, pg8::StaticOrder, true, true>(lds, gm, S, E, tid);
            } else {
#ifdef UP256
                pg8::Gemm gm{H, Wt + W_UP + (size_t)l * 4 * MEL, M, FF, D}; pg8::StaticOrder256 S; S.init(M, FF, G, bid);
                pg8::EpiUp256 E{SS + (size_t)(2 * l + 1) * M, SHW + (size_t)((2 * l + 1) * 5) * 4096, Fb, FF};
                pg8::gemm_phase256<pg8::EpiUp256, pg8::StaticOrder256, true, true>(lds, gm, S, E, tid);
#else
                pg8::Gemm gm{H, Wt + W_UP + (size_t)l * 4 * MEL, M, FF, D}; pg8::StaticOrder S; S.init(M, FF, G, bid);
                pg8::EpiUp E{SS + (size_t)(2 * l + 1) * M, SHW + (size_t)((2 * l + 1) * 5) * 4096, Fb, FF};
                pg8::gemm_phase<pg8::EpiUp, pg8::StaticOrder, true, true>(lds, gm, S, E, tid);
#endif
            }
        }
        if (pc + 1 < nprog) { if (pc == 0) { grid.sync(); xbar = xcd_barrier_post(xbar.bar, xbar.st); } else xcd_barrier(xbar); }
    }
}

#ifndef SINGLE_LAUNCH
#define SINGLE_LAUNCH 0
#endif
extern "C" void kernel_launch(void* const* d_in, const int* in_sizes, int n_in, void* d_out, int out_size, void* d_ws, size_t ws_size, hipStream_t stream) {
    static int grid = 0;
    if (grid == 0) {
        if (n_in != 21 || ws_size < WS_END) { fprintf(stderr, "kernel_launch: unexpected n_in %d / ws_size %zu\n", n_in, ws_size); grid = -1; return; }
        int dev = 0, cus = 0, per_cu = 0;
        hipGetDevice(&dev); hipDeviceGetAttribute(&cus, hipDeviceAttributeMultiprocessorCount, dev);
        hipFuncSetAttribute((const void*)fwd_kernel, hipFuncAttributeMaxDynamicSharedMemorySize, LDS_BYTES);
        hipOccupancyMaxActiveBlocksPerMultiprocessor(&per_cu, (const void*)fwd_kernel, NTHR, LDS_BYTES);
        if (per_cu < 1) { fprintf(stderr, "kernel_launch: occupancy query says %d blocks/CU\n", per_cu); per_cu = 1; }
        (void)hipGetLastError();
        grid = cus * per_cu;
    }
    if (grid < 0) return;
    Args a{};
    for (int i = 0; i < 21; ++i) a.in[i] = (const float*)d_in[i];
    a.out = (float*)d_out; a.ws = (unsigned char*)d_ws;
#if SINGLE_LAUNCH
    { int n = 0;
      for (int ph = 0; ph < NPH; ++ph) { a.prog[n++] = ph;
#ifdef PROBE_ATTN_MODE
          if (ph >= 2 && ph < NPH - 1 && (ph - 2) % 5 == 1 && ((ph - 2) / 5) % 2 == 0) a.prog[n++] = ph | (PROBE_ATTN_MODE << 6);
#endif
#ifdef PROBE_EMPTY
          if (ph == 5) for (int q = 0; q < PROBE_EMPTY; ++q) a.prog[n++] = 60;
#endif
#ifdef PROBE_REPEAT_P0
          if (ph == 0) a.prog[n++] = 0;
#endif
#ifdef PROBE_REPEAT_S
          if (ph >= 2 && ph < NPH - 1 && (ph - 2) % 5 == PROBE_REPEAT_S && (PROBE_REPEAT_PAR < 0 || ((ph - 2) / 5) % 2 == PROBE_REPEAT_PAR)) a.prog[n++] = ph;
#endif
      }
      a.nprog = n; }
    void* args[] = {&a};
    hipError_t e = hipLaunchCooperativeKernel((const void*)fwd_kernel, dim3(grid), dim3(NTHR), args, LDS_BYTES, stream);
    if (e != hipSuccess) fprintf(stderr, "cooperative launch failed: %s (grid %d)\n", hipGetErrorString(e), grid);
#else
    for (int ph = 0; ph < NPH; ++ph) { a.nprog = 1; a.prog[0] = ph; hipLaunchKernelGGL(fwd_kernel, dim3(grid), dim3(NTHR), LDS_BYTES, stream, a); }
#endif
}
```

```cpp
#define SINGLE_LAUNCH 1
#define UP256 1
#include <hip/hip_runtime.h>
#include <hip/hip_cooperative_groups.h>
#include <cstdio>
#include <cstdint>
#include <cmath>
#include <utility>
namespace cg = cooperative_groups;
namespace pg8 {
#define PG8_LAS __attribute__((address_space(3)))
typedef unsigned short bf16_t;
typedef short bf16x8 __attribute__((ext_vector_type(8)));
typedef float f32x4 __attribute__((ext_vector_type(4)));
typedef unsigned u32x4 __attribute__((ext_vector_type(4)));
constexpr int RM = 192;
constexpr int BM = 256, BK = 64, HALF = 128, HTB = HALF * BK * 2  , STAGE_BYTES = 8 * HTB, NXCD = 8, WGM = 8;

__host__ __device__ __forceinline__ int lds_byte(int r, int c) { const int st = (r >> 4) * 2 + (c >> 5), rr = r & 15, cc = c & 31, ob = rr * 64 + cc * 2; return st * 1024 + (ob ^ (((ob >> 9) & 1) << 5)); }
__host__ __device__ __forceinline__ void stage_rc(int b, int& R, int& C) { const int st = b / 1024, sb = b % 1024, swz = sb ^ (((sb >> 9) & 1) << 5); R = (st >> 1) * 16 + swz / 64; C = (st & 1) * 32 + (swz % 64) / 2; }
__host__ __device__ __forceinline__ int perm32(int rho) { const int n = rho >> 4, i = rho & 15; return 8 * (i >> 2) + 4 * n + (i & 3); }

struct Unit { int pm, pn; };
struct Gemm { const bf16_t* A; const bf16_t* Bt; int M, N, K; };

struct StaticOrder {
    int nM, nN, nwg, G, c;
    __host__ __device__ void init(int M, int N, int G_, int c_) { nM = M / RM; nN = N / BM; nwg = nM * nN; G = G_; c = c_; }
    __host__ __device__ bool next(int i, Unit& u) const {
        const long L = (long)i * G + c; if (L >= nwg) return false;
        int wgid = (int)L; { const int q = nwg / NXCD, r = nwg % NXCD, xcd = wgid % NXCD, off = wgid / NXCD; wgid = (xcd < r ? xcd * (q + 1) : r * (q + 1) + (xcd - r) * q) + off; }
        const int nig = WGM * nN, gid = wgid / nig, fm = gid * WGM, gsz = (nM - fm) < WGM ? (nM - fm) : WGM;
        u.pm = fm + ((wgid % nig) % gsz); u.pn = (wgid % nig) / gsz; return true;
    }
    __device__ __forceinline__ void a_ready(const Unit&) const {}
    __device__ __forceinline__ void done(const Unit&) const {}
};

__device__ __forceinline__ unsigned cvt_pk_bf16(float lo, float hi) { unsigned r; asm volatile("v_cvt_pk_bf16_f32 %0, %1, %2" : "=v"(r) : "v"(lo), "v"(hi)); return r; }
typedef float f32x2 __attribute__((ext_vector_type(2)));
__device__ __forceinline__ int cond_of_row(int r) { return r < 8192 ? 0 : 1 + ((r - 8192) >> 10); }
__device__ __forceinline__ int half_row0(int ai, int wr) { return ai == 0 ? wr * 64 : 128 + wr * 32; }
#define EPI_MLOOP(ai, m) _Pragma("unroll") for (int m = 0; m < 4; ++m) if (ai == 0 || m < 2)
struct EpiQKV {
    static constexpr bool PERM = true, AFTER_DRAIN = false;
    const float* ss; const float* shw;
    bf16_t* Q; size_t qkv_stride; float* ck; size_t ckv_stride;
    __device__ __forceinline__ void operator()(const f32x4 (&acc)[2][2][4][2], const Unit& u, int wr, int wc, int fr, int fq) const {
        const int t = u.pn >> 2;
        bf16_t* base = Q + (size_t)t * qkv_stride;
        const int col0 = (u.pn & 3) * BM + wc * 32 + 8 * fq;
        float* cbase = ck + (size_t)(t > 0 ? t - 1 : 0) * ckv_stride + col0;
#pragma unroll
        for (int ai = 0; ai < 2; ++ai) { const int rbase = u.pm * RM + half_row0(ai, wr) + fr; const bool wc_ = (t > 0) && (rbase < 8192);
            const float* sp = shw + cond_of_row(rbase) * 4096 + u.pn * BM + wc * 32 + 8 * fq;
            f32x4 sv[2][2];
#pragma unroll
            for (int bj = 0; bj < 2; ++bj) { sv[bj][0] = *(const f32x4*)(sp + bj * HALF); sv[bj][1] = *(const f32x4*)(sp + bj * HALF + 4); }
            float rr[4];
            EPI_MLOOP(ai, m) rr[m] = ss[rbase + m * 16];
            EPI_MLOOP(ai, m) { const int row = rbase + m * 16; bf16_t* rowp = base + (size_t)row * 1024 + col0;
                const float r = __builtin_amdgcn_rsqf(rr[m] * (1.f / 1024.f) + 1e-6f);
                float* cp0 = cbase + ((size_t)(row >> 8) * 2 * 256 + (row & 255)) * 1024;
#pragma unroll
                for (int bj = 0; bj < 2; ++bj) { const f32x4 v0 = acc[ai][bj][m][0] * r + sv[bj][0], v1 = acc[ai][bj][m][1] * r + sv[bj][1];
                    u32x4 w; w.x = cvt_pk_bf16(v0[0], v0[1]); w.y = cvt_pk_bf16(v0[2], v0[3]); w.z = cvt_pk_bf16(v1[0], v1[1]); w.w = cvt_pk_bf16(v1[2], v1[3]);
                    *(u32x4*)(rowp + bj * HALF) = w;
                    if (wc_) { float* cp = cp0 + bj * HALF; __builtin_nontemporal_store(v0, (f32x4*)cp); __builtin_nontemporal_store(v1, (f32x4*)(cp + 4)); } } } }
    }
};
struct EpiUp {
    static constexpr bool PERM = true, AFTER_DRAIN = false;
    const float* ss; const float* shw; bf16_t* O; int ldc;
    __device__ __forceinline__ void operator()(const f32x4 (&acc)[2][2][4][2], const Unit& u, int wr, int wc, int fr, int fq) const {
        const int col0 = u.pn * BM + wc * 32 + 8 * fq;
#pragma unroll
        for (int ai = 0; ai < 2; ++ai) { const int rbase = u.pm * RM + half_row0(ai, wr) + fr;
            const float* sp = shw + cond_of_row(rbase) * 4096 + col0;
            f32x4 sv[2][2];
#pragma unroll
            for (int bj = 0; bj < 2; ++bj) { sv[bj][0] = *(const f32x4*)(sp + bj * HALF); sv[bj][1] = *(const f32x4*)(sp + bj * HALF + 4); }
            float rr[4];
            EPI_MLOOP(ai, m) rr[m] = ss[rbase + m * 16];
            EPI_MLOOP(ai, m) { bf16_t* rowp = O + (size_t)(rbase + m * 16) * ldc + col0;
                const float r = __builtin_amdgcn_rsqf(rr[m] * (1.f / 1024.f) + 1e-6f);
#pragma unroll
                for (int bj = 0; bj < 2; ++bj) { f32x4 v0 = acc[ai][bj][m][0] * r + sv[bj][0], v1 = acc[ai][bj][m][1] * r + sv[bj][1];
#pragma unroll
                    for (int e = 0; e < 4; ++e) { const float a = fmaxf(v0[e], 0.f), b = fmaxf(v1[e], 0.f); v0[e] = a * a; v1[e] = b * b; }
                    u32x4 w; w.x = cvt_pk_bf16(v0[0], v0[1]); w.y = cvt_pk_bf16(v0[2], v0[3]); w.z = cvt_pk_bf16(v1[0], v1[1]); w.w = cvt_pk_bf16(v1[2], v1[3]);
                    *(u32x4*)(rowp + bj * HALF) = w; } } }
    }
};
struct EpiGLU {
    static constexpr bool PERM = true, AFTER_DRAIN = false;
    const float* ss; const float* shw; bf16_t* O;
    __device__ __forceinline__ void operator()(const f32x4 (&acc)[2][2][4][2], const Unit& u, int wr, int wc, int fr, int fq) const {
        const int col0 = u.pn * HALF + wc * 32 + 8 * fq;
#pragma unroll
        for (int ai = 0; ai < 2; ++ai) { const int rbase = u.pm * RM + half_row0(ai, wr) + fr;
            const float* sp = shw + cond_of_row(rbase) * 4096 + u.pn * BM + wc * 32 + 8 * fq;
            f32x4 sv[2][2];
#pragma unroll
            for (int bj = 0; bj < 2; ++bj) { sv[bj][0] = *(const f32x4*)(sp + bj * HALF); sv[bj][1] = *(const f32x4*)(sp + bj * HALF + 4); }
            float rr[4];
            EPI_MLOOP(ai, m) rr[m] = ss[rbase + m * 16];
            EPI_MLOOP(ai, m) { bf16_t* rowp = O + (size_t)(rbase + m * 16) * 1024 + col0;
                const float r = __builtin_amdgcn_rsqf(rr[m] * (1.f / 1024.f) + 1e-6f);
                f32x4 v0 = acc[ai][0][m][0] * r + sv[0][0], v1 = acc[ai][0][m][1] * r + sv[0][1]; const f32x4 g0 = acc[ai][1][m][0] * r + sv[1][0], g1 = acc[ai][1][m][1] * r + sv[1][1];
#pragma unroll
                for (int e = 0; e < 4; ++e) { v0[e] = v0[e] * __builtin_amdgcn_rcpf(1.f + __expf(-g0[e])); v1[e] = v1[e] * __builtin_amdgcn_rcpf(1.f + __expf(-g1[e])); }
                u32x4 w; w.x = cvt_pk_bf16(v0[0], v0[1]); w.y = cvt_pk_bf16(v0[2], v0[3]); w.z = cvt_pk_bf16(v1[0], v1[1]); w.w = cvt_pk_bf16(v1[2], v1[3]);
                *(u32x4*)rowp = w; } }
    }
};
struct EpiRes {
    static constexpr bool PERM = true, AFTER_DRAIN = false;
    const float* base_p; const float* base_s; const bf16_t* base_b; bf16_t* out; const float* gate;
    bf16_t* xb; const float* g_next; const float* sc_next; float* ss_next;
    __device__ __forceinline__ void operator()(const f32x4 (&acc)[2][2][4][2], const Unit& u, int wr, int wc, int fr, int fq) const {
        const int col0 = u.pn * BM + wc * 32 + 8 * fq;
        const int lane_x = fq * 16 + fr;
#pragma unroll
        for (int ai = 0; ai < 2; ++ai) { const int row0 = u.pm * RM + half_row0(ai, wr) + fr; const int cond = cond_of_row(row0);
            const float* gp = gate + cond * 6144 + col0;
            const float* bp = (row0 < 8192) ? base_p + (size_t)row0 * 1024 + col0 : base_s + (size_t)(row0 - 8192) * 1024 + col0;
            const bf16_t* bb = base_b + (size_t)row0 * 1024 + col0;
            bf16_t* op = out + (size_t)row0 * 1024 + col0;
            f32x4 gv[2][2], gs[2][2];
#pragma unroll
            for (int bj = 0; bj < 2; ++bj)
#pragma unroll
                for (int n = 0; n < 2; ++n) gv[bj][n] = *(const f32x4*)(gp + bj * HALF + n * 4);
            if (xb) { f32x4 ga[2][2], sa[2][2];
#pragma unroll
                for (int bj = 0; bj < 2; ++bj)
#pragma unroll
                    for (int n = 0; n < 2; ++n) { ga[bj][n] = *(const f32x4*)(g_next + col0 + bj * HALF + n * 4); sa[bj][n] = *(const f32x4*)(sc_next + cond * 6144 + col0 + bj * HALF + n * 4); }
#pragma unroll
                for (int bj = 0; bj < 2; ++bj)
#pragma unroll
                    for (int n = 0; n < 2; ++n) gs[bj][n] = ga[bj][n] * (1.f + sa[bj][n]); }
#pragma unroll
            for (int mp = 0; mp < 2; ++mp) if (ai == 0 || mp == 0) { f32x4 bs[2][2][2];
                if (base_b) {
#pragma unroll
                    for (int mm = 0; mm < 2; ++mm)
#pragma unroll
                        for (int bj = 0; bj < 2; ++bj) { const u32x4 w = *(const u32x4*)(bb + (size_t)((2 * mp + mm) * 16) * 1024 + bj * HALF);
                            bs[mm][bj][0] = (f32x4){__builtin_bit_cast(float, w.x << 16), __builtin_bit_cast(float, w.x & 0xffff0000u), __builtin_bit_cast(float, w.y << 16), __builtin_bit_cast(float, w.y & 0xffff0000u)};
                            bs[mm][bj][1] = (f32x4){__builtin_bit_cast(float, w.z << 16), __builtin_bit_cast(float, w.z & 0xffff0000u), __builtin_bit_cast(float, w.w << 16), __builtin_bit_cast(float, w.w & 0xffff0000u)}; }
                } else {
#pragma unroll
                    for (int mm = 0; mm < 2; ++mm)
#pragma unroll
                        for (int bj = 0; bj < 2; ++bj)
#pragma unroll
                            for (int n = 0; n < 2; ++n) bs[mm][bj][n] = *(const f32x4*)(bp + (size_t)((2 * mp + mm) * 16) * 1024 + bj * HALF + n * 4);
                }
#pragma unroll
                for (int mm = 0; mm < 2; ++mm) { float sq = 0.f;
#pragma unroll
                    for (int bj = 0; bj < 2; ++bj) { const f32x4 x0 = bs[mm][bj][0] + gv[bj][0] * acc[ai][bj][2 * mp + mm][0], x1 = bs[mm][bj][1] + gv[bj][1] * acc[ai][bj][2 * mp + mm][1];
                        { u32x4 w; w.x = cvt_pk_bf16(x0[0], x0[1]); w.y = cvt_pk_bf16(x0[2], x0[3]); w.z = cvt_pk_bf16(x1[0], x1[1]); w.w = cvt_pk_bf16(x1[2], x1[3]); *(u32x4*)(op + (size_t)((2 * mp + mm) * 16) * 1024 + bj * HALF) = w; }
                        if (xb) { const f32x4 h0 = x0 * gs[bj][0], h1 = x1 * gs[bj][1]; u32x4 w; w.x = cvt_pk_bf16(h0[0], h0[1]); w.y = cvt_pk_bf16(h0[2], h0[3]); w.z = cvt_pk_bf16(h1[0], h1[1]); w.w = cvt_pk_bf16(h1[2], h1[3]);
                            *(u32x4*)(xb + (size_t)(row0 + (2 * mp + mm) * 16) * 1024 + col0 + bj * HALF) = w;
                            sq += ((x0[0] * x0[0] + x0[1] * x0[1]) + (x0[2] * x0[2] + x0[3] * x0[3])) + ((x1[0] * x1[0] + x1[1] * x1[1]) + (x1[2] * x1[2] + x1[3] * x1[3])); } }
                    if (xb) {
                        sq += __builtin_bit_cast(float, __builtin_amdgcn_ds_bpermute((lane_x ^ 16) << 2, __builtin_bit_cast(int, sq)));
                        sq += __builtin_bit_cast(float, __builtin_amdgcn_ds_bpermute((lane_x ^ 32) << 2, __builtin_bit_cast(int, sq)));
                        if (fq == 0) atomicAdd(ss_next + row0 + (2 * mp + mm) * 16, sq); } }
                asm volatile("" ::: "memory"); } }
    }
};

struct StaticOrder256 {
    int nM, nN, nwg, G, c;
    __host__ __device__ void init(int M, int N, int G_, int c_) { nM = M / BM; nN = N / BM; nwg = nM * nN; G = G_; c = c_; }
    __host__ __device__ bool next(int i, Unit& u) const {
        const long L = (long)i * G + c; if (L >= nwg) return false;
        int wgid = (int)L; { const int q = nwg / NXCD, r = nwg % NXCD, xcd = wgid % NXCD, off = wgid / NXCD; wgid = (xcd < r ? xcd * (q + 1) : r * (q + 1) + (xcd - r) * q) + off; }
        const int nig = WGM * nN, gid = wgid / nig, fm = gid * WGM, gsz = (nM - fm) < WGM ? (nM - fm) : WGM;
        u.pm = fm + ((wgid % nig) % gsz); u.pn = (wgid % nig) / gsz; return true;
    }
    __device__ __forceinline__ void a_ready(const Unit&) const {}
    __device__ __forceinline__ void done(const Unit&) const {}
};
struct EpiUp256 {
    static constexpr bool PERM = true, AFTER_DRAIN = false;
    const float* ss; const float* shw; bf16_t* O; int ldc;
    __device__ __forceinline__ void operator()(const f32x4 (&acc)[2][2][4][2], const Unit& u, int wr, int wc, int fr, int fq) const {
        const int col0 = u.pn * BM + wc * 32 + 8 * fq;
        f32x4 sv[2][2][2]; float rr[2][4];
#pragma unroll
        for (int ai = 0; ai < 2; ++ai) { const int rbase = u.pm * BM + ai * HALF + wr * 64 + fr; const float* sp = shw + cond_of_row(rbase) * 4096 + col0;
#pragma unroll
            for (int bj = 0; bj < 2; ++bj) { sv[ai][bj][0] = *(const f32x4*)(sp + bj * HALF); sv[ai][bj][1] = *(const f32x4*)(sp + bj * HALF + 4); }
#pragma unroll
            for (int m = 0; m < 4; ++m) rr[ai][m] = ss[rbase + m * 16]; }
        __builtin_amdgcn_sched_barrier(0);
#pragma unroll
        for (int ai = 0; ai < 2; ++ai) { const int rbase = u.pm * BM + ai * HALF + wr * 64 + fr;
#pragma unroll
            for (int m = 0; m < 4; ++m) { bf16_t* rowp = O + (size_t)(rbase + m * 16) * ldc + col0;
                const float r = __builtin_amdgcn_rsqf(rr[ai][m] * (1.f / 1024.f) + 1e-6f);
#pragma unroll
                for (int bj = 0; bj < 2; ++bj) { f32x4 v0 = acc[ai][bj][m][0] * r + sv[ai][bj][0], v1 = acc[ai][bj][m][1] * r + sv[ai][bj][1];
#pragma unroll
                    for (int e = 0; e < 4; ++e) { const float a = fmaxf(v0[e], 0.f), b = fmaxf(v1[e], 0.f); v0[e] = a * a; v1[e] = b * b; }
                    u32x4 w; w.x = cvt_pk_bf16(v0[0], v0[1]); w.y = cvt_pk_bf16(v0[2], v0[3]); w.z = cvt_pk_bf16(v1[0], v1[1]); w.w = cvt_pk_bf16(v1[2], v1[3]);
                    *(u32x4*)(rowp + bj * HALF) = w; } } }
    }
};
template <class Epi, class Sched, bool ALIGN_EPI = false, bool SP2 = false>
__device__ __forceinline__ void gemm_phase256(PG8_LAS unsigned char* lds, const Gemm g, const Sched& S, const Epi& E, const int tid) {
    const int wid = __builtin_amdgcn_readfirstlane(tid >> 6), lane = tid & 63, wr = wid >> 2, wc = wid & 3, fr = lane & 15, fq = lane >> 4;
    const int K = g.K, nt = K / BK;
    unsigned voffA[2], voffB[2];
#pragma unroll
    for (int i = 0; i < 2; ++i) { int R, C; stage_rc(tid * 16 + i * 8192, R, C); const int Rb = Epi::PERM ? ((R & ~31) + perm32(R & 31)) : R;
        voffA[i] = (unsigned)(R * K + C) * 2u; voffB[i] = (unsigned)(Rb * K + C) * 2u; }
    const size_t kstep = (size_t)(BK * 2);
    const size_t hstep = (size_t)HALF * K * 2;
    const size_t tstep = 2 * hstep;
    const unsigned ldsw = (unsigned)wid * 1024u;
    const int aoff = lds_byte(wr * 64 + fr, fq * 8), boff = lds_byte(wc * 32 + fr, fq * 8);
#define PG8_SA(b, h) (((b) * 2 + (h)) * HTB)
#define PG8_SB(b, h) ((4 + (b) * 2 + (h)) * HTB)
#define PG8_STAGE(bufoff, gbase, voff) do { _Pragma("unroll") for (int _i = 0; _i < 2; ++_i) \
        __builtin_amdgcn_global_load_lds((const unsigned*)((const char*)(gbase) + (voff)[_i]), (PG8_LAS unsigned*)(lds + (bufoff) + ldsw + _i * 8192), 16, 0, 0); } while (0)
#define PG8_LDA(dst, b, h) do { _Pragma("unroll") for (int m = 0; m < 4; ++m) _Pragma("unroll") for (int k = 0; k < 2; ++k) dst[m][k] = *(const PG8_LAS bf16x8*)(lds + PG8_SA(b, h) + aoff + m * 2048 + k * 1024); } while (0)
#define PG8_LDB(dst, b, h) do { _Pragma("unroll") for (int n = 0; n < 2; ++n) _Pragma("unroll") for (int k = 0; k < 2; ++k) dst[n][k] = *(const PG8_LAS bf16x8*)(lds + PG8_SB(b, h) + boff + n * 2048 + k * 1024); } while (0)
#define PG8_MMA(ai, bj, At, Bt) do { __builtin_amdgcn_s_setprio(1); _Pragma("unroll") for (int m = 0; m < 4; ++m) _Pragma("unroll") for (int n = 0; n < 2; ++n) _Pragma("unroll") for (int k = 0; k < 2; ++k) \
        acc[ai][bj][m][n] = __builtin_amdgcn_mfma_f32_16x16x32_bf16(Bt[n][k], At[m][k], acc[ai][bj][m][n], 0, 0, 0); __builtin_amdgcn_s_setprio(0); } while (0)
#define PG8_WAIT_V(n) asm volatile("s_waitcnt vmcnt(" #n ")" ::: "memory")
#define PG8_WAIT_L(n) asm volatile("s_waitcnt lgkmcnt(" #n ")" ::: "memory")
#define PG8_BAR __builtin_amdgcn_s_barrier()
#define PG8_SCHED __builtin_amdgcn_sched_barrier(0)
    Unit cur, nxt; int ui = 0;
    if (!S.next(0, cur)) return;
    f32x4 acc[2][2][4][2];
#pragma unroll
    for (int a = 0; a < 2; ++a)
#pragma unroll
        for (int b = 0; b < 2; ++b)
#pragma unroll
            for (int m = 0; m < 4; ++m)
#pragma unroll
                for (int n = 0; n < 2; ++n) acc[a][b][m][n] = (f32x4){0.f, 0.f, 0.f, 0.f};
    bf16x8 At[4][2], B0[2][2], B1[2][2];
    const char* cA = (const char*)g.A + (size_t)cur.pm * tstep; const char* cB = (const char*)g.Bt + (size_t)cur.pn * tstep;
    S.a_ready(cur);
    if constexpr (SP2) {
        PG8_STAGE(PG8_SB(0, 0), cB, voffB); PG8_STAGE(PG8_SB(0, 1), cB + hstep, voffB); PG8_STAGE(PG8_SA(0, 0), cA, voffA); PG8_STAGE(PG8_SA(0, 1), cA + hstep, voffA);
        if (wr == 1) PG8_BAR;
        PG8_WAIT_V(2); PG8_BAR;
        PG8_STAGE(PG8_SB(1, 0), cB + kstep, voffB); PG8_STAGE(PG8_SA(1, 0), cA + kstep, voffA); PG8_STAGE(PG8_SB(1, 1), cB + hstep + kstep, voffB);
        PG8_WAIT_V(6); PG8_BAR;
    } else {
        PG8_STAGE(PG8_SB(0, 0), cB, voffB); PG8_STAGE(PG8_SA(0, 0), cA, voffA); PG8_STAGE(PG8_SB(0, 1), cB + hstep, voffB); PG8_STAGE(PG8_SA(0, 1), cA + hstep, voffA);
        if (wr == 1) PG8_BAR;
        PG8_WAIT_V(4); PG8_BAR;
        PG8_STAGE(PG8_SB(1, 0), cB + kstep, voffB); PG8_STAGE(PG8_SA(1, 0), cA + kstep, voffA); PG8_STAGE(PG8_SB(1, 1), cB + hstep + kstep, voffB);
        PG8_WAIT_V(6); PG8_BAR;
    }
    for (;;) {
        const bool has_next = S.next(ui + 1, nxt);
        const char* nA = has_next ? (const char*)g.A + (size_t)nxt.pm * tstep : cA; const char* nB = has_next ? (const char*)g.Bt + (size_t)nxt.pn * tstep : cB;
        for (int t = 0; t < nt; t += 2) {
            const bool last = (t == nt - 2);
            const char* a1 = cA + (size_t)(t + 1) * kstep;
            const char* a2 = last ? nA : cA + (size_t)(t + 2) * kstep; const char* b2 = last ? nB : cB + (size_t)(t + 2) * kstep;
            const char* a3 = a2 + kstep; const char* b3 = b2 + kstep;
            if (last && has_next) S.a_ready(nxt);
            if constexpr (SP2) {
            PG8_LDB(B0, 0, 0); PG8_LDB(B1, 0, 1); PG8_SCHED; PG8_LDA(At, 0, 0); PG8_STAGE(PG8_SA(1, 1), a1 + hstep, voffA);
            PG8_WAIT_V(8); PG8_WAIT_L(0); PG8_BAR; PG8_MMA(0, 0, At, B0); PG8_MMA(0, 1, At, B1); PG8_BAR; PG8_SCHED;
            PG8_LDA(At, 0, 1); PG8_STAGE(PG8_SB(0, 0), b2, voffB); PG8_STAGE(PG8_SB(0, 1), b2 + hstep, voffB); PG8_STAGE(PG8_SA(0, 0), a2, voffA);
            PG8_WAIT_V(8); PG8_WAIT_L(0); PG8_BAR; PG8_MMA(1, 0, At, B0); PG8_MMA(1, 1, At, B1); PG8_BAR; PG8_SCHED;
            PG8_LDB(B0, 1, 0); PG8_LDB(B1, 1, 1); PG8_SCHED; PG8_LDA(At, 1, 0); PG8_STAGE(PG8_SA(0, 1), a2 + hstep, voffA);
            PG8_WAIT_V(8); PG8_WAIT_L(0); PG8_BAR; PG8_MMA(0, 0, At, B0); PG8_MMA(0, 1, At, B1); PG8_BAR; PG8_SCHED;
            PG8_LDA(At, 1, 1); PG8_STAGE(PG8_SB(1, 0), b3, voffB); PG8_STAGE(PG8_SB(1, 1), b3 + hstep, voffB); PG8_STAGE(PG8_SA(1, 0), a3, voffA);
            PG8_WAIT_V(8); PG8_WAIT_L(0); PG8_BAR; PG8_MMA(1, 0, At, B0); PG8_MMA(1, 1, At, B1); PG8_BAR; PG8_SCHED;
            } else {
            PG8_LDB(B0, 0, 0); PG8_SCHED; PG8_LDA(At, 0, 0); PG8_STAGE(PG8_SA(1, 1), a1 + hstep, voffA);
            PG8_WAIT_L(8); PG8_BAR; PG8_WAIT_L(0); PG8_MMA(0, 0, At, B0); PG8_BAR; PG8_SCHED;
            PG8_LDB(B1, 0, 1); PG8_STAGE(PG8_SB(0, 0), b2, voffB);
            PG8_BAR; PG8_WAIT_L(0); PG8_MMA(0, 1, At, B1); PG8_BAR;
            PG8_LDA(At, 0, 1); PG8_STAGE(PG8_SA(0, 0), a2, voffA);
            PG8_BAR; PG8_WAIT_L(0); PG8_MMA(1, 0, At, B0); PG8_BAR; PG8_SCHED;
            PG8_STAGE(PG8_SB(0, 1), b2 + hstep, voffB);
            PG8_WAIT_V(6); PG8_BAR; PG8_MMA(1, 1, At, B1); PG8_BAR;
            PG8_LDB(B0, 1, 0); PG8_SCHED; PG8_LDA(At, 1, 0); PG8_STAGE(PG8_SA(0, 1), a2 + hstep, voffA);
            PG8_WAIT_L(8); PG8_BAR; PG8_WAIT_L(0); PG8_MMA(0, 0, At, B0); PG8_BAR; PG8_SCHED;
            PG8_LDB(B1, 1, 1); PG8_STAGE(PG8_SB(1, 0), b3, voffB);
            PG8_BAR; PG8_WAIT_L(0); PG8_MMA(0, 1, At, B1); PG8_BAR;
            PG8_LDA(At, 1, 1); PG8_STAGE(PG8_SA(1, 0), a3, voffA);
            PG8_BAR; PG8_WAIT_L(0); PG8_MMA(1, 0, At, B0); PG8_BAR; PG8_SCHED;
            PG8_STAGE(PG8_SB(1, 1), b3 + hstep, voffB);
            PG8_WAIT_V(6); PG8_BAR; PG8_MMA(1, 1, At, B1); PG8_BAR;
            }
        }
        if constexpr (ALIGN_EPI) { if (wr == 0) PG8_BAR; }
        if constexpr (!Epi::AFTER_DRAIN) { E(acc, cur, wr, wc, fr, fq); S.done(cur); }
        if (!has_next) break;
#pragma unroll
        for (int a = 0; a < 2; ++a)
#pragma unroll
            for (int b = 0; b < 2; ++b)
#pragma unroll
                for (int m = 0; m < 4; ++m)
#pragma unroll
                    for (int n = 0; n < 2; ++n) acc[a][b][m][n] = (f32x4){0.f, 0.f, 0.f, 0.f};
        cur = nxt; cA = nA; cB = nB; ++ui;
        if constexpr (ALIGN_EPI) { if (wr == 1) PG8_BAR; }
    }
    PG8_WAIT_V(0);
    if constexpr (!ALIGN_EPI) { if (wr == 0) PG8_BAR; }
    PG8_BAR;
    if constexpr (Epi::AFTER_DRAIN) { E.fused(acc, cur, wr, wc, fr, fq, lds, wid, lane); S.done(cur); }
#undef PG8_SA
#undef PG8_SB
#undef PG8_STAGE
#undef PG8_LDA
#undef PG8_LDB
#undef PG8_MMA
#undef PG8_WAIT_V
#undef PG8_WAIT_L
#undef PG8_BAR
#undef PG8_SCHED
}
template <class Epi, class Sched, bool ALIGN_EPI = false, bool SP2 = false>
__device__ __forceinline__ void gemm_phase(PG8_LAS unsigned char* lds, const Gemm g, const Sched& S, const Epi& E, const int tid) {
    static_assert(SP2, "the 192-row tile form exists for the SP2 loop only");
    const int wid = __builtin_amdgcn_readfirstlane(tid >> 6), lane = tid & 63, wr = wid >> 2, wc = wid & 3, fr = lane & 15, fq = lane >> 4;
    const int K = g.K, nt = K / BK;
    unsigned voffA[2], voffB[2];
#pragma unroll
    for (int i = 0; i < 2; ++i) { int R, C; stage_rc(tid * 16 + i * 8192, R, C); const int Rb = Epi::PERM ? ((R & ~31) + perm32(R & 31)) : R;
        voffA[i] = (unsigned)(R * K + C) * 2u; voffB[i] = (unsigned)(Rb * K + C) * 2u; }
    const size_t kstep = (size_t)(BK * 2);
    const size_t hstep = (size_t)HALF * K * 2;
    const size_t tstepA = (size_t)RM * K * 2;
    const size_t tstep = 2 * hstep;
    const unsigned ldsw = (unsigned)wid * 1024u;
    const int aoff = lds_byte(wr * 64 + fr, fq * 8), boff = lds_byte(wc * 32 + fr, fq * 8);
#define PG8_SA(b, h) (((b) * 2 + (h)) * HTB)
#define PG8_SB(b, h) ((4 + (b) * 2 + (h)) * HTB)
#define PG8_STAGE(bufoff, gbase, voff) do { _Pragma("unroll") for (int _i = 0; _i < 2; ++_i) \
        __builtin_amdgcn_global_load_lds((const unsigned*)((const char*)(gbase) + (voff)[_i]), (PG8_LAS unsigned*)(lds + (bufoff) + ldsw + _i * 8192), 16, 0, 0); } while (0)
#define PG8_LDA(dst, b, h) do { _Pragma("unroll") for (int m = 0; m < 4; ++m) _Pragma("unroll") for (int k = 0; k < 2; ++k) dst[m][k] = *(const PG8_LAS bf16x8*)(lds + PG8_SA(b, h) + aoff + m * 2048 + k * 1024); } while (0)
#define PG8_LDB(dst, b, h) do { _Pragma("unroll") for (int n = 0; n < 2; ++n) _Pragma("unroll") for (int k = 0; k < 2; ++k) dst[n][k] = *(const PG8_LAS bf16x8*)(lds + PG8_SB(b, h) + boff + n * 2048 + k * 1024); } while (0)
#define PG8_MMA(ai, bj, At, Bt) do { __builtin_amdgcn_s_setprio(1); _Pragma("unroll") for (int m = 0; m < 4; ++m) _Pragma("unroll") for (int n = 0; n < 2; ++n) _Pragma("unroll") for (int k = 0; k < 2; ++k) \
        acc[ai][bj][m][n] = __builtin_amdgcn_mfma_f32_16x16x32_bf16(Bt[n][k], At[m][k], acc[ai][bj][m][n], 0, 0, 0); __builtin_amdgcn_s_setprio(0); } while (0)
    const int aoff1 = lds_byte(wr * 32 + fr, fq * 8);
#define PG8_STAGE1(bufoff, gbase, voff) __builtin_amdgcn_global_load_lds((const unsigned*)((const char*)(gbase) + (voff)[0]), (PG8_LAS unsigned*)(lds + (bufoff) + ldsw), 16, 0, 0)
#define PG8_LDA1(dst, b) do { _Pragma("unroll") for (int m = 0; m < 2; ++m) _Pragma("unroll") for (int k = 0; k < 2; ++k) dst[m][k] = *(const PG8_LAS bf16x8*)(lds + PG8_SA(b, 1) + aoff1 + m * 2048 + k * 1024); } while (0)
#define PG8_MMA1(bj, At, Bt) do { __builtin_amdgcn_s_setprio(1); _Pragma("unroll") for (int m = 0; m < 2; ++m) _Pragma("unroll") for (int n = 0; n < 2; ++n) _Pragma("unroll") for (int k = 0; k < 2; ++k) \
        acc[1][bj][m][n] = __builtin_amdgcn_mfma_f32_16x16x32_bf16(Bt[n][k], At[m][k], acc[1][bj][m][n], 0, 0, 0); __builtin_amdgcn_s_setprio(0); } while (0)
#define PG8_WAIT_V(n) asm volatile("s_waitcnt vmcnt(" #n ")" ::: "memory")
#define PG8_WAIT_L(n) asm volatile("s_waitcnt lgkmcnt(" #n ")" ::: "memory")
#define PG8_BAR __builtin_amdgcn_s_barrier()
#define PG8_SCHED __builtin_amdgcn_sched_barrier(0)
    Unit cur, nxt; int ui = 0;
    if (!S.next(0, cur)) return;
    f32x4 acc[2][2][4][2];
#pragma unroll
    for (int a = 0; a < 2; ++a)
#pragma unroll
        for (int b = 0; b < 2; ++b)
#pragma unroll
            for (int m = 0; m < 4; ++m)
#pragma unroll
                for (int n = 0; n < 2; ++n) acc[a][b][m][n] = (f32x4){0.f, 0.f, 0.f, 0.f};
    bf16x8 At[4][2], B0[2][2], B1[2][2];
    const char* cA = (const char*)g.A + (size_t)cur.pm * tstepA; const char* cB = (const char*)g.Bt + (size_t)cur.pn * tstep;
    S.a_ready(cur);
    if constexpr (SP2) {
        PG8_STAGE(PG8_SB(0, 0), cB, voffB); PG8_STAGE(PG8_SB(0, 1), cB + hstep, voffB); PG8_STAGE(PG8_SA(0, 0), cA, voffA); PG8_STAGE1(PG8_SA(0, 1), cA + hstep, voffA);
        if (wr == 1) PG8_BAR;
        PG8_WAIT_V(1); PG8_BAR;
        PG8_STAGE(PG8_SB(1, 0), cB + kstep, voffB); PG8_STAGE(PG8_SA(1, 0), cA + kstep, voffA); PG8_STAGE(PG8_SB(1, 1), cB + hstep + kstep, voffB);
        PG8_WAIT_V(6); PG8_BAR;
    } else {
        PG8_STAGE(PG8_SB(0, 0), cB, voffB); PG8_STAGE(PG8_SA(0, 0), cA, voffA); PG8_STAGE(PG8_SB(0, 1), cB + hstep, voffB); PG8_STAGE(PG8_SA(0, 1), cA + hstep, voffA);
        if (wr == 1) PG8_BAR;
        PG8_WAIT_V(4); PG8_BAR;
        PG8_STAGE(PG8_SB(1, 0), cB + kstep, voffB); PG8_STAGE(PG8_SA(1, 0), cA + kstep, voffA); PG8_STAGE(PG8_SB(1, 1), cB + hstep + kstep, voffB);
        PG8_WAIT_V(6); PG8_BAR;
    }
    for (;;) {
        const bool has_next = S.next(ui + 1, nxt);
        const char* nA = has_next ? (const char*)g.A + (size_t)nxt.pm * tstepA : cA; const char* nB = has_next ? (const char*)g.Bt + (size_t)nxt.pn * tstep : cB;
        for (int t = 0; t < nt; t += 2) {
            const bool last = (t == nt - 2);
            const char* a1 = cA + (size_t)(t + 1) * kstep;
            const char* a2 = last ? nA : cA + (size_t)(t + 2) * kstep; const char* b2 = last ? nB : cB + (size_t)(t + 2) * kstep;
            const char* a3 = a2 + kstep; const char* b3 = b2 + kstep;
            if (last && has_next) S.a_ready(nxt);
            if constexpr (SP2) {
            PG8_LDB(B0, 0, 0); PG8_LDB(B1, 0, 1); PG8_SCHED; PG8_LDA(At, 0, 0); PG8_STAGE1(PG8_SA(1, 1), a1 + hstep, voffA);
            PG8_WAIT_V(7); PG8_WAIT_L(0); PG8_BAR; PG8_MMA(0, 0, At, B0); PG8_MMA(0, 1, At, B1); PG8_BAR; PG8_SCHED;
            PG8_LDA1(At, 0); PG8_STAGE(PG8_SB(0, 0), b2, voffB); PG8_STAGE(PG8_SB(0, 1), b2 + hstep, voffB); PG8_STAGE(PG8_SA(0, 0), a2, voffA);
            PG8_WAIT_V(7); PG8_WAIT_L(0); PG8_BAR; PG8_MMA1(0, At, B0); PG8_MMA1(1, At, B1); PG8_BAR; PG8_SCHED;
            PG8_LDB(B0, 1, 0); PG8_LDB(B1, 1, 1); PG8_SCHED; PG8_LDA(At, 1, 0); PG8_STAGE1(PG8_SA(0, 1), a2 + hstep, voffA);
            PG8_WAIT_V(7); PG8_WAIT_L(0); PG8_BAR; PG8_MMA(0, 0, At, B0); PG8_MMA(0, 1, At, B1); PG8_BAR; PG8_SCHED;
            PG8_LDA1(At, 1); PG8_STAGE(PG8_SB(1, 0), b3, voffB); PG8_STAGE(PG8_SB(1, 1), b3 + hstep, voffB); PG8_STAGE(PG8_SA(1, 0), a3, voffA);
            PG8_WAIT_V(7); PG8_WAIT_L(0); PG8_BAR; PG8_MMA1(0, At, B0); PG8_MMA1(1, At, B1); PG8_BAR; PG8_SCHED;
            } else {
            PG8_LDB(B0, 0, 0); PG8_SCHED; PG8_LDA(At, 0, 0); PG8_STAGE(PG8_SA(1, 1), a1 + hstep, voffA);
            PG8_WAIT_L(8); PG8_BAR; PG8_WAIT_L(0); PG8_MMA(0, 0, At, B0); PG8_BAR; PG8_SCHED;
            PG8_LDB(B1, 0, 1); PG8_STAGE(PG8_SB(0, 0), b2, voffB);
            PG8_BAR; PG8_WAIT_L(0); PG8_MMA(0, 1, At, B1); PG8_BAR;
            PG8_LDA(At, 0, 1); PG8_STAGE(PG8_SA(0, 0), a2, voffA);
            PG8_BAR; PG8_WAIT_L(0); PG8_MMA(1, 0, At, B0); PG8_BAR; PG8_SCHED;
            PG8_STAGE(PG8_SB(0, 1), b2 + hstep, voffB);
            PG8_WAIT_V(6); PG8_BAR; PG8_MMA(1, 1, At, B1); PG8_BAR;
            PG8_LDB(B0, 1, 0); PG8_SCHED; PG8_LDA(At, 1, 0); PG8_STAGE(PG8_SA(0, 1), a2 + hstep, voffA);
            PG8_WAIT_L(8); PG8_BAR; PG8_WAIT_L(0); PG8_MMA(0, 0, At, B0); PG8_BAR; PG8_SCHED;
            PG8_LDB(B1, 1, 1); PG8_STAGE(PG8_SB(1, 0), b3, voffB);
            PG8_BAR; PG8_WAIT_L(0); PG8_MMA(0, 1, At, B1); PG8_BAR;
            PG8_LDA(At, 1, 1); PG8_STAGE(PG8_SA(1, 0), a3, voffA);
            PG8_BAR; PG8_WAIT_L(0); PG8_MMA(1, 0, At, B0); PG8_BAR; PG8_SCHED;
            PG8_STAGE(PG8_SB(1, 1), b3 + hstep, voffB);
            PG8_WAIT_V(6); PG8_BAR; PG8_MMA(1, 1, At, B1); PG8_BAR;
            }
        }
        if constexpr (ALIGN_EPI) { if (wr == 0) PG8_BAR; }
        if constexpr (!Epi::AFTER_DRAIN) { E(acc, cur, wr, wc, fr, fq); S.done(cur); }
        if (!has_next) break;
#pragma unroll
        for (int a = 0; a < 2; ++a)
#pragma unroll
            for (int b = 0; b < 2; ++b)
#pragma unroll
                for (int m = 0; m < 4; ++m)
#pragma unroll
                    for (int n = 0; n < 2; ++n) acc[a][b][m][n] = (f32x4){0.f, 0.f, 0.f, 0.f};
        cur = nxt; cA = nA; cB = nB; ++ui;
        if constexpr (ALIGN_EPI) { if (wr == 1) PG8_BAR; }
    }
    PG8_WAIT_V(0);
    if constexpr (!ALIGN_EPI) { if (wr == 0) PG8_BAR; }
    PG8_BAR;
    if constexpr (Epi::AFTER_DRAIN) { E.fused(acc, cur, wr, wc, fr, fq, lds, wid, lane); S.done(cur); }
#undef PG8_SA
#undef PG8_SB
#undef PG8_STAGE
#undef PG8_LDA
#undef PG8_LDB
#undef PG8_MMA
#undef PG8_STAGE1
#undef PG8_LDA1
#undef PG8_MMA1
#undef PG8_WAIT_V
#undef PG8_WAIT_L
#undef PG8_BAR
#undef PG8_SCHED
}
}
constexpr int D = 1024, MP = 8192, MS = 4096, M = MP + MS, FF = 4096, NL = 4;
constexpr int NWAVES = 8, NTHR = 512;
constexpr size_t MiB = 1u << 20;
constexpr size_t WS_MOD = 1 * MiB;
constexpr size_t WS_W = 2 * MiB;
constexpr size_t WS_X = 94 * MiB;
constexpr size_t WS_H = 142 * MiB;
constexpr size_t WS_R = 166 * MiB;
constexpr size_t WS_CK = 262 * MiB, WS_CV = 266 * MiB, WS_SHW = 270 * MiB, WS_SS = 271 * MiB, WS_END = 272 * MiB;
constexpr size_t MEL = 1u << 20;
constexpr size_t W_QKV = 0, W_O = 6 * MEL, W_PW1 = 8 * MEL, W_PW2 = 12 * MEL, W_UP = 14 * MEL, W_DOWN = 30 * MEL;
constexpr int LDS_BYTES = 163840, LDS_ST = LDS_BYTES - 16, LDS_KC = 112640;

#define LAS __attribute__((address_space(3)))
#define SB0() __builtin_amdgcn_sched_barrier(0)
typedef unsigned short bf16;
typedef float f32x4 __attribute__((ext_vector_type(4)));
typedef float f32x2 __attribute__((ext_vector_type(2)));
typedef unsigned u32x4 __attribute__((ext_vector_type(4)));
typedef unsigned u32x2 __attribute__((ext_vector_type(2)));
typedef short bf16x8 __attribute__((ext_vector_type(8)));
typedef short s16x4 __attribute__((ext_vector_type(4)));
typedef float f32x32 __attribute__((ext_vector_type(32)));

__device__ __forceinline__ unsigned f2bf(float f) { unsigned u = __builtin_bit_cast(unsigned, f); return (u + 0x7fffu + ((u >> 16) & 1u)) >> 16; }
__device__ __forceinline__ unsigned pk2(float lo, float hi) { unsigned r; asm("v_cvt_pk_bf16_f32 %0, %1, %2" : "=v"(r) : "v"(lo), "v"(hi)); return r; }
__device__ __forceinline__ float bflo(unsigned w) { return __builtin_bit_cast(float, w << 16); }
__device__ __forceinline__ float bfhi(unsigned w) { return __builtin_bit_cast(float, w & 0xffff0000u); }
__device__ __forceinline__ float shx(float v, int k, int lane) { return __builtin_bit_cast(float, __builtin_amdgcn_ds_bpermute((lane ^ k) << 2, __builtin_bit_cast(int, v))); }
__device__ __forceinline__ float wave_sum(float v, int lane) {
#pragma unroll
    for (int o = 1; o < 64; o <<= 1) v += shx(v, o, lane);
    return v;
}

template <bool GLU>
__device__ __forceinline__ void transpose_item(const float* W, int K, int N, bf16* WT, LAS float* scr, int item, int lane) {
    const int nblk = N / 32, kb = item / nblk, nb = item % nblk, k0 = 64 * kb, n0 = 32 * nb;
    { float tv[32];
#pragma unroll
      for (int i = 0; i < 32; ++i) tv[i] = __builtin_nontemporal_load(W + (size_t)(k0 + 2 * i + (lane >> 5)) * N + n0 + (lane & 31));
      __builtin_amdgcn_sched_barrier(0);
#pragma unroll
      for (int i = 0; i < 32; ++i) scr[(2 * i + (lane >> 5)) * 33 + (lane & 31)] = tv[i]; }
    asm volatile("s_waitcnt lgkmcnt(0)" ::: "memory");
    int d0 = n0;
    if (GLU) { const int nn = n0 & 1023; d0 = ((nn >> 7) << 8) + (nn & 127) + ((n0 >> 10) << 7); }
    const int c = lane & 7;
#pragma unroll
    for (int j = 0; j < 4; ++j) { const int n = (lane >> 3) + 8 * j; const LAS float* s = scr + (8 * c) * 33 + n;
        u32x4 o; o.x = pk2(s[0 * 33], s[1 * 33]); o.y = pk2(s[2 * 33], s[3 * 33]); o.z = pk2(s[4 * 33], s[5 * 33]); o.w = pk2(s[6 * 33], s[7 * 33]);
        *(u32x4*)(WT + (size_t)(d0 + n) * K + k0 + 8 * c) = o; }
    asm volatile("s_waitcnt lgkmcnt(0)" ::: "memory");
}

struct Ptrs {
    const float *x_prompt, *x_sample, *cache_k, *cache_v, *c, *c_ctx, *norm_g, *w_ada, *b_ada, *w_qkv, *w_o, *rpb, *w_pw1, *w_dw, *b_dw, *ln_g, *ln_b, *w_pw2, *w_up, *w_down, *final_g;
};

__device__ __forceinline__ void p0_phase(const Ptrs& P, unsigned char* ws, LAS unsigned char* lds, int tid, int lane, int wave, int G, int bid) {
    bf16* Wt = (bf16*)(ws + WS_W);
    const int gw = bid * NWAVES + wave, NGW = G * NWAVES;
    LAS float* scr = (LAS float*)(lds + wave * 16384);
    constexpr int NIT = 23552;
    for (int it = gw; it < NIT; it += NGW) {
        if (it < 7168) { const int i = it / 3584; int r = it % 3584;
            if (r < 1536) { transpose_item<false>(P.w_qkv + (size_t)i * D * 3 * D, D, 3 * D, Wt + W_QKV + (size_t)i * 3 * MEL, scr, r, lane); continue; } r -= 1536;
            if (r < 512) { transpose_item<false>(P.w_o + (size_t)i * D * D, D, D, Wt + W_O + (size_t)i * MEL, scr, r, lane); continue; } r -= 512;
            if (r < 1024) { transpose_item<true>(P.w_pw1 + (size_t)i * D * 2 * D, D, 2 * D, Wt + W_PW1 + (size_t)i * 2 * MEL, scr, r, lane); continue; } r -= 1024;
            transpose_item<false>(P.w_pw2 + (size_t)i * D * D, D, D, Wt + W_PW2 + (size_t)i * MEL, scr, r, lane);
        } else { const int l = (it - 7168) / 4096; int r = (it - 7168) % 4096;
            if (r < 2048) transpose_item<false>(P.w_up + (size_t)l * D * FF, D, FF, Wt + W_UP + (size_t)l * 4 * MEL, scr, r, lane);
            else transpose_item<false>(P.w_down + (size_t)l * D * FF, FF, D, Wt + W_DOWN + (size_t)l * 4 * MEL, scr, r - 2048, lane);
        }
    }
    { bf16* CK = (bf16*)(ws + WS_CK); bf16* CV = (bf16*)(ws + WS_CV);
      const int NT = G * NTHR; constexpr int NV = 2 * 4 * 2 * 256 * 1024 / 4;
      for (int v = bid * NTHR + tid; v < NV; v += NT) { const int which = v >= NV / 2; const int e = (which ? v - NV / 2 : v) * 4;
          const f32x4 a = __builtin_nontemporal_load((const f32x4*)((which ? P.cache_v : P.cache_k) + e));
          u32x2 o; o.x = pk2(a[0], a[1]); o.y = pk2(a[2], a[3]);
          *(u32x2*)((which ? CV : CK) + e) = o; } }
    { f32x4* z = (f32x4*)(ws + WS_SS); const int NT = G * NTHR; float zf = 0.f; asm volatile("" : "+v"(zf));
      const f32x4 zz = (f32x4){zf, zf, zf, zf}; for (int v = bid * NTHR + tid; v < 9 * M / 4; v += NT) z[v] = zz; }
    __syncthreads();
    { LAS float* sil = (LAS float*)lds; LAS float* red = (LAS float*)(lds + 20480); float* mod = (float*)(ws + WS_MOD);
      for (int k = tid; k < 5 * 1024; k += NTHR) { const int cc = k >> 10, kk = k & 1023; const float v = cc == 0 ? P.c_ctx[kk] : P.c[(cc - 1) * 1024 + kk]; sil[k] = v / (1.f + __expf(-v)); }
      __syncthreads();
      const int kg = tid >> 4, cl = tid & 15; const bool cact = cl < 12;
      for (int item = bid; item < 512; item += G) { const int l = item >> 7, n0 = (item & 127) * 48;
          const float* W = P.w_ada + (size_t)l * D * 6144 + n0 + 4 * cl;
          f32x4 a[5];
#pragma unroll
          for (int cc = 0; cc < 5; ++cc) a[cc] = (f32x4){0.f, 0.f, 0.f, 0.f};
#pragma unroll 4
          for (int kk = 0; kk < 32; ++kk) { const int k = kg * 32 + kk; f32x4 w = (f32x4){0.f, 0.f, 0.f, 0.f}; if (cact) w = __builtin_nontemporal_load((const f32x4*)(W + (size_t)k * 6144));
#pragma unroll
              for (int cc = 0; cc < 5; ++cc) a[cc] += sil[cc * 1024 + k] * w; }
#pragma unroll
          for (int cc = 0; cc < 5; ++cc) *(LAS f32x4*)(red + (kg * 5 + cc) * 64 + 4 * cl) = a[cc];
          __syncthreads();
          if (tid < 320 && (tid & 63) < 48) { const int cc = tid >> 6, n = tid & 63; float s = 0.f;
#pragma unroll 8
              for (int g = 0; g < 32; ++g) s += red[(g * 5 + cc) * 64 + n];
              mod[(size_t)(l * 5 + cc) * 6144 + n0 + n] = s + P.b_ada[l * 6144 + n0 + n]; }
          __syncthreads();
      } }
}

__device__ __forceinline__ void norm_phase(const float* xp, const float* xs, bf16* H, float* yout, const float* g, const float* shift, const float* scale, int gw, int NGW, int lane) {
    f32x4 gv[4];
#pragma unroll
    for (int j = 0; j < 4; ++j) gv[j] = *(const f32x4*)(g + 4 * (lane + 64 * j));
    for (int m = gw; m < M; m += NGW) {
        const float* xrow = m < MP ? xp + (size_t)m * D : xs + (size_t)(m - MP) * D;
        const int cond = m < MP ? 0 : 1 + ((m - MP) >> 10);
        f32x4 v[4]; float ss = 0.f;
#pragma unroll
        for (int j = 0; j < 4; ++j) { v[j] = *(const f32x4*)(xrow + 4 * (lane + 64 * j)); ss += (v[j][0] * v[j][0] + v[j][1] * v[j][1]) + (v[j][2] * v[j][2] + v[j][3] * v[j][3]); }
        const float r = 1.0f / sqrtf(wave_sum(ss, lane) * (1.f / D) + 1e-6f);
        if (yout) {
#pragma unroll
            for (int j = 0; j < 4; ++j) *(f32x4*)(yout + (size_t)m * D + 4 * (lane + 64 * j)) = v[j] * r * gv[j];
        } else {
#pragma unroll
            for (int j = 0; j < 4; ++j) { const f32x4 sc = *(const f32x4*)(scale + cond * 6144 + 4 * (lane + 64 * j)), sh = *(const f32x4*)(shift + cond * 6144 + 4 * (lane + 64 * j));
                const f32x4 h = (v[j] * r * gv[j]) * (1.f + sc) + sh; u32x2 o; o.x = pk2(h[0], h[1]); o.y = pk2(h[2], h[3]);
                *(u32x2*)(H + (size_t)m * D + 4 * (lane + 64 * j)) = o; }
        }
    }
}

template <class F, int... I> __device__ __forceinline__ void sfor_impl(F&& f, std::integer_sequence<int, I...>) { (f(std::integral_constant<int, I>{}), ...); }
template <int N, class F> __device__ __forceinline__ void sfor(F&& f) { sfor_impl(f, std::make_integer_sequence<int, N>{}); }
__device__ __forceinline__ float dpp_add(float v, int ctrl_b1, int ctrl_4e, int dummy) { return v; }
__device__ __forceinline__ float wave_sum_dpp(float v) {
    v += __builtin_bit_cast(float, __builtin_amdgcn_update_dpp(0, __builtin_bit_cast(int, v), 0xB1, 0xf, 0xf, false));
    v += __builtin_bit_cast(float, __builtin_amdgcn_update_dpp(0, __builtin_bit_cast(int, v), 0x4E, 0xf, 0xf, false));
    v += __builtin_bit_cast(float, __builtin_amdgcn_update_dpp(0, __builtin_bit_cast(int, v), 0x141, 0xf, 0xf, false));
    v += __builtin_bit_cast(float, __builtin_amdgcn_update_dpp(0, __builtin_bit_cast(int, v), 0x140, 0xf, 0xf, false));
    const int vi = __builtin_bit_cast(int, v);
    return (__builtin_bit_cast(float, __builtin_amdgcn_readlane(vi, 0)) + __builtin_bit_cast(float, __builtin_amdgcn_readlane(vi, 16))) +
           (__builtin_bit_cast(float, __builtin_amdgcn_readlane(vi, 32)) + __builtin_bit_cast(float, __builtin_amdgcn_readlane(vi, 48)));
}
constexpr int CT = 16, CROWS = CT + 30, CCS = 16, CCH = (CROWS + CCS - 1) / CCS;
__device__ __forceinline__ void conv_phase(const bf16* U, bf16* Vc, const float* wdw, const float* bdw, const float* lng, const float* lnb, LAS unsigned char* lds, int tid, int lane, int wave, int G, int bid) {
    f32x2 w[31];
    sfor<31>([&](auto K) __attribute__((always_inline)) { constexpr int k = decltype(K)::value; w[k] = *(const f32x2*)(wdw + k * D + 2 * tid); });
    const f32x2 bd = *(const f32x2*)(bdw + 2 * tid), lg = *(const f32x2*)(lng + 2 * tid), lb = *(const f32x2*)(lnb + 2 * tid);
    LAS f32x2* part = (LAS f32x2*)lds;
    LAS f32x2* stats = part + 8 * CT;
    for (int un_ = bid; un_ < M / CT; un_ += G) {
        const int unit = (G == 256) ? (un_ & 7) * (M / CT / 8) + ((un_ >> 3) & 31) + 32 * (un_ >> 8) : un_;
        const int m0 = unit * CT, seg = m0 < MP ? 0 : MP, L = m0 < MP ? 256 : 1024, t0 = (m0 - seg) & (L - 1);
        const bf16* Ub = U + (size_t)(m0 - t0) * D + 2 * tid;
        f32x2 acc[CT];
        sfor<CT>([&](auto O) __attribute__((always_inline)) { acc[decltype(O)::value] = bd; });
        sfor<CCH>([&](auto C) __attribute__((always_inline)) { constexpr int c = decltype(C)::value;
            unsigned raw[CCS];
            sfor<CCS>([&](auto I) __attribute__((always_inline)) { constexpr int i = decltype(I)::value, j = c * CCS + i;
                if constexpr (j < CROWS) { const int t = t0 - 15 + j, tc = min(max(t, 0), L - 1);
                    raw[i] = *(const unsigned*)(Ub + (size_t)tc * D); } });
            SB0();
            sfor<CCS>([&](auto I) __attribute__((always_inline)) { constexpr int i = decltype(I)::value, j = c * CCS + i;
                if constexpr (j < CROWS) { const int t = t0 - 15 + j; const unsigned rm = raw[i] & (unsigned)(-(int)((t >= 0) & (t < L))); const f32x2 u = (f32x2){bflo(rm), bfhi(rm)};
                    sfor<31>([&](auto K) __attribute__((always_inline)) { constexpr int k = decltype(K)::value, o = j - k;
                        if constexpr (o >= 0 && o < CT) acc[o] += u * w[k]; }); } });
        });
        sfor<CT>([&](auto O) __attribute__((always_inline)) { constexpr int o = decltype(O)::value;
            const float s = wave_sum_dpp(acc[o].x + acc[o].y), q = wave_sum_dpp(acc[o].x * acc[o].x + acc[o].y * acc[o].y); if (lane == 0) part[wave * CT + o] = (f32x2){s, q}; });
        __syncthreads();
        if (tid < CT) { float s = 0.f, q = 0.f;
#pragma unroll
            for (int wv = 0; wv < 8; ++wv) { const f32x2 p = part[wv * CT + tid]; s += p.x; q += p.y; }
            const float mean = s * (1.f / D), var = fmaxf(q * (1.f / D) - mean * mean, 0.f); stats[tid] = (f32x2){mean, 1.0f / sqrtf(var + 1e-5f)}; }
        __syncthreads();
        sfor<CT>([&](auto O) __attribute__((always_inline)) { constexpr int o = decltype(O)::value;
            const f32x2 st = stats[o]; f32x2 y = (acc[o] - st.x) * st.y * lg + lb;
            y.x = y.x * __builtin_amdgcn_rcpf(1.f + __expf(-y.x)); y.y = y.y * __builtin_amdgcn_rcpf(1.f + __expf(-y.y));
            *(unsigned*)(Vc + (size_t)(m0 + o) * D + 2 * tid) = pk2(y.x, y.y); });
        __syncthreads();
    }
}

__device__ __forceinline__ void final_norm_phase(const bf16* X, float* yout, const float* g, int gw, int NGW, int lane) {
    f32x4 gv[4];
#pragma unroll
    for (int j = 0; j < 4; ++j) gv[j] = *(const f32x4*)(g + 4 * (lane + 64 * j));
    for (int m = gw; m < M; m += NGW) {
        const bf16* xr = X + (size_t)m * D;
        f32x4 v[4]; float sq = 0.f;
#pragma unroll
        for (int j = 0; j < 4; ++j) { const u32x2 w = *(const u32x2*)(xr + 4 * (lane + 64 * j)); v[j] = (f32x4){bflo(w.x), bfhi(w.x), bflo(w.y), bfhi(w.y)};
            sq += (v[j][0] * v[j][0] + v[j][1] * v[j][1]) + (v[j][2] * v[j][2] + v[j][3] * v[j][3]); }
        const float r = 1.0f / sqrtf(wave_sum_dpp(sq) * (1.f / D) + 1e-6f);
#pragma unroll
        for (int j = 0; j < 4; ++j) __builtin_nontemporal_store(v[j] * r * gv[j], (f32x4*)(yout + (size_t)m * D + 4 * (lane + 64 * j)));
    }
}

__device__ __forceinline__ void prep_phase(const float* xp, const float* xs, bf16* H, float* ss0, const float* g, const float* scale, const float* mod, const bf16* Wt, float* shw, int gw, int NGW, int lane) {
    { f32x4 gv[4];
#pragma unroll
      for (int j = 0; j < 4; ++j) gv[j] = *(const f32x4*)(g + 4 * (lane + 64 * j));
      for (int m = gw; m < M; m += NGW) {
          const float* xrow = m < MP ? xp + (size_t)m * D : xs + (size_t)(m - MP) * D;
          const int cond = m < MP ? 0 : 1 + ((m - MP) >> 10);
          f32x4 v[4]; float sq = 0.f;
#pragma unroll
          for (int j = 0; j < 4; ++j) { v[j] = *(const f32x4*)(xrow + 4 * (lane + 64 * j)); sq += (v[j][0] * v[j][0] + v[j][1] * v[j][1]) + (v[j][2] * v[j][2] + v[j][3] * v[j][3]); }
          sq = wave_sum_dpp(sq); if (lane == 0) ss0[m] = sq;
          f32x4 sc[4];
#pragma unroll
          for (int j = 0; j < 4; ++j) sc[j] = *(const f32x4*)(scale + cond * 6144 + 4 * (lane + 64 * j));
#pragma unroll
          for (int j = 0; j < 4; ++j) { const f32x4 h = v[j] * gv[j] * (1.f + sc[j]); u32x2 o; o.x = pk2(h[0], h[1]); o.y = pk2(h[2], h[3]);
              *(u32x2*)(H + (size_t)m * D + 4 * (lane + 64 * j)) = o; }
      } }
    for (int it = gw; it < 4 * 8192; it += NGW) {
        const int l = it >> 13, which = (it >> 12) & 1, n = it & 4095, i = l >> 1; const bool conv = (l & 1) != 0;
        const int N = which ? 4096 : (conv ? 2048 : 3072);
        if (n >= N) continue;
        const bf16* wrow = Wt + (which ? W_UP + (size_t)l * 4 * MEL : (conv ? W_PW1 + (size_t)i * 2 * MEL : W_QKV + (size_t)i * 3 * MEL)) + (size_t)n * D;
        float wv[16];
#pragma unroll
        for (int jj = 0; jj < 4; ++jj) { const u32x2 w = *(const u32x2*)(wrow + 4 * (lane + 64 * jj)); wv[4 * jj] = bflo(w.x); wv[4 * jj + 1] = bfhi(w.x); wv[4 * jj + 2] = bflo(w.y); wv[4 * jj + 3] = bfhi(w.y); }
#pragma unroll
        for (int cond = 0; cond < 5; ++cond) { const float* sh = mod + (size_t)(l * 5 + cond) * 6144 + (which ? 3 : 0) * 1024; float dot = 0.f;
#pragma unroll
            for (int jj = 0; jj < 4; ++jj) { const f32x4 s4 = *(const f32x4*)(sh + 4 * (lane + 64 * jj)); dot += (s4[0] * wv[4 * jj] + s4[1] * wv[4 * jj + 1]) + (s4[2] * wv[4 * jj + 2] + s4[3] * wv[4 * jj + 3]); }
            dot = wave_sum_dpp(dot); if (lane == 0) shw[(size_t)((l * 2 + which) * 5 + cond) * 4096 + n] = dot; }
    }
}

constexpr float SCL = 0.125f * 1.4426950408889634f, LOG2E = 1.4426950408889634f;
__device__ __forceinline__ void vt_write(LAS bf16* Vt, int pitch, int slot, int chunk, u32x4 v) {
    LAS bf16* p = Vt + (8 * chunk) * pitch + (slot ^ (chunk << 2));
    p[0] = (bf16)(v.x & 0xffffu); p[pitch] = (bf16)(v.x >> 16); p[2 * pitch] = (bf16)(v.y & 0xffffu); p[3 * pitch] = (bf16)(v.y >> 16);
    p[4 * pitch] = (bf16)(v.z & 0xffffu); p[5 * pitch] = (bf16)(v.z >> 16); p[6 * pitch] = (bf16)(v.w & 0xffffu); p[7 * pitch] = (bf16)(v.w >> 16);
}
template <int NB> __device__ __forceinline__ void softmax_part(f32x4 (&s)[NB], float& mx_out, float& sum_out, int lane, float m_floor = -INFINITY) {
    float mx = m_floor;
#pragma unroll
    for (int b = 0; b < NB; ++b) mx = fmaxf(mx, fmaxf(fmaxf(s[b][0], s[b][1]), fmaxf(s[b][2], s[b][3])));
    mx = fmaxf(mx, shx(mx, 16, lane)); mx = fmaxf(mx, shx(mx, 32, lane));
    float sum = 0.f;
#pragma unroll
    for (int b = 0; b < NB; ++b) {
#pragma unroll
        for (int e = 0; e < 4; ++e) { s[b][e] = __builtin_amdgcn_exp2f(s[b][e] - mx); sum += s[b][e]; } }
    sum += shx(sum, 16, lane); sum += shx(sum, 32, lane);
    mx_out = mx; sum_out = sum;
}
__device__ __forceinline__ bf16x8 pack_p(const f32x4& a, const f32x4& b) {
    u32x4 w; w.x = pk2(a[0], a[1]); w.y = pk2(a[2], a[3]); w.z = pk2(b[0], b[1]); w.w = pk2(b[2], b[3]); return __builtin_bit_cast(bf16x8, w);
}
__device__ __forceinline__ bf16x8 vt_read(const LAS bf16* p0, const LAS bf16* p1) {
    const s16x4 a = *(const LAS s16x4*)p0, b = *(const LAS s16x4*)p1; return (bf16x8){a[0], a[1], a[2], a[3], b[0], b[1], b[2], b[3]};
}
__device__ __forceinline__ f32x4 qk_block(const bf16* kp, const bf16x8& qf0, const bf16x8& qf1) {
    const bf16x8 k0 = *(const bf16x8*)kp, k1 = *(const bf16x8*)(kp + 32);
    f32x4 a = __builtin_amdgcn_mfma_f32_16x16x32_bf16(k0, qf0, (f32x4){0.f, 0.f, 0.f, 0.f}, 0, 0, 0);
    return __builtin_amdgcn_mfma_f32_16x16x32_bf16(k1, qf1, a, 0, 0, 0);
}
#define PV16(o, s, SLOT_EXPR, PITCH_) do { _Pragma("unroll") for (int pp = 0; pp < 8; ++pp) { const bf16x8 pf = pack_p(s[2 * pp], s[2 * pp + 1]); const int slot0 = (SLOT_EXPR); \
        _Pragma("unroll") for (int db = 0; db < 4; ++db) { const LAS bf16* vr = Vt + (16 * db + l15) * (PITCH_); const int sw_ = (2 * db + (l15 >> 3)) << 2; \
            o[db] = __builtin_amdgcn_mfma_f32_16x16x32_bf16(vt_read(vr + (slot0 ^ sw_), vr + ((slot0 + 16) ^ sw_)), pf, o[db], 0, 0, 0); } } } while (0)

#ifndef CBN
#define CBN 4
#endif
__device__ __forceinline__ void attn_phase(const bf16* Qb, const bf16* Kb, const bf16* Vb, bf16* Ob, const bf16* CK, const bf16* CV, const float* rpb  ,
                                           int li, LAS unsigned char* lds, int tid, int lane, int wave, int G, int bid, int ulo, int uhi) {
    LAS bf16* Vt = (LAS bf16*)lds; LAS float* rpl = (LAS float*)(lds + 110592); LAS unsigned char* Kc = lds + LDS_KC;
    for (int u = bid + ulo; u < uhi; u += G) {
        int lz_ = lane; asm volatile("" : "+v"(lz_));
        const int l15 = lz_ & 15, g = lz_ >> 4;
        if (u < 512) {
            const int b = u >> 4, h = u & 15; constexpr int PITCH = 264;
            const int qrow0 = b * 256 + 32 * wave + l15;
            const bf16x8 qa0 = *(const bf16x8*)(Qb + (size_t)qrow0 * D + h * 64 + 8 * g), qa1 = *(const bf16x8*)(Qb + (size_t)qrow0 * D + h * 64 + 32 + 8 * g);
            const bf16x8 qb0 = *(const bf16x8*)(Qb + (size_t)(qrow0 + 16) * D + h * 64 + 8 * g), qb1 = *(const bf16x8*)(Qb + (size_t)(qrow0 + 16) * D + h * 64 + 32 + 8 * g);
            SB0();
            { int t2 = tid; asm volatile("" : "+v"(t2));
              u32x4 v[4], kv[4];
#pragma unroll
              for (int it = 0; it < 4; ++it) { const int idx = t2 + NTHR * it, key = idx >> 3, chunk = idx & 7; const size_t off = (size_t)(b * 256 + key) * D + h * 64 + 8 * chunk;
                  v[it] = *(const u32x4*)(Vb + off); kv[it] = *(const u32x4*)(Kb + off); }
              SB0();
#pragma unroll
              for (int it = 0; it < 4; ++it) { const int idx = t2 + NTHR * it, key = idx >> 3, chunk = idx & 7;
                  *(LAS u32x4*)(Kc + key * 144 + chunk * 16) = kv[it];
                  vt_write(Vt, PITCH, key, chunk, v[it]); } }
            __syncthreads();
            SB0();
            f32x4 s0[16], s1[16];
            { const LAS unsigned char* kl = Kc + l15 * 144 + g * 16;
              sfor<16>([&](auto I) __attribute__((always_inline)) { constexpr int kb = decltype(I)::value;
                const bf16x8 k0 = *(const LAS bf16x8*)(kl + kb * (16 * 144)), k1 = *(const LAS bf16x8*)(kl + kb * (16 * 144) + 64);
                f32x4 a = __builtin_amdgcn_mfma_f32_16x16x32_bf16(k0, qa0, (f32x4){0.f, 0.f, 0.f, 0.f}, 0, 0, 0); s0[kb] = __builtin_amdgcn_mfma_f32_16x16x32_bf16(k1, qa1, a, 0, 0, 0) * SCL;
                f32x4 c = __builtin_amdgcn_mfma_f32_16x16x32_bf16(k0, qb0, (f32x4){0.f, 0.f, 0.f, 0.f}, 0, 0, 0); s1[kb] = __builtin_amdgcn_mfma_f32_16x16x32_bf16(k1, qb1, c, 0, 0, 0) * SCL; }); }
            { float mx, sum; softmax_part<16>(s0, mx, sum, lane);
              f32x4 o[4];
#pragma unroll
              for (int db = 0; db < 4; ++db) o[db] = (f32x4){0.f, 0.f, 0.f, 0.f};
              PV16(o, s0, 32 * pp + 4 * g, PITCH);
              const float rl = 1.0f / sum;
#pragma unroll
              for (int db = 0; db < 4; ++db) { const f32x4 ov = o[db] * rl; u32x2 w; w.x = pk2(ov[0], ov[1]); w.y = pk2(ov[2], ov[3]);
                  *(u32x2*)(Ob + (size_t)qrow0 * D + h * 64 + 16 * db + 4 * g) = w; } }
            { float mx, sum; softmax_part<16>(s1, mx, sum, lane);
              f32x4 o[4];
#pragma unroll
              for (int db = 0; db < 4; ++db) o[db] = (f32x4){0.f, 0.f, 0.f, 0.f};
              PV16(o, s1, 32 * pp + 4 * g, PITCH);
              const float rl = 1.0f / sum;
#pragma unroll
              for (int db = 0; db < 4; ++db) { const f32x4 ov = o[db] * rl; u32x2 w; w.x = pk2(ov[0], ov[1]); w.y = pk2(ov[2], ov[3]);
                  *(u32x2*)(Ob + (size_t)(qrow0 + 16) * D + h * 64 + 16 * db + 4 * g) = w; } }
            __syncthreads();
        } else {
            const int ui = u - 512, xcd = ui & 7, idx = (ui >> 3) & 63, uu = (G == 256) ? ((xcd * 8 + (idx >> 3)) << 3) + (idx & 7) : ui;
            const int b = uu >> 7, h = (uu >> 3) & 15, rp = uu & 7, r0 = 2 * rp; constexpr int PITCH = 840;
            const int rs0 = min(max(r0 - 4, 0), 8);
            const size_t tokb = (size_t)MP + (size_t)b * 1024;
            const int r = r0 + (wave >> 2), j = wave & 3, rs = min(max(r - 4, 0), 8), rrel = rs - rs0, kcs = min(max(16 * j - 8, 0), 32);
            const int qcol = 16 * j + l15, wst = min(max(qcol - 8, 0), 48);
            const size_t qtok = tokb + r * 64 + qcol;
            const bf16* kloc = Kb + (tokb + rs * 64 + kcs + l15) * D + h * 64 + 8 * g;
            bf16x8 kf[16][2];
#define LOAD_KLOC(H) sfor<8>([&](auto I) __attribute__((always_inline)) { constexpr int lb = 8 * (H) + decltype(I)::value; const bf16* kp = kloc + (size_t)((lb >> 1) * 64 + 16 * (lb & 1)) * D; kf[lb][0] = *(const bf16x8*)kp; kf[lb][1] = *(const bf16x8*)(kp + 32); })
            LOAD_KLOC(0);
            const bf16x8 qf0 = *(const bf16x8*)(Qb + qtok * D + h * 64 + 8 * g), qf1 = *(const bf16x8*)(Qb + qtok * D + h * 64 + 32 + 8 * g);
            SB0();
            { int t2 = tid; asm volatile("" : "+v"(t2));
              u32x4 vv[13], kv[4];
#pragma unroll
              for (int it = 0; it < 13; ++it) { const int idx = t2 + NTHR * it, slot = idx >> 3, chunk = idx & 7;
                  const bf16* src = (slot < 576) ? Vb + (tokb + min(rs0 + (slot >> 6), 15) * 64 + (slot & 63)) * D + h * 64 : CV + ((size_t)(b * 2 + li) * 256 + (slot - 576)) * D + h * 64;
                  vv[it] = *(const u32x4*)(src + 8 * chunk); }
#pragma unroll
              for (int it = 0; it < 4; ++it) { const int idx = t2 + NTHR * it, key = idx >> 3, chunk = idx & 7;
                  kv[it] = *(const u32x4*)(CK + ((size_t)(b * 2 + li) * 256 + key) * D + h * 64 + 8 * chunk); }
              const float rv = rpb[h * 465 + min(t2, 464)];
              SB0();
#pragma unroll
              for (int it = 0; it < 13; ++it) { const int idx = t2 + NTHR * it; vt_write(Vt, PITCH, idx >> 3, idx & 7, vv[it]); }
#pragma unroll
              for (int it = 0; it < 4; ++it) { const int idx = t2 + NTHR * it; *(LAS u32x4*)(Kc + (idx >> 3) * 144 + (idx & 7) * 16) = kv[it]; }
              if (t2 < 465) rpl[t2] = rv; }
            SB0(); LOAD_KLOC(1); SB0();
            __syncthreads();
            SB0();
            f32x4 o1[4]; float m1, l1, m2, l2;
#pragma unroll
            for (int db = 0; db < 4; ++db) o1[db] = (f32x4){0.f, 0.f, 0.f, 0.f};
            {
                int dcv[8]; unsigned vmask = 0u;
#pragma unroll
                for (int ce = 0; ce < 8; ++ce) { const int kc = kcs + 16 * (ce >> 2) + 4 * g + (ce & 3); vmask |= ((kc >= wst) && (kc < wst + 16)) ? (1u << ce) : 0u; dcv[ce] = min(max(kc - qcol + 15, 0), 30); }
                f32x4 s[16];
#define QK_LOC(H) sfor<8>([&](auto I) __attribute__((always_inline)) { constexpr int lb = 8 * (H) + decltype(I)::value, krow = lb >> 1, ch = lb & 1; \
                    f32x4 a = __builtin_amdgcn_mfma_f32_16x16x32_bf16(kf[lb][0], qf0, (f32x4){0.f, 0.f, 0.f, 0.f}, 0, 0, 0); a = __builtin_amdgcn_mfma_f32_16x16x32_bf16(kf[lb][1], qf1, a, 0, 0, 0); \
                    const LAS float* rp_row = rpl + (rs + krow - r + 7) * 31; float bias[4]; \
                    _Pragma("unroll") for (int e = 0; e < 4; ++e) bias[e] = rp_row[dcv[ch * 4 + e]]; \
                    _Pragma("unroll") for (int e = 0; e < 4; ++e) { const float t = a[e] * SCL + bias[e] * LOG2E; a[e] = ((vmask >> (ch * 4 + e)) & 1u) ? t : -INFINITY; } \
                    s[lb] = a; })
                QK_LOC(0); QK_LOC(1); SB0();
                softmax_part<16>(s, m1, l1, lane);
                PV16(o1, s, (rrel + pp) * 64 + kcs + 4 * g, PITCH);
            }
            SB0();
            {
                f32x4 s[16];
                { const LAS unsigned char* kl = Kc + l15 * 144 + g * 16;
                  sfor<16>([&](auto I) __attribute__((always_inline)) { constexpr int cb = decltype(I)::value;
                    const bf16x8 k0 = *(const LAS bf16x8*)(kl + cb * (16 * 144)), k1 = *(const LAS bf16x8*)(kl + cb * (16 * 144) + 64);
                    f32x4 a = __builtin_amdgcn_mfma_f32_16x16x32_bf16(k0, qf0, (f32x4){0.f, 0.f, 0.f, 0.f}, 0, 0, 0); s[cb] = __builtin_amdgcn_mfma_f32_16x16x32_bf16(k1, qf1, a, 0, 0, 0) * SCL; }); }
                softmax_part<16>(s, m2, l2, lane, m1);
                const float a1 = __builtin_amdgcn_exp2f(m1 - m2);
#pragma unroll
                for (int db = 0; db < 4; ++db) o1[db] = o1[db] * a1;
                l1 = l1 * a1 + l2;
                PV16(o1, s, 576 + 32 * pp + 4 * g, PITCH);
            }
            const float rl = 1.0f / l1;
            int r2_ = r; asm volatile("" : "+s"(r2_));
            const size_t qtok2 = tokb + r2_ * 64 + qcol;
#pragma unroll
            for (int db = 0; db < 4; ++db) { const f32x4 ov = o1[db] * rl; u32x2 w; w.x = pk2(ov[0], ov[1]); w.y = pk2(ov[2], ov[3]);
                *(u32x2*)(Ob + qtok2 * D + h * 64 + 16 * db + 4 * g) = w; }
            __syncthreads();
        }
    }
}

#define RLX_AGENT __ATOMIC_RELAXED, __HIP_MEMORY_SCOPE_AGENT
#define XB_TMO      128
#define XB_XCNT(j)  (256  + 64 * (j))
#define XB_XSUB(j)  (1280 + 64 * (j))
#define XB_XGEN(j)  (2304 + 64 * (j))
#define XB_TOP      3328
#define XB_TOPGEN   3392
#define XCD_BAR_WORDS 3456
#define XB_SPIN_CAP (1u << 18)

__device__ __forceinline__ unsigned xb_ld(unsigned* p)              { return __hip_atomic_load(p, __ATOMIC_RELAXED, __HIP_MEMORY_SCOPE_AGENT); }
__device__ __forceinline__ unsigned xb_add(unsigned* p, unsigned v) { return __hip_atomic_fetch_add(p, v, __ATOMIC_RELAXED, __HIP_MEMORY_SCOPE_AGENT); }
__device__ __forceinline__ unsigned xb_xcc_id() { return (unsigned)__builtin_amdgcn_s_getreg((3 << 11) | 20) & 0xFu; }
#define XB_SPIN(cond, bar) do { unsigned _sp = 0; while (cond) { __builtin_amdgcn_s_sleep(1); \
    if ((++_sp & 255u) == 0u) { if (xb_ld(&(bar)[XB_TMO])) break; if (_sp > XB_SPIN_CAP) { atomicAdd(&(bar)[XB_TMO], 1u); break; } } } } while (0)

struct XcdBarrier {
    unsigned* bar; unsigned x;
    volatile LAS unsigned* st;
};

__device__ __forceinline__ XcdBarrier xcd_barrier_post(unsigned* bar, volatile LAS unsigned* st) {
    XcdBarrier b; b.bar = bar; b.x = xb_xcc_id(); b.st = st;
    if (threadIdx.x == 0) (void)xb_add(&bar[XB_XCNT(b.x)], 1u);
    return b;
}
__device__ __forceinline__ void xcd_barrier_complete(unsigned* bar, unsigned x, unsigned& nloc, unsigned& nx) {
    const unsigned G = gridDim.x * gridDim.y * gridDim.z;
    unsigned sum, cnt, mine, sp = 0u;
    for (;;) {
        sum = 0u; cnt = 0u; mine = 0u;
#pragma unroll
        for (unsigned j = 0; j < 16; ++j) { const unsigned c = xb_ld(&bar[XB_XCNT(j)]); sum += c; cnt += (c > 0u) ? 1u : 0u; mine = (j == x) ? c : mine; }
        if (sum == G) break;
        __builtin_amdgcn_s_sleep(1);
        if ((++sp & 255u) == 0u) { if (xb_ld(&bar[XB_TMO])) break; if (sp > XB_SPIN_CAP) { atomicAdd(&bar[XB_TMO], 1u); break; } }
    }
    nloc = mine > 0u ? mine : 1u; nx = cnt > 0u ? cnt : 1u;
}

__device__ __forceinline__ void xcd_barrier(const XcdBarrier& b) {
    asm volatile("s_waitcnt vmcnt(0)" ::: "memory");
    __syncthreads();
    if (threadIdx.x == 0) {
        unsigned* bar = b.bar;
        __builtin_amdgcn_s_waitcnt(0);
        unsigned nloc = b.st[0], nx = b.st[1];
        if (nloc == 0u) { xcd_barrier_complete(bar, b.x, nloc, nx); b.st[0] = nloc; b.st[1] = nx; }
        const unsigned old = xb_add(&bar[XB_XSUB(b.x)], 1u);
        const unsigned gen = old / nloc;
        if (old + 1u == (gen + 1u) * nloc) {
            __builtin_amdgcn_fence(__ATOMIC_RELEASE, "agent");
            asm volatile("s_waitcnt vmcnt(0)" ::: "memory");
            const unsigned og = xb_add(&bar[XB_TOP], 1u);
            if (og + 1u == (gen + 1u) * nx) xb_add(&bar[XB_TOPGEN], 1u);
            else XB_SPIN(xb_ld(&bar[XB_TOPGEN]) == gen, bar);
            __builtin_amdgcn_fence(__ATOMIC_ACQUIRE, "agent");
            asm volatile("s_waitcnt vmcnt(0)" ::: "memory");
        } else {
            XB_SPIN(xb_ld(&bar[XB_TOPGEN]) == gen, bar);
            __builtin_amdgcn_fence(__ATOMIC_ACQUIRE, "agent");
            asm volatile("s_waitcnt vmcnt(0)" ::: "memory");
        }
    }
    __syncthreads();
}

constexpr int NPH = 2 + 5 * NL + 1;
struct Args { const float* in[21]; float* out; unsigned char* ws; int nprog, pad; int prog[48]; };
typedef const __attribute__((address_space(4))) Args* KArgPtr;
__global__ void __launch_bounds__(NTHR, 2) fwd_kernel(Args a_unused) {
    extern __shared__ __attribute__((aligned(16))) unsigned char lds_raw[];
    LAS unsigned char* lds = (LAS unsigned char*)lds_raw;
    cg::grid_group grid = cg::this_grid();
    const int wave0 = __builtin_amdgcn_readfirstlane((int)threadIdx.x >> 6);
    { volatile LAS unsigned* st0 = (volatile LAS unsigned*)(lds + LDS_ST); if (threadIdx.x < 2) st0[threadIdx.x] = 0u; }
    __syncthreads();
    XcdBarrier xbar; { KArgPtr kpb = (KArgPtr)__builtin_amdgcn_kernarg_segment_ptr(); xbar.bar = (unsigned*)kpb->ws; xbar.x = 0; xbar.st = (volatile LAS unsigned*)(lds + LDS_ST);
        if (blockIdx.x == 0) { for (int wI = threadIdx.x; wI < XCD_BAR_WORDS; wI += NTHR) __hip_atomic_store(xbar.bar + wI, 0u, __ATOMIC_RELAXED, __HIP_MEMORY_SCOPE_AGENT); } }
    int nprog; { KArgPtr kp0 = (KArgPtr)__builtin_amdgcn_kernarg_segment_ptr(); nprog = kp0->nprog; }
    for (int pc = 0; pc < nprog; ++pc) {
        KArgPtr kp = (KArgPtr)__builtin_amdgcn_kernarg_segment_ptr(); asm volatile("" : "+s"(kp));
        int z_ = 0; asm volatile("" : "+s"(z_));
        const int lane_ = (int)__builtin_amdgcn_mbcnt_hi(~0u, __builtin_amdgcn_mbcnt_lo(~0u, (unsigned)z_)); const int tid_ = wave0 * 64 + lane_;
        int bid_ = (int)__builtin_amdgcn_workgroup_id_x(), G_ = (int)gridDim.x; asm volatile("" : "+s"(bid_), "+s"(G_));
        const int pe_ = kp->prog[pc]; const int ph = pe_ & 63, amode = pe_ >> 6;
        const int tid = tid_, lane = lane_, wave = wave0, G = G_, bid = bid_;
        const int gw = bid * NWAVES + wave, NGW = G * NWAVES;
        Ptrs P; P = Ptrs{kp->in[0], kp->in[1], kp->in[2], kp->in[3], kp->in[4], kp->in[5], kp->in[6], kp->in[7], kp->in[8], kp->in[9], kp->in[10], kp->in[11], kp->in[12], kp->in[13], kp->in[14], kp->in[15], kp->in[16], kp->in[17], kp->in[18], kp->in[19], kp->in[20]};
        unsigned char* ws = kp->ws; float* outp = kp->out;
        float* mod = (float*)(ws + WS_MOD); bf16* Wt = (bf16*)(ws + WS_W); bf16* X = (bf16*)(ws + WS_X); bf16* H = (bf16*)(ws + WS_H);
        bf16* R = (bf16*)(ws + WS_R); bf16* Qb = R; bf16* Kb = R + (size_t)M * D; bf16* Vb = R + (size_t)2 * M * D; bf16* Ob = R + (size_t)3 * M * D;
        bf16* Ub = R; bf16* Vc = R + (size_t)M * D; bf16* Fb = R;
        const bf16* CK = (const bf16*)(ws + WS_CK); const bf16* CV = (const bf16*)(ws + WS_CV);
        float* out_y = outp; float* out_ck = outp + (size_t)M * D; float* out_cv = out_ck + (size_t)32 * 2 * 256 * 1024;
        float* SS = (float*)(ws + WS_SS); float* SHW = (float*)(ws + WS_SHW);
        if (ph == 0) { p0_phase(P, ws, lds, tid, lane, wave, G, bid); }
        else if (ph == 1) { prep_phase(P.x_prompt, P.x_sample, H, SS, P.norm_g, mod + 1 * 1024, mod, Wt, SHW, gw, NGW, lane); }
        else if (ph == NPH - 1) { final_norm_phase(X, out_y, P.final_g, gw, NGW, lane); }
        else if (ph >= 60) { }
        else {
            const int l = (ph - 2) / 5, s = (ph - 2) % 5, i = l >> 1; const bool conv = (l & 1) != 0;
            const float* modl = mod + (size_t)l * 5 * 6144;
            if (s == 0) {
                const float* ssl = SS + (size_t)(2 * l) * M; const float* shl = SHW + (size_t)((2 * l) * 5) * 4096;
                if (!conv) { pg8::Gemm gm{H, Wt + W_QKV + (size_t)i * 3 * MEL, M, 3 * D, D}; pg8::StaticOrder S; S.init(M, 3 * D, G, bid);
                    pg8::EpiQKV E{ssl, shl, Qb, (size_t)M * D, out_ck + (size_t)i * 256 * 1024, (size_t)32 * 2 * 256 * 1024};
                    pg8::gemm_phase<pg8::EpiQKV, pg8::StaticOrder, true, true>(lds, gm, S, E, tid); }
                else { pg8::Gemm gm{H, Wt + W_PW1 + (size_t)i * 2 * MEL, M, 2 * D, D}; pg8::StaticOrder S; S.init(M, 2 * D, G, bid);
                    pg8::EpiGLU E{ssl, shl, Ub};
                    pg8::gemm_phase<pg8::EpiGLU, pg8::StaticOrder, true, true>(lds, gm, S, E, tid); }
            } else if (s == 1) {
                if (!conv) attn_phase(Qb, Kb, Vb, Ob, CK, CV, P.rpb + (size_t)i * 16 * 15 * 31, i, lds, tid, lane, wave, G, bid, amode == 2 ? 512 : 0, amode == 1 ? 512 : 1024);
                else conv_phase(Ub, Vc, P.w_dw + (size_t)i * 31 * D, P.b_dw + i * D, P.ln_g + i * D, P.ln_b + i * D, lds, tid, lane, wave, G, bid);
            } else if (s == 2 || s == 4) {
                pg8::Gemm gm; pg8::EpiRes E;
                if (s == 2) { gm = pg8::Gemm{conv ? Vc : Ob, Wt + (conv ? W_PW2 : W_O) + (size_t)i * MEL, M, D, D};
                    E = pg8::EpiRes{P.x_prompt, P.x_sample, l == 0 ? (const bf16*)nullptr : X, X, modl + 2 * 1024, H, P.norm_g + (l * 2 + 1) * D, modl + 4 * 1024, SS + (size_t)(2 * l + 1) * M}; }
                else { gm = pg8::Gemm{Fb, Wt + W_DOWN + (size_t)l * 4 * MEL, M, D, FF};
                    E = pg8::EpiRes{P.x_prompt, P.x_sample, X, X, modl + 5 * 1024, l < NL - 1 ? H : nullptr, P.norm_g + ((l + 1) * 2) * D, modl + 5 * 6144 + 1 * 1024, SS + (size_t)(2 * l + 2) * M}; }
                pg8::StaticOrder S; S.init(M, D, G, bid);
                pg8::gemm_phase<pg8::EpiRes, pg8::StaticOrder, true, true>(lds, gm, S, E, tid);
            } else {
#ifdef UP256
                pg8::Gemm gm{H, Wt + W_UP + (size_t)l * 4 * MEL, M, FF, D}; pg8::StaticOrder256 S; S.init(M, FF, G, bid);
                pg8::EpiUp256 E{SS + (size_t)(2 * l + 1) * M, SHW + (size_t)((2 * l + 1) * 5) * 4096, Fb, FF};
                pg8::gemm_phase256<pg8::EpiUp256, pg8::StaticOrder256, true, true>(lds, gm, S, E, tid);
#else
                pg8::Gemm gm{H, Wt + W_UP + (size_t)l * 4 * MEL, M, FF, D}; pg8::StaticOrder S; S.init(M, FF, G, bid);
                pg8::EpiUp E{SS + (size_t)(2 * l + 1) * M, SHW + (size_t)((2 * l + 1) * 5) * 4096, Fb, FF};
                pg8::gemm_phase<pg8::EpiUp, pg8::StaticOrder, true, true>(lds, gm, S, E, tid);
#endif
            }
        }
        if (pc + 1 < nprog) { if (pc == 0) { grid.sync(); xbar = xcd_barrier_post(xbar.bar, xbar.st); } else xcd_barrier(xbar); }
    }
}

#ifndef SINGLE_LAUNCH
#define SINGLE_LAUNCH 0
#endif
extern "C" void kernel_launch(void* const* d_in, const int* in_sizes, int n_in, void* d_out, int out_size, void* d_ws, size_t ws_size, hipStream_t stream) {
    static int grid = 0;
    if (grid == 0) {
        if (n_in != 21 || ws_size < WS_END) { fprintf(stderr, "kernel_launch: unexpected n_in %d / ws_size %zu\n", n_in, ws_size); grid = -1; return; }
        int dev = 0, cus = 0, per_cu = 0;
        hipGetDevice(&dev); hipDeviceGetAttribute(&cus, hipDeviceAttributeMultiprocessorCount, dev);
        hipFuncSetAttribute((const void*)fwd_kernel, hipFuncAttributeMaxDynamicSharedMemorySize, LDS_BYTES);
        hipOccupancyMaxActiveBlocksPerMultiprocessor(&per_cu, (const void*)fwd_kernel, NTHR, LDS_BYTES);
        if (per_cu < 1) { fprintf(stderr, "kernel_launch: occupancy query says %d blocks/CU\n", per_cu); per_cu = 1; }
        (void)hipGetLastError();
        grid = cus * per_cu;
    }
    if (grid < 0) return;
    Args a{};
    for (int i = 0; i < 21; ++i) a.in[i] = (const float*)d_in[i];
    a.out = (float*)d_out; a.ws = (unsigned char*)d_ws;
#if SINGLE_LAUNCH
    { int n = 0;
      for (int ph = 0; ph < NPH; ++ph) { a.prog[n++] = ph;
#ifdef PROBE_ATTN_MODE
          if (ph >= 2 && ph < NPH - 1 && (ph - 2) % 5 == 1 && ((ph - 2) / 5) % 2 == 0) a.prog[n++] = ph | (PROBE_ATTN_MODE << 6);
#endif
#ifdef PROBE_EMPTY
          if (ph == 5) for (int q = 0; q < PROBE_EMPTY; ++q) a.prog[n++] = 60;
#endif
#ifdef PROBE_REPEAT_P0
          if (ph == 0) a.prog[n++] = 0;
#endif
#ifdef PROBE_REPEAT_S
          if (ph >= 2 && ph < NPH - 1 && (ph - 2) % 5 == PROBE_REPEAT_S && (PROBE_REPEAT_PAR < 0 || ((ph - 2) / 5) % 2 == PROBE_REPEAT_PAR)) a.prog[n++] = ph;
#endif
      }
      a.nprog = n; }
    void* args[] = {&a};
    hipError_t e = hipLaunchCooperativeKernel((const void*)fwd_kernel, dim3(grid), dim3(NTHR), args, LDS_BYTES, stream);
    if (e != hipSuccess) fprintf(stderr, "cooperative launch failed: %s (grid %d)\n", hipGetErrorString(e), grid);
#else
    for (int ph = 0; ph < NPH; ++ph) { a.nprog = 1; a.prog[0] = ph; hipLaunchKernelGGL(fwd_kernel, dim3(grid), dim3(NTHR), LDS_BYTES, stream, a); }
#endif
}
```

```cpp
#define SINGLE_LAUNCH 1
#define UP256 1
#include <hip/hip_runtime.h>
#include <hip/hip_cooperative_groups.h>
#include <cstdio>
#include <cstdint>
#include <cmath>
#include <utility>
namespace cg = cooperative_groups;
namespace pg8 {
#define PG8_LAS __attribute__((address_space(3)))
typedef unsigned short bf16_t;
typedef short bf16x8 __attribute__((ext_vector_type(8)));
typedef float f32x4 __attribute__((ext_vector_type(4)));
typedef unsigned u32x4 __attribute__((ext_vector_type(4)));
constexpr int RM = 192;
constexpr int BM = 256, BK = 64, HALF = 128, HTB = HALF * BK * 2  , STAGE_BYTES = 8 * HTB, NXCD = 8, WGM = 8;

__host__ __device__ __forceinline__ int lds_byte(int r, int c) { const int st = (r >> 4) * 2 + (c >> 5), rr = r & 15, cc = c & 31, ob = rr * 64 + cc * 2; return st * 1024 + (ob ^ (((ob >> 9) & 1) << 5)); }
__host__ __device__ __forceinline__ void stage_rc(int b, int& R, int& C) { const int st = b / 1024, sb = b % 1024, swz = sb ^ (((sb >> 9) & 1) << 5); R = (st >> 1) * 16 + swz / 64; C = (st & 1) * 32 + (swz % 64) / 2; }
__host__ __device__ __forceinline__ int perm32(int rho) { const int n = rho >> 4, i = rho & 15; return 8 * (i >> 2) + 4 * n + (i & 3); }

struct Unit { int pm, pn; };
struct Gemm { const bf16_t* A; const bf16_t* Bt; int M, N, K; };

struct StaticOrder {
    int nM, nN, nwg, G, c;
    __host__ __device__ void init(int M, int N, int G_, int c_) { nM = M / RM; nN = N / BM; nwg = nM * nN; G = G_; c = c_; }
    __host__ __device__ bool next(int i, Unit& u) const {
        const long L = (long)i * G + c; if (L >= nwg) return false;
        int wgid = (int)L; { const int q = nwg / NXCD, r = nwg % NXCD, xcd = wgid % NXCD, off = wgid / NXCD; wgid = (xcd < r ? xcd * (q + 1) : r * (q + 1) + (xcd - r) * q) + off; }
        const int nig = WGM * nN, gid = wgid / nig, fm = gid * WGM, gsz = (nM - fm) < WGM ? (nM - fm) : WGM;
        u.pm = fm + ((wgid % nig) % gsz); u.pn = (wgid % nig) / gsz; return true;
    }
    __device__ __forceinline__ void a_ready(const Unit&) const {}
    __device__ __forceinline__ void done(const Unit&) const {}
};

__device__ __forceinline__ unsigned cvt_pk_bf16(float lo, float hi) { unsigned r; asm volatile("v_cvt_pk_bf16_f32 %0, %1, %2" : "=v"(r) : "v"(lo), "v"(hi)); return r; }
typedef float f32x2 __attribute__((ext_vector_type(2)));
__device__ __forceinline__ int cond_of_row(int r) { return r < 8192 ? 0 : 1 + ((r - 8192) >> 10); }
__device__ __forceinline__ int half_row0(int ai, int wr) { return ai == 0 ? wr * 64 : 128 + wr * 32; }
#define EPI_MLOOP(ai, m) _Pragma("unroll") for (int m = 0; m < 4; ++m) if (ai == 0 || m < 2)
struct EpiQKV {
    static constexpr bool PERM = true, AFTER_DRAIN = false;
    const float* ss; const float* shw;
    bf16_t* Q; size_t qkv_stride; float* ck; size_t ckv_stride;
    __device__ __forceinline__ void operator()(const f32x4 (&acc)[2][2][4][2], const Unit& u, int wr, int wc, int fr, int fq) const {
        const int t = u.pn >> 2;
        bf16_t* base = Q + (size_t)t * qkv_stride;
        const int col0 = (u.pn & 3) * BM + wc * 32 + 8 * fq;
        float* cbase = ck + (size_t)(t > 0 ? t - 1 : 0) * ckv_stride + col0;
#pragma unroll
        for (int ai = 0; ai < 2; ++ai) { const int rbase = u.pm * RM + half_row0(ai, wr) + fr; const bool wc_ = (t > 0) && (rbase < 8192);
            const float* sp = shw + cond_of_row(rbase) * 4096 + u.pn * BM + wc * 32 + 8 * fq;
            f32x4 sv[2][2];
#pragma unroll
            for (int bj = 0; bj < 2; ++bj) { sv[bj][0] = *(const f32x4*)(sp + bj * HALF); sv[bj][1] = *(const f32x4*)(sp + bj * HALF + 4); }
            float rr[4];
            EPI_MLOOP(ai, m) rr[m] = ss[rbase + m * 16];
            EPI_MLOOP(ai, m) { const int row = rbase + m * 16; bf16_t* rowp = base + (size_t)row * 1024 + col0;
                const float r = __builtin_amdgcn_rsqf(rr[m] * (1.f / 1024.f) + 1e-6f);
                float* cp0 = cbase + ((size_t)(row >> 8) * 2 * 256 + (row & 255)) * 1024;
#pragma unroll
                for (int bj = 0; bj < 2; ++bj) { const f32x4 v0 = acc[ai][bj][m][0] * r + sv[bj][0], v1 = acc[ai][bj][m][1] * r + sv[bj][1];
                    u32x4 w; w.x = cvt_pk_bf16(v0[0], v0[1]); w.y = cvt_pk_bf16(v0[2], v0[3]); w.z = cvt_pk_bf16(v1[0], v1[1]); w.w = cvt_pk_bf16(v1[2], v1[3]);
                    *(u32x4*)(rowp + bj * HALF) = w;
                    if (wc_) { float* cp = cp0 + bj * HALF; __builtin_nontemporal_store(v0, (f32x4*)cp); __builtin_nontemporal_store(v1, (f32x4*)(cp + 4)); } } } }
    }
};
struct EpiUp {
    static constexpr bool PERM = true, AFTER_DRAIN = false;
    const float* ss; const float* shw; bf16_t* O; int ldc;
    __device__ __forceinline__ void operator()(const f32x4 (&acc)[2][2][4][2], const Unit& u, int wr, int wc, int fr, int fq) const {
        const int col0 = u.pn * BM + wc * 32 + 8 * fq;
#pragma unroll
        for (int ai = 0; ai < 2; ++ai) { const int rbase = u.pm * RM + half_row0(ai, wr) + fr;
            const float* sp = shw + cond_of_row(rbase) * 4096 + col0;
            f32x4 sv[2][2];
#pragma unroll
            for (int bj = 0; bj < 2; ++bj) { sv[bj][0] = *(const f32x4*)(sp + bj * HALF); sv[bj][1] = *(const f32x4*)(sp + bj * HALF + 4); }
            float rr[4];
            EPI_MLOOP(ai, m) rr[m] = ss[rbase + m * 16];
            EPI_MLOOP(ai, m) { bf16_t* rowp = O + (size_t)(rbase + m * 16) * ldc + col0;
                const float r = __builtin_amdgcn_rsqf(rr[m] * (1.f / 1024.f) + 1e-6f);
#pragma unroll
                for (int bj = 0; bj < 2; ++bj) { f32x4 v0 = acc[ai][bj][m][0] * r + sv[bj][0], v1 = acc[ai][bj][m][1] * r + sv[bj][1];
#pragma unroll
                    for (int e = 0; e < 4; ++e) { const float a = fmaxf(v0[e], 0.f), b = fmaxf(v1[e], 0.f); v0[e] = a * a; v1[e] = b * b; }
                    u32x4 w; w.x = cvt_pk_bf16(v0[0], v0[1]); w.y = cvt_pk_bf16(v0[2], v0[3]); w.z = cvt_pk_bf16(v1[0], v1[1]); w.w = cvt_pk_bf16(v1[2], v1[3]);
                    *(u32x4*)(rowp + bj * HALF) = w; } } }
    }
};
struct EpiGLU {
    static constexpr bool PERM = true, AFTER_DRAIN = false;
    const float* ss; const float* shw; bf16_t* O;
    __device__ __forceinline__ void operator()(const f32x4 (&acc)[2][2][4][2], const Unit& u, int wr, int wc, int fr, int fq) const {
        const int col0 = u.pn * HALF + wc * 32 + 8 * fq;
#pragma unroll
        for (int ai = 0; ai < 2; ++ai) { const int rbase = u.pm * RM + half_row0(ai, wr) + fr;
            const float* sp = shw + cond_of_row(rbase) * 4096 + u.pn * BM + wc * 32 + 8 * fq;
            f32x4 sv[2][2];
#pragma unroll
            for (int bj = 0; bj < 2; ++bj) { sv[bj][0] = *(const f32x4*)(sp + bj * HALF); sv[bj][1] = *(const f32x4*)(sp + bj * HALF + 4); }
            float rr[4];
            EPI_MLOOP(ai, m) rr[m] = ss[rbase + m * 16];
            EPI_MLOOP(ai, m) { bf16_t* rowp = O + (size_t)(rbase + m * 16) * 1024 + col0;
                const float r = __builtin_amdgcn_rsqf(rr[m] * (1.f / 1024.f) + 1e-6f);
                f32x4 v0 = acc[ai][0][m][0] * r + sv[0][0], v1 = acc[ai][0][m][1] * r + sv[0][1]; const f32x4 g0 = acc[ai][1][m][0] * r + sv[1][0], g1 = acc[ai][1][m][1] * r + sv[1][1];
#pragma unroll
                for (int e = 0; e < 4; ++e) { v0[e] = v0[e] * __builtin_amdgcn_rcpf(1.f + __expf(-g0[e])); v1[e] = v1[e] * __builtin_amdgcn_rcpf(1.f + __expf(-g1[e])); }
                u32x4 w; w.x = cvt_pk_bf16(v0[0], v0[1]); w.y = cvt_pk_bf16(v0[2], v0[3]); w.z = cvt_pk_bf16(v1[0], v1[1]); w.w = cvt_pk_bf16(v1[2], v1[3]);
                *(u32x4*)rowp = w; } }
    }
};
struct EpiRes {
    static constexpr bool PERM = true, AFTER_DRAIN = false;
    const float* base_p; const float* base_s; const bf16_t* base_b; bf16_t* out; const float* gate;
    bf16_t* xb; const float* g_next; const float* sc_next; float* ss_next;
    __device__ __forceinline__ void operator()(const f32x4 (&acc)[2][2][4][2], const Unit& u, int wr, int wc, int fr, int fq) const {
        const int col0 = u.pn * BM + wc * 32 + 8 * fq;
        const int lane_x = fq * 16 + fr;
#pragma unroll
        for (int ai = 0; ai < 2; ++ai) { const int row0 = u.pm * RM + half_row0(ai, wr) + fr; const int cond = cond_of_row(row0);
            const float* gp = gate + cond * 6144 + col0;
            const float* bp = (row0 < 8192) ? base_p + (size_t)row0 * 1024 + col0 : base_s + (size_t)(row0 - 8192) * 1024 + col0;
            const bf16_t* bb = base_b + (size_t)row0 * 1024 + col0;
            bf16_t* op = out + (size_t)row0 * 1024 + col0;
            f32x4 gv[2][2], gs[2][2];
#pragma unroll
            for (int bj = 0; bj < 2; ++bj)
#pragma unroll
                for (int n = 0; n < 2; ++n) gv[bj][n] = *(const f32x4*)(gp + bj * HALF + n * 4);
            if (xb) { f32x4 ga[2][2], sa[2][2];
#pragma unroll
                for (int bj = 0; bj < 2; ++bj)
#pragma unroll
                    for (int n = 0; n < 2; ++n) { ga[bj][n] = *(const f32x4*)(g_next + col0 + bj * HALF + n * 4); sa[bj][n] = *(const f32x4*)(sc_next + cond * 6144 + col0 + bj * HALF + n * 4); }
#pragma unroll
                for (int bj = 0; bj < 2; ++bj)
#pragma unroll
                    for (int n = 0; n < 2; ++n) gs[bj][n] = ga[bj][n] * (1.f + sa[bj][n]); }
#pragma unroll
            for (int mp = 0; mp < 2; ++mp) if (ai == 0 || mp == 0) { f32x4 bs[2][2][2];
                if (base_b) {
#pragma unroll
                    for (int mm = 0; mm < 2; ++mm)
#pragma unroll
                        for (int bj = 0; bj < 2; ++bj) { const u32x4 w = *(const u32x4*)(bb + (size_t)((2 * mp + mm) * 16) * 1024 + bj * HALF);
                            bs[mm][bj][0] = (f32x4){__builtin_bit_cast(float, w.x << 16), __builtin_bit_cast(float, w.x & 0xffff0000u), __builtin_bit_cast(float, w.y << 16), __builtin_bit_cast(float, w.y & 0xffff0000u)};
                            bs[mm][bj][1] = (f32x4){__builtin_bit_cast(float, w.z << 16), __builtin_bit_cast(float, w.z & 0xffff0000u), __builtin_bit_cast(float, w.w << 16), __builtin_bit_cast(float, w.w & 0xffff0000u)}; }
                } else {
#pragma unroll
                    for (int mm = 0; mm < 2; ++mm)
#pragma unroll
                        for (int bj = 0; bj < 2; ++bj)
#pragma unroll
                            for (int n = 0; n < 2; ++n) bs[mm][bj][n] = *(const f32x4*)(bp + (size_t)((2 * mp + mm) * 16) * 1024 + bj * HALF + n * 4);
                }
#pragma unroll
                for (int mm = 0; mm < 2; ++mm) { float sq = 0.f;
#pragma unroll
                    for (int bj = 0; bj < 2; ++bj) { const f32x4 x0 = bs[mm][bj][0] + gv[bj][0] * acc[ai][bj][2 * mp + mm][0], x1 = bs[mm][bj][1] + gv[bj][1] * acc[ai][bj][2 * mp + mm][1];
                        { u32x4 w; w.x = cvt_pk_bf16(x0[0], x0[1]); w.y = cvt_pk_bf16(x0[2], x0[3]); w.z = cvt_pk_bf16(x1[0], x1[1]); w.w = cvt_pk_bf16(x1[2], x1[3]); *(u32x4*)(op + (size_t)((2 * mp + mm) * 16) * 1024 + bj * HALF) = w; }
                        if (xb) { const f32x4 h0 = x0 * gs[bj][0], h1 = x1 * gs[bj][1]; u32x4 w; w.x = cvt_pk_bf16(h0[0], h0[1]); w.y = cvt_pk_bf16(h0[2], h0[3]); w.z = cvt_pk_bf16(h1[0], h1[1]); w.w = cvt_pk_bf16(h1[2], h1[3]);
                            *(u32x4*)(xb + (size_t)(row0 + (2 * mp + mm) * 16) * 1024 + col0 + bj * HALF) = w;
                            sq += ((x0[0] * x0[0] + x0[1] * x0[1]) + (x0[2] * x0[2] + x0[3] * x0[3])) + ((x1[0] * x1[0] + x1[1] * x1[1]) + (x1[2] * x1[2] + x1[3] * x1[3])); } }
                    if (xb) {
                        sq += __builtin_bit_cast(float, __builtin_amdgcn_ds_bpermute((lane_x ^ 16) << 2, __builtin_bit_cast(int, sq)));
                        sq += __builtin_bit_cast(float, __builtin_amdgcn_ds_bpermute((lane_x ^ 32) << 2, __builtin_bit_cast(int, sq)));
                        if (fq == 0) atomicAdd(ss_next + row0 + (2 * mp + mm) * 16, sq); } }
                asm volatile("" ::: "memory"); } }
    }
};

struct StaticOrder256 {
    int nM, nN, nwg, G, c;
    __host__ __device__ void init(int M, int N, int G_, int c_) { nM = M / BM; nN = N / BM; nwg = nM * nN; G = G_; c = c_; }
    __host__ __device__ bool next(int i, Unit& u) const {
        const long L = (long)i * G + c; if (L >= nwg) return false;
        int wgid = (int)L; { const int q = nwg / NXCD, r = nwg % NXCD, xcd = wgid % NXCD, off = wgid / NXCD; wgid = (xcd < r ? xcd * (q + 1) : r * (q + 1) + (xcd - r) * q) + off; }
        const int nig = WGM * nN, gid = wgid / nig, fm = gid * WGM, gsz = (nM - fm) < WGM ? (nM - fm) : WGM;
        u.pm = fm + ((wgid % nig) % gsz); u.pn = (wgid % nig) / gsz; return true;
    }
    __device__ __forceinline__ void a_ready(const Unit&) const {}
    __device__ __forceinline__ void done(const Unit&) const {}
};
struct EpiUp256 {
    static constexpr bool PERM = true, AFTER_DRAIN = false;
    const float* ss; const float* shw; bf16_t* O; int ldc;
    __device__ __forceinline__ void operator()(const f32x4 (&acc)[2][2][4][2], const Unit& u, int wr, int wc, int fr, int fq) const {
        const int col0 = u.pn * BM + wc * 32 + 8 * fq;
        f32x4 sv[2][2][2]; float rr[2][4];
#pragma unroll
        for (int ai = 0; ai < 2; ++ai) { const int rbase = u.pm * BM + ai * HALF + wr * 64 + fr; const float* sp = shw + cond_of_row(rbase) * 4096 + col0;
#pragma unroll
            for (int bj = 0; bj < 2; ++bj) { sv[ai][bj][0] = *(const f32x4*)(sp + bj * HALF); sv[ai][bj][1] = *(const f32x4*)(sp + bj * HALF + 4); }
#pragma unroll
            for (int m = 0; m < 4; ++m) rr[ai][m] = ss[rbase + m * 16]; }
        __builtin_amdgcn_sched_barrier(0);
#pragma unroll
        for (int ai = 0; ai < 2; ++ai) { const int rbase = u.pm * BM + ai * HALF + wr * 64 + fr;
#pragma unroll
            for (int m = 0; m < 4; ++m) { bf16_t* rowp = O + (size_t)(rbase + m * 16) * ldc + col0;
                const float r = __builtin_amdgcn_rsqf(rr[ai][m] * (1.f / 1024.f) + 1e-6f);
#pragma unroll
                for (int bj = 0; bj < 2; ++bj) { f32x4 v0 = acc[ai][bj][m][0] * r + sv[ai][bj][0], v1 = acc[ai][bj][m][1] * r + sv[ai][bj][1];
#pragma unroll
                    for (int e = 0; e < 4; ++e) { const float a = fmaxf(v0[e], 0.f), b = fmaxf(v1[e], 0.f); v0[e] = a * a; v1[e] = b * b; }
                    u32x4 w; w.x = cvt_pk_bf16(v0[0], v0[1]); w.y = cvt_pk_bf16(v0[2], v0[3]); w.z = cvt_pk_bf16(v1[0], v1[1]); w.w = cvt_pk_bf16(v1[2], v1[3]);
                    *(u32x4*)(rowp + bj * HALF) = w; } } }
    }
};
template <class Epi, class Sched, bool ALIGN_EPI = false, bool SP2 = false>
__device__ __forceinline__ void gemm_phase256(PG8_LAS unsigned char* lds, const Gemm g, const Sched& S, const Epi& E, const int tid) {
    const int wid = __builtin_amdgcn_readfirstlane(tid >> 6), lane = tid & 63, wr = wid >> 2, wc = wid & 3, fr = lane & 15, fq = lane >> 4;
    const int K = g.K, nt = K / BK;
    unsigned voffA[2], voffB[2];
#pragma unroll
    for (int i = 0; i < 2; ++i) { int R, C; stage_rc(tid * 16 + i * 8192, R, C); const int Rb = Epi::PERM ? ((R & ~31) + perm32(R & 31)) : R;
        voffA[i] = (unsigned)(R * K + C) * 2u; voffB[i] = (unsigned)(Rb * K + C) * 2u; }
    const size_t kstep = (size_t)(BK * 2);
    const size_t hstep = (size_t)HALF * K * 2;
    const size_t tstep = 2 * hstep;
    const unsigned ldsw = (unsigned)wid * 1024u;
    const int aoff = lds_byte(wr * 64 + fr, fq * 8), boff = lds_byte(wc * 32 + fr, fq * 8);
#define PG8_SA(b, h) (((b) * 2 + (h)) * HTB)
#define PG8_SB(b, h) ((4 + (b) * 2 + (h)) * HTB)
#define PG8_STAGE(bufoff, gbase, voff) do { _Pragma("unroll") for (int _i = 0; _i < 2; ++_i) \
        __builtin_amdgcn_global_load_lds((const unsigned*)((const char*)(gbase) + (voff)[_i]), (PG8_LAS unsigned*)(lds + (bufoff) + ldsw + _i * 8192), 16, 0, 0); } while (0)
#define PG8_LDA(dst, b, h) do { _Pragma("unroll") for (int m = 0; m < 4; ++m) _Pragma("unroll") for (int k = 0; k < 2; ++k) dst[m][k] = *(const PG8_LAS bf16x8*)(lds + PG8_SA(b, h) + aoff + m * 2048 + k * 1024); } while (0)
#define PG8_LDB(dst, b, h) do { _Pragma("unroll") for (int n = 0; n < 2; ++n) _Pragma("unroll") for (int k = 0; k < 2; ++k) dst[n][k] = *(const PG8_LAS bf16x8*)(lds + PG8_SB(b, h) + boff + n * 2048 + k * 1024); } while (0)
#define PG8_MMA(ai, bj, At, Bt) do { __builtin_amdgcn_s_setprio(1); _Pragma("unroll") for (int m = 0; m < 4; ++m) _Pragma("unroll") for (int n = 0; n < 2; ++n) _Pragma("unroll") for (int k = 0; k < 2; ++k) \
        acc[ai][bj][m][n] = __builtin_amdgcn_mfma_f32_16x16x32_bf16(Bt[n][k], At[m][k], acc[ai][bj][m][n], 0, 0, 0); __builtin_amdgcn_s_setprio(0); } while (0)
#define PG8_WAIT_V(n) asm volatile("s_waitcnt vmcnt(" #n ")" ::: "memory")
#define PG8_WAIT_L(n) asm volatile("s_waitcnt lgkmcnt(" #n ")" ::: "memory")
#define PG8_BAR __builtin_amdgcn_s_barrier()
#define PG8_SCHED __builtin_amdgcn_sched_barrier(0)
    Unit cur, nxt; int ui = 0;
    if (!S.next(0, cur)) return;
    f32x4 acc[2][2][4][2];
#pragma unroll
    for (int a = 0; a < 2; ++a)
#pragma unroll
        for (int b = 0; b < 2; ++b)
#pragma unroll
            for (int m = 0; m < 4; ++m)
#pragma unroll
                for (int n = 0; n < 2; ++n) acc[a][b][m][n] = (f32x4){0.f, 0.f, 0.f, 0.f};
    bf16x8 At[4][2], B0[2][2], B1[2][2];
    const char* cA = (const char*)g.A + (size_t)cur.pm * tstep; const char* cB = (const char*)g.Bt + (size_t)cur.pn * tstep;
    S.a_ready(cur);
    if constexpr (SP2) {
        PG8_STAGE(PG8_SB(0, 0), cB, voffB); PG8_STAGE(PG8_SB(0, 1), cB + hstep, voffB); PG8_STAGE(PG8_SA(0, 0), cA, voffA); PG8_STAGE(PG8_SA(0, 1), cA + hstep, voffA);
        if (wr == 1) PG8_BAR;
        PG8_WAIT_V(2); PG8_BAR;
        PG8_STAGE(PG8_SB(1, 0), cB + kstep, voffB); PG8_STAGE(PG8_SA(1, 0), cA + kstep, voffA); PG8_STAGE(PG8_SB(1, 1), cB + hstep + kstep, voffB);
        PG8_WAIT_V(6); PG8_BAR;
    } else {
        PG8_STAGE(PG8_SB(0, 0), cB, voffB); PG8_STAGE(PG8_SA(0, 0), cA, voffA); PG8_STAGE(PG8_SB(0, 1), cB + hstep, voffB); PG8_STAGE(PG8_SA(0, 1), cA + hstep, voffA);
        if (wr == 1) PG8_BAR;
        PG8_WAIT_V(4); PG8_BAR;
        PG8_STAGE(PG8_SB(1, 0), cB + kstep, voffB); PG8_STAGE(PG8_SA(1, 0), cA + kstep, voffA); PG8_STAGE(PG8_SB(1, 1), cB + hstep + kstep, voffB);
        PG8_WAIT_V(6); PG8_BAR;
    }
    for (;;) {
        const bool has_next = S.next(ui + 1, nxt);
        const char* nA = has_next ? (const char*)g.A + (size_t)nxt.pm * tstep : cA; const char* nB = has_next ? (const char*)g.Bt + (size_t)nxt.pn * tstep : cB;
        for (int t = 0; t < nt; t += 2) {
            const bool last = (t == nt - 2);
            const char* a1 = cA + (size_t)(t + 1) * kstep;
            const char* a2 = last ? nA : cA + (size_t)(t + 2) * kstep; const char* b2 = last ? nB : cB + (size_t)(t + 2) * kstep;
            const char* a3 = a2 + kstep; const char* b3 = b2 + kstep;
            if (last && has_next) S.a_ready(nxt);
            if constexpr (SP2) {
            PG8_LDB(B0, 0, 0); PG8_LDB(B1, 0, 1); PG8_SCHED; PG8_LDA(At, 0, 0); PG8_STAGE(PG8_SA(1, 1), a1 + hstep, voffA);
            PG8_WAIT_V(8); PG8_WAIT_L(0); PG8_BAR; PG8_MMA(0, 0, At, B0); PG8_MMA(0, 1, At, B1); PG8_BAR; PG8_SCHED;
            PG8_LDA(At, 0, 1); PG8_STAGE(PG8_SB(0, 0), b2, voffB); PG8_STAGE(PG8_SB(0, 1), b2 + hstep, voffB); PG8_STAGE(PG8_SA(0, 0), a2, voffA);
            PG8_WAIT_V(8); PG8_WAIT_L(0); PG8_BAR; PG8_MMA(1, 0, At, B0); PG8_MMA(1, 1, At, B1); PG8_BAR; PG8_SCHED;
            PG8_LDB(B0, 1, 0); PG8_LDB(B1, 1, 1); PG8_SCHED; PG8_LDA(At, 1, 0); PG8_STAGE(PG8_SA(0, 1), a2 + hstep, voffA);
            PG8_WAIT_V(8); PG8_WAIT_L(0); PG8_BAR; PG8_MMA(0, 0, At, B0); PG8_MMA(0, 1, At, B1); PG8_BAR; PG8_SCHED;
            PG8_LDA(At, 1, 1); PG8_STAGE(PG8_SB(1, 0), b3, voffB); PG8_STAGE(PG8_SB(1, 1), b3 + hstep, voffB); PG8_STAGE(PG8_SA(1, 0), a3, voffA);
            PG8_WAIT_V(8); PG8_WAIT_L(0); PG8_BAR; PG8_MMA(1, 0, At, B0); PG8_MMA(1, 1, At, B1); PG8_BAR; PG8_SCHED;
            } else {
            PG8_LDB(B0, 0, 0); PG8_SCHED; PG8_LDA(At, 0, 0); PG8_STAGE(PG8_SA(1, 1), a1 + hstep, voffA);
            PG8_WAIT_L(8); PG8_BAR; PG8_WAIT_L(0); PG8_MMA(0, 0, At, B0); PG8_BAR; PG8_SCHED;
            PG8_LDB(B1, 0, 1); PG8_STAGE(PG8_SB(0, 0), b2, voffB);
            PG8_BAR; PG8_WAIT_L(0); PG8_MMA(0, 1, At, B1); PG8_BAR;
            PG8_LDA(At, 0, 1); PG8_STAGE(PG8_SA(0, 0), a2, voffA);
            PG8_BAR; PG8_WAIT_L(0); PG8_MMA(1, 0, At, B0); PG8_BAR; PG8_SCHED;
            PG8_STAGE(PG8_SB(0, 1), b2 + hstep, voffB);
            PG8_WAIT_V(6); PG8_BAR; PG8_MMA(1, 1, At, B1); PG8_BAR;
            PG8_LDB(B0, 1, 0); PG8_SCHED; PG8_LDA(At, 1, 0); PG8_STAGE(PG8_SA(0, 1), a2 + hstep, voffA);
            PG8_WAIT_L(8); PG8_BAR; PG8_WAIT_L(0); PG8_MMA(0, 0, At, B0); PG8_BAR; PG8_SCHED;
            PG8_LDB(B1, 1, 1); PG8_STAGE(PG8_SB(1, 0), b3, voffB);
            PG8_BAR; PG8_WAIT_L(0); PG8_MMA(0, 1, At, B1); PG8_BAR;
            PG8_LDA(At, 1, 1); PG8_STAGE(PG8_SA(1, 0), a3, voffA);
            PG8_BAR; PG8_WAIT_L(0); PG8_MMA(1, 0, At, B0); PG8_BAR; PG8_SCHED;
            PG8_STAGE(PG8_SB(1, 1), b3 + hstep, voffB);
            PG8_WAIT_V(6); PG8_BAR; PG8_MMA(1, 1, At, B1); PG8_BAR;
            }
        }
        if constexpr (ALIGN_EPI) { if (wr == 0) PG8_BAR; }
        if constexpr (!Epi::AFTER_DRAIN) { E(acc, cur, wr, wc, fr, fq); S.done(cur); }
        if (!has_next) break;
#pragma unroll
        for (int a = 0; a < 2; ++a)
#pragma unroll
            for (int b = 0; b < 2; ++b)
#pragma unroll
                for (int m = 0; m < 4; ++m)
#pragma unroll
                    for (int n = 0; n < 2; ++n) acc[a][b][m][n] = (f32x4){0.f, 0.f, 0.f, 0.f};
        cur = nxt; cA = nA; cB = nB; ++ui;
        if constexpr (ALIGN_EPI) { if (wr == 1) PG8_BAR; }
    }
    PG8_WAIT_V(0);
    if constexpr (!ALIGN_EPI) { if (wr == 0) PG8_BAR; }
    PG8_BAR;
    if constexpr (Epi::AFTER_DRAIN) { E.fused(acc, cur, wr, wc, fr, fq, lds, wid, lane); S.done(cur); }
#undef PG8_SA
#undef PG8_SB
#undef PG8_STAGE
#undef PG8_LDA
#undef PG8_LDB
#undef PG8_MMA
#undef PG8_WAIT_V
#undef PG8_WAIT_L
#undef PG8_BAR
#undef PG8_SCHED
}
template <class Epi, class Sched, bool ALIGN_EPI = false, bool SP2 = false>
__device__ __forceinline__ void gemm_phase(PG8_LAS unsigned char* lds, const Gemm g, const Sched& S, const Epi& E, const int tid) {
    static_assert(SP2, "the 192-row tile form exists for the SP2 loop only");
    const int wid = __builtin_amdgcn_readfirstlane(tid >> 6), lane = tid & 63, wr = wid >> 2, wc = wid & 3, fr = lane & 15, fq = lane >> 4;
    const int K = g.K, nt = K / BK;
    unsigned voffA[2], voffB[2];
#pragma unroll
    for (int i = 0; i < 2; ++i) { int R, C; stage_rc(tid * 16 + i * 8192, R, C); const int Rb = Epi::PERM ? ((R & ~31) + perm32(R & 31)) : R;
        voffA[i] = (unsigned)(R * K + C) * 2u; voffB[i] = (unsigned)(Rb * K + C) * 2u; }
    const size_t kstep = (size_t)(BK * 2);
    const size_t hstep = (size_t)HALF * K * 2;
    const size_t tstepA = (size_t)RM * K * 2;
    const size_t tstep = 2 * hstep;
    const unsigned ldsw = (unsigned)wid * 1024u;
    const int aoff = lds_byte(wr * 64 + fr, fq * 8), boff = lds_byte(wc * 32 + fr, fq * 8);
#define PG8_SA(b, h) (((b) * 2 + (h)) * HTB)
#define PG8_SB(b, h) ((4 + (b) * 2 + (h)) * HTB)
#define PG8_STAGE(bufoff, gbase, voff) do { _Pragma("unroll") for (int _i = 0; _i < 2; ++_i) \
        __builtin_amdgcn_global_load_lds((const unsigned*)((const char*)(gbase) + (voff)[_i]), (PG8_LAS unsigned*)(lds + (bufoff) + ldsw + _i * 8192), 16, 0, 0); } while (0)
#define PG8_LDA(dst, b, h) do { _Pragma("unroll") for (int m = 0; m < 4; ++m) _Pragma("unroll") for (int k = 0; k < 2; ++k) dst[m][k] = *(const PG8_LAS bf16x8*)(lds + PG8_SA(b, h) + aoff + m * 2048 + k * 1024); } while (0)
#define PG8_LDB(dst, b, h) do { _Pragma("unroll") for (int n = 0; n < 2; ++n) _Pragma("unroll") for (int k = 0; k < 2; ++k) dst[n][k] = *(const PG8_LAS bf16x8*)(lds + PG8_SB(b, h) + boff + n * 2048 + k * 1024); } while (0)
#define PG8_MMA(ai, bj, At, Bt) do { __builtin_amdgcn_s_setprio(1); _Pragma("unroll") for (int m = 0; m < 4; ++m) _Pragma("unroll") for (int n = 0; n < 2; ++n) _Pragma("unroll") for (int k = 0; k < 2; ++k) \
        acc[ai][bj][m][n] = __builtin_amdgcn_mfma_f32_16x16x32_bf16(Bt[n][k], At[m][k], acc[ai][bj][m][n], 0, 0, 0); __builtin_amdgcn_s_setprio(0); } while (0)
    const int aoff1 = lds_byte(wr * 32 + fr, fq * 8);
#define PG8_STAGE1(bufoff, gbase, voff) __builtin_amdgcn_global_load_lds((const unsigned*)((const char*)(gbase) + (voff)[0]), (PG8_LAS unsigned*)(lds + (bufoff) + ldsw), 16, 0, 0)
#define PG8_LDA1(dst, b) do { _Pragma("unroll") for (int m = 0; m < 2; ++m) _Pragma("unroll") for (int k = 0; k < 2; ++k) dst[m][k] = *(const PG8_LAS bf16x8*)(lds + PG8_SA(b, 1) + aoff1 + m * 2048 + k * 1024); } while (0)
#define PG8_MMA1(bj, At, Bt) do { __builtin_amdgcn_s_setprio(1); _Pragma("unroll") for (int m = 0; m < 2; ++m) _Pragma("unroll") for (int n = 0; n < 2; ++n) _Pragma("unroll") for (int k = 0; k < 2; ++k) \
        acc[1][bj][m][n] = __builtin_amdgcn_mfma_f32_16x16x32_bf16(Bt[n][k], At[m][k], acc[1][bj][m][n], 0, 0, 0); __builtin_amdgcn_s_setprio(0); } while (0)
#define PG8_WAIT_V(n) asm volatile("s_waitcnt vmcnt(" #n ")" ::: "memory")
#define PG8_WAIT_L(n) asm volatile("s_waitcnt lgkmcnt(" #n ")" ::: "memory")
#define PG8_BAR __builtin_amdgcn_s_barrier()
#define PG8_SCHED __builtin_amdgcn_sched_barrier(0)
    Unit cur, nxt; int ui = 0;
    if (!S.next(0, cur)) return;
    f32x4 acc[2][2][4][2];
#pragma unroll
    for (int a = 0; a < 2; ++a)
#pragma unroll
        for (int b = 0; b < 2; ++b)
#pragma unroll
            for (int m = 0; m < 4; ++m)
#pragma unroll
                for (int n = 0; n < 2; ++n) acc[a][b][m][n] = (f32x4){0.f, 0.f, 0.f, 0.f};
    bf16x8 At[4][2], B0[2][2], B1[2][2];
    const char* cA = (const char*)g.A + (size_t)cur.pm * tstepA; const char* cB = (const char*)g.Bt + (size_t)cur.pn * tstep;
    S.a_ready(cur);
    if constexpr (SP2) {
        PG8_STAGE(PG8_SB(0, 0), cB, voffB); PG8_STAGE(PG8_SB(0, 1), cB + hstep, voffB); PG8_STAGE(PG8_SA(0, 0), cA, voffA); PG8_STAGE1(PG8_SA(0, 1), cA + hstep, voffA);
        if (wr == 1) PG8_BAR;
        PG8_WAIT_V(1); PG8_BAR;
        PG8_STAGE(PG8_SB(1, 0), cB + kstep, voffB); PG8_STAGE(PG8_SA(1, 0), cA + kstep, voffA); PG8_STAGE(PG8_SB(1, 1), cB + hstep + kstep, voffB);
        PG8_WAIT_V(6); PG8_BAR;
    } else {
        PG8_STAGE(PG8_SB(0, 0), cB, voffB); PG8_STAGE(PG8_SA(0, 0), cA, voffA); PG8_STAGE(PG8_SB(0, 1), cB + hstep, voffB); PG8_STAGE(PG8_SA(0, 1), cA + hstep, voffA);
        if (wr == 1) PG8_BAR;
        PG8_WAIT_V(4); PG8_BAR;
        PG8_STAGE(PG8_SB(1, 0), cB + kstep, voffB); PG8_STAGE(PG8_SA(1, 0), cA + kstep, voffA); PG8_STAGE(PG8_SB(1, 1), cB + hstep + kstep, voffB);
        PG8_WAIT_V(6); PG8_BAR;
    }
    for (;;) {
        const bool has_next = S.next(ui + 1, nxt);
        const char* nA = has_next ? (const char*)g.A + (size_t)nxt.pm * tstepA : cA; const char* nB = has_next ? (const char*)g.Bt + (size_t)nxt.pn * tstep : cB;
        for (int t = 0; t < nt; t += 2) {
            const bool last = (t == nt - 2);
            const char* a1 = cA + (size_t)(t + 1) * kstep;
            const char* a2 = last ? nA : cA + (size_t)(t + 2) * kstep; const char* b2 = last ? nB : cB + (size_t)(t + 2) * kstep;
            const char* a3 = a2 + kstep; const char* b3 = b2 + kstep;
            if (last && has_next) S.a_ready(nxt);
            if constexpr (SP2) {
            PG8_LDB(B0, 0, 0); PG8_LDB(B1, 0, 1); PG8_SCHED; PG8_LDA(At, 0, 0); PG8_STAGE1(PG8_SA(1, 1), a1 + hstep, voffA);
            PG8_WAIT_V(7); PG8_WAIT_L(0); PG8_BAR; PG8_MMA(0, 0, At, B0); PG8_MMA(0, 1, At, B1); PG8_BAR; PG8_SCHED;
            PG8_LDA1(At, 0); PG8_STAGE(PG8_SB(0, 0), b2, voffB); PG8_STAGE(PG8_SB(0, 1), b2 + hstep, voffB); PG8_STAGE(PG8_SA(0, 0), a2, voffA);
            PG8_WAIT_V(7); PG8_WAIT_L(0); PG8_BAR; PG8_MMA1(0, At, B0); PG8_MMA1(1, At, B1); PG8_BAR; PG8_SCHED;
            PG8_LDB(B0, 1, 0); PG8_LDB(B1, 1, 1); PG8_SCHED; PG8_LDA(At, 1, 0); PG8_STAGE1(PG8_SA(0, 1), a2 + hstep, voffA);
            PG8_WAIT_V(7); PG8_WAIT_L(0); PG8_BAR; PG8_MMA(0, 0, At, B0); PG8_MMA(0, 1, At, B1); PG8_BAR; PG8_SCHED;
            PG8_LDA1(At, 1); PG8_STAGE(PG8_SB(1, 0), b3, voffB); PG8_STAGE(PG8_SB(1, 1), b3 + hstep, voffB); PG8_STAGE(PG8_SA(1, 0), a3, voffA);
            PG8_WAIT_V(7); PG8_WAIT_L(0); PG8_BAR; PG8_MMA1(0, At, B0); PG8_MMA1(1, At, B1); PG8_BAR; PG8_SCHED;
            } else {
            PG8_LDB(B0, 0, 0); PG8_SCHED; PG8_LDA(At, 0, 0); PG8_STAGE(PG8_SA(1, 1), a1 + hstep, voffA);
            PG8_WAIT_L(8); PG8_BAR; PG8_WAIT_L(0); PG8_MMA(0, 0, At, B0); PG8_BAR; PG8_SCHED;
            PG8_LDB(B1, 0, 1); PG8_STAGE(PG8_SB(0, 0), b2, voffB);
            PG8_BAR; PG8_WAIT_L(0); PG8_MMA(0, 1, At, B1); PG8_BAR;
            PG8_LDA(At, 0, 1); PG8_STAGE(PG8_SA(0, 0), a2, voffA);
            PG8_BAR; PG8_WAIT_L(0); PG8_MMA(1, 0, At, B0); PG8_BAR; PG8_SCHED;
            PG8_STAGE(PG8_SB(0, 1), b2 + hstep, voffB);
            PG8_WAIT_V(6); PG8_BAR; PG8_MMA(1, 1, At, B1); PG8_BAR;
            PG8_LDB(B0, 1, 0); PG8_SCHED; PG8_LDA(At, 1, 0); PG8_STAGE(PG8_SA(0, 1), a2 + hstep, voffA);
            PG8_WAIT_L(8); PG8_BAR; PG8_WAIT_L(0); PG8_MMA(0, 0, At, B0); PG8_BAR; PG8_SCHED;
            PG8_LDB(B1, 1, 1); PG8_STAGE(PG8_SB(1, 0), b3, voffB);
            PG8_BAR; PG8_WAIT_L(0); PG8_MMA(0, 1, At, B1); PG8_BAR;
            PG8_LDA(At, 1, 1); PG8_STAGE(PG8_SA(1, 0), a3, voffA);
            PG8_BAR; PG8_WAIT_L(0); PG8_MMA(1, 0, At, B0); PG8_BAR; PG8_SCHED;
            PG8_STAGE(PG8_SB(1, 1), b3 + hstep, voffB);
            PG8_WAIT_V(6); PG8_BAR; PG8_MMA(1, 1, At, B1); PG8_BAR;
            }
        }
        if constexpr (ALIGN_EPI) { if (wr == 0) PG8_BAR; }
        if constexpr (!Epi::AFTER_DRAIN) { E(acc, cur, wr, wc, fr, fq); S.done(cur); }
        if (!has_next) break;
#pragma unroll
        for (int a = 0; a < 2; ++a)
#pragma unroll
            for (int b = 0; b < 2; ++b)
#pragma unroll
                for (int m = 0; m < 4; ++m)
#pragma unroll
                    for (int n = 0; n < 2; ++n) acc[a][b][m][n] = (f32x4){0.f, 0.f, 0.f, 0.f};
        cur = nxt; cA = nA; cB = nB; ++ui;
        if constexpr (ALIGN_EPI) { if (wr == 1) PG8_BAR; }
    }
    PG8_WAIT_V(0);
    if constexpr (!ALIGN_EPI) { if (wr == 0) PG8_BAR; }
    PG8_BAR;
    if constexpr (Epi::AFTER_DRAIN) { E.fused(acc, cur, wr, wc, fr, fq, lds, wid, lane); S.done(cur); }
#undef PG8_SA
#undef PG8_SB
#undef PG8_STAGE
#undef PG8_LDA
#undef PG8_LDB
#undef PG8_MMA
#undef PG8_STAGE1
#undef PG8_LDA1
#undef PG8_MMA1
#undef PG8_WAIT_V
#undef PG8_WAIT_L
#undef PG8_BAR
#undef PG8_SCHED
}
}
constexpr int D = 1024, MP = 8192, MS = 4096, M = MP + MS, FF = 4096, NL = 4;
constexpr int NWAVES = 8, NTHR = 512;
constexpr size_t MiB = 1u << 20;
constexpr size_t WS_MOD = 1 * MiB;
constexpr size_t WS_W = 2 * MiB;
constexpr size_t WS_X = 94 * MiB;
constexpr size_t WS_H = 142 * MiB;
constexpr size_t WS_R = 166 * MiB;
constexpr size_t WS_CK = 262 * MiB, WS_CV = 266 * MiB, WS_SHW = 270 * MiB, WS_SS = 271 * MiB, WS_END = 272 * MiB;
constexpr size_t MEL = 1u << 20;
constexpr size_t W_QKV = 0, W_O = 6 * MEL, W_PW1 = 8 * MEL, W_PW2 = 12 * MEL, W_UP = 14 * MEL, W_DOWN = 30 * MEL;
constexpr int LDS_BYTES = 163840, LDS_ST = LDS_BYTES - 16, LDS_KC = 112640;

#define LAS __attribute__((address_space(3)))
#define SB0() __builtin_amdgcn_sched_barrier(0)
typedef unsigned short bf16;
typedef float f32x4 __attribute__((ext_vector_type(4)));
typedef float f32x2 __attribute__((ext_vector_type(2)));
typedef unsigned u32x4 __attribute__((ext_vector_type(4)));
typedef unsigned u32x2 __attribute__((ext_vector_type(2)));
typedef short bf16x8 __attribute__((ext_vector_type(8)));
typedef short s16x4 __attribute__((ext_vector_type(4)));
typedef float f32x32 __attribute__((ext_vector_type(32)));

__device__ __forceinline__ unsigned f2bf(float f) { unsigned u = __builtin_bit_cast(unsigned, f); return (u + 0x7fffu + ((u >> 16) & 1u)) >> 16; }
__device__ __forceinline__ unsigned pk2(float lo, float hi) { unsigned r; asm("v_cvt_pk_bf16_f32 %0, %1, %2" : "=v"(r) : "v"(lo), "v"(hi)); return r; }
__device__ __forceinline__ float bflo(unsigned w) { return __builtin_bit_cast(float, w << 16); }
__device__ __forceinline__ float bfhi(unsigned w) { return __builtin_bit_cast(float, w & 0xffff0000u); }
__device__ __forceinline__ float shx(float v, int k, int lane) { return __builtin_bit_cast(float, __builtin_amdgcn_ds_bpermute((lane ^ k) << 2, __builtin_bit_cast(int, v))); }
__device__ __forceinline__ float wave_sum(float v, int lane) {
#pragma unroll
    for (int o = 1; o < 64; o <<= 1) v += shx(v, o, lane);
    return v;
}

template <bool GLU>
__device__ __forceinline__ void transpose_item(const float* W, int K, int N, bf16* WT, LAS float* scr, int item, int lane) {
    const int nblk = N / 32, kb = item / nblk, nb = item % nblk, k0 = 64 * kb, n0 = 32 * nb;
    { float tv[32];
#pragma unroll
      for (int i = 0; i < 32; ++i) tv[i] = __builtin_nontemporal_load(W + (size_t)(k0 + 2 * i + (lane >> 5)) * N + n0 + (lane & 31));
      __builtin_amdgcn_sched_barrier(0);
#pragma unroll
      for (int i = 0; i < 32; ++i) scr[(2 * i + (lane >> 5)) * 33 + (((lane & 31) + 4 * (i >> 4)) & 31)] = tv[i]; }
    asm volatile("s_waitcnt lgkmcnt(0)" ::: "memory");
    int d0 = n0;
    if (GLU) { const int nn = n0 & 1023; d0 = ((nn >> 7) << 8) + (nn & 127) + ((n0 >> 10) << 7); }
    const int c = lane & 7;
#pragma unroll
    for (int j = 0; j < 4; ++j) { const int n = (lane >> 3) + 8 * j; const LAS float* s = scr + (8 * c) * 33 + ((n + 4 * (c >> 2)) & 31);
        u32x4 o; o.x = pk2(s[0 * 33], s[1 * 33]); o.y = pk2(s[2 * 33], s[3 * 33]); o.z = pk2(s[4 * 33], s[5 * 33]); o.w = pk2(s[6 * 33], s[7 * 33]);
        *(u32x4*)(WT + (size_t)(d0 + n) * K + k0 + 8 * c) = o; }
    asm volatile("s_waitcnt lgkmcnt(0)" ::: "memory");
}

struct Ptrs {
    const float *x_prompt, *x_sample, *cache_k, *cache_v, *c, *c_ctx, *norm_g, *w_ada, *b_ada, *w_qkv, *w_o, *rpb, *w_pw1, *w_dw, *b_dw, *ln_g, *ln_b, *w_pw2, *w_up, *w_down, *final_g;
};

__device__ __forceinline__ void p0_phase(const Ptrs& P, unsigned char* ws, LAS unsigned char* lds, int tid, int lane, int wave, int G, int bid) {
    bf16* Wt = (bf16*)(ws + WS_W);
    const int gw = bid * NWAVES + wave, NGW = G * NWAVES;
    LAS float* scr = (LAS float*)(lds + wave * 16384);
    constexpr int NIT = 23552;
    for (int it = gw; it < NIT; it += NGW) {
        if (it < 7168) { const int i = it / 3584; int r = it % 3584;
            if (r < 1536) { transpose_item<false>(P.w_qkv + (size_t)i * D * 3 * D, D, 3 * D, Wt + W_QKV + (size_t)i * 3 * MEL, scr, r, lane); continue; } r -= 1536;
            if (r < 512) { transpose_item<false>(P.w_o + (size_t)i * D * D, D, D, Wt + W_O + (size_t)i * MEL, scr, r, lane); continue; } r -= 512;
            if (r < 1024) { transpose_item<true>(P.w_pw1 + (size_t)i * D * 2 * D, D, 2 * D, Wt + W_PW1 + (size_t)i * 2 * MEL, scr, r, lane); continue; } r -= 1024;
            transpose_item<false>(P.w_pw2 + (size_t)i * D * D, D, D, Wt + W_PW2 + (size_t)i * MEL, scr, r, lane);
        } else { const int l = (it - 7168) / 4096; int r = (it - 7168) % 4096;
            if (r < 2048) transpose_item<false>(P.w_up + (size_t)l * D * FF, D, FF, Wt + W_UP + (size_t)l * 4 * MEL, scr, r, lane);
            else transpose_item<false>(P.w_down + (size_t)l * D * FF, FF, D, Wt + W_DOWN + (size_t)l * 4 * MEL, scr, r - 2048, lane);
        }
    }
    { bf16* CK = (bf16*)(ws + WS_CK); bf16* CV = (bf16*)(ws + WS_CV);
      const int NT = G * NTHR; constexpr int NV = 2 * 4 * 2 * 256 * 1024 / 4;
      for (int v = bid * NTHR + tid; v < NV; v += NT) { const int which = v >= NV / 2; const int e = (which ? v - NV / 2 : v) * 4;
          const f32x4 a = __builtin_nontemporal_load((const f32x4*)((which ? P.cache_v : P.cache_k) + e));
          u32x2 o; o.x = pk2(a[0], a[1]); o.y = pk2(a[2], a[3]);
          *(u32x2*)((which ? CV : CK) + e) = o; } }
    { f32x4* z = (f32x4*)(ws + WS_SS); const int NT = G * NTHR; float zf = 0.f; asm volatile("" : "+v"(zf));
      const f32x4 zz = (f32x4){zf, zf, zf, zf}; for (int v = bid * NTHR + tid; v < 9 * M / 4; v += NT) z[v] = zz; }
    __syncthreads();
    { LAS float* sil = (LAS float*)lds; LAS float* red = (LAS float*)(lds + 20480); float* mod = (float*)(ws + WS_MOD);
      for (int k = tid; k < 5 * 1024; k += NTHR) { const int cc = k >> 10, kk = k & 1023; const float v = cc == 0 ? P.c_ctx[kk] : P.c[(cc - 1) * 1024 + kk]; sil[k] = v / (1.f + __expf(-v)); }
      __syncthreads();
      const int kg = tid >> 4, cl = tid & 15; const bool cact = cl < 12;
      for (int item = bid; item < 512; item += G) { const int l = item >> 7, n0 = (item & 127) * 48;
          const float* W = P.w_ada + (size_t)l * D * 6144 + n0 + 4 * cl;
          f32x4 a[5];
#pragma unroll
          for (int cc = 0; cc < 5; ++cc) a[cc] = (f32x4){0.f, 0.f, 0.f, 0.f};
#pragma unroll 4
          for (int kk = 0; kk < 32; ++kk) { const int k = kg * 32 + kk; f32x4 w = (f32x4){0.f, 0.f, 0.f, 0.f}; if (cact) w = __builtin_nontemporal_load((const f32x4*)(W + (size_t)k * 6144));
#pragma unroll
              for (int cc = 0; cc < 5; ++cc) a[cc] += sil[cc * 1024 + k] * w; }
#pragma unroll
          for (int cc = 0; cc < 5; ++cc) *(LAS f32x4*)(red + (kg * 5 + cc) * 64 + 4 * cl) = a[cc];
          __syncthreads();
          if (tid < 320 && (tid & 63) < 48) { const int cc = tid >> 6, n = tid & 63; float s = 0.f;
#pragma unroll 8
              for (int g = 0; g < 32; ++g) s += red[(g * 5 + cc) * 64 + n];
              mod[(size_t)(l * 5 + cc) * 6144 + n0 + n] = s + P.b_ada[l * 6144 + n0 + n]; }
          __syncthreads();
      } }
}

__device__ __forceinline__ void norm_phase(const float* xp, const float* xs, bf16* H, float* yout, const float* g, const float* shift, const float* scale, int gw, int NGW, int lane) {
    f32x4 gv[4];
#pragma unroll
    for (int j = 0; j < 4; ++j) gv[j] = *(const f32x4*)(g + 4 * (lane + 64 * j));
    for (int m = gw; m < M; m += NGW) {
        const float* xrow = m < MP ? xp + (size_t)m * D : xs + (size_t)(m - MP) * D;
        const int cond = m < MP ? 0 : 1 + ((m - MP) >> 10);
        f32x4 v[4]; float ss = 0.f;
#pragma unroll
        for (int j = 0; j < 4; ++j) { v[j] = *(const f32x4*)(xrow + 4 * (lane + 64 * j)); ss += (v[j][0] * v[j][0] + v[j][1] * v[j][1]) + (v[j][2] * v[j][2] + v[j][3] * v[j][3]); }
        const float r = 1.0f / sqrtf(wave_sum(ss, lane) * (1.f / D) + 1e-6f);
        if (yout) {
#pragma unroll
            for (int j = 0; j < 4; ++j) *(f32x4*)(yout + (size_t)m * D + 4 * (lane + 64 * j)) = v[j] * r * gv[j];
        } else {
#pragma unroll
            for (int j = 0; j < 4; ++j) { const f32x4 sc = *(const f32x4*)(scale + cond * 6144 + 4 * (lane + 64 * j)), sh = *(const f32x4*)(shift + cond * 6144 + 4 * (lane + 64 * j));
                const f32x4 h = (v[j] * r * gv[j]) * (1.f + sc) + sh; u32x2 o; o.x = pk2(h[0], h[1]); o.y = pk2(h[2], h[3]);
                *(u32x2*)(H + (size_t)m * D + 4 * (lane + 64 * j)) = o; }
        }
    }
}

template <class F, int... I> __device__ __forceinline__ void sfor_impl(F&& f, std::integer_sequence<int, I...>) { (f(std::integral_constant<int, I>{}), ...); }
template <int N, class F> __device__ __forceinline__ void sfor(F&& f) { sfor_impl(f, std::make_integer_sequence<int, N>{}); }
__device__ __forceinline__ float dpp_add(float v, int ctrl_b1, int ctrl_4e, int dummy) { return v; }
__device__ __forceinline__ float wave_sum_dpp(float v) {
    v += __builtin_bit_cast(float, __builtin_amdgcn_update_dpp(0, __builtin_bit_cast(int, v), 0xB1, 0xf, 0xf, false));
    v += __builtin_bit_cast(float, __builtin_amdgcn_update_dpp(0, __builtin_bit_cast(int, v), 0x4E, 0xf, 0xf, false));
    v += __builtin_bit_cast(float, __builtin_amdgcn_update_dpp(0, __builtin_bit_cast(int, v), 0x141, 0xf, 0xf, false));
    v += __builtin_bit_cast(float, __builtin_amdgcn_update_dpp(0, __builtin_bit_cast(int, v), 0x140, 0xf, 0xf, false));
    const int vi = __builtin_bit_cast(int, v);
    return (__builtin_bit_cast(float, __builtin_amdgcn_readlane(vi, 0)) + __builtin_bit_cast(float, __builtin_amdgcn_readlane(vi, 16))) +
           (__builtin_bit_cast(float, __builtin_amdgcn_readlane(vi, 32)) + __builtin_bit_cast(float, __builtin_amdgcn_readlane(vi, 48)));
}
constexpr int CT = 16, CROWS = CT + 30, CCS = 16, CCH = (CROWS + CCS - 1) / CCS;
__device__ __forceinline__ void conv_phase(const bf16* U, bf16* Vc, const float* wdw, const float* bdw, const float* lng, const float* lnb, LAS unsigned char* lds, int tid, int lane, int wave, int G, int bid) {
    f32x2 w[31];
    sfor<31>([&](auto K) __attribute__((always_inline)) { constexpr int k = decltype(K)::value; w[k] = *(const f32x2*)(wdw + k * D + 2 * tid); });
    const f32x2 bd = *(const f32x2*)(bdw + 2 * tid), lg = *(const f32x2*)(lng + 2 * tid), lb = *(const f32x2*)(lnb + 2 * tid);
    LAS f32x2* part = (LAS f32x2*)lds;
    LAS f32x2* stats = part + 8 * CT;
    for (int un_ = bid; un_ < M / CT; un_ += G) {
        const int unit = (G == 256) ? (un_ & 7) * (M / CT / 8) + ((un_ >> 3) & 31) + 32 * (un_ >> 8) : un_;
        const int m0 = unit * CT, seg = m0 < MP ? 0 : MP, L = m0 < MP ? 256 : 1024, t0 = (m0 - seg) & (L - 1);
        const bf16* Ub = U + (size_t)(m0 - t0) * D + 2 * tid;
        f32x2 acc[CT];
        sfor<CT>([&](auto O) __attribute__((always_inline)) { acc[decltype(O)::value] = bd; });
        sfor<CCH>([&](auto C) __attribute__((always_inline)) { constexpr int c = decltype(C)::value;
            unsigned raw[CCS];
            sfor<CCS>([&](auto I) __attribute__((always_inline)) { constexpr int i = decltype(I)::value, j = c * CCS + i;
                if constexpr (j < CROWS) { const int t = t0 - 15 + j, tc = min(max(t, 0), L - 1);
                    raw[i] = *(const unsigned*)(Ub + (size_t)tc * D); } });
            SB0();
            sfor<CCS>([&](auto I) __attribute__((always_inline)) { constexpr int i = decltype(I)::value, j = c * CCS + i;
                if constexpr (j < CROWS) { const int t = t0 - 15 + j; const unsigned rm = raw[i] & (unsigned)(-(int)((t >= 0) & (t < L))); const f32x2 u = (f32x2){bflo(rm), bfhi(rm)};
                    sfor<31>([&](auto K) __attribute__((always_inline)) { constexpr int k = decltype(K)::value, o = j - k;
                        if constexpr (o >= 0 && o < CT) acc[o] += u * w[k]; }); } });
        });
        sfor<CT>([&](auto O) __attribute__((always_inline)) { constexpr int o = decltype(O)::value;
            const float s = wave_sum_dpp(acc[o].x + acc[o].y), q = wave_sum_dpp(acc[o].x * acc[o].x + acc[o].y * acc[o].y); if (lane == 0) part[wave * CT + o] = (f32x2){s, q}; });
        __syncthreads();
        if (tid < CT) { float s = 0.f, q = 0.f;
#pragma unroll
            for (int wv = 0; wv < 8; ++wv) { const f32x2 p = part[wv * CT + tid]; s += p.x; q += p.y; }
            const float mean = s * (1.f / D), var = fmaxf(q * (1.f / D) - mean * mean, 0.f); stats[tid] = (f32x2){mean, 1.0f / sqrtf(var + 1e-5f)}; }
        __syncthreads();
        sfor<CT>([&](auto O) __attribute__((always_inline)) { constexpr int o = decltype(O)::value;
            const f32x2 st = stats[o]; f32x2 y = (acc[o] - st.x) * st.y * lg + lb;
            y.x = y.x * __builtin_amdgcn_rcpf(1.f + __expf(-y.x)); y.y = y.y * __builtin_amdgcn_rcpf(1.f + __expf(-y.y));
            *(unsigned*)(Vc + (size_t)(m0 + o) * D + 2 * tid) = pk2(y.x, y.y); });
        __syncthreads();
    }
}

__device__ __forceinline__ void final_norm_phase(const bf16* X, float* yout, const float* g, int gw, int NGW, int lane) {
    f32x4 gv[4];
#pragma unroll
    for (int j = 0; j < 4; ++j) gv[j] = *(const f32x4*)(g + 4 * (lane + 64 * j));
    for (int m = gw; m < M; m += NGW) {
        const bf16* xr = X + (size_t)m * D;
        f32x4 v[4]; float sq = 0.f;
#pragma unroll
        for (int j = 0; j < 4; ++j) { const u32x2 w = *(const u32x2*)(xr + 4 * (lane + 64 * j)); v[j] = (f32x4){bflo(w.x), bfhi(w.x), bflo(w.y), bfhi(w.y)};
            sq += (v[j][0] * v[j][0] + v[j][1] * v[j][1]) + (v[j][2] * v[j][2] + v[j][3] * v[j][3]); }
        const float r = 1.0f / sqrtf(wave_sum_dpp(sq) * (1.f / D) + 1e-6f);
#pragma unroll
        for (int j = 0; j < 4; ++j) __builtin_nontemporal_store(v[j] * r * gv[j], (f32x4*)(yout + (size_t)m * D + 4 * (lane + 64 * j)));
    }
}

__device__ __forceinline__ void prep_phase(const float* xp, const float* xs, bf16* H, float* ss0, const float* g, const float* scale, const float* mod, const bf16* Wt, float* shw, int gw, int NGW, int lane) {
    { f32x4 gv[4];
#pragma unroll
      for (int j = 0; j < 4; ++j) gv[j] = *(const f32x4*)(g + 4 * (lane + 64 * j));
      for (int m = gw; m < M; m += NGW) {
          const float* xrow = m < MP ? xp + (size_t)m * D : xs + (size_t)(m - MP) * D;
          const int cond = m < MP ? 0 : 1 + ((m - MP) >> 10);
          f32x4 v[4]; float sq = 0.f;
#pragma unroll
          for (int j = 0; j < 4; ++j) { v[j] = *(const f32x4*)(xrow + 4 * (lane + 64 * j)); sq += (v[j][0] * v[j][0] + v[j][1] * v[j][1]) + (v[j][2] * v[j][2] + v[j][3] * v[j][3]); }
          sq = wave_sum_dpp(sq); if (lane == 0) ss0[m] = sq;
          f32x4 sc[4];
#pragma unroll
          for (int j = 0; j < 4; ++j) sc[j] = *(const f32x4*)(scale + cond * 6144 + 4 * (lane + 64 * j));
#pragma unroll
          for (int j = 0; j < 4; ++j) { const f32x4 h = v[j] * gv[j] * (1.f + sc[j]); u32x2 o; o.x = pk2(h[0], h[1]); o.y = pk2(h[2], h[3]);
              *(u32x2*)(H + (size_t)m * D + 4 * (lane + 64 * j)) = o; }
      } }
    for (int it = gw; it < 4 * 8192; it += NGW) {
        const int l = it >> 13, which = (it >> 12) & 1, n = it & 4095, i = l >> 1; const bool conv = (l & 1) != 0;
        const int N = which ? 4096 : (conv ? 2048 : 3072);
        if (n >= N) continue;
        const bf16* wrow = Wt + (which ? W_UP + (size_t)l * 4 * MEL : (conv ? W_PW1 + (size_t)i * 2 * MEL : W_QKV + (size_t)i * 3 * MEL)) + (size_t)n * D;
        float wv[16];
#pragma unroll
        for (int jj = 0; jj < 4; ++jj) { const u32x2 w = *(const u32x2*)(wrow + 4 * (lane + 64 * jj)); wv[4 * jj] = bflo(w.x); wv[4 * jj + 1] = bfhi(w.x); wv[4 * jj + 2] = bflo(w.y); wv[4 * jj + 3] = bfhi(w.y); }
#pragma unroll
        for (int cond = 0; cond < 5; ++cond) { const float* sh = mod + (size_t)(l * 5 + cond) * 6144 + (which ? 3 : 0) * 1024; float dot = 0.f;
#pragma unroll
            for (int jj = 0; jj < 4; ++jj) { const f32x4 s4 = *(const f32x4*)(sh + 4 * (lane + 64 * jj)); dot += (s4[0] * wv[4 * jj] + s4[1] * wv[4 * jj + 1]) + (s4[2] * wv[4 * jj + 2] + s4[3] * wv[4 * jj + 3]); }
            dot = wave_sum_dpp(dot); if (lane == 0) shw[(size_t)((l * 2 + which) * 5 + cond) * 4096 + n] = dot; }
    }
}

constexpr float SCL = 0.125f * 1.4426950408889634f, LOG2E = 1.4426950408889634f;
__device__ __forceinline__ void vt_write(LAS bf16* Vt, int pitch, int slot, int chunk, u32x4 v) {
    LAS bf16* p = Vt + (8 * chunk) * pitch + (slot ^ (chunk << 2));
    p[0] = (bf16)(v.x & 0xffffu); p[pitch] = (bf16)(v.x >> 16); p[2 * pitch] = (bf16)(v.y & 0xffffu); p[3 * pitch] = (bf16)(v.y >> 16);
    p[4 * pitch] = (bf16)(v.z & 0xffffu); p[5 * pitch] = (bf16)(v.z >> 16); p[6 * pitch] = (bf16)(v.w & 0xffffu); p[7 * pitch] = (bf16)(v.w >> 16);
}
template <int NB> __device__ __forceinline__ void softmax_part(f32x4 (&s)[NB], float& mx_out, float& sum_out, int lane, float m_floor = -INFINITY) {
    float mx = m_floor;
#pragma unroll
    for (int b = 0; b < NB; ++b) mx = fmaxf(mx, fmaxf(fmaxf(s[b][0], s[b][1]), fmaxf(s[b][2], s[b][3])));
    mx = fmaxf(mx, shx(mx, 16, lane)); mx = fmaxf(mx, shx(mx, 32, lane));
    float sum = 0.f;
#pragma unroll
    for (int b = 0; b < NB; ++b) {
#pragma unroll
        for (int e = 0; e < 4; ++e) { s[b][e] = __builtin_amdgcn_exp2f(s[b][e] - mx); sum += s[b][e]; } }
    sum += shx(sum, 16, lane); sum += shx(sum, 32, lane);
    mx_out = mx; sum_out = sum;
}
__device__ __forceinline__ bf16x8 pack_p(const f32x4& a, const f32x4& b) {
    u32x4 w; w.x = pk2(a[0], a[1]); w.y = pk2(a[2], a[3]); w.z = pk2(b[0], b[1]); w.w = pk2(b[2], b[3]); return __builtin_bit_cast(bf16x8, w);
}
__device__ __forceinline__ bf16x8 vt_read(const LAS bf16* p0, const LAS bf16* p1) {
    const s16x4 a = *(const LAS s16x4*)p0, b = *(const LAS s16x4*)p1; return (bf16x8){a[0], a[1], a[2], a[3], b[0], b[1], b[2], b[3]};
}
__device__ __forceinline__ f32x4 qk_block(const bf16* kp, const bf16x8& qf0, const bf16x8& qf1) {
    const bf16x8 k0 = *(const bf16x8*)kp, k1 = *(const bf16x8*)(kp + 32);
    f32x4 a = __builtin_amdgcn_mfma_f32_16x16x32_bf16(k0, qf0, (f32x4){0.f, 0.f, 0.f, 0.f}, 0, 0, 0);
    return __builtin_amdgcn_mfma_f32_16x16x32_bf16(k1, qf1, a, 0, 0, 0);
}
#define PV16(o, s, SLOT_EXPR, PITCH_) do { _Pragma("unroll") for (int pp = 0; pp < 8; ++pp) { const bf16x8 pf = pack_p(s[2 * pp], s[2 * pp + 1]); const int slot0 = (SLOT_EXPR); \
        _Pragma("unroll") for (int db = 0; db < 4; ++db) { const LAS bf16* vr = Vt + (16 * db + l15) * (PITCH_); const int sw_ = (2 * db + (l15 >> 3)) << 2; \
            o[db] = __builtin_amdgcn_mfma_f32_16x16x32_bf16(vt_read(vr + (slot0 ^ sw_), vr + ((slot0 + 16) ^ sw_)), pf, o[db], 0, 0, 0); } } } while (0)

#ifndef CBN
#define CBN 4
#endif
__device__ __forceinline__ void attn_phase(const bf16* Qb, const bf16* Kb, const bf16* Vb, bf16* Ob, const bf16* CK, const bf16* CV, const float* rpb  ,
                                           int li, LAS unsigned char* lds, int tid, int lane, int wave, int G, int bid, int ulo, int uhi) {
    LAS bf16* Vt = (LAS bf16*)lds; LAS float* rpl = (LAS float*)(lds + 110592); LAS unsigned char* Kc = lds + LDS_KC;
    for (int u = bid + ulo; u < uhi; u += G) {
        int lz_ = lane; asm volatile("" : "+v"(lz_));
        const int l15 = lz_ & 15, g = lz_ >> 4;
        if (u < 512) {
            const int b = u >> 4, h = u & 15; constexpr int PITCH = 264;
            const int qrow0 = b * 256 + 32 * wave + l15;
            const bf16x8 qa0 = *(const bf16x8*)(Qb + (size_t)qrow0 * D + h * 64 + 8 * g), qa1 = *(const bf16x8*)(Qb + (size_t)qrow0 * D + h * 64 + 32 + 8 * g);
            const bf16x8 qb0 = *(const bf16x8*)(Qb + (size_t)(qrow0 + 16) * D + h * 64 + 8 * g), qb1 = *(const bf16x8*)(Qb + (size_t)(qrow0 + 16) * D + h * 64 + 32 + 8 * g);
            SB0();
            { int t2 = tid; asm volatile("" : "+v"(t2));
              u32x4 v[4], kv[4];
#pragma unroll
              for (int it = 0; it < 4; ++it) { const int idx = t2 + NTHR * it, key = idx >> 3, chunk = idx & 7; const size_t off = (size_t)(b * 256 + key) * D + h * 64 + 8 * chunk;
                  v[it] = *(const u32x4*)(Vb + off); kv[it] = *(const u32x4*)(Kb + off); }
              SB0();
#pragma unroll
              for (int it = 0; it < 4; ++it) { const int idx = t2 + NTHR * it, key = idx >> 3, chunk = idx & 7;
                  *(LAS u32x4*)(Kc + key * 144 + chunk * 16) = kv[it];
                  vt_write(Vt, PITCH, key, chunk, v[it]); } }
            __syncthreads();
            SB0();
            f32x4 s0[16], s1[16];
            { const LAS unsigned char* kl = Kc + l15 * 144 + g * 16;
              sfor<16>([&](auto I) __attribute__((always_inline)) { constexpr int kb = decltype(I)::value;
                const bf16x8 k0 = *(const LAS bf16x8*)(kl + kb * (16 * 144)), k1 = *(const LAS bf16x8*)(kl + kb * (16 * 144) + 64);
                f32x4 a = __builtin_amdgcn_mfma_f32_16x16x32_bf16(k0, qa0, (f32x4){0.f, 0.f, 0.f, 0.f}, 0, 0, 0); s0[kb] = __builtin_amdgcn_mfma_f32_16x16x32_bf16(k1, qa1, a, 0, 0, 0) * SCL;
                f32x4 c = __builtin_amdgcn_mfma_f32_16x16x32_bf16(k0, qb0, (f32x4){0.f, 0.f, 0.f, 0.f}, 0, 0, 0); s1[kb] = __builtin_amdgcn_mfma_f32_16x16x32_bf16(k1, qb1, c, 0, 0, 0) * SCL; }); }
            { float mx, sum; softmax_part<16>(s0, mx, sum, lane);
              f32x4 o[4];
#pragma unroll
              for (int db = 0; db < 4; ++db) o[db] = (f32x4){0.f, 0.f, 0.f, 0.f};
              PV16(o, s0, 32 * pp + 4 * g, PITCH);
              const float rl = 1.0f / sum;
#pragma unroll
              for (int db = 0; db < 4; ++db) { const f32x4 ov = o[db] * rl; u32x2 w; w.x = pk2(ov[0], ov[1]); w.y = pk2(ov[2], ov[3]);
                  *(u32x2*)(Ob + (size_t)qrow0 * D + h * 64 + 16 * db + 4 * g) = w; } }
            { float mx, sum; softmax_part<16>(s1, mx, sum, lane);
              f32x4 o[4];
#pragma unroll
              for (int db = 0; db < 4; ++db) o[db] = (f32x4){0.f, 0.f, 0.f, 0.f};
              PV16(o, s1, 32 * pp + 4 * g, PITCH);
              const float rl = 1.0f / sum;
#pragma unroll
              for (int db = 0; db < 4; ++db) { const f32x4 ov = o[db] * rl; u32x2 w; w.x = pk2(ov[0], ov[1]); w.y = pk2(ov[2], ov[3]);
                  *(u32x2*)(Ob + (size_t)(qrow0 + 16) * D + h * 64 + 16 * db + 4 * g) = w; } }
            __syncthreads();
        } else {
            const int ui = u - 512, xcd = ui & 7, idx = (ui >> 3) & 63, uu = (G == 256) ? ((xcd * 8 + (idx >> 3)) << 3) + (idx & 7) : ui;
            const int b = uu >> 7, h = (uu >> 3) & 15, rp = uu & 7, r0 = 2 * rp; constexpr int PITCH = 840;
            const int rs0 = min(max(r0 - 4, 0), 8);
            const size_t tokb = (size_t)MP + (size_t)b * 1024;
            const int r = r0 + (wave >> 2), j = wave & 3, rs = min(max(r - 4, 0), 8), rrel = rs - rs0, kcs = min(max(16 * j - 8, 0), 32);
            const int qcol = 16 * j + l15, wst = min(max(qcol - 8, 0), 48);
            const size_t qtok = tokb + r * 64 + qcol;
            const bf16* kloc = Kb + (tokb + rs * 64 + kcs + l15) * D + h * 64 + 8 * g;
            bf16x8 kf[16][2];
#define LOAD_KLOC(H) sfor<8>([&](auto I) __attribute__((always_inline)) { constexpr int lb = 8 * (H) + decltype(I)::value; const bf16* kp = kloc + (size_t)((lb >> 1) * 64 + 16 * (lb & 1)) * D; kf[lb][0] = *(const bf16x8*)kp; kf[lb][1] = *(const bf16x8*)(kp + 32); })
            LOAD_KLOC(0);
            const bf16x8 qf0 = *(const bf16x8*)(Qb + qtok * D + h * 64 + 8 * g), qf1 = *(const bf16x8*)(Qb + qtok * D + h * 64 + 32 + 8 * g);
            SB0();
            { int t2 = tid; asm volatile("" : "+v"(t2));
              u32x4 vv[13], kv[4];
#pragma unroll
              for (int it = 0; it < 13; ++it) { const int idx = t2 + NTHR * it, slot = idx >> 3, chunk = idx & 7;
                  const bf16* src = (slot < 576) ? Vb + (tokb + min(rs0 + (slot >> 6), 15) * 64 + (slot & 63)) * D + h * 64 : CV + ((size_t)(b * 2 + li) * 256 + (slot - 576)) * D + h * 64;
                  vv[it] = *(const u32x4*)(src + 8 * chunk); }
#pragma unroll
              for (int it = 0; it < 4; ++it) { const int idx = t2 + NTHR * it, key = idx >> 3, chunk = idx & 7;
                  kv[it] = *(const u32x4*)(CK + ((size_t)(b * 2 + li) * 256 + key) * D + h * 64 + 8 * chunk); }
              const float rv = rpb[h * 465 + min(t2, 464)];
              SB0();
#pragma unroll
              for (int it = 0; it < 13; ++it) { const int idx = t2 + NTHR * it; vt_write(Vt, PITCH, idx >> 3, idx & 7, vv[it]); }
#pragma unroll
              for (int it = 0; it < 4; ++it) { const int idx = t2 + NTHR * it; *(LAS u32x4*)(Kc + (idx >> 3) * 144 + (idx & 7) * 16) = kv[it]; }
              if (t2 < 465) rpl[t2] = rv; }
            SB0(); LOAD_KLOC(1); SB0();
            __syncthreads();
            SB0();
            f32x4 o1[4]; float m1, l1, m2, l2;
#pragma unroll
            for (int db = 0; db < 4; ++db) o1[db] = (f32x4){0.f, 0.f, 0.f, 0.f};
            {
                int dcv[8]; unsigned vmask = 0u;
#pragma unroll
                for (int ce = 0; ce < 8; ++ce) { const int kc = kcs + 16 * (ce >> 2) + 4 * g + (ce & 3); vmask |= ((kc >= wst) && (kc < wst + 16)) ? (1u << ce) : 0u; dcv[ce] = min(max(kc - qcol + 15, 0), 30); }
                f32x4 s[16];
#define QK_LOC(H) sfor<8>([&](auto I) __attribute__((always_inline)) { constexpr int lb = 8 * (H) + decltype(I)::value, krow = lb >> 1, ch = lb & 1; \
                    f32x4 a = __builtin_amdgcn_mfma_f32_16x16x32_bf16(kf[lb][0], qf0, (f32x4){0.f, 0.f, 0.f, 0.f}, 0, 0, 0); a = __builtin_amdgcn_mfma_f32_16x16x32_bf16(kf[lb][1], qf1, a, 0, 0, 0); \
                    const LAS float* rp_row = rpl + (rs + krow - r + 7) * 31; float bias[4]; \
                    _Pragma("unroll") for (int e = 0; e < 4; ++e) bias[e] = rp_row[dcv[ch * 4 + e]]; \
                    _Pragma("unroll") for (int e = 0; e < 4; ++e) { const float t = a[e] * SCL + bias[e] * LOG2E; a[e] = ((vmask >> (ch * 4 + e)) & 1u) ? t : -INFINITY; } \
                    s[lb] = a; })
                QK_LOC(0); QK_LOC(1); SB0();
                softmax_part<16>(s, m1, l1, lane);
                PV16(o1, s, (rrel + pp) * 64 + kcs + 4 * g, PITCH);
            }
            SB0();
            {
                f32x4 s[16];
                { const LAS unsigned char* kl = Kc + l15 * 144 + g * 16;
                  sfor<16>([&](auto I) __attribute__((always_inline)) { constexpr int cb = decltype(I)::value;
                    const bf16x8 k0 = *(const LAS bf16x8*)(kl + cb * (16 * 144)), k1 = *(const LAS bf16x8*)(kl + cb * (16 * 144) + 64);
                    f32x4 a = __builtin_amdgcn_mfma_f32_16x16x32_bf16(k0, qf0, (f32x4){0.f, 0.f, 0.f, 0.f}, 0, 0, 0); s[cb] = __builtin_amdgcn_mfma_f32_16x16x32_bf16(k1, qf1, a, 0, 0, 0) * SCL; }); }
                softmax_part<16>(s, m2, l2, lane, m1);
                const float a1 = __builtin_amdgcn_exp2f(m1 - m2);
#pragma unroll
                for (int db = 0; db < 4; ++db) o1[db] = o1[db] * a1;
                l1 = l1 * a1 + l2;
                PV16(o1, s, 576 + 32 * pp + 4 * g, PITCH);
            }
            const float rl = 1.0f / l1;
            int r2_ = r; asm volatile("" : "+s"(r2_));
            const size_t qtok2 = tokb + r2_ * 64 + qcol;
#pragma unroll
            for (int db = 0; db < 4; ++db) { const f32x4 ov = o1[db] * rl; u32x2 w; w.x = pk2(ov[0], ov[1]); w.y = pk2(ov[2], ov[3]);
                *(u32x2*)(Ob + qtok2 * D + h * 64 + 16 * db + 4 * g) = w; }
            __syncthreads();
        }
    }
}

#define RLX_AGENT __ATOMIC_RELAXED, __HIP_MEMORY_SCOPE_AGENT
#define XB_TMO      128
#define XB_XCNT(j)  (256  + 64 * (j))
#define XB_XSUB(j)  (1280 + 64 * (j))
#define XB_XGEN(j)  (2304 + 64 * (j))
#define XB_TOP      3328
#define XB_TOPGEN   3392
#define XCD_BAR_WORDS 3456
#define XB_SPIN_CAP (1u << 18)

__device__ __forceinline__ unsigned xb_ld(unsigned* p)              { return __hip_atomic_load(p, __ATOMIC_RELAXED, __HIP_MEMORY_SCOPE_AGENT); }
__device__ __forceinline__ unsigned xb_add(unsigned* p, unsigned v) { return __hip_atomic_fetch_add(p, v, __ATOMIC_RELAXED, __HIP_MEMORY_SCOPE_AGENT); }
__device__ __forceinline__ unsigned xb_xcc_id() { return (unsigned)__builtin_amdgcn_s_getreg((3 << 11) | 20) & 0xFu; }
#define XB_SPIN(cond, bar) do { unsigned _sp = 0; while (cond) { __builtin_amdgcn_s_sleep(1); \
    if ((++_sp & 255u) == 0u) { if (xb_ld(&(bar)[XB_TMO])) break; if (_sp > XB_SPIN_CAP) { atomicAdd(&(bar)[XB_TMO], 1u); break; } } } } while (0)

struct XcdBarrier {
    unsigned* bar; unsigned x;
    volatile LAS unsigned* st;
};

__device__ __forceinline__ XcdBarrier xcd_barrier_post(unsigned* bar, volatile LAS unsigned* st) {
    XcdBarrier b; b.bar = bar; b.x = xb_xcc_id(); b.st = st;
    if (threadIdx.x == 0) (void)xb_add(&bar[XB_XCNT(b.x)], 1u);
    return b;
}
__device__ __forceinline__ void xcd_barrier_complete(unsigned* bar, unsigned x, unsigned& nloc, unsigned& nx) {
    const unsigned G = gridDim.x * gridDim.y * gridDim.z;
    unsigned sum, cnt, mine, sp = 0u;
    for (;;) {
        sum = 0u; cnt = 0u; mine = 0u;
#pragma unroll
        for (unsigned j = 0; j < 16; ++j) { const unsigned c = xb_ld(&bar[XB_XCNT(j)]); sum += c; cnt += (c > 0u) ? 1u : 0u; mine = (j == x) ? c : mine; }
        if (sum == G) break;
        __builtin_amdgcn_s_sleep(1);
        if ((++sp & 255u) == 0u) { if (xb_ld(&bar[XB_TMO])) break; if (sp > XB_SPIN_CAP) { atomicAdd(&bar[XB_TMO], 1u); break; } }
    }
    nloc = mine > 0u ? mine : 1u; nx = cnt > 0u ? cnt : 1u;
}

__device__ __forceinline__ void xcd_barrier(const XcdBarrier& b) {
    asm volatile("s_waitcnt vmcnt(0)" ::: "memory");
    __syncthreads();
    if (threadIdx.x == 0) {
        unsigned* bar = b.bar;
        __builtin_amdgcn_s_waitcnt(0);
        unsigned nloc = b.st[0], nx = b.st[1];
        if (nloc == 0u) { xcd_barrier_complete(bar, b.x, nloc, nx); b.st[0] = nloc; b.st[1] = nx; }
        const unsigned old = xb_add(&bar[XB_XSUB(b.x)], 1u);
        const unsigned gen = old / nloc;
        if (old + 1u == (gen + 1u) * nloc) {
            __builtin_amdgcn_fence(__ATOMIC_RELEASE, "agent");
            asm volatile("s_waitcnt vmcnt(0)" ::: "memory");
            const unsigned og = xb_add(&bar[XB_TOP], 1u);
            if (og + 1u == (gen + 1u) * nx) xb_add(&bar[XB_TOPGEN], 1u);
            else XB_SPIN(xb_ld(&bar[XB_TOPGEN]) == gen, bar);
            __builtin_amdgcn_fence(__ATOMIC_ACQUIRE, "agent");
            asm volatile("s_waitcnt vmcnt(0)" ::: "memory");
        } else {
            XB_SPIN(xb_ld(&bar[XB_TOPGEN]) == gen, bar);
            __builtin_amdgcn_fence(__ATOMIC_ACQUIRE, "agent");
            asm volatile("s_waitcnt vmcnt(0)" ::: "memory");
        }
    }
    __syncthreads();
}

constexpr int NPH = 2 + 5 * NL + 1;
struct Args { const float* in[21]; float* out; unsigned char* ws; int nprog, pad; int prog[48]; };
typedef const __attribute__((address_space(4))) Args* KArgPtr;
__global__ void __launch_bounds__(NTHR, 2) fwd_kernel(Args a_unused) {
    extern __shared__ __attribute__((aligned(16))) unsigned char lds_raw[];
    LAS unsigned char* lds = (LAS unsigned char*)lds_raw;
    cg::grid_group grid = cg::this_grid();
    const int wave0 = __builtin_amdgcn_readfirstlane((int)threadIdx.x >> 6);
    { volatile LAS unsigned* st0 = (volatile LAS unsigned*)(lds + LDS_ST); if (threadIdx.x < 2) st0[threadIdx.x] = 0u; }
    __syncthreads();
    XcdBarrier xbar; { KArgPtr kpb = (KArgPtr)__builtin_amdgcn_kernarg_segment_ptr(); xbar.bar = (unsigned*)kpb->ws; xbar.x = 0; xbar.st = (volatile LAS unsigned*)(lds + LDS_ST);
        if (blockIdx.x == 0) { for (int wI = threadIdx.x; wI < XCD_BAR_WORDS; wI += NTHR) __hip_atomic_store(xbar.bar + wI, 0u, __ATOMIC_RELAXED, __HIP_MEMORY_SCOPE_AGENT); } }
    int nprog; { KArgPtr kp0 = (KArgPtr)__builtin_amdgcn_kernarg_segment_ptr(); nprog = kp0->nprog; }
    for (int pc = 0; pc < nprog; ++pc) {
        KArgPtr kp = (KArgPtr)__builtin_amdgcn_kernarg_segment_ptr(); asm volatile("" : "+s"(kp));
        int z_ = 0; asm volatile("" : "+s"(z_));
        const int lane_ = (int)__builtin_amdgcn_mbcnt_hi(~0u, __builtin_amdgcn_mbcnt_lo(~0u, (unsigned)z_)); const int tid_ = wave0 * 64 + lane_;
        int bid_ = (int)__builtin_amdgcn_workgroup_id_x(), G_ = (int)gridDim.x; asm volatile("" : "+s"(bid_), "+s"(G_));
        const int pe_ = kp->prog[pc]; const int ph = pe_ & 63, amode = pe_ >> 6;
        const int tid = tid_, lane = lane_, wave = wave0, G = G_, bid = bid_;
        const int gw = bid * NWAVES + wave, NGW = G * NWAVES;
        Ptrs P; P = Ptrs{kp->in[0], kp->in[1], kp->in[2], kp->in[3], kp->in[4], kp->in[5], kp->in[6], kp->in[7], kp->in[8], kp->in[9], kp->in[10], kp->in[11], kp->in[12], kp->in[13], kp->in[14], kp->in[15], kp->in[16], kp->in[17], kp->in[18], kp->in[19], kp->in[20]};
        unsigned char* ws = kp->ws; float* outp = kp->out;
        float* mod = (float*)(ws + WS_MOD); bf16* Wt = (bf16*)(ws + WS_W); bf16* X = (bf16*)(ws + WS_X); bf16* H = (bf16*)(ws + WS_H);
        bf16* R = (bf16*)(ws + WS_R); bf16* Qb = R; bf16* Kb = R + (size_t)M * D; bf16* Vb = R + (size_t)2 * M * D; bf16* Ob = R + (size_t)3 * M * D;
        bf16* Ub = R; bf16* Vc = R + (size_t)M * D; bf16* Fb = R;
        const bf16* CK = (const bf16*)(ws + WS_CK); const bf16* CV = (const bf16*)(ws + WS_CV);
        float* out_y = outp; float* out_ck = outp + (size_t)M * D; float* out_cv = out_ck + (size_t)32 * 2 * 256 * 1024;
        float* SS = (float*)(ws + WS_SS); float* SHW = (float*)(ws + WS_SHW);
        if (ph == 0) { p0_phase(P, ws, lds, tid, lane, wave, G, bid); }
        else if (ph == 1) { prep_phase(P.x_prompt, P.x_sample, H, SS, P.norm_g, mod + 1 * 1024, mod, Wt, SHW, gw, NGW, lane); }
        else if (ph == NPH - 1) { final_norm_phase(X, out_y, P.final_g, gw, NGW, lane); }
        else if (ph >= 60) { }
        else {
            const int l = (ph - 2) / 5, s = (ph - 2) % 5, i = l >> 1; const bool conv = (l & 1) != 0;
            const float* modl = mod + (size_t)l * 5 * 6144;
            if (s == 0) {
                const float* ssl = SS + (size_t)(2 * l) * M; const float* shl = SHW + (size_t)((2 * l) * 5) * 4096;
                if (!conv) { pg8::Gemm gm{H, Wt + W_QKV + (size_t)i * 3 * MEL, M, 3 * D, D}; pg8::StaticOrder S; S.init(M, 3 * D, G, bid);
                    pg8::EpiQKV E{ssl, shl, Qb, (size_t)M * D, out_ck + (size_t)i * 256 * 1024, (size_t)32 * 2 * 256 * 1024};
                    pg8::gemm_phase<pg8::EpiQKV, pg8::StaticOrder, true, true>(lds, gm, S, E, tid); }
                else { pg8::Gemm gm{H, Wt + W_PW1 + (size_t)i * 2 * MEL, M, 2 * D, D}; pg8::StaticOrder S; S.init(M, 2 * D, G, bid);
                    pg8::EpiGLU E{ssl, shl, Ub};
                    pg8::gemm_phase<pg8::EpiGLU, pg8::StaticOrder, true, true>(lds, gm, S, E, tid); }
            } else if (s == 1) {
                if (!conv) attn_phase(Qb, Kb, Vb, Ob, CK, CV, P.rpb + (size_t)i * 16 * 15 * 31, i, lds, tid, lane, wave, G, bid, amode == 2 ? 512 : 0, amode == 1 ? 512 : 1024);
                else conv_phase(Ub, Vc, P.w_dw + (size_t)i * 31 * D, P.b_dw + i * D, P.ln_g + i * D, P.ln_b + i * D, lds, tid, lane, wave, G, bid);
            } else if (s == 2 || s == 4) {
                pg8::Gemm gm; pg8::EpiRes E;
                if (s == 2) { gm = pg8::Gemm{conv ? Vc : Ob, Wt + (conv ? W_PW2 : W_O) + (size_t)i * MEL, M, D, D};
                    E = pg8::EpiRes{P.x_prompt, P.x_sample, l == 0 ? (const bf16*)nullptr : X, X, modl + 2 * 1024, H, P.norm_g + (l * 2 + 1) * D, modl + 4 * 1024, SS + (size_t)(2 * l + 1) * M}; }
                else { gm = pg8::Gemm{Fb, Wt + W_DOWN + (size_t)l * 4 * MEL, M, D, FF};
                    E = pg8::EpiRes{P.x_prompt, P.x_sample, X, X, modl + 5 * 1024, l < NL - 1 ? H : nullptr, P.norm_g + ((l + 1) * 2) * D, modl + 5 * 6144 + 1 * 1024, SS + (size_t)(2 * l + 2) * M}; }
                pg8::StaticOrder S; S.init(M, D, G, bid);
                pg8::gemm_phase<pg8::EpiRes, pg8::StaticOrder, true, true>(lds, gm, S, E, tid);
            } else {
#ifdef UP256
                pg8::Gemm gm{H, Wt + W_UP + (size_t)l * 4 * MEL, M, FF, D}; pg8::StaticOrder256 S; S.init(M, FF, G, bid);
                pg8::EpiUp256 E{SS + (size_t)(2 * l + 1) * M, SHW + (size_t)((2 * l + 1) * 5) * 4096, Fb, FF};
                pg8::gemm_phase256<pg8::EpiUp256, pg8::StaticOrder256, true, true>(lds, gm, S, E, tid);
#else
                pg8::Gemm gm{H, Wt + W_UP + (size_t)l * 4 * MEL, M, FF, D}; pg8::StaticOrder S; S.init(M, FF, G, bid);
                pg8::EpiUp E{SS + (size_t)(2 * l + 1) * M, SHW + (size_t)((2 * l + 1) * 5) * 4096, Fb, FF};
                pg8::gemm_phase<pg8::EpiUp, pg8::StaticOrder, true, true>(lds, gm, S, E, tid);
#endif
            }
        }
        if (pc + 1 < nprog) { if (pc == 0) { grid.sync(); xbar = xcd_barrier_post(xbar.bar, xbar.st); } else xcd_barrier(xbar); }
    }
}

#ifndef SINGLE_LAUNCH
#define SINGLE_LAUNCH 0
#endif
extern "C" void kernel_launch(void* const* d_in, const int* in_sizes, int n_in, void* d_out, int out_size, void* d_ws, size_t ws_size, hipStream_t stream) {
    static int grid = 0;
    if (grid == 0) {
        if (n_in != 21 || ws_size < WS_END) { fprintf(stderr, "kernel_launch: unexpected n_in %d / ws_size %zu\n", n_in, ws_size); grid = -1; return; }
        int dev = 0, cus = 0, per_cu = 0;
        hipGetDevice(&dev); hipDeviceGetAttribute(&cus, hipDeviceAttributeMultiprocessorCount, dev);
        hipFuncSetAttribute((const void*)fwd_kernel, hipFuncAttributeMaxDynamicSharedMemorySize, LDS_BYTES);
        hipOccupancyMaxActiveBlocksPerMultiprocessor(&per_cu, (const void*)fwd_kernel, NTHR, LDS_BYTES);
        if (per_cu < 1) { fprintf(stderr, "kernel_launch: occupancy query says %d blocks/CU\n", per_cu); per_cu = 1; }
        (void)hipGetLastError();
        grid = cus * per_cu;
    }
    if (grid < 0) return;
    Args a{};
    for (int i = 0; i < 21; ++i) a.in[i] = (const float*)d_in[i];
    a.out = (float*)d_out; a.ws = (unsigned char*)d_ws;
#if SINGLE_LAUNCH
    { int n = 0;
      for (int ph = 0; ph < NPH; ++ph) { a.prog[n++] = ph;
#ifdef PROBE_ATTN_MODE
          if (ph >= 2 && ph < NPH - 1 && (ph - 2) % 5 == 1 && ((ph - 2) / 5) % 2 == 0) a.prog[n++] = ph | (PROBE_ATTN_MODE << 6);
#endif
#ifdef PROBE_EMPTY
          if (ph == 5) for (int q = 0; q < PROBE_EMPTY; ++q) a.prog[n++] = 60;
#endif
#ifdef PROBE_REPEAT_P0
          if (ph == 0) a.prog[n++] = 0;
#endif
#ifdef PROBE_REPEAT_S
          if (ph >= 2 && ph < NPH - 1 && (ph - 2) % 5 == PROBE_REPEAT_S && (PROBE_REPEAT_PAR < 0 || ((ph - 2) / 5) % 2 == PROBE_REPEAT_PAR)) a.prog[n++] = ph;
#endif
      }
      a.nprog = n; }
    void* args[] = {&a};
    hipError_t e = hipLaunchCooperativeKernel((const void*)fwd_kernel, dim3(grid), dim3(NTHR), args, LDS_BYTES, stream);
    if (e != hipSuccess) fprintf(stderr, "cooperative launch failed: %s (grid %d)\n", hipGetErrorString(e), grid);
#else
    for (int ph = 0; ph < NPH; ++ph) { a.nprog = 1; a.prog[0] = ph; hipLaunchKernelGGL(fwd_kernel, dim3(grid), dim3(NTHR), LDS_BYTES, stream, a); }
#endif
}
```

```cpp
#define SINGLE_LAUNCH 1
#define UP256 1
#include <hip/hip_runtime.h>
#include <hip/hip_cooperative_groups.h>
#include <cstdio>
#include <cstdint>
#include <cmath>
#include <utility>
namespace cg = cooperative_groups;
namespace pg8 {
#define PG8_LAS __attribute__((address_space(3)))
typedef unsigned short bf16_t;
typedef short bf16x8 __attribute__((ext_vector_type(8)));
typedef float f32x4 __attribute__((ext_vector_type(4)));
typedef unsigned u32x4 __attribute__((ext_vector_type(4)));
constexpr int RM = 192;
constexpr int BM = 256, BK = 64, HALF = 128, HTB = HALF * BK * 2  , STAGE_BYTES = 8 * HTB, NXCD = 8, WGM = 8;

__host__ __device__ __forceinline__ int lds_byte(int r, int c) { const int st = (r >> 4) * 2 + (c >> 5), rr = r & 15, cc = c & 31, ob = rr * 64 + cc * 2; return st * 1024 + (ob ^ (((ob >> 9) & 1) << 5)); }
__host__ __device__ __forceinline__ void stage_rc(int b, int& R, int& C) { const int st = b / 1024, sb = b % 1024, swz = sb ^ (((sb >> 9) & 1) << 5); R = (st >> 1) * 16 + swz / 64; C = (st & 1) * 32 + (swz % 64) / 2; }
__host__ __device__ __forceinline__ int perm32(int rho) { const int n = rho >> 4, i = rho & 15; return 8 * (i >> 2) + 4 * n + (i & 3); }

struct Unit { int pm, pn; };
struct Gemm { const bf16_t* A; const bf16_t* Bt; int M, N, K; };

struct StaticOrder {
    int nM, nN, nwg, G, c;
    __host__ __device__ void init(int M, int N, int G_, int c_) { nM = M / RM; nN = N / BM; nwg = nM * nN; G = G_; c = c_; }
    __host__ __device__ bool next(int i, Unit& u) const {
        const long L = (long)i * G + c; if (L >= nwg) return false;
        int wgid = (int)L; { const int q = nwg / NXCD, r = nwg % NXCD, xcd = wgid % NXCD, off = wgid / NXCD; wgid = (xcd < r ? xcd * (q + 1) : r * (q + 1) + (xcd - r) * q) + off; }
        const int nig = WGM * nN, gid = wgid / nig, fm = gid * WGM, gsz = (nM - fm) < WGM ? (nM - fm) : WGM;
        u.pm = fm + ((wgid % nig) % gsz); u.pn = (wgid % nig) / gsz; return true;
    }
    __device__ __forceinline__ void a_ready(const Unit&) const {}
    __device__ __forceinline__ void done(const Unit&) const {}
};

__device__ __forceinline__ unsigned cvt_pk_bf16(float lo, float hi) { unsigned r; asm volatile("v_cvt_pk_bf16_f32 %0, %1, %2" : "=v"(r) : "v"(lo), "v"(hi)); return r; }
typedef float f32x2 __attribute__((ext_vector_type(2)));
__device__ __forceinline__ int cond_of_row(int r) { return r < 8192 ? 0 : 1 + ((r - 8192) >> 10); }
__device__ __forceinline__ int half_row0(int ai, int wr) { return ai == 0 ? wr * 64 : 128 + wr * 32; }
#define EPI_MLOOP(ai, m) _Pragma("unroll") for (int m = 0; m < 4; ++m) if (ai == 0 || m < 2)
struct EpiQKV {
    static constexpr bool PERM = true, AFTER_DRAIN = false;
    const float* ss; const float* shw;
    bf16_t* Q; size_t qkv_stride; float* ck; size_t ckv_stride;
    __device__ __forceinline__ void operator()(const f32x4 (&acc)[2][2][4][2], const Unit& u, int wr, int wc, int fr, int fq) const {
        const int t = u.pn >> 2;
        bf16_t* base = Q + (size_t)t * qkv_stride;
        const int col0 = (u.pn & 3) * BM + wc * 32 + 8 * fq;
        float* cbase = ck + (size_t)(t > 0 ? t - 1 : 0) * ckv_stride + col0;
#pragma unroll
        for (int ai = 0; ai < 2; ++ai) { const int rbase = u.pm * RM + half_row0(ai, wr) + fr; const bool wc_ = (t > 0) && (rbase < 8192);
            const float* sp = shw + cond_of_row(rbase) * 4096 + u.pn * BM + wc * 32 + 8 * fq;
            f32x4 sv[2][2];
#pragma unroll
            for (int bj = 0; bj < 2; ++bj) { sv[bj][0] = *(const f32x4*)(sp + bj * HALF); sv[bj][1] = *(const f32x4*)(sp + bj * HALF + 4); }
            float rr[4];
            EPI_MLOOP(ai, m) rr[m] = ss[rbase + m * 16];
            EPI_MLOOP(ai, m) { const int row = rbase + m * 16; bf16_t* rowp = base + (size_t)row * 1024 + col0;
                const float r = __builtin_amdgcn_rsqf(rr[m] * (1.f / 1024.f) + 1e-6f);
                float* cp0 = cbase + ((size_t)(row >> 8) * 2 * 256 + (row & 255)) * 1024;
#pragma unroll
                for (int bj = 0; bj < 2; ++bj) { const f32x4 v0 = acc[ai][bj][m][0] * r + sv[bj][0], v1 = acc[ai][bj][m][1] * r + sv[bj][1];
                    u32x4 w; w.x = cvt_pk_bf16(v0[0], v0[1]); w.y = cvt_pk_bf16(v0[2], v0[3]); w.z = cvt_pk_bf16(v1[0], v1[1]); w.w = cvt_pk_bf16(v1[2], v1[3]);
                    *(u32x4*)(rowp + bj * HALF) = w;
                    if (wc_) { float* cp = cp0 + bj * HALF; __builtin_nontemporal_store(v0, (f32x4*)cp); __builtin_nontemporal_store(v1, (f32x4*)(cp + 4)); } } } }
    }
};
struct EpiUp {
    static constexpr bool PERM = true, AFTER_DRAIN = false;
    const float* ss; const float* shw; bf16_t* O; int ldc;
    __device__ __forceinline__ void operator()(const f32x4 (&acc)[2][2][4][2], const Unit& u, int wr, int wc, int fr, int fq) const {
        const int col0 = u.pn * BM + wc * 32 + 8 * fq;
#pragma unroll
        for (int ai = 0; ai < 2; ++ai) { const int rbase = u.pm * RM + half_row0(ai, wr) + fr;
            const float* sp = shw + cond_of_row(rbase) * 4096 + col0;
            f32x4 sv[2][2];
#pragma unroll
            for (int bj = 0; bj < 2; ++bj) { sv[bj][0] = *(const f32x4*)(sp + bj * HALF); sv[bj][1] = *(const f32x4*)(sp + bj * HALF + 4); }
            float rr[4];
            EPI_MLOOP(ai, m) rr[m] = ss[rbase + m * 16];
            EPI_MLOOP(ai, m) { bf16_t* rowp = O + (size_t)(rbase + m * 16) * ldc + col0;
                const float r = __builtin_amdgcn_rsqf(rr[m] * (1.f / 1024.f) + 1e-6f);
#pragma unroll
                for (int bj = 0; bj < 2; ++bj) { f32x4 v0 = acc[ai][bj][m][0] * r + sv[bj][0], v1 = acc[ai][bj][m][1] * r + sv[bj][1];
#pragma unroll
                    for (int e = 0; e < 4; ++e) { const float a = fmaxf(v0[e], 0.f), b = fmaxf(v1[e], 0.f); v0[e] = a * a; v1[e] = b * b; }
                    u32x4 w; w.x = cvt_pk_bf16(v0[0], v0[1]); w.y = cvt_pk_bf16(v0[2], v0[3]); w.z = cvt_pk_bf16(v1[0], v1[1]); w.w = cvt_pk_bf16(v1[2], v1[3]);
                    *(u32x4*)(rowp + bj * HALF) = w; } } }
    }
};
struct EpiGLU {
    static constexpr bool PERM = true, AFTER_DRAIN = false;
    const float* ss; const float* shw; bf16_t* O;
    __device__ __forceinline__ void operator()(const f32x4 (&acc)[2][2][4][2], const Unit& u, int wr, int wc, int fr, int fq) const {
        const int col0 = u.pn * HALF + wc * 32 + 8 * fq;
#pragma unroll
        for (int ai = 0; ai < 2; ++ai) { const int rbase = u.pm * RM + half_row0(ai, wr) + fr;
            const float* sp = shw + cond_of_row(rbase) * 4096 + u.pn * BM + wc * 32 + 8 * fq;
            f32x4 sv[2][2];
#pragma unroll
            for (int bj = 0; bj < 2; ++bj) { sv[bj][0] = *(const f32x4*)(sp + bj * HALF); sv[bj][1] = *(const f32x4*)(sp + bj * HALF + 4); }
            float rr[4];
            EPI_MLOOP(ai, m) rr[m] = ss[rbase + m * 16];
            EPI_MLOOP(ai, m) { bf16_t* rowp = O + (size_t)(rbase + m * 16) * 1024 + col0;
                const float r = __builtin_amdgcn_rsqf(rr[m] * (1.f / 1024.f) + 1e-6f);
                f32x4 v0 = acc[ai][0][m][0] * r + sv[0][0], v1 = acc[ai][0][m][1] * r + sv[0][1]; const f32x4 g0 = acc[ai][1][m][0] * r + sv[1][0], g1 = acc[ai][1][m][1] * r + sv[1][1];
#pragma unroll
                for (int e = 0; e < 4; ++e) { v0[e] = v0[e] * __builtin_amdgcn_rcpf(1.f + __expf(-g0[e])); v1[e] = v1[e] * __builtin_amdgcn_rcpf(1.f + __expf(-g1[e])); }
                u32x4 w; w.x = cvt_pk_bf16(v0[0], v0[1]); w.y = cvt_pk_bf16(v0[2], v0[3]); w.z = cvt_pk_bf16(v1[0], v1[1]); w.w = cvt_pk_bf16(v1[2], v1[3]);
                *(u32x4*)rowp = w; } }
    }
};
struct EpiRes {
    static constexpr bool PERM = true, AFTER_DRAIN = false;
    const float* base_p; const float* base_s; const bf16_t* base_b; bf16_t* out; const float* gate;
    bf16_t* xb; const float* g_next; const float* sc_next; float* ss_next;
    __device__ __forceinline__ void operator()(const f32x4 (&acc)[2][2][4][2], const Unit& u, int wr, int wc, int fr, int fq) const {
        const int col0 = u.pn * BM + wc * 32 + 8 * fq;
        const int lane_x = fq * 16 + fr;
#pragma unroll
        for (int ai = 0; ai < 2; ++ai) { const int row0 = u.pm * RM + half_row0(ai, wr) + fr; const int cond = cond_of_row(row0);
            const float* gp = gate + cond * 6144 + col0;
            const float* bp = (row0 < 8192) ? base_p + (size_t)row0 * 1024 + col0 : base_s + (size_t)(row0 - 8192) * 1024 + col0;
            const bf16_t* bb = base_b + (size_t)row0 * 1024 + col0;
            bf16_t* op = out + (size_t)row0 * 1024 + col0;
            f32x4 gv[2][2], gs[2][2];
#pragma unroll
            for (int bj = 0; bj < 2; ++bj)
#pragma unroll
                for (int n = 0; n < 2; ++n) gv[bj][n] = *(const f32x4*)(gp + bj * HALF + n * 4);
            if (xb) { f32x4 ga[2][2], sa[2][2];
#pragma unroll
                for (int bj = 0; bj < 2; ++bj)
#pragma unroll
                    for (int n = 0; n < 2; ++n) { ga[bj][n] = *(const f32x4*)(g_next + col0 + bj * HALF + n * 4); sa[bj][n] = *(const f32x4*)(sc_next + cond * 6144 + col0 + bj * HALF + n * 4); }
#pragma unroll
                for (int bj = 0; bj < 2; ++bj)
#pragma unroll
                    for (int n = 0; n < 2; ++n) gs[bj][n] = ga[bj][n] * (1.f + sa[bj][n]); }
#pragma unroll
            for (int mp = 0; mp < 2; ++mp) if (ai == 0 || mp == 0) { f32x4 bs[2][2][2];
                if (base_b) {
#pragma unroll
                    for (int mm = 0; mm < 2; ++mm)
#pragma unroll
                        for (int bj = 0; bj < 2; ++bj) { const u32x4 w = *(const u32x4*)(bb + (size_t)((2 * mp + mm) * 16) * 1024 + bj * HALF);
                            bs[mm][bj][0] = (f32x4){__builtin_bit_cast(float, w.x << 16), __builtin_bit_cast(float, w.x & 0xffff0000u), __builtin_bit_cast(float, w.y << 16), __builtin_bit_cast(float, w.y & 0xffff0000u)};
                            bs[mm][bj][1] = (f32x4){__builtin_bit_cast(float, w.z << 16), __builtin_bit_cast(float, w.z & 0xffff0000u), __builtin_bit_cast(float, w.w << 16), __builtin_bit_cast(float, w.w & 0xffff0000u)}; }
                } else {
#pragma unroll
                    for (int mm = 0; mm < 2; ++mm)
#pragma unroll
                        for (int bj = 0; bj < 2; ++bj)
#pragma unroll
                            for (int n = 0; n < 2; ++n) bs[mm][bj][n] = *(const f32x4*)(bp + (size_t)((2 * mp + mm) * 16) * 1024 + bj * HALF + n * 4);
                }
#pragma unroll
                for (int mm = 0; mm < 2; ++mm) { float sq = 0.f;
#pragma unroll
                    for (int bj = 0; bj < 2; ++bj) { const f32x4 x0 = bs[mm][bj][0] + gv[bj][0] * acc[ai][bj][2 * mp + mm][0], x1 = bs[mm][bj][1] + gv[bj][1] * acc[ai][bj][2 * mp + mm][1];
                        { u32x4 w; w.x = cvt_pk_bf16(x0[0], x0[1]); w.y = cvt_pk_bf16(x0[2], x0[3]); w.z = cvt_pk_bf16(x1[0], x1[1]); w.w = cvt_pk_bf16(x1[2], x1[3]); *(u32x4*)(op + (size_t)((2 * mp + mm) * 16) * 1024 + bj * HALF) = w; }
                        if (xb) { const f32x4 h0 = x0 * gs[bj][0], h1 = x1 * gs[bj][1]; u32x4 w; w.x = cvt_pk_bf16(h0[0], h0[1]); w.y = cvt_pk_bf16(h0[2], h0[3]); w.z = cvt_pk_bf16(h1[0], h1[1]); w.w = cvt_pk_bf16(h1[2], h1[3]);
                            *(u32x4*)(xb + (size_t)(row0 + (2 * mp + mm) * 16) * 1024 + col0 + bj * HALF) = w;
                            sq += ((x0[0] * x0[0] + x0[1] * x0[1]) + (x0[2] * x0[2] + x0[3] * x0[3])) + ((x1[0] * x1[0] + x1[1] * x1[1]) + (x1[2] * x1[2] + x1[3] * x1[3])); } }
                    if (xb) {
                        sq += __builtin_bit_cast(float, __builtin_amdgcn_ds_bpermute((lane_x ^ 16) << 2, __builtin_bit_cast(int, sq)));
                        sq += __builtin_bit_cast(float, __builtin_amdgcn_ds_bpermute((lane_x ^ 32) << 2, __builtin_bit_cast(int, sq)));
                        if (fq == 0) atomicAdd(ss_next + row0 + (2 * mp + mm) * 16, sq); } }
                asm volatile("" ::: "memory"); } }
    }
};

struct StaticOrder256 {
    int nM, nN, nwg, G, c;
    __host__ __device__ void init(int M, int N, int G_, int c_) { nM = M / BM; nN = N / BM; nwg = nM * nN; G = G_; c = c_; }
    __host__ __device__ bool next(int i, Unit& u) const {
        const long L = (long)i * G + c; if (L >= nwg) return false;
        int wgid = (int)L; { const int q = nwg / NXCD, r = nwg % NXCD, xcd = wgid % NXCD, off = wgid / NXCD; wgid = (xcd < r ? xcd * (q + 1) : r * (q + 1) + (xcd - r) * q) + off; }
        const int nig = WGM * nN, gid = wgid / nig, fm = gid * WGM, gsz = (nM - fm) < WGM ? (nM - fm) : WGM;
        u.pm = fm + ((wgid % nig) % gsz); u.pn = (wgid % nig) / gsz; return true;
    }
    __device__ __forceinline__ void a_ready(const Unit&) const {}
    __device__ __forceinline__ void done(const Unit&) const {}
};
struct EpiUp256 {
    static constexpr bool PERM = true, AFTER_DRAIN = false;
    const float* ss; const float* shw; bf16_t* O; int ldc;
    __device__ __forceinline__ void operator()(const f32x4 (&acc)[2][2][4][2], const Unit& u, int wr, int wc, int fr, int fq) const {
        const int col0 = u.pn * BM + wc * 32 + 8 * fq;
        f32x4 sv[2][2][2]; float rr[2][4];
#pragma unroll
        for (int ai = 0; ai < 2; ++ai) { const int rbase = u.pm * BM + ai * HALF + wr * 64 + fr; const float* sp = shw + cond_of_row(rbase) * 4096 + col0;
#pragma unroll
            for (int bj = 0; bj < 2; ++bj) { sv[ai][bj][0] = *(const f32x4*)(sp + bj * HALF); sv[ai][bj][1] = *(const f32x4*)(sp + bj * HALF + 4); }
#pragma unroll
            for (int m = 0; m < 4; ++m) rr[ai][m] = ss[rbase + m * 16]; }
        __builtin_amdgcn_sched_barrier(0);
#pragma unroll
        for (int ai = 0; ai < 2; ++ai) { const int rbase = u.pm * BM + ai * HALF + wr * 64 + fr;
#pragma unroll
            for (int m = 0; m < 4; ++m) { bf16_t* rowp = O + (size_t)(rbase + m * 16) * ldc + col0;
                const float r = __builtin_amdgcn_rsqf(rr[ai][m] * (1.f / 1024.f) + 1e-6f);
#pragma unroll
                for (int bj = 0; bj < 2; ++bj) { f32x4 v0 = acc[ai][bj][m][0] * r + sv[ai][bj][0], v1 = acc[ai][bj][m][1] * r + sv[ai][bj][1];
#pragma unroll
                    for (int e = 0; e < 4; ++e) { const float a = fmaxf(v0[e], 0.f), b = fmaxf(v1[e], 0.f); v0[e] = a * a; v1[e] = b * b; }
                    u32x4 w; w.x = cvt_pk_bf16(v0[0], v0[1]); w.y = cvt_pk_bf16(v0[2], v0[3]); w.z = cvt_pk_bf16(v1[0], v1[1]); w.w = cvt_pk_bf16(v1[2], v1[3]);
                    *(u32x4*)(rowp + bj * HALF) = w; } } }
    }
};
template <class Epi, class Sched, bool ALIGN_EPI = false, bool SP2 = false>
__device__ __forceinline__ void gemm_phase256(PG8_LAS unsigned char* lds, const Gemm g, const Sched& S, const Epi& E, const int tid) {
    const int wid = __builtin_amdgcn_readfirstlane(tid >> 6), lane = tid & 63, wr = wid >> 2, wc = wid & 3, fr = lane & 15, fq = lane >> 4;
    const int K = g.K, nt = K / BK;
    unsigned voffA[2], voffB[2];
#pragma unroll
    for (int i = 0; i < 2; ++i) { int R, C; stage_rc(tid * 16 + i * 8192, R, C); const int Rb = Epi::PERM ? ((R & ~31) + perm32(R & 31)) : R;
        voffA[i] = (unsigned)(R * K + C) * 2u; voffB[i] = (unsigned)(Rb * K + C) * 2u; }
    const size_t kstep = (size_t)(BK * 2);
    const size_t hstep = (size_t)HALF * K * 2;
    const size_t tstep = 2 * hstep;
    const unsigned ldsw = (unsigned)wid * 1024u;
    const int aoff = lds_byte(wr * 64 + fr, fq * 8), boff = lds_byte(wc * 32 + fr, fq * 8);
#define PG8_SA(b, h) (((b) * 2 + (h)) * HTB)
#define PG8_SB(b, h) ((4 + (b) * 2 + (h)) * HTB)
#define PG8_STAGE(bufoff, gbase, voff) do { _Pragma("unroll") for (int _i = 0; _i < 2; ++_i) \
        __builtin_amdgcn_global_load_lds((const unsigned*)((const char*)(gbase) + (voff)[_i]), (PG8_LAS unsigned*)(lds + (bufoff) + ldsw + _i * 8192), 16, 0, 0); } while (0)
#define PG8_LDA(dst, b, h) do { _Pragma("unroll") for (int m = 0; m < 4; ++m) _Pragma("unroll") for (int k = 0; k < 2; ++k) dst[m][k] = *(const PG8_LAS bf16x8*)(lds + PG8_SA(b, h) + aoff + m * 2048 + k * 1024); } while (0)
#define PG8_LDB(dst, b, h) do { _Pragma("unroll") for (int n = 0; n < 2; ++n) _Pragma("unroll") for (int k = 0; k < 2; ++k) dst[n][k] = *(const PG8_LAS bf16x8*)(lds + PG8_SB(b, h) + boff + n * 2048 + k * 1024); } while (0)
#define PG8_MMA(ai, bj, At, Bt) do { __builtin_amdgcn_s_setprio(1); _Pragma("unroll") for (int m = 0; m < 4; ++m) _Pragma("unroll") for (int n = 0; n < 2; ++n) _Pragma("unroll") for (int k = 0; k < 2; ++k) \
        acc[ai][bj][m][n] = __builtin_amdgcn_mfma_f32_16x16x32_bf16(Bt[n][k], At[m][k], acc[ai][bj][m][n], 0, 0, 0); __builtin_amdgcn_s_setprio(0); } while (0)
#define PG8_WAIT_V(n) asm volatile("s_waitcnt vmcnt(" #n ")" ::: "memory")
#define PG8_WAIT_L(n) asm volatile("s_waitcnt lgkmcnt(" #n ")" ::: "memory")
#define PG8_BAR __builtin_amdgcn_s_barrier()
#define PG8_SCHED __builtin_amdgcn_sched_barrier(0)
    Unit cur, nxt; int ui = 0;
    if (!S.next(0, cur)) return;
    f32x4 acc[2][2][4][2];
#pragma unroll
    for (int a = 0; a < 2; ++a)
#pragma unroll
        for (int b = 0; b < 2; ++b)
#pragma unroll
            for (int m = 0; m < 4; ++m)
#pragma unroll
                for (int n = 0; n < 2; ++n) acc[a][b][m][n] = (f32x4){0.f, 0.f, 0.f, 0.f};
    bf16x8 At[4][2], B0[2][2], B1[2][2];
    const char* cA = (const char*)g.A + (size_t)cur.pm * tstep; const char* cB = (const char*)g.Bt + (size_t)cur.pn * tstep;
    S.a_ready(cur);
    if constexpr (SP2) {
        PG8_STAGE(PG8_SB(0, 0), cB, voffB); PG8_STAGE(PG8_SB(0, 1), cB + hstep, voffB); PG8_STAGE(PG8_SA(0, 0), cA, voffA); PG8_STAGE(PG8_SA(0, 1), cA + hstep, voffA);
        if (wr == 1) PG8_BAR;
        PG8_WAIT_V(2); PG8_BAR;
        PG8_STAGE(PG8_SB(1, 0), cB + kstep, voffB); PG8_STAGE(PG8_SA(1, 0), cA + kstep, voffA); PG8_STAGE(PG8_SB(1, 1), cB + hstep + kstep, voffB);
        PG8_WAIT_V(6); PG8_BAR;
    } else {
        PG8_STAGE(PG8_SB(0, 0), cB, voffB); PG8_STAGE(PG8_SA(0, 0), cA, voffA); PG8_STAGE(PG8_SB(0, 1), cB + hstep, voffB); PG8_STAGE(PG8_SA(0, 1), cA + hstep, voffA);
        if (wr == 1) PG8_BAR;
        PG8_WAIT_V(4); PG8_BAR;
        PG8_STAGE(PG8_SB(1, 0), cB + kstep, voffB); PG8_STAGE(PG8_SA(1, 0), cA + kstep, voffA); PG8_STAGE(PG8_SB(1, 1), cB + hstep + kstep, voffB);
        PG8_WAIT_V(6); PG8_BAR;
    }
    for (;;) {
        const bool has_next = S.next(ui + 1, nxt);
        const char* nA = has_next ? (const char*)g.A + (size_t)nxt.pm * tstep : cA; const char* nB = has_next ? (const char*)g.Bt + (size_t)nxt.pn * tstep : cB;
        for (int t = 0; t < nt; t += 2) {
            const bool last = (t == nt - 2);
            const char* a1 = cA + (size_t)(t + 1) * kstep;
            const char* a2 = last ? nA : cA + (size_t)(t + 2) * kstep; const char* b2 = last ? nB : cB + (size_t)(t + 2) * kstep;
            const char* a3 = a2 + kstep; const char* b3 = b2 + kstep;
            if (last && has_next) S.a_ready(nxt);
            if constexpr (SP2) {
            PG8_LDB(B0, 0, 0); PG8_LDB(B1, 0, 1); PG8_SCHED; PG8_LDA(At, 0, 0); PG8_STAGE(PG8_SA(1, 1), a1 + hstep, voffA);
            PG8_WAIT_V(8); PG8_WAIT_L(0); PG8_BAR; PG8_MMA(0, 0, At, B0); PG8_MMA(0, 1, At, B1); PG8_BAR; PG8_SCHED;
            PG8_LDA(At, 0, 1); PG8_STAGE(PG8_SB(0, 0), b2, voffB); PG8_STAGE(PG8_SB(0, 1), b2 + hstep, voffB); PG8_STAGE(PG8_SA(0, 0), a2, voffA);
            PG8_WAIT_V(8); PG8_WAIT_L(0); PG8_BAR; PG8_MMA(1, 0, At, B0); PG8_MMA(1, 1, At, B1); PG8_BAR; PG8_SCHED;
            PG8_LDB(B0, 1, 0); PG8_LDB(B1, 1, 1); PG8_SCHED; PG8_LDA(At, 1, 0); PG8_STAGE(PG8_SA(0, 1), a2 + hstep, voffA);
            PG8_WAIT_V(8); PG8_WAIT_L(0); PG8_BAR; PG8_MMA(0, 0, At, B0); PG8_MMA(0, 1, At, B1); PG8_BAR; PG8_SCHED;
            PG8_LDA(At, 1, 1); PG8_STAGE(PG8_SB(1, 0), b3, voffB); PG8_STAGE(PG8_SB(1, 1), b3 + hstep, voffB); PG8_STAGE(PG8_SA(1, 0), a3, voffA);
            PG8_WAIT_V(8); PG8_WAIT_L(0); PG8_BAR; PG8_MMA(1, 0, At, B0); PG8_MMA(1, 1, At, B1); PG8_BAR; PG8_SCHED;
            } else {
            PG8_LDB(B0, 0, 0); PG8_SCHED; PG8_LDA(At, 0, 0); PG8_STAGE(PG8_SA(1, 1), a1 + hstep, voffA);
            PG8_WAIT_L(8); PG8_BAR; PG8_WAIT_L(0); PG8_MMA(0, 0, At, B0); PG8_BAR; PG8_SCHED;
            PG8_LDB(B1, 0, 1); PG8_STAGE(PG8_SB(0, 0), b2, voffB);
            PG8_BAR; PG8_WAIT_L(0); PG8_MMA(0, 1, At, B1); PG8_BAR;
            PG8_LDA(At, 0, 1); PG8_STAGE(PG8_SA(0, 0), a2, voffA);
            PG8_BAR; PG8_WAIT_L(0); PG8_MMA(1, 0, At, B0); PG8_BAR; PG8_SCHED;
            PG8_STAGE(PG8_SB(0, 1), b2 + hstep, voffB);
            PG8_WAIT_V(6); PG8_BAR; PG8_MMA(1, 1, At, B1); PG8_BAR;
            PG8_LDB(B0, 1, 0); PG8_SCHED; PG8_LDA(At, 1, 0); PG8_STAGE(PG8_SA(0, 1), a2 + hstep, voffA);
            PG8_WAIT_L(8); PG8_BAR; PG8_WAIT_L(0); PG8_MMA(0, 0, At, B0); PG8_BAR; PG8_SCHED;
            PG8_LDB(B1, 1, 1); PG8_STAGE(PG8_SB(1, 0), b3, voffB);
            PG8_BAR; PG8_WAIT_L(0); PG8_MMA(0, 1, At, B1); PG8_BAR;
            PG8_LDA(At, 1, 1); PG8_STAGE(PG8_SA(1, 0), a3, voffA);
            PG8_BAR; PG8_WAIT_L(0); PG8_MMA(1, 0, At, B0); PG8_BAR; PG8_SCHED;
            PG8_STAGE(PG8_SB(1, 1), b3 + hstep, voffB);
            PG8_WAIT_V(6); PG8_BAR; PG8_MMA(1, 1, At, B1); PG8_BAR;
            }
        }
        if constexpr (ALIGN_EPI) { if (wr == 0) PG8_BAR; }
        if constexpr (!Epi::AFTER_DRAIN) { E(acc, cur, wr, wc, fr, fq); S.done(cur); }
        if (!has_next) break;
#pragma unroll
        for (int a = 0; a < 2; ++a)
#pragma unroll
            for (int b = 0; b < 2; ++b)
#pragma unroll
                for (int m = 0; m < 4; ++m)
#pragma unroll
                    for (int n = 0; n < 2; ++n) acc[a][b][m][n] = (f32x4){0.f, 0.f, 0.f, 0.f};
        cur = nxt; cA = nA; cB = nB; ++ui;
        if constexpr (ALIGN_EPI) { if (wr == 1) PG8_BAR; }
    }
    PG8_WAIT_V(0);
    if constexpr (!ALIGN_EPI) { if (wr == 0) PG8_BAR; }
    PG8_BAR;
    if constexpr (Epi::AFTER_DRAIN) { E.fused(acc, cur, wr, wc, fr, fq, lds, wid, lane); S.done(cur); }
#undef PG8_SA
#undef PG8_SB
#undef PG8_STAGE
#undef PG8_LDA
#undef PG8_LDB
#undef PG8_MMA
#undef PG8_WAIT_V
#undef PG8_WAIT_L
#undef PG8_BAR
#undef PG8_SCHED
}
template <class Epi, class Sched, bool ALIGN_EPI = false, bool SP2 = false>
__device__ __forceinline__ void gemm_phase(PG8_LAS unsigned char* lds, const Gemm g, const Sched& S, const Epi& E, const int tid) {
    static_assert(SP2, "the 192-row tile form exists for the SP2 loop only");
    const int wid = __builtin_amdgcn_readfirstlane(tid >> 6), lane = tid & 63, wr = wid >> 2, wc = wid & 3, fr = lane & 15, fq = lane >> 4;
    const int K = g.K, nt = K / BK;
    unsigned voffA[2], voffB[2];
#pragma unroll
    for (int i = 0; i < 2; ++i) { int R, C; stage_rc(tid * 16 + i * 8192, R, C); const int Rb = Epi::PERM ? ((R & ~31) + perm32(R & 31)) : R;
        voffA[i] = (unsigned)(R * K + C) * 2u; voffB[i] = (unsigned)(Rb * K + C) * 2u; }
    const size_t kstep = (size_t)(BK * 2);
    const size_t hstep = (size_t)HALF * K * 2;
    const size_t tstepA = (size_t)RM * K * 2;
    const size_t tstep = 2 * hstep;
    const unsigned ldsw = (unsigned)wid * 1024u;
    const int aoff = lds_byte(wr * 64 + fr, fq * 8), boff = lds_byte(wc * 32 + fr, fq * 8);
#define PG8_SA(b, h) (((b) * 2 + (h)) * HTB)
#define PG8_SB(b, h) ((4 + (b) * 2 + (h)) * HTB)
#define PG8_STAGE(bufoff, gbase, voff) do { _Pragma("unroll") for (int _i = 0; _i < 2; ++_i) \
        __builtin_amdgcn_global_load_lds((const unsigned*)((const char*)(gbase) + (voff)[_i]), (PG8_LAS unsigned*)(lds + (bufoff) + ldsw + _i * 8192), 16, 0, 0); } while (0)
#define PG8_LDA(dst, b, h) do { _Pragma("unroll") for (int m = 0; m < 4; ++m) _Pragma("unroll") for (int k = 0; k < 2; ++k) dst[m][k] = *(const PG8_LAS bf16x8*)(lds + PG8_SA(b, h) + aoff + m * 2048 + k * 1024); } while (0)
#define PG8_LDB(dst, b, h) do { _Pragma("unroll") for (int n = 0; n < 2; ++n) _Pragma("unroll") for (int k = 0; k < 2; ++k) dst[n][k] = *(const PG8_LAS bf16x8*)(lds + PG8_SB(b, h) + boff + n * 2048 + k * 1024); } while (0)
#define PG8_MMA(ai, bj, At, Bt) do { __builtin_amdgcn_s_setprio(1); _Pragma("unroll") for (int m = 0; m < 4; ++m) _Pragma("unroll") for (int n = 0; n < 2; ++n) _Pragma("unroll") for (int k = 0; k < 2; ++k) \
        acc[ai][bj][m][n] = __builtin_amdgcn_mfma_f32_16x16x32_bf16(Bt[n][k], At[m][k], acc[ai][bj][m][n], 0, 0, 0); __builtin_amdgcn_s_setprio(0); } while (0)
    const int aoff1 = lds_byte(wr * 32 + fr, fq * 8);
#define PG8_STAGE1(bufoff, gbase, voff) __builtin_amdgcn_global_load_lds((const unsigned*)((const char*)(gbase) + (voff)[0]), (PG8_LAS unsigned*)(lds + (bufoff) + ldsw), 16, 0, 0)
#define PG8_LDA1(dst, b) do { _Pragma("unroll") for (int m = 0; m < 2; ++m) _Pragma("unroll") for (int k = 0; k < 2; ++k) dst[m][k] = *(const PG8_LAS bf16x8*)(lds + PG8_SA(b, 1) + aoff1 + m * 2048 + k * 1024); } while (0)
#define PG8_MMA1(bj, At, Bt) do { __builtin_amdgcn_s_setprio(1); _Pragma("unroll") for (int m = 0; m < 2; ++m) _Pragma("unroll") for (int n = 0; n < 2; ++n) _Pragma("unroll") for (int k = 0; k < 2; ++k) \
        acc[1][bj][m][n] = __builtin_amdgcn_mfma_f32_16x16x32_bf16(Bt[n][k], At[m][k], acc[1][bj][m][n], 0, 0, 0); __builtin_amdgcn_s_setprio(0); } while (0)
#define PG8_WAIT_V(n) asm volatile("s_waitcnt vmcnt(" #n ")" ::: "memory")
#define PG8_WAIT_L(n) asm volatile("s_waitcnt lgkmcnt(" #n ")" ::: "memory")
#define PG8_BAR __builtin_amdgcn_s_barrier()
#define PG8_SCHED __builtin_amdgcn_sched_barrier(0)
    Unit cur, nxt; int ui = 0;
    if (!S.next(0, cur)) return;
    f32x4 acc[2][2][4][2];
#pragma unroll
    for (int a = 0; a < 2; ++a)
#pragma unroll
        for (int b = 0; b < 2; ++b)
#pragma unroll
            for (int m = 0; m < 4; ++m)
#pragma unroll
                for (int n = 0; n < 2; ++n) acc[a][b][m][n] = (f32x4){0.f, 0.f, 0.f, 0.f};
    bf16x8 At[4][2], B0[2][2], B1[2][2];
    const char* cA = (const char*)g.A + (size_t)cur.pm * tstepA; const char* cB = (const char*)g.Bt + (size_t)cur.pn * tstep;
    S.a_ready(cur);
    if constexpr (SP2) {
        PG8_STAGE(PG8_SB(0, 0), cB, voffB); PG8_STAGE(PG8_SB(0, 1), cB + hstep, voffB); PG8_STAGE(PG8_SA(0, 0), cA, voffA); PG8_STAGE1(PG8_SA(0, 1), cA + hstep, voffA);
        if (wr == 1) PG8_BAR;
        PG8_WAIT_V(1); PG8_BAR;
        PG8_STAGE(PG8_SB(1, 0), cB + kstep, voffB); PG8_STAGE(PG8_SA(1, 0), cA + kstep, voffA); PG8_STAGE(PG8_SB(1, 1), cB + hstep + kstep, voffB);
        PG8_WAIT_V(6); PG8_BAR;
    } else {
        PG8_STAGE(PG8_SB(0, 0), cB, voffB); PG8_STAGE(PG8_SA(0, 0), cA, voffA); PG8_STAGE(PG8_SB(0, 1), cB + hstep, voffB); PG8_STAGE(PG8_SA(0, 1), cA + hstep, voffA);
        if (wr == 1) PG8_BAR;
        PG8_WAIT_V(4); PG8_BAR;
        PG8_STAGE(PG8_SB(1, 0), cB + kstep, voffB); PG8_STAGE(PG8_SA(1, 0), cA + kstep, voffA); PG8_STAGE(PG8_SB(1, 1), cB + hstep + kstep, voffB);
        PG8_WAIT_V(6); PG8_BAR;
    }
    for (;;) {
        const bool has_next = S.next(ui + 1, nxt);
        const char* nA = has_next ? (const char*)g.A + (size_t)nxt.pm * tstepA : cA; const char* nB = has_next ? (const char*)g.Bt + (size_t)nxt.pn * tstep : cB;
        for (int t = 0; t < nt; t += 2) {
            const bool last = (t == nt - 2);
            const char* a1 = cA + (size_t)(t + 1) * kstep;
            const char* a2 = last ? nA : cA + (size_t)(t + 2) * kstep; const char* b2 = last ? nB : cB + (size_t)(t + 2) * kstep;
            const char* a3 = a2 + kstep; const char* b3 = b2 + kstep;
            if (last && has_next) S.a_ready(nxt);
            if constexpr (SP2) {
            PG8_LDB(B0, 0, 0); PG8_LDB(B1, 0, 1); PG8_SCHED; PG8_LDA(At, 0, 0); PG8_STAGE1(PG8_SA(1, 1), a1 + hstep, voffA);
            PG8_WAIT_V(7); PG8_WAIT_L(0); PG8_BAR; PG8_MMA(0, 0, At, B0); PG8_MMA(0, 1, At, B1); PG8_BAR; PG8_SCHED;
            PG8_LDA1(At, 0); PG8_STAGE(PG8_SB(0, 0), b2, voffB); PG8_STAGE(PG8_SB(0, 1), b2 + hstep, voffB); PG8_STAGE(PG8_SA(0, 0), a2, voffA);
            PG8_WAIT_V(7); PG8_WAIT_L(0); PG8_BAR; PG8_MMA1(0, At, B0); PG8_MMA1(1, At, B1); PG8_BAR; PG8_SCHED;
            PG8_LDB(B0, 1, 0); PG8_LDB(B1, 1, 1); PG8_SCHED; PG8_LDA(At, 1, 0); PG8_STAGE1(PG8_SA(0, 1), a2 + hstep, voffA);
            PG8_WAIT_V(7); PG8_WAIT_L(0); PG8_BAR; PG8_MMA(0, 0, At, B0); PG8_MMA(0, 1, At, B1); PG8_BAR; PG8_SCHED;
            PG8_LDA1(At, 1); PG8_STAGE(PG8_SB(1, 0), b3, voffB); PG8_STAGE(PG8_SB(1, 1), b3 + hstep, voffB); PG8_STAGE(PG8_SA(1, 0), a3, voffA);
            PG8_WAIT_V(7); PG8_WAIT_L(0); PG8_BAR; PG8_MMA1(0, At, B0); PG8_MMA1(1, At, B1); PG8_BAR; PG8_SCHED;
            } else {
            PG8_LDB(B0, 0, 0); PG8_SCHED; PG8_LDA(At, 0, 0); PG8_STAGE(PG8_SA(1, 1), a1 + hstep, voffA);
            PG8_WAIT_L(8); PG8_BAR; PG8_WAIT_L(0); PG8_MMA(0, 0, At, B0); PG8_BAR; PG8_SCHED;
            PG8_LDB(B1, 0, 1); PG8_STAGE(PG8_SB(0, 0), b2, voffB);
            PG8_BAR; PG8_WAIT_L(0); PG8_MMA(0, 1, At, B1); PG8_BAR;
            PG8_LDA(At, 0, 1); PG8_STAGE(PG8_SA(0, 0), a2, voffA);
            PG8_BAR; PG8_WAIT_L(0); PG8_MMA(1, 0, At, B0); PG8_BAR; PG8_SCHED;
            PG8_STAGE(PG8_SB(0, 1), b2 + hstep, voffB);
            PG8_WAIT_V(6); PG8_BAR; PG8_MMA(1, 1, At, B1); PG8_BAR;
            PG8_LDB(B0, 1, 0); PG8_SCHED; PG8_LDA(At, 1, 0); PG8_STAGE(PG8_SA(0, 1), a2 + hstep, voffA);
            PG8_WAIT_L(8); PG8_BAR; PG8_WAIT_L(0); PG8_MMA(0, 0, At, B0); PG8_BAR; PG8_SCHED;
            PG8_LDB(B1, 1, 1); PG8_STAGE(PG8_SB(1, 0), b3, voffB);
            PG8_BAR; PG8_WAIT_L(0); PG8_MMA(0, 1, At, B1); PG8_BAR;
            PG8_LDA(At, 1, 1); PG8_STAGE(PG8_SA(1, 0), a3, voffA);
            PG8_BAR; PG8_WAIT_L(0); PG8_MMA(1, 0, At, B0); PG8_BAR; PG8_SCHED;
            PG8_STAGE(PG8_SB(1, 1), b3 + hstep, voffB);
            PG8_WAIT_V(6); PG8_BAR; PG8_MMA(1, 1, At, B1); PG8_BAR;
            }
        }
        if constexpr (ALIGN_EPI) { if (wr == 0) PG8_BAR; }
        if constexpr (!Epi::AFTER_DRAIN) { E(acc, cur, wr, wc, fr, fq); S.done(cur); }
        if (!has_next) break;
#pragma unroll
        for (int a = 0; a < 2; ++a)
#pragma unroll
            for (int b = 0; b < 2; ++b)
#pragma unroll
                for (int m = 0; m < 4; ++m)
#pragma unroll
                    for (int n = 0; n < 2; ++n) acc[a][b][m][n] = (f32x4){0.f, 0.f, 0.f, 0.f};
        cur = nxt; cA = nA; cB = nB; ++ui;
        if constexpr (ALIGN_EPI) { if (wr == 1) PG8_BAR; }
    }
    PG8_WAIT_V(0);
    if constexpr (!ALIGN_EPI) { if (wr == 0) PG8_BAR; }
    PG8_BAR;
    if constexpr (Epi::AFTER_DRAIN) { E.fused(acc, cur, wr, wc, fr, fq, lds, wid, lane); S.done(cur); }
#undef PG8_SA
#undef PG8_SB
#undef PG8_STAGE
#undef PG8_LDA
#undef PG8_LDB
#undef PG8_MMA
#undef PG8_STAGE1
#undef PG8_LDA1
#undef PG8_MMA1
#undef PG8_WAIT_V
#undef PG8_WAIT_L
#undef PG8_BAR
#undef PG8_SCHED
}
}
constexpr int D = 1024, MP = 8192, MS = 4096, M = MP + MS, FF = 4096, NL = 4;
constexpr int NWAVES = 8, NTHR = 512;
constexpr size_t MiB = 1u << 20;
constexpr size_t WS_MOD = 1 * MiB;
constexpr size_t WS_W = 2 * MiB;
constexpr size_t WS_X = 94 * MiB;
constexpr size_t WS_H = 142 * MiB;
constexpr size_t WS_R = 166 * MiB;
constexpr size_t WS_CK = 262 * MiB, WS_CV = 266 * MiB, WS_SHW = 270 * MiB, WS_SS = 271 * MiB, WS_END = 272 * MiB;
constexpr size_t MEL = 1u << 20;
constexpr size_t W_QKV = 0, W_O = 6 * MEL, W_PW1 = 8 * MEL, W_PW2 = 12 * MEL, W_UP = 14 * MEL, W_DOWN = 30 * MEL;
constexpr int LDS_BYTES = 163840, LDS_ST = LDS_BYTES - 16, LDS_KC = 112640;

#define LAS __attribute__((address_space(3)))
#define SB0() __builtin_amdgcn_sched_barrier(0)
typedef unsigned short bf16;
typedef float f32x4 __attribute__((ext_vector_type(4)));
typedef float f32x2 __attribute__((ext_vector_type(2)));
typedef unsigned u32x4 __attribute__((ext_vector_type(4)));
typedef unsigned u32x2 __attribute__((ext_vector_type(2)));
typedef short bf16x8 __attribute__((ext_vector_type(8)));
typedef short s16x4 __attribute__((ext_vector_type(4)));
typedef float f32x32 __attribute__((ext_vector_type(32)));

__device__ __forceinline__ unsigned f2bf(float f) { unsigned u = __builtin_bit_cast(unsigned, f); return (u + 0x7fffu + ((u >> 16) & 1u)) >> 16; }
__device__ __forceinline__ unsigned pk2(float lo, float hi) { unsigned r; asm("v_cvt_pk_bf16_f32 %0, %1, %2" : "=v"(r) : "v"(lo), "v"(hi)); return r; }
__device__ __forceinline__ float bflo(unsigned w) { return __builtin_bit_cast(float, w << 16); }
__device__ __forceinline__ float bfhi(unsigned w) { return __builtin_bit_cast(float, w & 0xffff0000u); }
__device__ __forceinline__ float shx(float v, int k, int lane) { return __builtin_bit_cast(float, __builtin_amdgcn_ds_bpermute((lane ^ k) << 2, __builtin_bit_cast(int, v))); }
__device__ __forceinline__ float wave_sum(float v, int lane) {
#pragma unroll
    for (int o = 1; o < 64; o <<= 1) v += shx(v, o, lane);
    return v;
}

template <bool GLU>
__device__ __forceinline__ void transpose_item(const float* W, int K, int N, bf16* WT, LAS float* scr, int item, int lane) {
    const int nblk = N / 32, kb = item / nblk, nb = item % nblk, k0 = 64 * kb, n0 = 32 * nb;
    { float tv[32];
#pragma unroll
      for (int i = 0; i < 32; ++i) tv[i] = __builtin_nontemporal_load(W + (size_t)(k0 + 2 * i + (lane >> 5)) * N + n0 + (lane & 31));
      __builtin_amdgcn_sched_barrier(0);
#pragma unroll
      for (int i = 0; i < 32; ++i) scr[(2 * i + (lane >> 5)) * 33 + (((lane & 31) + 4 * (i >> 4)) & 31)] = tv[i]; }
    asm volatile("s_waitcnt lgkmcnt(0)" ::: "memory");
    int d0 = n0;
    if (GLU) { const int nn = n0 & 1023; d0 = ((nn >> 7) << 8) + (nn & 127) + ((n0 >> 10) << 7); }
    const int c = lane & 7;
#pragma unroll
    for (int j = 0; j < 4; ++j) { const int n = (lane >> 3) + 8 * j; const LAS float* s = scr + (8 * c) * 33 + ((n + 4 * (c >> 2)) & 31);
        u32x4 o; o.x = pk2(s[0 * 33], s[1 * 33]); o.y = pk2(s[2 * 33], s[3 * 33]); o.z = pk2(s[4 * 33], s[5 * 33]); o.w = pk2(s[6 * 33], s[7 * 33]);
        *(u32x4*)(WT + (size_t)(d0 + n) * K + k0 + 8 * c) = o; }
    asm volatile("s_waitcnt lgkmcnt(0)" ::: "memory");
}

struct Ptrs {
    const float *x_prompt, *x_sample, *cache_k, *cache_v, *c, *c_ctx, *norm_g, *w_ada, *b_ada, *w_qkv, *w_o, *rpb, *w_pw1, *w_dw, *b_dw, *ln_g, *ln_b, *w_pw2, *w_up, *w_down, *final_g;
};

__device__ __forceinline__ void p0_phase(const Ptrs& P, unsigned char* ws, LAS unsigned char* lds, int tid, int lane, int wave, int G, int bid) {
    bf16* Wt = (bf16*)(ws + WS_W);
    const int gw = bid * NWAVES + wave, NGW = G * NWAVES;
    LAS float* scr = (LAS float*)(lds + wave * 16384);
    constexpr int NIT = 23552;
    for (int it = gw; it < NIT; it += NGW) {
        if (it < 7168) { const int i = it / 3584; int r = it % 3584;
            if (r < 1536) { transpose_item<false>(P.w_qkv + (size_t)i * D * 3 * D, D, 3 * D, Wt + W_QKV + (size_t)i * 3 * MEL, scr, r, lane); continue; } r -= 1536;
            if (r < 512) { transpose_item<false>(P.w_o + (size_t)i * D * D, D, D, Wt + W_O + (size_t)i * MEL, scr, r, lane); continue; } r -= 512;
            if (r < 1024) { transpose_item<true>(P.w_pw1 + (size_t)i * D * 2 * D, D, 2 * D, Wt + W_PW1 + (size_t)i * 2 * MEL, scr, r, lane); continue; } r -= 1024;
            transpose_item<false>(P.w_pw2 + (size_t)i * D * D, D, D, Wt + W_PW2 + (size_t)i * MEL, scr, r, lane);
        } else { const int l = (it - 7168) / 4096; int r = (it - 7168) % 4096;
            if (r < 2048) transpose_item<false>(P.w_up + (size_t)l * D * FF, D, FF, Wt + W_UP + (size_t)l * 4 * MEL, scr, r, lane);
            else transpose_item<false>(P.w_down + (size_t)l * D * FF, FF, D, Wt + W_DOWN + (size_t)l * 4 * MEL, scr, r - 2048, lane);
        }
    }
    { bf16* CK = (bf16*)(ws + WS_CK); bf16* CV = (bf16*)(ws + WS_CV);
      const int NT = G * NTHR; constexpr int NV = 2 * 4 * 2 * 256 * 1024 / 4;
      for (int v = bid * NTHR + tid; v < NV; v += NT) { const int which = v >= NV / 2; const int e = (which ? v - NV / 2 : v) * 4;
          const f32x4 a = __builtin_nontemporal_load((const f32x4*)((which ? P.cache_v : P.cache_k) + e));
          u32x2 o; o.x = pk2(a[0], a[1]); o.y = pk2(a[2], a[3]);
          *(u32x2*)((which ? CV : CK) + e) = o; } }
    { f32x4* z = (f32x4*)(ws + WS_SS); const int NT = G * NTHR; float zf = 0.f; asm volatile("" : "+v"(zf));
      const f32x4 zz = (f32x4){zf, zf, zf, zf}; for (int v = bid * NTHR + tid; v < 9 * M / 4; v += NT) z[v] = zz; }
    __syncthreads();
    { LAS float* sil = (LAS float*)lds; LAS float* red = (LAS float*)(lds + 20480); float* mod = (float*)(ws + WS_MOD);
      for (int k = tid; k < 5 * 1024; k += NTHR) { const int cc = k >> 10, kk = k & 1023; const float v = cc == 0 ? P.c_ctx[kk] : P.c[(cc - 1) * 1024 + kk]; sil[k] = v / (1.f + __expf(-v)); }
      __syncthreads();
      const int kg = tid >> 4, cl = tid & 15; const bool cact = cl < 12;
      for (int item = bid; item < 512; item += G) { const int l = item >> 7, n0 = (item & 127) * 48;
          const float* W = P.w_ada + (size_t)l * D * 6144 + n0 + 4 * cl;
          f32x4 a[5];
#pragma unroll
          for (int cc = 0; cc < 5; ++cc) a[cc] = (f32x4){0.f, 0.f, 0.f, 0.f};
#pragma unroll 4
          for (int kk = 0; kk < 32; ++kk) { const int k = kg * 32 + kk; f32x4 w = (f32x4){0.f, 0.f, 0.f, 0.f}; if (cact) w = __builtin_nontemporal_load((const f32x4*)(W + (size_t)k * 6144));
#pragma unroll
              for (int cc = 0; cc < 5; ++cc) a[cc] += sil[cc * 1024 + k] * w; }
#pragma unroll
          for (int cc = 0; cc < 5; ++cc) *(LAS f32x4*)(red + (kg * 5 + cc) * 64 + 4 * cl) = a[cc];
          __syncthreads();
          if (tid < 320 && (tid & 63) < 48) { const int cc = tid >> 6, n = tid & 63; float s = 0.f;
#pragma unroll 8
              for (int g = 0; g < 32; ++g) s += red[(g * 5 + cc) * 64 + n];
              mod[(size_t)(l * 5 + cc) * 6144 + n0 + n] = s + P.b_ada[l * 6144 + n0 + n]; }
          __syncthreads();
      } }
}

__device__ __forceinline__ void norm_phase(const float* xp, const float* xs, bf16* H, float* yout, const float* g, const float* shift, const float* scale, int gw, int NGW, int lane) {
    f32x4 gv[4];
#pragma unroll
    for (int j = 0; j < 4; ++j) gv[j] = *(const f32x4*)(g + 4 * (lane + 64 * j));
    for (int m = gw; m < M; m += NGW) {
        const float* xrow = m < MP ? xp + (size_t)m * D : xs + (size_t)(m - MP) * D;
        const int cond = m < MP ? 0 : 1 + ((m - MP) >> 10);
        f32x4 v[4]; float ss = 0.f;
#pragma unroll
        for (int j = 0; j < 4; ++j) { v[j] = *(const f32x4*)(xrow + 4 * (lane + 64 * j)); ss += (v[j][0] * v[j][0] + v[j][1] * v[j][1]) + (v[j][2] * v[j][2] + v[j][3] * v[j][3]); }
        const float r = 1.0f / sqrtf(wave_sum(ss, lane) * (1.f / D) + 1e-6f);
        if (yout) {
#pragma unroll
            for (int j = 0; j < 4; ++j) *(f32x4*)(yout + (size_t)m * D + 4 * (lane + 64 * j)) = v[j] * r * gv[j];
        } else {
#pragma unroll
            for (int j = 0; j < 4; ++j) { const f32x4 sc = *(const f32x4*)(scale + cond * 6144 + 4 * (lane + 64 * j)), sh = *(const f32x4*)(shift + cond * 6144 + 4 * (lane + 64 * j));
                const f32x4 h = (v[j] * r * gv[j]) * (1.f + sc) + sh; u32x2 o; o.x = pk2(h[0], h[1]); o.y = pk2(h[2], h[3]);
                *(u32x2*)(H + (size_t)m * D + 4 * (lane + 64 * j)) = o; }
        }
    }
}

template <class F, int... I> __device__ __forceinline__ void sfor_impl(F&& f, std::integer_sequence<int, I...>) { (f(std::integral_constant<int, I>{}), ...); }
template <int N, class F> __device__ __forceinline__ void sfor(F&& f) { sfor_impl(f, std::make_integer_sequence<int, N>{}); }
__device__ __forceinline__ float dpp_add(float v, int ctrl_b1, int ctrl_4e, int dummy) { return v; }
__device__ __forceinline__ float wave_sum_dpp(float v) {
    v += __builtin_bit_cast(float, __builtin_amdgcn_update_dpp(0, __builtin_bit_cast(int, v), 0xB1, 0xf, 0xf, false));
    v += __builtin_bit_cast(float, __builtin_amdgcn_update_dpp(0, __builtin_bit_cast(int, v), 0x4E, 0xf, 0xf, false));
    v += __builtin_bit_cast(float, __builtin_amdgcn_update_dpp(0, __builtin_bit_cast(int, v), 0x141, 0xf, 0xf, false));
    v += __builtin_bit_cast(float, __builtin_amdgcn_update_dpp(0, __builtin_bit_cast(int, v), 0x140, 0xf, 0xf, false));
    const int vi = __builtin_bit_cast(int, v);
    return (__builtin_bit_cast(float, __builtin_amdgcn_readlane(vi, 0)) + __builtin_bit_cast(float, __builtin_amdgcn_readlane(vi, 16))) +
           (__builtin_bit_cast(float, __builtin_amdgcn_readlane(vi, 32)) + __builtin_bit_cast(float, __builtin_amdgcn_readlane(vi, 48)));
}
constexpr int CT = 16, CROWS = CT + 30, CCS = 16, CCH = (CROWS + CCS - 1) / CCS;
__device__ __forceinline__ void conv_phase(const bf16* U, bf16* Vc, const float* wdw, const float* bdw, const float* lng, const float* lnb, LAS unsigned char* lds, int tid, int lane, int wave, int G, int bid) {
    f32x2 w[31];
    sfor<31>([&](auto K) __attribute__((always_inline)) { constexpr int k = decltype(K)::value; w[k] = *(const f32x2*)(wdw + k * D + 2 * tid); });
    const f32x2 bd = *(const f32x2*)(bdw + 2 * tid), lg = *(const f32x2*)(lng + 2 * tid), lb = *(const f32x2*)(lnb + 2 * tid);
    LAS f32x2* part = (LAS f32x2*)lds;
    LAS f32x2* stats = part + 8 * CT;
    for (int un_ = bid; un_ < M / CT; un_ += G) {
        const int unit = (G == 256) ? (un_ & 7) * (M / CT / 8) + ((un_ >> 3) & 31) + 32 * (un_ >> 8) : un_;
        const int m0 = unit * CT, seg = m0 < MP ? 0 : MP, L = m0 < MP ? 256 : 1024, t0 = (m0 - seg) & (L - 1);
        const bf16* Ub = U + (size_t)(m0 - t0) * D + 2 * tid;
        f32x2 acc[CT];
        sfor<CT>([&](auto O) __attribute__((always_inline)) { acc[decltype(O)::value] = bd; });
        sfor<CCH>([&](auto C) __attribute__((always_inline)) { constexpr int c = decltype(C)::value;
            unsigned raw[CCS];
            sfor<CCS>([&](auto I) __attribute__((always_inline)) { constexpr int i = decltype(I)::value, j = c * CCS + i;
                if constexpr (j < CROWS) { const int t = t0 - 15 + j, tc = min(max(t, 0), L - 1);
                    raw[i] = *(const unsigned*)(Ub + (size_t)tc * D); } });
            SB0();
            sfor<CCS>([&](auto I) __attribute__((always_inline)) { constexpr int i = decltype(I)::value, j = c * CCS + i;
                if constexpr (j < CROWS) { const int t = t0 - 15 + j; const unsigned rm = raw[i] & (unsigned)(-(int)((t >= 0) & (t < L))); const f32x2 u = (f32x2){bflo(rm), bfhi(rm)};
                    sfor<31>([&](auto K) __attribute__((always_inline)) { constexpr int k = decltype(K)::value, o = j - k;
                        if constexpr (o >= 0 && o < CT) acc[o] += u * w[k]; }); } });
        });
        sfor<CT>([&](auto O) __attribute__((always_inline)) { constexpr int o = decltype(O)::value;
            const float s = wave_sum_dpp(acc[o].x + acc[o].y), q = wave_sum_dpp(acc[o].x * acc[o].x + acc[o].y * acc[o].y); if (lane == 0) part[wave * CT + o] = (f32x2){s, q}; });
        __syncthreads();
        if (tid < CT) { float s = 0.f, q = 0.f;
#pragma unroll
            for (int wv = 0; wv < 8; ++wv) { const f32x2 p = part[wv * CT + tid]; s += p.x; q += p.y; }
            const float mean = s * (1.f / D), var = fmaxf(q * (1.f / D) - mean * mean, 0.f); stats[tid] = (f32x2){mean, 1.0f / sqrtf(var + 1e-5f)}; }
        __syncthreads();
        sfor<CT>([&](auto O) __attribute__((always_inline)) { constexpr int o = decltype(O)::value;
            const f32x2 st = stats[o]; f32x2 y = (acc[o] - st.x) * st.y * lg + lb;
            y.x = y.x * __builtin_amdgcn_rcpf(1.f + __expf(-y.x)); y.y = y.y * __builtin_amdgcn_rcpf(1.f + __expf(-y.y));
            *(unsigned*)(Vc + (size_t)(m0 + o) * D + 2 * tid) = pk2(y.x, y.y); });
        __syncthreads();
    }
}

__device__ __forceinline__ void final_norm_phase(const bf16* X, float* yout, const float* g, int gw, int NGW, int lane) {
    f32x4 gv[4];
#pragma unroll
    for (int j = 0; j < 4; ++j) gv[j] = *(const f32x4*)(g + 4 * (lane + 64 * j));
    for (int m = gw; m < M; m += NGW) {
        const bf16* xr = X + (size_t)m * D;
        f32x4 v[4]; float sq = 0.f;
#pragma unroll
        for (int j = 0; j < 4; ++j) { const u32x2 w = __builtin_nontemporal_load((const u32x2*)(xr + 4 * (lane + 64 * j))); v[j] = (f32x4){bflo(w.x), bfhi(w.x), bflo(w.y), bfhi(w.y)};
            sq += (v[j][0] * v[j][0] + v[j][1] * v[j][1]) + (v[j][2] * v[j][2] + v[j][3] * v[j][3]); }
        const float r = 1.0f / sqrtf(wave_sum_dpp(sq) * (1.f / D) + 1e-6f);
#pragma unroll
        for (int j = 0; j < 4; ++j) __builtin_nontemporal_store(v[j] * r * gv[j], (f32x4*)(yout + (size_t)m * D + 4 * (lane + 64 * j)));
    }
}

__device__ __forceinline__ void prep_phase(const float* xp, const float* xs, bf16* H, float* ss0, const float* g, const float* scale, const float* mod, const bf16* Wt, float* shw, int gw, int NGW, int lane) {
    { f32x4 gv[4];
#pragma unroll
      for (int j = 0; j < 4; ++j) gv[j] = *(const f32x4*)(g + 4 * (lane + 64 * j));
      for (int m = gw; m < M; m += NGW) {
          const float* xrow = m < MP ? xp + (size_t)m * D : xs + (size_t)(m - MP) * D;
          const int cond = m < MP ? 0 : 1 + ((m - MP) >> 10);
          f32x4 v[4]; float sq = 0.f;
#pragma unroll
          for (int j = 0; j < 4; ++j) { v[j] = *(const f32x4*)(xrow + 4 * (lane + 64 * j)); sq += (v[j][0] * v[j][0] + v[j][1] * v[j][1]) + (v[j][2] * v[j][2] + v[j][3] * v[j][3]); }
          sq = wave_sum_dpp(sq); if (lane == 0) ss0[m] = sq;
          f32x4 sc[4];
#pragma unroll
          for (int j = 0; j < 4; ++j) sc[j] = *(const f32x4*)(scale + cond * 6144 + 4 * (lane + 64 * j));
#pragma unroll
          for (int j = 0; j < 4; ++j) { const f32x4 h = v[j] * gv[j] * (1.f + sc[j]); u32x2 o; o.x = pk2(h[0], h[1]); o.y = pk2(h[2], h[3]);
              *(u32x2*)(H + (size_t)m * D + 4 * (lane + 64 * j)) = o; }
      } }
    for (int it = gw; it < 4 * 8192; it += NGW) {
        const int l = it >> 13, which = (it >> 12) & 1, n = it & 4095, i = l >> 1; const bool conv = (l & 1) != 0;
        const int N = which ? 4096 : (conv ? 2048 : 3072);
        if (n >= N) continue;
        const bf16* wrow = Wt + (which ? W_UP + (size_t)l * 4 * MEL : (conv ? W_PW1 + (size_t)i * 2 * MEL : W_QKV + (size_t)i * 3 * MEL)) + (size_t)n * D;
        float wv[16];
#pragma unroll
        for (int jj = 0; jj < 4; ++jj) { const u32x2 w = *(const u32x2*)(wrow + 4 * (lane + 64 * jj)); wv[4 * jj] = bflo(w.x); wv[4 * jj + 1] = bfhi(w.x); wv[4 * jj + 2] = bflo(w.y); wv[4 * jj + 3] = bfhi(w.y); }
#pragma unroll
        for (int cond = 0; cond < 5; ++cond) { const float* sh = mod + (size_t)(l * 5 + cond) * 6144 + (which ? 3 : 0) * 1024; float dot = 0.f;
#pragma unroll
            for (int jj = 0; jj < 4; ++jj) { const f32x4 s4 = *(const f32x4*)(sh + 4 * (lane + 64 * jj)); dot += (s4[0] * wv[4 * jj] + s4[1] * wv[4 * jj + 1]) + (s4[2] * wv[4 * jj + 2] + s4[3] * wv[4 * jj + 3]); }
            dot = wave_sum_dpp(dot); if (lane == 0) shw[(size_t)((l * 2 + which) * 5 + cond) * 4096 + n] = dot; }
    }
}

constexpr float SCL = 0.125f * 1.4426950408889634f, LOG2E = 1.4426950408889634f;
__device__ __forceinline__ void vt_write(LAS bf16* Vt, int pitch, int slot, int chunk, u32x4 v) {
    LAS bf16* p = Vt + (8 * chunk) * pitch + (slot ^ (chunk << 2));
    p[0] = (bf16)(v.x & 0xffffu); p[pitch] = (bf16)(v.x >> 16); p[2 * pitch] = (bf16)(v.y & 0xffffu); p[3 * pitch] = (bf16)(v.y >> 16);
    p[4 * pitch] = (bf16)(v.z & 0xffffu); p[5 * pitch] = (bf16)(v.z >> 16); p[6 * pitch] = (bf16)(v.w & 0xffffu); p[7 * pitch] = (bf16)(v.w >> 16);
}
template <int NB> __device__ __forceinline__ void softmax_part(f32x4 (&s)[NB], float& mx_out, float& sum_out, int lane, float m_floor = -INFINITY) {
    float mx = m_floor;
#pragma unroll
    for (int b = 0; b < NB; ++b) mx = fmaxf(mx, fmaxf(fmaxf(s[b][0], s[b][1]), fmaxf(s[b][2], s[b][3])));
    mx = fmaxf(mx, shx(mx, 16, lane)); mx = fmaxf(mx, shx(mx, 32, lane));
    float sum = 0.f;
#pragma unroll
    for (int b = 0; b < NB; ++b) {
#pragma unroll
        for (int e = 0; e < 4; ++e) { s[b][e] = __builtin_amdgcn_exp2f(s[b][e] - mx); sum += s[b][e]; } }
    sum += shx(sum, 16, lane); sum += shx(sum, 32, lane);
    mx_out = mx; sum_out = sum;
}
__device__ __forceinline__ bf16x8 pack_p(const f32x4& a, const f32x4& b) {
    u32x4 w; w.x = pk2(a[0], a[1]); w.y = pk2(a[2], a[3]); w.z = pk2(b[0], b[1]); w.w = pk2(b[2], b[3]); return __builtin_bit_cast(bf16x8, w);
}
__device__ __forceinline__ bf16x8 vt_read(const LAS bf16* p0, const LAS bf16* p1) {
    const s16x4 a = *(const LAS s16x4*)p0, b = *(const LAS s16x4*)p1; return (bf16x8){a[0], a[1], a[2], a[3], b[0], b[1], b[2], b[3]};
}
__device__ __forceinline__ f32x4 qk_block(const bf16* kp, const bf16x8& qf0, const bf16x8& qf1) {
    const bf16x8 k0 = *(const bf16x8*)kp, k1 = *(const bf16x8*)(kp + 32);
    f32x4 a = __builtin_amdgcn_mfma_f32_16x16x32_bf16(k0, qf0, (f32x4){0.f, 0.f, 0.f, 0.f}, 0, 0, 0);
    return __builtin_amdgcn_mfma_f32_16x16x32_bf16(k1, qf1, a, 0, 0, 0);
}
#define PV16(o, s, SLOT_EXPR, PITCH_) do { _Pragma("unroll") for (int pp = 0; pp < 8; ++pp) { const bf16x8 pf = pack_p(s[2 * pp], s[2 * pp + 1]); const int slot0 = (SLOT_EXPR); \
        _Pragma("unroll") for (int db = 0; db < 4; ++db) { const LAS bf16* vr = Vt + (16 * db + l15) * (PITCH_); const int sw_ = (2 * db + (l15 >> 3)) << 2; \
            o[db] = __builtin_amdgcn_mfma_f32_16x16x32_bf16(vt_read(vr + (slot0 ^ sw_), vr + ((slot0 + 16) ^ sw_)), pf, o[db], 0, 0, 0); } } } while (0)

#ifndef CBN
#define CBN 4
#endif
__device__ __forceinline__ void attn_phase(const bf16* Qb, const bf16* Kb, const bf16* Vb, bf16* Ob, const bf16* CK, const bf16* CV, const float* rpb  ,
                                           int li, LAS unsigned char* lds, int tid, int lane, int wave, int G, int bid, int ulo, int uhi) {
    LAS bf16* Vt = (LAS bf16*)lds; LAS float* rpl = (LAS float*)(lds + 110592); LAS unsigned char* Kc = lds + LDS_KC;
    for (int u = bid + ulo; u < uhi; u += G) {
        int lz_ = lane; asm volatile("" : "+v"(lz_));
        const int l15 = lz_ & 15, g = lz_ >> 4;
        if (u < 512) {
            const int b = u >> 4, h = u & 15; constexpr int PITCH = 264;
            const int qrow0 = b * 256 + 32 * wave + l15;
            const bf16x8 qa0 = *(const bf16x8*)(Qb + (size_t)qrow0 * D + h * 64 + 8 * g), qa1 = *(const bf16x8*)(Qb + (size_t)qrow0 * D + h * 64 + 32 + 8 * g);
            const bf16x8 qb0 = *(const bf16x8*)(Qb + (size_t)(qrow0 + 16) * D + h * 64 + 8 * g), qb1 = *(const bf16x8*)(Qb + (size_t)(qrow0 + 16) * D + h * 64 + 32 + 8 * g);
            SB0();
            { int t2 = tid; asm volatile("" : "+v"(t2));
              u32x4 v[4], kv[4];
#pragma unroll
              for (int it = 0; it < 4; ++it) { const int idx = t2 + NTHR * it, key = idx >> 3, chunk = idx & 7; const size_t off = (size_t)(b * 256 + key) * D + h * 64 + 8 * chunk;
                  v[it] = *(const u32x4*)(Vb + off); kv[it] = *(const u32x4*)(Kb + off); }
              SB0();
#pragma unroll
              for (int it = 0; it < 4; ++it) { const int idx = t2 + NTHR * it, key = idx >> 3, chunk = idx & 7;
                  *(LAS u32x4*)(Kc + key * 144 + chunk * 16) = kv[it];
                  vt_write(Vt, PITCH, key, chunk, v[it]); } }
            __syncthreads();
            SB0();
            f32x4 s0[16], s1[16];
            { const LAS unsigned char* kl = Kc + l15 * 144 + g * 16;
              sfor<16>([&](auto I) __attribute__((always_inline)) { constexpr int kb = decltype(I)::value;
                const bf16x8 k0 = *(const LAS bf16x8*)(kl + kb * (16 * 144)), k1 = *(const LAS bf16x8*)(kl + kb * (16 * 144) + 64);
                f32x4 a = __builtin_amdgcn_mfma_f32_16x16x32_bf16(k0, qa0, (f32x4){0.f, 0.f, 0.f, 0.f}, 0, 0, 0); s0[kb] = __builtin_amdgcn_mfma_f32_16x16x32_bf16(k1, qa1, a, 0, 0, 0) * SCL;
                f32x4 c = __builtin_amdgcn_mfma_f32_16x16x32_bf16(k0, qb0, (f32x4){0.f, 0.f, 0.f, 0.f}, 0, 0, 0); s1[kb] = __builtin_amdgcn_mfma_f32_16x16x32_bf16(k1, qb1, c, 0, 0, 0) * SCL; }); }
            { float mx, sum; softmax_part<16>(s0, mx, sum, lane);
              f32x4 o[4];
#pragma unroll
              for (int db = 0; db < 4; ++db) o[db] = (f32x4){0.f, 0.f, 0.f, 0.f};
              PV16(o, s0, 32 * pp + 4 * g, PITCH);
              const float rl = 1.0f / sum;
#pragma unroll
              for (int db = 0; db < 4; ++db) { const f32x4 ov = o[db] * rl; u32x2 w; w.x = pk2(ov[0], ov[1]); w.y = pk2(ov[2], ov[3]);
                  *(u32x2*)(Ob + (size_t)qrow0 * D + h * 64 + 16 * db + 4 * g) = w; } }
            { float mx, sum; softmax_part<16>(s1, mx, sum, lane);
              f32x4 o[4];
#pragma unroll
              for (int db = 0; db < 4; ++db) o[db] = (f32x4){0.f, 0.f, 0.f, 0.f};
              PV16(o, s1, 32 * pp + 4 * g, PITCH);
              const float rl = 1.0f / sum;
#pragma unroll
              for (int db = 0; db < 4; ++db) { const f32x4 ov = o[db] * rl; u32x2 w; w.x = pk2(ov[0], ov[1]); w.y = pk2(ov[2], ov[3]);
                  *(u32x2*)(Ob + (size_t)(qrow0 + 16) * D + h * 64 + 16 * db + 4 * g) = w; } }
            __syncthreads();
        } else {
            const int ui = u - 512, xcd = ui & 7, idx = (ui >> 3) & 63, uu = (G == 256) ? ((xcd * 8 + (idx >> 3)) << 3) + (idx & 7) : ui;
            const int b = uu >> 7, h = (uu >> 3) & 15, rp = uu & 7, r0 = 2 * rp; constexpr int PITCH = 840;
            const int rs0 = min(max(r0 - 4, 0), 8);
            const size_t tokb = (size_t)MP + (size_t)b * 1024;
            const int r = r0 + (wave >> 2), j = wave & 3, rs = min(max(r - 4, 0), 8), rrel = rs - rs0, kcs = min(max(16 * j - 8, 0), 32);
            const int qcol = 16 * j + l15, wst = min(max(qcol - 8, 0), 48);
            const size_t qtok = tokb + r * 64 + qcol;
            const bf16* kloc = Kb + (tokb + rs * 64 + kcs + l15) * D + h * 64 + 8 * g;
            bf16x8 kf[16][2];
#define LOAD_KLOC(H) sfor<8>([&](auto I) __attribute__((always_inline)) { constexpr int lb = 8 * (H) + decltype(I)::value; const bf16* kp = kloc + (size_t)((lb >> 1) * 64 + 16 * (lb & 1)) * D; kf[lb][0] = *(const bf16x8*)kp; kf[lb][1] = *(const bf16x8*)(kp + 32); })
            LOAD_KLOC(0);
            const bf16x8 qf0 = *(const bf16x8*)(Qb + qtok * D + h * 64 + 8 * g), qf1 = *(const bf16x8*)(Qb + qtok * D + h * 64 + 32 + 8 * g);
            SB0();
            { int t2 = tid; asm volatile("" : "+v"(t2));
              u32x4 vv[13], kv[4];
#pragma unroll
              for (int it = 0; it < 13; ++it) { const int idx = t2 + NTHR * it, slot = idx >> 3, chunk = idx & 7;
                  const bf16* src = (slot < 576) ? Vb + (tokb + min(rs0 + (slot >> 6), 15) * 64 + (slot & 63)) * D + h * 64 : CV + ((size_t)(b * 2 + li) * 256 + (slot - 576)) * D + h * 64;
                  vv[it] = *(const u32x4*)(src + 8 * chunk); }
#pragma unroll
              for (int it = 0; it < 4; ++it) { const int idx = t2 + NTHR * it, key = idx >> 3, chunk = idx & 7;
                  kv[it] = *(const u32x4*)(CK + ((size_t)(b * 2 + li) * 256 + key) * D + h * 64 + 8 * chunk); }
              const float rv = rpb[h * 465 + min(t2, 464)];
              SB0();
#pragma unroll
              for (int it = 0; it < 13; ++it) { const int idx = t2 + NTHR * it; vt_write(Vt, PITCH, idx >> 3, idx & 7, vv[it]); }
#pragma unroll
              for (int it = 0; it < 4; ++it) { const int idx = t2 + NTHR * it; *(LAS u32x4*)(Kc + (idx >> 3) * 144 + (idx & 7) * 16) = kv[it]; }
              if (t2 < 465) rpl[t2] = rv; }
            SB0(); LOAD_KLOC(1); SB0();
            __syncthreads();
            SB0();
            f32x4 o1[4]; float m1, l1, m2, l2;
#pragma unroll
            for (int db = 0; db < 4; ++db) o1[db] = (f32x4){0.f, 0.f, 0.f, 0.f};
            {
                int dcv[8]; unsigned vmask = 0u;
#pragma unroll
                for (int ce = 0; ce < 8; ++ce) { const int kc = kcs + 16 * (ce >> 2) + 4 * g + (ce & 3); vmask |= ((kc >= wst) && (kc < wst + 16)) ? (1u << ce) : 0u; dcv[ce] = min(max(kc - qcol + 15, 0), 30); }
                f32x4 s[16];
#define QK_LOC(H) sfor<8>([&](auto I) __attribute__((always_inline)) { constexpr int lb = 8 * (H) + decltype(I)::value, krow = lb >> 1, ch = lb & 1; \
                    f32x4 a = __builtin_amdgcn_mfma_f32_16x16x32_bf16(kf[lb][0], qf0, (f32x4){0.f, 0.f, 0.f, 0.f}, 0, 0, 0); a = __builtin_amdgcn_mfma_f32_16x16x32_bf16(kf[lb][1], qf1, a, 0, 0, 0); \
                    const LAS float* rp_row = rpl + (rs + krow - r + 7) * 31; float bias[4]; \
                    _Pragma("unroll") for (int e = 0; e < 4; ++e) bias[e] = rp_row[dcv[ch * 4 + e]]; \
                    _Pragma("unroll") for (int e = 0; e < 4; ++e) { const float t = a[e] * SCL + bias[e] * LOG2E; a[e] = ((vmask >> (ch * 4 + e)) & 1u) ? t : -INFINITY; } \
                    s[lb] = a; })
                QK_LOC(0); QK_LOC(1); SB0();
                softmax_part<16>(s, m1, l1, lane);
                PV16(o1, s, (rrel + pp) * 64 + kcs + 4 * g, PITCH);
            }
            SB0();
            {
                f32x4 s[16];
                { const LAS unsigned char* kl = Kc + l15 * 144 + g * 16;
                  sfor<16>([&](auto I) __attribute__((always_inline)) { constexpr int cb = decltype(I)::value;
                    const bf16x8 k0 = *(const LAS bf16x8*)(kl + cb * (16 * 144)), k1 = *(const LAS bf16x8*)(kl + cb * (16 * 144) + 64);
                    f32x4 a = __builtin_amdgcn_mfma_f32_16x16x32_bf16(k0, qf0, (f32x4){0.f, 0.f, 0.f, 0.f}, 0, 0, 0); s[cb] = __builtin_amdgcn_mfma_f32_16x16x32_bf16(k1, qf1, a, 0, 0, 0) * SCL; }); }
                softmax_part<16>(s, m2, l2, lane, m1);
                const float a1 = __builtin_amdgcn_exp2f(m1 - m2);
#pragma unroll
                for (int db = 0; db < 4; ++db) o1[db] = o1[db] * a1;
                l1 = l1 * a1 + l2;
                PV16(o1, s, 576 + 32 * pp + 4 * g, PITCH);
            }
            const float rl = 1.0f / l1;
            int r2_ = r; asm volatile("" : "+s"(r2_));
            const size_t qtok2 = tokb + r2_ * 64 + qcol;
#pragma unroll
            for (int db = 0; db < 4; ++db) { const f32x4 ov = o1[db] * rl; u32x2 w; w.x = pk2(ov[0], ov[1]); w.y = pk2(ov[2], ov[3]);
                *(u32x2*)(Ob + qtok2 * D + h * 64 + 16 * db + 4 * g) = w; }
            __syncthreads();
        }
    }
}

#define RLX_AGENT __ATOMIC_RELAXED, __HIP_MEMORY_SCOPE_AGENT
#define XB_TMO      128
#define XB_XCNT(j)  (256  + 64 * (j))
#define XB_XSUB(j)  (1280 + 64 * (j))
#define XB_XGEN(j)  (2304 + 64 * (j))
#define XB_TOP      3328
#define XB_TOPGEN   3392
#define XCD_BAR_WORDS 3456
#define XB_SPIN_CAP (1u << 18)

__device__ __forceinline__ unsigned xb_ld(unsigned* p)              { return __hip_atomic_load(p, __ATOMIC_RELAXED, __HIP_MEMORY_SCOPE_AGENT); }
__device__ __forceinline__ unsigned xb_add(unsigned* p, unsigned v) { return __hip_atomic_fetch_add(p, v, __ATOMIC_RELAXED, __HIP_MEMORY_SCOPE_AGENT); }
__device__ __forceinline__ unsigned xb_xcc_id() { return (unsigned)__builtin_amdgcn_s_getreg((3 << 11) | 20) & 0xFu; }
#define XB_SPIN(cond, bar) do { unsigned _sp = 0; while (cond) { __builtin_amdgcn_s_sleep(1); \
    if ((++_sp & 255u) == 0u) { if (xb_ld(&(bar)[XB_TMO])) break; if (_sp > XB_SPIN_CAP) { atomicAdd(&(bar)[XB_TMO], 1u); break; } } } } while (0)

struct XcdBarrier {
    unsigned* bar; unsigned x;
    volatile LAS unsigned* st;
};

__device__ __forceinline__ XcdBarrier xcd_barrier_post(unsigned* bar, volatile LAS unsigned* st) {
    XcdBarrier b; b.bar = bar; b.x = xb_xcc_id(); b.st = st;
    if (threadIdx.x == 0) (void)xb_add(&bar[XB_XCNT(b.x)], 1u);
    return b;
}
__device__ __forceinline__ void xcd_barrier_complete(unsigned* bar, unsigned x, unsigned& nloc, unsigned& nx) {
    const unsigned G = gridDim.x * gridDim.y * gridDim.z;
    unsigned sum, cnt, mine, sp = 0u;
    for (;;) {
        sum = 0u; cnt = 0u; mine = 0u;
#pragma unroll
        for (unsigned j = 0; j < 16; ++j) { const unsigned c = xb_ld(&bar[XB_XCNT(j)]); sum += c; cnt += (c > 0u) ? 1u : 0u; mine = (j == x) ? c : mine; }
        if (sum == G) break;
        __builtin_amdgcn_s_sleep(1);
        if ((++sp & 255u) == 0u) { if (xb_ld(&bar[XB_TMO])) break; if (sp > XB_SPIN_CAP) { atomicAdd(&bar[XB_TMO], 1u); break; } }
    }
    nloc = mine > 0u ? mine : 1u; nx = cnt > 0u ? cnt : 1u;
}

__device__ __forceinline__ void xcd_barrier(const XcdBarrier& b) {
    asm volatile("s_waitcnt vmcnt(0)" ::: "memory");
    __syncthreads();
    if (threadIdx.x == 0) {
        unsigned* bar = b.bar;
        __builtin_amdgcn_s_waitcnt(0);
        unsigned nloc = b.st[0], nx = b.st[1];
        if (nloc == 0u) { xcd_barrier_complete(bar, b.x, nloc, nx); b.st[0] = nloc; b.st[1] = nx; }
        const unsigned old = xb_add(&bar[XB_XSUB(b.x)], 1u);
        const unsigned gen = old / nloc;
        if (old + 1u == (gen + 1u) * nloc) {
            __builtin_amdgcn_fence(__ATOMIC_RELEASE, "agent");
            asm volatile("s_waitcnt vmcnt(0)" ::: "memory");
            const unsigned og = xb_add(&bar[XB_TOP], 1u);
            if (og + 1u == (gen + 1u) * nx) xb_add(&bar[XB_TOPGEN], 1u);
            else XB_SPIN(xb_ld(&bar[XB_TOPGEN]) == gen, bar);
            __builtin_amdgcn_fence(__ATOMIC_ACQUIRE, "agent");
            asm volatile("s_waitcnt vmcnt(0)" ::: "memory");
        } else {
            XB_SPIN(xb_ld(&bar[XB_TOPGEN]) == gen, bar);
            __builtin_amdgcn_fence(__ATOMIC_ACQUIRE, "agent");
            asm volatile("s_waitcnt vmcnt(0)" ::: "memory");
        }
    }
    __syncthreads();
}

constexpr int NPH = 2 + 5 * NL + 1;
struct Args { const float* in[21]; float* out; unsigned char* ws; int nprog, pad; int prog[48]; };
typedef const __attribute__((address_space(4))) Args* KArgPtr;
__global__ void __launch_bounds__(NTHR, 2) fwd_kernel(Args a_unused) {
    extern __shared__ __attribute__((aligned(16))) unsigned char lds_raw[];
    LAS unsigned char* lds = (LAS unsigned char*)lds_raw;
    cg::grid_group grid = cg::this_grid();
    const int wave0 = __builtin_amdgcn_readfirstlane((int)threadIdx.x >> 6);
    { volatile LAS unsigned* st0 = (volatile LAS unsigned*)(lds + LDS_ST); if (threadIdx.x < 2) st0[threadIdx.x] = 0u; }
    __syncthreads();
    XcdBarrier xbar; { KArgPtr kpb = (KArgPtr)__builtin_amdgcn_kernarg_segment_ptr(); xbar.bar = (unsigned*)kpb->ws; xbar.x = 0; xbar.st = (volatile LAS unsigned*)(lds + LDS_ST);
        if (blockIdx.x == 0) { for (int wI = threadIdx.x; wI < XCD_BAR_WORDS; wI += NTHR) __hip_atomic_store(xbar.bar + wI, 0u, __ATOMIC_RELAXED, __HIP_MEMORY_SCOPE_AGENT); } }
    int nprog; { KArgPtr kp0 = (KArgPtr)__builtin_amdgcn_kernarg_segment_ptr(); nprog = kp0->nprog; }
    for (int pc = 0; pc < nprog; ++pc) {
        KArgPtr kp = (KArgPtr)__builtin_amdgcn_kernarg_segment_ptr(); asm volatile("" : "+s"(kp));
        int z_ = 0; asm volatile("" : "+s"(z_));
        const int lane_ = (int)__builtin_amdgcn_mbcnt_hi(~0u, __builtin_amdgcn_mbcnt_lo(~0u, (unsigned)z_)); const int tid_ = wave0 * 64 + lane_;
        int bid_ = (int)__builtin_amdgcn_workgroup_id_x(), G_ = (int)gridDim.x; asm volatile("" : "+s"(bid_), "+s"(G_));
        const int pe_ = kp->prog[pc]; const int ph = pe_ & 63, amode = pe_ >> 6;
        const int tid = tid_, lane = lane_, wave = wave0, G = G_, bid = bid_;
        const int gw = bid * NWAVES + wave, NGW = G * NWAVES;
        Ptrs P; P = Ptrs{kp->in[0], kp->in[1], kp->in[2], kp->in[3], kp->in[4], kp->in[5], kp->in[6], kp->in[7], kp->in[8], kp->in[9], kp->in[10], kp->in[11], kp->in[12], kp->in[13], kp->in[14], kp->in[15], kp->in[16], kp->in[17], kp->in[18], kp->in[19], kp->in[20]};
        unsigned char* ws = kp->ws; float* outp = kp->out;
        float* mod = (float*)(ws + WS_MOD); bf16* Wt = (bf16*)(ws + WS_W); bf16* X = (bf16*)(ws + WS_X); bf16* H = (bf16*)(ws + WS_H);
        bf16* R = (bf16*)(ws + WS_R); bf16* Qb = R; bf16* Kb = R + (size_t)M * D; bf16* Vb = R + (size_t)2 * M * D; bf16* Ob = R + (size_t)3 * M * D;
        bf16* Ub = R; bf16* Vc = R + (size_t)M * D; bf16* Fb = R;
        const bf16* CK = (const bf16*)(ws + WS_CK); const bf16* CV = (const bf16*)(ws + WS_CV);
        float* out_y = outp; float* out_ck = outp + (size_t)M * D; float* out_cv = out_ck + (size_t)32 * 2 * 256 * 1024;
        float* SS = (float*)(ws + WS_SS); float* SHW = (float*)(ws + WS_SHW);
        if (ph == 0) { p0_phase(P, ws, lds, tid, lane, wave, G, bid); }
        else if (ph == 1) { prep_phase(P.x_prompt, P.x_sample, H, SS, P.norm_g, mod + 1 * 1024, mod, Wt, SHW, gw, NGW, lane); }
        else if (ph == NPH - 1) { final_norm_phase(X, out_y, P.final_g, gw, NGW, lane); }
        else if (ph >= 60) { }
        else {
            const int l = (ph - 2) / 5, s = (ph - 2) % 5, i = l >> 1; const bool conv = (l & 1) != 0;
            const float* modl = mod + (size_t)l * 5 * 6144;
            if (s == 0) {
                const float* ssl = SS + (size_t)(2 * l) * M; const float* shl = SHW + (size_t)((2 * l) * 5) * 4096;
                if (!conv) { pg8::Gemm gm{H, Wt + W_QKV + (size_t)i * 3 * MEL, M, 3 * D, D}; pg8::StaticOrder S; S.init(M, 3 * D, G, bid);
                    pg8::EpiQKV E{ssl, shl, Qb, (size_t)M * D, out_ck + (size_t)i * 256 * 1024, (size_t)32 * 2 * 256 * 1024};
                    pg8::gemm_phase<pg8::EpiQKV, pg8::StaticOrder, true, true>(lds, gm, S, E, tid); }
                else { pg8::Gemm gm{H, Wt + W_PW1 + (size_t)i * 2 * MEL, M, 2 * D, D}; pg8::StaticOrder S; S.init(M, 2 * D, G, bid);
                    pg8::EpiGLU E{ssl, shl, Ub};
                    pg8::gemm_phase<pg8::EpiGLU, pg8::StaticOrder, true, true>(lds, gm, S, E, tid); }
            } else if (s == 1) {
                if (!conv) attn_phase(Qb, Kb, Vb, Ob, CK, CV, P.rpb + (size_t)i * 16 * 15 * 31, i, lds, tid, lane, wave, G, bid, amode == 2 ? 512 : 0, amode == 1 ? 512 : 1024);
                else conv_phase(Ub, Vc, P.w_dw + (size_t)i * 31 * D, P.b_dw + i * D, P.ln_g + i * D, P.ln_b + i * D, lds, tid, lane, wave, G, bid);
            } else if (s == 2 || s == 4) {
                pg8::Gemm gm; pg8::EpiRes E;
                if (s == 2) { gm = pg8::Gemm{conv ? Vc : Ob, Wt + (conv ? W_PW2 : W_O) + (size_t)i * MEL, M, D, D};
                    E = pg8::EpiRes{P.x_prompt, P.x_sample, l == 0 ? (const bf16*)nullptr : X, X, modl + 2 * 1024, H, P.norm_g + (l * 2 + 1) * D, modl + 4 * 1024, SS + (size_t)(2 * l + 1) * M}; }
                else { gm = pg8::Gemm{Fb, Wt + W_DOWN + (size_t)l * 4 * MEL, M, D, FF};
                    E = pg8::EpiRes{P.x_prompt, P.x_sample, X, X, modl + 5 * 1024, l < NL - 1 ? H : nullptr, P.norm_g + ((l + 1) * 2) * D, modl + 5 * 6144 + 1 * 1024, SS + (size_t)(2 * l + 2) * M}; }
                pg8::StaticOrder S; S.init(M, D, G, bid);
                pg8::gemm_phase<pg8::EpiRes, pg8::StaticOrder, true, true>(lds, gm, S, E, tid);
            } else {
#ifdef UP256
                pg8::Gemm gm{H, Wt + W_UP + (size_t)l * 4 * MEL, M, FF, D}; pg8::StaticOrder256 S; S.init(M, FF, G, bid);
                pg8::EpiUp256 E{SS + (size_t)(2 * l + 1) * M, SHW + (size_t)((2 * l + 1) * 5) * 4096, Fb, FF};
                pg8::gemm_phase256<pg8::EpiUp256, pg8::StaticOrder256, true, true>(lds, gm, S, E, tid);
#else
                pg8::Gemm gm{H, Wt + W_UP + (size_t)l * 4 * MEL, M, FF, D}; pg8::StaticOrder S; S.init(M, FF, G, bid);
                pg8::EpiUp E{SS + (size_t)(2 * l + 1) * M, SHW + (size_t)((2 * l + 1) * 5) * 4096, Fb, FF};
                pg8::gemm_phase<pg8::EpiUp, pg8::StaticOrder, true, true>(lds, gm, S, E, tid);
#endif
            }
        }
        if (pc + 1 < nprog) { if (pc == 0) { grid.sync(); xbar = xcd_barrier_post(xbar.bar, xbar.st); } else xcd_barrier(xbar); }
    }
}

#ifndef SINGLE_LAUNCH
#define SINGLE_LAUNCH 0
#endif
extern "C" void kernel_launch(void* const* d_in, const int* in_sizes, int n_in, void* d_out, int out_size, void* d_ws, size_t ws_size, hipStream_t stream) {
    static int grid = 0;
    if (grid == 0) {
        if (n_in != 21 || ws_size < WS_END) { fprintf(stderr, "kernel_launch: unexpected n_in %d / ws_size %zu\n", n_in, ws_size); grid = -1; return; }
        int dev = 0, cus = 0, per_cu = 0;
        hipGetDevice(&dev); hipDeviceGetAttribute(&cus, hipDeviceAttributeMultiprocessorCount, dev);
        hipFuncSetAttribute((const void*)fwd_kernel, hipFuncAttributeMaxDynamicSharedMemorySize, LDS_BYTES);
        hipOccupancyMaxActiveBlocksPerMultiprocessor(&per_cu, (const void*)fwd_kernel, NTHR, LDS_BYTES);
        if (per_cu < 1) { fprintf(stderr, "kernel_launch: occupancy query says %d blocks/CU\n", per_cu); per_cu = 1; }
        (void)hipGetLastError();
        grid = cus * per_cu;
    }
    if (grid < 0) return;
    Args a{};
    for (int i = 0; i < 21; ++i) a.in[i] = (const float*)d_in[i];
    a.out = (float*)d_out; a.ws = (unsigned char*)d_ws;
#if SINGLE_LAUNCH
    { int n = 0;
      for (int ph = 0; ph < NPH; ++ph) { a.prog[n++] = ph;
#ifdef PROBE_ATTN_MODE
          if (ph >= 2 && ph < NPH - 1 && (ph - 2) % 5 == 1 && ((ph - 2) / 5) % 2 == 0) a.prog[n++] = ph | (PROBE_ATTN_MODE << 6);
#endif
#ifdef PROBE_EMPTY
          if (ph == 5) for (int q = 0; q < PROBE_EMPTY; ++q) a.prog[n++] = 60;
#endif
#ifdef PROBE_REPEAT_P0
          if (ph == 0) a.prog[n++] = 0;
#endif
#ifdef PROBE_REPEAT_S
          if (ph >= 2 && ph < NPH - 1 && (ph - 2) % 5 == PROBE_REPEAT_S && (PROBE_REPEAT_PAR < 0 || ((ph - 2) / 5) % 2 == PROBE_REPEAT_PAR)) a.prog[n++] = ph;
#endif
      }
      a.nprog = n; }
    void* args[] = {&a};
    hipError_t e = hipLaunchCooperativeKernel((const void*)fwd_kernel, dim3(grid), dim3(NTHR), args, LDS_BYTES, stream);
    if (e != hipSuccess) fprintf(stderr, "cooperative launch failed: %s (grid %d)\n", hipGetErrorString(e), grid);
#else
    for (int ph = 0; ph < NPH; ++ph) { a.nprog = 1; a.prog[0] = ph; hipLaunchKernelGGL(fwd_kernel, dim3(grid), dim3(NTHR), LDS_BYTES, stream, a); }
#endif
}
```

```cpp
#define SINGLE_LAUNCH 1
#define UP256 1
#include <hip/hip_runtime.h>
#include <hip/hip_cooperative_groups.h>
#include <cstdio>
#include <cstdint>
#include <cmath>
#include <utility>
namespace cg = cooperative_groups;
namespace pg8 {
#define PG8_LAS __attribute__((address_space(3)))
typedef unsigned short bf16_t;
typedef short bf16x8 __attribute__((ext_vector_type(8)));
typedef float f32x4 __attribute__((ext_vector_type(4)));
typedef unsigned u32x4 __attribute__((ext_vector_type(4)));
constexpr int RM = 192;
constexpr int BM = 256, BK = 64, HALF = 128, HTB = HALF * BK * 2  , STAGE_BYTES = 8 * HTB, NXCD = 8, WGM = 8;

__host__ __device__ __forceinline__ int lds_byte(int r, int c) { const int st = (r >> 4) * 2 + (c >> 5), rr = r & 15, cc = c & 31, ob = rr * 64 + cc * 2; return st * 1024 + (ob ^ (((ob >> 9) & 1) << 5)); }
__host__ __device__ __forceinline__ void stage_rc(int b, int& R, int& C) { const int st = b / 1024, sb = b % 1024, swz = sb ^ (((sb >> 9) & 1) << 5); R = (st >> 1) * 16 + swz / 64; C = (st & 1) * 32 + (swz % 64) / 2; }
__host__ __device__ __forceinline__ int perm32(int rho) { const int n = rho >> 4, i = rho & 15; return 8 * (i >> 2) + 4 * n + (i & 3); }

struct Unit { int pm, pn; };
struct Gemm { const bf16_t* A; const bf16_t* Bt; int M, N, K; };

struct StaticOrder {
    int nM, nN, nwg, G, c;
    __host__ __device__ void init(int M, int N, int G_, int c_) { nM = M / RM; nN = N / BM; nwg = nM * nN; G = G_; c = c_; }
    __host__ __device__ bool next(int i, Unit& u) const {
        const long L = (long)i * G + c; if (L >= nwg) return false;
        int wgid = (int)L; { const int q = nwg / NXCD, r = nwg % NXCD, xcd = wgid % NXCD, off = wgid / NXCD; wgid = (xcd < r ? xcd * (q + 1) : r * (q + 1) + (xcd - r) * q) + off; }
        const int nig = WGM * nN, gid = wgid / nig, fm = gid * WGM, gsz = (nM - fm) < WGM ? (nM - fm) : WGM;
        u.pm = fm + ((wgid % nig) % gsz); u.pn = (wgid % nig) / gsz; return true;
    }
    __device__ __forceinline__ void a_ready(const Unit&) const {}
    __device__ __forceinline__ void done(const Unit&) const {}
};

__device__ __forceinline__ unsigned cvt_pk_bf16(float lo, float hi) { unsigned r; asm volatile("v_cvt_pk_bf16_f32 %0, %1, %2" : "=v"(r) : "v"(lo), "v"(hi)); return r; }
typedef float f32x2 __attribute__((ext_vector_type(2)));
__device__ __forceinline__ int cond_of_row(int r) { return r < 8192 ? 0 : 1 + ((r - 8192) >> 10); }
__device__ __forceinline__ int half_row0(int ai, int wr) { return ai == 0 ? wr * 64 : 128 + wr * 32; }
#define EPI_MLOOP(ai, m) _Pragma("unroll") for (int m = 0; m < 4; ++m) if (ai == 0 || m < 2)
struct EpiQKV {
    static constexpr bool PERM = true, AFTER_DRAIN = false;
    const float* ss; const float* shw;
    bf16_t* Q; size_t qkv_stride; float* ck; size_t ckv_stride;
    __device__ __forceinline__ void operator()(const f32x4 (&acc)[2][2][4][2], const Unit& u, int wr, int wc, int fr, int fq) const {
        const int t = u.pn >> 2;
        bf16_t* base = Q + (size_t)t * qkv_stride;
        const int col0 = (u.pn & 3) * BM + wc * 32 + 8 * fq;
        float* cbase = ck + (size_t)(t > 0 ? t - 1 : 0) * ckv_stride + col0;
#pragma unroll
        for (int ai = 0; ai < 2; ++ai) { const int rbase = u.pm * RM + half_row0(ai, wr) + fr; const bool wc_ = (t > 0) && (rbase < 8192);
            const float* sp = shw + cond_of_row(rbase) * 4096 + u.pn * BM + wc * 32 + 8 * fq;
            f32x4 sv[2][2];
#pragma unroll
            for (int bj = 0; bj < 2; ++bj) { sv[bj][0] = *(const f32x4*)(sp + bj * HALF); sv[bj][1] = *(const f32x4*)(sp + bj * HALF + 4); }
            float rr[4];
            EPI_MLOOP(ai, m) rr[m] = ss[rbase + m * 16];
            EPI_MLOOP(ai, m) { const int row = rbase + m * 16; bf16_t* rowp = base + (size_t)row * 1024 + col0;
                const float r = __builtin_amdgcn_rsqf(rr[m] * (1.f / 1024.f) + 1e-6f);
                float* cp0 = cbase + ((size_t)(row >> 8) * 2 * 256 + (row & 255)) * 1024;
#pragma unroll
                for (int bj = 0; bj < 2; ++bj) { const f32x4 v0 = acc[ai][bj][m][0] * r + sv[bj][0], v1 = acc[ai][bj][m][1] * r + sv[bj][1];
                    u32x4 w; w.x = cvt_pk_bf16(v0[0], v0[1]); w.y = cvt_pk_bf16(v0[2], v0[3]); w.z = cvt_pk_bf16(v1[0], v1[1]); w.w = cvt_pk_bf16(v1[2], v1[3]);
                    *(u32x4*)(rowp + bj * HALF) = w;
                    if (wc_) { float* cp = cp0 + bj * HALF; __builtin_nontemporal_store(v0, (f32x4*)cp); __builtin_nontemporal_store(v1, (f32x4*)(cp + 4)); } } } }
    }
};
struct EpiUp {
    static constexpr bool PERM = true, AFTER_DRAIN = false;
    const float* ss; const float* shw; bf16_t* O; int ldc;
    __device__ __forceinline__ void operator()(const f32x4 (&acc)[2][2][4][2], const Unit& u, int wr, int wc, int fr, int fq) const {
        const int col0 = u.pn * BM + wc * 32 + 8 * fq;
#pragma unroll
        for (int ai = 0; ai < 2; ++ai) { const int rbase = u.pm * RM + half_row0(ai, wr) + fr;
            const float* sp = shw + cond_of_row(rbase) * 4096 + col0;
            f32x4 sv[2][2];
#pragma unroll
            for (int bj = 0; bj < 2; ++bj) { sv[bj][0] = *(const f32x4*)(sp + bj * HALF); sv[bj][1] = *(const f32x4*)(sp + bj * HALF + 4); }
            float rr[4];
            EPI_MLOOP(ai, m) rr[m] = ss[rbase + m * 16];
            EPI_MLOOP(ai, m) { bf16_t* rowp = O + (size_t)(rbase + m * 16) * ldc + col0;
                const float r = __builtin_amdgcn_rsqf(rr[m] * (1.f / 1024.f) + 1e-6f);
#pragma unroll
                for (int bj = 0; bj < 2; ++bj) { f32x4 v0 = acc[ai][bj][m][0] * r + sv[bj][0], v1 = acc[ai][bj][m][1] * r + sv[bj][1];
#pragma unroll
                    for (int e = 0; e < 4; ++e) { const float a = fmaxf(v0[e], 0.f), b = fmaxf(v1[e], 0.f); v0[e] = a * a; v1[e] = b * b; }
                    u32x4 w; w.x = cvt_pk_bf16(v0[0], v0[1]); w.y = cvt_pk_bf16(v0[2], v0[3]); w.z = cvt_pk_bf16(v1[0], v1[1]); w.w = cvt_pk_bf16(v1[2], v1[3]);
                    *(u32x4*)(rowp + bj * HALF) = w; } } }
    }
};
struct EpiGLU {
    static constexpr bool PERM = true, AFTER_DRAIN = false;
    const float* ss; const float* shw; bf16_t* O;
    __device__ __forceinline__ void operator()(const f32x4 (&acc)[2][2][4][2], const Unit& u, int wr, int wc, int fr, int fq) const {
        const int col0 = u.pn * HALF + wc * 32 + 8 * fq;
#pragma unroll
        for (int ai = 0; ai < 2; ++ai) { const int rbase = u.pm * RM + half_row0(ai, wr) + fr;
            const float* sp = shw + cond_of_row(rbase) * 4096 + u.pn * BM + wc * 32 + 8 * fq;
            f32x4 sv[2][2];
#pragma unroll
            for (int bj = 0; bj < 2; ++bj) { sv[bj][0] = *(const f32x4*)(sp + bj * HALF); sv[bj][1] = *(const f32x4*)(sp + bj * HALF + 4); }
            float rr[4];
            EPI_MLOOP(ai, m) rr[m] = ss[rbase + m * 16];
            EPI_MLOOP(ai, m) { bf16_t* rowp = O + (size_t)(rbase + m * 16) * 1024 + col0;
                const float r = __builtin_amdgcn_rsqf(rr[m] * (1.f / 1024.f) + 1e-6f);
                f32x4 v0 = acc[ai][0][m][0] * r + sv[0][0], v1 = acc[ai][0][m][1] * r + sv[0][1]; const f32x4 g0 = acc[ai][1][m][0] * r + sv[1][0], g1 = acc[ai][1][m][1] * r + sv[1][1];
#pragma unroll
                for (int e = 0; e < 4; ++e) { v0[e] = v0[e] * __builtin_amdgcn_rcpf(1.f + __expf(-g0[e])); v1[e] = v1[e] * __builtin_amdgcn_rcpf(1.f + __expf(-g1[e])); }
                u32x4 w; w.x = cvt_pk_bf16(v0[0], v0[1]); w.y = cvt_pk_bf16(v0[2], v0[3]); w.z = cvt_pk_bf16(v1[0], v1[1]); w.w = cvt_pk_bf16(v1[2], v1[3]);
                *(u32x4*)rowp = w; } }
    }
};
struct EpiRes {
    static constexpr bool PERM = true, AFTER_DRAIN = false;
    const float* base_p; const float* base_s; const bf16_t* base_b; bf16_t* out; const float* gate;
    bf16_t* xb; const float* g_next; const float* sc_next; float* ss_next;
    __device__ __forceinline__ void operator()(const f32x4 (&acc)[2][2][4][2], const Unit& u, int wr, int wc, int fr, int fq) const {
        const int col0 = u.pn * BM + wc * 32 + 8 * fq;
        const int lane_x = fq * 16 + fr;
#pragma unroll
        for (int ai = 0; ai < 2; ++ai) { const int row0 = u.pm * RM + half_row0(ai, wr) + fr; const int cond = cond_of_row(row0);
            const float* gp = gate + cond * 6144 + col0;
            const float* bp = (row0 < 8192) ? base_p + (size_t)row0 * 1024 + col0 : base_s + (size_t)(row0 - 8192) * 1024 + col0;
            const bf16_t* bb = base_b + (size_t)row0 * 1024 + col0;
            bf16_t* op = out + (size_t)row0 * 1024 + col0;
            f32x4 gv[2][2], gs[2][2];
#pragma unroll
            for (int bj = 0; bj < 2; ++bj)
#pragma unroll
                for (int n = 0; n < 2; ++n) gv[bj][n] = *(const f32x4*)(gp + bj * HALF + n * 4);
            if (xb) { f32x4 ga[2][2], sa[2][2];
#pragma unroll
                for (int bj = 0; bj < 2; ++bj)
#pragma unroll
                    for (int n = 0; n < 2; ++n) { ga[bj][n] = *(const f32x4*)(g_next + col0 + bj * HALF + n * 4); sa[bj][n] = *(const f32x4*)(sc_next + cond * 6144 + col0 + bj * HALF + n * 4); }
#pragma unroll
                for (int bj = 0; bj < 2; ++bj)
#pragma unroll
                    for (int n = 0; n < 2; ++n) gs[bj][n] = ga[bj][n] * (1.f + sa[bj][n]); }
#pragma unroll
            for (int mp = 0; mp < 2; ++mp) if (ai == 0 || mp == 0) { f32x4 bs[2][2][2];
                if (base_b) {
#pragma unroll
                    for (int mm = 0; mm < 2; ++mm)
#pragma unroll
                        for (int bj = 0; bj < 2; ++bj) { const u32x4 w = *(const u32x4*)(bb + (size_t)((2 * mp + mm) * 16) * 1024 + bj * HALF);
                            bs[mm][bj][0] = (f32x4){__builtin_bit_cast(float, w.x << 16), __builtin_bit_cast(float, w.x & 0xffff0000u), __builtin_bit_cast(float, w.y << 16), __builtin_bit_cast(float, w.y & 0xffff0000u)};
                            bs[mm][bj][1] = (f32x4){__builtin_bit_cast(float, w.z << 16), __builtin_bit_cast(float, w.z & 0xffff0000u), __builtin_bit_cast(float, w.w << 16), __builtin_bit_cast(float, w.w & 0xffff0000u)}; }
                } else {
#pragma unroll
                    for (int mm = 0; mm < 2; ++mm)
#pragma unroll
                        for (int bj = 0; bj < 2; ++bj)
#pragma unroll
                            for (int n = 0; n < 2; ++n) bs[mm][bj][n] = __builtin_nontemporal_load((const f32x4*)(bp + (size_t)((2 * mp + mm) * 16) * 1024 + bj * HALF + n * 4));
                }
#pragma unroll
                for (int mm = 0; mm < 2; ++mm) { float sq = 0.f;
#pragma unroll
                    for (int bj = 0; bj < 2; ++bj) { const f32x4 x0 = bs[mm][bj][0] + gv[bj][0] * acc[ai][bj][2 * mp + mm][0], x1 = bs[mm][bj][1] + gv[bj][1] * acc[ai][bj][2 * mp + mm][1];
                        { u32x4 w; w.x = cvt_pk_bf16(x0[0], x0[1]); w.y = cvt_pk_bf16(x0[2], x0[3]); w.z = cvt_pk_bf16(x1[0], x1[1]); w.w = cvt_pk_bf16(x1[2], x1[3]); *(u32x4*)(op + (size_t)((2 * mp + mm) * 16) * 1024 + bj * HALF) = w; }
                        if (xb) { const f32x4 h0 = x0 * gs[bj][0], h1 = x1 * gs[bj][1]; u32x4 w; w.x = cvt_pk_bf16(h0[0], h0[1]); w.y = cvt_pk_bf16(h0[2], h0[3]); w.z = cvt_pk_bf16(h1[0], h1[1]); w.w = cvt_pk_bf16(h1[2], h1[3]);
                            *(u32x4*)(xb + (size_t)(row0 + (2 * mp + mm) * 16) * 1024 + col0 + bj * HALF) = w;
                            sq += ((x0[0] * x0[0] + x0[1] * x0[1]) + (x0[2] * x0[2] + x0[3] * x0[3])) + ((x1[0] * x1[0] + x1[1] * x1[1]) + (x1[2] * x1[2] + x1[3] * x1[3])); } }
                    if (xb) {
                        sq += __builtin_bit_cast(float, __builtin_amdgcn_ds_bpermute((lane_x ^ 16) << 2, __builtin_bit_cast(int, sq)));
                        sq += __builtin_bit_cast(float, __builtin_amdgcn_ds_bpermute((lane_x ^ 32) << 2, __builtin_bit_cast(int, sq)));
                        if (fq == 0) atomicAdd(ss_next + row0 + (2 * mp + mm) * 16, sq); } }
                asm volatile("" ::: "memory"); } }
    }
};

struct StaticOrder256 {
    int nM, nN, nwg, G, c;
    __host__ __device__ void init(int M, int N, int G_, int c_) { nM = M / BM; nN = N / BM; nwg = nM * nN; G = G_; c = c_; }
    __host__ __device__ bool next(int i, Unit& u) const {
        const long L = (long)i * G + c; if (L >= nwg) return false;
        int wgid = (int)L; { const int q = nwg / NXCD, r = nwg % NXCD, xcd = wgid % NXCD, off = wgid / NXCD; wgid = (xcd < r ? xcd * (q + 1) : r * (q + 1) + (xcd - r) * q) + off; }
        const int nig = WGM * nN, gid = wgid / nig, fm = gid * WGM, gsz = (nM - fm) < WGM ? (nM - fm) : WGM;
        u.pm = fm + ((wgid % nig) % gsz); u.pn = (wgid % nig) / gsz; return true;
    }
    __device__ __forceinline__ void a_ready(const Unit&) const {}
    __device__ __forceinline__ void done(const Unit&) const {}
};
struct EpiUp256 {
    static constexpr bool PERM = true, AFTER_DRAIN = false;
    const float* ss; const float* shw; bf16_t* O; int ldc;
    __device__ __forceinline__ void operator()(const f32x4 (&acc)[2][2][4][2], const Unit& u, int wr, int wc, int fr, int fq) const {
        const int col0 = u.pn * BM + wc * 32 + 8 * fq;
        f32x4 sv[2][2][2]; float rr[2][4];
#pragma unroll
        for (int ai = 0; ai < 2; ++ai) { const int rbase = u.pm * BM + ai * HALF + wr * 64 + fr; const float* sp = shw + cond_of_row(rbase) * 4096 + col0;
#pragma unroll
            for (int bj = 0; bj < 2; ++bj) { sv[ai][bj][0] = *(const f32x4*)(sp + bj * HALF); sv[ai][bj][1] = *(const f32x4*)(sp + bj * HALF + 4); }
#pragma unroll
            for (int m = 0; m < 4; ++m) rr[ai][m] = ss[rbase + m * 16]; }
        __builtin_amdgcn_sched_barrier(0);
#pragma unroll
        for (int ai = 0; ai < 2; ++ai) { const int rbase = u.pm * BM + ai * HALF + wr * 64 + fr;
#pragma unroll
            for (int m = 0; m < 4; ++m) { bf16_t* rowp = O + (size_t)(rbase + m * 16) * ldc + col0;
                const float r = __builtin_amdgcn_rsqf(rr[ai][m] * (1.f / 1024.f) + 1e-6f);
#pragma unroll
                for (int bj = 0; bj < 2; ++bj) { f32x4 v0 = acc[ai][bj][m][0] * r + sv[ai][bj][0], v1 = acc[ai][bj][m][1] * r + sv[ai][bj][1];
#pragma unroll
                    for (int e = 0; e < 4; ++e) { const float a = fmaxf(v0[e], 0.f), b = fmaxf(v1[e], 0.f); v0[e] = a * a; v1[e] = b * b; }
                    u32x4 w; w.x = cvt_pk_bf16(v0[0], v0[1]); w.y = cvt_pk_bf16(v0[2], v0[3]); w.z = cvt_pk_bf16(v1[0], v1[1]); w.w = cvt_pk_bf16(v1[2], v1[3]);
                    *(u32x4*)(rowp + bj * HALF) = w; } } }
    }
};
template <class Epi, class Sched, bool ALIGN_EPI = false, bool SP2 = false>
__device__ __forceinline__ void gemm_phase256(PG8_LAS unsigned char* lds, const Gemm g, const Sched& S, const Epi& E, const int tid) {
    const int wid = __builtin_amdgcn_readfirstlane(tid >> 6), lane = tid & 63, wr = wid >> 2, wc = wid & 3, fr = lane & 15, fq = lane >> 4;
    const int K = g.K, nt = K / BK;
    unsigned voffA[2], voffB[2];
#pragma unroll
    for (int i = 0; i < 2; ++i) { int R, C; stage_rc(tid * 16 + i * 8192, R, C); const int Rb = Epi::PERM ? ((R & ~31) + perm32(R & 31)) : R;
        voffA[i] = (unsigned)(R * K + C) * 2u; voffB[i] = (unsigned)(Rb * K + C) * 2u; }
    const size_t kstep = (size_t)(BK * 2);
    const size_t hstep = (size_t)HALF * K * 2;
    const size_t tstep = 2 * hstep;
    const unsigned ldsw = (unsigned)wid * 1024u;
    const int aoff = lds_byte(wr * 64 + fr, fq * 8), boff = lds_byte(wc * 32 + fr, fq * 8);
#define PG8_SA(b, h) (((b) * 2 + (h)) * HTB)
#define PG8_SB(b, h) ((4 + (b) * 2 + (h)) * HTB)
#define PG8_STAGE(bufoff, gbase, voff) do { _Pragma("unroll") for (int _i = 0; _i < 2; ++_i) \
        __builtin_amdgcn_global_load_lds((const unsigned*)((const char*)(gbase) + (voff)[_i]), (PG8_LAS unsigned*)(lds + (bufoff) + ldsw + _i * 8192), 16, 0, 0); } while (0)
#define PG8_LDA(dst, b, h) do { _Pragma("unroll") for (int m = 0; m < 4; ++m) _Pragma("unroll") for (int k = 0; k < 2; ++k) dst[m][k] = *(const PG8_LAS bf16x8*)(lds + PG8_SA(b, h) + aoff + m * 2048 + k * 1024); } while (0)
#define PG8_LDB(dst, b, h) do { _Pragma("unroll") for (int n = 0; n < 2; ++n) _Pragma("unroll") for (int k = 0; k < 2; ++k) dst[n][k] = *(const PG8_LAS bf16x8*)(lds + PG8_SB(b, h) + boff + n * 2048 + k * 1024); } while (0)
#define PG8_MMA(ai, bj, At, Bt) do { __builtin_amdgcn_s_setprio(1); _Pragma("unroll") for (int m = 0; m < 4; ++m) _Pragma("unroll") for (int n = 0; n < 2; ++n) _Pragma("unroll") for (int k = 0; k < 2; ++k) \
        acc[ai][bj][m][n] = __builtin_amdgcn_mfma_f32_16x16x32_bf16(Bt[n][k], At[m][k], acc[ai][bj][m][n], 0, 0, 0); __builtin_amdgcn_s_setprio(0); } while (0)
#define PG8_WAIT_V(n) asm volatile("s_waitcnt vmcnt(" #n ")" ::: "memory")
#define PG8_WAIT_L(n) asm volatile("s_waitcnt lgkmcnt(" #n ")" ::: "memory")
#define PG8_BAR __builtin_amdgcn_s_barrier()
#define PG8_SCHED __builtin_amdgcn_sched_barrier(0)
    Unit cur, nxt; int ui = 0;
    if (!S.next(0, cur)) return;
    f32x4 acc[2][2][4][2];
#pragma unroll
    for (int a = 0; a < 2; ++a)
#pragma unroll
        for (int b = 0; b < 2; ++b)
#pragma unroll
            for (int m = 0; m < 4; ++m)
#pragma unroll
                for (int n = 0; n < 2; ++n) acc[a][b][m][n] = (f32x4){0.f, 0.f, 0.f, 0.f};
    bf16x8 At[4][2], B0[2][2], B1[2][2];
    const char* cA = (const char*)g.A + (size_t)cur.pm * tstep; const char* cB = (const char*)g.Bt + (size_t)cur.pn * tstep;
    S.a_ready(cur);
    if constexpr (SP2) {
        PG8_STAGE(PG8_SB(0, 0), cB, voffB); PG8_STAGE(PG8_SB(0, 1), cB + hstep, voffB); PG8_STAGE(PG8_SA(0, 0), cA, voffA); PG8_STAGE(PG8_SA(0, 1), cA + hstep, voffA);
        if (wr == 1) PG8_BAR;
        PG8_WAIT_V(2); PG8_BAR;
        PG8_STAGE(PG8_SB(1, 0), cB + kstep, voffB); PG8_STAGE(PG8_SA(1, 0), cA + kstep, voffA); PG8_STAGE(PG8_SB(1, 1), cB + hstep + kstep, voffB);
        PG8_WAIT_V(6); PG8_BAR;
    } else {
        PG8_STAGE(PG8_SB(0, 0), cB, voffB); PG8_STAGE(PG8_SA(0, 0), cA, voffA); PG8_STAGE(PG8_SB(0, 1), cB + hstep, voffB); PG8_STAGE(PG8_SA(0, 1), cA + hstep, voffA);
        if (wr == 1) PG8_BAR;
        PG8_WAIT_V(4); PG8_BAR;
        PG8_STAGE(PG8_SB(1, 0), cB + kstep, voffB); PG8_STAGE(PG8_SA(1, 0), cA + kstep, voffA); PG8_STAGE(PG8_SB(1, 1), cB + hstep + kstep, voffB);
        PG8_WAIT_V(6); PG8_BAR;
    }
    for (;;) {
        const bool has_next = S.next(ui + 1, nxt);
        const char* nA = has_next ? (const char*)g.A + (size_t)nxt.pm * tstep : cA; const char* nB = has_next ? (const char*)g.Bt + (size_t)nxt.pn * tstep : cB;
        for (int t = 0; t < nt; t += 2) {
            const bool last = (t == nt - 2);
            const char* a1 = cA + (size_t)(t + 1) * kstep;
            const char* a2 = last ? nA : cA + (size_t)(t + 2) * kstep; const char* b2 = last ? nB : cB + (size_t)(t + 2) * kstep;
            const char* a3 = a2 + kstep; const char* b3 = b2 + kstep;
            if (last && has_next) S.a_ready(nxt);
            if constexpr (SP2) {
            PG8_LDB(B0, 0, 0); PG8_LDB(B1, 0, 1); PG8_SCHED; PG8_LDA(At, 0, 0); PG8_STAGE(PG8_SA(1, 1), a1 + hstep, voffA);
            PG8_WAIT_V(8); PG8_WAIT_L(0); PG8_BAR; PG8_MMA(0, 0, At, B0); PG8_MMA(0, 1, At, B1); PG8_BAR; PG8_SCHED;
            PG8_LDA(At, 0, 1); PG8_STAGE(PG8_SB(0, 0), b2, voffB); PG8_STAGE(PG8_SB(0, 1), b2 + hstep, voffB); PG8_STAGE(PG8_SA(0, 0), a2, voffA);
            PG8_WAIT_V(8); PG8_WAIT_L(0); PG8_BAR; PG8_MMA(1, 0, At, B0); PG8_MMA(1, 1, At, B1); PG8_BAR; PG8_SCHED;
            PG8_LDB(B0, 1, 0); PG8_LDB(B1, 1, 1); PG8_SCHED; PG8_LDA(At, 1, 0); PG8_STAGE(PG8_SA(0, 1), a2 + hstep, voffA);
            PG8_WAIT_V(8); PG8_WAIT_L(0); PG8_BAR; PG8_MMA(0, 0, At, B0); PG8_MMA(0, 1, At, B1); PG8_BAR; PG8_SCHED;
            PG8_LDA(At, 1, 1); PG8_STAGE(PG8_SB(1, 0), b3, voffB); PG8_STAGE(PG8_SB(1, 1), b3 + hstep, voffB); PG8_STAGE(PG8_SA(1, 0), a3, voffA);
            PG8_WAIT_V(8); PG8_WAIT_L(0); PG8_BAR; PG8_MMA(1, 0, At, B0); PG8_MMA(1, 1, At, B1); PG8_BAR; PG8_SCHED;
            } else {
            PG8_LDB(B0, 0, 0); PG8_SCHED; PG8_LDA(At, 0, 0); PG8_STAGE(PG8_SA(1, 1), a1 + hstep, voffA);
            PG8_WAIT_L(8); PG8_BAR; PG8_WAIT_L(0); PG8_MMA(0, 0, At, B0); PG8_BAR; PG8_SCHED;
            PG8_LDB(B1, 0, 1); PG8_STAGE(PG8_SB(0, 0), b2, voffB);
            PG8_BAR; PG8_WAIT_L(0); PG8_MMA(0, 1, At, B1); PG8_BAR;
            PG8_LDA(At, 0, 1); PG8_STAGE(PG8_SA(0, 0), a2, voffA);
            PG8_BAR; PG8_WAIT_L(0); PG8_MMA(1, 0, At, B0); PG8_BAR; PG8_SCHED;
            PG8_STAGE(PG8_SB(0, 1), b2 + hstep, voffB);
            PG8_WAIT_V(6); PG8_BAR; PG8_MMA(1, 1, At, B1); PG8_BAR;
            PG8_LDB(B0, 1, 0); PG8_SCHED; PG8_LDA(At, 1, 0); PG8_STAGE(PG8_SA(0, 1), a2 + hstep, voffA);
            PG8_WAIT_L(8); PG8_BAR; PG8_WAIT_L(0); PG8_MMA(0, 0, At, B0); PG8_BAR; PG8_SCHED;
            PG8_LDB(B1, 1, 1); PG8_STAGE(PG8_SB(1, 0), b3, voffB);
            PG8_BAR; PG8_WAIT_L(0); PG8_MMA(0, 1, At, B1); PG8_BAR;
            PG8_LDA(At, 1, 1); PG8_STAGE(PG8_SA(1, 0), a3, voffA);
            PG8_BAR; PG8_WAIT_L(0); PG8_MMA(1, 0, At, B0); PG8_BAR; PG8_SCHED;
            PG8_STAGE(PG8_SB(1, 1), b3 + hstep, voffB);
            PG8_WAIT_V(6); PG8_BAR; PG8_MMA(1, 1, At, B1); PG8_BAR;
            }
        }
        if constexpr (ALIGN_EPI) { if (wr == 0) PG8_BAR; }
        if constexpr (!Epi::AFTER_DRAIN) { E(acc, cur, wr, wc, fr, fq); S.done(cur); }
        if (!has_next) break;
#pragma unroll
        for (int a = 0; a < 2; ++a)
#pragma unroll
            for (int b = 0; b < 2; ++b)
#pragma unroll
                for (int m = 0; m < 4; ++m)
#pragma unroll
                    for (int n = 0; n < 2; ++n) acc[a][b][m][n] = (f32x4){0.f, 0.f, 0.f, 0.f};
        cur = nxt; cA = nA; cB = nB; ++ui;
        if constexpr (ALIGN_EPI) { if (wr == 1) PG8_BAR; }
    }
    PG8_WAIT_V(0);
    if constexpr (!ALIGN_EPI) { if (wr == 0) PG8_BAR; }
    PG8_BAR;
    if constexpr (Epi::AFTER_DRAIN) { E.fused(acc, cur, wr, wc, fr, fq, lds, wid, lane); S.done(cur); }
#undef PG8_SA
#undef PG8_SB
#undef PG8_STAGE
#undef PG8_LDA
#undef PG8_LDB
#undef PG8_MMA
#undef PG8_WAIT_V
#undef PG8_WAIT_L
#undef PG8_BAR
#undef PG8_SCHED
}
template <class Epi, class Sched, bool ALIGN_EPI = false, bool SP2 = false>
__device__ __forceinline__ void gemm_phase(PG8_LAS unsigned char* lds, const Gemm g, const Sched& S, const Epi& E, const int tid) {
    static_assert(SP2, "the 192-row tile form exists for the SP2 loop only");
    const int wid = __builtin_amdgcn_readfirstlane(tid >> 6), lane = tid & 63, wr = wid >> 2, wc = wid & 3, fr = lane & 15, fq = lane >> 4;
    const int K = g.K, nt = K / BK;
    unsigned voffA[2], voffB[2];
#pragma unroll
    for (int i = 0; i < 2; ++i) { int R, C; stage_rc(tid * 16 + i * 8192, R, C); const int Rb = Epi::PERM ? ((R & ~31) + perm32(R & 31)) : R;
        voffA[i] = (unsigned)(R * K + C) * 2u; voffB[i] = (unsigned)(Rb * K + C) * 2u; }
    const size_t kstep = (size_t)(BK * 2);
    const size_t hstep = (size_t)HALF * K * 2;
    const size_t tstepA = (size_t)RM * K * 2;
    const size_t tstep = 2 * hstep;
    const unsigned ldsw = (unsigned)wid * 1024u;
    const int aoff = lds_byte(wr * 64 + fr, fq * 8), boff = lds_byte(wc * 32 + fr, fq * 8);
#define PG8_SA(b, h) (((b) * 2 + (h)) * HTB)
#define PG8_SB(b, h) ((4 + (b) * 2 + (h)) * HTB)
#define PG8_STAGE(bufoff, gbase, voff) do { _Pragma("unroll") for (int _i = 0; _i < 2; ++_i) \
        __builtin_amdgcn_global_load_lds((const unsigned*)((const char*)(gbase) + (voff)[_i]), (PG8_LAS unsigned*)(lds + (bufoff) + ldsw + _i * 8192), 16, 0, 0); } while (0)
#define PG8_LDA(dst, b, h) do { _Pragma("unroll") for (int m = 0; m < 4; ++m) _Pragma("unroll") for (int k = 0; k < 2; ++k) dst[m][k] = *(const PG8_LAS bf16x8*)(lds + PG8_SA(b, h) + aoff + m * 2048 + k * 1024); } while (0)
#define PG8_LDB(dst, b, h) do { _Pragma("unroll") for (int n = 0; n < 2; ++n) _Pragma("unroll") for (int k = 0; k < 2; ++k) dst[n][k] = *(const PG8_LAS bf16x8*)(lds + PG8_SB(b, h) + boff + n * 2048 + k * 1024); } while (0)
#define PG8_MMA(ai, bj, At, Bt) do { __builtin_amdgcn_s_setprio(1); _Pragma("unroll") for (int m = 0; m < 4; ++m) _Pragma("unroll") for (int n = 0; n < 2; ++n) _Pragma("unroll") for (int k = 0; k < 2; ++k) \
        acc[ai][bj][m][n] = __builtin_amdgcn_mfma_f32_16x16x32_bf16(Bt[n][k], At[m][k], acc[ai][bj][m][n], 0, 0, 0); __builtin_amdgcn_s_setprio(0); } while (0)
    const int aoff1 = lds_byte(wr * 32 + fr, fq * 8);
#define PG8_STAGE1(bufoff, gbase, voff) __builtin_amdgcn_global_load_lds((const unsigned*)((const char*)(gbase) + (voff)[0]), (PG8_LAS unsigned*)(lds + (bufoff) + ldsw), 16, 0, 0)
#define PG8_LDA1(dst, b) do { _Pragma("unroll") for (int m = 0; m < 2; ++m) _Pragma("unroll") for (int k = 0; k < 2; ++k) dst[m][k] = *(const PG8_LAS bf16x8*)(lds + PG8_SA(b, 1) + aoff1 + m * 2048 + k * 1024); } while (0)
#define PG8_MMA1(bj, At, Bt) do { __builtin_amdgcn_s_setprio(1); _Pragma("unroll") for (int m = 0; m < 2; ++m) _Pragma("unroll") for (int n = 0; n < 2; ++n) _Pragma("unroll") for (int k = 0; k < 2; ++k) \
        acc[1][bj][m][n] = __builtin_amdgcn_mfma_f32_16x16x32_bf16(Bt[n][k], At[m][k], acc[1][bj][m][n], 0, 0, 0); __builtin_amdgcn_s_setprio(0); } while (0)
#define PG8_WAIT_V(n) asm volatile("s_waitcnt vmcnt(" #n ")" ::: "memory")
#define PG8_WAIT_L(n) asm volatile("s_waitcnt lgkmcnt(" #n ")" ::: "memory")
#define PG8_BAR __builtin_amdgcn_s_barrier()
#define PG8_SCHED __builtin_amdgcn_sched_barrier(0)
    Unit cur, nxt; int ui = 0;
    if (!S.next(0, cur)) return;
    f32x4 acc[2][2][4][2];
#pragma unroll
    for (int a = 0; a < 2; ++a)
#pragma unroll
        for (int b = 0; b < 2; ++b)
#pragma unroll
            for (int m = 0; m < 4; ++m)
#pragma unroll
                for (int n = 0; n < 2; ++n) acc[a][b][m][n] = (f32x4){0.f, 0.f, 0.f, 0.f};
    bf16x8 At[4][2], B0[2][2], B1[2][2];
    const char* cA = (const char*)g.A + (size_t)cur.pm * tstepA; const char* cB = (const char*)g.Bt + (size_t)cur.pn * tstep;
    S.a_ready(cur);
    if constexpr (SP2) {
        PG8_STAGE(PG8_SB(0, 0), cB, voffB); PG8_STAGE(PG8_SB(0, 1), cB + hstep, voffB); PG8_STAGE(PG8_SA(0, 0), cA, voffA); PG8_STAGE1(PG8_SA(0, 1), cA + hstep, voffA);
        if (wr == 1) PG8_BAR;
        PG8_WAIT_V(1); PG8_BAR;
        PG8_STAGE(PG8_SB(1, 0), cB + kstep, voffB); PG8_STAGE(PG8_SA(1, 0), cA + kstep, voffA); PG8_STAGE(PG8_SB(1, 1), cB + hstep + kstep, voffB);
        PG8_WAIT_V(6); PG8_BAR;
    } else {
        PG8_STAGE(PG8_SB(0, 0), cB, voffB); PG8_STAGE(PG8_SA(0, 0), cA, voffA); PG8_STAGE(PG8_SB(0, 1), cB + hstep, voffB); PG8_STAGE(PG8_SA(0, 1), cA + hstep, voffA);
        if (wr == 1) PG8_BAR;
        PG8_WAIT_V(4); PG8_BAR;
        PG8_STAGE(PG8_SB(1, 0), cB + kstep, voffB); PG8_STAGE(PG8_SA(1, 0), cA + kstep, voffA); PG8_STAGE(PG8_SB(1, 1), cB + hstep + kstep, voffB);
        PG8_WAIT_V(6); PG8_BAR;
    }
    for (;;) {
        const bool has_next = S.next(ui + 1, nxt);
        const char* nA = has_next ? (const char*)g.A + (size_t)nxt.pm * tstepA : cA; const char* nB = has_next ? (const char*)g.Bt + (size_t)nxt.pn * tstep : cB;
        for (int t = 0; t < nt; t += 2) {
            const bool last = (t == nt - 2);
            const char* a1 = cA + (size_t)(t + 1) * kstep;
            const char* a2 = last ? nA : cA + (size_t)(t + 2) * kstep; const char* b2 = last ? nB : cB + (size_t)(t + 2) * kstep;
            const char* a3 = a2 + kstep; const char* b3 = b2 + kstep;
            if (last && has_next) S.a_ready(nxt);
            if constexpr (SP2) {
            PG8_LDB(B0, 0, 0); PG8_LDB(B1, 0, 1); PG8_SCHED; PG8_LDA(At, 0, 0); PG8_STAGE1(PG8_SA(1, 1), a1 + hstep, voffA);
            PG8_WAIT_V(7); PG8_WAIT_L(0); PG8_BAR; PG8_MMA(0, 0, At, B0); PG8_MMA(0, 1, At, B1); PG8_BAR; PG8_SCHED;
            PG8_LDA1(At, 0); PG8_STAGE(PG8_SB(0, 0), b2, voffB); PG8_STAGE(PG8_SB(0, 1), b2 + hstep, voffB); PG8_STAGE(PG8_SA(0, 0), a2, voffA);
            PG8_WAIT_V(7); PG8_WAIT_L(0); PG8_BAR; PG8_MMA1(0, At, B0); PG8_MMA1(1, At, B1); PG8_BAR; PG8_SCHED;
            PG8_LDB(B0, 1, 0); PG8_LDB(B1, 1, 1); PG8_SCHED; PG8_LDA(At, 1, 0); PG8_STAGE1(PG8_SA(0, 1), a2 + hstep, voffA);
            PG8_WAIT_V(7); PG8_WAIT_L(0); PG8_BAR; PG8_MMA(0, 0, At, B0); PG8_MMA(0, 1, At, B1); PG8_BAR; PG8_SCHED;
            PG8_LDA1(At, 1); PG8_STAGE(PG8_SB(1, 0), b3, voffB); PG8_STAGE(PG8_SB(1, 1), b3 + hstep, voffB); PG8_STAGE(PG8_SA(1, 0), a3, voffA);
            PG8_WAIT_V(7); PG8_WAIT_L(0); PG8_BAR; PG8_MMA1(0, At, B0); PG8_MMA1(1, At, B1); PG8_BAR; PG8_SCHED;
            } else {
            PG8_LDB(B0, 0, 0); PG8_SCHED; PG8_LDA(At, 0, 0); PG8_STAGE(PG8_SA(1, 1), a1 + hstep, voffA);
            PG8_WAIT_L(8); PG8_BAR; PG8_WAIT_L(0); PG8_MMA(0, 0, At, B0); PG8_BAR; PG8_SCHED;
            PG8_LDB(B1, 0, 1); PG8_STAGE(PG8_SB(0, 0), b2, voffB);
            PG8_BAR; PG8_WAIT_L(0); PG8_MMA(0, 1, At, B1); PG8_BAR;
            PG8_LDA(At, 0, 1); PG8_STAGE(PG8_SA(0, 0), a2, voffA);
            PG8_BAR; PG8_WAIT_L(0); PG8_MMA(1, 0, At, B0); PG8_BAR; PG8_SCHED;
            PG8_STAGE(PG8_SB(0, 1), b2 + hstep, voffB);
            PG8_WAIT_V(6); PG8_BAR; PG8_MMA(1, 1, At, B1); PG8_BAR;
            PG8_LDB(B0, 1, 0); PG8_SCHED; PG8_LDA(At, 1, 0); PG8_STAGE(PG8_SA(0, 1), a2 + hstep, voffA);
            PG8_WAIT_L(8); PG8_BAR; PG8_WAIT_L(0); PG8_MMA(0, 0, At, B0); PG8_BAR; PG8_SCHED;
            PG8_LDB(B1, 1, 1); PG8_STAGE(PG8_SB(1, 0), b3, voffB);
            PG8_BAR; PG8_WAIT_L(0); PG8_MMA(0, 1, At, B1); PG8_BAR;
            PG8_LDA(At, 1, 1); PG8_STAGE(PG8_SA(1, 0), a3, voffA);
            PG8_BAR; PG8_WAIT_L(0); PG8_MMA(1, 0, At, B0); PG8_BAR; PG8_SCHED;
            PG8_STAGE(PG8_SB(1, 1), b3 + hstep, voffB);
            PG8_WAIT_V(6); PG8_BAR; PG8_MMA(1, 1, At, B1); PG8_BAR;
            }
        }
        if constexpr (ALIGN_EPI) { if (wr == 0) PG8_BAR; }
        if constexpr (!Epi::AFTER_DRAIN) { E(acc, cur, wr, wc, fr, fq); S.done(cur); }
        if (!has_next) break;
#pragma unroll
        for (int a = 0; a < 2; ++a)
#pragma unroll
            for (int b = 0; b < 2; ++b)
#pragma unroll
                for (int m = 0; m < 4; ++m)
#pragma unroll
                    for (int n = 0; n < 2; ++n) acc[a][b][m][n] = (f32x4){0.f, 0.f, 0.f, 0.f};
        cur = nxt; cA = nA; cB = nB; ++ui;
        if constexpr (ALIGN_EPI) { if (wr == 1) PG8_BAR; }
    }
    PG8_WAIT_V(0);
    if constexpr (!ALIGN_EPI) { if (wr == 0) PG8_BAR; }
    PG8_BAR;
    if constexpr (Epi::AFTER_DRAIN) { E.fused(acc, cur, wr, wc, fr, fq, lds, wid, lane); S.done(cur); }
#undef PG8_SA
#undef PG8_SB
#undef PG8_STAGE
#undef PG8_LDA
#undef PG8_LDB
#undef PG8_MMA
#undef PG8_STAGE1
#undef PG8_LDA1
#undef PG8_MMA1
#undef PG8_WAIT_V
#undef PG8_WAIT_L
#undef PG8_BAR
#undef PG8_SCHED
}
}
constexpr int D = 1024, MP = 8192, MS = 4096, M = MP + MS, FF = 4096, NL = 4;
constexpr int NWAVES = 8, NTHR = 512;
constexpr size_t MiB = 1u << 20;
constexpr size_t WS_MOD = 1 * MiB;
constexpr size_t WS_W = 2 * MiB;
constexpr size_t WS_X = 94 * MiB;
constexpr size_t WS_H = 142 * MiB;
constexpr size_t WS_R = 166 * MiB;
constexpr size_t WS_CK = 262 * MiB, WS_CV = 266 * MiB, WS_SHW = 270 * MiB, WS_SS = 271 * MiB, WS_END = 272 * MiB;
constexpr size_t MEL = 1u << 20;
constexpr size_t W_QKV = 0, W_O = 6 * MEL, W_PW1 = 8 * MEL, W_PW2 = 12 * MEL, W_UP = 14 * MEL, W_DOWN = 30 * MEL;
constexpr int LDS_BYTES = 163840, LDS_ST = LDS_BYTES - 16, LDS_KC = 112640;

#define LAS __attribute__((address_space(3)))
#define SB0() __builtin_amdgcn_sched_barrier(0)
typedef unsigned short bf16;
typedef float f32x4 __attribute__((ext_vector_type(4)));
typedef float f32x2 __attribute__((ext_vector_type(2)));
typedef unsigned u32x4 __attribute__((ext_vector_type(4)));
typedef unsigned u32x2 __attribute__((ext_vector_type(2)));
typedef short bf16x8 __attribute__((ext_vector_type(8)));
typedef short s16x4 __attribute__((ext_vector_type(4)));
typedef float f32x32 __attribute__((ext_vector_type(32)));

__device__ __forceinline__ unsigned f2bf(float f) { unsigned u = __builtin_bit_cast(unsigned, f); return (u + 0x7fffu + ((u >> 16) & 1u)) >> 16; }
__device__ __forceinline__ unsigned pk2(float lo, float hi) { unsigned r; asm("v_cvt_pk_bf16_f32 %0, %1, %2" : "=v"(r) : "v"(lo), "v"(hi)); return r; }
__device__ __forceinline__ float bflo(unsigned w) { return __builtin_bit_cast(float, w << 16); }
__device__ __forceinline__ float bfhi(unsigned w) { return __builtin_bit_cast(float, w & 0xffff0000u); }
__device__ __forceinline__ float shx(float v, int k, int lane) { return __builtin_bit_cast(float, __builtin_amdgcn_ds_bpermute((lane ^ k) << 2, __builtin_bit_cast(int, v))); }
__device__ __forceinline__ float wave_sum(float v, int lane) {
#pragma unroll
    for (int o = 1; o < 64; o <<= 1) v += shx(v, o, lane);
    return v;
}

template <bool GLU>
__device__ __forceinline__ void transpose_item(const float* W, int K, int N, bf16* WT, LAS float* scr, int item, int lane) {
    const int nblk = N / 32, kb = item / nblk, nb = item % nblk, k0 = 64 * kb, n0 = 32 * nb;
    { float tv[32];
#pragma unroll
      for (int i = 0; i < 32; ++i) tv[i] = __builtin_nontemporal_load(W + (size_t)(k0 + 2 * i + (lane >> 5)) * N + n0 + (lane & 31));
      __builtin_amdgcn_sched_barrier(0);
#pragma unroll
      for (int i = 0; i < 32; ++i) scr[(2 * i + (lane >> 5)) * 33 + (((lane & 31) + 4 * (i >> 4)) & 31)] = tv[i]; }
    asm volatile("s_waitcnt lgkmcnt(0)" ::: "memory");
    int d0 = n0;
    if (GLU) { const int nn = n0 & 1023; d0 = ((nn >> 7) << 8) + (nn & 127) + ((n0 >> 10) << 7); }
    const int c = lane & 7;
#pragma unroll
    for (int j = 0; j < 4; ++j) { const int n = (lane >> 3) + 8 * j; const LAS float* s = scr + (8 * c) * 33 + ((n + 4 * (c >> 2)) & 31);
        u32x4 o; o.x = pk2(s[0 * 33], s[1 * 33]); o.y = pk2(s[2 * 33], s[3 * 33]); o.z = pk2(s[4 * 33], s[5 * 33]); o.w = pk2(s[6 * 33], s[7 * 33]);
        *(u32x4*)(WT + (size_t)(d0 + n) * K + k0 + 8 * c) = o; }
    asm volatile("s_waitcnt lgkmcnt(0)" ::: "memory");
}

struct Ptrs {
    const float *x_prompt, *x_sample, *cache_k, *cache_v, *c, *c_ctx, *norm_g, *w_ada, *b_ada, *w_qkv, *w_o, *rpb, *w_pw1, *w_dw, *b_dw, *ln_g, *ln_b, *w_pw2, *w_up, *w_down, *final_g;
};

__device__ __forceinline__ void p0_phase(const Ptrs& P, unsigned char* ws, LAS unsigned char* lds, int tid, int lane, int wave, int G, int bid) {
    bf16* Wt = (bf16*)(ws + WS_W);
    const int gw = bid * NWAVES + wave, NGW = G * NWAVES;
    LAS float* scr = (LAS float*)(lds + wave * 16384);
    constexpr int NIT = 23552;
    for (int it = gw; it < NIT; it += NGW) {
        if (it < 7168) { const int i = it / 3584; int r = it % 3584;
            if (r < 1536) { transpose_item<false>(P.w_qkv + (size_t)i * D * 3 * D, D, 3 * D, Wt + W_QKV + (size_t)i * 3 * MEL, scr, r, lane); continue; } r -= 1536;
            if (r < 512) { transpose_item<false>(P.w_o + (size_t)i * D * D, D, D, Wt + W_O + (size_t)i * MEL, scr, r, lane); continue; } r -= 512;
            if (r < 1024) { transpose_item<true>(P.w_pw1 + (size_t)i * D * 2 * D, D, 2 * D, Wt + W_PW1 + (size_t)i * 2 * MEL, scr, r, lane); continue; } r -= 1024;
            transpose_item<false>(P.w_pw2 + (size_t)i * D * D, D, D, Wt + W_PW2 + (size_t)i * MEL, scr, r, lane);
        } else { const int l = (it - 7168) / 4096; int r = (it - 7168) % 4096;
            if (r < 2048) transpose_item<false>(P.w_up + (size_t)l * D * FF, D, FF, Wt + W_UP + (size_t)l * 4 * MEL, scr, r, lane);
            else transpose_item<false>(P.w_down + (size_t)l * D * FF, FF, D, Wt + W_DOWN + (size_t)l * 4 * MEL, scr, r - 2048, lane);
        }
    }
    { bf16* CK = (bf16*)(ws + WS_CK); bf16* CV = (bf16*)(ws + WS_CV);
      const int NT = G * NTHR; constexpr int NV = 2 * 4 * 2 * 256 * 1024 / 4;
      for (int v = bid * NTHR + tid; v < NV; v += NT) { const int which = v >= NV / 2; const int e = (which ? v - NV / 2 : v) * 4;
          const f32x4 a = __builtin_nontemporal_load((const f32x4*)((which ? P.cache_v : P.cache_k) + e));
          u32x2 o; o.x = pk2(a[0], a[1]); o.y = pk2(a[2], a[3]);
          *(u32x2*)((which ? CV : CK) + e) = o; } }
    { f32x4* z = (f32x4*)(ws + WS_SS); const int NT = G * NTHR; float zf = 0.f; asm volatile("" : "+v"(zf));
      const f32x4 zz = (f32x4){zf, zf, zf, zf}; for (int v = bid * NTHR + tid; v < 9 * M / 4; v += NT) z[v] = zz; }
    __syncthreads();
    { LAS float* sil = (LAS float*)lds; LAS float* red = (LAS float*)(lds + 20480); float* mod = (float*)(ws + WS_MOD);
      for (int k = tid; k < 5 * 1024; k += NTHR) { const int cc = k >> 10, kk = k & 1023; const float v = cc == 0 ? P.c_ctx[kk] : P.c[(cc - 1) * 1024 + kk]; sil[k] = v / (1.f + __expf(-v)); }
      __syncthreads();
      const int kg = tid >> 4, cl = tid & 15; const bool cact = cl < 12;
      for (int item = bid; item < 512; item += G) { const int l = item >> 7, n0 = (item & 127) * 48;
          const float* W = P.w_ada + (size_t)l * D * 6144 + n0 + 4 * cl;
          f32x4 a[5];
#pragma unroll
          for (int cc = 0; cc < 5; ++cc) a[cc] = (f32x4){0.f, 0.f, 0.f, 0.f};
#pragma unroll 4
          for (int kk = 0; kk < 32; ++kk) { const int k = kg * 32 + kk; f32x4 w = (f32x4){0.f, 0.f, 0.f, 0.f}; if (cact) w = __builtin_nontemporal_load((const f32x4*)(W + (size_t)k * 6144));
#pragma unroll
              for (int cc = 0; cc < 5; ++cc) a[cc] += sil[cc * 1024 + k] * w; }
#pragma unroll
          for (int cc = 0; cc < 5; ++cc) *(LAS f32x4*)(red + (kg * 5 + cc) * 64 + 4 * cl) = a[cc];
          __syncthreads();
          if (tid < 320 && (tid & 63) < 48) { const int cc = tid >> 6, n = tid & 63; float s = 0.f;
#pragma unroll 8
              for (int g = 0; g < 32; ++g) s += red[(g * 5 + cc) * 64 + n];
              mod[(size_t)(l * 5 + cc) * 6144 + n0 + n] = s + P.b_ada[l * 6144 + n0 + n]; }
          __syncthreads();
      } }
}

__device__ __forceinline__ void norm_phase(const float* xp, const float* xs, bf16* H, float* yout, const float* g, const float* shift, const float* scale, int gw, int NGW, int lane) {
    f32x4 gv[4];
#pragma unroll
    for (int j = 0; j < 4; ++j) gv[j] = *(const f32x4*)(g + 4 * (lane + 64 * j));
    for (int m = gw; m < M; m += NGW) {
        const float* xrow = m < MP ? xp + (size_t)m * D : xs + (size_t)(m - MP) * D;
        const int cond = m < MP ? 0 : 1 + ((m - MP) >> 10);
        f32x4 v[4]; float ss = 0.f;
#pragma unroll
        for (int j = 0; j < 4; ++j) { v[j] = *(const f32x4*)(xrow + 4 * (lane + 64 * j)); ss += (v[j][0] * v[j][0] + v[j][1] * v[j][1]) + (v[j][2] * v[j][2] + v[j][3] * v[j][3]); }
        const float r = 1.0f / sqrtf(wave_sum(ss, lane) * (1.f / D) + 1e-6f);
        if (yout) {
#pragma unroll
            for (int j = 0; j < 4; ++j) *(f32x4*)(yout + (size_t)m * D + 4 * (lane + 64 * j)) = v[j] * r * gv[j];
        } else {
#pragma unroll
            for (int j = 0; j < 4; ++j) { const f32x4 sc = *(const f32x4*)(scale + cond * 6144 + 4 * (lane + 64 * j)), sh = *(const f32x4*)(shift + cond * 6144 + 4 * (lane + 64 * j));
                const f32x4 h = (v[j] * r * gv[j]) * (1.f + sc) + sh; u32x2 o; o.x = pk2(h[0], h[1]); o.y = pk2(h[2], h[3]);
                *(u32x2*)(H + (size_t)m * D + 4 * (lane + 64 * j)) = o; }
        }
    }
}

template <class F, int... I> __device__ __forceinline__ void sfor_impl(F&& f, std::integer_sequence<int, I...>) { (f(std::integral_constant<int, I>{}), ...); }
template <int N, class F> __device__ __forceinline__ void sfor(F&& f) { sfor_impl(f, std::make_integer_sequence<int, N>{}); }
__device__ __forceinline__ float dpp_add(float v, int ctrl_b1, int ctrl_4e, int dummy) { return v; }
__device__ __forceinline__ float wave_sum_dpp(float v) {
    v += __builtin_bit_cast(float, __builtin_amdgcn_update_dpp(0, __builtin_bit_cast(int, v), 0xB1, 0xf, 0xf, false));
    v += __builtin_bit_cast(float, __builtin_amdgcn_update_dpp(0, __builtin_bit_cast(int, v), 0x4E, 0xf, 0xf, false));
    v += __builtin_bit_cast(float, __builtin_amdgcn_update_dpp(0, __builtin_bit_cast(int, v), 0x141, 0xf, 0xf, false));
    v += __builtin_bit_cast(float, __builtin_amdgcn_update_dpp(0, __builtin_bit_cast(int, v), 0x140, 0xf, 0xf, false));
    const int vi = __builtin_bit_cast(int, v);
    return (__builtin_bit_cast(float, __builtin_amdgcn_readlane(vi, 0)) + __builtin_bit_cast(float, __builtin_amdgcn_readlane(vi, 16))) +
           (__builtin_bit_cast(float, __builtin_amdgcn_readlane(vi, 32)) + __builtin_bit_cast(float, __builtin_amdgcn_readlane(vi, 48)));
}
constexpr int CT = 16, CROWS = CT + 30, CCS = 16, CCH = (CROWS + CCS - 1) / CCS;
__device__ __forceinline__ void conv_phase(const bf16* U, bf16* Vc, const float* wdw, const float* bdw, const float* lng, const float* lnb, LAS unsigned char* lds, int tid, int lane, int wave, int G, int bid) {
    f32x2 w[31];
    sfor<31>([&](auto K) __attribute__((always_inline)) { constexpr int k = decltype(K)::value; w[k] = *(const f32x2*)(wdw + k * D + 2 * tid); });
    const f32x2 bd = *(const f32x2*)(bdw + 2 * tid), lg = *(const f32x2*)(lng + 2 * tid), lb = *(const f32x2*)(lnb + 2 * tid);
    LAS f32x2* part = (LAS f32x2*)lds;
    LAS f32x2* stats = part + 8 * CT;
    for (int un_ = bid; un_ < M / CT; un_ += G) {
        const int unit = (G == 256) ? (un_ & 7) * (M / CT / 8) + ((un_ >> 3) & 31) + 32 * (un_ >> 8) : un_;
        const int m0 = unit * CT, seg = m0 < MP ? 0 : MP, L = m0 < MP ? 256 : 1024, t0 = (m0 - seg) & (L - 1);
        const bf16* Ub = U + (size_t)(m0 - t0) * D + 2 * tid;
        f32x2 acc[CT];
        sfor<CT>([&](auto O) __attribute__((always_inline)) { acc[decltype(O)::value] = bd; });
        sfor<CCH>([&](auto C) __attribute__((always_inline)) { constexpr int c = decltype(C)::value;
            unsigned raw[CCS];
            sfor<CCS>([&](auto I) __attribute__((always_inline)) { constexpr int i = decltype(I)::value, j = c * CCS + i;
                if constexpr (j < CROWS) { const int t = t0 - 15 + j, tc = min(max(t, 0), L - 1);
                    raw[i] = *(const unsigned*)(Ub + (size_t)tc * D); } });
            SB0();
            sfor<CCS>([&](auto I) __attribute__((always_inline)) { constexpr int i = decltype(I)::value, j = c * CCS + i;
                if constexpr (j < CROWS) { const int t = t0 - 15 + j; const unsigned rm = raw[i] & (unsigned)(-(int)((t >= 0) & (t < L))); const f32x2 u = (f32x2){bflo(rm), bfhi(rm)};
                    sfor<31>([&](auto K) __attribute__((always_inline)) { constexpr int k = decltype(K)::value, o = j - k;
                        if constexpr (o >= 0 && o < CT) acc[o] += u * w[k]; }); } });
        });
        sfor<CT>([&](auto O) __attribute__((always_inline)) { constexpr int o = decltype(O)::value;
            const float s = wave_sum_dpp(acc[o].x + acc[o].y), q = wave_sum_dpp(acc[o].x * acc[o].x + acc[o].y * acc[o].y); if (lane == 0) part[wave * CT + o] = (f32x2){s, q}; });
        __syncthreads();
        if (tid < CT) { float s = 0.f, q = 0.f;
#pragma unroll
            for (int wv = 0; wv < 8; ++wv) { const f32x2 p = part[wv * CT + tid]; s += p.x; q += p.y; }
            const float mean = s * (1.f / D), var = fmaxf(q * (1.f / D) - mean * mean, 0.f); stats[tid] = (f32x2){mean, 1.0f / sqrtf(var + 1e-5f)}; }
        __syncthreads();
        sfor<CT>([&](auto O) __attribute__((always_inline)) { constexpr int o = decltype(O)::value;
            const f32x2 st = stats[o]; f32x2 y = (acc[o] - st.x) * st.y * lg + lb;
            y.x = y.x * __builtin_amdgcn_rcpf(1.f + __expf(-y.x)); y.y = y.y * __builtin_amdgcn_rcpf(1.f + __expf(-y.y));
            *(unsigned*)(Vc + (size_t)(m0 + o) * D + 2 * tid) = pk2(y.x, y.y); });
        __syncthreads();
    }
}

__device__ __forceinline__ void final_norm_phase(const bf16* X, float* yout, const float* g, int gw, int NGW, int lane) {
    f32x4 gv[4];
#pragma unroll
    for (int j = 0; j < 4; ++j) gv[j] = *(const f32x4*)(g + 4 * (lane + 64 * j));
    for (int m = gw; m < M; m += NGW) {
        const bf16* xr = X + (size_t)m * D;
        f32x4 v[4]; float sq = 0.f;
#pragma unroll
        for (int j = 0; j < 4; ++j) { const u32x2 w = __builtin_nontemporal_load((const u32x2*)(xr + 4 * (lane + 64 * j))); v[j] = (f32x4){bflo(w.x), bfhi(w.x), bflo(w.y), bfhi(w.y)};
            sq += (v[j][0] * v[j][0] + v[j][1] * v[j][1]) + (v[j][2] * v[j][2] + v[j][3] * v[j][3]); }
        const float r = 1.0f / sqrtf(wave_sum_dpp(sq) * (1.f / D) + 1e-6f);
#pragma unroll
        for (int j = 0; j < 4; ++j) __builtin_nontemporal_store(v[j] * r * gv[j], (f32x4*)(yout + (size_t)m * D + 4 * (lane + 64 * j)));
    }
}

__device__ __forceinline__ void prep_phase(const float* xp, const float* xs, bf16* H, float* ss0, const float* g, const float* scale, const float* mod, const bf16* Wt, float* shw, int gw, int NGW, int lane) {
    { f32x4 gv[4];
#pragma unroll
      for (int j = 0; j < 4; ++j) gv[j] = *(const f32x4*)(g + 4 * (lane + 64 * j));
      for (int m = gw; m < M; m += NGW) {
          const float* xrow = m < MP ? xp + (size_t)m * D : xs + (size_t)(m - MP) * D;
          const int cond = m < MP ? 0 : 1 + ((m - MP) >> 10);
          f32x4 v[4]; float sq = 0.f;
#pragma unroll
          for (int j = 0; j < 4; ++j) { v[j] = *(const f32x4*)(xrow + 4 * (lane + 64 * j)); sq += (v[j][0] * v[j][0] + v[j][1] * v[j][1]) + (v[j][2] * v[j][2] + v[j][3] * v[j][3]); }
          sq = wave_sum_dpp(sq); if (lane == 0) ss0[m] = sq;
          f32x4 sc[4];
#pragma unroll
          for (int j = 0; j < 4; ++j) sc[j] = *(const f32x4*)(scale + cond * 6144 + 4 * (lane + 64 * j));
#pragma unroll
          for (int j = 0; j < 4; ++j) { const f32x4 h = v[j] * gv[j] * (1.f + sc[j]); u32x2 o; o.x = pk2(h[0], h[1]); o.y = pk2(h[2], h[3]);
              *(u32x2*)(H + (size_t)m * D + 4 * (lane + 64 * j)) = o; }
      } }
    for (int it = gw; it < 4 * 8192; it += NGW) {
        const int l = it >> 13, which = (it >> 12) & 1, n = it & 4095, i = l >> 1; const bool conv = (l & 1) != 0;
        const int N = which ? 4096 : (conv ? 2048 : 3072);
        if (n >= N) continue;
        const bf16* wrow = Wt + (which ? W_UP + (size_t)l * 4 * MEL : (conv ? W_PW1 + (size_t)i * 2 * MEL : W_QKV + (size_t)i * 3 * MEL)) + (size_t)n * D;
        float wv[16];
#pragma unroll
        for (int jj = 0; jj < 4; ++jj) { const u32x2 w = *(const u32x2*)(wrow + 4 * (lane + 64 * jj)); wv[4 * jj] = bflo(w.x); wv[4 * jj + 1] = bfhi(w.x); wv[4 * jj + 2] = bflo(w.y); wv[4 * jj + 3] = bfhi(w.y); }
#pragma unroll
        for (int cond = 0; cond < 5; ++cond) { const float* sh = mod + (size_t)(l * 5 + cond) * 6144 + (which ? 3 : 0) * 1024; float dot = 0.f;
#pragma unroll
            for (int jj = 0; jj < 4; ++jj) { const f32x4 s4 = *(const f32x4*)(sh + 4 * (lane + 64 * jj)); dot += (s4[0] * wv[4 * jj] + s4[1] * wv[4 * jj + 1]) + (s4[2] * wv[4 * jj + 2] + s4[3] * wv[4 * jj + 3]); }
            dot = wave_sum_dpp(dot); if (lane == 0) shw[(size_t)((l * 2 + which) * 5 + cond) * 4096 + n] = dot; }
    }
}

constexpr float SCL = 0.125f * 1.4426950408889634f, LOG2E = 1.4426950408889634f;
__device__ __forceinline__ void vt_write(LAS bf16* Vt, int pitch, int slot, int chunk, u32x4 v) {
    LAS bf16* p = Vt + (8 * chunk) * pitch + (slot ^ (chunk << 2));
    p[0] = (bf16)(v.x & 0xffffu); p[pitch] = (bf16)(v.x >> 16); p[2 * pitch] = (bf16)(v.y & 0xffffu); p[3 * pitch] = (bf16)(v.y >> 16);
    p[4 * pitch] = (bf16)(v.z & 0xffffu); p[5 * pitch] = (bf16)(v.z >> 16); p[6 * pitch] = (bf16)(v.w & 0xffffu); p[7 * pitch] = (bf16)(v.w >> 16);
}
template <int NB> __device__ __forceinline__ void softmax_part(f32x4 (&s)[NB], float& mx_out, float& sum_out, int lane, float m_floor = -INFINITY) {
    float mx = m_floor;
#pragma unroll
    for (int b = 0; b < NB; ++b) mx = fmaxf(mx, fmaxf(fmaxf(s[b][0], s[b][1]), fmaxf(s[b][2], s[b][3])));
    mx = fmaxf(mx, shx(mx, 16, lane)); mx = fmaxf(mx, shx(mx, 32, lane));
    float sum = 0.f;
#pragma unroll
    for (int b = 0; b < NB; ++b) {
#pragma unroll
        for (int e = 0; e < 4; ++e) { s[b][e] = __builtin_amdgcn_exp2f(s[b][e] - mx); sum += s[b][e]; } }
    sum += shx(sum, 16, lane); sum += shx(sum, 32, lane);
    mx_out = mx; sum_out = sum;
}
__device__ __forceinline__ bf16x8 pack_p(const f32x4& a, const f32x4& b) {
    u32x4 w; w.x = pk2(a[0], a[1]); w.y = pk2(a[2], a[3]); w.z = pk2(b[0], b[1]); w.w = pk2(b[2], b[3]); return __builtin_bit_cast(bf16x8, w);
}
__device__ __forceinline__ bf16x8 vt_read(const LAS bf16* p0, const LAS bf16* p1) {
    const s16x4 a = *(const LAS s16x4*)p0, b = *(const LAS s16x4*)p1; return (bf16x8){a[0], a[1], a[2], a[3], b[0], b[1], b[2], b[3]};
}
__device__ __forceinline__ f32x4 qk_block(const bf16* kp, const bf16x8& qf0, const bf16x8& qf1) {
    const bf16x8 k0 = *(const bf16x8*)kp, k1 = *(const bf16x8*)(kp + 32);
    f32x4 a = __builtin_amdgcn_mfma_f32_16x16x32_bf16(k0, qf0, (f32x4){0.f, 0.f, 0.f, 0.f}, 0, 0, 0);
    return __builtin_amdgcn_mfma_f32_16x16x32_bf16(k1, qf1, a, 0, 0, 0);
}
#define PV16(o, s, SLOT_EXPR, PITCH_) do { _Pragma("unroll") for (int pp = 0; pp < 8; ++pp) { const bf16x8 pf = pack_p(s[2 * pp], s[2 * pp + 1]); const int slot0 = (SLOT_EXPR); \
        _Pragma("unroll") for (int db = 0; db < 4; ++db) { const LAS bf16* vr = Vt + (16 * db + l15) * (PITCH_); const int sw_ = (2 * db + (l15 >> 3)) << 2; \
            o[db] = __builtin_amdgcn_mfma_f32_16x16x32_bf16(vt_read(vr + (slot0 ^ sw_), vr + ((slot0 + 16) ^ sw_)), pf, o[db], 0, 0, 0); } } } while (0)

#ifndef CBN
#define CBN 4
#endif
__device__ __forceinline__ void attn_phase(const bf16* Qb, const bf16* Kb, const bf16* Vb, bf16* Ob, const bf16* CK, const bf16* CV, const float* rpb  ,
                                           int li, LAS unsigned char* lds, int tid, int lane, int wave, int G, int bid, int ulo, int uhi) {
    LAS bf16* Vt = (LAS bf16*)lds; LAS float* rpl = (LAS float*)(lds + 110592); LAS unsigned char* Kc = lds + LDS_KC;
    for (int u = bid + ulo; u < uhi; u += G) {
        int lz_ = lane; asm volatile("" : "+v"(lz_));
        const int l15 = lz_ & 15, g = lz_ >> 4;
        if (u < 512) {
            const int b = u >> 4, h = u & 15; constexpr int PITCH = 264;
            const int qrow0 = b * 256 + 32 * wave + l15;
            const bf16x8 qa0 = *(const bf16x8*)(Qb + (size_t)qrow0 * D + h * 64 + 8 * g), qa1 = *(const bf16x8*)(Qb + (size_t)qrow0 * D + h * 64 + 32 + 8 * g);
            const bf16x8 qb0 = *(const bf16x8*)(Qb + (size_t)(qrow0 + 16) * D + h * 64 + 8 * g), qb1 = *(const bf16x8*)(Qb + (size_t)(qrow0 + 16) * D + h * 64 + 32 + 8 * g);
            SB0();
            { int t2 = tid; asm volatile("" : "+v"(t2));
              u32x4 v[4], kv[4];
#pragma unroll
              for (int it = 0; it < 4; ++it) { const int idx = t2 + NTHR * it, key = idx >> 3, chunk = idx & 7; const size_t off = (size_t)(b * 256 + key) * D + h * 64 + 8 * chunk;
                  v[it] = *(const u32x4*)(Vb + off); kv[it] = *(const u32x4*)(Kb + off); }
              SB0();
#pragma unroll
              for (int it = 0; it < 4; ++it) { const int idx = t2 + NTHR * it, key = idx >> 3, chunk = idx & 7;
                  *(LAS u32x4*)(Kc + key * 144 + chunk * 16) = kv[it];
                  vt_write(Vt, PITCH, key, chunk, v[it]); } }
            __syncthreads();
            SB0();
            f32x4 s0[16], s1[16];
            { const LAS unsigned char* kl = Kc + l15 * 144 + g * 16;
              sfor<16>([&](auto I) __attribute__((always_inline)) { constexpr int kb = decltype(I)::value;
                const bf16x8 k0 = *(const LAS bf16x8*)(kl + kb * (16 * 144)), k1 = *(const LAS bf16x8*)(kl + kb * (16 * 144) + 64);
                f32x4 a = __builtin_amdgcn_mfma_f32_16x16x32_bf16(k0, qa0, (f32x4){0.f, 0.f, 0.f, 0.f}, 0, 0, 0); s0[kb] = __builtin_amdgcn_mfma_f32_16x16x32_bf16(k1, qa1, a, 0, 0, 0) * SCL;
                f32x4 c = __builtin_amdgcn_mfma_f32_16x16x32_bf16(k0, qb0, (f32x4){0.f, 0.f, 0.f, 0.f}, 0, 0, 0); s1[kb] = __builtin_amdgcn_mfma_f32_16x16x32_bf16(k1, qb1, c, 0, 0, 0) * SCL; }); }
            { float mx, sum; softmax_part<16>(s0, mx, sum, lane);
              f32x4 o[4];
#pragma unroll
              for (int db = 0; db < 4; ++db) o[db] = (f32x4){0.f, 0.f, 0.f, 0.f};
              PV16(o, s0, 32 * pp + 4 * g, PITCH);
              const float rl = 1.0f / sum;
#pragma unroll
              for (int db = 0; db < 4; ++db) { const f32x4 ov = o[db] * rl; u32x2 w; w.x = pk2(ov[0], ov[1]); w.y = pk2(ov[2], ov[3]);
                  *(u32x2*)(Ob + (size_t)qrow0 * D + h * 64 + 16 * db + 4 * g) = w; } }
            { float mx, sum; softmax_part<16>(s1, mx, sum, lane);
              f32x4 o[4];
#pragma unroll
              for (int db = 0; db < 4; ++db) o[db] = (f32x4){0.f, 0.f, 0.f, 0.f};
              PV16(o, s1, 32 * pp + 4 * g, PITCH);
              const float rl = 1.0f / sum;
#pragma unroll
              for (int db = 0; db < 4; ++db) { const f32x4 ov = o[db] * rl; u32x2 w; w.x = pk2(ov[0], ov[1]); w.y = pk2(ov[2], ov[3]);
                  *(u32x2*)(Ob + (size_t)(qrow0 + 16) * D + h * 64 + 16 * db + 4 * g) = w; } }
            __syncthreads();
        } else {
            const int ui = u - 512, xcd = ui & 7, idx = (ui >> 3) & 63, uu = (G == 256) ? ((xcd * 8 + (idx >> 3)) << 3) + (idx & 7) : ui;
            const int b = uu >> 7, h = (uu >> 3) & 15, rp = uu & 7, r0 = 2 * rp; constexpr int PITCH = 840;
            const int rs0 = min(max(r0 - 4, 0), 8);
            const size_t tokb = (size_t)MP + (size_t)b * 1024;
            const int r = r0 + (wave >> 2), j = wave & 3, rs = min(max(r - 4, 0), 8), rrel = rs - rs0, kcs = min(max(16 * j - 8, 0), 32);
            const int qcol = 16 * j + l15, wst = min(max(qcol - 8, 0), 48);
            const size_t qtok = tokb + r * 64 + qcol;
            const bf16* kloc = Kb + (tokb + rs * 64 + kcs + l15) * D + h * 64 + 8 * g;
            bf16x8 kf[16][2];
#define LOAD_KLOC(H) sfor<8>([&](auto I) __attribute__((always_inline)) { constexpr int lb = 8 * (H) + decltype(I)::value; const bf16* kp = kloc + (size_t)((lb >> 1) * 64 + 16 * (lb & 1)) * D; kf[lb][0] = *(const bf16x8*)kp; kf[lb][1] = *(const bf16x8*)(kp + 32); })
            LOAD_KLOC(0);
            const bf16x8 qf0 = *(const bf16x8*)(Qb + qtok * D + h * 64 + 8 * g), qf1 = *(const bf16x8*)(Qb + qtok * D + h * 64 + 32 + 8 * g);
            SB0();
            { int t2 = tid; asm volatile("" : "+v"(t2));
              u32x4 vv[13], kv[4];
#pragma unroll
              for (int it = 0; it < 13; ++it) { const int idx = t2 + NTHR * it, slot = idx >> 3, chunk = idx & 7;
                  const bf16* src = (slot < 576) ? Vb + (tokb + min(rs0 + (slot >> 6), 15) * 64 + (slot & 63)) * D + h * 64 : CV + ((size_t)(b * 2 + li) * 256 + (slot - 576)) * D + h * 64;
                  vv[it] = *(const u32x4*)(src + 8 * chunk); }
#pragma unroll
              for (int it = 0; it < 4; ++it) { const int idx = t2 + NTHR * it, key = idx >> 3, chunk = idx & 7;
                  kv[it] = *(const u32x4*)(CK + ((size_t)(b * 2 + li) * 256 + key) * D + h * 64 + 8 * chunk); }
              const float rv = rpb[h * 465 + min(t2, 464)];
              SB0();
#pragma unroll
              for (int it = 0; it < 13; ++it) { const int idx = t2 + NTHR * it; vt_write(Vt, PITCH, idx >> 3, idx & 7, vv[it]); }
#pragma unroll
              for (int it = 0; it < 4; ++it) { const int idx = t2 + NTHR * it; *(LAS u32x4*)(Kc + (idx >> 3) * 144 + (idx & 7) * 16) = kv[it]; }
              if (t2 < 465) rpl[t2] = rv; }
            SB0(); LOAD_KLOC(1); SB0();
            __syncthreads();
            SB0();
            f32x4 o1[4]; float m1, l1, m2, l2;
#pragma unroll
            for (int db = 0; db < 4; ++db) o1[db] = (f32x4){0.f, 0.f, 0.f, 0.f};
            {
                int dcv[8]; unsigned vmask = 0u;
#pragma unroll
                for (int ce = 0; ce < 8; ++ce) { const int kc = kcs + 16 * (ce >> 2) + 4 * g + (ce & 3); vmask |= ((kc >= wst) && (kc < wst + 16)) ? (1u << ce) : 0u; dcv[ce] = min(max(kc - qcol + 15, 0), 30); }
                f32x4 s[16];
#define QK_LOC(H) sfor<8>([&](auto I) __attribute__((always_inline)) { constexpr int lb = 8 * (H) + decltype(I)::value, krow = lb >> 1, ch = lb & 1; \
                    f32x4 a = __builtin_amdgcn_mfma_f32_16x16x32_bf16(kf[lb][0], qf0, (f32x4){0.f, 0.f, 0.f, 0.f}, 0, 0, 0); a = __builtin_amdgcn_mfma_f32_16x16x32_bf16(kf[lb][1], qf1, a, 0, 0, 0); \
                    const LAS float* rp_row = rpl + (rs + krow - r + 7) * 31; float bias[4]; \
                    _Pragma("unroll") for (int e = 0; e < 4; ++e) bias[e] = rp_row[dcv[ch * 4 + e]]; \
                    _Pragma("unroll") for (int e = 0; e < 4; ++e) { const float t = a[e] * SCL + bias[e] * LOG2E; a[e] = ((vmask >> (ch * 4 + e)) & 1u) ? t : -INFINITY; } \
                    s[lb] = a; })
                QK_LOC(0); QK_LOC(1); SB0();
                softmax_part<16>(s, m1, l1, lane);
                PV16(o1, s, (rrel + pp) * 64 + kcs + 4 * g, PITCH);
            }
            SB0();
            {
                f32x4 s[16];
                { const LAS unsigned char* kl = Kc + l15 * 144 + g * 16;
                  sfor<16>([&](auto I) __attribute__((always_inline)) { constexpr int cb = decltype(I)::value;
                    const bf16x8 k0 = *(const LAS bf16x8*)(kl + cb * (16 * 144)), k1 = *(const LAS bf16x8*)(kl + cb * (16 * 144) + 64);
                    f32x4 a = __builtin_amdgcn_mfma_f32_16x16x32_bf16(k0, qf0, (f32x4){0.f, 0.f, 0.f, 0.f}, 0, 0, 0); s[cb] = __builtin_amdgcn_mfma_f32_16x16x32_bf16(k1, qf1, a, 0, 0, 0) * SCL; }); }
                softmax_part<16>(s, m2, l2, lane, m1);
                const float a1 = __builtin_amdgcn_exp2f(m1 - m2);
#pragma unroll
                for (int db = 0; db < 4; ++db) o1[db] = o1[db] * a1;
                l1 = l1 * a1 + l2;
                PV16(o1, s, 576 + 32 * pp + 4 * g, PITCH);
            }
            const float rl = 1.0f / l1;
            int r2_ = r; asm volatile("" : "+s"(r2_));
            const size_t qtok2 = tokb + r2_ * 64 + qcol;
#pragma unroll
            for (int db = 0; db < 4; ++db) { const f32x4 ov = o1[db] * rl; u32x2 w; w.x = pk2(ov[0], ov[1]); w.y = pk2(ov[2], ov[3]);
                *(u32x2*)(Ob + qtok2 * D + h * 64 + 16 * db + 4 * g) = w; }
            __syncthreads();
        }
    }
}

#define RLX_AGENT __ATOMIC_RELAXED, __HIP_MEMORY_SCOPE_AGENT
#define XB_TMO      128
#define XB_XCNT(j)  (256  + 64 * (j))
#define XB_XSUB(j)  (1280 + 64 * (j))
#define XB_XGEN(j)  (2304 + 64 * (j))
#define XB_TOP      3328
#define XB_TOPGEN   3392
#define XCD_BAR_WORDS 3456
#define XB_SPIN_CAP (1u << 18)

__device__ __forceinline__ unsigned xb_ld(unsigned* p)              { return __hip_atomic_load(p, __ATOMIC_RELAXED, __HIP_MEMORY_SCOPE_AGENT); }
__device__ __forceinline__ unsigned xb_add(unsigned* p, unsigned v) { return __hip_atomic_fetch_add(p, v, __ATOMIC_RELAXED, __HIP_MEMORY_SCOPE_AGENT); }
__device__ __forceinline__ unsigned xb_xcc_id() { return (unsigned)__builtin_amdgcn_s_getreg((3 << 11) | 20) & 0xFu; }
#define XB_SPIN(cond, bar) do { unsigned _sp = 0; while (cond) { __builtin_amdgcn_s_sleep(1); \
    if ((++_sp & 255u) == 0u) { if (xb_ld(&(bar)[XB_TMO])) break; if (_sp > XB_SPIN_CAP) { atomicAdd(&(bar)[XB_TMO], 1u); break; } } } } while (0)

struct XcdBarrier {
    unsigned* bar; unsigned x;
    volatile LAS unsigned* st;
};

__device__ __forceinline__ XcdBarrier xcd_barrier_post(unsigned* bar, volatile LAS unsigned* st) {
    XcdBarrier b; b.bar = bar; b.x = xb_xcc_id(); b.st = st;
    if (threadIdx.x == 0) (void)xb_add(&bar[XB_XCNT(b.x)], 1u);
    return b;
}
__device__ __forceinline__ void xcd_barrier_complete(unsigned* bar, unsigned x, unsigned& nloc, unsigned& nx) {
    const unsigned G = gridDim.x * gridDim.y * gridDim.z;
    unsigned sum, cnt, mine, sp = 0u;
    for (;;) {
        sum = 0u; cnt = 0u; mine = 0u;
#pragma unroll
        for (unsigned j = 0; j < 16; ++j) { const unsigned c = xb_ld(&bar[XB_XCNT(j)]); sum += c; cnt += (c > 0u) ? 1u : 0u; mine = (j == x) ? c : mine; }
        if (sum == G) break;
        __builtin_amdgcn_s_sleep(1);
        if ((++sp & 255u) == 0u) { if (xb_ld(&bar[XB_TMO])) break; if (sp > XB_SPIN_CAP) { atomicAdd(&bar[XB_TMO], 1u); break; } }
    }
    nloc = mine > 0u ? mine : 1u; nx = cnt > 0u ? cnt : 1u;
}

__device__ __forceinline__ void xcd_barrier(const XcdBarrier& b) {
    asm volatile("s_waitcnt vmcnt(0)" ::: "memory");
    __syncthreads();
    if (threadIdx.x == 0) {
        unsigned* bar = b.bar;
        __builtin_amdgcn_s_waitcnt(0);
        unsigned nloc = b.st[0], nx = b.st[1];
        if (nloc == 0u) { xcd_barrier_complete(bar, b.x, nloc, nx); b.st[0] = nloc; b.st[1] = nx; }
        const unsigned old = xb_add(&bar[XB_XSUB(b.x)], 1u);
        const unsigned gen = old / nloc;
        if (old + 1u == (gen + 1u) * nloc) {
            __builtin_amdgcn_fence(__ATOMIC_RELEASE, "agent");
            asm volatile("s_waitcnt vmcnt(0)" ::: "memory");
            const unsigned og = xb_add(&bar[XB_TOP], 1u);
            if (og + 1u == (gen + 1u) * nx) xb_add(&bar[XB_TOPGEN], 1u);
            else XB_SPIN(xb_ld(&bar[XB_TOPGEN]) == gen, bar);
            __builtin_amdgcn_fence(__ATOMIC_ACQUIRE, "agent");
            asm volatile("s_waitcnt vmcnt(0)" ::: "memory");
        } else {
            XB_SPIN(xb_ld(&bar[XB_TOPGEN]) == gen, bar);
            __builtin_amdgcn_fence(__ATOMIC_ACQUIRE, "agent");
            asm volatile("s_waitcnt vmcnt(0)" ::: "memory");
        }
    }
    __syncthreads();
}

constexpr int NPH = 2 + 5 * NL + 1;
struct Args { const float* in[21]; float* out; unsigned char* ws; int nprog, pad; int prog[48]; };
typedef const __attribute__((address_space(4))) Args* KArgPtr;
__global__ void __launch_bounds__(NTHR, 2) fwd_kernel(Args a_unused) {
    extern __shared__ __attribute__((aligned(16))) unsigned char lds_raw[];
    LAS unsigned char* lds = (LAS unsigned char*)lds_raw;
    cg::grid_group grid = cg::this_grid();
    const int wave0 = __builtin_amdgcn_readfirstlane((int)threadIdx.x >> 6);
    { volatile LAS unsigned* st0 = (volatile LAS unsigned*)(lds + LDS_ST); if (threadIdx.x < 2) st0[threadIdx.x] = 0u; }
    __syncthreads();
    XcdBarrier xbar; { KArgPtr kpb = (KArgPtr)__builtin_amdgcn_kernarg_segment_ptr(); xbar.bar = (unsigned*)kpb->ws; xbar.x = 0; xbar.st = (volatile LAS unsigned*)(lds + LDS_ST);
        if (blockIdx.x == 0) { for (int wI = threadIdx.x; wI < XCD_BAR_WORDS; wI += NTHR) __hip_atomic_store(xbar.bar + wI, 0u, __ATOMIC_RELAXED, __HIP_MEMORY_SCOPE_AGENT); } }
    int nprog; { KArgPtr kp0 = (KArgPtr)__builtin_amdgcn_kernarg_segment_ptr(); nprog = kp0->nprog; }
    for (int pc = 0; pc < nprog; ++pc) {
        KArgPtr kp = (KArgPtr)__builtin_amdgcn_kernarg_segment_ptr(); asm volatile("" : "+s"(kp));
        int z_ = 0; asm volatile("" : "+s"(z_));
        const int lane_ = (int)__builtin_amdgcn_mbcnt_hi(~0u, __builtin_amdgcn_mbcnt_lo(~0u, (unsigned)z_)); const int tid_ = wave0 * 64 + lane_;
        int bid_ = (int)__builtin_amdgcn_workgroup_id_x(), G_ = (int)gridDim.x; asm volatile("" : "+s"(bid_), "+s"(G_));
        const int pe_ = kp->prog[pc]; const int ph = pe_ & 63, amode = pe_ >> 6;
        const int tid = tid_, lane = lane_, wave = wave0, G = G_, bid = bid_;
        const int gw = bid * NWAVES + wave, NGW = G * NWAVES;
        Ptrs P; P = Ptrs{kp->in[0], kp->in[1], kp->in[2], kp->in[3], kp->in[4], kp->in[5], kp->in[6], kp->in[7], kp->in[8], kp->in[9], kp->in[10], kp->in[11], kp->in[12], kp->in[13], kp->in[14], kp->in[15], kp->in[16], kp->in[17], kp->in[18], kp->in[19], kp->in[20]};
        unsigned char* ws = kp->ws; float* outp = kp->out;
        float* mod = (float*)(ws + WS_MOD); bf16* Wt = (bf16*)(ws + WS_W); bf16* X = (bf16*)(ws + WS_X); bf16* H = (bf16*)(ws + WS_H);
        bf16* R = (bf16*)(ws + WS_R); bf16* Qb = R; bf16* Kb = R + (size_t)M * D; bf16* Vb = R + (size_t)2 * M * D; bf16* Ob = R + (size_t)3 * M * D;
        bf16* Ub = R; bf16* Vc = R + (size_t)M * D; bf16* Fb = R;
        const bf16* CK = (const bf16*)(ws + WS_CK); const bf16* CV = (const bf16*)(ws + WS_CV);
        float* out_y = outp; float* out_ck = outp + (size_t)M * D; float* out_cv = out_ck + (size_t)32 * 2 * 256 * 1024;
        float* SS = (float*)(ws + WS_SS); float* SHW = (float*)(ws + WS_SHW);
        if (ph == 0) { p0_phase(P, ws, lds, tid, lane, wave, G, bid); }
        else if (ph == 1) { prep_phase(P.x_prompt, P.x_sample, H, SS, P.norm_g, mod + 1 * 1024, mod, Wt, SHW, gw, NGW, lane); }
        else if (ph == NPH - 1) { final_norm_phase(X, out_y, P.final_g, gw, NGW, lane); }
        else if (ph >= 60) { }
        else {
            const int l = (ph - 2) / 5, s = (ph - 2) % 5, i = l >> 1; const bool conv = (l & 1) != 0;
            const float* modl = mod + (size_t)l * 5 * 6144;
            if (s == 0) {
                const float* ssl = SS + (size_t)(2 * l) * M; const float* shl = SHW + (size_t)((2 * l) * 5) * 4096;
                if (!conv) { pg8::Gemm gm{H, Wt + W_QKV + (size_t)i * 3 * MEL, M, 3 * D, D}; pg8::StaticOrder S; S.init(M, 3 * D, G, bid);
                    pg8::EpiQKV E{ssl, shl, Qb, (size_t)M * D, out_ck + (size_t)i * 256 * 1024, (size_t)32 * 2 * 256 * 1024};
                    pg8::gemm_phase<pg8::EpiQKV, pg8::StaticOrder, true, true>(lds, gm, S, E, tid); }
                else { pg8::Gemm gm{H, Wt + W_PW1 + (size_t)i * 2 * MEL, M, 2 * D, D}; pg8::StaticOrder S; S.init(M, 2 * D, G, bid);
                    pg8::EpiGLU E{ssl, shl, Ub};
                    pg8::gemm_phase<pg8::EpiGLU, pg8::StaticOrder, true, true>(lds, gm, S, E, tid); }
            } else if (s == 1) {
                if (!conv) attn_phase(Qb, Kb, Vb, Ob, CK, CV, P.rpb + (size_t)i * 16 * 15 * 31, i, lds, tid, lane, wave, G, bid, amode == 2 ? 512 : 0, amode == 1 ? 512 : 1024);
                else conv_phase(Ub, Vc, P.w_dw + (size_t)i * 31 * D, P.b_dw + i * D, P.ln_g + i * D, P.ln_b + i * D, lds, tid, lane, wave, G, bid);
            } else if (s == 2 || s == 4) {
                pg8::Gemm gm; pg8::EpiRes E;
                if (s == 2) { gm = pg8::Gemm{conv ? Vc : Ob, Wt + (conv ? W_PW2 : W_O) + (size_t)i * MEL, M, D, D};
                    E = pg8::EpiRes{P.x_prompt, P.x_sample, l == 0 ? (const bf16*)nullptr : X, X, modl + 2 * 1024, H, P.norm_g + (l * 2 + 1) * D, modl + 4 * 1024, SS + (size_t)(2 * l + 1) * M}; }
                else { gm = pg8::Gemm{Fb, Wt + W_DOWN + (size_t)l * 4 * MEL, M, D, FF};
                    E = pg8::EpiRes{P.x_prompt, P.x_sample, X, X, modl + 5 * 1024, l < NL - 1 ? H : nullptr, P.norm_g + ((l + 1) * 2) * D, modl + 5 * 6144 + 1 * 1024, SS + (size_t)(2 * l + 2) * M}; }
                pg8::StaticOrder S; S.init(M, D, G, bid);
                pg8::gemm_phase<pg8::EpiRes, pg8::StaticOrder, true, true>(lds, gm, S, E, tid);
            } else {
#ifdef UP256
                pg8::Gemm gm{H, Wt + W_UP + (size_t)l * 4 * MEL, M, FF, D}; pg8::StaticOrder256 S; S.init(M, FF, G, bid);
                pg8::EpiUp256 E{SS + (size_t)(2 * l + 1) * M, SHW + (size_t)((2 * l + 1) * 5) * 4096, Fb, FF};
                pg8::gemm_phase256<pg8::EpiUp256, pg8::StaticOrder256, true, true>(lds, gm, S, E, tid);
#else
                pg8::Gemm gm{H, Wt + W_UP + (size_t)l * 4 * MEL, M, FF, D}; pg8::StaticOrder S; S.init(M, FF, G, bid);
                pg8::EpiUp E{SS + (size_t)(2 * l + 1) * M, SHW + (size_t)((2 * l + 1) * 5) * 4096, Fb, FF};
                pg8::gemm_phase<pg8::EpiUp, pg8::StaticOrder, true, true>(lds, gm, S, E, tid);
#endif
            }
        }
        if (pc + 1 < nprog) { if (pc == 0) { grid.sync(); xbar = xcd_barrier_post(xbar.bar, xbar.st); } else xcd_barrier(xbar); }
    }
}

#ifndef SINGLE_LAUNCH
#define SINGLE_LAUNCH 0
#endif
extern "C" void kernel_launch(void* const* d_in, const int* in_sizes, int n_in, void* d_out, int out_size, void* d_ws, size_t ws_size, hipStream_t stream) {
    static int grid = 0;
    if (grid == 0) {
        if (n_in != 21 || ws_size < WS_END) { fprintf(stderr, "kernel_launch: unexpected n_in %d / ws_size %zu\n", n_in, ws_size); grid = -1; return; }
        int dev = 0, cus = 0, per_cu = 0;
        hipGetDevice(&dev); hipDeviceGetAttribute(&cus, hipDeviceAttributeMultiprocessorCount, dev);
        hipFuncSetAttribute((const void*)fwd_kernel, hipFuncAttributeMaxDynamicSharedMemorySize, LDS_BYTES);
        hipOccupancyMaxActiveBlocksPerMultiprocessor(&per_cu, (const void*)fwd_kernel, NTHR, LDS_BYTES);
        if (per_cu < 1) { fprintf(stderr, "kernel_launch: occupancy query says %d blocks/CU\n", per_cu); per_cu = 1; }
        (void)hipGetLastError();
        grid = cus * per_cu;
    }
    if (grid < 0) return;
    Args a{};
    for (int i = 0; i < 21; ++i) a.in[i] = (const float*)d_in[i];
    a.out = (float*)d_out; a.ws = (unsigned char*)d_ws;
#if SINGLE_LAUNCH
    { int n = 0;
      for (int ph = 0; ph < NPH; ++ph) { a.prog[n++] = ph;
#ifdef PROBE_ATTN_MODE
          if (ph >= 2 && ph < NPH - 1 && (ph - 2) % 5 == 1 && ((ph - 2) / 5) % 2 == 0) a.prog[n++] = ph | (PROBE_ATTN_MODE << 6);
#endif
#ifdef PROBE_EMPTY
          if (ph == 5) for (int q = 0; q < PROBE_EMPTY; ++q) a.prog[n++] = 60;
#endif
#ifdef PROBE_REPEAT_P0
          if (ph == 0) a.prog[n++] = 0;
#endif
#ifdef PROBE_REPEAT_S
          if (ph >= 2 && ph < NPH - 1 && (ph - 2) % 5 == PROBE_REPEAT_S && (PROBE_REPEAT_PAR < 0 || ((ph - 2) / 5) % 2 == PROBE_REPEAT_PAR)) a.prog[n++] = ph;
#endif
      }
      a.nprog = n; }
    void* args[] = {&a};
    hipError_t e = hipLaunchCooperativeKernel((const void*)fwd_kernel, dim3(grid), dim3(NTHR), args, LDS_BYTES, stream);
    if (e != hipSuccess) fprintf(stderr, "cooperative launch failed: %s (grid %d)\n", hipGetErrorString(e), grid);
#else
    for (int ph = 0; ph < NPH; ++ph) { a.nprog = 1; a.prog[0] = ph; hipLaunchKernelGGL(fwd_kernel, dim3(grid), dim3(NTHR), LDS_BYTES, stream, a); }
#endif
}
```

```cpp
#define SINGLE_LAUNCH 1
#define UP256 1
#include <hip/hip_runtime.h>
#include <hip/hip_cooperative_groups.h>
#include <cstdio>
#include <cstdint>
#include <cmath>
#include <utility>
namespace cg = cooperative_groups;
namespace pg8 {
#define PG8_LAS __attribute__((address_space(3)))
typedef unsigned short bf16_t;
typedef short bf16x8 __attribute__((ext_vector_type(8)));
typedef float f32x4 __attribute__((ext_vector_type(4)));
typedef unsigned u32x4 __attribute__((ext_vector_type(4)));
constexpr int RM = 192;
constexpr int BM = 256, BK = 64, HALF = 128, HTB = HALF * BK * 2  , STAGE_BYTES = 8 * HTB, NXCD = 8, WGM = 8;

__host__ __device__ __forceinline__ int lds_byte(int r, int c) { const int st = (r >> 4) * 2 + (c >> 5), rr = r & 15, cc = c & 31, ob = rr * 64 + cc * 2; return st * 1024 + (ob ^ (((ob >> 9) & 1) << 5)); }
__host__ __device__ __forceinline__ void stage_rc(int b, int& R, int& C) { const int st = b / 1024, sb = b % 1024, swz = sb ^ (((sb >> 9) & 1) << 5); R = (st >> 1) * 16 + swz / 64; C = (st & 1) * 32 + (swz % 64) / 2; }
__host__ __device__ __forceinline__ int perm32(int rho) { const int n = rho >> 4, i = rho & 15; return 8 * (i >> 2) + 4 * n + (i & 3); }

struct Unit { int pm, pn; };
struct Gemm { const bf16_t* A; const bf16_t* Bt; int M, N, K; };

struct StaticOrder {
    int nM, nN, nwg, G, c;
    __host__ __device__ void init(int M, int N, int G_, int c_) { nM = M / RM; nN = N / BM; nwg = nM * nN; G = G_; c = c_; }
    __host__ __device__ bool next(int i, Unit& u) const {
        const long L = (long)i * G + c; if (L >= nwg) return false;
        int wgid = (int)L; { const int q = nwg / NXCD, r = nwg % NXCD, xcd = wgid % NXCD, off = wgid / NXCD; wgid = (xcd < r ? xcd * (q + 1) : r * (q + 1) + (xcd - r) * q) + off; }
        const int nig = WGM * nN, gid = wgid / nig, fm = gid * WGM, gsz = (nM - fm) < WGM ? (nM - fm) : WGM;
        u.pm = fm + ((wgid % nig) % gsz); u.pn = (wgid % nig) / gsz; return true;
    }
    __device__ __forceinline__ void a_ready(const Unit&) const {}
    __device__ __forceinline__ void done(const Unit&) const {}
};

__device__ __forceinline__ unsigned cvt_pk_bf16(float lo, float hi) { unsigned r; asm volatile("v_cvt_pk_bf16_f32 %0, %1, %2" : "=v"(r) : "v"(lo), "v"(hi)); return r; }
typedef float f32x2 __attribute__((ext_vector_type(2)));
__device__ __forceinline__ int cond_of_row(int r) { return r < 8192 ? 0 : 1 + ((r - 8192) >> 10); }
__device__ __forceinline__ int half_row0(int ai, int wr) { return ai == 0 ? wr * 64 : 128 + wr * 32; }
#define EPI_MLOOP(ai, m) _Pragma("unroll") for (int m = 0; m < 4; ++m) if (ai == 0 || m < 2)
struct EpiQKV {
    static constexpr bool PERM = true, AFTER_DRAIN = false;
    const float* ss; const float* shw;
    bf16_t* Q; size_t qkv_stride; float* ck; size_t ckv_stride;
    __device__ __forceinline__ void operator()(const f32x4 (&acc)[2][2][4][2], const Unit& u, int wr, int wc, int fr, int fq) const {
        const int t = u.pn >> 2;
        bf16_t* base = Q + (size_t)t * qkv_stride;
        const int col0 = (u.pn & 3) * BM + wc * 32 + 8 * fq;
        float* cbase = ck + (size_t)(t > 0 ? t - 1 : 0) * ckv_stride + col0;
#pragma unroll
        for (int ai = 0; ai < 2; ++ai) { const int rbase = u.pm * RM + half_row0(ai, wr) + fr; const bool wc_ = (t > 0) && (rbase < 8192);
            const float* sp = shw + cond_of_row(rbase) * 4096 + u.pn * BM + wc * 32 + 8 * fq;
            f32x4 sv[2][2];
#pragma unroll
            for (int bj = 0; bj < 2; ++bj) { sv[bj][0] = *(const f32x4*)(sp + bj * HALF); sv[bj][1] = *(const f32x4*)(sp + bj * HALF + 4); }
            float rr[4];
            EPI_MLOOP(ai, m) rr[m] = ss[rbase + m * 16];
            EPI_MLOOP(ai, m) { const int row = rbase + m * 16; bf16_t* rowp = base + (size_t)row * 1024 + col0;
                const float r = __builtin_amdgcn_rsqf(rr[m] * (1.f / 1024.f) + 1e-6f);
                float* cp0 = cbase + ((size_t)(row >> 8) * 2 * 256 + (row & 255)) * 1024;
#pragma unroll
                for (int bj = 0; bj < 2; ++bj) { const f32x4 v0 = acc[ai][bj][m][0] * r + sv[bj][0], v1 = acc[ai][bj][m][1] * r + sv[bj][1];
                    u32x4 w; w.x = cvt_pk_bf16(v0[0], v0[1]); w.y = cvt_pk_bf16(v0[2], v0[3]); w.z = cvt_pk_bf16(v1[0], v1[1]); w.w = cvt_pk_bf16(v1[2], v1[3]);
                    *(u32x4*)(rowp + bj * HALF) = w;
                    if (wc_) { float* cp = cp0 + bj * HALF; __builtin_nontemporal_store(v0, (f32x4*)cp); __builtin_nontemporal_store(v1, (f32x4*)(cp + 4)); } } } }
    }
};
struct EpiUp {
    static constexpr bool PERM = true, AFTER_DRAIN = false;
    const float* ss; const float* shw; bf16_t* O; int ldc;
    __device__ __forceinline__ void operator()(const f32x4 (&acc)[2][2][4][2], const Unit& u, int wr, int wc, int fr, int fq) const {
        const int col0 = u.pn * BM + wc * 32 + 8 * fq;
#pragma unroll
        for (int ai = 0; ai < 2; ++ai) { const int rbase = u.pm * RM + half_row0(ai, wr) + fr;
            const float* sp = shw + cond_of_row(rbase) * 4096 + col0;
            f32x4 sv[2][2];
#pragma unroll
            for (int bj = 0; bj < 2; ++bj) { sv[bj][0] = *(const f32x4*)(sp + bj * HALF); sv[bj][1] = *(const f32x4*)(sp + bj * HALF + 4); }
            float rr[4];
            EPI_MLOOP(ai, m) rr[m] = ss[rbase + m * 16];
            EPI_MLOOP(ai, m) { bf16_t* rowp = O + (size_t)(rbase + m * 16) * ldc + col0;
                const float r = __builtin_amdgcn_rsqf(rr[m] * (1.f / 1024.f) + 1e-6f);
#pragma unroll
                for (int bj = 0; bj < 2; ++bj) { f32x4 v0 = acc[ai][bj][m][0] * r + sv[bj][0], v1 = acc[ai][bj][m][1] * r + sv[bj][1];
#pragma unroll
                    for (int e = 0; e < 4; ++e) { const float a = fmaxf(v0[e], 0.f), b = fmaxf(v1[e], 0.f); v0[e] = a * a; v1[e] = b * b; }
                    u32x4 w; w.x = cvt_pk_bf16(v0[0], v0[1]); w.y = cvt_pk_bf16(v0[2], v0[3]); w.z = cvt_pk_bf16(v1[0], v1[1]); w.w = cvt_pk_bf16(v1[2], v1[3]);
                    *(u32x4*)(rowp + bj * HALF) = w; } } }
    }
};
struct EpiGLU {
    static constexpr bool PERM = true, AFTER_DRAIN = false;
    const float* ss; const float* shw; bf16_t* O;
    __device__ __forceinline__ void operator()(const f32x4 (&acc)[2][2][4][2], const Unit& u, int wr, int wc, int fr, int fq) const {
        const int col0 = u.pn * HALF + wc * 32 + 8 * fq;
#pragma unroll
        for (int ai = 0; ai < 2; ++ai) { const int rbase = u.pm * RM + half_row0(ai, wr) + fr;
            const float* sp = shw + cond_of_row(rbase) * 4096 + u.pn * BM + wc * 32 + 8 * fq;
            f32x4 sv[2][2];
#pragma unroll
            for (int bj = 0; bj < 2; ++bj) { sv[bj][0] = *(const f32x4*)(sp + bj * HALF); sv[bj][1] = *(const f32x4*)(sp + bj * HALF + 4); }
            float rr[4];
            EPI_MLOOP(ai, m) rr[m] = ss[rbase + m * 16];
            EPI_MLOOP(ai, m) { bf16_t* rowp = O + (size_t)(rbase + m * 16) * 1024 + col0;
                const float r = __builtin_amdgcn_rsqf(rr[m] * (1.f / 1024.f) + 1e-6f);
                f32x4 v0 = acc[ai][0][m][0] * r + sv[0][0], v1 = acc[ai][0][m][1] * r + sv[0][1]; const f32x4 g0 = acc[ai][1][m][0] * r + sv[1][0], g1 = acc[ai][1][m][1] * r + sv[1][1];
#pragma unroll
                for (int e = 0; e < 4; ++e) { v0[e] = v0[e] * __builtin_amdgcn_rcpf(1.f + __expf(-g0[e])); v1[e] = v1[e] * __builtin_amdgcn_rcpf(1.f + __expf(-g1[e])); }
                u32x4 w; w.x = cvt_pk_bf16(v0[0], v0[1]); w.y = cvt_pk_bf16(v0[2], v0[3]); w.z = cvt_pk_bf16(v1[0], v1[1]); w.w = cvt_pk_bf16(v1[2], v1[3]);
                *(u32x4*)rowp = w; } }
    }
};
struct EpiRes {
    static constexpr bool PERM = true, AFTER_DRAIN = false;
    const float* base_p; const float* base_s; const bf16_t* base_b; bf16_t* out; const float* gate;
    bf16_t* xb; const float* g_next; const float* sc_next; float* ss_next;
    __device__ __forceinline__ void operator()(const f32x4 (&acc)[2][2][4][2], const Unit& u, int wr, int wc, int fr, int fq) const {
        const int col0 = u.pn * BM + wc * 32 + 8 * fq;
        const int lane_x = fq * 16 + fr;
#pragma unroll
        for (int ai = 0; ai < 2; ++ai) { const int row0 = u.pm * RM + half_row0(ai, wr) + fr; const int cond = cond_of_row(row0);
            const float* gp = gate + cond * 6144 + col0;
            const float* bp = (row0 < 8192) ? base_p + (size_t)row0 * 1024 + col0 : base_s + (size_t)(row0 - 8192) * 1024 + col0;
            const bf16_t* bb = base_b + (size_t)row0 * 1024 + col0;
            bf16_t* op = out + (size_t)row0 * 1024 + col0;
            f32x4 gv[2][2], gs[2][2];
#pragma unroll
            for (int bj = 0; bj < 2; ++bj)
#pragma unroll
                for (int n = 0; n < 2; ++n) gv[bj][n] = *(const f32x4*)(gp + bj * HALF + n * 4);
            if (xb) { f32x4 ga[2][2], sa[2][2];
#pragma unroll
                for (int bj = 0; bj < 2; ++bj)
#pragma unroll
                    for (int n = 0; n < 2; ++n) { ga[bj][n] = *(const f32x4*)(g_next + col0 + bj * HALF + n * 4); sa[bj][n] = *(const f32x4*)(sc_next + cond * 6144 + col0 + bj * HALF + n * 4); }
#pragma unroll
                for (int bj = 0; bj < 2; ++bj)
#pragma unroll
                    for (int n = 0; n < 2; ++n) gs[bj][n] = ga[bj][n] * (1.f + sa[bj][n]); }
#pragma unroll
            for (int mp = 0; mp < 2; ++mp) if (ai == 0 || mp == 0) { f32x4 bs[2][2][2];
                if (base_b) {
#pragma unroll
                    for (int mm = 0; mm < 2; ++mm)
#pragma unroll
                        for (int bj = 0; bj < 2; ++bj) { const u32x4 w = *(const u32x4*)(bb + (size_t)((2 * mp + mm) * 16) * 1024 + bj * HALF);
                            bs[mm][bj][0] = (f32x4){__builtin_bit_cast(float, w.x << 16), __builtin_bit_cast(float, w.x & 0xffff0000u), __builtin_bit_cast(float, w.y << 16), __builtin_bit_cast(float, w.y & 0xffff0000u)};
                            bs[mm][bj][1] = (f32x4){__builtin_bit_cast(float, w.z << 16), __builtin_bit_cast(float, w.z & 0xffff0000u), __builtin_bit_cast(float, w.w << 16), __builtin_bit_cast(float, w.w & 0xffff0000u)}; }
                } else {
#pragma unroll
                    for (int mm = 0; mm < 2; ++mm)
#pragma unroll
                        for (int bj = 0; bj < 2; ++bj)
#pragma unroll
                            for (int n = 0; n < 2; ++n) bs[mm][bj][n] = __builtin_nontemporal_load((const f32x4*)(bp + (size_t)((2 * mp + mm) * 16) * 1024 + bj * HALF + n * 4));
                }
#pragma unroll
                for (int mm = 0; mm < 2; ++mm) { float sq = 0.f;
#pragma unroll
                    for (int bj = 0; bj < 2; ++bj) { const f32x4 x0 = bs[mm][bj][0] + gv[bj][0] * acc[ai][bj][2 * mp + mm][0], x1 = bs[mm][bj][1] + gv[bj][1] * acc[ai][bj][2 * mp + mm][1];
                        { u32x4 w; w.x = cvt_pk_bf16(x0[0], x0[1]); w.y = cvt_pk_bf16(x0[2], x0[3]); w.z = cvt_pk_bf16(x1[0], x1[1]); w.w = cvt_pk_bf16(x1[2], x1[3]); *(u32x4*)(op + (size_t)((2 * mp + mm) * 16) * 1024 + bj * HALF) = w; }
                        if (xb) { const f32x4 h0 = x0 * gs[bj][0], h1 = x1 * gs[bj][1]; u32x4 w; w.x = cvt_pk_bf16(h0[0], h0[1]); w.y = cvt_pk_bf16(h0[2], h0[3]); w.z = cvt_pk_bf16(h1[0], h1[1]); w.w = cvt_pk_bf16(h1[2], h1[3]);
                            *(u32x4*)(xb + (size_t)(row0 + (2 * mp + mm) * 16) * 1024 + col0 + bj * HALF) = w;
                            sq += ((x0[0] * x0[0] + x0[1] * x0[1]) + (x0[2] * x0[2] + x0[3] * x0[3])) + ((x1[0] * x1[0] + x1[1] * x1[1]) + (x1[2] * x1[2] + x1[3] * x1[3])); } }
                    if (xb) {
                        sq += __builtin_bit_cast(float, __builtin_amdgcn_ds_bpermute((lane_x ^ 16) << 2, __builtin_bit_cast(int, sq)));
                        sq += __builtin_bit_cast(float, __builtin_amdgcn_ds_bpermute((lane_x ^ 32) << 2, __builtin_bit_cast(int, sq)));
                        if (fq == 0) atomicAdd(ss_next + row0 + (2 * mp + mm) * 16, sq); } }
                asm volatile("" ::: "memory"); } }
    }
};

struct StaticOrder256 {
    int nM, nN, nwg, G, c;
    __host__ __device__ void init(int M, int N, int G_, int c_) { nM = M / BM; nN = N / BM; nwg = nM * nN; G = G_; c = c_; }
    __host__ __device__ bool next(int i, Unit& u) const {
        const long L = (long)i * G + c; if (L >= nwg) return false;
        int wgid = (int)L; { const int q = nwg / NXCD, r = nwg % NXCD, xcd = wgid % NXCD, off = wgid / NXCD; wgid = (xcd < r ? xcd * (q + 1) : r * (q + 1) + (xcd - r) * q) + off; }
        const int nig = WGM * nN, gid = wgid / nig, fm = gid * WGM, gsz = (nM - fm) < WGM ? (nM - fm) : WGM;
        u.pm = fm + ((wgid % nig) % gsz); u.pn = (wgid % nig) / gsz; return true;
    }
    __device__ __forceinline__ void a_ready(const Unit&) const {}
    __device__ __forceinline__ void done(const Unit&) const {}
};
struct EpiUp256 {
    static constexpr bool PERM = true, AFTER_DRAIN = false;
    const float* ss; const float* shw; bf16_t* O; int ldc;
    __device__ __forceinline__ void operator()(const f32x4 (&acc)[2][2][4][2], const Unit& u, int wr, int wc, int fr, int fq) const {
        const int col0 = u.pn * BM + wc * 32 + 8 * fq;
        f32x4 sv[2][2][2]; float rr[2][4];
#pragma unroll
        for (int ai = 0; ai < 2; ++ai) { const int rbase = u.pm * BM + ai * HALF + wr * 64 + fr; const float* sp = shw + cond_of_row(rbase) * 4096 + col0;
#pragma unroll
            for (int bj = 0; bj < 2; ++bj) { sv[ai][bj][0] = *(const f32x4*)(sp + bj * HALF); sv[ai][bj][1] = *(const f32x4*)(sp + bj * HALF + 4); }
#pragma unroll
            for (int m = 0; m < 4; ++m) rr[ai][m] = ss[rbase + m * 16]; }
        __builtin_amdgcn_sched_barrier(0);
#pragma unroll
        for (int ai = 0; ai < 2; ++ai) { const int rbase = u.pm * BM + ai * HALF + wr * 64 + fr;
#pragma unroll
            for (int m = 0; m < 4; ++m) { bf16_t* rowp = O + (size_t)(rbase + m * 16) * ldc + col0;
                const float r = __builtin_amdgcn_rsqf(rr[ai][m] * (1.f / 1024.f) + 1e-6f);
#pragma unroll
                for (int bj = 0; bj < 2; ++bj) { f32x4 v0 = acc[ai][bj][m][0] * r + sv[ai][bj][0], v1 = acc[ai][bj][m][1] * r + sv[ai][bj][1];
#pragma unroll
                    for (int e = 0; e < 4; ++e) { const float a = fmaxf(v0[e], 0.f), b = fmaxf(v1[e], 0.f); v0[e] = a * a; v1[e] = b * b; }
                    u32x4 w; w.x = cvt_pk_bf16(v0[0], v0[1]); w.y = cvt_pk_bf16(v0[2], v0[3]); w.z = cvt_pk_bf16(v1[0], v1[1]); w.w = cvt_pk_bf16(v1[2], v1[3]);
                    *(u32x4*)(rowp + bj * HALF) = w; } } }
    }
};
template <class Epi, class Sched, bool ALIGN_EPI = false, bool SP2 = false>
__device__ __forceinline__ void gemm_phase256(PG8_LAS unsigned char* lds, const Gemm g, const Sched& S, const Epi& E, const int tid) {
    const int wid = __builtin_amdgcn_readfirstlane(tid >> 6), lane = tid & 63, wr = wid >> 2, wc = wid & 3, fr = lane & 15, fq = lane >> 4;
    const int K = g.K, nt = K / BK;
    unsigned voffA[2], voffB[2];
#pragma unroll
    for (int i = 0; i < 2; ++i) { int R, C; stage_rc(tid * 16 + i * 8192, R, C); const int Rb = Epi::PERM ? ((R & ~31) + perm32(R & 31)) : R;
        voffA[i] = (unsigned)(R * K + C) * 2u; voffB[i] = (unsigned)(Rb * K + C) * 2u; }
    const size_t kstep = (size_t)(BK * 2);
    const size_t hstep = (size_t)HALF * K * 2;
    const size_t tstep = 2 * hstep;
    const unsigned ldsw = (unsigned)wid * 1024u;
    const int aoff = lds_byte(wr * 64 + fr, fq * 8), boff = lds_byte(wc * 32 + fr, fq * 8);
#define PG8_SA(b, h) (((b) * 2 + (h)) * HTB)
#define PG8_SB(b, h) ((4 + (b) * 2 + (h)) * HTB)
#define PG8_STAGE(bufoff, gbase, voff) do { _Pragma("unroll") for (int _i = 0; _i < 2; ++_i) \
        __builtin_amdgcn_global_load_lds((const unsigned*)((const char*)(gbase) + (voff)[_i]), (PG8_LAS unsigned*)(lds + (bufoff) + ldsw + _i * 8192), 16, 0, 0); } while (0)
#define PG8_LDA(dst, b, h) do { _Pragma("unroll") for (int m = 0; m < 4; ++m) _Pragma("unroll") for (int k = 0; k < 2; ++k) dst[m][k] = *(const PG8_LAS bf16x8*)(lds + PG8_SA(b, h) + aoff + m * 2048 + k * 1024); } while (0)
#define PG8_LDB(dst, b, h) do { _Pragma("unroll") for (int n = 0; n < 2; ++n) _Pragma("unroll") for (int k = 0; k < 2; ++k) dst[n][k] = *(const PG8_LAS bf16x8*)(lds + PG8_SB(b, h) + boff + n * 2048 + k * 1024); } while (0)
#define PG8_MMA(ai, bj, At, Bt) do { __builtin_amdgcn_s_setprio(1); _Pragma("unroll") for (int m = 0; m < 4; ++m) _Pragma("unroll") for (int n = 0; n < 2; ++n) _Pragma("unroll") for (int k = 0; k < 2; ++k) \
        acc[ai][bj][m][n] = __builtin_amdgcn_mfma_f32_16x16x32_bf16(Bt[n][k], At[m][k], acc[ai][bj][m][n], 0, 0, 0); __builtin_amdgcn_s_setprio(0); } while (0)
#define PG8_WAIT_V(n) asm volatile("s_waitcnt vmcnt(" #n ")" ::: "memory")
#define PG8_WAIT_L(n) asm volatile("s_waitcnt lgkmcnt(" #n ")" ::: "memory")
#define PG8_BAR __builtin_amdgcn_s_barrier()
#define PG8_SCHED __builtin_amdgcn_sched_barrier(0)
    Unit cur, nxt; int ui = 0;
    if (!S.next(0, cur)) return;
    f32x4 acc[2][2][4][2];
#pragma unroll
    for (int a = 0; a < 2; ++a)
#pragma unroll
        for (int b = 0; b < 2; ++b)
#pragma unroll
            for (int m = 0; m < 4; ++m)
#pragma unroll
                for (int n = 0; n < 2; ++n) acc[a][b][m][n] = (f32x4){0.f, 0.f, 0.f, 0.f};
    bf16x8 At[4][2], B0[2][2], B1[2][2];
    const char* cA = (const char*)g.A + (size_t)cur.pm * tstep; const char* cB = (const char*)g.Bt + (size_t)cur.pn * tstep;
    S.a_ready(cur);
    if constexpr (SP2) {
        PG8_STAGE(PG8_SB(0, 0), cB, voffB); PG8_STAGE(PG8_SB(0, 1), cB + hstep, voffB); PG8_STAGE(PG8_SA(0, 0), cA, voffA); PG8_STAGE(PG8_SA(0, 1), cA + hstep, voffA);
        if (wr == 1) PG8_BAR;
        PG8_WAIT_V(2); PG8_BAR;
        PG8_STAGE(PG8_SB(1, 0), cB + kstep, voffB); PG8_STAGE(PG8_SA(1, 0), cA + kstep, voffA); PG8_STAGE(PG8_SB(1, 1), cB + hstep + kstep, voffB);
        PG8_WAIT_V(6); PG8_BAR;
    } else {
        PG8_STAGE(PG8_SB(0, 0), cB, voffB); PG8_STAGE(PG8_SA(0, 0), cA, voffA); PG8_STAGE(PG8_SB(0, 1), cB + hstep, voffB); PG8_STAGE(PG8_SA(0, 1), cA + hstep, voffA);
        if (wr == 1) PG8_BAR;
        PG8_WAIT_V(4); PG8_BAR;
        PG8_STAGE(PG8_SB(1, 0), cB + kstep, voffB); PG8_STAGE(PG8_SA(1, 0), cA + kstep, voffA); PG8_STAGE(PG8_SB(1, 1), cB + hstep + kstep, voffB);
        PG8_WAIT_V(6); PG8_BAR;
    }
    for (;;) {
        const bool has_next = S.next(ui + 1, nxt);
        const char* nA = has_next ? (const char*)g.A + (size_t)nxt.pm * tstep : cA; const char* nB = has_next ? (const char*)g.Bt + (size_t)nxt.pn * tstep : cB;
        for (int t = 0; t < nt; t += 2) {
            const bool last = (t == nt - 2);
            const char* a1 = cA + (size_t)(t + 1) * kstep;
            const char* a2 = last ? nA : cA + (size_t)(t + 2) * kstep; const char* b2 = last ? nB : cB + (size_t)(t + 2) * kstep;
            const char* a3 = a2 + kstep; const char* b3 = b2 + kstep;
            if (last && has_next) S.a_ready(nxt);
            if constexpr (SP2) {
            PG8_LDB(B0, 0, 0); PG8_LDB(B1, 0, 1); PG8_SCHED; PG8_LDA(At, 0, 0); PG8_STAGE(PG8_SA(1, 1), a1 + hstep, voffA);
            PG8_WAIT_V(8); PG8_WAIT_L(0); PG8_BAR; PG8_MMA(0, 0, At, B0); PG8_MMA(0, 1, At, B1); PG8_BAR; PG8_SCHED;
            PG8_LDA(At, 0, 1); PG8_STAGE(PG8_SB(0, 0), b2, voffB); PG8_STAGE(PG8_SB(0, 1), b2 + hstep, voffB); PG8_STAGE(PG8_SA(0, 0), a2, voffA);
            PG8_WAIT_V(8); PG8_WAIT_L(0); PG8_BAR; PG8_MMA(1, 0, At, B0); PG8_MMA(1, 1, At, B1); PG8_BAR; PG8_SCHED;
            PG8_LDB(B0, 1, 0); PG8_LDB(B1, 1, 1); PG8_SCHED; PG8_LDA(At, 1, 0); PG8_STAGE(PG8_SA(0, 1), a2 + hstep, voffA);
            PG8_WAIT_V(8); PG8_WAIT_L(0); PG8_BAR; PG8_MMA(0, 0, At, B0); PG8_MMA(0, 1, At, B1); PG8_BAR; PG8_SCHED;
            PG8_LDA(At, 1, 1); PG8_STAGE(PG8_SB(1, 0), b3, voffB); PG8_STAGE(PG8_SB(1, 1), b3 + hstep, voffB); PG8_STAGE(PG8_SA(1, 0), a3, voffA);
            PG8_WAIT_V(8); PG8_WAIT_L(0); PG8_BAR; PG8_MMA(1, 0, At, B0); PG8_MMA(1, 1, At, B1); PG8_BAR; PG8_SCHED;
            } else {
            PG8_LDB(B0, 0, 0); PG8_SCHED; PG8_LDA(At, 0, 0); PG8_STAGE(PG8_SA(1, 1), a1 + hstep, voffA);
            PG8_WAIT_L(8); PG8_BAR; PG8_WAIT_L(0); PG8_MMA(0, 0, At, B0); PG8_BAR; PG8_SCHED;
            PG8_LDB(B1, 0, 1); PG8_STAGE(PG8_SB(0, 0), b2, voffB);
            PG8_BAR; PG8_WAIT_L(0); PG8_MMA(0, 1, At, B1); PG8_BAR;
            PG8_LDA(At, 0, 1); PG8_STAGE(PG8_SA(0, 0), a2, voffA);
            PG8_BAR; PG8_WAIT_L(0); PG8_MMA(1, 0, At, B0); PG8_BAR; PG8_SCHED;
            PG8_STAGE(PG8_SB(0, 1), b2 + hstep, voffB);
            PG8_WAIT_V(6); PG8_BAR; PG8_MMA(1, 1, At, B1); PG8_BAR;
            PG8_LDB(B0, 1, 0); PG8_SCHED; PG8_LDA(At, 1, 0); PG8_STAGE(PG8_SA(0, 1), a2 + hstep, voffA);
            PG8_WAIT_L(8); PG8_BAR; PG8_WAIT_L(0); PG8_MMA(0, 0, At, B0); PG8_BAR; PG8_SCHED;
            PG8_LDB(B1, 1, 1); PG8_STAGE(PG8_SB(1, 0), b3, voffB);
            PG8_BAR; PG8_WAIT_L(0); PG8_MMA(0, 1, At, B1); PG8_BAR;
            PG8_LDA(At, 1, 1); PG8_STAGE(PG8_SA(1, 0), a3, voffA);
            PG8_BAR; PG8_WAIT_L(0); PG8_MMA(1, 0, At, B0); PG8_BAR; PG8_SCHED;
            PG8_STAGE(PG8_SB(1, 1), b3 + hstep, voffB);
            PG8_WAIT_V(6); PG8_BAR; PG8_MMA(1, 1, At, B1); PG8_BAR;
            }
        }
        if constexpr (ALIGN_EPI) { if (wr == 0) PG8_BAR; }
        if constexpr (!Epi::AFTER_DRAIN) { E(acc, cur, wr, wc, fr, fq); S.done(cur); }
        if (!has_next) break;
#pragma unroll
        for (int a = 0; a < 2; ++a)
#pragma unroll
            for (int b = 0; b < 2; ++b)
#pragma unroll
                for (int m = 0; m < 4; ++m)
#pragma unroll
                    for (int n = 0; n < 2; ++n) acc[a][b][m][n] = (f32x4){0.f, 0.f, 0.f, 0.f};
        cur = nxt; cA = nA; cB = nB; ++ui;
        if constexpr (ALIGN_EPI) { if (wr == 1) PG8_BAR; }
    }
    PG8_WAIT_V(0);
    if constexpr (!ALIGN_EPI) { if (wr == 0) PG8_BAR; }
    PG8_BAR;
    if constexpr (Epi::AFTER_DRAIN) { E.fused(acc, cur, wr, wc, fr, fq, lds, wid, lane); S.done(cur); }
#undef PG8_SA
#undef PG8_SB
#undef PG8_STAGE
#undef PG8_LDA
#undef PG8_LDB
#undef PG8_MMA
#undef PG8_WAIT_V
#undef PG8_WAIT_L
#undef PG8_BAR
#undef PG8_SCHED
}
template <class Epi, class Sched, bool ALIGN_EPI = false, bool SP2 = false>
__device__ __forceinline__ void gemm_phase(PG8_LAS unsigned char* lds, const Gemm g, const Sched& S, const Epi& E, const int tid) {
    static_assert(SP2, "the 192-row tile form exists for the SP2 loop only");
    const int wid = __builtin_amdgcn_readfirstlane(tid >> 6), lane = tid & 63, wr = wid >> 2, wc = wid & 3, fr = lane & 15, fq = lane >> 4;
    const int K = g.K, nt = K / BK;
    unsigned voffA[2], voffB[2];
#pragma unroll
    for (int i = 0; i < 2; ++i) { int R, C; stage_rc(tid * 16 + i * 8192, R, C); const int Rb = Epi::PERM ? ((R & ~31) + perm32(R & 31)) : R;
        voffA[i] = (unsigned)(R * K + C) * 2u; voffB[i] = (unsigned)(Rb * K + C) * 2u; }
    const size_t kstep = (size_t)(BK * 2);
    const size_t hstep = (size_t)HALF * K * 2;
    const size_t tstepA = (size_t)RM * K * 2;
    const size_t tstep = 2 * hstep;
    const unsigned ldsw = (unsigned)wid * 1024u;
    const int aoff = lds_byte(wr * 64 + fr, fq * 8), boff = lds_byte(wc * 32 + fr, fq * 8);
#define PG8_SA(b, h) (((b) * 2 + (h)) * HTB)
#define PG8_SB(b, h) ((4 + (b) * 2 + (h)) * HTB)
#define PG8_STAGE(bufoff, gbase, voff) do { _Pragma("unroll") for (int _i = 0; _i < 2; ++_i) \
        __builtin_amdgcn_global_load_lds((const unsigned*)((const char*)(gbase) + (voff)[_i]), (PG8_LAS unsigned*)(lds + (bufoff) + ldsw + _i * 8192), 16, 0, 0); } while (0)
#define PG8_LDA(dst, b, h) do { _Pragma("unroll") for (int m = 0; m < 4; ++m) _Pragma("unroll") for (int k = 0; k < 2; ++k) dst[m][k] = *(const PG8_LAS bf16x8*)(lds + PG8_SA(b, h) + aoff + m * 2048 + k * 1024); } while (0)
#define PG8_LDB(dst, b, h) do { _Pragma("unroll") for (int n = 0; n < 2; ++n) _Pragma("unroll") for (int k = 0; k < 2; ++k) dst[n][k] = *(const PG8_LAS bf16x8*)(lds + PG8_SB(b, h) + boff + n * 2048 + k * 1024); } while (0)
#define PG8_MMA(ai, bj, At, Bt) do { __builtin_amdgcn_s_setprio(1); _Pragma("unroll") for (int m = 0; m < 4; ++m) _Pragma("unroll") for (int n = 0; n < 2; ++n) _Pragma("unroll") for (int k = 0; k < 2; ++k) \
        acc[ai][bj][m][n] = __builtin_amdgcn_mfma_f32_16x16x32_bf16(Bt[n][k], At[m][k], acc[ai][bj][m][n], 0, 0, 0); __builtin_amdgcn_s_setprio(0); } while (0)
    const int aoff1 = lds_byte(wr * 32 + fr, fq * 8);
#define PG8_STAGE1(bufoff, gbase, voff) __builtin_amdgcn_global_load_lds((const unsigned*)((const char*)(gbase) + (voff)[0]), (PG8_LAS unsigned*)(lds + (bufoff) + ldsw), 16, 0, 0)
#define PG8_LDA1(dst, b) do { _Pragma("unroll") for (int m = 0; m < 2; ++m) _Pragma("unroll") for (int k = 0; k < 2; ++k) dst[m][k] = *(const PG8_LAS bf16x8*)(lds + PG8_SA(b, 1) + aoff1 + m * 2048 + k * 1024); } while (0)
#define PG8_MMA1(bj, At, Bt) do { __builtin_amdgcn_s_setprio(1); _Pragma("unroll") for (int m = 0; m < 2; ++m) _Pragma("unroll") for (int n = 0; n < 2; ++n) _Pragma("unroll") for (int k = 0; k < 2; ++k) \
        acc[1][bj][m][n] = __builtin_amdgcn_mfma_f32_16x16x32_bf16(Bt[n][k], At[m][k], acc[1][bj][m][n], 0, 0, 0); __builtin_amdgcn_s_setprio(0); } while (0)
#define PG8_WAIT_V(n) asm volatile("s_waitcnt vmcnt(" #n ")" ::: "memory")
#define PG8_WAIT_L(n) asm volatile("s_waitcnt lgkmcnt(" #n ")" ::: "memory")
#define PG8_BAR __builtin_amdgcn_s_barrier()
#define PG8_SCHED __builtin_amdgcn_sched_barrier(0)
    Unit cur, nxt; int ui = 0;
    if (!S.next(0, cur)) return;
    f32x4 acc[2][2][4][2];
#pragma unroll
    for (int a = 0; a < 2; ++a)
#pragma unroll
        for (int b = 0; b < 2; ++b)
#pragma unroll
            for (int m = 0; m < 4; ++m)
#pragma unroll
                for (int n = 0; n < 2; ++n) acc[a][b][m][n] = (f32x4){0.f, 0.f, 0.f, 0.f};
    bf16x8 At[4][2], B0[2][2], B1[2][2];
    const char* cA = (const char*)g.A + (size_t)cur.pm * tstepA; const char* cB = (const char*)g.Bt + (size_t)cur.pn * tstep;
    S.a_ready(cur);
    if constexpr (SP2) {
        PG8_STAGE(PG8_SB(0, 0), cB, voffB); PG8_STAGE(PG8_SB(0, 1), cB + hstep, voffB); PG8_STAGE(PG8_SA(0, 0), cA, voffA); PG8_STAGE1(PG8_SA(0, 1), cA + hstep, voffA);
        if (wr == 1) PG8_BAR;
        PG8_WAIT_V(1); PG8_BAR;
        PG8_STAGE(PG8_SB(1, 0), cB + kstep, voffB); PG8_STAGE(PG8_SA(1, 0), cA + kstep, voffA); PG8_STAGE(PG8_SB(1, 1), cB + hstep + kstep, voffB);
        PG8_WAIT_V(6); PG8_BAR;
    } else {
        PG8_STAGE(PG8_SB(0, 0), cB, voffB); PG8_STAGE(PG8_SA(0, 0), cA, voffA); PG8_STAGE(PG8_SB(0, 1), cB + hstep, voffB); PG8_STAGE(PG8_SA(0, 1), cA + hstep, voffA);
        if (wr == 1) PG8_BAR;
        PG8_WAIT_V(4); PG8_BAR;
        PG8_STAGE(PG8_SB(1, 0), cB + kstep, voffB); PG8_STAGE(PG8_SA(1, 0), cA + kstep, voffA); PG8_STAGE(PG8_SB(1, 1), cB + hstep + kstep, voffB);
        PG8_WAIT_V(6); PG8_BAR;
    }
    for (;;) {
        const bool has_next = S.next(ui + 1, nxt);
        const char* nA = has_next ? (const char*)g.A + (size_t)nxt.pm * tstepA : cA; const char* nB = has_next ? (const char*)g.Bt + (size_t)nxt.pn * tstep : cB;
        for (int t = 0; t < nt; t += 2) {
            const bool last = (t == nt - 2);
            const char* a1 = cA + (size_t)(t + 1) * kstep;
            const char* a2 = last ? nA : cA + (size_t)(t + 2) * kstep; const char* b2 = last ? nB : cB + (size_t)(t + 2) * kstep;
            const char* a3 = a2 + kstep; const char* b3 = b2 + kstep;
            if (last && has_next) S.a_ready(nxt);
            if constexpr (SP2) {
            PG8_LDB(B0, 0, 0); PG8_LDB(B1, 0, 1); PG8_SCHED; PG8_LDA(At, 0, 0); PG8_STAGE1(PG8_SA(1, 1), a1 + hstep, voffA);
            PG8_WAIT_V(7); PG8_WAIT_L(0); PG8_BAR; PG8_MMA(0, 0, At, B0); PG8_MMA(0, 1, At, B1); PG8_BAR; PG8_SCHED;
            PG8_LDA1(At, 0); PG8_STAGE(PG8_SB(0, 0), b2, voffB); PG8_STAGE(PG8_SB(0, 1), b2 + hstep, voffB); PG8_STAGE(PG8_SA(0, 0), a2, voffA);
            PG8_WAIT_V(7); PG8_WAIT_L(0); PG8_BAR; PG8_MMA1(0, At, B0); PG8_MMA1(1, At, B1); PG8_BAR; PG8_SCHED;
            PG8_LDB(B0, 1, 0); PG8_LDB(B1, 1, 1); PG8_SCHED; PG8_LDA(At, 1, 0); PG8_STAGE1(PG8_SA(0, 1), a2 + hstep, voffA);
            PG8_WAIT_V(7); PG8_WAIT_L(0); PG8_BAR; PG8_MMA(0, 0, At, B0); PG8_MMA(0, 1, At, B1); PG8_BAR; PG8_SCHED;
            PG8_LDA1(At, 1); PG8_STAGE(PG8_SB(1, 0), b3, voffB); PG8_STAGE(PG8_SB(1, 1), b3 + hstep, voffB); PG8_STAGE(PG8_SA(1, 0), a3, voffA);
            PG8_WAIT_V(7); PG8_WAIT_L(0); PG8_BAR; PG8_MMA1(0, At, B0); PG8_MMA1(1, At, B1); PG8_BAR; PG8_SCHED;
            } else {
            PG8_LDB(B0, 0, 0); PG8_SCHED; PG8_LDA(At, 0, 0); PG8_STAGE(PG8_SA(1, 1), a1 + hstep, voffA);
            PG8_WAIT_L(8); PG8_BAR; PG8_WAIT_L(0); PG8_MMA(0, 0, At, B0); PG8_BAR; PG8_SCHED;
            PG8_LDB(B1, 0, 1); PG8_STAGE(PG8_SB(0, 0), b2, voffB);
            PG8_BAR; PG8_WAIT_L(0); PG8_MMA(0, 1, At, B1); PG8_BAR;
            PG8_LDA(At, 0, 1); PG8_STAGE(PG8_SA(0, 0), a2, voffA);
            PG8_BAR; PG8_WAIT_L(0); PG8_MMA(1, 0, At, B0); PG8_BAR; PG8_SCHED;
            PG8_STAGE(PG8_SB(0, 1), b2 + hstep, voffB);
            PG8_WAIT_V(6); PG8_BAR; PG8_MMA(1, 1, At, B1); PG8_BAR;
            PG8_LDB(B0, 1, 0); PG8_SCHED; PG8_LDA(At, 1, 0); PG8_STAGE(PG8_SA(0, 1), a2 + hstep, voffA);
            PG8_WAIT_L(8); PG8_BAR; PG8_WAIT_L(0); PG8_MMA(0, 0, At, B0); PG8_BAR; PG8_SCHED;
            PG8_LDB(B1, 1, 1); PG8_STAGE(PG8_SB(1, 0), b3, voffB);
            PG8_BAR; PG8_WAIT_L(0); PG8_MMA(0, 1, At, B1); PG8_BAR;
            PG8_LDA(At, 1, 1); PG8_STAGE(PG8_SA(1, 0), a3, voffA);
            PG8_BAR; PG8_WAIT_L(0); PG8_MMA(1, 0, At, B0); PG8_BAR; PG8_SCHED;
            PG8_STAGE(PG8_SB(1, 1), b3 + hstep, voffB);
            PG8_WAIT_V(6); PG8_BAR; PG8_MMA(1, 1, At, B1); PG8_BAR;
            }
        }
        if constexpr (ALIGN_EPI) { if (wr == 0) PG8_BAR; }
        if constexpr (!Epi::AFTER_DRAIN) { E(acc, cur, wr, wc, fr, fq); S.done(cur); }
        if (!has_next) break;
#pragma unroll
        for (int a = 0; a < 2; ++a)
#pragma unroll
            for (int b = 0; b < 2; ++b)
#pragma unroll
                for (int m = 0; m < 4; ++m)
#pragma unroll
                    for (int n = 0; n < 2; ++n) acc[a][b][m][n] = (f32x4){0.f, 0.f, 0.f, 0.f};
        cur = nxt; cA = nA; cB = nB; ++ui;
        if constexpr (ALIGN_EPI) { if (wr == 1) PG8_BAR; }
    }
    PG8_WAIT_V(0);
    if constexpr (!ALIGN_EPI) { if (wr == 0) PG8_BAR; }
    PG8_BAR;
    if constexpr (Epi::AFTER_DRAIN) { E.fused(acc, cur, wr, wc, fr, fq, lds, wid, lane); S.done(cur); }
#undef PG8_SA
#undef PG8_SB
#undef PG8_STAGE
#undef PG8_LDA
#undef PG8_LDB
#undef PG8_MMA
#undef PG8_STAGE1
#undef PG8_LDA1
#undef PG8_MMA1
#undef PG8_WAIT_V
#undef PG8_WAIT_L
#undef PG8_BAR
#undef PG8_SCHED
}
}
constexpr int D = 1024, MP = 8192, MS = 4096, M = MP + MS, FF = 4096, NL = 4;
constexpr int NWAVES = 8, NTHR = 512;
constexpr size_t MiB = 1u << 20;
constexpr size_t WS_MOD = 1 * MiB;
constexpr size_t WS_W = 2 * MiB;
constexpr size_t WS_X = 94 * MiB;
constexpr size_t WS_H = 142 * MiB;
constexpr size_t WS_R = 166 * MiB;
constexpr size_t WS_CK = 262 * MiB, WS_CV = 266 * MiB, WS_SHW = 270 * MiB, WS_SS = 271 * MiB, WS_END = 272 * MiB;
constexpr size_t MEL = 1u << 20;
constexpr size_t W_QKV = 0, W_O = 6 * MEL, W_PW1 = 8 * MEL, W_PW2 = 12 * MEL, W_UP = 14 * MEL, W_DOWN = 30 * MEL;
constexpr int LDS_BYTES = 163840, LDS_ST = LDS_BYTES - 16, LDS_KC = 112640;

#define LAS __attribute__((address_space(3)))
#define SB0() __builtin_amdgcn_sched_barrier(0)
typedef unsigned short bf16;
typedef float f32x4 __attribute__((ext_vector_type(4)));
typedef float f32x2 __attribute__((ext_vector_type(2)));
typedef unsigned u32x4 __attribute__((ext_vector_type(4)));
typedef unsigned u32x2 __attribute__((ext_vector_type(2)));
typedef short bf16x8 __attribute__((ext_vector_type(8)));
typedef short s16x4 __attribute__((ext_vector_type(4)));
typedef float f32x32 __attribute__((ext_vector_type(32)));

__device__ __forceinline__ unsigned f2bf(float f) { unsigned u = __builtin_bit_cast(unsigned, f); return (u + 0x7fffu + ((u >> 16) & 1u)) >> 16; }
__device__ __forceinline__ unsigned pk2(float lo, float hi) { unsigned r; asm("v_cvt_pk_bf16_f32 %0, %1, %2" : "=v"(r) : "v"(lo), "v"(hi)); return r; }
__device__ __forceinline__ float bflo(unsigned w) { return __builtin_bit_cast(float, w << 16); }
__device__ __forceinline__ float bfhi(unsigned w) { return __builtin_bit_cast(float, w & 0xffff0000u); }
__device__ __forceinline__ float shx(float v, int k, int lane) { return __builtin_bit_cast(float, __builtin_amdgcn_ds_bpermute((lane ^ k) << 2, __builtin_bit_cast(int, v))); }
__device__ __forceinline__ float wave_sum(float v, int lane) {
#pragma unroll
    for (int o = 1; o < 64; o <<= 1) v += shx(v, o, lane);
    return v;
}

template <bool GLU>
__device__ __forceinline__ void transpose_item(const float* W, int K, int N, bf16* WT, LAS float* scr, int item, int lane) {
    const int nblk = N / 32, kb = item / nblk, nb = item % nblk, k0 = 64 * kb, n0 = 32 * nb;
    { float tv[32];
#pragma unroll
      for (int i = 0; i < 32; ++i) tv[i] = __builtin_nontemporal_load(W + (size_t)(k0 + 2 * i + (lane >> 5)) * N + n0 + (lane & 31));
      __builtin_amdgcn_sched_barrier(0);
#pragma unroll
      for (int i = 0; i < 32; ++i) scr[(2 * i + (lane >> 5)) * 33 + (((lane & 31) + 4 * (i >> 4)) & 31)] = tv[i]; }
    asm volatile("s_waitcnt lgkmcnt(0)" ::: "memory");
    int d0 = n0;
    if (GLU) { const int nn = n0 & 1023; d0 = ((nn >> 7) << 8) + (nn & 127) + ((n0 >> 10) << 7); }
    const int c = lane & 7;
#pragma unroll
    for (int j = 0; j < 4; ++j) { const int n = (lane >> 3) + 8 * j; const LAS float* s = scr + (8 * c) * 33 + ((n + 4 * (c >> 2)) & 31);
        u32x4 o; o.x = pk2(s[0 * 33], s[1 * 33]); o.y = pk2(s[2 * 33], s[3 * 33]); o.z = pk2(s[4 * 33], s[5 * 33]); o.w = pk2(s[6 * 33], s[7 * 33]);
        *(u32x4*)(WT + (size_t)(d0 + n) * K + k0 + 8 * c) = o; }
    asm volatile("s_waitcnt lgkmcnt(0)" ::: "memory");
}

struct Ptrs {
    const float *x_prompt, *x_sample, *cache_k, *cache_v, *c, *c_ctx, *norm_g, *w_ada, *b_ada, *w_qkv, *w_o, *rpb, *w_pw1, *w_dw, *b_dw, *ln_g, *ln_b, *w_pw2, *w_up, *w_down, *final_g;
};

__device__ __forceinline__ void p0_phase(const Ptrs& P, unsigned char* ws, LAS unsigned char* lds, int tid, int lane, int wave, int G, int bid) {
    bf16* Wt = (bf16*)(ws + WS_W);
    const int gw = bid * NWAVES + wave, NGW = G * NWAVES;
    LAS float* scr = (LAS float*)(lds + wave * 16384);
    constexpr int NIT = 23552;
    for (int it = gw; it < NIT; it += NGW) {
        if (it < 7168) { const int i = it / 3584; int r = it % 3584;
            if (r < 1536) { transpose_item<false>(P.w_qkv + (size_t)i * D * 3 * D, D, 3 * D, Wt + W_QKV + (size_t)i * 3 * MEL, scr, r, lane); continue; } r -= 1536;
            if (r < 512) { transpose_item<false>(P.w_o + (size_t)i * D * D, D, D, Wt + W_O + (size_t)i * MEL, scr, r, lane); continue; } r -= 512;
            if (r < 1024) { transpose_item<true>(P.w_pw1 + (size_t)i * D * 2 * D, D, 2 * D, Wt + W_PW1 + (size_t)i * 2 * MEL, scr, r, lane); continue; } r -= 1024;
            transpose_item<false>(P.w_pw2 + (size_t)i * D * D, D, D, Wt + W_PW2 + (size_t)i * MEL, scr, r, lane);
        } else { const int l = (it - 7168) / 4096; int r = (it - 7168) % 4096;
            if (r < 2048) transpose_item<false>(P.w_up + (size_t)l * D * FF, D, FF, Wt + W_UP + (size_t)l * 4 * MEL, scr, r, lane);
            else transpose_item<false>(P.w_down + (size_t)l * D * FF, FF, D, Wt + W_DOWN + (size_t)l * 4 * MEL, scr, r - 2048, lane);
        }
    }
    { bf16* CK = (bf16*)(ws + WS_CK); bf16* CV = (bf16*)(ws + WS_CV);
      const int NT = G * NTHR; constexpr int NV = 2 * 4 * 2 * 256 * 1024 / 4;
      for (int v = bid * NTHR + tid; v < NV; v += NT) { const int which = v >= NV / 2; const int e = (which ? v - NV / 2 : v) * 4;
          const f32x4 a = __builtin_nontemporal_load((const f32x4*)((which ? P.cache_v : P.cache_k) + e));
          u32x2 o; o.x = pk2(a[0], a[1]); o.y = pk2(a[2], a[3]);
          *(u32x2*)((which ? CV : CK) + e) = o; } }
    { f32x4* z = (f32x4*)(ws + WS_SS); const int NT = G * NTHR; float zf = 0.f; asm volatile("" : "+v"(zf));
      const f32x4 zz = (f32x4){zf, zf, zf, zf}; for (int v = bid * NTHR + tid; v < 9 * M / 4; v += NT) z[v] = zz; }
    __syncthreads();
    { LAS float* sil = (LAS float*)lds; LAS float* red = (LAS float*)(lds + 20480); float* mod = (float*)(ws + WS_MOD);
      for (int k = tid; k < 5 * 1024; k += NTHR) { const int cc = k >> 10, kk = k & 1023; const float v = cc == 0 ? P.c_ctx[kk] : P.c[(cc - 1) * 1024 + kk]; sil[k] = v / (1.f + __expf(-v)); }
      __syncthreads();
      const int kg = tid >> 4, cl = tid & 15; const bool cact = cl < 12;
      for (int item = bid; item < 512; item += G) { const int l = item >> 7, n0 = (item & 127) * 48;
          const float* W = P.w_ada + (size_t)l * D * 6144 + n0 + 4 * cl;
          f32x4 a[5];
#pragma unroll
          for (int cc = 0; cc < 5; ++cc) a[cc] = (f32x4){0.f, 0.f, 0.f, 0.f};
#pragma unroll 4
          for (int kk = 0; kk < 32; ++kk) { const int k = kg * 32 + kk; f32x4 w = (f32x4){0.f, 0.f, 0.f, 0.f}; if (cact) w = __builtin_nontemporal_load((const f32x4*)(W + (size_t)k * 6144));
#pragma unroll
              for (int cc = 0; cc < 5; ++cc) a[cc] += sil[cc * 1024 + k] * w; }
#pragma unroll
          for (int cc = 0; cc < 5; ++cc) *(LAS f32x4*)(red + (kg * 5 + cc) * 64 + 4 * cl) = a[cc];
          __syncthreads();
          if (tid < 320 && (tid & 63) < 48) { const int cc = tid >> 6, n = tid & 63; float s = 0.f;
#pragma unroll 8
              for (int g = 0; g < 32; ++g) s += red[(g * 5 + cc) * 64 + n];
              mod[(size_t)(l * 5 + cc) * 6144 + n0 + n] = s + P.b_ada[l * 6144 + n0 + n]; }
          __syncthreads();
      } }
}

__device__ __forceinline__ void norm_phase(const float* xp, const float* xs, bf16* H, float* yout, const float* g, const float* shift, const float* scale, int gw, int NGW, int lane) {
    f32x4 gv[4];
#pragma unroll
    for (int j = 0; j < 4; ++j) gv[j] = *(const f32x4*)(g + 4 * (lane + 64 * j));
    for (int m = gw; m < M; m += NGW) {
        const float* xrow = m < MP ? xp + (size_t)m * D : xs + (size_t)(m - MP) * D;
        const int cond = m < MP ? 0 : 1 + ((m - MP) >> 10);
        f32x4 v[4]; float ss = 0.f;
#pragma unroll
        for (int j = 0; j < 4; ++j) { v[j] = *(const f32x4*)(xrow + 4 * (lane + 64 * j)); ss += (v[j][0] * v[j][0] + v[j][1] * v[j][1]) + (v[j][2] * v[j][2] + v[j][3] * v[j][3]); }
        const float r = 1.0f / sqrtf(wave_sum(ss, lane) * (1.f / D) + 1e-6f);
        if (yout) {
#pragma unroll
            for (int j = 0; j < 4; ++j) *(f32x4*)(yout + (size_t)m * D + 4 * (lane + 64 * j)) = v[j] * r * gv[j];
        } else {
#pragma unroll
            for (int j = 0; j < 4; ++j) { const f32x4 sc = *(const f32x4*)(scale + cond * 6144 + 4 * (lane + 64 * j)), sh = *(const f32x4*)(shift + cond * 6144 + 4 * (lane + 64 * j));
                const f32x4 h = (v[j] * r * gv[j]) * (1.f + sc) + sh; u32x2 o; o.x = pk2(h[0], h[1]); o.y = pk2(h[2], h[3]);
                *(u32x2*)(H + (size_t)m * D + 4 * (lane + 64 * j)) = o; }
        }
    }
}

template <class F, int... I> __device__ __forceinline__ void sfor_impl(F&& f, std::integer_sequence<int, I...>) { (f(std::integral_constant<int, I>{}), ...); }
template <int N, class F> __device__ __forceinline__ void sfor(F&& f) { sfor_impl(f, std::make_integer_sequence<int, N>{}); }
__device__ __forceinline__ float dpp_add(float v, int ctrl_b1, int ctrl_4e, int dummy) { return v; }
__device__ __forceinline__ float wave_sum_dpp(float v) {
    v += __builtin_bit_cast(float, __builtin_amdgcn_update_dpp(0, __builtin_bit_cast(int, v), 0xB1, 0xf, 0xf, false));
    v += __builtin_bit_cast(float, __builtin_amdgcn_update_dpp(0, __builtin_bit_cast(int, v), 0x4E, 0xf, 0xf, false));
    v += __builtin_bit_cast(float, __builtin_amdgcn_update_dpp(0, __builtin_bit_cast(int, v), 0x141, 0xf, 0xf, false));
    v += __builtin_bit_cast(float, __builtin_amdgcn_update_dpp(0, __builtin_bit_cast(int, v), 0x140, 0xf, 0xf, false));
    const int vi = __builtin_bit_cast(int, v);
    return (__builtin_bit_cast(float, __builtin_amdgcn_readlane(vi, 0)) + __builtin_bit_cast(float, __builtin_amdgcn_readlane(vi, 16))) +
           (__builtin_bit_cast(float, __builtin_amdgcn_readlane(vi, 32)) + __builtin_bit_cast(float, __builtin_amdgcn_readlane(vi, 48)));
}
constexpr int CT = 16, CROWS = CT + 30, CCS = 16, CCH = (CROWS + CCS - 1) / CCS;
__device__ __forceinline__ void conv_phase(const bf16* U, bf16* Vc, const float* wdw, const float* bdw, const float* lng, const float* lnb, LAS unsigned char* lds, int tid, int lane, int wave, int G, int bid) {
    f32x2 w[31];
    sfor<31>([&](auto K) __attribute__((always_inline)) { constexpr int k = decltype(K)::value; w[k] = *(const f32x2*)(wdw + k * D + 2 * tid); });
    const f32x2 bd = *(const f32x2*)(bdw + 2 * tid), lg = *(const f32x2*)(lng + 2 * tid), lb = *(const f32x2*)(lnb + 2 * tid);
    LAS f32x2* part = (LAS f32x2*)lds;
    LAS f32x2* stats = part + 8 * CT;
    for (int un_ = bid; un_ < M / CT; un_ += G) {
        const int unit = (G == 256) ? (un_ & 7) * (M / CT / 8) + ((un_ >> 3) & 31) + 32 * (un_ >> 8) : un_;
        const int m0 = unit * CT, seg = m0 < MP ? 0 : MP, L = m0 < MP ? 256 : 1024, t0 = (m0 - seg) & (L - 1);
        const bf16* Ub = U + (size_t)(m0 - t0) * D + 2 * tid;
        f32x2 acc[CT];
        sfor<CT>([&](auto O) __attribute__((always_inline)) { acc[decltype(O)::value] = bd; });
        sfor<CCH>([&](auto C) __attribute__((always_inline)) { constexpr int c = decltype(C)::value;
            unsigned raw[CCS];
            sfor<CCS>([&](auto I) __attribute__((always_inline)) { constexpr int i = decltype(I)::value, j = c * CCS + i;
                if constexpr (j < CROWS) { const int t = t0 - 15 + j, tc = min(max(t, 0), L - 1);
                    raw[i] = *(const unsigned*)(Ub + (size_t)tc * D); } });
            SB0();
            sfor<CCS>([&](auto I) __attribute__((always_inline)) { constexpr int i = decltype(I)::value, j = c * CCS + i;
                if constexpr (j < CROWS) { const int t = t0 - 15 + j; const unsigned rm = raw[i] & (unsigned)(-(int)((t >= 0) & (t < L))); const f32x2 u = (f32x2){bflo(rm), bfhi(rm)};
                    sfor<31>([&](auto K) __attribute__((always_inline)) { constexpr int k = decltype(K)::value, o = j - k;
                        if constexpr (o >= 0 && o < CT) acc[o] += u * w[k]; }); } });
        });
        sfor<CT>([&](auto O) __attribute__((always_inline)) { constexpr int o = decltype(O)::value;
            const float s = wave_sum_dpp(acc[o].x + acc[o].y), q = wave_sum_dpp(acc[o].x * acc[o].x + acc[o].y * acc[o].y); if (lane == 0) part[wave * CT + o] = (f32x2){s, q}; });
        __syncthreads();
        if (tid < CT) { float s = 0.f, q = 0.f;
#pragma unroll
            for (int wv = 0; wv < 8; ++wv) { const f32x2 p = part[wv * CT + tid]; s += p.x; q += p.y; }
            const float mean = s * (1.f / D), var = fmaxf(q * (1.f / D) - mean * mean, 0.f); stats[tid] = (f32x2){mean, 1.0f / sqrtf(var + 1e-5f)}; }
        __syncthreads();
        sfor<CT>([&](auto O) __attribute__((always_inline)) { constexpr int o = decltype(O)::value;
            const f32x2 st = stats[o]; f32x2 y = (acc[o] - st.x) * st.y * lg + lb;
            y.x = y.x * __builtin_amdgcn_rcpf(1.f + __expf(-y.x)); y.y = y.y * __builtin_amdgcn_rcpf(1.f + __expf(-y.y));
            *(unsigned*)(Vc + (size_t)(m0 + o) * D + 2 * tid) = pk2(y.x, y.y); });
        __syncthreads();
    }
}

__device__ __forceinline__ void final_norm_phase(const bf16* X, float* yout, const float* g, int gw, int NGW, int lane) {
    f32x4 gv[4];
#pragma unroll
    for (int j = 0; j < 4; ++j) gv[j] = *(const f32x4*)(g + 4 * (lane + 64 * j));
    for (int m = gw; m < M; m += NGW) {
        const bf16* xr = X + (size_t)m * D;
        f32x4 v[4]; float sq = 0.f;
#pragma unroll
        for (int j = 0; j < 4; ++j) { const u32x2 w = __builtin_nontemporal_load((const u32x2*)(xr + 4 * (lane + 64 * j))); v[j] = (f32x4){bflo(w.x), bfhi(w.x), bflo(w.y), bfhi(w.y)};
            sq += (v[j][0] * v[j][0] + v[j][1] * v[j][1]) + (v[j][2] * v[j][2] + v[j][3] * v[j][3]); }
        const float r = 1.0f / sqrtf(wave_sum_dpp(sq) * (1.f / D) + 1e-6f);
#pragma unroll
        for (int j = 0; j < 4; ++j) __builtin_nontemporal_store(v[j] * r * gv[j], (f32x4*)(yout + (size_t)m * D + 4 * (lane + 64 * j)));
    }
}

__device__ __forceinline__ void prep_phase(const float* xp, const float* xs, bf16* H, float* ss0, const float* g, const float* scale, const float* mod, const bf16* Wt, float* shw, int gw, int NGW, int lane) {
    { f32x4 gv[4];
#pragma unroll
      for (int j = 0; j < 4; ++j) gv[j] = *(const f32x4*)(g + 4 * (lane + 64 * j));
      for (int m = gw; m < M; m += NGW) {
          const float* xrow = m < MP ? xp + (size_t)m * D : xs + (size_t)(m - MP) * D;
          const int cond = m < MP ? 0 : 1 + ((m - MP) >> 10);
          f32x4 v[4]; float sq = 0.f;
#pragma unroll
          for (int j = 0; j < 4; ++j) { v[j] = *(const f32x4*)(xrow + 4 * (lane + 64 * j)); sq += (v[j][0] * v[j][0] + v[j][1] * v[j][1]) + (v[j][2] * v[j][2] + v[j][3] * v[j][3]); }
          sq = wave_sum_dpp(sq); if (lane == 0) ss0[m] = sq;
          f32x4 sc[4];
#pragma unroll
          for (int j = 0; j < 4; ++j) sc[j] = *(const f32x4*)(scale + cond * 6144 + 4 * (lane + 64 * j));
#pragma unroll
          for (int j = 0; j < 4; ++j) { const f32x4 h = v[j] * gv[j] * (1.f + sc[j]); u32x2 o; o.x = pk2(h[0], h[1]); o.y = pk2(h[2], h[3]);
              *(u32x2*)(H + (size_t)m * D + 4 * (lane + 64 * j)) = o; }
      } }
    for (int it = gw; it < 4 * 8192; it += NGW) {
        const int l = it >> 13, which = (it >> 12) & 1, n = it & 4095, i = l >> 1; const bool conv = (l & 1) != 0;
        const int N = which ? 4096 : (conv ? 2048 : 3072);
        if (n >= N) continue;
        const bf16* wrow = Wt + (which ? W_UP + (size_t)l * 4 * MEL : (conv ? W_PW1 + (size_t)i * 2 * MEL : W_QKV + (size_t)i * 3 * MEL)) + (size_t)n * D;
        float wv[16];
#pragma unroll
        for (int jj = 0; jj < 4; ++jj) { const u32x2 w = *(const u32x2*)(wrow + 4 * (lane + 64 * jj)); wv[4 * jj] = bflo(w.x); wv[4 * jj + 1] = bfhi(w.x); wv[4 * jj + 2] = bflo(w.y); wv[4 * jj + 3] = bfhi(w.y); }
#pragma unroll
        for (int cond = 0; cond < 5; ++cond) { const float* sh = mod + (size_t)(l * 5 + cond) * 6144 + (which ? 3 : 0) * 1024; float dot = 0.f;
#pragma unroll
            for (int jj = 0; jj < 4; ++jj) { const f32x4 s4 = *(const f32x4*)(sh + 4 * (lane + 64 * jj)); dot += (s4[0] * wv[4 * jj] + s4[1] * wv[4 * jj + 1]) + (s4[2] * wv[4 * jj + 2] + s4[3] * wv[4 * jj + 3]); }
            dot = wave_sum_dpp(dot); if (lane == 0) shw[(size_t)((l * 2 + which) * 5 + cond) * 4096 + n] = dot; }
    }
}

constexpr float SCL = 0.125f * 1.4426950408889634f, LOG2E = 1.4426950408889634f;
__device__ __forceinline__ void vt_write(LAS bf16* Vt, int pitch, int slot, int chunk, u32x4 v) {
    LAS bf16* p = Vt + (8 * chunk) * pitch + (slot ^ (chunk << 2));
    p[0] = (bf16)(v.x & 0xffffu); p[pitch] = (bf16)(v.x >> 16); p[2 * pitch] = (bf16)(v.y & 0xffffu); p[3 * pitch] = (bf16)(v.y >> 16);
    p[4 * pitch] = (bf16)(v.z & 0xffffu); p[5 * pitch] = (bf16)(v.z >> 16); p[6 * pitch] = (bf16)(v.w & 0xffffu); p[7 * pitch] = (bf16)(v.w >> 16);
}
template <int NB> __device__ __forceinline__ void softmax_part(f32x4 (&s)[NB], float& mx_out, float& sum_out, int lane, float m_floor = -INFINITY) {
    float mx = m_floor;
#pragma unroll
    for (int b = 0; b < NB; ++b) mx = fmaxf(mx, fmaxf(fmaxf(s[b][0], s[b][1]), fmaxf(s[b][2], s[b][3])));
    mx = fmaxf(mx, shx(mx, 16, lane)); mx = fmaxf(mx, shx(mx, 32, lane));
    float sum = 0.f;
#pragma unroll
    for (int b = 0; b < NB; ++b) {
#pragma unroll
        for (int e = 0; e < 4; ++e) { s[b][e] = __builtin_amdgcn_exp2f(s[b][e] - mx); sum += s[b][e]; } }
    sum += shx(sum, 16, lane); sum += shx(sum, 32, lane);
    mx_out = mx; sum_out = sum;
}
__device__ __forceinline__ bf16x8 pack_p(const f32x4& a, const f32x4& b) {
    u32x4 w; w.x = pk2(a[0], a[1]); w.y = pk2(a[2], a[3]); w.z = pk2(b[0], b[1]); w.w = pk2(b[2], b[3]); return __builtin_bit_cast(bf16x8, w);
}
__device__ __forceinline__ bf16x8 vt_read(const LAS bf16* p0, const LAS bf16* p1) {
    const s16x4 a = *(const LAS s16x4*)p0, b = *(const LAS s16x4*)p1; return (bf16x8){a[0], a[1], a[2], a[3], b[0], b[1], b[2], b[3]};
}
__device__ __forceinline__ f32x4 qk_block(const bf16* kp, const bf16x8& qf0, const bf16x8& qf1) {
    const bf16x8 k0 = *(const bf16x8*)kp, k1 = *(const bf16x8*)(kp + 32);
    f32x4 a = __builtin_amdgcn_mfma_f32_16x16x32_bf16(k0, qf0, (f32x4){0.f, 0.f, 0.f, 0.f}, 0, 0, 0);
    return __builtin_amdgcn_mfma_f32_16x16x32_bf16(k1, qf1, a, 0, 0, 0);
}
#define PV16(o, s, SLOT_EXPR, PITCH_) do { _Pragma("unroll") for (int pp = 0; pp < 8; ++pp) { const bf16x8 pf = pack_p(s[2 * pp], s[2 * pp + 1]); const int slot0 = (SLOT_EXPR); \
        _Pragma("unroll") for (int db = 0; db < 4; ++db) { const LAS bf16* vr = Vt + (16 * db + l15) * (PITCH_); const int sw_ = (2 * db + (l15 >> 3)) << 2; \
            o[db] = __builtin_amdgcn_mfma_f32_16x16x32_bf16(vt_read(vr + (slot0 ^ sw_), vr + ((slot0 + 16) ^ sw_)), pf, o[db], 0, 0, 0); } } } while (0)

#ifndef CBN
#define CBN 4
#endif
__device__ __forceinline__ void attn_phase(const bf16* Qb, const bf16* Kb, const bf16* Vb, bf16* Ob, const bf16* CK, const bf16* CV, const float* rpb  ,
                                           int li, LAS unsigned char* lds, int tid, int lane, int wave, int G, int bid, int ulo, int uhi) {
    LAS bf16* Vt = (LAS bf16*)lds; LAS float* rpl = (LAS float*)(lds + 110592); LAS unsigned char* Kc = lds + LDS_KC;
    for (int u = bid + ulo; u < uhi; u += G) {
        int lz_ = lane; asm volatile("" : "+v"(lz_));
        const int l15 = lz_ & 15, g = lz_ >> 4;
        if (u < 512) {
            const int b = u >> 4, h = u & 15; constexpr int PITCH = 264;
            const int qrow0 = b * 256 + 32 * wave + l15;
            const bf16x8 qa0 = __builtin_nontemporal_load((const bf16x8*)(Qb + (size_t)qrow0 * D + h * 64 + 8 * g)), qa1 = __builtin_nontemporal_load((const bf16x8*)(Qb + (size_t)qrow0 * D + h * 64 + 32 + 8 * g));
            const bf16x8 qb0 = __builtin_nontemporal_load((const bf16x8*)(Qb + (size_t)(qrow0 + 16) * D + h * 64 + 8 * g)), qb1 = __builtin_nontemporal_load((const bf16x8*)(Qb + (size_t)(qrow0 + 16) * D + h * 64 + 32 + 8 * g));
            SB0();
            { int t2 = tid; asm volatile("" : "+v"(t2));
              u32x4 v[4], kv[4];
#pragma unroll
              for (int it = 0; it < 4; ++it) { const int idx = t2 + NTHR * it, key = idx >> 3, chunk = idx & 7; const size_t off = (size_t)(b * 256 + key) * D + h * 64 + 8 * chunk;
                  v[it] = *(const u32x4*)(Vb + off); kv[it] = *(const u32x4*)(Kb + off); }
              SB0();
#pragma unroll
              for (int it = 0; it < 4; ++it) { const int idx = t2 + NTHR * it, key = idx >> 3, chunk = idx & 7;
                  *(LAS u32x4*)(Kc + key * 144 + chunk * 16) = kv[it];
                  vt_write(Vt, PITCH, key, chunk, v[it]); } }
            __syncthreads();
            SB0();
            f32x4 s0[16], s1[16];
            { const LAS unsigned char* kl = Kc + l15 * 144 + g * 16;
              sfor<16>([&](auto I) __attribute__((always_inline)) { constexpr int kb = decltype(I)::value;
                const bf16x8 k0 = *(const LAS bf16x8*)(kl + kb * (16 * 144)), k1 = *(const LAS bf16x8*)(kl + kb * (16 * 144) + 64);
                f32x4 a = __builtin_amdgcn_mfma_f32_16x16x32_bf16(k0, qa0, (f32x4){0.f, 0.f, 0.f, 0.f}, 0, 0, 0); s0[kb] = __builtin_amdgcn_mfma_f32_16x16x32_bf16(k1, qa1, a, 0, 0, 0) * SCL;
                f32x4 c = __builtin_amdgcn_mfma_f32_16x16x32_bf16(k0, qb0, (f32x4){0.f, 0.f, 0.f, 0.f}, 0, 0, 0); s1[kb] = __builtin_amdgcn_mfma_f32_16x16x32_bf16(k1, qb1, c, 0, 0, 0) * SCL; }); }
            { float mx, sum; softmax_part<16>(s0, mx, sum, lane);
              f32x4 o[4];
#pragma unroll
              for (int db = 0; db < 4; ++db) o[db] = (f32x4){0.f, 0.f, 0.f, 0.f};
              PV16(o, s0, 32 * pp + 4 * g, PITCH);
              const float rl = 1.0f / sum;
#pragma unroll
              for (int db = 0; db < 4; ++db) { const f32x4 ov = o[db] * rl; u32x2 w; w.x = pk2(ov[0], ov[1]); w.y = pk2(ov[2], ov[3]);
                  *(u32x2*)(Ob + (size_t)qrow0 * D + h * 64 + 16 * db + 4 * g) = w; } }
            { float mx, sum; softmax_part<16>(s1, mx, sum, lane);
              f32x4 o[4];
#pragma unroll
              for (int db = 0; db < 4; ++db) o[db] = (f32x4){0.f, 0.f, 0.f, 0.f};
              PV16(o, s1, 32 * pp + 4 * g, PITCH);
              const float rl = 1.0f / sum;
#pragma unroll
              for (int db = 0; db < 4; ++db) { const f32x4 ov = o[db] * rl; u32x2 w; w.x = pk2(ov[0], ov[1]); w.y = pk2(ov[2], ov[3]);
                  *(u32x2*)(Ob + (size_t)(qrow0 + 16) * D + h * 64 + 16 * db + 4 * g) = w; } }
            __syncthreads();
        } else {
            const int ui = u - 512, xcd = ui & 7, idx = (ui >> 3) & 63, uu = (G == 256) ? ((xcd * 8 + (idx >> 3)) << 3) + (idx & 7) : ui;
            const int b = uu >> 7, h = (uu >> 3) & 15, rp = uu & 7, r0 = 2 * rp; constexpr int PITCH = 840;
            const int rs0 = min(max(r0 - 4, 0), 8);
            const size_t tokb = (size_t)MP + (size_t)b * 1024;
            const int r = r0 + (wave >> 2), j = wave & 3, rs = min(max(r - 4, 0), 8), rrel = rs - rs0, kcs = min(max(16 * j - 8, 0), 32);
            const int qcol = 16 * j + l15, wst = min(max(qcol - 8, 0), 48);
            const size_t qtok = tokb + r * 64 + qcol;
            const bf16* kloc = Kb + (tokb + rs * 64 + kcs + l15) * D + h * 64 + 8 * g;
            bf16x8 kf[16][2];
#define LOAD_KLOC(H) sfor<8>([&](auto I) __attribute__((always_inline)) { constexpr int lb = 8 * (H) + decltype(I)::value; const bf16* kp = kloc + (size_t)((lb >> 1) * 64 + 16 * (lb & 1)) * D; kf[lb][0] = *(const bf16x8*)kp; kf[lb][1] = *(const bf16x8*)(kp + 32); })
            LOAD_KLOC(0);
            const bf16x8 qf0 = __builtin_nontemporal_load((const bf16x8*)(Qb + qtok * D + h * 64 + 8 * g)), qf1 = __builtin_nontemporal_load((const bf16x8*)(Qb + qtok * D + h * 64 + 32 + 8 * g));
            SB0();
            { int t2 = tid; asm volatile("" : "+v"(t2));
              u32x4 vv[13], kv[4];
#pragma unroll
              for (int it = 0; it < 13; ++it) { const int idx = t2 + NTHR * it, slot = idx >> 3, chunk = idx & 7;
                  const bf16* src = (slot < 576) ? Vb + (tokb + min(rs0 + (slot >> 6), 15) * 64 + (slot & 63)) * D + h * 64 : CV + ((size_t)(b * 2 + li) * 256 + (slot - 576)) * D + h * 64;
                  vv[it] = *(const u32x4*)(src + 8 * chunk); }
#pragma unroll
              for (int it = 0; it < 4; ++it) { const int idx = t2 + NTHR * it, key = idx >> 3, chunk = idx & 7;
                  kv[it] = *(const u32x4*)(CK + ((size_t)(b * 2 + li) * 256 + key) * D + h * 64 + 8 * chunk); }
              const float rv = rpb[h * 465 + min(t2, 464)];
              SB0();
#pragma unroll
              for (int it = 0; it < 13; ++it) { const int idx = t2 + NTHR * it; vt_write(Vt, PITCH, idx >> 3, idx & 7, vv[it]); }
#pragma unroll
              for (int it = 0; it < 4; ++it) { const int idx = t2 + NTHR * it; *(LAS u32x4*)(Kc + (idx >> 3) * 144 + (idx & 7) * 16) = kv[it]; }
              if (t2 < 465) rpl[t2] = rv; }
            SB0(); LOAD_KLOC(1); SB0();
            __syncthreads();
            SB0();
            f32x4 o1[4]; float m1, l1, m2, l2;
#pragma unroll
            for (int db = 0; db < 4; ++db) o1[db] = (f32x4){0.f, 0.f, 0.f, 0.f};
            {
                int dcv[8]; unsigned vmask = 0u;
#pragma unroll
                for (int ce = 0; ce < 8; ++ce) { const int kc = kcs + 16 * (ce >> 2) + 4 * g + (ce & 3); vmask |= ((kc >= wst) && (kc < wst + 16)) ? (1u << ce) : 0u; dcv[ce] = min(max(kc - qcol + 15, 0), 30); }
                f32x4 s[16];
#define QK_LOC(H) sfor<8>([&](auto I) __attribute__((always_inline)) { constexpr int lb = 8 * (H) + decltype(I)::value, krow = lb >> 1, ch = lb & 1; \
                    f32x4 a = __builtin_amdgcn_mfma_f32_16x16x32_bf16(kf[lb][0], qf0, (f32x4){0.f, 0.f, 0.f, 0.f}, 0, 0, 0); a = __builtin_amdgcn_mfma_f32_16x16x32_bf16(kf[lb][1], qf1, a, 0, 0, 0); \
                    const LAS float* rp_row = rpl + (rs + krow - r + 7) * 31; float bias[4]; \
                    _Pragma("unroll") for (int e = 0; e < 4; ++e) bias[e] = rp_row[dcv[ch * 4 + e]]; \
                    _Pragma("unroll") for (int e = 0; e < 4; ++e) { const float t = a[e] * SCL + bias[e] * LOG2E; a[e] = ((vmask >> (ch * 4 + e)) & 1u) ? t : -INFINITY; } \
                    s[lb] = a; })
                QK_LOC(0); QK_LOC(1); SB0();
                softmax_part<16>(s, m1, l1, lane);
                PV16(o1, s, (rrel + pp) * 64 + kcs + 4 * g, PITCH);
            }
            SB0();
            {
                f32x4 s[16];
                { const LAS unsigned char* kl = Kc + l15 * 144 + g * 16;
                  sfor<16>([&](auto I) __attribute__((always_inline)) { constexpr int cb = decltype(I)::value;
                    const bf16x8 k0 = *(const LAS bf16x8*)(kl + cb * (16 * 144)), k1 = *(const LAS bf16x8*)(kl + cb * (16 * 144) + 64);
                    f32x4 a = __builtin_amdgcn_mfma_f32_16x16x32_bf16(k0, qf0, (f32x4){0.f, 0.f, 0.f, 0.f}, 0, 0, 0); s[cb] = __builtin_amdgcn_mfma_f32_16x16x32_bf16(k1, qf1, a, 0, 0, 0) * SCL; }); }
                softmax_part<16>(s, m2, l2, lane, m1);
                const float a1 = __builtin_amdgcn_exp2f(m1 - m2);
#pragma unroll
                for (int db = 0; db < 4; ++db) o1[db] = o1[db] * a1;
                l1 = l1 * a1 + l2;
                PV16(o1, s, 576 + 32 * pp + 4 * g, PITCH);
            }
            const float rl = 1.0f / l1;
            int r2_ = r; asm volatile("" : "+s"(r2_));
            const size_t qtok2 = tokb + r2_ * 64 + qcol;
#pragma unroll
            for (int db = 0; db < 4; ++db) { const f32x4 ov = o1[db] * rl; u32x2 w; w.x = pk2(ov[0], ov[1]); w.y = pk2(ov[2], ov[3]);
                *(u32x2*)(Ob + qtok2 * D + h * 64 + 16 * db + 4 * g) = w; }
            __syncthreads();
        }
    }
}

#define RLX_AGENT __ATOMIC_RELAXED, __HIP_MEMORY_SCOPE_AGENT
#define XB_TMO      128
#define XB_XCNT(j)  (256  + 64 * (j))
#define XB_XSUB(j)  (1280 + 64 * (j))
#define XB_XGEN(j)  (2304 + 64 * (j))
#define XB_TOP      3328
#define XB_TOPGEN   3392
#define XCD_BAR_WORDS 3456
#define XB_SPIN_CAP (1u << 18)

__device__ __forceinline__ unsigned xb_ld(unsigned* p)              { return __hip_atomic_load(p, __ATOMIC_RELAXED, __HIP_MEMORY_SCOPE_AGENT); }
__device__ __forceinline__ unsigned xb_add(unsigned* p, unsigned v) { return __hip_atomic_fetch_add(p, v, __ATOMIC_RELAXED, __HIP_MEMORY_SCOPE_AGENT); }
__device__ __forceinline__ unsigned xb_xcc_id() { return (unsigned)__builtin_amdgcn_s_getreg((3 << 11) | 20) & 0xFu; }
#define XB_SPIN(cond, bar) do { unsigned _sp = 0; while (cond) { __builtin_amdgcn_s_sleep(1); \
    if ((++_sp & 255u) == 0u) { if (xb_ld(&(bar)[XB_TMO])) break; if (_sp > XB_SPIN_CAP) { atomicAdd(&(bar)[XB_TMO], 1u); break; } } } } while (0)

struct XcdBarrier {
    unsigned* bar; unsigned x;
    volatile LAS unsigned* st;
};

__device__ __forceinline__ XcdBarrier xcd_barrier_post(unsigned* bar, volatile LAS unsigned* st) {
    XcdBarrier b; b.bar = bar; b.x = xb_xcc_id(); b.st = st;
    if (threadIdx.x == 0) (void)xb_add(&bar[XB_XCNT(b.x)], 1u);
    return b;
}
__device__ __forceinline__ void xcd_barrier_complete(unsigned* bar, unsigned x, unsigned& nloc, unsigned& nx) {
    const unsigned G = gridDim.x * gridDim.y * gridDim.z;
    unsigned sum, cnt, mine, sp = 0u;
    for (;;) {
        sum = 0u; cnt = 0u; mine = 0u;
#pragma unroll
        for (unsigned j = 0; j < 16; ++j) { const unsigned c = xb_ld(&bar[XB_XCNT(j)]); sum += c; cnt += (c > 0u) ? 1u : 0u; mine = (j == x) ? c : mine; }
        if (sum == G) break;
        __builtin_amdgcn_s_sleep(1);
        if ((++sp & 255u) == 0u) { if (xb_ld(&bar[XB_TMO])) break; if (sp > XB_SPIN_CAP) { atomicAdd(&bar[XB_TMO], 1u); break; } }
    }
    nloc = mine > 0u ? mine : 1u; nx = cnt > 0u ? cnt : 1u;
}

__device__ __forceinline__ void xcd_barrier(const XcdBarrier& b) {
    asm volatile("s_waitcnt vmcnt(0)" ::: "memory");
    __syncthreads();
    if (threadIdx.x == 0) {
        unsigned* bar = b.bar;
        __builtin_amdgcn_s_waitcnt(0);
        unsigned nloc = b.st[0], nx = b.st[1];
        if (nloc == 0u) { xcd_barrier_complete(bar, b.x, nloc, nx); b.st[0] = nloc; b.st[1] = nx; }
        const unsigned old = xb_add(&bar[XB_XSUB(b.x)], 1u);
        const unsigned gen = old / nloc;
        if (old + 1u == (gen + 1u) * nloc) {
            __builtin_amdgcn_fence(__ATOMIC_RELEASE, "agent");
            asm volatile("s_waitcnt vmcnt(0)" ::: "memory");
            const unsigned og = xb_add(&bar[XB_TOP], 1u);
            if (og + 1u == (gen + 1u) * nx) xb_add(&bar[XB_TOPGEN], 1u);
            else XB_SPIN(xb_ld(&bar[XB_TOPGEN]) == gen, bar);
            __builtin_amdgcn_fence(__ATOMIC_ACQUIRE, "agent");
            asm volatile("s_waitcnt vmcnt(0)" ::: "memory");
        } else {
            XB_SPIN(xb_ld(&bar[XB_TOPGEN]) == gen, bar);
            __builtin_amdgcn_fence(__ATOMIC_ACQUIRE, "agent");
            asm volatile("s_waitcnt vmcnt(0)" ::: "memory");
        }
    }
    __syncthreads();
}

constexpr int NPH = 2 + 5 * NL + 1;
struct Args { const float* in[21]; float* out; unsigned char* ws; int nprog, pad; int prog[48]; };
typedef const __attribute__((address_space(4))) Args* KArgPtr;
__global__ void __launch_bounds__(NTHR, 2) fwd_kernel(Args a_unused) {
    extern __shared__ __attribute__((aligned(16))) unsigned char lds_raw[];
    LAS unsigned char* lds = (LAS unsigned char*)lds_raw;
    cg::grid_group grid = cg::this_grid();
    const int wave0 = __builtin_amdgcn_readfirstlane((int)threadIdx.x >> 6);
    { volatile LAS unsigned* st0 = (volatile LAS unsigned*)(lds + LDS_ST); if (threadIdx.x < 2) st0[threadIdx.x] = 0u; }
    __syncthreads();
    XcdBarrier xbar; { KArgPtr kpb = (KArgPtr)__builtin_amdgcn_kernarg_segment_ptr(); xbar.bar = (unsigned*)kpb->ws; xbar.x = 0; xbar.st = (volatile LAS unsigned*)(lds + LDS_ST);
        if (blockIdx.x == 0) { for (int wI = threadIdx.x; wI < XCD_BAR_WORDS; wI += NTHR) __hip_atomic_store(xbar.bar + wI, 0u, __ATOMIC_RELAXED, __HIP_MEMORY_SCOPE_AGENT); } }
    int nprog; { KArgPtr kp0 = (KArgPtr)__builtin_amdgcn_kernarg_segment_ptr(); nprog = kp0->nprog; }
    for (int pc = 0; pc < nprog; ++pc) {
        KArgPtr kp = (KArgPtr)__builtin_amdgcn_kernarg_segment_ptr(); asm volatile("" : "+s"(kp));
        int z_ = 0; asm volatile("" : "+s"(z_));
        const int lane_ = (int)__builtin_amdgcn_mbcnt_hi(~0u, __builtin_amdgcn_mbcnt_lo(~0u, (unsigned)z_)); const int tid_ = wave0 * 64 + lane_;
        int bid_ = (int)__builtin_amdgcn_workgroup_id_x(), G_ = (int)gridDim.x; asm volatile("" : "+s"(bid_), "+s"(G_));
        const int pe_ = kp->prog[pc]; const int ph = pe_ & 63, amode = pe_ >> 6;
        const int tid = tid_, lane = lane_, wave = wave0, G = G_, bid = bid_;
        const int gw = bid * NWAVES + wave, NGW = G * NWAVES;
        Ptrs P; P = Ptrs{kp->in[0], kp->in[1], kp->in[2], kp->in[3], kp->in[4], kp->in[5], kp->in[6], kp->in[7], kp->in[8], kp->in[9], kp->in[10], kp->in[11], kp->in[12], kp->in[13], kp->in[14], kp->in[15], kp->in[16], kp->in[17], kp->in[18], kp->in[19], kp->in[20]};
        unsigned char* ws = kp->ws; float* outp = kp->out;
        float* mod = (float*)(ws + WS_MOD); bf16* Wt = (bf16*)(ws + WS_W); bf16* X = (bf16*)(ws + WS_X); bf16* H = (bf16*)(ws + WS_H);
        bf16* R = (bf16*)(ws + WS_R); bf16* Qb = R; bf16* Kb = R + (size_t)M * D; bf16* Vb = R + (size_t)2 * M * D; bf16* Ob = R + (size_t)3 * M * D;
        bf16* Ub = R; bf16* Vc = R + (size_t)M * D; bf16* Fb = R;
        const bf16* CK = (const bf16*)(ws + WS_CK); const bf16* CV = (const bf16*)(ws + WS_CV);
        float* out_y = outp; float* out_ck = outp + (size_t)M * D; float* out_cv = out_ck + (size_t)32 * 2 * 256 * 1024;
        float* SS = (float*)(ws + WS_SS); float* SHW = (float*)(ws + WS_SHW);
        if (ph == 0) { p0_phase(P, ws, lds, tid, lane, wave, G, bid); }
        else if (ph == 1) { prep_phase(P.x_prompt, P.x_sample, H, SS, P.norm_g, mod + 1 * 1024, mod, Wt, SHW, gw, NGW, lane); }
        else if (ph == NPH - 1) { final_norm_phase(X, out_y, P.final_g, gw, NGW, lane); }
        else if (ph >= 60) { }
        else {
            const int l = (ph - 2) / 5, s = (ph - 2) % 5, i = l >> 1; const bool conv = (l & 1) != 0;
            const float* modl = mod + (size_t)l * 5 * 6144;
            if (s == 0) {
                const float* ssl = SS + (size_t)(2 * l) * M; const float* shl = SHW + (size_t)((2 * l) * 5) * 4096;
                if (!conv) { pg8::Gemm gm{H, Wt + W_QKV + (size_t)i * 3 * MEL, M, 3 * D, D}; pg8::StaticOrder S; S.init(M, 3 * D, G, bid);
                    pg8::EpiQKV E{ssl, shl, Qb, (size_t)M * D, out_ck + (size_t)i * 256 * 1024, (size_t)32 * 2 * 256 * 1024};
                    pg8::gemm_phase<pg8::EpiQKV, pg8::StaticOrder, true, true>(lds, gm, S, E, tid); }
                else { pg8::Gemm gm{H, Wt + W_PW1 + (size_t)i * 2 * MEL, M, 2 * D, D}; pg8::StaticOrder S; S.init(M, 2 * D, G, bid);
                    pg8::EpiGLU E{ssl, shl, Ub};
                    pg8::gemm_phase<pg8::EpiGLU, pg8::StaticOrder, true, true>(lds, gm, S, E, tid); }
            } else if (s == 1) {
                if (!conv) attn_phase(Qb, Kb, Vb, Ob, CK, CV, P.rpb + (size_t)i * 16 * 15 * 31, i, lds, tid, lane, wave, G, bid, amode == 2 ? 512 : 0, amode == 1 ? 512 : 1024);
                else conv_phase(Ub, Vc, P.w_dw + (size_t)i * 31 * D, P.b_dw + i * D, P.ln_g + i * D, P.ln_b + i * D, lds, tid, lane, wave, G, bid);
            } else if (s == 2 || s == 4) {
                pg8::Gemm gm; pg8::EpiRes E;
                if (s == 2) { gm = pg8::Gemm{conv ? Vc : Ob, Wt + (conv ? W_PW2 : W_O) + (size_t)i * MEL, M, D, D};
                    E = pg8::EpiRes{P.x_prompt, P.x_sample, l == 0 ? (const bf16*)nullptr : X, X, modl + 2 * 1024, H, P.norm_g + (l * 2 + 1) * D, modl + 4 * 1024, SS + (size_t)(2 * l + 1) * M}; }
                else { gm = pg8::Gemm{Fb, Wt + W_DOWN + (size_t)l * 4 * MEL, M, D, FF};
                    E = pg8::EpiRes{P.x_prompt, P.x_sample, X, X, modl + 5 * 1024, l < NL - 1 ? H : nullptr, P.norm_g + ((l + 1) * 2) * D, modl + 5 * 6144 + 1 * 1024, SS + (size_t)(2 * l + 2) * M}; }
                pg8::StaticOrder S; S.init(M, D, G, bid);
                pg8::gemm_phase<pg8::EpiRes, pg8::StaticOrder, true, true>(lds, gm, S, E, tid);
            } else {
#ifdef UP256
                pg8::Gemm gm{H, Wt + W_UP + (size_t)l * 4 * MEL, M, FF, D}; pg8::StaticOrder256 S; S.init(M, FF, G, bid);
                pg8::EpiUp256 E{SS + (size_t)(2 * l + 1) * M, SHW + (size_t)((2 * l + 1) * 5) * 4096, Fb, FF};
                pg8::gemm_phase256<pg8::EpiUp256, pg8::StaticOrder256, true, true>(lds, gm, S, E, tid);
#else
                pg8::Gemm gm{H, Wt + W_UP + (size_t)l * 4 * MEL, M, FF, D}; pg8::StaticOrder S; S.init(M, FF, G, bid);
                pg8::EpiUp E{SS + (size_t)(2 * l + 1) * M, SHW + (size_t)((2 * l + 1) * 5) * 4096, Fb, FF};
                pg8::gemm_phase<pg8::EpiUp, pg8::StaticOrder, true, true>(lds, gm, S, E, tid);
#endif
            }
        }
        if (pc + 1 < nprog) { if (pc == 0) { grid.sync(); xbar = xcd_barrier_post(xbar.bar, xbar.st); } else xcd_barrier(xbar); }
    }
}

#ifndef SINGLE_LAUNCH
#define SINGLE_LAUNCH 0
#endif
extern "C" void kernel_launch(void* const* d_in, const int* in_sizes, int n_in, void* d_out, int out_size, void* d_ws, size_t ws_size, hipStream_t stream) {
    static int grid = 0;
    if (grid == 0) {
        if (n_in != 21 || ws_size < WS_END) { fprintf(stderr, "kernel_launch: unexpected n_in %d / ws_size %zu\n", n_in, ws_size); grid = -1; return; }
        int dev = 0, cus = 0, per_cu = 0;
        hipGetDevice(&dev); hipDeviceGetAttribute(&cus, hipDeviceAttributeMultiprocessorCount, dev);
        hipFuncSetAttribute((const void*)fwd_kernel, hipFuncAttributeMaxDynamicSharedMemorySize, LDS_BYTES);
        hipOccupancyMaxActiveBlocksPerMultiprocessor(&per_cu, (const void*)fwd_kernel, NTHR, LDS_BYTES);
        if (per_cu < 1) { fprintf(stderr, "kernel_launch: occupancy query says %d blocks/CU\n", per_cu); per_cu = 1; }
        (void)hipGetLastError();
        grid = cus * per_cu;
    }
    if (grid < 0) return;
    Args a{};
    for (int i = 0; i < 21; ++i) a.in[i] = (const float*)d_in[i];
    a.out = (float*)d_out; a.ws = (unsigned char*)d_ws;
#if SINGLE_LAUNCH
    { int n = 0;
      for (int ph = 0; ph < NPH; ++ph) { a.prog[n++] = ph;
#ifdef PROBE_ATTN_MODE
          if (ph >= 2 && ph < NPH - 1 && (ph - 2) % 5 == 1 && ((ph - 2) / 5) % 2 == 0) a.prog[n++] = ph | (PROBE_ATTN_MODE << 6);
#endif
#ifdef PROBE_EMPTY
          if (ph == 5) for (int q = 0; q < PROBE_EMPTY; ++q) a.prog[n++] = 60;
#endif
#ifdef PROBE_REPEAT_P0
          if (ph == 0) a.prog[n++] = 0;
#endif
#ifdef PROBE_REPEAT_S
          if (ph >= 2 && ph < NPH - 1 && (ph - 2) % 5 == PROBE_REPEAT_S && (PROBE_REPEAT_PAR < 0 || ((ph - 2) / 5) % 2 == PROBE_REPEAT_PAR)) a.prog[n++] = ph;
#endif
      }
      a.nprog = n; }
    void* args[] = {&a};
    hipError_t e = hipLaunchCooperativeKernel((const void*)fwd_kernel, dim3(grid), dim3(NTHR), args, LDS_BYTES, stream);
    if (e != hipSuccess) fprintf(stderr, "cooperative launch failed: %s (grid %d)\n", hipGetErrorString(e), grid);
#else
    for (int ph = 0; ph < NPH; ++ph) { a.nprog = 1; a.prog[0] = ph; hipLaunchKernelGGL(fwd_kernel, dim3(grid), dim3(NTHR), LDS_BYTES, stream, a); }
#endif
}
```
